# Optimizing an MI355X kernel written in HIP

```python
import jax, jax.numpy as jnp
from jax import lax
import numpy as np

D_MODEL = 1024
BATCH = 16
SEQ = 256
DEPTH = 2
DEC_BATCH = 8
DEC_SEQ = 4096
PAST_LEN = 512

GRID_W = 64
HEAD_DIM = 128
N_Q_HEADS = 8
N_KV_HEADS = 2
Q_PER_KV = N_Q_HEADS // N_KV_HEADS
ATTN_WIDTH = N_Q_HEADS * HEAD_DIM
KV_WIDTH = N_KV_HEADS * HEAD_DIM
Q_BLOCK = 128
ROPE_THETA = 10000.0
ROPE_PAIRS = HEAD_DIM // 4
POOL_WINDOWS = (2, 4, 8, 16)
N_POOL_GROUPS = 4
POOL_WIDTH = D_MODEL // 2
POOL_GROUP_DIM = POOL_WIDTH // N_POOL_GROUPS
CHUNK = 128
N_SGU_GROUPS = 4
SGU_WIDTH = D_MODEL // 2
SGU_GROUP_DIM = SGU_WIDTH // N_SGU_GROUPS
N_BRANCHES = 3
IN_WIDTH = ATTN_WIDTH + 2 * KV_WIDTH + POOL_WIDTH + 2 * SGU_WIDTH + N_BRANCHES * D_MODEL
SPLIT_Q = ATTN_WIDTH
SPLIT_K = SPLIT_Q + KV_WIDTH
SPLIT_V = SPLIT_K + KV_WIDTH
SPLIT_POOL = SPLIT_V + POOL_WIDTH
SPLIT_U = SPLIT_POOL + SGU_WIDTH
SPLIT_SV = SPLIT_U + SGU_WIDTH
D_FF = ((8 * D_MODEL + 3 * 256 - 1) // (3 * 256)) * 256
DEEPNORM_ALPHA = (2 * DEPTH) ** 0.25
DEEPNORM_BETA = (8 * DEPTH) ** -0.25
EPS = 1e-6

kernel_name = "hybrid_dit_gated_attn_pool_sgu_step"


def layer_norm(x, g, b):
    xf = x.astype(jnp.float32)
    mu = jnp.mean(xf, axis=-1, keepdims=True)
    xc = xf - mu
    var = jnp.mean(xc * xc, axis=-1, keepdims=True)
    y = xc * lax.rsqrt(var + EPS) * g.astype(jnp.float32) + b.astype(jnp.float32)
    return y.astype(x.dtype)


def plain_layer_norm(x):
    xf = x.astype(jnp.float32)
    mu = jnp.mean(xf, axis=-1, keepdims=True)
    xc = xf - mu
    var = jnp.mean(xc * xc, axis=-1, keepdims=True)
    return (xc * lax.rsqrt(var + EPS)).astype(x.dtype)


def rms_norm(x, g):
    xf = x.astype(jnp.float32)
    y = xf * lax.rsqrt(jnp.mean(xf * xf, axis=-1, keepdims=True) + EPS) * g.astype(jnp.float32)
    return y.astype(x.dtype)


def axial_rope_tables(rows):
    row = jnp.repeat(jnp.arange(rows), GRID_W).astype(jnp.float32)
    col = jnp.tile(jnp.arange(GRID_W), rows).astype(jnp.float32)
    inv_freq = ROPE_THETA ** (-jnp.arange(ROPE_PAIRS, dtype=jnp.float32) / ROPE_PAIRS)
    ang = jnp.stack([row[:, None] * inv_freq, col[:, None] * inv_freq], axis=1)
    return jnp.cos(ang), jnp.sin(ang)


def apply_axial_rope(x, cos, sin):
    B, S, H, _ = x.shape
    xr = x.astype(jnp.float32).reshape(B, S, H, 2, 2, ROPE_PAIRS)
    x1 = xr[..., 0, :]
    x2 = xr[..., 1, :]
    c = cos[None, :, None]
    s = sin[None, :, None]
    out = jnp.stack([x1 * c - x2 * s, x2 * c + x1 * s], axis=-2)
    return out.reshape(x.shape).astype(x.dtype)


def blocked_attention(q, k, v):
    B, S = q.shape[0], q.shape[1]
    nb = S // Q_BLOCK
    qb = q.reshape(B, nb, Q_BLOCK, N_KV_HEADS, Q_PER_KV, HEAD_DIM).transpose(1, 0, 2, 3, 4, 5)
    scale = HEAD_DIM ** -0.5

    def one_block(qblk):
        s = jnp.einsum('bqhgd,bkhd->bhgqk', qblk, k).astype(jnp.float32) * scale
        p = jax.nn.softmax(s, axis=-1)
        return jnp.einsum('bhgqk,bkhd->bqhgd', p.astype(v.dtype), v)

    out = lax.map(one_block, qb)
    return out.transpose(1, 0, 2, 3, 4, 5).reshape(B, S, ATTN_WIDTH)


def pool_mixer(xp, w_pg, pscale):
    B, S, _ = xp.shape
    xf = xp.astype(jnp.float32).reshape(B, S, N_POOL_GROUPS, POOL_GROUP_DIM)
    cs = jnp.concatenate([jnp.zeros((B, 1, N_POOL_GROUPS, POOL_GROUP_DIM), jnp.float32),
                          jnp.cumsum(xf, axis=1)], axis=1)
    w = jnp.array(POOL_WINDOWS, dtype=jnp.int32)[None, :]
    t = jnp.arange(S, dtype=jnp.int32)[:, None]
    lo = jnp.maximum(t - w // 2, 0)
    hi = jnp.minimum(t + (w - w // 2), S)
    g = jnp.arange(N_POOL_GROUPS, dtype=jnp.int32)[None, :]
    sums = cs[:, hi, g] - cs[:, lo, g]
    cnt = (hi - lo).astype(jnp.float32)[None, :, :, None]
    pooled = (sums / cnt - xf).astype(xp.dtype)
    y = jnp.einsum('bsgc,gcd->bsgd', pooled, w_pg).reshape(B, S, POOL_WIDTH)
    return y * pscale


def spatial_gating(u, v, w_s, b_s):
    B, S, _ = u.shape
    n = S // CHUNK
    vr = plain_layer_norm(v).reshape(B, n, CHUNK, N_SGU_GROUPS, SGU_GROUP_DIM)
    mixed = jnp.einsum('gpq,bnqgc->bnpgc', w_s, vr) + b_s.T[None, None, :, :, None]
    return u * mixed.reshape(B, S, SGU_WIDTH)


def trunk_layer(x, mod, rope, ctx_k, ctx_v, p):
    B, S, _ = x.shape
    sh1, sc1, g1, sh2, sc2, g2 = jnp.split(mod, 6, axis=-1)
    h = x * (1 + sc1) + sh1
    proj = h @ p['w_in']
    q, k, v, xp, xu, xv, gates = jnp.split(
        proj, [SPLIT_Q, SPLIT_K, SPLIT_V, SPLIT_POOL, SPLIT_U, SPLIT_SV], axis=-1)
    q = rms_norm(q.reshape(B, S, N_Q_HEADS, HEAD_DIM), p['q_norm_g'])
    k = rms_norm(k.reshape(B, S, N_KV_HEADS, HEAD_DIM), p['k_norm_g'])
    v = v.reshape(B, S, N_KV_HEADS, HEAD_DIM)
    if rope is None:
        k_all, v_all = k, v
    else:
        cos, sin = rope
        q = apply_axial_rope(q, cos, sin)
        k_lat = apply_axial_rope(k, cos, sin)
        k_all = jnp.concatenate([ctx_k, k_lat], axis=1)
        v_all = jnp.concatenate([ctx_v, v], axis=1)
    attn = blocked_attention(q, k_all, v_all)
    pool = pool_mixer(xp, p['w_pool_g'], p['pool_scale'])
    sgu = spatial_gating(jax.nn.gelu(xu, approximate=False), jax.nn.gelu(xv, approximate=False),
                         p['w_sgu'], p['b_sgu'])
    ga, gp, gs = jnp.split(jax.nn.sigmoid(gates), N_BRANCHES, axis=-1)
    merged = ga * (attn @ p['w_attn_o']) + gp * (pool @ p['w_pool_o']) + gs * (sgu @ p['w_sgu_o'])
    mix = merged @ p['w_out']
    x = layer_norm(DEEPNORM_ALPHA * x + g1 * mix, p['ln1_g'], p['ln1_b'])
    h2 = x * (1 + sc2) + sh2
    a, b = jnp.split(h2 @ p['w_ffn_in'], 2, axis=-1)
    f = (jax.nn.silu(a) * b) @ p['w_ffn_out']
    x = layer_norm(DEEPNORM_ALPHA * x + g2 * f, p['ln2_g'], p['ln2_b'])
    return x, k, v


def setup_inputs(seed: int = 0) -> dict:
    key = jax.random.key(seed)
    ks = jax.random.split(key, 25)
    nrm = jax.random.normal
    D = D_MODEL
    return {
        "x_prompt": nrm(ks[0], (BATCH, SEQ, D), jnp.float32),
        "x_sample": nrm(ks[1], (DEC_BATCH, DEC_SEQ, D), jnp.float32),
        "cache_k": nrm(ks[2], (DEC_BATCH, DEPTH, PAST_LEN, N_KV_HEADS, HEAD_DIM), jnp.float32),
        "cache_v": nrm(ks[3], (DEC_BATCH, DEPTH, PAST_LEN, N_KV_HEADS, HEAD_DIM), jnp.float32),
        "c": nrm(ks[4], (DEC_BATCH, D), jnp.float32),
        "c_ctx": nrm(ks[5], (D,), jnp.float32),
        "w_ada": nrm(ks[6], (DEPTH, D, 6 * D), jnp.float32) * (0.5 * D ** -0.5),
        "b_ada": nrm(ks[7], (DEPTH, 6 * D), jnp.float32) * 0.02,
        "w_in": nrm(ks[8], (DEPTH, D, IN_WIDTH), jnp.float32) * D ** -0.5,
        "q_norm_g": 1.0 + 0.02 * nrm(ks[9], (DEPTH, HEAD_DIM), jnp.float32),
        "k_norm_g": 1.0 + 0.02 * nrm(ks[10], (DEPTH, HEAD_DIM), jnp.float32),
        "w_pool_g": nrm(ks[11], (DEPTH, N_POOL_GROUPS, POOL_GROUP_DIM, POOL_GROUP_DIM), jnp.float32) * POOL_GROUP_DIM ** -0.5,
        "pool_scale": 1.0 + 0.1 * nrm(ks[12], (DEPTH, POOL_WIDTH), jnp.float32),
        "w_sgu": nrm(ks[13], (DEPTH, N_SGU_GROUPS, CHUNK, CHUNK), jnp.float32) * CHUNK ** -0.5,
        "b_sgu": 1.0 + 0.1 * nrm(ks[14], (DEPTH, N_SGU_GROUPS, CHUNK), jnp.float32),
        "w_attn_o": nrm(ks[15], (DEPTH, ATTN_WIDTH, D), jnp.float32) * (ATTN_WIDTH ** -0.5 * DEEPNORM_BETA),
        "w_pool_o": nrm(ks[16], (DEPTH, POOL_WIDTH, D), jnp.float32) * (POOL_WIDTH ** -0.5 * DEEPNORM_BETA),
        "w_sgu_o": nrm(ks[17], (DEPTH, SGU_WIDTH, D), jnp.float32) * (SGU_WIDTH ** -0.5 * DEEPNORM_BETA),
        "w_out": nrm(ks[18], (DEPTH, D, D), jnp.float32) * (D ** -0.5 * DEEPNORM_BETA),
        "ln1_g": 1.0 + 0.02 * nrm(ks[19], (DEPTH, D), jnp.float32),
        "ln1_b": 0.02 * nrm(ks[20], (DEPTH, D), jnp.float32),
        "w_ffn_in": nrm(ks[21], (DEPTH, D, 2 * D_FF), jnp.float32) * D ** -0.5,
        "w_ffn_out": nrm(ks[22], (DEPTH, D_FF, D), jnp.float32) * (D_FF ** -0.5 * DEEPNORM_BETA),
        "ln2_g": 1.0 + 0.02 * nrm(ks[23], (DEPTH, D), jnp.float32),
        "ln2_b": 0.02 * nrm(ks[24], (DEPTH, D), jnp.float32),
    }


def reference(x_prompt, x_sample, cache_k, cache_v, c, c_ctx, w_ada, b_ada, w_in, q_norm_g,
              k_norm_g, w_pool_g, pool_scale, w_sgu, b_sgu, w_attn_o, w_pool_o, w_sgu_o, w_out,
              ln1_g, ln1_b, w_ffn_in, w_ffn_out, ln2_g, ln2_b):
    rows = x_sample.shape[1] // GRID_W
    rope = axial_rope_tables(rows)
    silu_ctx = jax.nn.silu(c_ctx)
    silu_c = jax.nn.silu(c)
    y_p = x_prompt
    y_s = x_sample
    new_k = []
    new_v = []
    for l in range(DEPTH):
        p = {
            'w_in': w_in[l], 'q_norm_g': q_norm_g[l], 'k_norm_g': k_norm_g[l],
            'w_pool_g': w_pool_g[l], 'pool_scale': pool_scale[l],
            'w_sgu': w_sgu[l], 'b_sgu': b_sgu[l],
            'w_attn_o': w_attn_o[l], 'w_pool_o': w_pool_o[l], 'w_sgu_o': w_sgu_o[l],
            'w_out': w_out[l], 'ln1_g': ln1_g[l], 'ln1_b': ln1_b[l],
            'w_ffn_in': w_ffn_in[l], 'w_ffn_out': w_ffn_out[l],
            'ln2_g': ln2_g[l], 'ln2_b': ln2_b[l],
        }
        mod_ctx = (silu_ctx @ w_ada[l] + b_ada[l])[None, None, :]
        mod_lat = (silu_c @ w_ada[l] + b_ada[l])[:, None, :]
        y_p, k_ctx, v_ctx = trunk_layer(y_p, mod_ctx, None, None, None, p)
        new_k.append(k_ctx)
        new_v.append(v_ctx)
        y_s, _, _ = trunk_layer(y_s, mod_lat, rope, cache_k[:, l], cache_v[:, l], p)
    new_cache_k = jnp.stack(new_k, axis=1)
    new_cache_v = jnp.stack(new_v, axis=1)
    return (y_p, y_s, new_cache_k, new_cache_v)
```

```cpp
#include <hip/hip_runtime.h>
#include <hip/hip_bf16.h>
#include <hip/hip_cooperative_groups.h>
#include <cstdio>
#include <cstdint>
namespace cg = cooperative_groups;

#ifndef MK_MULTI
#define MK_MULTI 0
#endif

#define LAS __attribute__((address_space(3)))
typedef unsigned short bf16_t;
typedef short bf16x8 __attribute__((ext_vector_type(8)));
typedef short s16x4 __attribute__((ext_vector_type(4)));
typedef float f32x2 __attribute__((ext_vector_type(2)));
typedef float f32x4 __attribute__((ext_vector_type(4)));
typedef float f32x16 __attribute__((ext_vector_type(16)));
typedef unsigned u32x2 __attribute__((ext_vector_type(2)));
typedef unsigned u32x4 __attribute__((ext_vector_type(4)));

constexpr int DM = 1024, NPROJ = 6144, DFF = 2816, DEPTH = 2;
constexpr int T_CTX = 4096, T_ALL = 36864;
constexpr int CTX_S = 256, LAT_S = 4096, PAST = 512, SKV_LAT = 4608;
constexpr int PC_Q = 0, PC_U = 1024, PC_K = 1536, PC_V = 1792, PC_XV = 2048, PC_XP = 2560, PC_G = 3072;
constexpr float LN_EPS = 1e-6f;
constexpr float ALPHA = 1.41421356237309515f;
constexpr int NW = 8;
__host__ __device__ constexpr int part_row0(int p) { return p == 0 ? 0 : 20480; }
__host__ __device__ constexpr int part_rows(int p) { return p == 0 ? 20480 : 16384; }

constexpr size_t MiB = 1u << 20;
constexpr size_t WS_MOD = 0;
constexpr size_t WS_ROPE = 512 * 1024;
constexpr size_t WS_WSGU = 768 * 1024;
constexpr size_t WS_WIN = 1 * MiB;
constexpr size_t WS_WM = 25 * MiB;
constexpr size_t WS_WOUT = 33 * MiB;
constexpr size_t WS_WF1 = 37 * MiB;
constexpr size_t WS_WF2 = 59 * MiB;
constexpr size_t WS_ACT = 70 * MiB;
constexpr size_t WS_PROJ = 142 * MiB;
constexpr size_t WS_KL = 382 * MiB, WS_VL = 391 * MiB;
constexpr size_t WS_KC = 400 * MiB, WS_VC = 402 * MiB;
constexpr size_t WS_VRT = 404 * MiB;
constexpr size_t WS_END = 424 * MiB;

constexpr int LDS_BYTES = 135168;

__device__ __forceinline__ unsigned cvt_pk_bf16(float lo, float hi) { unsigned r; asm volatile("v_cvt_pk_bf16_f32 %0, %1, %2" : "=v"(r) : "v"(lo), "v"(hi)); return r; }
__device__ __forceinline__ float bf_lo(unsigned u) { return __uint_as_float(u << 16); }
__device__ __forceinline__ float bf_hi(unsigned u) { return __uint_as_float(u & 0xffff0000u); }
__device__ __forceinline__ float wave_sum(float v) {
#pragma unroll
    for (int o = 1; o < 64; o <<= 1) v += __shfl_xor(v, o);
    return v;
}
__device__ __forceinline__ float gelu1(float v) {
    const float av = fabsf(v), d = av * 0.2316418882f + 1.0f;
    const float t = __builtin_amdgcn_rcpf(d);
    float q = t * 0.5307027145f + (-0.7265760135f); q = q * t + 0.7107068705f; q = q * t + (-0.142248368f); q = q * t + 0.127414796f; q = q * t;
    const float e = __builtin_amdgcn_exp2f((v * v) * (-0.72134752044f));
    const float m = v * (q * e), r = v - m;
    return v < 0.f ? m : r;
}
__device__ __forceinline__ float sigmoidf_(float x) { return 1.0f / (1.0f + __expf(-x)); }

namespace pg8 {
constexpr int BM = 256, BK = 64, HALF = 128, HTB = HALF * BK * 2, STAGE_BYTES = 8 * HTB, NXCD = 8, WGM = 8;
__host__ __device__ __forceinline__ int lds_byte(int r, int c) { const int st = (r >> 4) * 2 + (c >> 5), rr = r & 15, cc = c & 31, ob = rr * 64 + cc * 2; return st * 1024 + (ob ^ (((ob >> 9) & 1) << 5)); }
__host__ __device__ __forceinline__ void stage_rc(int b, int& R, int& C) { const int st = b / 1024, sb = b % 1024, swz = sb ^ (((sb >> 9) & 1) << 5); R = (st >> 1) * 16 + swz / 64; C = (st & 1) * 32 + (swz % 64) / 2; }
__host__ __device__ __forceinline__ int perm32(int rho) { const int n = rho >> 4, i = rho & 15; return 8 * (i >> 2) + 4 * n + (i & 3); }

struct Unit { int pm, pn, seg; };
struct Gemm { const bf16_t* A; const bf16_t* Bt; int lda, ldb, nM, nN, nseg; int k0[3]; int nt[3]; };

struct Order {
    int nM, nN, nwg, G, c, nseg;
    __device__ void init(int nM_, int nN_, int nseg_, int G_, int c_) { nM = nM_; nN = nN_; nwg = nM * nN; G = G_; c = c_; nseg = nseg_; }
    __device__ bool next(int i, Unit& u) const {
        const int ti = i / nseg; u.seg = i - ti * nseg;
        const long L = (long)ti * G + c; if (L >= nwg) return false;
        int wgid = (int)L; { const int q = nwg / NXCD, r = nwg % NXCD, xcd = wgid % NXCD, off = wgid / NXCD; wgid = (xcd < r ? xcd * (q + 1) : r * (q + 1) + (xcd - r) * q) + off; }
        const int nig = WGM * nN, gid = wgid / nig, fm = gid * WGM, gsz = (nM - fm) < WGM ? (nM - fm) : WGM;
        u.pm = fm + ((wgid % nig) % gsz); u.pn = (wgid % nig) / gsz; return true;
    }
};

struct EpiStore {
    static constexpr bool PERM = true;
    bf16_t* O; int ldc;
    __device__ __forceinline__ void run(f32x4 (&acc)[2][2][4][2], const Unit& u, int wr, int wc, int fr, int fq) const {
        const int row0 = u.pm * BM + wr * 64 + fr; const int col0 = u.pn * BM + wc * 32 + 8 * fq;
#pragma unroll
        for (int ai = 0; ai < 2; ++ai)
#pragma unroll
            for (int m = 0; m < 4; ++m) { bf16_t* rowp = O + (size_t)(row0 + ai * HALF + m * 16) * ldc + col0;
#pragma unroll
                for (int bj = 0; bj < 2; ++bj) { const f32x4 v0 = acc[ai][bj][m][0], v1 = acc[ai][bj][m][1];
                    u32x4 w; w.x = cvt_pk_bf16(v0[0], v0[1]); w.y = cvt_pk_bf16(v0[2], v0[3]); w.z = cvt_pk_bf16(v1[0], v1[1]); w.w = cvt_pk_bf16(v1[2], v1[3]);
                    *(u32x4*)(rowp + bj * HALF) = w; } }
    }
};
struct EpiSwiGLU {
    static constexpr bool PERM = true;
    bf16_t* O; int ldc;
    __device__ __forceinline__ void run(f32x4 (&acc)[2][2][4][2], const Unit& u, int wr, int wc, int fr, int fq) const {
        const int row0 = u.pm * BM + wr * 64 + fr; const int col0 = u.pn * HALF + wc * 32 + 8 * fq;
#pragma unroll
        for (int ai = 0; ai < 2; ++ai)
#pragma unroll
            for (int m = 0; m < 4; ++m) { bf16_t* rowp = O + (size_t)(row0 + ai * HALF + m * 16) * ldc + col0;
                float o[8];
#pragma unroll
                for (int n = 0; n < 2; ++n)
#pragma unroll
                    for (int e = 0; e < 4; ++e) { const float a = acc[ai][0][m][n][e], b = acc[ai][1][m][n][e]; o[n * 4 + e] = a * sigmoidf_(a) * b; }
                u32x4 w; w.x = cvt_pk_bf16(o[0], o[1]); w.y = cvt_pk_bf16(o[2], o[3]); w.z = cvt_pk_bf16(o[4], o[5]); w.w = cvt_pk_bf16(o[6], o[7]);
                *(u32x4*)rowp = w; }
    }
};
struct EpiResid {
    static constexpr bool PERM = false;
    const float* xres_ctx; const float* xres_lat;
    float* out; const float* mod; int goff;
    __device__ __forceinline__ void run(f32x4 (&acc)[2][2][4][2], const Unit& u, int wr, int wc, int fr, int fq) const {
        const int v = u.pm < 16 ? 0 : 1 + ((u.pm - 16) >> 4);
        const float* xb = u.pm < 16 ? xres_ctx + (size_t)u.pm * BM * DM : xres_lat + (size_t)(u.pm - 16) * BM * DM;
        float* ob = out + (size_t)u.pm * BM * DM;
        const int col0 = u.pn * BM + wc * 32 + 4 * fq;
        const float* gp = mod + v * 6144 + goff + col0;
        f32x4 gv[2][2];
#pragma unroll
        for (int bj = 0; bj < 2; ++bj)
#pragma unroll
            for (int n = 0; n < 2; ++n) gv[bj][n] = *(const f32x4*)(gp + bj * HALF + n * 16);
#pragma unroll
        for (int ai = 0; ai < 2; ++ai)
#pragma unroll
            for (int m = 0; m < 4; ++m) { const size_t off = (size_t)(ai * HALF + wr * 64 + m * 16 + fr) * DM + col0;
#pragma unroll
                for (int bj = 0; bj < 2; ++bj)
#pragma unroll
                    for (int n = 0; n < 2; ++n) { const f32x4 x = *(const f32x4*)(xb + off + bj * HALF + n * 16);
                        *(f32x4*)(ob + off + bj * HALF + n * 16) = x * ALPHA + gv[bj][n] * acc[ai][bj][m][n]; } }
    }
};
struct EpiGate {
    static constexpr bool PERM = true;
    const bf16_t* P;
    bf16_t* O; int ldc;
    __device__ __forceinline__ void run(f32x4 (&acc)[2][2][4][2], const Unit& u, int wr, int wc, int fr, int fq) const {
        const int row0 = u.pm * BM + wr * 64 + fr; const int col0 = u.pn * BM + wc * 32 + 8 * fq;
        const int noff = u.seg == 0 ? 0 : (u.seg == 1 ? 2048 : 1024), doff = u.seg == 0 ? 2048 : 1024;
        const bool last = u.seg == 2;
#pragma unroll
        for (int ai = 0; ai < 2; ++ai)
#pragma unroll
            for (int m = 0; m < 4; ++m) { const size_t r = (size_t)(row0 + ai * HALF + m * 16);
                const bf16_t* gp = P + r * NPROJ + PC_G + col0;
#pragma unroll
                for (int bj = 0; bj < 2; ++bj) {
                    const u32x4 gn = *(const u32x4*)(gp + noff + bj * HALF);
                    u32x4 gd = gn; if (!last) gd = *(const u32x4*)(gp + doff + bj * HALF);
                    float f[8];
#pragma unroll
                    for (int e = 0; e < 4; ++e) {
                        float a0 = bf_lo(gn[e]), a1 = bf_hi(gn[e]);
                        a0 = fminf(fmaxf(a0, -60.f), 60.f); a1 = fminf(fmaxf(a1, -60.f), 60.f);
                        const float ea0 = __expf(-a0), ea1 = __expf(-a1);
                        if (last) { f[2 * e] = 1.0f / (1.0f + ea0); f[2 * e + 1] = 1.0f / (1.0f + ea1); }
                        else { float b0 = bf_lo(gd[e]), b1 = bf_hi(gd[e]);
                            b0 = fminf(fmaxf(b0, -60.f), 60.f); b1 = fminf(fmaxf(b1, -60.f), 60.f);
                            f[2 * e] = (1.0f + __expf(-b0)) / (1.0f + ea0); f[2 * e + 1] = (1.0f + __expf(-b1)) / (1.0f + ea1); }
                    }
                    f32x4 v0 = acc[ai][bj][m][0], v1 = acc[ai][bj][m][1];
                    v0[0] *= f[0]; v0[1] *= f[1]; v0[2] *= f[2]; v0[3] *= f[3]; v1[0] *= f[4]; v1[1] *= f[5]; v1[2] *= f[6]; v1[3] *= f[7];
                    if (last) { u32x4 w; w.x = cvt_pk_bf16(v0[0], v0[1]); w.y = cvt_pk_bf16(v0[2], v0[3]); w.z = cvt_pk_bf16(v1[0], v1[1]); w.w = cvt_pk_bf16(v1[2], v1[3]);
                        *(u32x4*)(O + r * ldc + col0 + bj * HALF) = w; }
                    else { acc[ai][bj][m][0] = v0; acc[ai][bj][m][1] = v1; }
                } }
    }
};

template <class Epi>
__device__ __forceinline__ void gemm_phase(LAS unsigned char* lds, const Gemm g, const Order& S, const Epi& E, const int tid) {
    const int wid = __builtin_amdgcn_readfirstlane(tid >> 6), lane = tid & 63, wr = wid >> 2, wc = wid & 3, fr = lane & 15, fq = lane >> 4;
    unsigned voffA[2], voffB[2];
#pragma unroll
    for (int i = 0; i < 2; ++i) { int R, C; stage_rc(tid * 16 + i * 8192, R, C); const int Rb = Epi::PERM ? ((R & ~31) + perm32(R & 31)) : R;
        voffA[i] = (unsigned)(R * g.lda + C) * 2u; voffB[i] = (unsigned)(Rb * g.ldb + C) * 2u; }
    const size_t kstep = (size_t)(BK * 2);
    const size_t hstepA = (size_t)HALF * g.lda * 2, hstepB = (size_t)HALF * g.ldb * 2;
    const size_t tstepA = 2 * hstepA, tstepB = 2 * hstepB;
    const unsigned ldsw = (unsigned)wid * 1024u;
    const int aoff = lds_byte(wr * 64 + fr, fq * 8), boff = lds_byte(wc * 32 + fr, fq * 8);
#define PG8_SA(b, h) (((b) * 2 + (h)) * HTB)
#define PG8_SB(b, h) ((4 + (b) * 2 + (h)) * HTB)
#define PG8_STAGE(bufoff, gbase, voff) do { _Pragma("unroll") for (int _i = 0; _i < 2; ++_i) \
        __builtin_amdgcn_global_load_lds((const unsigned*)((const char*)(gbase) + (voff)[_i]), (LAS unsigned*)(lds + (bufoff) + ldsw + _i * 8192), 16, 0, 0); } while (0)
#define PG8_LDA(dst, b, h) do { _Pragma("unroll") for (int m = 0; m < 4; ++m) _Pragma("unroll") for (int k = 0; k < 2; ++k) dst[m][k] = *(const LAS bf16x8*)(lds + PG8_SA(b, h) + aoff + m * 2048 + k * 1024); } while (0)
#define PG8_LDB(dst, b, h) do { _Pragma("unroll") for (int n = 0; n < 2; ++n) _Pragma("unroll") for (int k = 0; k < 2; ++k) dst[n][k] = *(const LAS bf16x8*)(lds + PG8_SB(b, h) + boff + n * 2048 + k * 1024); } while (0)
#define PG8_MMA(ai, bj, At, Bt) do { __builtin_amdgcn_s_setprio(1); _Pragma("unroll") for (int m = 0; m < 4; ++m) _Pragma("unroll") for (int n = 0; n < 2; ++n) _Pragma("unroll") for (int k = 0; k < 2; ++k) \
        acc[ai][bj][m][n] = __builtin_amdgcn_mfma_f32_16x16x32_bf16(Bt[n][k], At[m][k], acc[ai][bj][m][n], 0, 0, 0); __builtin_amdgcn_s_setprio(0); } while (0)
#define PG8_WAIT_V(n) asm volatile("s_waitcnt vmcnt(" #n ")" ::: "memory")
#define PG8_WAIT_L(n) asm volatile("s_waitcnt lgkmcnt(" #n ")" ::: "memory")
#define PG8_BAR __builtin_amdgcn_s_barrier()
#define PG8_SCHED __builtin_amdgcn_sched_barrier(0)
#define KOF(sg) ((sg) == 0 ? g.k0[0] : ((sg) == 1 ? g.k0[1] : g.k0[2]))
#define NTF(sg) ((sg) == 0 ? g.nt[0] : ((sg) == 1 ? g.nt[1] : g.nt[2]))
    Unit cur, nxt; int ui = 0;
    if (!S.next(0, cur)) return;
    f32x4 acc[2][2][4][2];
#pragma unroll
    for (int a = 0; a < 2; ++a)
#pragma unroll
        for (int b = 0; b < 2; ++b)
#pragma unroll
            for (int m = 0; m < 4; ++m)
#pragma unroll
                for (int n = 0; n < 2; ++n) acc[a][b][m][n] = (f32x4){0.f, 0.f, 0.f, 0.f};
    bf16x8 At[4][2], B0[2][2], B1[2][2];
    const char* cA = (const char*)g.A + (size_t)cur.pm * tstepA + (size_t)KOF(cur.seg) * 2; const char* cB = (const char*)g.Bt + (size_t)cur.pn * tstepB + (size_t)KOF(cur.seg) * 2;
    PG8_STAGE(PG8_SB(0, 0), cB, voffB); PG8_STAGE(PG8_SB(0, 1), cB + hstepB, voffB); PG8_STAGE(PG8_SA(0, 0), cA, voffA); PG8_STAGE(PG8_SA(0, 1), cA + hstepA, voffA);
    if (wr == 1) PG8_BAR;
    PG8_WAIT_V(2); PG8_BAR;
    PG8_STAGE(PG8_SB(1, 0), cB + kstep, voffB); PG8_STAGE(PG8_SA(1, 0), cA + kstep, voffA); PG8_STAGE(PG8_SB(1, 1), cB + hstepB + kstep, voffB);
    PG8_WAIT_V(6); PG8_BAR;
    for (;;) {
        const bool has_next = S.next(ui + 1, nxt);
        const int nt = NTF(cur.seg);
        const char* nA = has_next ? (const char*)g.A + (size_t)nxt.pm * tstepA + (size_t)KOF(nxt.seg) * 2 : cA;
        const char* nB = has_next ? (const char*)g.Bt + (size_t)nxt.pn * tstepB + (size_t)KOF(nxt.seg) * 2 : cB;
        for (int t = 0; t < nt; t += 2) {
            const bool last = (t == nt - 2);
            const char* a1 = cA + (size_t)(t + 1) * kstep;
            const char* a2 = last ? nA : cA + (size_t)(t + 2) * kstep; const char* b2 = last ? nB : cB + (size_t)(t + 2) * kstep;
            const char* a3 = a2 + kstep; const char* b3 = b2 + kstep;
            PG8_LDB(B0, 0, 0); PG8_LDB(B1, 0, 1); PG8_SCHED; PG8_LDA(At, 0, 0); PG8_STAGE(PG8_SA(1, 1), a1 + hstepA, voffA);
            PG8_WAIT_V(8); PG8_WAIT_L(0); PG8_BAR; PG8_MMA(0, 0, At, B0); PG8_MMA(0, 1, At, B1); PG8_BAR; PG8_SCHED;
            PG8_LDA(At, 0, 1); PG8_STAGE(PG8_SB(0, 0), b2, voffB); PG8_STAGE(PG8_SB(0, 1), b2 + hstepB, voffB); PG8_STAGE(PG8_SA(0, 0), a2, voffA);
            PG8_WAIT_V(8); PG8_WAIT_L(0); PG8_BAR; PG8_MMA(1, 0, At, B0); PG8_MMA(1, 1, At, B1); PG8_BAR; PG8_SCHED;
            PG8_LDB(B0, 1, 0); PG8_LDB(B1, 1, 1); PG8_SCHED; PG8_LDA(At, 1, 0); PG8_STAGE(PG8_SA(0, 1), a2 + hstepA, voffA);
            PG8_WAIT_V(8); PG8_WAIT_L(0); PG8_BAR; PG8_MMA(0, 0, At, B0); PG8_MMA(0, 1, At, B1); PG8_BAR; PG8_SCHED;
            PG8_LDA(At, 1, 1); PG8_STAGE(PG8_SB(1, 0), b3, voffB); PG8_STAGE(PG8_SB(1, 1), b3 + hstepB, voffB); PG8_STAGE(PG8_SA(1, 0), a3, voffA);
            PG8_WAIT_V(8); PG8_WAIT_L(0); PG8_BAR; PG8_MMA(1, 0, At, B0); PG8_MMA(1, 1, At, B1); PG8_BAR; PG8_SCHED;
        }
        if (wr == 0) PG8_BAR;
        E.run(acc, cur, wr, wc, fr, fq);
        if (!has_next) break;
        if (cur.seg == g.nseg - 1) {
#pragma unroll
            for (int a = 0; a < 2; ++a)
#pragma unroll
                for (int b = 0; b < 2; ++b)
#pragma unroll
                    for (int m = 0; m < 4; ++m)
#pragma unroll
                        for (int n = 0; n < 2; ++n) acc[a][b][m][n] = (f32x4){0.f, 0.f, 0.f, 0.f};
        }
        cur = nxt; cA = nA; cB = nB; ++ui;
        if (wr == 1) PG8_BAR;
    }
    PG8_WAIT_V(0);
    PG8_BAR;
#undef KOF
#undef NTF
#undef PG8_SA
#undef PG8_SB
#undef PG8_STAGE
#undef PG8_LDA
#undef PG8_LDB
#undef PG8_MMA
#undef PG8_WAIT_V
#undef PG8_WAIT_L
#undef PG8_BAR
#undef PG8_SCHED
}
}

namespace att {
constexpr int D = 128, QBLK = 32, KVBLK = 64;
constexpr float SCALE = 0.088388347648318440f;
constexpr float THR = 8.f;
constexpr size_t SHM_V = KVBLK * D * 2, SHM_K = KVBLK * D * 2, SHM_ATTN = 2 * SHM_V + 2 * SHM_K + NW * 64 * 4;
#define KSWZ(row, colB) ((row) * 256 + ((colB) ^ (((row) & 7) << 4)))
#define SBAR() __builtin_amdgcn_sched_barrier(0)
__device__ __forceinline__ int crow(int r, int hi) { return (r & 3) + 8 * (r >> 2) + 4 * hi; }
__device__ __forceinline__ unsigned cvtpk(float lo, float hi) { unsigned r; asm volatile("v_cvt_pk_bf16_f32 %0, %1, %2" : "=v"(r) : "v"(lo), "v"(hi)); return r; }
__device__ __forceinline__ void partialSM(f32x16& p0, f32x16& p1, float& m_reg, float& mn, float& alpha) {
  constexpr float C = SCALE * 1.4426950408889634f;
  float pmax = p0[0];
#pragma unroll
  for (int r = 1; r < 16; ++r) pmax = fmaxf(pmax, p0[r]);
#pragma unroll
  for (int r = 0; r < 16; ++r) pmax = fmaxf(pmax, p1[r]);
  { auto rr = __builtin_amdgcn_permlane32_swap(__float_as_uint(pmax), __float_as_uint(pmax), false, false);
    pmax = fmaxf(__uint_as_float(rr[0]), __uint_as_float(rr[1])); }
  if (__builtin_expect(__all(pmax - m_reg <= THR / SCALE), 1)) { mn = m_reg; alpha = 1.f; }
  else { mn = fmaxf(m_reg, pmax); alpha = __builtin_amdgcn_exp2f((m_reg - mn) * C); m_reg = mn; }
  float mnC = -mn * C;
#pragma unroll
  for (int r = 0; r < 16; ++r) p0[r] = fmaf(p0[r], C, mnC);
#pragma unroll
  for (int r = 0; r < 16; ++r) p1[r] = fmaf(p1[r], C, mnC);
#pragma unroll
  for (int r = 0; r < 16; ++r) p0[r] = __builtin_amdgcn_exp2f(p0[r]);
}
__device__ __forceinline__ void finishSM(f32x16& p0, f32x16& p1, float alpha, float& l_reg, bf16x8& pa0, bf16x8& pa1, bf16x8& pa2, bf16x8& pa3) {
#pragma unroll
  for (int r = 0; r < 16; ++r) p1[r] = __builtin_amdgcn_exp2f(p1[r]);
  float ps = 0;
#pragma unroll
  for (int r = 0; r < 16; ++r) ps += p0[r];
#pragma unroll
  for (int r = 0; r < 16; ++r) ps += p1[r];
  { auto rr = __builtin_amdgcn_permlane32_swap(__float_as_uint(ps), __float_as_uint(ps), false, false);
    ps = __uint_as_float(rr[0]) + __uint_as_float(rr[1]); }
  l_reg = l_reg * alpha + ps;
#define PK4(P, BASE, OUT) do { unsigned a0 = cvtpk(P[BASE + 0], P[BASE + 1]), a1 = cvtpk(P[BASE + 2], P[BASE + 3]);   \
    unsigned b0 = cvtpk(P[BASE + 4], P[BASE + 5]), b1 = cvtpk(P[BASE + 6], P[BASE + 7]);                              \
    auto r0 = __builtin_amdgcn_permlane32_swap(a0, b0, false, false); auto r1 = __builtin_amdgcn_permlane32_swap(a1, b1, false, false); \
    u32x4 w = {r0[0], r1[0], r0[1], r1[1]}; OUT = *reinterpret_cast<bf16x8*>(&w); } while (0)
  PK4(p0, 0, pa0); PK4(p0, 8, pa1); PK4(p1, 0, pa2); PK4(p1, 8, pa3);
#undef PK4
}
__device__ __forceinline__ void qkt(f32x16& p0, f32x16& p1, const bf16_t* Ks, const bf16x8* qr, int r32, int hi) {
  p0 = f32x16{}; p1 = f32x16{};
#pragma unroll
  for (int d0 = 0; d0 < 8; ++d0) { int cb = (d0 * 16 + hi * 8) * 2;
    bf16x8 b0 = *reinterpret_cast<const bf16x8*>((const char*)Ks + KSWZ(r32, cb));
    bf16x8 b1 = *reinterpret_cast<const bf16x8*>((const char*)Ks + KSWZ(32 + r32, cb));
    p0 = __builtin_amdgcn_mfma_f32_32x32x16_bf16(b0, qr[d0], p0, 0, 0, 0);
    p1 = __builtin_amdgcn_mfma_f32_32x32x16_bf16(b1, qr[d0], p1, 0, 0, 0); }
}
__device__ __forceinline__ int v_st(int k, int c) { const int kk = (k & ~0xC) | ((k & 4) << 1) | ((k & 8) >> 1); return ((kk >> 3) * 4 + (c >> 5)) * 512 + ((kk & 7) * 32 + (c & 31)) * 2; }
__device__ __forceinline__ int v_rd_base(int lane) { return ((lane & 3) << 3) | (((lane >> 2) & 3) << 6) | (((lane >> 4) & 1) << 5) | (((lane >> 5) & 1) << 8); }
constexpr int v_rd_off(int d0, int ks, int half) { return d0 * 512 + ks * 4096 + half * 2048; }
template <int OFF> __device__ __forceinline__ s16x4 tr_read(int vb) {
  s16x4 r; asm volatile("ds_read_b64_tr_b16 %0, %1 offset:%2" : "=&v"(r) : "v"(vb), "i"(OFF) : "memory"); return r;
}
template <int D0> __device__ __forceinline__ void pv_one(f32x16& od, int vb, bf16x8 pa0, bf16x8 pa1, bf16x8 pa2, bf16x8 pa3) {
  const s16x4 l0 = tr_read<v_rd_off(D0, 0, 0)>(vb), h0 = tr_read<v_rd_off(D0, 0, 1)>(vb), l1 = tr_read<v_rd_off(D0, 1, 0)>(vb), h1 = tr_read<v_rd_off(D0, 1, 1)>(vb);
  const s16x4 l2 = tr_read<v_rd_off(D0, 2, 0)>(vb), h2 = tr_read<v_rd_off(D0, 2, 1)>(vb), l3 = tr_read<v_rd_off(D0, 3, 0)>(vb), h3 = tr_read<v_rd_off(D0, 3, 1)>(vb);
  asm volatile("s_waitcnt lgkmcnt(0)" ::: "memory"); SBAR();
#define PK(L, H) (bf16x8){L[0], L[1], L[2], L[3], H[0], H[1], H[2], H[3]}
  od = __builtin_amdgcn_mfma_f32_32x32x16_bf16(pa0, PK(l0, h0), od, 0, 0, 0);
  od = __builtin_amdgcn_mfma_f32_32x32x16_bf16(pa1, PK(l1, h1), od, 0, 0, 0);
  od = __builtin_amdgcn_mfma_f32_32x32x16_bf16(pa2, PK(l2, h2), od, 0, 0, 0);
  od = __builtin_amdgcn_mfma_f32_32x32x16_bf16(pa3, PK(l3, h3), od, 0, 0, 0);
#undef PK
}
__device__ __forceinline__ void pv_d0(f32x16* o, int vb, bf16x8 pa0, bf16x8 pa1, bf16x8 pa2, bf16x8 pa3) {
  pv_one<0>(o[0], vb, pa0, pa1, pa2, pa3); pv_one<1>(o[1], vb, pa0, pa1, pa2, pa3); pv_one<2>(o[2], vb, pa0, pa1, pa2, pa3); pv_one<3>(o[3], vb, pa0, pa1, pa2, pa3);
}
constexpr int LDQ = NPROJ, LDK = 256;
__device__ __forceinline__ void attn_dense_body(bf16_t* Qb, const bf16_t* __restrict__ Kh, const bf16_t* __restrict__ Vh, int seq, char* lds, const int tid) {
  const int wid = tid >> 6, lane = tid & 63, r32 = lane & 31, hi = lane >> 5;
  bf16_t* V_lds = (bf16_t*)lds; bf16_t* K_lds = (bf16_t*)(lds + 2 * SHM_V);
  float* ws = (float*)(lds + 2 * SHM_V + 2 * SHM_K) + wid * 64; float* li_l = ws; float* al_l = ws + 32;
  float m_reg = -1e30f, l_reg = 0; f32x16 o[4] = {}; bf16x8 qr[8];
  const bf16_t* Qw = Qb + (long)(wid * QBLK + r32) * LDQ + hi * 8;
#pragma unroll
  for (int d0 = 0; d0 < 8; ++d0) qr[d0] = *reinterpret_cast<const bf16x8*>(Qw + d0 * 16);
  const int sr = tid >> 4, sc = (tid & 15) * 8, vst0 = v_st(sr, sc), vst1 = v_st(32 + sr, sc);
  const int vb0 = (int)(uintptr_t)V_lds + v_rd_base(lane);
  struct { bf16x8 vs0, vs1, ks0, ks1; } sr_[1];
#define LD8(p) (*reinterpret_cast<const bf16x8*>(p))
#define SLOAD(i, k0) do { sr_[i].vs0 = LD8(&Vh[(long)((k0) + sr) * LDK + sc]); sr_[i].vs1 = LD8(&Vh[(long)((k0) + 32 + sr) * LDK + sc]); \
    sr_[i].ks0 = LD8(&Kh[(long)((k0) + sr) * LDK + sc]); sr_[i].ks1 = LD8(&Kh[(long)((k0) + 32 + sr) * LDK + sc]); } while (0)
#define SWRITE(b, i) do { *(bf16x8*)((char*)V_lds + (b) * SHM_V + vst0) = sr_[i].vs0;          \
    *(bf16x8*)((char*)V_lds + (b) * SHM_V + vst1) = sr_[i].vs1; int kc = sc * 2;               \
    *(bf16x8*)((char*)K_lds + (b) * SHM_K + KSWZ(sr, kc)) = sr_[i].ks0;                       \
    *(bf16x8*)((char*)K_lds + (b) * SHM_K + KSWZ(32 + sr, kc)) = sr_[i].ks1; } while (0)
#define SWAIT() asm volatile("s_waitcnt vmcnt(0)" ::: "memory")
#define RESC(a) do { if (__any((a) < 1.f)) { if (hi == 0) al_l[r32] = (a); asm volatile("s_waitcnt lgkmcnt(0)" ::: "memory"); \
    _Pragma("unroll") for (int d = 0; d < 4; ++d) _Pragma("unroll") for (int r = 0; r < 16; ++r) o[d][r] *= al_l[crow(r, hi)]; } } while (0)
  f32x16 pA0, pA1, pB0, pB1; float mnA, mnB, alA, alB; bf16x8 pa0, pa1, pa2, pa3; const int NT = seq / KVBLK;
  constexpr int SE = 0, SO = 0;
  SLOAD(SE, 0); asm volatile("s_waitcnt vmcnt(0)" ::: "memory"); SWRITE(0, SE); __syncthreads();
  qkt(pA0, pA1, K_lds, qr, r32, hi); partialSM(pA0, pA1, m_reg, mnA, alA);
  SLOAD(SO, KVBLK);
  SWAIT(); SWRITE(1, SO); __syncthreads();
  for (int j = 1; j + 1 < NT; j += 2) {
    SBAR(); qkt(pB0, pB1, (bf16_t*)((char*)K_lds + SHM_K), qr, r32, hi);
    finishSM(pA0, pA1, alA, l_reg, pa0, pa1, pa2, pa3); SBAR();
    SLOAD(SO, (j + 1) * KVBLK); SBAR();
    pv_d0(o, vb0, pa0, pa1, pa2, pa3); partialSM(pB0, pB1, m_reg, mnB, alB);
    __syncthreads(); SWAIT(); SWRITE(0, SE);
    RESC(alB); __syncthreads();
    SBAR(); qkt(pA0, pA1, K_lds, qr, r32, hi);
    finishSM(pB0, pB1, alB, l_reg, pa0, pa1, pa2, pa3); SBAR();
    SLOAD(SE, (j + 2) * KVBLK); SBAR();
    pv_d0(o, vb0 + (int)SHM_V, pa0, pa1, pa2, pa3); partialSM(pA0, pA1, m_reg, mnA, alA);
    __syncthreads(); SWAIT(); SWRITE(1, SO);
    RESC(alA); __syncthreads();
  }
  SBAR(); qkt(pB0, pB1, (bf16_t*)((char*)K_lds + SHM_K), qr, r32, hi);
  finishSM(pA0, pA1, alA, l_reg, pa0, pa1, pa2, pa3); SBAR();
  pv_d0(o, vb0, pa0, pa1, pa2, pa3); partialSM(pB0, pB1, m_reg, mnB, alB);
  __syncthreads(); RESC(alB);
  finishSM(pB0, pB1, alB, l_reg, pa0, pa1, pa2, pa3); SBAR();
  pv_d0(o, vb0 + (int)SHM_V, pa0, pa1, pa2, pa3);
  if (hi == 0) li_l[r32] = l_reg; asm volatile("s_waitcnt lgkmcnt(0)" ::: "memory");
  float rli[16];
#pragma unroll
  for (int r = 0; r < 16; ++r) rli[r] = __builtin_amdgcn_rcpf(li_l[crow(r, hi)]);
  __syncthreads();
  { bf16_t* stg = (bf16_t*)lds + wid * 4096;
#pragma unroll
    for (int r = 0; r < 16; ++r) { const int orow = crow(r, hi);
#pragma unroll
      for (int d0 = 0; d0 < 4; ++d0) stg[orow * 128 + d0 * 32 + r32] = (bf16_t)(cvtpk(o[d0][r] * rli[r], 0.f) & 0xffffu); }
    asm volatile("s_waitcnt lgkmcnt(0)" ::: "memory");
    bf16_t* Ow = Qb + (long)(wid * QBLK + (lane >> 4)) * LDQ + (lane & 15) * 8;
#pragma unroll
    for (int i = 0; i < 8; ++i) { const u32x4 v = *(const u32x4*)(stg + (i * 4 + (lane >> 4)) * 128 + (lane & 15) * 8); *(u32x4*)(Ow + (long)i * 4 * LDQ) = v; }
  }
  __syncthreads();
#undef LD8
#undef SLOAD
#undef SWRITE
#undef SWAIT
#undef RESC
}
#undef KSWZ
#undef SBAR
}

struct Args { const float* in[25]; float* out; unsigned char* ws; int ph_lo, ph_hi; };

struct Frame {
    LAS unsigned char* lds; char* ldsg;
    int tid, lane, wave, G, bx, gw, NGW;
    const float* const* in;
    unsigned char* ws; float* out;
};
enum { I_XP = 0, I_XS, I_CK, I_CV, I_C, I_CCTX, I_WADA, I_BADA, I_WIN, I_QG, I_KG, I_WPG, I_PSC, I_WSGU, I_BSGU, I_WAO, I_WPO, I_WSO, I_WOUT, I_LN1G, I_LN1B, I_WF1, I_WF2, I_LN2G, I_LN2B };

__device__ __forceinline__ void tr_item(const float* W, int ldw, int src_col, int kb, bf16_t* WT, int ldt, int dst_row, int dst_k, LAS float* scr, int lane) {
    const int k0 = 64 * kb;
#pragma unroll 8
    for (int i = 0; i < 32; ++i) { const int kk = 2 * i + (lane >> 5); scr[kk * 33 + (lane & 31)] = W[(size_t)(k0 + kk) * ldw + src_col + (lane & 31)]; }
    asm volatile("s_waitcnt lgkmcnt(0)" ::: "memory");
    const int c = lane & 7;
#pragma unroll
    for (int j = 0; j < 4; ++j) { const int n = (lane >> 3) + 8 * j; const LAS float* s = scr + (8 * c) * 33 + n;
        u32x4 o; o.x = cvt_pk_bf16(s[0 * 33], s[1 * 33]); o.y = cvt_pk_bf16(s[2 * 33], s[3 * 33]); o.z = cvt_pk_bf16(s[4 * 33], s[5 * 33]); o.w = cvt_pk_bf16(s[6 * 33], s[7 * 33]);
        *(u32x4*)(WT + (size_t)(dst_row + n) * ldt + dst_k + k0 + 8 * c) = o; }
    asm volatile("s_waitcnt lgkmcnt(0)" ::: "memory");
}

__device__ __forceinline__ int win_src_col(int d) {
    if (d < 1024) return d;
    if (d < 1536) return 2048 + (d - 1024);
    if (d < 2048) return 1024 + (d - 1536);
    if (d < 2560) return 2560 + (d - 2048);
    if (d < 3072) return 1536 + (d - 2560);
    return d;
}

__device__ __forceinline__ void phase_prologue(Frame& F) {
    if (F.bx < 192) {
        const int l = F.bx / 96, nb = F.bx % 96;
        LAS float* sc = (LAS float*)F.lds;
        LAS float* red = (LAS float*)(F.lds + 9 * 1024 * 4);
        for (int idx = F.tid; idx < 9 * 1024; idx += 512) { const int v = idx >> 10, k = idx & 1023;
            const float x = v == 0 ? F.in[I_CCTX][k] : F.in[I_C][(v - 1) * 1024 + k]; sc[idx] = x / (1.0f + __expf(-x)); }
        __syncthreads();
        float acc[9];
#pragma unroll
        for (int v = 0; v < 9; ++v) acc[v] = 0.f;
        const float* wp = F.in[I_WADA] + ((size_t)l * 1024 + F.wave * 128) * 6144 + nb * 64 + F.lane;
#pragma unroll 8
        for (int k = 0; k < 128; ++k) { const float w = wp[(size_t)k * 6144];
#pragma unroll
            for (int v = 0; v < 9; ++v) acc[v] += sc[v * 1024 + F.wave * 128 + k] * w; }
#pragma unroll
        for (int v = 0; v < 9; ++v) red[(F.wave * 9 + v) * 64 + F.lane] = acc[v];
        __syncthreads();
        float* mod = (float*)(F.ws + WS_MOD);
        for (int idx = F.tid; idx < 576; idx += 512) { const int v = idx >> 6, ln = idx & 63; float s = 0.f;
#pragma unroll
            for (int w = 0; w < 8; ++w) s += red[(w * 9 + v) * 64 + ln];
            mod[(l * 9 + v) * 6144 + nb * 64 + ln] = s + F.in[I_BADA][l * 6144 + nb * 64 + ln]; }
        __syncthreads();
    }
    LAS float* scr = (LAS float*)(F.lds + F.wave * 8448);
    constexpr int N_WIN = 16 * 192, N_AO = 16 * 32, N_SO = 8 * 32, N_WO = 16 * 32, N_F1 = 16 * 176, N_F2 = 44 * 32, N_PE = 1024, N_WS = 128;
    constexpr int N_L = N_WIN + N_AO + N_SO + N_WO + N_F1 + N_F2 + N_PE + N_WS;
    constexpr int N_ALL = 2 * N_L + 32;
    for (int it = F.gw; it < N_ALL; it += F.NGW) {
        if (it >= 2 * N_L) {
            const int idx = (it - 2 * N_L) * 64 + F.lane; const int pos = idx >> 5, p = idx & 31;
            const float inv = powf(10000.0f, -(float)p / 32.0f); const float ang = (float)pos * inv;
            float* rope = (float*)(F.ws + WS_ROPE); rope[idx] = cosf(ang); rope[2048 + idx] = sinf(ang);
            continue;
        }
        const int l = it / N_L; int r = it % N_L;
        if (r < N_WIN) { const int kb = r / 192, nb = r % 192;
            tr_item(F.in[I_WIN] + (size_t)l * 1024 * 6144, 6144, win_src_col(nb * 32), kb, (bf16_t*)(F.ws + WS_WIN) + (size_t)l * 6144 * 1024, 1024, nb * 32, 0, scr, F.lane); continue; } r -= N_WIN;
        if (r < N_AO) { const int kb = r / 32, nb = r % 32;
            tr_item(F.in[I_WAO] + (size_t)l * 1024 * 1024, 1024, nb * 32, kb, (bf16_t*)(F.ws + WS_WM) + (size_t)l * 1024 * 2048, 2048, nb * 32, 0, scr, F.lane); continue; } r -= N_AO;
        if (r < N_SO) { const int kb = r / 32, nb = r % 32;
            tr_item(F.in[I_WSO] + (size_t)l * 512 * 1024, 1024, nb * 32, kb, (bf16_t*)(F.ws + WS_WM) + (size_t)l * 1024 * 2048, 2048, nb * 32, 1024, scr, F.lane); continue; } r -= N_SO;
        if (r < N_WO) { const int kb = r / 32, nb = r % 32;
            tr_item(F.in[I_WOUT] + (size_t)l * 1024 * 1024, 1024, nb * 32, kb, (bf16_t*)(F.ws + WS_WOUT) + (size_t)l * 1024 * 1024, 1024, nb * 32, 0, scr, F.lane); continue; } r -= N_WO;
        if (r < N_F1) { const int kb = r / 176, nb = r % 176; const int drow = nb * 32; const int pn = drow >> 8, j = drow & 255;
            const int src = j < 128 ? pn * 128 + j : DFF + pn * 128 + (j - 128);
            tr_item(F.in[I_WF1] + (size_t)l * 1024 * 5632, 5632, src, kb, (bf16_t*)(F.ws + WS_WF1) + (size_t)l * 5632 * 1024, 1024, drow, 0, scr, F.lane); continue; } r -= N_F1;
        if (r < N_F2) { const int kb = r / 32, nb = r % 32;
            tr_item(F.in[I_WF2] + (size_t)l * DFF * 1024, 1024, nb * 32, kb, (bf16_t*)(F.ws + WS_WF2) + (size_t)l * 1024 * DFF, DFF, nb * 32, 0, scr, F.lane); continue; } r -= N_F2;
        if (r < N_PE) {
            const int kg = r >> 4, nb = r & 15; const int k0 = kg * 8, g = k0 >> 7; const int n = nb * 64 + F.lane;
            const float* wpg = F.in[I_WPG] + ((size_t)(l * 4 + g) * 128 + (k0 & 127)) * 128;
            const float* psc = F.in[I_PSC] + l * 512 + g * 128;
            const float* wpo = F.in[I_WPO] + ((size_t)l * 512 + g * 128) * 1024 + n;
            float a[8];
#pragma unroll
            for (int i = 0; i < 8; ++i) a[i] = 0.f;
#pragma unroll 4
            for (int j = 0; j < 128; ++j) { const float w = wpo[(size_t)j * 1024] * psc[j];
#pragma unroll
                for (int i = 0; i < 8; ++i) a[i] += wpg[i * 128 + j] * w; }
            u32x4 o; o.x = cvt_pk_bf16(a[0], a[1]); o.y = cvt_pk_bf16(a[2], a[3]); o.z = cvt_pk_bf16(a[4], a[5]); o.w = cvt_pk_bf16(a[6], a[7]);
            *(u32x4*)((bf16_t*)(F.ws + WS_WM) + (size_t)l * 1024 * 2048 + (size_t)n * 2048 + 1536 + k0) = o;
            continue; } r -= N_PE;
        {
            const size_t e0 = (size_t)l * 65536 + (size_t)r * 512 + F.lane * 8;
            const f32x4 a = *(const f32x4*)(F.in[I_WSGU] + e0), b = *(const f32x4*)(F.in[I_WSGU] + e0 + 4);
            u32x4 o; o.x = cvt_pk_bf16(a[0], a[1]); o.y = cvt_pk_bf16(a[2], a[3]); o.z = cvt_pk_bf16(b[0], b[1]); o.w = cvt_pk_bf16(b[2], b[3]);
            *(u32x4*)((bf16_t*)(F.ws + WS_WSGU) + e0) = o;
        }
    }
}

__device__ __forceinline__ const float* x0_row(Frame& F, int t) { return t < T_CTX ? F.in[I_XP] + (size_t)t * DM : F.in[I_XS] + (size_t)(t - T_CTX) * DM; }
__device__ __forceinline__ int vec_of_row(int t) { return t < T_CTX ? 0 : 1 + ((t - T_CTX) >> 12); }

__device__ __forceinline__ void phase_h0(Frame& F) {
    const float* mod = (const float*)(F.ws + WS_MOD);
    bf16_t* act = (bf16_t*)(F.ws + WS_ACT);
    for (int t = F.gw; t < T_ALL; t += F.NGW) {
        const f32x4* xr = (const f32x4*)x0_row(F, t) + F.lane;
        const float* mv = mod + vec_of_row(t) * 6144;
        unsigned long long* o8 = (unsigned long long*)(act + (size_t)t * DM) + F.lane;
#pragma unroll
        for (int j = 0; j < 4; ++j) { const f32x4 x = xr[64 * j]; const int c = 256 * j + 4 * F.lane;
            const f32x4 sh = *(const f32x4*)(mv + c), sc = *(const f32x4*)(mv + 1024 + c);
            const f32x4 h = x * (sc + 1.0f) + sh;
            o8[64 * j] = (unsigned long long)cvt_pk_bf16(h[0], h[1]) | ((unsigned long long)cvt_pk_bf16(h[2], h[3]) << 32); }
    }
}

__device__ __forceinline__ void phase_ln(Frame& F, const float* lg, const float* lb, const float* modl  , int sh_off, int sc_off) {
    float* X = F.out; bf16_t* act = (bf16_t*)(F.ws + WS_ACT);
    for (int t = F.gw; t < T_ALL; t += F.NGW) {
        f32x4* xr = (f32x4*)(X + (size_t)t * DM) + F.lane;
        f32x4 v[4]; float s = 0.f;
#pragma unroll
        for (int j = 0; j < 4; ++j) { v[j] = xr[64 * j]; s += (v[j][0] + v[j][1]) + (v[j][2] + v[j][3]); }
        const float mean = wave_sum(s) * (1.f / DM); float s2 = 0.f;
#pragma unroll
        for (int j = 0; j < 4; ++j) { v[j] = v[j] - mean; s2 += (v[j][0] * v[j][0] + v[j][1] * v[j][1]) + (v[j][2] * v[j][2] + v[j][3] * v[j][3]); }
        const float rstd = rsqrtf(wave_sum(s2) * (1.f / DM) + LN_EPS);
        const float* mv = modl ? modl + vec_of_row(t) * 6144 : nullptr;
        unsigned long long* o8 = (unsigned long long*)(act + (size_t)t * DM) + F.lane;
#pragma unroll
        for (int j = 0; j < 4; ++j) { const int c = 256 * j + 4 * F.lane;
            const f32x4 g = *(const f32x4*)(lg + c), b = *(const f32x4*)(lb + c);
            const f32x4 y = v[j] * rstd * g + b; xr[64 * j] = y;
            if (mv) { const f32x4 sh = *(const f32x4*)(mv + sh_off + c), sc = *(const f32x4*)(mv + sc_off + c);
                const f32x4 h = y * (sc + 1.0f) + sh;
                o8[64 * j] = (unsigned long long)cvt_pk_bf16(h[0], h[1]) | ((unsigned long long)cvt_pk_bf16(h[2], h[3]) << 32); } }
    }
}

__device__ __forceinline__ void load16h(const bf16_t* p, int j, float (&x)[16]) {
#pragma unroll
    for (int a = 0; a < 2; ++a)
#pragma unroll
        for (int hf = 0; hf < 2; ++hf) { const u32x2 w = *(const u32x2*)(p + a * 64 + hf * 32 + 4 * j);
            x[(a * 2 + hf) * 4 + 0] = bf_lo(w.x); x[(a * 2 + hf) * 4 + 1] = bf_hi(w.x); x[(a * 2 + hf) * 4 + 2] = bf_lo(w.y); x[(a * 2 + hf) * 4 + 3] = bf_hi(w.y); }
}
__device__ __forceinline__ void rmsn(float (&x)[16], const float (&g)[16]) {
    float ss = 0.f;
#pragma unroll
    for (int i = 0; i < 16; ++i) ss += x[i] * x[i];
    ss += __shfl_xor(ss, 1); ss += __shfl_xor(ss, 2); ss += __shfl_xor(ss, 4);
    const float rinv = rsqrtf(ss * (1.0f / 128.0f) + LN_EPS);
#pragma unroll
    for (int i = 0; i < 16; ++i) x[i] = x[i] * rinv * g[i];
}
__device__ __forceinline__ void rope16(float (&x)[16], const float* rope, int rowpos, int colpos, int j) {
#pragma unroll
    for (int a = 0; a < 2; ++a) { const int pos = a == 0 ? rowpos : colpos;
        const f32x4 c = *(const f32x4*)(rope + pos * 32 + 4 * j), s = *(const f32x4*)(rope + 2048 + pos * 32 + 4 * j);
#pragma unroll
        for (int e = 0; e < 4; ++e) { const float x1 = x[(a * 2) * 4 + e], x2 = x[(a * 2 + 1) * 4 + e];
            x[(a * 2) * 4 + e] = x1 * c[e] - x2 * s[e]; x[(a * 2 + 1) * 4 + e] = x2 * c[e] + x1 * s[e]; } }
}
__device__ __forceinline__ void store16h(bf16_t* p, int j, const float (&x)[16]) {
#pragma unroll
    for (int a = 0; a < 2; ++a)
#pragma unroll
        for (int hf = 0; hf < 2; ++hf) { u32x2 w; w.x = cvt_pk_bf16(x[(a * 2 + hf) * 4 + 0], x[(a * 2 + hf) * 4 + 1]); w.y = cvt_pk_bf16(x[(a * 2 + hf) * 4 + 2], x[(a * 2 + hf) * 4 + 3]);
            *(u32x2*)(p + a * 64 + hf * 32 + 4 * j) = w; }
}

__device__ __forceinline__ void phase_mid(Frame& F, int l, int part) {
    bf16_t* proj = (bf16_t*)(F.ws + WS_PROJ);
    const float* rope = (const float*)(F.ws + WS_ROPE);
    bf16_t* vrt = (bf16_t*)(F.ws + WS_VRT);
    bf16_t* KL = (bf16_t*)(F.ws + WS_KL); bf16_t* VL = (bf16_t*)(F.ws + WS_VL); bf16_t* KC = (bf16_t*)(F.ws + WS_KC); bf16_t* VC = (bf16_t*)(F.ws + WS_VC);
    float* outk = F.out + (size_t)T_ALL * DM; float* outv = outk + (size_t)16 * 2 * 256 * 256;
    const int lane = F.lane, hj = lane & 7;
    const int n8 = part_rows(part) / 8, ncache = 4 * PAST;
    float qg[16], kg[16];
#pragma unroll
    for (int a = 0; a < 2; ++a)
#pragma unroll
        for (int hf = 0; hf < 2; ++hf)
#pragma unroll
            for (int e = 0; e < 4; ++e) { const int d = a * 64 + hf * 32 + 4 * hj + e; qg[(a * 2 + hf) * 4 + e] = F.in[I_QG][l * 128 + d]; kg[(a * 2 + hf) * 4 + e] = F.in[I_KG][l * 128 + d]; }
    for (int it = F.gw; it < n8 + ncache; it += F.NGW) {
        if (it >= n8) {
            const int cr = it - n8; const int bl = cr >> 9, s = cr & 511; const int b = part * 4 + bl;
            const size_t src = (((size_t)b * 2 + l) * PAST + s) * 256 + lane * 4;
            const f32x4 kx = *(const f32x4*)(F.in[I_CK] + src), vx = *(const f32x4*)(F.in[I_CV] + src);
            const size_t dst = ((size_t)bl * SKV_LAT + s) * 256 + lane * 4;
            u32x2 kw, vw; kw.x = cvt_pk_bf16(kx[0], kx[1]); kw.y = cvt_pk_bf16(kx[2], kx[3]); vw.x = cvt_pk_bf16(vx[0], vx[1]); vw.y = cvt_pk_bf16(vx[2], vx[3]);
            *(u32x2*)(KL + dst) = kw; *(u32x2*)(VL + dst) = vw;
            continue;
        }
        const int lr0 = it * 8, t0 = part_row0(part) + lr0;
        const bool is_ctx = t0 < T_CTX;
        bf16_t* P0 = proj + (size_t)lr0 * NPROJ;
        {
            float val[8][8];
#pragma unroll
            for (int i = 0; i < 8; ++i) { const u32x4 w = *(const u32x4*)(P0 + (size_t)i * NPROJ + PC_XV + lane * 8);
#pragma unroll
                for (int e = 0; e < 4; ++e) { val[i][2 * e] = gelu1(bf_lo(w[e])); val[i][2 * e + 1] = gelu1(bf_hi(w[e])); } }
#pragma unroll
            for (int i = 0; i < 8; ++i) { float s = 0.f;
#pragma unroll
                for (int e = 0; e < 8; ++e) s += val[i][e];
                const float mean = wave_sum(s) * (1.0f / 512.0f); float s2 = 0.f;
#pragma unroll
                for (int e = 0; e < 8; ++e) { val[i][e] -= mean; s2 += val[i][e] * val[i][e]; }
                const float rstd = rsqrtf(wave_sum(s2) * (1.0f / 512.0f) + LN_EPS);
#pragma unroll
                for (int e = 0; e < 8; ++e) val[i][e] *= rstd; }
            const int chunk = lr0 >> 7, q0 = lr0 & 127;
            bf16_t* vb = vrt + ((size_t)chunk * 512 + lane * 8) * 128 + q0;
#pragma unroll
            for (int e = 0; e < 8; ++e) { u32x4 o; o.x = cvt_pk_bf16(val[0][e], val[1][e]); o.y = cvt_pk_bf16(val[2][e], val[3][e]); o.z = cvt_pk_bf16(val[4][e], val[5][e]); o.w = cvt_pk_bf16(val[6][e], val[7][e]);
                *(u32x4*)(vb + (size_t)e * 128) = o; }
        }
#pragma unroll 1
        for (int i = 0; i < 8; ++i) {
            bf16_t* Pr = P0 + (size_t)i * NPROJ; const int t = t0 + i;
            int spos, seqS, rowpos = 0, colpos = 0, bl = 0;
            if (is_ctx) { spos = t & 255; seqS = CTX_S; } else { const int tl = t - T_CTX; spos = tl & 4095; seqS = LAT_S; rowpos = spos >> 6; colpos = spos & 63; bl = (tl >> 12) - part * 4; }
            float x[16];
            load16h(Pr + PC_Q + (lane >> 3) * 128, hj, x); rmsn(x, qg); if (!is_ctx) rope16(x, rope, rowpos, colpos, hj);
            store16h(Pr + PC_Q + (lane >> 3) * 128, hj, x);
            const int kh = (lane >> 3) & 1;
            load16h(Pr + PC_K + kh * 128, hj, x); rmsn(x, kg);
            const int vi = (lane - 16) & 31;
            const u32x4 vw = *(const u32x4*)(Pr + PC_V + vi * 8);
            float pacc[8], pself[8];
            {
                const int hw = 1 << (lane >> 4);
                const int lo = max(spos - hw, 0), hi = min(spos + hw, seqS);
#pragma unroll
                for (int e = 0; e < 8; ++e) pacc[e] = 0.f;
                for (int dd = lo - spos; dd < hi - spos; ++dd) { const u32x4 w = *(const u32x4*)(Pr + (long)dd * NPROJ + PC_XP + lane * 8);
#pragma unroll
                    for (int e = 0; e < 4; ++e) { pacc[2 * e] += bf_lo(w[e]); pacc[2 * e + 1] += bf_hi(w[e]); } }
                const u32x4 w = *(const u32x4*)(Pr + PC_XP + lane * 8);
#pragma unroll
                for (int e = 0; e < 4; ++e) { pself[2 * e] = bf_lo(w[e]); pself[2 * e + 1] = bf_hi(w[e]); }
                const float rc = 1.0f / (float)(hi - lo);
#pragma unroll
                for (int e = 0; e < 8; ++e) pacc[e] = pacc[e] * rc - pself[e];
            }
            asm volatile("s_waitcnt vmcnt(0)" ::: "memory");
            if (is_ctx) {
                if (lane < 16) {
                    float* ok = outk + (((size_t)(t >> 8) * 2 + l) * 256 + (t & 255)) * 256 + kh * 128;
#pragma unroll
                    for (int a = 0; a < 2; ++a)
#pragma unroll
                        for (int hf = 0; hf < 2; ++hf) *(f32x4*)(ok + a * 64 + hf * 32 + 4 * hj) = (f32x4){x[(a * 2 + hf) * 4], x[(a * 2 + hf) * 4 + 1], x[(a * 2 + hf) * 4 + 2], x[(a * 2 + hf) * 4 + 3]};
                    store16h(KC + (size_t)t * 256 + kh * 128, hj, x);
                }
                if (lane >= 16 && lane < 48) {
                    float* ov = outv + (((size_t)(t >> 8) * 2 + l) * 256 + (t & 255)) * 256 + vi * 8;
                    *(f32x4*)ov = (f32x4){bf_lo(vw[0]), bf_hi(vw[0]), bf_lo(vw[1]), bf_hi(vw[1])};
                    *(f32x4*)(ov + 4) = (f32x4){bf_lo(vw[2]), bf_hi(vw[2]), bf_lo(vw[3]), bf_hi(vw[3])};
                    *(u32x4*)(VC + (size_t)t * 256 + vi * 8) = vw;
                }
            } else {
                rope16(x, rope, rowpos, colpos, hj);
                const size_t krow = ((size_t)bl * SKV_LAT + PAST + spos) * 256;
                if (lane < 16) store16h(KL + krow + kh * 128, hj, x);
                if (lane >= 16 && lane < 48) *(u32x4*)(VL + krow + vi * 8) = vw;
            }
            { u32x4 o; o.x = cvt_pk_bf16(pacc[0], pacc[1]); o.y = cvt_pk_bf16(pacc[2], pacc[3]); o.z = cvt_pk_bf16(pacc[4], pacc[5]); o.w = cvt_pk_bf16(pacc[6], pacc[7]);
              *(u32x4*)(Pr + PC_K + lane * 8) = o; }
        }
    }
}

__device__ __forceinline__ void phase_attn(Frame& F, int l, int part) {
    bf16_t* proj = (bf16_t*)(F.ws + WS_PROJ);
    const bf16_t* KL = (const bf16_t*)(F.ws + WS_KL); const bf16_t* VL = (const bf16_t*)(F.ws + WS_VL); const bf16_t* KC = (const bf16_t*)(F.ws + WS_KC); const bf16_t* VC = (const bf16_t*)(F.ws + WS_VC);
    const int lat_row0 = part == 0 ? T_CTX : 0;
    {
        int pair, idx, step;
        const bool xcdmap = (F.G % 8) == 0;
        if (xcdmap) { pair = F.bx & 7; idx = F.bx >> 3; step = F.G >> 3; } else { pair = 0; idx = F.bx; step = F.G; }
        for (;;) {
            int pr = pair, ix = idx;
            if (!xcdmap) { pr = idx >> 6; ix = idx & 63; if (idx >= 512) break; } else if (idx >= 64) break;
            const int bl = pr >> 1, kvh = pr & 1, h = kvh * 4 + (ix >> 4), qb = ix & 15;
            bf16_t* Qb = proj + (size_t)(lat_row0 + bl * LAT_S + qb * 256) * NPROJ + PC_Q + h * 128;
            att::attn_dense_body(Qb, KL + (size_t)bl * SKV_LAT * 256 + kvh * 128, VL + (size_t)bl * SKV_LAT * 256 + kvh * 128, SKV_LAT, F.ldsg, F.tid);
            idx += step;
        }
    }
    if (part == 0) {
        for (int u = F.bx; u < 128; u += F.G) { const int b = u >> 3, h = u & 7;
            bf16_t* Qb = proj + (size_t)(b * 256) * NPROJ + PC_Q + h * 128;
            att::attn_dense_body(Qb, KC + (size_t)b * 256 * 256 + (h >> 2) * 128, VC + (size_t)b * 256 * 256 + (h >> 2) * 128, CTX_S, F.ldsg, F.tid); }
    }
    const bf16_t* vrt = (const bf16_t*)(F.ws + WS_VRT);
    const bf16_t* wsb = (const bf16_t*)(F.ws + WS_WSGU) + (size_t)l * 65536;
    const float* bs = F.in[I_BSGU] + l * 512;
    const int nitem = (part_rows(part) / 128) * 32;
    const int ln = F.lane & 15, quad = F.lane >> 4;
    for (int it = F.gw; it < nitem; it += F.NGW) {
        const int chunk = it >> 5, g = (it >> 3) & 3, cb = (it >> 1) & 3, pb = it & 1;
        f32x4 acc[2][4];
#pragma unroll
        for (int a = 0; a < 2; ++a)
#pragma unroll
            for (int b = 0; b < 4; ++b) acc[a][b] = (f32x4){0.f, 0.f, 0.f, 0.f};
        const bf16_t* ap = vrt + ((size_t)chunk * 512 + g * 128 + cb * 32 + ln) * 128 + quad * 8;
        const bf16_t* bp = wsb + ((size_t)g * 128 + pb * 64 + ln) * 128 + quad * 8;
#pragma unroll
        for (int ks = 0; ks < 4; ++ks) {
            bf16x8 af[2], bfr[4];
#pragma unroll
            for (int ct = 0; ct < 2; ++ct) af[ct] = *(const bf16x8*)(ap + ct * 16 * 128 + ks * 32);
#pragma unroll
            for (int pt = 0; pt < 4; ++pt) bfr[pt] = *(const bf16x8*)(bp + pt * 16 * 128 + ks * 32);
#pragma unroll
            for (int ct = 0; ct < 2; ++ct)
#pragma unroll
                for (int pt = 0; pt < 4; ++pt) acc[ct][pt] = __builtin_amdgcn_mfma_f32_16x16x32_bf16(af[ct], bfr[pt], acc[ct][pt], 0, 0, 0);
        }
#pragma unroll
        for (int pt = 0; pt < 4; ++pt) { const int p = pb * 64 + pt * 16 + ln; const float bsv = bs[g * 128 + p];
#pragma unroll
            for (int ct = 0; ct < 2; ++ct) { const int c = g * 128 + cb * 32 + ct * 16 + quad * 4;
                bf16_t* up = proj + (size_t)(chunk * 128 + p) * NPROJ + PC_U + c;
                const u32x2 w = *(const u32x2*)up;
                const float u0 = gelu1(bf_lo(w.x)), u1 = gelu1(bf_hi(w.x)), u2 = gelu1(bf_lo(w.y)), u3 = gelu1(bf_hi(w.y));
                const f32x4 a = acc[ct][pt];
                u32x2 o; o.x = cvt_pk_bf16(u0 * (a[0] + bsv), u1 * (a[1] + bsv)); o.y = cvt_pk_bf16(u2 * (a[2] + bsv), u3 * (a[3] + bsv));
                *(u32x2*)up = o; } }
    }
}

constexpr int NPL = 13, NPHASE = 2 + DEPTH * NPL;
__global__ void __launch_bounds__(NW * 64, 2) fwd_kernel(Args args) {
    extern __shared__ __attribute__((aligned(16))) unsigned char lds[];
    Frame F;
    F.lds = (LAS unsigned char*)lds; F.ldsg = (char*)lds;
    F.G = gridDim.x; F.bx = blockIdx.x; F.NGW = F.G * NW;
    F.in = args.in; F.ws = args.ws; F.out = args.out;
    const float* mod = (const float*)(F.ws + WS_MOD);
    bf16_t* act = (bf16_t*)(F.ws + WS_ACT); bf16_t* proj = (bf16_t*)(F.ws + WS_PROJ);

    for (int ph = args.ph_lo; ph < args.ph_hi; ++ph) {
        { int tidv = threadIdx.x; asm volatile("" : "+v"(tidv));
          F.tid = tidv; F.lane = tidv & 63; F.wave = __builtin_amdgcn_readfirstlane(tidv >> 6); F.gw = F.bx * NW + F.wave; }
#ifndef PHMASK
#define PHMASK 0xffff
#endif
        if (ph == 0) { if (PHMASK & 1) phase_prologue(F); }
        else if (ph == 1) { if (PHMASK & 2) phase_h0(F); }
        else {
            const int l = (ph - 2) / NPL, s = (ph - 2) % NPL;
            if (s < 8) {
                const int part = s >> 2, q = s & 3;
                if (q == 0) { if (PHMASK & 4) {
                    pg8::Gemm g{}; g.A = act + (size_t)part_row0(part) * DM; g.Bt = (const bf16_t*)(F.ws + WS_WIN) + (size_t)l * NPROJ * DM; g.lda = DM; g.ldb = DM;
                    g.nM = part_rows(part) / 256; g.nN = NPROJ / 256; g.nseg = 1; g.k0[0] = 0; g.nt[0] = 16; g.k0[1] = 0; g.nt[1] = 16; g.k0[2] = 0; g.nt[2] = 16;
                    pg8::Order S; S.init(g.nM, g.nN, 1, F.G, F.bx);
                    pg8::EpiStore E{proj, NPROJ};
                    pg8::gemm_phase<pg8::EpiStore>(F.lds, g, S, E, F.tid); }
                } else if (q == 1) { if (PHMASK & 8) phase_mid(F, l, part); }
                else if (q == 2) { if (PHMASK & 16) phase_attn(F, l, part); }
                else if (PHMASK & 32) {
                    pg8::Gemm g{}; g.A = proj; g.Bt = (const bf16_t*)(F.ws + WS_WM) + (size_t)l * DM * 2048; g.lda = NPROJ; g.ldb = 2048;
                    g.nM = part_rows(part) / 256; g.nN = 4; g.nseg = 3; g.k0[0] = 0; g.nt[0] = 16; g.k0[1] = 1024; g.nt[1] = 8; g.k0[2] = 1536; g.nt[2] = 8;
                    pg8::Order S; S.init(g.nM, g.nN, 3, F.G, F.bx);
                    pg8::EpiGate E{proj, act + (size_t)part_row0(part) * DM, DM};
                    pg8::gemm_phase<pg8::EpiGate>(F.lds, g, S, E, F.tid);
                }
            } else if (s == 8) { if (PHMASK & 64) {
                pg8::Gemm g{}; g.A = act; g.Bt = (const bf16_t*)(F.ws + WS_WOUT) + (size_t)l * DM * DM; g.lda = DM; g.ldb = DM;
                g.nM = T_ALL / 256; g.nN = 4; g.nseg = 1; g.k0[0] = 0; g.nt[0] = 16; g.k0[1] = 0; g.nt[1] = 16; g.k0[2] = 0; g.nt[2] = 16;
                pg8::Order S; S.init(g.nM, g.nN, 1, F.G, F.bx);
                pg8::EpiResid E{l == 0 ? F.in[I_XP] : F.out, l == 0 ? F.in[I_XS] : F.out + (size_t)T_CTX * DM, F.out, mod + l * 9 * 6144, 2048};
                pg8::gemm_phase<pg8::EpiResid>(F.lds, g, S, E, F.tid); }
            } else if (s == 9) {
                if (PHMASK & 128) phase_ln(F, F.in[I_LN1G] + l * DM, F.in[I_LN1B] + l * DM, mod + l * 9 * 6144, 3072, 4096);
            } else if (s == 10) { if (PHMASK & 256) {
                pg8::Gemm g{}; g.A = act; g.Bt = (const bf16_t*)(F.ws + WS_WF1) + (size_t)l * 2 * DFF * DM; g.lda = DM; g.ldb = DM;
                g.nM = T_ALL / 256; g.nN = 2 * DFF / 256; g.nseg = 1; g.k0[0] = 0; g.nt[0] = 16; g.k0[1] = 0; g.nt[1] = 16; g.k0[2] = 0; g.nt[2] = 16;
                pg8::Order S; S.init(g.nM, g.nN, 1, F.G, F.bx);
                pg8::EpiSwiGLU E{proj, DFF};
                pg8::gemm_phase<pg8::EpiSwiGLU>(F.lds, g, S, E, F.tid); }
            } else if (s == 11) { if (PHMASK & 512) {
                pg8::Gemm g{}; g.A = proj; g.Bt = (const bf16_t*)(F.ws + WS_WF2) + (size_t)l * DM * DFF; g.lda = DFF; g.ldb = DFF;
                g.nM = T_ALL / 256; g.nN = 4; g.nseg = 1; g.k0[0] = 0; g.nt[0] = 44; g.k0[1] = 0; g.nt[1] = 44; g.k0[2] = 0; g.nt[2] = 44;
                pg8::Order S; S.init(g.nM, g.nN, 1, F.G, F.bx);
                pg8::EpiResid E{F.out, F.out + (size_t)T_CTX * DM, F.out, mod + l * 9 * 6144, 5120};
                pg8::gemm_phase<pg8::EpiResid>(F.lds, g, S, E, F.tid); }
            } else if (PHMASK & 1024) {
                phase_ln(F, F.in[I_LN2G] + l * DM, F.in[I_LN2B] + l * DM, l + 1 < DEPTH ? mod + (l + 1) * 9 * 6144 : nullptr, 0, 1024);
            }
        }
        if (ph + 1 < args.ph_hi) cg::this_grid().sync();
    }
}

extern "C" void kernel_launch(void* const* d_in, const int* in_sizes, int n_in, void* d_out, int out_size, void* d_ws, size_t ws_size, hipStream_t stream) {
    static int grid = 0;
    if (grid == 0) {
        if (n_in != 25 || ws_size < WS_END) { fprintf(stderr, "kernel_launch: unexpected n_in %d / ws %zu\n", n_in, ws_size); grid = -1; return; }
        int dev = 0, cus = 0, per_cu = 0;
        if (hipGetDevice(&dev) != hipSuccess || hipDeviceGetAttribute(&cus, hipDeviceAttributeMultiprocessorCount, dev) != hipSuccess) { grid = -1; return; }
        if (hipFuncSetAttribute((const void*)fwd_kernel, hipFuncAttributeMaxDynamicSharedMemorySize, LDS_BYTES) != hipSuccess) { fprintf(stderr, "kernel_launch: hipFuncSetAttribute failed\n"); grid = -1; return; }
        if (hipOccupancyMaxActiveBlocksPerMultiprocessor(&per_cu, (const void*)fwd_kernel, NW * 64, LDS_BYTES) != hipSuccess || per_cu < 1) per_cu = 1;
        (void)hipGetLastError();
        grid = cus * (per_cu > 1 ? 1 : per_cu);
    }
    if (grid < 0) return;
    Args a{};
    for (int i = 0; i < 25; ++i) a.in[i] = (const float*)d_in[i];
    a.out = (float*)d_out; a.ws = (unsigned char*)d_ws;
#if MK_MULTI
    for (int ph = 0; ph < NPHASE; ++ph) { a.ph_lo = ph; a.ph_hi = ph + 1; hipLaunchKernelGGL(fwd_kernel, dim3(grid), dim3(NW * 64), LDS_BYTES, stream, a); }
#else
    a.ph_lo = 0; a.ph_hi = NPHASE;
    void* kargs[] = {&a};
    hipError_t e = hipLaunchCooperativeKernel((const void*)fwd_kernel, dim3(grid), dim3(NW * 64), kargs, LDS_BYTES, stream);
    if (e != hipSuccess) fprintf(stderr, "cooperative launch failed: %s (grid %d)\n", hipGetErrorString(e), grid);
#endif
}
```

```cpp
#include <hip/hip_runtime.h>
#include <hip/hip_bf16.h>
#include <hip/hip_cooperative_groups.h>
#include <cstdio>
#include <cstdint>
namespace cg = cooperative_groups;

#ifndef PROBE
#define PROBE 0
#endif
#ifndef MK_MULTI
#define MK_MULTI 0
#endif

#define LAS __attribute__((address_space(3)))
typedef unsigned short bf16_t;
typedef short bf16x8 __attribute__((ext_vector_type(8)));
typedef short s16x4 __attribute__((ext_vector_type(4)));
typedef float f32x2 __attribute__((ext_vector_type(2)));
typedef float f32x4 __attribute__((ext_vector_type(4)));
typedef float f32x16 __attribute__((ext_vector_type(16)));
typedef unsigned u32x2 __attribute__((ext_vector_type(2)));
typedef unsigned u32x4 __attribute__((ext_vector_type(4)));

constexpr int DM = 1024, NPROJ = 6144, DFF = 2816, DEPTH = 2;
constexpr int T_CTX = 4096, T_ALL = 36864;
constexpr int CTX_S = 256, LAT_S = 4096, PAST = 512, SKV_LAT = 4608;
constexpr int PC_Q = 0, PC_U = 1024, PC_K = 1536, PC_V = 1792, PC_XV = 2048, PC_XP = 2560, PC_G = 3072;
constexpr float LN_EPS = 1e-6f;
constexpr float ALPHA = 1.41421356237309515f;
constexpr int NW = 8;
__host__ __device__ constexpr int part_row0(int p) { return p == 0 ? 0 : 20480; }
__host__ __device__ constexpr int part_rows(int p) { return p == 0 ? 20480 : 16384; }

constexpr size_t MiB = 1u << 20;
constexpr size_t WS_MOD = 0;
constexpr size_t WS_BAR = 448 * 1024;
constexpr size_t WS_ROPE = 512 * 1024;
constexpr size_t WS_WSGU = 768 * 1024;
constexpr size_t WS_WIN = 1 * MiB;
constexpr size_t WS_WM = 25 * MiB;
constexpr size_t WS_WOUT = 33 * MiB;
constexpr size_t WS_WF1 = 37 * MiB;
constexpr size_t WS_WF2 = 59 * MiB;
constexpr size_t WS_ACT = 70 * MiB;
constexpr size_t WS_PROJ = 142 * MiB;
constexpr size_t WS_KL = 382 * MiB, WS_VL = 391 * MiB;
constexpr size_t WS_KC = 400 * MiB, WS_VC = 402 * MiB;
constexpr size_t WS_VRT = 404 * MiB;
constexpr size_t WS_END = 424 * MiB;

constexpr int LDS_BYTES = 135168;

__device__ __forceinline__ unsigned cvt_pk_bf16(float lo, float hi) { unsigned r; asm volatile("v_cvt_pk_bf16_f32 %0, %1, %2" : "=v"(r) : "v"(lo), "v"(hi)); return r; }
__device__ __forceinline__ float bf_lo(unsigned u) { return __uint_as_float(u << 16); }
__device__ __forceinline__ float bf_hi(unsigned u) { return __uint_as_float(u & 0xffff0000u); }
__device__ __forceinline__ float wave_sum(float v) {
#pragma unroll
    for (int o = 1; o < 64; o <<= 1) v += __shfl_xor(v, o);
    return v;
}
__device__ __forceinline__ float gelu1(float v) {
    const float av = fabsf(v), d = av * 0.2316418882f + 1.0f;
    const float t = __builtin_amdgcn_rcpf(d);
    float q = t * 0.5307027145f + (-0.7265760135f); q = q * t + 0.7107068705f; q = q * t + (-0.142248368f); q = q * t + 0.127414796f; q = q * t;
    const float e = __builtin_amdgcn_exp2f((v * v) * (-0.72134752044f));
    const float m = v * (q * e), r = v - m;
    return v < 0.f ? m : r;
}
__device__ __forceinline__ float sigmoidf_(float x) { return 1.0f / (1.0f + __expf(-x)); }

namespace pg8 {
constexpr int BM = 256, BK = 64, HALF = 128, HTB = HALF * BK * 2, STAGE_BYTES = 8 * HTB, NXCD = 8, WGM = 8;
__host__ __device__ __forceinline__ int lds_byte(int r, int c) { const int st = (r >> 4) * 2 + (c >> 5), rr = r & 15, cc = c & 31, ob = rr * 64 + cc * 2; return st * 1024 + (ob ^ (((ob >> 9) & 1) << 5)); }
__host__ __device__ __forceinline__ void stage_rc(int b, int& R, int& C) { const int st = b / 1024, sb = b % 1024, swz = sb ^ (((sb >> 9) & 1) << 5); R = (st >> 1) * 16 + swz / 64; C = (st & 1) * 32 + (swz % 64) / 2; }
__host__ __device__ __forceinline__ int perm32(int rho) { const int n = rho >> 4, i = rho & 15; return 8 * (i >> 2) + 4 * n + (i & 3); }

struct Unit { int pm, pn, seg; };
struct Gemm { const bf16_t* A; const bf16_t* Bt; int lda, ldb, nM, nN, nseg; int k0[3]; int nt[3]; };

struct Order {
    int nM, nN, nwg, G, c, nseg;
    __device__ void init(int nM_, int nN_, int nseg_, int G_, int c_) { nM = nM_; nN = nN_; nwg = nM * nN; G = G_; c = c_; nseg = nseg_; }
    __device__ bool next(int i, Unit& u) const {
        const int ti = i / nseg; u.seg = i - ti * nseg;
        const long L = (long)ti * G + c; if (L >= nwg) return false;
        int wgid = (int)L; { const int q = nwg / NXCD, r = nwg % NXCD, xcd = wgid % NXCD, off = wgid / NXCD; wgid = (xcd < r ? xcd * (q + 1) : r * (q + 1) + (xcd - r) * q) + off; }
        const int nig = WGM * nN, gid = wgid / nig, fm = gid * WGM, gsz = (nM - fm) < WGM ? (nM - fm) : WGM;
        u.pm = fm + ((wgid % nig) % gsz); u.pn = (wgid % nig) / gsz; return true;
    }
};

struct EpiStore {
    static constexpr bool PERM = true;
    bf16_t* O; int ldc;
    __device__ __forceinline__ void run(f32x4 (&acc)[2][2][4][2], const Unit& u, int wr, int wc, int fr, int fq) const {
        const int row0 = u.pm * BM + wr * 64 + fr; const int col0 = u.pn * BM + wc * 32 + 8 * fq;
#pragma unroll
        for (int ai = 0; ai < 2; ++ai)
#pragma unroll
            for (int m = 0; m < 4; ++m) { bf16_t* rowp = O + (size_t)(row0 + ai * HALF + m * 16) * ldc + col0;
#pragma unroll
                for (int bj = 0; bj < 2; ++bj) { const f32x4 v0 = acc[ai][bj][m][0], v1 = acc[ai][bj][m][1];
                    u32x4 w; w.x = cvt_pk_bf16(v0[0], v0[1]); w.y = cvt_pk_bf16(v0[2], v0[3]); w.z = cvt_pk_bf16(v1[0], v1[1]); w.w = cvt_pk_bf16(v1[2], v1[3]);
                    *(u32x4*)(rowp + bj * HALF) = w; } }
    }
};
struct EpiSwiGLU {
    static constexpr bool PERM = true;
    bf16_t* O; int ldc;
    __device__ __forceinline__ void run(f32x4 (&acc)[2][2][4][2], const Unit& u, int wr, int wc, int fr, int fq) const {
        const int row0 = u.pm * BM + wr * 64 + fr; const int col0 = u.pn * HALF + wc * 32 + 8 * fq;
#pragma unroll
        for (int ai = 0; ai < 2; ++ai)
#pragma unroll
            for (int m = 0; m < 4; ++m) { bf16_t* rowp = O + (size_t)(row0 + ai * HALF + m * 16) * ldc + col0;
                float o[8];
#pragma unroll
                for (int n = 0; n < 2; ++n)
#pragma unroll
                    for (int e = 0; e < 4; ++e) { const float a = acc[ai][0][m][n][e], b = acc[ai][1][m][n][e]; o[n * 4 + e] = a * sigmoidf_(a) * b; }
                u32x4 w; w.x = cvt_pk_bf16(o[0], o[1]); w.y = cvt_pk_bf16(o[2], o[3]); w.z = cvt_pk_bf16(o[4], o[5]); w.w = cvt_pk_bf16(o[6], o[7]);
                *(u32x4*)rowp = w; }
    }
};
struct EpiResid {
    static constexpr bool PERM = false;
    const float* xres_ctx; const float* xres_lat;
    float* out; const float* mod; int goff;
    __device__ __forceinline__ void run(f32x4 (&acc)[2][2][4][2], const Unit& u, int wr, int wc, int fr, int fq) const {
        const int v = u.pm < 16 ? 0 : 1 + ((u.pm - 16) >> 4);
        const float* xb = u.pm < 16 ? xres_ctx + (size_t)u.pm * BM * DM : xres_lat + (size_t)(u.pm - 16) * BM * DM;
        float* ob = out + (size_t)u.pm * BM * DM;
        const int col0 = u.pn * BM + wc * 32 + 4 * fq;
        const float* gp = mod + v * 6144 + goff + col0;
        f32x4 gv[2][2];
#pragma unroll
        for (int bj = 0; bj < 2; ++bj)
#pragma unroll
            for (int n = 0; n < 2; ++n) gv[bj][n] = *(const f32x4*)(gp + bj * HALF + n * 16);
#pragma unroll
        for (int ai = 0; ai < 2; ++ai)
#pragma unroll
            for (int m = 0; m < 4; ++m) { const size_t off = (size_t)(ai * HALF + wr * 64 + m * 16 + fr) * DM + col0;
#pragma unroll
                for (int bj = 0; bj < 2; ++bj)
#pragma unroll
                    for (int n = 0; n < 2; ++n) { const f32x4 x = *(const f32x4*)(xb + off + bj * HALF + n * 16);
                        *(f32x4*)(ob + off + bj * HALF + n * 16) = x * ALPHA + gv[bj][n] * acc[ai][bj][m][n]; } }
    }
};
struct EpiGate {
    static constexpr bool PERM = true;
    const bf16_t* P;
    bf16_t* O; int ldc;
    __device__ __forceinline__ void run(f32x4 (&acc)[2][2][4][2], const Unit& u, int wr, int wc, int fr, int fq) const {
        const int row0 = u.pm * BM + wr * 64 + fr; const int col0 = u.pn * BM + wc * 32 + 8 * fq;
        const int noff = u.seg == 0 ? 0 : (u.seg == 1 ? 2048 : 1024), doff = u.seg == 0 ? 2048 : 1024;
        const bool last = u.seg == 2;
#pragma unroll
        for (int ai = 0; ai < 2; ++ai)
#pragma unroll
            for (int m = 0; m < 4; ++m) { const size_t r = (size_t)(row0 + ai * HALF + m * 16);
                const bf16_t* gp = P + r * NPROJ + PC_G + col0;
#pragma unroll
                for (int bj = 0; bj < 2; ++bj) {
                    const u32x4 gn = *(const u32x4*)(gp + noff + bj * HALF);
                    u32x4 gd = gn; if (!last) gd = *(const u32x4*)(gp + doff + bj * HALF);
                    float f[8];
#pragma unroll
                    for (int e = 0; e < 4; ++e) {
                        float a0 = bf_lo(gn[e]), a1 = bf_hi(gn[e]);
                        a0 = fminf(fmaxf(a0, -60.f), 60.f); a1 = fminf(fmaxf(a1, -60.f), 60.f);
                        const float ea0 = __expf(-a0), ea1 = __expf(-a1);
                        if (last) { f[2 * e] = 1.0f / (1.0f + ea0); f[2 * e + 1] = 1.0f / (1.0f + ea1); }
                        else { float b0 = bf_lo(gd[e]), b1 = bf_hi(gd[e]);
                            b0 = fminf(fmaxf(b0, -60.f), 60.f); b1 = fminf(fmaxf(b1, -60.f), 60.f);
                            f[2 * e] = (1.0f + __expf(-b0)) / (1.0f + ea0); f[2 * e + 1] = (1.0f + __expf(-b1)) / (1.0f + ea1); }
                    }
                    f32x4 v0 = acc[ai][bj][m][0], v1 = acc[ai][bj][m][1];
                    v0[0] *= f[0]; v0[1] *= f[1]; v0[2] *= f[2]; v0[3] *= f[3]; v1[0] *= f[4]; v1[1] *= f[5]; v1[2] *= f[6]; v1[3] *= f[7];
                    if (last) { u32x4 w; w.x = cvt_pk_bf16(v0[0], v0[1]); w.y = cvt_pk_bf16(v0[2], v0[3]); w.z = cvt_pk_bf16(v1[0], v1[1]); w.w = cvt_pk_bf16(v1[2], v1[3]);
                        *(u32x4*)(O + r * ldc + col0 + bj * HALF) = w; }
                    else { acc[ai][bj][m][0] = v0; acc[ai][bj][m][1] = v1; }
                } }
    }
};

struct EpiNone { static constexpr bool PERM = true; __device__ __forceinline__ void run(f32x4 (&acc)[2][2][4][2], const Unit& u, int wr, int wc, int fr, int fq) const {
    _Pragma("unroll") for (int a = 0; a < 2; ++a) _Pragma("unroll") for (int b = 0; b < 2; ++b) _Pragma("unroll") for (int m = 0; m < 4; ++m) _Pragma("unroll") for (int n = 0; n < 2; ++n) asm volatile("" :: "v"(acc[a][b][m][n])); } };
template <class Epi>
__device__ __forceinline__ void gemm_phase(LAS unsigned char* lds, const Gemm g, const Order& S, const Epi& E, const int tid) {
    const int wid = __builtin_amdgcn_readfirstlane(tid >> 6), lane = tid & 63, wr = wid >> 2, wc = wid & 3, fr = lane & 15, fq = lane >> 4;
    unsigned voffA[2], voffB[2];
#pragma unroll
    for (int i = 0; i < 2; ++i) { int R, C; stage_rc(tid * 16 + i * 8192, R, C); const int Rb = Epi::PERM ? ((R & ~31) + perm32(R & 31)) : R;
        voffA[i] = (unsigned)(R * g.lda + C) * 2u; voffB[i] = (unsigned)(Rb * g.ldb + C) * 2u; }
    const size_t kstep = (size_t)(BK * 2);
    const size_t hstepA = (size_t)HALF * g.lda * 2, hstepB = (size_t)HALF * g.ldb * 2;
    const size_t tstepA = 2 * hstepA, tstepB = 2 * hstepB;
    const unsigned ldsw = (unsigned)wid * 1024u;
    const int aoff = lds_byte(wr * 64 + fr, fq * 8), boff = lds_byte(wc * 32 + fr, fq * 8);
#define PG8_SA(b, h) (((b) * 2 + (h)) * HTB)
#define PG8_SB(b, h) ((4 + (b) * 2 + (h)) * HTB)
#define PG8_STAGE(bufoff, gbase, voff) do { _Pragma("unroll") for (int _i = 0; _i < 2; ++_i) \
        __builtin_amdgcn_global_load_lds((const unsigned*)((const char*)(gbase) + (voff)[_i]), (LAS unsigned*)(lds + (bufoff) + ldsw + _i * 8192), 16, 0, 0); } while (0)
#define PG8_LDA(dst, b, h) do { _Pragma("unroll") for (int m = 0; m < 4; ++m) _Pragma("unroll") for (int k = 0; k < 2; ++k) dst[m][k] = *(const LAS bf16x8*)(lds + PG8_SA(b, h) + aoff + m * 2048 + k * 1024); } while (0)
#define PG8_LDB(dst, b, h) do { _Pragma("unroll") for (int n = 0; n < 2; ++n) _Pragma("unroll") for (int k = 0; k < 2; ++k) dst[n][k] = *(const LAS bf16x8*)(lds + PG8_SB(b, h) + boff + n * 2048 + k * 1024); } while (0)
#define PG8_MMA(ai, bj, At, Bt) do { __builtin_amdgcn_s_setprio(1); _Pragma("unroll") for (int m = 0; m < 4; ++m) _Pragma("unroll") for (int n = 0; n < 2; ++n) _Pragma("unroll") for (int k = 0; k < 2; ++k) \
        acc[ai][bj][m][n] = __builtin_amdgcn_mfma_f32_16x16x32_bf16(Bt[n][k], At[m][k], acc[ai][bj][m][n], 0, 0, 0); __builtin_amdgcn_s_setprio(0); } while (0)
#define PG8_WAIT_V(n) asm volatile("s_waitcnt vmcnt(" #n ")" ::: "memory")
#define PG8_WAIT_L(n) asm volatile("s_waitcnt lgkmcnt(" #n ")" ::: "memory")
#define PG8_BAR __builtin_amdgcn_s_barrier()
#define PG8_SCHED __builtin_amdgcn_sched_barrier(0)
#define KOF(sg) ((sg) == 0 ? g.k0[0] : ((sg) == 1 ? g.k0[1] : g.k0[2]))
#define NTF(sg) ((sg) == 0 ? g.nt[0] : ((sg) == 1 ? g.nt[1] : g.nt[2]))
    Unit cur, nxt; int ui = 0;
    if (!S.next(0, cur)) return;
    f32x4 acc[2][2][4][2];
#pragma unroll
    for (int a = 0; a < 2; ++a)
#pragma unroll
        for (int b = 0; b < 2; ++b)
#pragma unroll
            for (int m = 0; m < 4; ++m)
#pragma unroll
                for (int n = 0; n < 2; ++n) acc[a][b][m][n] = (f32x4){0.f, 0.f, 0.f, 0.f};
    bf16x8 At[4][2], B0[2][2], B1[2][2];
    const char* cA = (const char*)g.A + (size_t)cur.pm * tstepA + (size_t)KOF(cur.seg) * 2; const char* cB = (const char*)g.Bt + (size_t)cur.pn * tstepB + (size_t)KOF(cur.seg) * 2;
    PG8_STAGE(PG8_SB(0, 0), cB, voffB); PG8_STAGE(PG8_SB(0, 1), cB + hstepB, voffB); PG8_STAGE(PG8_SA(0, 0), cA, voffA); PG8_STAGE(PG8_SA(0, 1), cA + hstepA, voffA);
    if (wr == 1) PG8_BAR;
    PG8_WAIT_V(2); PG8_BAR;
    PG8_STAGE(PG8_SB(1, 0), cB + kstep, voffB); PG8_STAGE(PG8_SA(1, 0), cA + kstep, voffA); PG8_STAGE(PG8_SB(1, 1), cB + hstepB + kstep, voffB);
    PG8_WAIT_V(6); PG8_BAR;
    for (;;) {
        const bool has_next = S.next(ui + 1, nxt);
        const int nt = NTF(cur.seg);
        const char* nA = has_next ? (const char*)g.A + (size_t)nxt.pm * tstepA + (size_t)KOF(nxt.seg) * 2 : cA;
        const char* nB = has_next ? (const char*)g.Bt + (size_t)nxt.pn * tstepB + (size_t)KOF(nxt.seg) * 2 : cB;
        for (int t = 0; t < nt; t += 2) {
            const bool last = (t == nt - 2);
            const char* a1 = cA + (size_t)(t + 1) * kstep;
            const char* a2 = last ? nA : cA + (size_t)(t + 2) * kstep; const char* b2 = last ? nB : cB + (size_t)(t + 2) * kstep;
            const char* a3 = a2 + kstep; const char* b3 = b2 + kstep;
            PG8_LDB(B0, 0, 0); PG8_LDB(B1, 0, 1); PG8_SCHED; PG8_LDA(At, 0, 0); PG8_STAGE(PG8_SA(1, 1), a1 + hstepA, voffA);
            PG8_WAIT_V(8); PG8_WAIT_L(0); PG8_BAR; PG8_MMA(0, 0, At, B0); PG8_MMA(0, 1, At, B1); PG8_BAR; PG8_SCHED;
            PG8_LDA(At, 0, 1); PG8_STAGE(PG8_SB(0, 0), b2, voffB); PG8_STAGE(PG8_SB(0, 1), b2 + hstepB, voffB); PG8_STAGE(PG8_SA(0, 0), a2, voffA);
            PG8_WAIT_V(8); PG8_WAIT_L(0); PG8_BAR; PG8_MMA(1, 0, At, B0); PG8_MMA(1, 1, At, B1); PG8_BAR; PG8_SCHED;
            PG8_LDB(B0, 1, 0); PG8_LDB(B1, 1, 1); PG8_SCHED; PG8_LDA(At, 1, 0); PG8_STAGE(PG8_SA(0, 1), a2 + hstepA, voffA);
            PG8_WAIT_V(8); PG8_WAIT_L(0); PG8_BAR; PG8_MMA(0, 0, At, B0); PG8_MMA(0, 1, At, B1); PG8_BAR; PG8_SCHED;
            PG8_LDA(At, 1, 1); PG8_STAGE(PG8_SB(1, 0), b3, voffB); PG8_STAGE(PG8_SB(1, 1), b3 + hstepB, voffB); PG8_STAGE(PG8_SA(1, 0), a3, voffA);
            PG8_WAIT_V(8); PG8_WAIT_L(0); PG8_BAR; PG8_MMA(1, 0, At, B0); PG8_MMA(1, 1, At, B1); PG8_BAR; PG8_SCHED;
        }
        if (wr == 0) PG8_BAR;
        E.run(acc, cur, wr, wc, fr, fq);
        if (!has_next) break;
        if (cur.seg == g.nseg - 1) {
#pragma unroll
            for (int a = 0; a < 2; ++a)
#pragma unroll
                for (int b = 0; b < 2; ++b)
#pragma unroll
                    for (int m = 0; m < 4; ++m)
#pragma unroll
                        for (int n = 0; n < 2; ++n) acc[a][b][m][n] = (f32x4){0.f, 0.f, 0.f, 0.f};
        }
        cur = nxt; cA = nA; cB = nB; ++ui;
        if (wr == 1) PG8_BAR;
    }
    PG8_WAIT_V(0);
    PG8_BAR;
#undef KOF
#undef NTF
#undef PG8_SA
#undef PG8_SB
#undef PG8_STAGE
#undef PG8_LDA
#undef PG8_LDB
#undef PG8_MMA
#undef PG8_WAIT_V
#undef PG8_WAIT_L
#undef PG8_BAR
#undef PG8_SCHED
}
}

namespace att {
constexpr int D = 128, QBLK = 32, KVBLK = 64;
constexpr float SCALE = 0.088388347648318440f;
constexpr float THR = 8.f;
constexpr size_t SHM_V = KVBLK * D * 2, SHM_K = KVBLK * D * 2, SHM_ATTN = 2 * SHM_V + 2 * SHM_K + NW * 64 * 4;
#define KSWZ(row, colB) ((row) * 256 + ((colB) ^ (((row) & 7) << 4)))
#define SBAR() __builtin_amdgcn_sched_barrier(0)
__device__ __forceinline__ int crow(int r, int hi) { return (r & 3) + 8 * (r >> 2) + 4 * hi; }
__device__ __forceinline__ unsigned cvtpk(float lo, float hi) { unsigned r; asm volatile("v_cvt_pk_bf16_f32 %0, %1, %2" : "=v"(r) : "v"(lo), "v"(hi)); return r; }
__device__ __forceinline__ void partialSM(f32x16& p0, f32x16& p1, float& m_reg, float& mn, float& alpha) {
  constexpr float C = SCALE * 1.4426950408889634f;
  float pmax = p0[0];
#pragma unroll
  for (int r = 1; r < 16; ++r) pmax = fmaxf(pmax, p0[r]);
#pragma unroll
  for (int r = 0; r < 16; ++r) pmax = fmaxf(pmax, p1[r]);
  { auto rr = __builtin_amdgcn_permlane32_swap(__float_as_uint(pmax), __float_as_uint(pmax), false, false);
    pmax = fmaxf(__uint_as_float(rr[0]), __uint_as_float(rr[1])); }
  if (__builtin_expect(__all(pmax - m_reg <= THR / SCALE), 1)) { mn = m_reg; alpha = 1.f; }
  else { mn = fmaxf(m_reg, pmax); alpha = __builtin_amdgcn_exp2f((m_reg - mn) * C); m_reg = mn; }
  float mnC = -mn * C;
#pragma unroll
  for (int r = 0; r < 16; ++r) p0[r] = fmaf(p0[r], C, mnC);
#pragma unroll
  for (int r = 0; r < 16; ++r) p1[r] = fmaf(p1[r], C, mnC);
#pragma unroll
  for (int r = 0; r < 16; ++r) p0[r] = __builtin_amdgcn_exp2f(p0[r]);
}
__device__ __forceinline__ void finishSM(f32x16& p0, f32x16& p1, float alpha, float& l_reg, bf16x8& pa0, bf16x8& pa1, bf16x8& pa2, bf16x8& pa3) {
#pragma unroll
  for (int r = 0; r < 16; ++r) p1[r] = __builtin_amdgcn_exp2f(p1[r]);
  float ps = 0;
#pragma unroll
  for (int r = 0; r < 16; ++r) ps += p0[r];
#pragma unroll
  for (int r = 0; r < 16; ++r) ps += p1[r];
  { auto rr = __builtin_amdgcn_permlane32_swap(__float_as_uint(ps), __float_as_uint(ps), false, false);
    ps = __uint_as_float(rr[0]) + __uint_as_float(rr[1]); }
  l_reg = l_reg * alpha + ps;
#define PK4(P, BASE, OUT) do { unsigned a0 = cvtpk(P[BASE + 0], P[BASE + 1]), a1 = cvtpk(P[BASE + 2], P[BASE + 3]);   \
    unsigned b0 = cvtpk(P[BASE + 4], P[BASE + 5]), b1 = cvtpk(P[BASE + 6], P[BASE + 7]);                              \
    auto r0 = __builtin_amdgcn_permlane32_swap(a0, b0, false, false); auto r1 = __builtin_amdgcn_permlane32_swap(a1, b1, false, false); \
    u32x4 w = {r0[0], r1[0], r0[1], r1[1]}; OUT = *reinterpret_cast<bf16x8*>(&w); } while (0)
  PK4(p0, 0, pa0); PK4(p0, 8, pa1); PK4(p1, 0, pa2); PK4(p1, 8, pa3);
#undef PK4
}
__device__ __forceinline__ void qkt(f32x16& p0, f32x16& p1, const bf16_t* Ks, const bf16x8* qr, int r32, int hi) {
  p0 = f32x16{}; p1 = f32x16{};
#pragma unroll
  for (int d0 = 0; d0 < 8; ++d0) { int cb = (d0 * 16 + hi * 8) * 2;
    bf16x8 b0 = *reinterpret_cast<const bf16x8*>((const char*)Ks + KSWZ(r32, cb));
    bf16x8 b1 = *reinterpret_cast<const bf16x8*>((const char*)Ks + KSWZ(32 + r32, cb));
    p0 = __builtin_amdgcn_mfma_f32_32x32x16_bf16(b0, qr[d0], p0, 0, 0, 0);
    p1 = __builtin_amdgcn_mfma_f32_32x32x16_bf16(b1, qr[d0], p1, 0, 0, 0); }
}
__device__ __forceinline__ int v_st(int k, int c) { const int kk = (k & ~0xC) | ((k & 4) << 1) | ((k & 8) >> 1); return ((kk >> 3) * 4 + (c >> 5)) * 512 + ((kk & 7) * 32 + (c & 31)) * 2; }
__device__ __forceinline__ int v_rd_base(int lane) { return ((lane & 3) << 3) | (((lane >> 2) & 3) << 6) | (((lane >> 4) & 1) << 5) | (((lane >> 5) & 1) << 8); }
constexpr int v_rd_off(int d0, int ks, int half) { return d0 * 512 + ks * 4096 + half * 2048; }
template <int OFF> __device__ __forceinline__ s16x4 tr_read(int vb) {
  s16x4 r; asm volatile("ds_read_b64_tr_b16 %0, %1 offset:%2" : "=&v"(r) : "v"(vb), "i"(OFF) : "memory"); return r;
}
template <int D0> __device__ __forceinline__ void pv_one(f32x16& od, int vb, bf16x8 pa0, bf16x8 pa1, bf16x8 pa2, bf16x8 pa3) {
  const s16x4 l0 = tr_read<v_rd_off(D0, 0, 0)>(vb), h0 = tr_read<v_rd_off(D0, 0, 1)>(vb), l1 = tr_read<v_rd_off(D0, 1, 0)>(vb), h1 = tr_read<v_rd_off(D0, 1, 1)>(vb);
  const s16x4 l2 = tr_read<v_rd_off(D0, 2, 0)>(vb), h2 = tr_read<v_rd_off(D0, 2, 1)>(vb), l3 = tr_read<v_rd_off(D0, 3, 0)>(vb), h3 = tr_read<v_rd_off(D0, 3, 1)>(vb);
  asm volatile("s_waitcnt lgkmcnt(0)" ::: "memory"); SBAR();
#define PK(L, H) (bf16x8){L[0], L[1], L[2], L[3], H[0], H[1], H[2], H[3]}
  od = __builtin_amdgcn_mfma_f32_32x32x16_bf16(pa0, PK(l0, h0), od, 0, 0, 0);
  od = __builtin_amdgcn_mfma_f32_32x32x16_bf16(pa1, PK(l1, h1), od, 0, 0, 0);
  od = __builtin_amdgcn_mfma_f32_32x32x16_bf16(pa2, PK(l2, h2), od, 0, 0, 0);
  od = __builtin_amdgcn_mfma_f32_32x32x16_bf16(pa3, PK(l3, h3), od, 0, 0, 0);
#undef PK
}
__device__ __forceinline__ void pv_d0(f32x16* o, int vb, bf16x8 pa0, bf16x8 pa1, bf16x8 pa2, bf16x8 pa3) {
  pv_one<0>(o[0], vb, pa0, pa1, pa2, pa3); pv_one<1>(o[1], vb, pa0, pa1, pa2, pa3); pv_one<2>(o[2], vb, pa0, pa1, pa2, pa3); pv_one<3>(o[3], vb, pa0, pa1, pa2, pa3);
}
constexpr int LDQ = NPROJ, LDK = 256;
__device__ __forceinline__ void attn_dense_body(bf16_t* Qb, const bf16_t* __restrict__ Kh, const bf16_t* __restrict__ Vh, int seq, char* lds, const int tid, const bool STORE = true) {
  const int wid = tid >> 6, lane = tid & 63, r32 = lane & 31, hi = lane >> 5;
  bf16_t* V_lds = (bf16_t*)lds; bf16_t* K_lds = (bf16_t*)(lds + 2 * SHM_V);
  float* ws = (float*)(lds + 2 * SHM_V + 2 * SHM_K) + wid * 64; float* li_l = ws; float* al_l = ws + 32;
  float m_reg = -1e30f, l_reg = 0; f32x16 o[4] = {}; bf16x8 qr[8];
  const bf16_t* Qw = Qb + (long)(wid * QBLK + r32) * LDQ + hi * 8;
#pragma unroll
  for (int d0 = 0; d0 < 8; ++d0) qr[d0] = *reinterpret_cast<const bf16x8*>(Qw + d0 * 16);
  const int sr = tid >> 4, sc = (tid & 15) * 8, vst0 = v_st(sr, sc), vst1 = v_st(32 + sr, sc);
  const int vb0 = (int)(uintptr_t)V_lds + v_rd_base(lane);
  struct { bf16x8 vs0, vs1, ks0, ks1; } sr_[1];
#define LD8(p) (*reinterpret_cast<const bf16x8*>(p))
#define SLOAD(i, k0) do { sr_[i].vs0 = LD8(&Vh[(long)((k0) + sr) * LDK + sc]); sr_[i].vs1 = LD8(&Vh[(long)((k0) + 32 + sr) * LDK + sc]); \
    sr_[i].ks0 = LD8(&Kh[(long)((k0) + sr) * LDK + sc]); sr_[i].ks1 = LD8(&Kh[(long)((k0) + 32 + sr) * LDK + sc]); } while (0)
#define SWRITE(b, i) do { *(bf16x8*)((char*)V_lds + (b) * SHM_V + vst0) = sr_[i].vs0;          \
    *(bf16x8*)((char*)V_lds + (b) * SHM_V + vst1) = sr_[i].vs1; int kc = sc * 2;               \
    *(bf16x8*)((char*)K_lds + (b) * SHM_K + KSWZ(sr, kc)) = sr_[i].ks0;                       \
    *(bf16x8*)((char*)K_lds + (b) * SHM_K + KSWZ(32 + sr, kc)) = sr_[i].ks1; } while (0)
#define SWAIT() asm volatile("s_waitcnt vmcnt(0)" ::: "memory")
#define RESC(a) do { if (__any((a) < 1.f)) { if (hi == 0) al_l[r32] = (a); asm volatile("s_waitcnt lgkmcnt(0)" ::: "memory"); \
    _Pragma("unroll") for (int d = 0; d < 4; ++d) _Pragma("unroll") for (int r = 0; r < 16; ++r) o[d][r] *= al_l[crow(r, hi)]; } } while (0)
  f32x16 pA0, pA1, pB0, pB1; float mnA, mnB, alA, alB; bf16x8 pa0, pa1, pa2, pa3; const int NT = seq / KVBLK;
  constexpr int SE = 0, SO = 0;
  SLOAD(SE, 0); asm volatile("s_waitcnt vmcnt(0)" ::: "memory"); SWRITE(0, SE); __syncthreads();
  qkt(pA0, pA1, K_lds, qr, r32, hi); partialSM(pA0, pA1, m_reg, mnA, alA);
  SLOAD(SO, KVBLK);
  SWAIT(); SWRITE(1, SO); __syncthreads();
  for (int j = 1; j + 1 < NT; j += 2) {
    SBAR(); qkt(pB0, pB1, (bf16_t*)((char*)K_lds + SHM_K), qr, r32, hi);
    finishSM(pA0, pA1, alA, l_reg, pa0, pa1, pa2, pa3); SBAR();
    SLOAD(SO, (j + 1) * KVBLK); SBAR();
    pv_d0(o, vb0, pa0, pa1, pa2, pa3); partialSM(pB0, pB1, m_reg, mnB, alB);
    __syncthreads(); SWAIT(); SWRITE(0, SE);
    RESC(alB); __syncthreads();
    SBAR(); qkt(pA0, pA1, K_lds, qr, r32, hi);
    finishSM(pB0, pB1, alB, l_reg, pa0, pa1, pa2, pa3); SBAR();
    SLOAD(SE, (j + 2) * KVBLK); SBAR();
    pv_d0(o, vb0 + (int)SHM_V, pa0, pa1, pa2, pa3); partialSM(pA0, pA1, m_reg, mnA, alA);
    __syncthreads(); SWAIT(); SWRITE(1, SO);
    RESC(alA); __syncthreads();
  }
  SBAR(); qkt(pB0, pB1, (bf16_t*)((char*)K_lds + SHM_K), qr, r32, hi);
  finishSM(pA0, pA1, alA, l_reg, pa0, pa1, pa2, pa3); SBAR();
  pv_d0(o, vb0, pa0, pa1, pa2, pa3); partialSM(pB0, pB1, m_reg, mnB, alB);
  __syncthreads(); RESC(alB);
  finishSM(pB0, pB1, alB, l_reg, pa0, pa1, pa2, pa3); SBAR();
  pv_d0(o, vb0 + (int)SHM_V, pa0, pa1, pa2, pa3);
  if (hi == 0) li_l[r32] = l_reg; asm volatile("s_waitcnt lgkmcnt(0)" ::: "memory");
  float rli[16];
#pragma unroll
  for (int r = 0; r < 16; ++r) rli[r] = __builtin_amdgcn_rcpf(li_l[crow(r, hi)]);
  __syncthreads();
  { bf16_t* stg = (bf16_t*)lds + wid * 4096;
#pragma unroll
    for (int r = 0; r < 16; ++r) { const int orow = crow(r, hi);
#pragma unroll
      for (int d0 = 0; d0 < 4; ++d0) stg[orow * 128 + d0 * 32 + r32] = (bf16_t)(cvtpk(o[d0][r] * rli[r], 0.f) & 0xffffu); }
    asm volatile("s_waitcnt lgkmcnt(0)" ::: "memory");
    bf16_t* Ow = Qb + (long)(wid * QBLK + (lane >> 4)) * LDQ + (lane & 15) * 8;
#pragma unroll
    for (int i = 0; i < 8; ++i) { const u32x4 v = *(const u32x4*)(stg + (i * 4 + (lane >> 4)) * 128 + (lane & 15) * 8); if (STORE) *(u32x4*)(Ow + (long)i * 4 * LDQ) = v; else asm volatile("" :: "v"(v)); }
  }
  __syncthreads();
#undef LD8
#undef SLOAD
#undef SWRITE
#undef SWAIT
#undef RESC
}
#undef KSWZ
#undef SBAR
}


#define XB_TMO      128
#define XB_XCNT(j)  (256  + 64 * (j))
#define XB_XSUB(j)  (1280 + 64 * (j))
#define XB_XGEN(j)  (2304 + 64 * (j))
#define XB_TOP      3328
#define XB_TOPGEN   3392
#define XCD_BAR_WORDS 3456
#define XB_SPIN_CAP (1u << 18)
__device__ __forceinline__ unsigned xb_ld(unsigned* p)              { return __hip_atomic_load(p, __ATOMIC_RELAXED, __HIP_MEMORY_SCOPE_AGENT); }
__device__ __forceinline__ unsigned xb_add(unsigned* p, unsigned v) { return __hip_atomic_fetch_add(p, v, __ATOMIC_RELAXED, __HIP_MEMORY_SCOPE_AGENT); }
__device__ __forceinline__ unsigned xb_xcc_id() { return (unsigned)__builtin_amdgcn_s_getreg((3 << 11) | 20) & 0xFu; }
#define XB_SPIN(cond, bar) do { unsigned _sp = 0; while (cond) { __builtin_amdgcn_s_sleep(1); \
    if ((++_sp & 255u) == 0u) { if (xb_ld(&(bar)[XB_TMO])) break; if (_sp > XB_SPIN_CAP) { atomicAdd(&(bar)[XB_TMO], 1u); break; } } } } while (0)
struct XcdBarrier { unsigned* bar; unsigned x; volatile LAS unsigned* st; };
__device__ __forceinline__ XcdBarrier xcd_barrier_post(unsigned* bar, volatile LAS unsigned* st) {
    XcdBarrier b; b.bar = bar; b.x = xb_xcc_id(); b.st = st;
    if (threadIdx.x == 0) (void)xb_add(&bar[XB_XCNT(b.x)], 1u);
    return b;
}
__device__ __forceinline__ void xcd_barrier_complete(unsigned* bar, unsigned x, unsigned& nloc, unsigned& nx) {
    const unsigned G = gridDim.x * gridDim.y * gridDim.z;
    unsigned sum, cnt, mine, sp = 0u;
    for (;;) {
        sum = 0u; cnt = 0u; mine = 0u;
#pragma unroll
        for (unsigned j = 0; j < 16; ++j) { const unsigned c = xb_ld(&bar[XB_XCNT(j)]); sum += c; cnt += (c > 0u) ? 1u : 0u; mine = (j == x) ? c : mine; }
        if (sum == G) break;
        __builtin_amdgcn_s_sleep(1);
        if ((++sp & 255u) == 0u) { if (xb_ld(&bar[XB_TMO])) break; if (sp > XB_SPIN_CAP) { atomicAdd(&bar[XB_TMO], 1u); break; } }
    }
    nloc = mine > 0u ? mine : 1u; nx = cnt > 0u ? cnt : 1u;
}
__device__ __forceinline__ void xcd_barrier(const XcdBarrier& b) {
    asm volatile("s_waitcnt vmcnt(0)" ::: "memory");
    __syncthreads();
    if (threadIdx.x == 0) {
        unsigned* bar = b.bar;
        __builtin_amdgcn_s_waitcnt(0);
        unsigned nloc = b.st[0], nx = b.st[1];
        if (nloc == 0u) { xcd_barrier_complete(bar, b.x, nloc, nx); b.st[0] = nloc; b.st[1] = nx; }
        const unsigned old = xb_add(&bar[XB_XSUB(b.x)], 1u);
        const unsigned gen = old / nloc;
        if (old + 1u == (gen + 1u) * nloc) {
            __builtin_amdgcn_fence(__ATOMIC_RELEASE, "agent");
            asm volatile("s_waitcnt vmcnt(0)" ::: "memory");
            const unsigned og = xb_add(&bar[XB_TOP], 1u);
            const unsigned tg = og / nx;
            if (og + 1u == (tg + 1u) * nx) xb_add(&bar[XB_TOPGEN], 1u);
            else XB_SPIN(xb_ld(&bar[XB_TOPGEN]) == tg, bar);
            __builtin_amdgcn_fence(__ATOMIC_ACQUIRE, "agent");
            xb_add(&bar[XB_XGEN(b.x)], 1u);
            asm volatile("s_waitcnt vmcnt(0)" ::: "memory");
        } else {
            XB_SPIN(xb_ld(&bar[XB_XGEN(b.x)]) == gen, bar);
            __builtin_amdgcn_fence(__ATOMIC_ACQUIRE, "agent");
            asm volatile("s_waitcnt vmcnt(0)" ::: "memory");
        }
    }
    __syncthreads();
}

struct Args { const float* in[25]; float* out; unsigned char* ws; int ph_lo, ph_hi; };

struct Frame {
    LAS unsigned char* lds; char* ldsg;
    int tid, lane, wave, G, bx, gw, NGW;
    const float* const* in;
    unsigned char* ws; float* out;
};
enum { I_XP = 0, I_XS, I_CK, I_CV, I_C, I_CCTX, I_WADA, I_BADA, I_WIN, I_QG, I_KG, I_WPG, I_PSC, I_WSGU, I_BSGU, I_WAO, I_WPO, I_WSO, I_WOUT, I_LN1G, I_LN1B, I_WF1, I_WF2, I_LN2G, I_LN2B };

__device__ __forceinline__ void tr_item(const float* W, int ldw, int src_col, int kb, bf16_t* WT, int ldt, int dst_row, int dst_k, LAS float* scr, int lane) {
    const int k0 = 64 * kb;
#pragma unroll 8
    for (int i = 0; i < 32; ++i) { const int kk = 2 * i + (lane >> 5); scr[kk * 33 + (lane & 31)] = W[(size_t)(k0 + kk) * ldw + src_col + (lane & 31)]; }
    asm volatile("s_waitcnt lgkmcnt(0)" ::: "memory");
    const int c = lane & 7;
#pragma unroll
    for (int j = 0; j < 4; ++j) { const int n = (lane >> 3) + 8 * j; const LAS float* s = scr + (8 * c) * 33 + n;
        u32x4 o; o.x = cvt_pk_bf16(s[0 * 33], s[1 * 33]); o.y = cvt_pk_bf16(s[2 * 33], s[3 * 33]); o.z = cvt_pk_bf16(s[4 * 33], s[5 * 33]); o.w = cvt_pk_bf16(s[6 * 33], s[7 * 33]);
        *(u32x4*)(WT + (size_t)(dst_row + n) * ldt + dst_k + k0 + 8 * c) = o; }
    asm volatile("s_waitcnt lgkmcnt(0)" ::: "memory");
}

__device__ __forceinline__ int win_src_col(int d) {
    if (d < 1024) return d;
    if (d < 1536) return 2048 + (d - 1024);
    if (d < 2048) return 1024 + (d - 1536);
    if (d < 2560) return 2560 + (d - 2048);
    if (d < 3072) return 1536 + (d - 2560);
    return d;
}

__device__ __forceinline__ void phase_prologue(Frame& F) {
    if (F.bx < 192) {
        const int l = F.bx / 96, nb = F.bx % 96;
        LAS float* sc = (LAS float*)F.lds;
        LAS float* red = (LAS float*)(F.lds + 9 * 1024 * 4);
        for (int idx = F.tid; idx < 9 * 1024; idx += 512) { const int v = idx >> 10, k = idx & 1023;
            const float x = v == 0 ? F.in[I_CCTX][k] : F.in[I_C][(v - 1) * 1024 + k]; sc[idx] = x / (1.0f + __expf(-x)); }
        __syncthreads();
        float acc[9];
#pragma unroll
        for (int v = 0; v < 9; ++v) acc[v] = 0.f;
        const float* wp = F.in[I_WADA] + ((size_t)l * 1024 + F.wave * 128) * 6144 + nb * 64 + F.lane;
#pragma unroll 8
        for (int k = 0; k < 128; ++k) { const float w = wp[(size_t)k * 6144];
#pragma unroll
            for (int v = 0; v < 9; ++v) acc[v] += sc[v * 1024 + F.wave * 128 + k] * w; }
#pragma unroll
        for (int v = 0; v < 9; ++v) red[(F.wave * 9 + v) * 64 + F.lane] = acc[v];
        __syncthreads();
        float* mod = (float*)(F.ws + WS_MOD);
        for (int idx = F.tid; idx < 576; idx += 512) { const int v = idx >> 6, ln = idx & 63; float s = 0.f;
#pragma unroll
            for (int w = 0; w < 8; ++w) s += red[(w * 9 + v) * 64 + ln];
            mod[(l * 9 + v) * 6144 + nb * 64 + ln] = s + F.in[I_BADA][l * 6144 + nb * 64 + ln]; }
        __syncthreads();
    }
    LAS float* scr = (LAS float*)(F.lds + F.wave * 8448);
    constexpr int N_WIN = 16 * 192, N_AO = 16 * 32, N_SO = 8 * 32, N_WO = 16 * 32, N_F1 = 16 * 176, N_F2 = 44 * 32, N_PE = 1024, N_WS = 128;
    constexpr int N_L = N_WIN + N_AO + N_SO + N_WO + N_F1 + N_F2 + N_PE + N_WS;
    constexpr int N_ALL = 2 * N_L + 32;
    for (int it = F.gw; it < N_ALL; it += F.NGW) {
        if (it >= 2 * N_L) {
            const int idx = (it - 2 * N_L) * 64 + F.lane; const int pos = idx >> 5, p = idx & 31;
            const float inv = powf(10000.0f, -(float)p / 32.0f); const float ang = (float)pos * inv;
            float* rope = (float*)(F.ws + WS_ROPE); rope[idx] = cosf(ang); rope[2048 + idx] = sinf(ang);
            continue;
        }
        const int l = it / N_L; int r = it % N_L;
        if (r < N_WIN) { const int kb = r / 192, nb = r % 192;
            tr_item(F.in[I_WIN] + (size_t)l * 1024 * 6144, 6144, win_src_col(nb * 32), kb, (bf16_t*)(F.ws + WS_WIN) + (size_t)l * 6144 * 1024, 1024, nb * 32, 0, scr, F.lane); continue; } r -= N_WIN;
        if (r < N_AO) { const int kb = r / 32, nb = r % 32;
            tr_item(F.in[I_WAO] + (size_t)l * 1024 * 1024, 1024, nb * 32, kb, (bf16_t*)(F.ws + WS_WM) + (size_t)l * 1024 * 2048, 2048, nb * 32, 0, scr, F.lane); continue; } r -= N_AO;
        if (r < N_SO) { const int kb = r / 32, nb = r % 32;
            tr_item(F.in[I_WSO] + (size_t)l * 512 * 1024, 1024, nb * 32, kb, (bf16_t*)(F.ws + WS_WM) + (size_t)l * 1024 * 2048, 2048, nb * 32, 1024, scr, F.lane); continue; } r -= N_SO;
        if (r < N_WO) { const int kb = r / 32, nb = r % 32;
            tr_item(F.in[I_WOUT] + (size_t)l * 1024 * 1024, 1024, nb * 32, kb, (bf16_t*)(F.ws + WS_WOUT) + (size_t)l * 1024 * 1024, 1024, nb * 32, 0, scr, F.lane); continue; } r -= N_WO;
        if (r < N_F1) { const int kb = r / 176, nb = r % 176; const int drow = nb * 32; const int pn = drow >> 8, j = drow & 255;
            const int src = j < 128 ? pn * 128 + j : DFF + pn * 128 + (j - 128);
            tr_item(F.in[I_WF1] + (size_t)l * 1024 * 5632, 5632, src, kb, (bf16_t*)(F.ws + WS_WF1) + (size_t)l * 5632 * 1024, 1024, drow, 0, scr, F.lane); continue; } r -= N_F1;
        if (r < N_F2) { const int kb = r / 32, nb = r % 32;
            tr_item(F.in[I_WF2] + (size_t)l * DFF * 1024, 1024, nb * 32, kb, (bf16_t*)(F.ws + WS_WF2) + (size_t)l * 1024 * DFF, DFF, nb * 32, 0, scr, F.lane); continue; } r -= N_F2;
        if (r < N_PE) {
            const int kg = r >> 4, nb = r & 15; const int k0 = kg * 8, g = k0 >> 7; const int n = nb * 64 + F.lane;
            const float* wpg = F.in[I_WPG] + ((size_t)(l * 4 + g) * 128 + (k0 & 127)) * 128;
            const float* psc = F.in[I_PSC] + l * 512 + g * 128;
            const float* wpo = F.in[I_WPO] + ((size_t)l * 512 + g * 128) * 1024 + n;
            float a[8];
#pragma unroll
            for (int i = 0; i < 8; ++i) a[i] = 0.f;
#pragma unroll 4
            for (int j = 0; j < 128; ++j) { const float w = wpo[(size_t)j * 1024] * psc[j];
#pragma unroll
                for (int i = 0; i < 8; ++i) a[i] += wpg[i * 128 + j] * w; }
            u32x4 o; o.x = cvt_pk_bf16(a[0], a[1]); o.y = cvt_pk_bf16(a[2], a[3]); o.z = cvt_pk_bf16(a[4], a[5]); o.w = cvt_pk_bf16(a[6], a[7]);
            *(u32x4*)((bf16_t*)(F.ws + WS_WM) + (size_t)l * 1024 * 2048 + (size_t)n * 2048 + 1536 + k0) = o;
            continue; } r -= N_PE;
        {
            const size_t e0 = (size_t)l * 65536 + (size_t)r * 512 + F.lane * 8;
            const f32x4 a = *(const f32x4*)(F.in[I_WSGU] + e0), b = *(const f32x4*)(F.in[I_WSGU] + e0 + 4);
            u32x4 o; o.x = cvt_pk_bf16(a[0], a[1]); o.y = cvt_pk_bf16(a[2], a[3]); o.z = cvt_pk_bf16(b[0], b[1]); o.w = cvt_pk_bf16(b[2], b[3]);
            *(u32x4*)((bf16_t*)(F.ws + WS_WSGU) + e0) = o;
        }
    }
}

__device__ __forceinline__ const float* x0_row(Frame& F, int t) { return t < T_CTX ? F.in[I_XP] + (size_t)t * DM : F.in[I_XS] + (size_t)(t - T_CTX) * DM; }
__device__ __forceinline__ int vec_of_row(int t) { return t < T_CTX ? 0 : 1 + ((t - T_CTX) >> 12); }

__device__ __forceinline__ void phase_h0(Frame& F) {
    const float* mod = (const float*)(F.ws + WS_MOD);
    bf16_t* act = (bf16_t*)(F.ws + WS_ACT);
    for (int t = F.gw; t < T_ALL; t += F.NGW) {
        const f32x4* xr = (const f32x4*)x0_row(F, t) + F.lane;
        const float* mv = mod + vec_of_row(t) * 6144;
        unsigned long long* o8 = (unsigned long long*)(act + (size_t)t * DM) + F.lane;
#pragma unroll
        for (int j = 0; j < 4; ++j) { const f32x4 x = xr[64 * j]; const int c = 256 * j + 4 * F.lane;
            const f32x4 sh = *(const f32x4*)(mv + c), sc = *(const f32x4*)(mv + 1024 + c);
            const f32x4 h = x * (sc + 1.0f) + sh;
            o8[64 * j] = (unsigned long long)cvt_pk_bf16(h[0], h[1]) | ((unsigned long long)cvt_pk_bf16(h[2], h[3]) << 32); }
    }
}

__device__ __forceinline__ void phase_ln(Frame& F, const float* lg, const float* lb, const float* modl  , int sh_off, int sc_off) {
    float* X = F.out; bf16_t* act = (bf16_t*)(F.ws + WS_ACT);
    for (int t = F.gw; t < T_ALL; t += F.NGW) {
        f32x4* xr = (f32x4*)(X + (size_t)t * DM) + F.lane;
        f32x4 v[4]; float s = 0.f;
#pragma unroll
        for (int j = 0; j < 4; ++j) { v[j] = xr[64 * j]; s += (v[j][0] + v[j][1]) + (v[j][2] + v[j][3]); }
        const float mean = wave_sum(s) * (1.f / DM); float s2 = 0.f;
#pragma unroll
        for (int j = 0; j < 4; ++j) { v[j] = v[j] - mean; s2 += (v[j][0] * v[j][0] + v[j][1] * v[j][1]) + (v[j][2] * v[j][2] + v[j][3] * v[j][3]); }
        const float rstd = rsqrtf(wave_sum(s2) * (1.f / DM) + LN_EPS);
        const float* mv = modl ? modl + vec_of_row(t) * 6144 : nullptr;
        unsigned long long* o8 = (unsigned long long*)(act + (size_t)t * DM) + F.lane;
#pragma unroll
        for (int j = 0; j < 4; ++j) { const int c = 256 * j + 4 * F.lane;
            const f32x4 g = *(const f32x4*)(lg + c), b = *(const f32x4*)(lb + c);
            const f32x4 y = v[j] * rstd * g + b; xr[64 * j] = y;
            if (mv) { const f32x4 sh = *(const f32x4*)(mv + sh_off + c), sc = *(const f32x4*)(mv + sc_off + c);
                const f32x4 h = y * (sc + 1.0f) + sh;
                o8[64 * j] = (unsigned long long)cvt_pk_bf16(h[0], h[1]) | ((unsigned long long)cvt_pk_bf16(h[2], h[3]) << 32); } }
    }
}

__device__ __forceinline__ void load16h(const bf16_t* p, int j, float (&x)[16]) {
#pragma unroll
    for (int a = 0; a < 2; ++a)
#pragma unroll
        for (int hf = 0; hf < 2; ++hf) { const u32x2 w = *(const u32x2*)(p + a * 64 + hf * 32 + 4 * j);
            x[(a * 2 + hf) * 4 + 0] = bf_lo(w.x); x[(a * 2 + hf) * 4 + 1] = bf_hi(w.x); x[(a * 2 + hf) * 4 + 2] = bf_lo(w.y); x[(a * 2 + hf) * 4 + 3] = bf_hi(w.y); }
}
__device__ __forceinline__ void rmsn(float (&x)[16], const float (&g)[16]) {
    float ss = 0.f;
#pragma unroll
    for (int i = 0; i < 16; ++i) ss += x[i] * x[i];
    ss += __shfl_xor(ss, 1); ss += __shfl_xor(ss, 2); ss += __shfl_xor(ss, 4);
    const float rinv = rsqrtf(ss * (1.0f / 128.0f) + LN_EPS);
#pragma unroll
    for (int i = 0; i < 16; ++i) x[i] = x[i] * rinv * g[i];
}
__device__ __forceinline__ void rope16(float (&x)[16], const float* rope, int rowpos, int colpos, int j) {
#pragma unroll
    for (int a = 0; a < 2; ++a) { const int pos = a == 0 ? rowpos : colpos;
        const f32x4 c = *(const f32x4*)(rope + pos * 32 + 4 * j), s = *(const f32x4*)(rope + 2048 + pos * 32 + 4 * j);
#pragma unroll
        for (int e = 0; e < 4; ++e) { const float x1 = x[(a * 2) * 4 + e], x2 = x[(a * 2 + 1) * 4 + e];
            x[(a * 2) * 4 + e] = x1 * c[e] - x2 * s[e]; x[(a * 2 + 1) * 4 + e] = x2 * c[e] + x1 * s[e]; } }
}
__device__ __forceinline__ void store16h(bf16_t* p, int j, const float (&x)[16]) {
#pragma unroll
    for (int a = 0; a < 2; ++a)
#pragma unroll
        for (int hf = 0; hf < 2; ++hf) { u32x2 w; w.x = cvt_pk_bf16(x[(a * 2 + hf) * 4 + 0], x[(a * 2 + hf) * 4 + 1]); w.y = cvt_pk_bf16(x[(a * 2 + hf) * 4 + 2], x[(a * 2 + hf) * 4 + 3]);
            *(u32x2*)(p + a * 64 + hf * 32 + 4 * j) = w; }
}

__device__ __forceinline__ void phase_mid(Frame& F, int l, int part) {
    bf16_t* proj = (bf16_t*)(F.ws + WS_PROJ);
    const float* rope = (const float*)(F.ws + WS_ROPE);
    bf16_t* vrt = (bf16_t*)(F.ws + WS_VRT);
    bf16_t* KL = (bf16_t*)(F.ws + WS_KL); bf16_t* VL = (bf16_t*)(F.ws + WS_VL); bf16_t* KC = (bf16_t*)(F.ws + WS_KC); bf16_t* VC = (bf16_t*)(F.ws + WS_VC);
    float* outk = F.out + (size_t)T_ALL * DM; float* outv = outk + (size_t)16 * 2 * 256 * 256;
    const int lane = F.lane, hj = lane & 7;
    const int n8 = part_rows(part) / 8, ncache = 4 * PAST;
    float qg[16], kg[16];
#pragma unroll
    for (int a = 0; a < 2; ++a)
#pragma unroll
        for (int hf = 0; hf < 2; ++hf)
#pragma unroll
            for (int e = 0; e < 4; ++e) { const int d = a * 64 + hf * 32 + 4 * hj + e; qg[(a * 2 + hf) * 4 + e] = F.in[I_QG][l * 128 + d]; kg[(a * 2 + hf) * 4 + e] = F.in[I_KG][l * 128 + d]; }
    for (int it = F.gw; it < n8 + ncache; it += F.NGW) {
        if (it >= n8) {
            const int cr = it - n8; const int bl = cr >> 9, s = cr & 511; const int b = part * 4 + bl;
            const size_t src = (((size_t)b * 2 + l) * PAST + s) * 256 + lane * 4;
            const f32x4 kx = *(const f32x4*)(F.in[I_CK] + src), vx = *(const f32x4*)(F.in[I_CV] + src);
            const size_t dst = ((size_t)bl * SKV_LAT + s) * 256 + lane * 4;
            u32x2 kw, vw; kw.x = cvt_pk_bf16(kx[0], kx[1]); kw.y = cvt_pk_bf16(kx[2], kx[3]); vw.x = cvt_pk_bf16(vx[0], vx[1]); vw.y = cvt_pk_bf16(vx[2], vx[3]);
            *(u32x2*)(KL + dst) = kw; *(u32x2*)(VL + dst) = vw;
            continue;
        }
        const int lr0 = it * 8, t0 = part_row0(part) + lr0;
        const bool is_ctx = t0 < T_CTX;
        bf16_t* P0 = proj + (size_t)lr0 * NPROJ;
        {
            float val[8][8];
#pragma unroll
            for (int i = 0; i < 8; ++i) { const u32x4 w = *(const u32x4*)(P0 + (size_t)i * NPROJ + PC_XV + lane * 8);
#pragma unroll
                for (int e = 0; e < 4; ++e) { val[i][2 * e] = gelu1(bf_lo(w[e])); val[i][2 * e + 1] = gelu1(bf_hi(w[e])); } }
#pragma unroll
            for (int i = 0; i < 8; ++i) { float s = 0.f;
#pragma unroll
                for (int e = 0; e < 8; ++e) s += val[i][e];
                const float mean = wave_sum(s) * (1.0f / 512.0f); float s2 = 0.f;
#pragma unroll
                for (int e = 0; e < 8; ++e) { val[i][e] -= mean; s2 += val[i][e] * val[i][e]; }
                const float rstd = rsqrtf(wave_sum(s2) * (1.0f / 512.0f) + LN_EPS);
#pragma unroll
                for (int e = 0; e < 8; ++e) val[i][e] *= rstd; }
            const int chunk = lr0 >> 7, q0 = lr0 & 127;
            bf16_t* vb = vrt + ((size_t)chunk * 512 + lane * 8) * 128 + q0;
#pragma unroll
            for (int e = 0; e < 8; ++e) { u32x4 o; o.x = cvt_pk_bf16(val[0][e], val[1][e]); o.y = cvt_pk_bf16(val[2][e], val[3][e]); o.z = cvt_pk_bf16(val[4][e], val[5][e]); o.w = cvt_pk_bf16(val[6][e], val[7][e]);
                *(u32x4*)(vb + (size_t)e * 128) = o; }
        }
#pragma unroll 1
        for (int i = 0; i < 8; ++i) {
            bf16_t* Pr = P0 + (size_t)i * NPROJ; const int t = t0 + i;
            int spos, seqS, rowpos = 0, colpos = 0, bl = 0;
            if (is_ctx) { spos = t & 255; seqS = CTX_S; } else { const int tl = t - T_CTX; spos = tl & 4095; seqS = LAT_S; rowpos = spos >> 6; colpos = spos & 63; bl = (tl >> 12) - part * 4; }
            float x[16];
            load16h(Pr + PC_Q + (lane >> 3) * 128, hj, x); rmsn(x, qg); if (!is_ctx) rope16(x, rope, rowpos, colpos, hj);
            store16h(Pr + PC_Q + (lane >> 3) * 128, hj, x);
            const int kh = (lane >> 3) & 1;
            load16h(Pr + PC_K + kh * 128, hj, x); rmsn(x, kg);
            const int vi = (lane - 16) & 31;
            const u32x4 vw = *(const u32x4*)(Pr + PC_V + vi * 8);
            float pacc[8], pself[8];
            {
                const int hw = 1 << (lane >> 4);
                const int lo = max(spos - hw, 0), hi = min(spos + hw, seqS);
#pragma unroll
                for (int e = 0; e < 8; ++e) pacc[e] = 0.f;
                for (int dd = lo - spos; dd < hi - spos; ++dd) { const u32x4 w = *(const u32x4*)(Pr + (long)dd * NPROJ + PC_XP + lane * 8);
#pragma unroll
                    for (int e = 0; e < 4; ++e) { pacc[2 * e] += bf_lo(w[e]); pacc[2 * e + 1] += bf_hi(w[e]); } }
                const u32x4 w = *(const u32x4*)(Pr + PC_XP + lane * 8);
#pragma unroll
                for (int e = 0; e < 4; ++e) { pself[2 * e] = bf_lo(w[e]); pself[2 * e + 1] = bf_hi(w[e]); }
                const float rc = 1.0f / (float)(hi - lo);
#pragma unroll
                for (int e = 0; e < 8; ++e) pacc[e] = pacc[e] * rc - pself[e];
            }
            asm volatile("s_waitcnt vmcnt(0)" ::: "memory");
            if (is_ctx) {
                if (lane < 16) {
                    float* ok = outk + (((size_t)(t >> 8) * 2 + l) * 256 + (t & 255)) * 256 + kh * 128;
#pragma unroll
                    for (int a = 0; a < 2; ++a)
#pragma unroll
                        for (int hf = 0; hf < 2; ++hf) *(f32x4*)(ok + a * 64 + hf * 32 + 4 * hj) = (f32x4){x[(a * 2 + hf) * 4], x[(a * 2 + hf) * 4 + 1], x[(a * 2 + hf) * 4 + 2], x[(a * 2 + hf) * 4 + 3]};
                    store16h(KC + (size_t)t * 256 + kh * 128, hj, x);
                }
                if (lane >= 16 && lane < 48) {
                    float* ov = outv + (((size_t)(t >> 8) * 2 + l) * 256 + (t & 255)) * 256 + vi * 8;
                    *(f32x4*)ov = (f32x4){bf_lo(vw[0]), bf_hi(vw[0]), bf_lo(vw[1]), bf_hi(vw[1])};
                    *(f32x4*)(ov + 4) = (f32x4){bf_lo(vw[2]), bf_hi(vw[2]), bf_lo(vw[3]), bf_hi(vw[3])};
                    *(u32x4*)(VC + (size_t)t * 256 + vi * 8) = vw;
                }
            } else {
                rope16(x, rope, rowpos, colpos, hj);
                const size_t krow = ((size_t)bl * SKV_LAT + PAST + spos) * 256;
                if (lane < 16) store16h(KL + krow + kh * 128, hj, x);
                if (lane >= 16 && lane < 48) *(u32x4*)(VL + krow + vi * 8) = vw;
            }
            { u32x4 o; o.x = cvt_pk_bf16(pacc[0], pacc[1]); o.y = cvt_pk_bf16(pacc[2], pacc[3]); o.z = cvt_pk_bf16(pacc[4], pacc[5]); o.w = cvt_pk_bf16(pacc[6], pacc[7]);
              *(u32x4*)(Pr + PC_K + lane * 8) = o; }
        }
    }
}

__device__ __forceinline__ void phase_attn(Frame& F, int l, int part) {
    bf16_t* proj = (bf16_t*)(F.ws + WS_PROJ);
    const bf16_t* KL = (const bf16_t*)(F.ws + WS_KL); const bf16_t* VL = (const bf16_t*)(F.ws + WS_VL); const bf16_t* KC = (const bf16_t*)(F.ws + WS_KC); const bf16_t* VC = (const bf16_t*)(F.ws + WS_VC);
    const int lat_row0 = part == 0 ? T_CTX : 0;
    {
        int pair, idx, step; int rep = 0;
        const bool xcdmap = (F.G % 8) == 0;
        if (xcdmap) { pair = F.bx & 7; idx = F.bx >> 3; step = F.G >> 3; } else { pair = 0; idx = F.bx; step = F.G; }
        for (;;) {
            int pr = pair, ix = idx;
            if (!xcdmap) { pr = idx >> 6; ix = idx & 63; if (idx >= 512) break; } else if (idx >= 64) break;
            const int bl = pr >> 1, kvh = pr & 1, h = kvh * 4 + (ix >> 4), qb = ix & 15;
            bf16_t* Qb = proj + (size_t)(lat_row0 + bl * LAT_S + qb * 256) * NPROJ + PC_Q + h * 128;
            att::attn_dense_body(Qb, KL + (size_t)bl * SKV_LAT * 256 + kvh * 128, VL + (size_t)bl * SKV_LAT * 256 + kvh * 128, SKV_LAT, F.ldsg, F.tid, PROBE == 3 ? rep == 1 : true);
            if (PROBE == 3) { if (rep == 0) { rep = 1; continue; } rep = 0; }
            idx += step;
        }
    }
    if (part == 0) {
        for (int u = F.bx; u < 128; u += F.G) { const int b = u >> 3, h = u & 7;
            bf16_t* Qb = proj + (size_t)(b * 256) * NPROJ + PC_Q + h * 128;
            att::attn_dense_body(Qb, KC + (size_t)b * 256 * 256 + (h >> 2) * 128, VC + (size_t)b * 256 * 256 + (h >> 2) * 128, CTX_S, F.ldsg, F.tid); }
    }
    const bf16_t* vrt = (const bf16_t*)(F.ws + WS_VRT);
    const bf16_t* wsb = (const bf16_t*)(F.ws + WS_WSGU) + (size_t)l * 65536;
    const float* bs = F.in[I_BSGU] + l * 512;
    const int nitem = (part_rows(part) / 128) * 32;
    const int ln = F.lane & 15, quad = F.lane >> 4;
    for (int it = F.gw; it < nitem; it += F.NGW) {
        const int chunk = it >> 5, g = (it >> 3) & 3, cb = (it >> 1) & 3, pb = it & 1;
        f32x4 acc[2][4];
#pragma unroll
        for (int a = 0; a < 2; ++a)
#pragma unroll
            for (int b = 0; b < 4; ++b) acc[a][b] = (f32x4){0.f, 0.f, 0.f, 0.f};
        const bf16_t* ap = vrt + ((size_t)chunk * 512 + g * 128 + cb * 32 + ln) * 128 + quad * 8;
        const bf16_t* bp = wsb + ((size_t)g * 128 + pb * 64 + ln) * 128 + quad * 8;
#pragma unroll
        for (int ks = 0; ks < 4; ++ks) {
            bf16x8 af[2], bfr[4];
#pragma unroll
            for (int ct = 0; ct < 2; ++ct) af[ct] = *(const bf16x8*)(ap + ct * 16 * 128 + ks * 32);
#pragma unroll
            for (int pt = 0; pt < 4; ++pt) bfr[pt] = *(const bf16x8*)(bp + pt * 16 * 128 + ks * 32);
#pragma unroll
            for (int ct = 0; ct < 2; ++ct)
#pragma unroll
                for (int pt = 0; pt < 4; ++pt) acc[ct][pt] = __builtin_amdgcn_mfma_f32_16x16x32_bf16(af[ct], bfr[pt], acc[ct][pt], 0, 0, 0);
        }
#pragma unroll
        for (int pt = 0; pt < 4; ++pt) { const int p = pb * 64 + pt * 16 + ln; const float bsv = bs[g * 128 + p];
#pragma unroll
            for (int ct = 0; ct < 2; ++ct) { const int c = g * 128 + cb * 32 + ct * 16 + quad * 4;
                bf16_t* up = proj + (size_t)(chunk * 128 + p) * NPROJ + PC_U + c;
                const u32x2 w = *(const u32x2*)up;
                const float u0 = gelu1(bf_lo(w.x)), u1 = gelu1(bf_hi(w.x)), u2 = gelu1(bf_lo(w.y)), u3 = gelu1(bf_hi(w.y));
                const f32x4 a = acc[ct][pt];
                u32x2 o; o.x = cvt_pk_bf16(u0 * (a[0] + bsv), u1 * (a[1] + bsv)); o.y = cvt_pk_bf16(u2 * (a[2] + bsv), u3 * (a[3] + bsv));
                *(u32x2*)up = o; } }
    }
}

constexpr int NPL = 13, NPHASE = 2 + DEPTH * NPL;
__global__ void __launch_bounds__(NW * 64, 2) fwd_kernel(Args args) {
    extern __shared__ __attribute__((aligned(16))) unsigned char lds[];
    Frame F;
    F.lds = (LAS unsigned char*)lds; F.ldsg = (char*)lds;
    F.G = gridDim.x; F.bx = blockIdx.x; F.NGW = F.G * NW;
    F.in = args.in; F.ws = args.ws; F.out = args.out;
    const float* mod = (const float*)(F.ws + WS_MOD);
    bf16_t* act = (bf16_t*)(F.ws + WS_ACT); bf16_t* proj = (bf16_t*)(F.ws + WS_PROJ);

    volatile LAS unsigned* bst = (volatile LAS unsigned*)(F.lds + 131072 + 64);
    if (threadIdx.x < 2) bst[threadIdx.x] = 0u;
    unsigned* barw = (unsigned*)(F.ws + WS_BAR);
    if (blockIdx.x == 0 && args.ph_lo == 0) for (int i = threadIdx.x; i < XCD_BAR_WORDS; i += NW * 64) barw[i] = 0u;
    __syncthreads();
    XcdBarrier xbar; xbar.bar = barw; xbar.x = 0; xbar.st = bst;
    for (int ph = args.ph_lo; ph < args.ph_hi; ++ph) {
        { int tidv = threadIdx.x; asm volatile("" : "+v"(tidv));
          F.tid = tidv; F.lane = tidv & 63; F.wave = __builtin_amdgcn_readfirstlane(tidv >> 6); F.gw = F.bx * NW + F.wave; }
#ifndef PHMASK
#define PHMASK 0xffff
#endif
        if (ph == 0) { if (PHMASK & 1) phase_prologue(F); }
        else if (ph == 1) { if (PHMASK & 2) phase_h0(F); }
        else {
            const int l = (ph - 2) / NPL, s = (ph - 2) % NPL;
            if (s < 8) {
                const int part = s >> 2, q = s & 3;
                if (q == 0) { if (PHMASK & 4) {
                    pg8::Gemm g{}; g.A = act + (size_t)part_row0(part) * DM; g.Bt = (const bf16_t*)(F.ws + WS_WIN) + (size_t)l * NPROJ * DM; g.lda = DM; g.ldb = DM;
                    g.nM = part_rows(part) / 256; g.nN = NPROJ / 256; g.nseg = 1; g.k0[0] = 0; g.nt[0] = 16; g.k0[1] = 0; g.nt[1] = 16; g.k0[2] = 0; g.nt[2] = 16;
                    pg8::Order S; S.init(g.nM, g.nN, 1, F.G, F.bx);
                    pg8::EpiStore E{proj, NPROJ};
                    if (PROBE == 2) { pg8::EpiNone E0; pg8::gemm_phase<pg8::EpiNone>(F.lds, g, S, E0, F.tid); }
                    pg8::gemm_phase<pg8::EpiStore>(F.lds, g, S, E, F.tid); }
                } else if (q == 1) { if (PHMASK & 8) phase_mid(F, l, part); }
                else if (q == 2) { if (PHMASK & 16) phase_attn(F, l, part); }
                else if (PHMASK & 32) {
                    pg8::Gemm g{}; g.A = proj; g.Bt = (const bf16_t*)(F.ws + WS_WM) + (size_t)l * DM * 2048; g.lda = NPROJ; g.ldb = 2048;
                    g.nM = part_rows(part) / 256; g.nN = 4; g.nseg = 3; g.k0[0] = 0; g.nt[0] = 16; g.k0[1] = 1024; g.nt[1] = 8; g.k0[2] = 1536; g.nt[2] = 8;
                    pg8::Order S; S.init(g.nM, g.nN, 3, F.G, F.bx);
                    pg8::EpiGate E{proj, act + (size_t)part_row0(part) * DM, DM};
                    if (PROBE == 2) { pg8::EpiNone E0; pg8::gemm_phase<pg8::EpiNone>(F.lds, g, S, E0, F.tid); }
                    pg8::gemm_phase<pg8::EpiGate>(F.lds, g, S, E, F.tid);
                }
            } else if (s == 8) { if (PHMASK & 64) {
                pg8::Gemm g{}; g.A = act; g.Bt = (const bf16_t*)(F.ws + WS_WOUT) + (size_t)l * DM * DM; g.lda = DM; g.ldb = DM;
                g.nM = T_ALL / 256; g.nN = 4; g.nseg = 1; g.k0[0] = 0; g.nt[0] = 16; g.k0[1] = 0; g.nt[1] = 16; g.k0[2] = 0; g.nt[2] = 16;
                pg8::Order S; S.init(g.nM, g.nN, 1, F.G, F.bx);
                pg8::EpiResid E{l == 0 ? F.in[I_XP] : F.out, l == 0 ? F.in[I_XS] : F.out + (size_t)T_CTX * DM, F.out, mod + l * 9 * 6144, 2048};
                if (PROBE == 2) { pg8::EpiNone E0; pg8::gemm_phase<pg8::EpiNone>(F.lds, g, S, E0, F.tid); }
                    pg8::gemm_phase<pg8::EpiResid>(F.lds, g, S, E, F.tid); }
            } else if (s == 9) {
                if (PHMASK & 128) phase_ln(F, F.in[I_LN1G] + l * DM, F.in[I_LN1B] + l * DM, mod + l * 9 * 6144, 3072, 4096);
            } else if (s == 10) { if (PHMASK & 256) {
                pg8::Gemm g{}; g.A = act; g.Bt = (const bf16_t*)(F.ws + WS_WF1) + (size_t)l * 2 * DFF * DM; g.lda = DM; g.ldb = DM;
                g.nM = T_ALL / 256; g.nN = 2 * DFF / 256; g.nseg = 1; g.k0[0] = 0; g.nt[0] = 16; g.k0[1] = 0; g.nt[1] = 16; g.k0[2] = 0; g.nt[2] = 16;
                pg8::Order S; S.init(g.nM, g.nN, 1, F.G, F.bx);
                pg8::EpiSwiGLU E{proj, DFF};
                if (PROBE == 2) { pg8::EpiNone E0; pg8::gemm_phase<pg8::EpiNone>(F.lds, g, S, E0, F.tid); }
                    pg8::gemm_phase<pg8::EpiSwiGLU>(F.lds, g, S, E, F.tid); }
            } else if (s == 11) { if (PHMASK & 512) {
                pg8::Gemm g{}; g.A = proj; g.Bt = (const bf16_t*)(F.ws + WS_WF2) + (size_t)l * DM * DFF; g.lda = DFF; g.ldb = DFF;
                g.nM = T_ALL / 256; g.nN = 4; g.nseg = 1; g.k0[0] = 0; g.nt[0] = 44; g.k0[1] = 0; g.nt[1] = 44; g.k0[2] = 0; g.nt[2] = 44;
                pg8::Order S; S.init(g.nM, g.nN, 1, F.G, F.bx);
                pg8::EpiResid E{F.out, F.out + (size_t)T_CTX * DM, F.out, mod + l * 9 * 6144, 5120};
                if (PROBE == 2) { pg8::EpiNone E0; pg8::gemm_phase<pg8::EpiNone>(F.lds, g, S, E0, F.tid); }
                    pg8::gemm_phase<pg8::EpiResid>(F.lds, g, S, E, F.tid); }
            } else if (PHMASK & 1024) {
                phase_ln(F, F.in[I_LN2G] + l * DM, F.in[I_LN2B] + l * DM, l + 1 < DEPTH ? mod + (l + 1) * 9 * 6144 : nullptr, 0, 1024);
            }
        }
        if (ph + 1 < args.ph_hi) {
            if (ph == args.ph_lo) { cg::this_grid().sync(); xbar = xcd_barrier_post(barw, bst); }
            else xcd_barrier(xbar);
            if (PROBE == 1 && ph == 1) { for (int k = 0; k < 20; ++k) xcd_barrier(xbar); }
        }
    }
}

extern "C" void kernel_launch(void* const* d_in, const int* in_sizes, int n_in, void* d_out, int out_size, void* d_ws, size_t ws_size, hipStream_t stream) {
    static int grid = 0;
    if (grid == 0) {
        if (n_in != 25 || ws_size < WS_END) { fprintf(stderr, "kernel_launch: unexpected n_in %d / ws %zu\n", n_in, ws_size); grid = -1; return; }
        int dev = 0, cus = 0, per_cu = 0;
        if (hipGetDevice(&dev) != hipSuccess || hipDeviceGetAttribute(&cus, hipDeviceAttributeMultiprocessorCount, dev) != hipSuccess) { grid = -1; return; }
        if (hipFuncSetAttribute((const void*)fwd_kernel, hipFuncAttributeMaxDynamicSharedMemorySize, LDS_BYTES) != hipSuccess) { fprintf(stderr, "kernel_launch: hipFuncSetAttribute failed\n"); grid = -1; return; }
        if (hipOccupancyMaxActiveBlocksPerMultiprocessor(&per_cu, (const void*)fwd_kernel, NW * 64, LDS_BYTES) != hipSuccess || per_cu < 1) per_cu = 1;
        (void)hipGetLastError();
        grid = cus * (per_cu > 1 ? 1 : per_cu);
    }
    if (grid < 0) return;
    Args a{};
    for (int i = 0; i < 25; ++i) a.in[i] = (const float*)d_in[i];
    a.out = (float*)d_out; a.ws = (unsigned char*)d_ws;
#if MK_MULTI
    for (int ph = 0; ph < NPHASE; ++ph) { a.ph_lo = ph; a.ph_hi = ph + 1; hipLaunchKernelGGL(fwd_kernel, dim3(grid), dim3(NW * 64), LDS_BYTES, stream, a); }
#else
    a.ph_lo = 0; a.ph_hi = NPHASE;
    void* kargs[] = {&a};
    hipError_t e = hipLaunchCooperativeKernel((const void*)fwd_kernel, dim3(grid), dim3(NW * 64), kargs, LDS_BYTES, stream);
    if (e != hipSuccess) fprintf(stderr, "cooperative launch failed: %s (grid %d)\n", hipGetErrorString(e), grid);
#endif
}
```

```cpp
#include <hip/hip_runtime.h>
#include <hip/hip_bf16.h>
#include <hip/hip_cooperative_groups.h>
#include <cstdio>
#include <cstdint>
namespace cg = cooperative_groups;

#ifndef PROBE
#define PROBE 0
#endif
#ifndef MK_MULTI
#define MK_MULTI 0
#endif

#define LAS __attribute__((address_space(3)))
typedef unsigned short bf16_t;
typedef short bf16x8 __attribute__((ext_vector_type(8)));
typedef short s16x4 __attribute__((ext_vector_type(4)));
typedef float f32x2 __attribute__((ext_vector_type(2)));
typedef float f32x4 __attribute__((ext_vector_type(4)));
typedef float f32x16 __attribute__((ext_vector_type(16)));
typedef unsigned u32x2 __attribute__((ext_vector_type(2)));
typedef unsigned u32x4 __attribute__((ext_vector_type(4)));

constexpr int DM = 1024, NPROJ = 6144, DFF = 2816, DEPTH = 2;
constexpr int T_CTX = 4096, T_ALL = 36864;
constexpr int CTX_S = 256, LAT_S = 4096, PAST = 512, SKV_LAT = 4608;
constexpr int PC_Q = 0, PC_U = 1024, PC_K = 1536, PC_V = 1792, PC_XV = 2048, PC_XP = 2560, PC_G = 3072;
constexpr float LN_EPS = 1e-6f;
constexpr float ALPHA = 1.41421356237309515f;
constexpr int NW = 8;
__host__ __device__ constexpr int part_row0(int p) { return p == 0 ? 0 : 20480; }
__host__ __device__ constexpr int part_rows(int p) { return p == 0 ? 20480 : 16384; }

constexpr size_t MiB = 1u << 20;
constexpr size_t WS_MOD = 0;
constexpr size_t WS_BAR = 448 * 1024;
constexpr size_t WS_ROPE = 512 * 1024;
constexpr size_t WS_WSGU = 768 * 1024;
constexpr size_t WS_WIN = 1 * MiB;
constexpr size_t WS_WM = 25 * MiB;
constexpr size_t WS_WOUT = 33 * MiB;
constexpr size_t WS_WF1 = 37 * MiB;
constexpr size_t WS_WF2 = 59 * MiB;
constexpr size_t WS_ACT = 70 * MiB;
constexpr size_t WS_PROJ = 142 * MiB;
constexpr size_t WS_KL = 382 * MiB, WS_VL = 391 * MiB;
constexpr size_t WS_KC = 400 * MiB, WS_VC = 402 * MiB;
constexpr size_t WS_VRT = 404 * MiB;
constexpr size_t WS_XBUF = 424 * MiB;
constexpr size_t WS_CNT = 426 * MiB;
constexpr int CNT_WORDS = 4 * 144 * 64;
constexpr size_t WS_END = 427 * MiB;

constexpr int LDS_BYTES = 143360;
constexpr int LDS_XCH = 131072 + 256;

__device__ __forceinline__ unsigned cvt_pk_bf16(float lo, float hi) { unsigned r; asm volatile("v_cvt_pk_bf16_f32 %0, %1, %2" : "=v"(r) : "v"(lo), "v"(hi)); return r; }
__device__ __forceinline__ float bf_lo(unsigned u) { return __uint_as_float(u << 16); }
__device__ __forceinline__ float bf_hi(unsigned u) { return __uint_as_float(u & 0xffff0000u); }
__device__ __forceinline__ float wave_sum(float v) {
#pragma unroll
    for (int o = 1; o < 64; o <<= 1) v += __shfl_xor(v, o);
    return v;
}
__device__ __forceinline__ float gelu1(float v) {
    const float av = fabsf(v), d = av * 0.2316418882f + 1.0f;
    const float t = __builtin_amdgcn_rcpf(d);
    float q = t * 0.5307027145f + (-0.7265760135f); q = q * t + 0.7107068705f; q = q * t + (-0.142248368f); q = q * t + 0.127414796f; q = q * t;
    const float e = __builtin_amdgcn_exp2f((v * v) * (-0.72134752044f));
    const float m = v * (q * e), r = v - m;
    return v < 0.f ? m : r;
}
__device__ __forceinline__ float sigmoidf_(float x) { return 1.0f / (1.0f + __expf(-x)); }

namespace pg8 {
constexpr int BM = 256, BK = 64, HALF = 128, HTB = HALF * BK * 2, STAGE_BYTES = 8 * HTB, NXCD = 8, WGM = 8;
__host__ __device__ __forceinline__ int lds_byte(int r, int c) { const int st = (r >> 4) * 2 + (c >> 5), rr = r & 15, cc = c & 31, ob = rr * 64 + cc * 2; return st * 1024 + (ob ^ (((ob >> 9) & 1) << 5)); }
__host__ __device__ __forceinline__ void stage_rc(int b, int& R, int& C) { const int st = b / 1024, sb = b % 1024, swz = sb ^ (((sb >> 9) & 1) << 5); R = (st >> 1) * 16 + swz / 64; C = (st & 1) * 32 + (swz % 64) / 2; }
__host__ __device__ __forceinline__ int perm32(int rho) { const int n = rho >> 4, i = rho & 15; return 8 * (i >> 2) + 4 * n + (i & 3); }

struct Unit { int pm, pn, seg; };
struct Gemm { const bf16_t* A; const bf16_t* Bt; int lda, ldb, nM, nN, nseg; int k0[3]; int nt[3]; };

struct Order {
    int nM, nN, nwg, G, c, nseg, team;
    __device__ void init(int nM_, int nN_, int nseg_, int G_, int c_, int team_ = 0) { nM = nM_; nN = nN_; nwg = nM * nN; G = G_; c = c_; nseg = nseg_; team = team_; }
    __device__ bool next(int i, Unit& u) const {
        if (team) {
            u.seg = 0; const int j = c >> 3; u.pn = j & 3; u.pm = i * (G >> 2) + (c & 7) * (G >> 5) + (j >> 2); return u.pm < nM;
        }
        const int ti = i / nseg; u.seg = i - ti * nseg;
        const long L = (long)ti * G + c; if (L >= nwg) return false;
        int wgid = (int)L; { const int q = nwg / NXCD, r = nwg % NXCD, xcd = wgid % NXCD, off = wgid / NXCD; wgid = (xcd < r ? xcd * (q + 1) : r * (q + 1) + (xcd - r) * q) + off; }
        const int nig = WGM * nN, gid = wgid / nig, fm = gid * WGM, gsz = (nM - fm) < WGM ? (nM - fm) : WGM;
        u.pm = fm + ((wgid % nig) % gsz); u.pn = (wgid % nig) / gsz; return true;
    }
};

struct EpiStore {
    static constexpr bool PERM = true;
    bf16_t* O; int ldc;
    __device__ __forceinline__ void run(f32x4 (&acc)[2][2][4][2], const Unit& u, int wr, int wc, int fr, int fq) const {
        const int row0 = u.pm * BM + wr * 64 + fr; const int col0 = u.pn * BM + wc * 32 + 8 * fq;
#pragma unroll
        for (int ai = 0; ai < 2; ++ai)
#pragma unroll
            for (int m = 0; m < 4; ++m) { bf16_t* rowp = O + (size_t)(row0 + ai * HALF + m * 16) * ldc + col0;
#pragma unroll
                for (int bj = 0; bj < 2; ++bj) { const f32x4 v0 = acc[ai][bj][m][0], v1 = acc[ai][bj][m][1];
                    u32x4 w; w.x = cvt_pk_bf16(v0[0], v0[1]); w.y = cvt_pk_bf16(v0[2], v0[3]); w.z = cvt_pk_bf16(v1[0], v1[1]); w.w = cvt_pk_bf16(v1[2], v1[3]);
                    *(u32x4*)(rowp + bj * HALF) = w; } }
    }
};
struct EpiSwiGLU {
    static constexpr bool PERM = true;
    bf16_t* O; int ldc;
    __device__ __forceinline__ void run(f32x4 (&acc)[2][2][4][2], const Unit& u, int wr, int wc, int fr, int fq) const {
        const int row0 = u.pm * BM + wr * 64 + fr; const int col0 = u.pn * HALF + wc * 32 + 8 * fq;
#pragma unroll
        for (int ai = 0; ai < 2; ++ai)
#pragma unroll
            for (int m = 0; m < 4; ++m) { bf16_t* rowp = O + (size_t)(row0 + ai * HALF + m * 16) * ldc + col0;
                float o[8];
#pragma unroll
                for (int n = 0; n < 2; ++n)
#pragma unroll
                    for (int e = 0; e < 4; ++e) { const float a = acc[ai][0][m][n][e], b = acc[ai][1][m][n][e]; o[n * 4 + e] = a * sigmoidf_(a) * b; }
                u32x4 w; w.x = cvt_pk_bf16(o[0], o[1]); w.y = cvt_pk_bf16(o[2], o[3]); w.z = cvt_pk_bf16(o[4], o[5]); w.w = cvt_pk_bf16(o[6], o[7]);
                *(u32x4*)rowp = w; }
    }
};
struct EpiResid {
    static constexpr bool PERM = false;
    const float* xres_ctx; const float* xres_lat;
    float* out; const float* mod; int goff;
    __device__ __forceinline__ void run(f32x4 (&acc)[2][2][4][2], const Unit& u, int wr, int wc, int fr, int fq) const {
        const int v = u.pm < 16 ? 0 : 1 + ((u.pm - 16) >> 4);
        const float* xb = u.pm < 16 ? xres_ctx + (size_t)u.pm * BM * DM : xres_lat + (size_t)(u.pm - 16) * BM * DM;
        float* ob = out + (size_t)u.pm * BM * DM;
        const int col0 = u.pn * BM + wc * 32 + 4 * fq;
        const float* gp = mod + v * 6144 + goff + col0;
        f32x4 gv[2][2];
#pragma unroll
        for (int bj = 0; bj < 2; ++bj)
#pragma unroll
            for (int n = 0; n < 2; ++n) gv[bj][n] = *(const f32x4*)(gp + bj * HALF + n * 16);
#pragma unroll
        for (int ai = 0; ai < 2; ++ai)
#pragma unroll
            for (int m = 0; m < 4; ++m) { const size_t off = (size_t)(ai * HALF + wr * 64 + m * 16 + fr) * DM + col0;
#pragma unroll
                for (int bj = 0; bj < 2; ++bj)
#pragma unroll
                    for (int n = 0; n < 2; ++n) { const f32x4 x = *(const f32x4*)(xb + off + bj * HALF + n * 16);
                        *(f32x4*)(ob + off + bj * HALF + n * 16) = x * ALPHA + gv[bj][n] * acc[ai][bj][m][n]; } }
    }
};

struct PanelStats {
    unsigned long long* xbuf;
    unsigned* cnt;
    LAS unsigned char* lx;
    __device__ __forceinline__ void run(const f32x4 (&v)[2][2][4][2], const Unit& u, int wr, int wc, int fr, int fq, int wid, int lane) const {
        LAS f32x2* P = (LAS f32x2*)lx; LAS f32x2* S = (LAS f32x2*)(lx + 8192);
#pragma unroll
        for (int ai = 0; ai < 2; ++ai)
#pragma unroll
            for (int m = 0; m < 4; ++m) {
                float s = 0.f;
#pragma unroll
                for (int bj = 0; bj < 2; ++bj)
#pragma unroll
                    for (int n = 0; n < 2; ++n) { const f32x4 x = v[ai][bj][m][n]; s += (x[0] + x[1]) + (x[2] + x[3]); }
                s += __shfl_xor(s, 16); s += __shfl_xor(s, 32);
                const float mw = s * (1.0f / 64.0f); float q = 0.f;
#pragma unroll
                for (int bj = 0; bj < 2; ++bj)
#pragma unroll
                    for (int n = 0; n < 2; ++n) { const f32x4 d = v[ai][bj][m][n] - mw; q += (d[0] * d[0] + d[1] * d[1]) + (d[2] * d[2] + d[3] * d[3]); }
                q += __shfl_xor(q, 16); q += __shfl_xor(q, 32);
                if (fq == 0) P[(ai * HALF + wr * 64 + m * 16 + fr) * 4 + wc] = (f32x2){mw, q};
            }
        asm volatile("s_waitcnt lgkmcnt(0)" ::: "memory"); __builtin_amdgcn_s_barrier(); asm volatile("" ::: "memory");
        const int row = wid * 32 + (lane & 31);
        if (lane < 32) {
            const f32x2 a = P[row * 4 + 0], b = P[row * 4 + 1], c = P[row * 4 + 2], d = P[row * 4 + 3];
            const float mt = (a.x + b.x + c.x + d.x) * 0.25f;
            const float da = a.x - mt, db = b.x - mt, dc = c.x - mt, dd = d.x - mt;
            const float m2 = (a.y + b.y) + (c.y + d.y) + 64.0f * ((da * da + db * db) + (dc * dc + dd * dd));
            unsigned long long* slot = xbuf + ((size_t)(u.pm * BM + row) * 4 + u.pn);
            __hip_atomic_store(slot, ((unsigned long long)__float_as_uint(m2) << 32) | __float_as_uint(mt), __ATOMIC_RELAXED, __HIP_MEMORY_SCOPE_AGENT);
        }
        asm volatile("s_waitcnt vmcnt(0)" ::: "memory");
        if (lane == 0) __hip_atomic_fetch_add(cnt + 64 * u.pm, 1u, __ATOMIC_RELAXED, __HIP_MEMORY_SCOPE_AGENT);
        if (wid == 0) {
            unsigned sp = 0;
            for (;;) {
                if ((unsigned)__builtin_amdgcn_readfirstlane(__hip_atomic_load(cnt + 64 * u.pm, __ATOMIC_RELAXED, __HIP_MEMORY_SCOPE_AGENT)) >= 32u) break;
                if (++sp > (1u << 22)) break;
                __builtin_amdgcn_s_sleep(2);
            }
            __builtin_amdgcn_fence(__ATOMIC_ACQUIRE, "agent");
        }
        asm volatile("s_waitcnt vmcnt(0) lgkmcnt(0)" ::: "memory"); __builtin_amdgcn_s_barrier(); asm volatile("" ::: "memory");
        if (lane < 32) {
            const unsigned long long* slot = xbuf + (size_t)(u.pm * BM + row) * 4; float mt[4], m2[4]; float ms = 0.f;
#pragma unroll
            for (int t = 0; t < 4; ++t) { const unsigned long long w = __hip_atomic_load(slot + t, __ATOMIC_RELAXED, __HIP_MEMORY_SCOPE_AGENT); mt[t] = __uint_as_float((unsigned)w); m2[t] = __uint_as_float((unsigned)(w >> 32)); ms += mt[t]; }
            const float mean = ms * 0.25f; float q = 0.f;
#pragma unroll
            for (int t = 0; t < 4; ++t) { const float dm = mt[t] - mean; q += m2[t] + 256.0f * dm * dm; }
            S[row] = (f32x2){mean, rsqrtf(q * (1.0f / 1024.0f) + LN_EPS)};
        }
        asm volatile("s_waitcnt lgkmcnt(0)" ::: "memory"); __builtin_amdgcn_s_barrier(); asm volatile("" ::: "memory");
    }
};
template <int WHICH>
struct EpiResidLn {
    static constexpr bool PERM = false;
    const float* const* in; unsigned char* ws; float* out_; int l; LAS unsigned char* lx;
    __device__ __forceinline__ void run(f32x4 (&acc)[2][2][4][2], const Unit& u, int wr, int wc, int fr_, int fq_) const {
        int fr = fr_, fq = fq_; asm volatile("" : "+v"(fr), "+v"(fq));
        int lv = l; asm volatile("" : "+v"(lv)); lv = __builtin_amdgcn_readfirstlane(lv);
        const float* mod = (const float*)(ws + 0) + lv * 9 * 6144;
        float* out = out_;
        const float* xres_ctx = (WHICH == 0 && lv == 0) ? in[0] : out;
        const float* xres_lat = (WHICH == 0 && lv == 0) ? in[1] : out + (size_t)T_CTX * DM;
        const int goff = WHICH == 0 ? 2048 : 5120;
        const float* lg = in[WHICH == 0 ? 19 : 23] + lv * DM; const float* lb = in[WHICH == 0 ? 20 : 24] + lv * DM;
        bf16_t* act = (bf16_t*)(ws + (size_t)70 * 1048576);
        const float* modn = WHICH == 0 ? mod : (const float*)(ws + 0) + (lv + 1 < DEPTH ? lv + 1 : lv) * 9 * 6144;
        const int sh_off = WHICH == 0 ? 3072 : 0, sc_off = WHICH == 0 ? 4096 : 1024;
        PanelStats st{(unsigned long long*)(ws + (size_t)424 * 1048576), (unsigned*)(ws + (size_t)426 * 1048576) + (lv * 2 + WHICH) * 144 * 64, lx};
        const int v = u.pm < 16 ? 0 : 1 + ((u.pm - 16) >> 4);
        const float* xb = u.pm < 16 ? xres_ctx + (size_t)u.pm * BM * DM : xres_lat + (size_t)(u.pm - 16) * BM * DM;
        float* ob = out + (size_t)u.pm * BM * DM;
        const int col0 = u.pn * BM + wc * 32 + 4 * fq;
        const size_t roff = (size_t)(wr * 64 + fr) * DM + col0;
        {
            const float* gp = mod + v * 6144 + goff + col0;
#pragma unroll
            for (int bj = 0; bj < 2; ++bj)
#pragma unroll
                for (int n = 0; n < 2; ++n) { const f32x4 gv = *(const f32x4*)(gp + bj * HALF + n * 16);
#pragma unroll
                    for (int ai = 0; ai < 2; ++ai) {
#pragma unroll
                        for (int m = 0; m < 4; ++m) { const f32x4 x = *(const f32x4*)(xb + roff + (size_t)(ai * HALF + m * 16) * DM + bj * HALF + n * 16); acc[ai][bj][m][n] = x * ALPHA + gv * acc[ai][bj][m][n]; }
#pragma unroll
                        for (int m = 0; m < 4; ++m) asm volatile("" : "+v"(acc[ai][bj][m][n]));
                        asm volatile("" ::: "memory"); } }
        }
        const int lane = fq * 16 + fr, wid = wr * 4 + wc;
        st.run(acc, u, wr, wc, fr, fq, wid, lane);
        const LAS f32x2* S = (const LAS f32x2*)(st.lx + 8192);
        const float* mv = modn + v * 6144;
#pragma unroll
        for (int bj = 0; bj < 2; ++bj)
#pragma unroll
            for (int n = 0; n < 2; ++n) { const int c = col0 + bj * HALF + n * 16;
                const f32x4 g4 = *(const f32x4*)(lg + c), b4 = *(const f32x4*)(lb + c);
                f32x4 sh = (f32x4){0.f, 0.f, 0.f, 0.f}, sc = sh;
                sh = *(const f32x4*)(mv + sh_off + c); sc = *(const f32x4*)(mv + sc_off + c) + 1.0f;
#pragma unroll
                for (int ai = 0; ai < 2; ++ai)
#pragma unroll
                    for (int m = 0; m < 4; ++m) { const size_t off = roff + (size_t)(ai * HALF + m * 16) * DM + bj * HALF + n * 16;
                        const f32x2 sr = S[ai * HALF + wr * 64 + m * 16 + fr];
                        const f32x4 y = (acc[ai][bj][m][n] - sr.x) * sr.y * g4 + b4;
                        *(f32x4*)(ob + off) = y;
                        { const f32x4 h = y * sc + sh; u32x2 w; w.x = cvt_pk_bf16(h[0], h[1]); w.y = cvt_pk_bf16(h[2], h[3]);
                            *(u32x2*)(act + (size_t)u.pm * BM * DM + off) = w; } }
                asm volatile("" ::: "memory"); }
    }
};
struct EpiGate {
    static constexpr bool PERM = true;
    const bf16_t* P;
    bf16_t* O; int ldc;
    __device__ __forceinline__ void run(f32x4 (&acc)[2][2][4][2], const Unit& u, int wr, int wc, int fr, int fq) const {
        const int row0 = u.pm * BM + wr * 64 + fr; const int col0 = u.pn * BM + wc * 32 + 8 * fq;
        const int noff = u.seg == 0 ? 0 : (u.seg == 1 ? 2048 : 1024), doff = u.seg == 0 ? 2048 : 1024;
        const bool last = u.seg == 2;
#pragma unroll
        for (int ai = 0; ai < 2; ++ai)
#pragma unroll
            for (int m = 0; m < 4; ++m) { const size_t r = (size_t)(row0 + ai * HALF + m * 16);
                const bf16_t* gp = P + r * NPROJ + PC_G + col0;
#pragma unroll
                for (int bj = 0; bj < 2; ++bj) {
                    const u32x4 gn = *(const u32x4*)(gp + noff + bj * HALF);
                    u32x4 gd = gn; if (!last) gd = *(const u32x4*)(gp + doff + bj * HALF);
                    float f[8];
#pragma unroll
                    for (int e = 0; e < 4; ++e) {
                        float a0 = bf_lo(gn[e]), a1 = bf_hi(gn[e]);
                        a0 = fminf(fmaxf(a0, -60.f), 60.f); a1 = fminf(fmaxf(a1, -60.f), 60.f);
                        const float ea0 = __expf(-a0), ea1 = __expf(-a1);
                        if (last) { f[2 * e] = 1.0f / (1.0f + ea0); f[2 * e + 1] = 1.0f / (1.0f + ea1); }
                        else { float b0 = bf_lo(gd[e]), b1 = bf_hi(gd[e]);
                            b0 = fminf(fmaxf(b0, -60.f), 60.f); b1 = fminf(fmaxf(b1, -60.f), 60.f);
                            f[2 * e] = (1.0f + __expf(-b0)) / (1.0f + ea0); f[2 * e + 1] = (1.0f + __expf(-b1)) / (1.0f + ea1); }
                    }
                    f32x4 v0 = acc[ai][bj][m][0], v1 = acc[ai][bj][m][1];
                    v0[0] *= f[0]; v0[1] *= f[1]; v0[2] *= f[2]; v0[3] *= f[3]; v1[0] *= f[4]; v1[1] *= f[5]; v1[2] *= f[6]; v1[3] *= f[7];
                    if (last) { u32x4 w; w.x = cvt_pk_bf16(v0[0], v0[1]); w.y = cvt_pk_bf16(v0[2], v0[3]); w.z = cvt_pk_bf16(v1[0], v1[1]); w.w = cvt_pk_bf16(v1[2], v1[3]);
                        *(u32x4*)(O + r * ldc + col0 + bj * HALF) = w; }
                    else { acc[ai][bj][m][0] = v0; acc[ai][bj][m][1] = v1; }
                } }
    }
};

struct EpiNone { static constexpr bool PERM = true; __device__ __forceinline__ void run(f32x4 (&acc)[2][2][4][2], const Unit& u, int wr, int wc, int fr, int fq) const {
    _Pragma("unroll") for (int a = 0; a < 2; ++a) _Pragma("unroll") for (int b = 0; b < 2; ++b) _Pragma("unroll") for (int m = 0; m < 4; ++m) _Pragma("unroll") for (int n = 0; n < 2; ++n) asm volatile("" :: "v"(acc[a][b][m][n])); } };
template <class Epi>
__device__ __forceinline__ void gemm_phase(LAS unsigned char* lds, const Gemm g, const Order& S, const Epi& E, const int tid) {
    const int wid = __builtin_amdgcn_readfirstlane(tid >> 6), lane = tid & 63, wr = wid >> 2, wc = wid & 3, fr = lane & 15, fq = lane >> 4;
    unsigned voffA[2], voffB[2];
#pragma unroll
    for (int i = 0; i < 2; ++i) { int R, C; stage_rc(tid * 16 + i * 8192, R, C); const int Rb = Epi::PERM ? ((R & ~31) + perm32(R & 31)) : R;
        voffA[i] = (unsigned)(R * g.lda + C) * 2u; voffB[i] = (unsigned)(Rb * g.ldb + C) * 2u; }
    const size_t kstep = (size_t)(BK * 2);
    const size_t hstepA = (size_t)HALF * g.lda * 2, hstepB = (size_t)HALF * g.ldb * 2;
    const size_t tstepA = 2 * hstepA, tstepB = 2 * hstepB;
    const unsigned ldsw = (unsigned)wid * 1024u;
    const int aoff = lds_byte(wr * 64 + fr, fq * 8), boff = lds_byte(wc * 32 + fr, fq * 8);
#define PG8_SA(b, h) (((b) * 2 + (h)) * HTB)
#define PG8_SB(b, h) ((4 + (b) * 2 + (h)) * HTB)
#define PG8_STAGE(bufoff, gbase, voff) do { _Pragma("unroll") for (int _i = 0; _i < 2; ++_i) \
        __builtin_amdgcn_global_load_lds((const unsigned*)((const char*)(gbase) + (voff)[_i]), (LAS unsigned*)(lds + (bufoff) + ldsw + _i * 8192), 16, 0, 0); } while (0)
#define PG8_LDA(dst, b, h) do { _Pragma("unroll") for (int m = 0; m < 4; ++m) _Pragma("unroll") for (int k = 0; k < 2; ++k) dst[m][k] = *(const LAS bf16x8*)(lds + PG8_SA(b, h) + aoff + m * 2048 + k * 1024); } while (0)
#define PG8_LDB(dst, b, h) do { _Pragma("unroll") for (int n = 0; n < 2; ++n) _Pragma("unroll") for (int k = 0; k < 2; ++k) dst[n][k] = *(const LAS bf16x8*)(lds + PG8_SB(b, h) + boff + n * 2048 + k * 1024); } while (0)
#define PG8_MMA(ai, bj, At, Bt) do { __builtin_amdgcn_s_setprio(1); _Pragma("unroll") for (int m = 0; m < 4; ++m) _Pragma("unroll") for (int n = 0; n < 2; ++n) _Pragma("unroll") for (int k = 0; k < 2; ++k) \
        acc[ai][bj][m][n] = __builtin_amdgcn_mfma_f32_16x16x32_bf16(Bt[n][k], At[m][k], acc[ai][bj][m][n], 0, 0, 0); __builtin_amdgcn_s_setprio(0); } while (0)
#define PG8_WAIT_V(n) asm volatile("s_waitcnt vmcnt(" #n ")" ::: "memory")
#define PG8_WAIT_L(n) asm volatile("s_waitcnt lgkmcnt(" #n ")" ::: "memory")
#define PG8_BAR __builtin_amdgcn_s_barrier()
#define PG8_SCHED __builtin_amdgcn_sched_barrier(0)
#define KOF(sg) ((sg) == 0 ? g.k0[0] : ((sg) == 1 ? g.k0[1] : g.k0[2]))
#define NTF(sg) ((sg) == 0 ? g.nt[0] : ((sg) == 1 ? g.nt[1] : g.nt[2]))
    Unit cur, nxt; int ui = 0;
    if (!S.next(0, cur)) return;
    f32x4 acc[2][2][4][2];
#pragma unroll
    for (int a = 0; a < 2; ++a)
#pragma unroll
        for (int b = 0; b < 2; ++b)
#pragma unroll
            for (int m = 0; m < 4; ++m)
#pragma unroll
                for (int n = 0; n < 2; ++n) acc[a][b][m][n] = (f32x4){0.f, 0.f, 0.f, 0.f};
    bf16x8 At[4][2], B0[2][2], B1[2][2];
    const char* cA = (const char*)g.A + (size_t)cur.pm * tstepA + (size_t)KOF(cur.seg) * 2; const char* cB = (const char*)g.Bt + (size_t)cur.pn * tstepB + (size_t)KOF(cur.seg) * 2;
    PG8_STAGE(PG8_SB(0, 0), cB, voffB); PG8_STAGE(PG8_SB(0, 1), cB + hstepB, voffB); PG8_STAGE(PG8_SA(0, 0), cA, voffA); PG8_STAGE(PG8_SA(0, 1), cA + hstepA, voffA);
    if (wr == 1) PG8_BAR;
    PG8_WAIT_V(2); PG8_BAR;
    PG8_STAGE(PG8_SB(1, 0), cB + kstep, voffB); PG8_STAGE(PG8_SA(1, 0), cA + kstep, voffA); PG8_STAGE(PG8_SB(1, 1), cB + hstepB + kstep, voffB);
    PG8_WAIT_V(6); PG8_BAR;
    for (;;) {
        const bool has_next = S.next(ui + 1, nxt);
        const int nt = NTF(cur.seg);
        const char* nA = has_next ? (const char*)g.A + (size_t)nxt.pm * tstepA + (size_t)KOF(nxt.seg) * 2 : cA;
        const char* nB = has_next ? (const char*)g.Bt + (size_t)nxt.pn * tstepB + (size_t)KOF(nxt.seg) * 2 : cB;
        for (int t = 0; t < nt; t += 2) {
            const bool last = (t == nt - 2);
            const char* a1 = cA + (size_t)(t + 1) * kstep;
            const char* a2 = last ? nA : cA + (size_t)(t + 2) * kstep; const char* b2 = last ? nB : cB + (size_t)(t + 2) * kstep;
            const char* a3 = a2 + kstep; const char* b3 = b2 + kstep;
            PG8_LDB(B0, 0, 0); PG8_LDB(B1, 0, 1); PG8_SCHED; PG8_LDA(At, 0, 0); PG8_STAGE(PG8_SA(1, 1), a1 + hstepA, voffA);
            PG8_WAIT_V(8); PG8_WAIT_L(0); PG8_BAR; PG8_MMA(0, 0, At, B0); PG8_MMA(0, 1, At, B1); PG8_BAR; PG8_SCHED;
            PG8_LDA(At, 0, 1); PG8_STAGE(PG8_SB(0, 0), b2, voffB); PG8_STAGE(PG8_SB(0, 1), b2 + hstepB, voffB); PG8_STAGE(PG8_SA(0, 0), a2, voffA);
            PG8_WAIT_V(8); PG8_WAIT_L(0); PG8_BAR; PG8_MMA(1, 0, At, B0); PG8_MMA(1, 1, At, B1); PG8_BAR; PG8_SCHED;
            PG8_LDB(B0, 1, 0); PG8_LDB(B1, 1, 1); PG8_SCHED; PG8_LDA(At, 1, 0); PG8_STAGE(PG8_SA(0, 1), a2 + hstepA, voffA);
            PG8_WAIT_V(8); PG8_WAIT_L(0); PG8_BAR; PG8_MMA(0, 0, At, B0); PG8_MMA(0, 1, At, B1); PG8_BAR; PG8_SCHED;
            PG8_LDA(At, 1, 1); PG8_STAGE(PG8_SB(1, 0), b3, voffB); PG8_STAGE(PG8_SB(1, 1), b3 + hstepB, voffB); PG8_STAGE(PG8_SA(1, 0), a3, voffA);
            PG8_WAIT_V(8); PG8_WAIT_L(0); PG8_BAR; PG8_MMA(1, 0, At, B0); PG8_MMA(1, 1, At, B1); PG8_BAR; PG8_SCHED;
        }
        if (wr == 0) PG8_BAR;
        E.run(acc, cur, wr, wc, fr, fq);
        if (!has_next) break;
        if (cur.seg == g.nseg - 1) {
#pragma unroll
            for (int a = 0; a < 2; ++a)
#pragma unroll
                for (int b = 0; b < 2; ++b)
#pragma unroll
                    for (int m = 0; m < 4; ++m)
#pragma unroll
                        for (int n = 0; n < 2; ++n) acc[a][b][m][n] = (f32x4){0.f, 0.f, 0.f, 0.f};
        }
        cur = nxt; cA = nA; cB = nB; ++ui;
        if (wr == 1) PG8_BAR;
    }
    PG8_WAIT_V(0);
    PG8_BAR;
#undef KOF
#undef NTF
#undef PG8_SA
#undef PG8_SB
#undef PG8_STAGE
#undef PG8_LDA
#undef PG8_LDB
#undef PG8_MMA
#undef PG8_WAIT_V
#undef PG8_WAIT_L
#undef PG8_BAR
#undef PG8_SCHED
}
}

namespace att {
constexpr int D = 128, QBLK = 32, KVBLK = 64;
constexpr float SCALE = 0.088388347648318440f;
constexpr float THR = 8.f;
constexpr size_t SHM_V = KVBLK * D * 2, SHM_K = KVBLK * D * 2, SHM_ATTN = 2 * SHM_V + 2 * SHM_K + NW * 64 * 4;
#define KSWZ(row, colB) ((row) * 256 + ((colB) ^ (((row) & 7) << 4)))
#define SBAR() __builtin_amdgcn_sched_barrier(0)
__device__ __forceinline__ int crow(int r, int hi) { return (r & 3) + 8 * (r >> 2) + 4 * hi; }
__device__ __forceinline__ unsigned cvtpk(float lo, float hi) { unsigned r; asm volatile("v_cvt_pk_bf16_f32 %0, %1, %2" : "=v"(r) : "v"(lo), "v"(hi)); return r; }
__device__ __forceinline__ void partialSM(f32x16& p0, f32x16& p1, float& m_reg, float& mn, float& alpha) {
  constexpr float C = SCALE * 1.4426950408889634f;
  float pmax = p0[0];
#pragma unroll
  for (int r = 1; r < 16; ++r) pmax = fmaxf(pmax, p0[r]);
#pragma unroll
  for (int r = 0; r < 16; ++r) pmax = fmaxf(pmax, p1[r]);
  { auto rr = __builtin_amdgcn_permlane32_swap(__float_as_uint(pmax), __float_as_uint(pmax), false, false);
    pmax = fmaxf(__uint_as_float(rr[0]), __uint_as_float(rr[1])); }
  if (__builtin_expect(__all(pmax - m_reg <= THR / SCALE), 1)) { mn = m_reg; alpha = 1.f; }
  else { mn = fmaxf(m_reg, pmax); alpha = __builtin_amdgcn_exp2f((m_reg - mn) * C); m_reg = mn; }
  float mnC = -mn * C;
#pragma unroll
  for (int r = 0; r < 16; ++r) p0[r] = fmaf(p0[r], C, mnC);
#pragma unroll
  for (int r = 0; r < 16; ++r) p1[r] = fmaf(p1[r], C, mnC);
#pragma unroll
  for (int r = 0; r < 16; ++r) p0[r] = __builtin_amdgcn_exp2f(p0[r]);
}
__device__ __forceinline__ void finishSM(f32x16& p0, f32x16& p1, float alpha, float& l_reg, bf16x8& pa0, bf16x8& pa1, bf16x8& pa2, bf16x8& pa3) {
#pragma unroll
  for (int r = 0; r < 16; ++r) p1[r] = __builtin_amdgcn_exp2f(p1[r]);
  float ps = 0;
#pragma unroll
  for (int r = 0; r < 16; ++r) ps += p0[r];
#pragma unroll
  for (int r = 0; r < 16; ++r) ps += p1[r];
  { auto rr = __builtin_amdgcn_permlane32_swap(__float_as_uint(ps), __float_as_uint(ps), false, false);
    ps = __uint_as_float(rr[0]) + __uint_as_float(rr[1]); }
  l_reg = l_reg * alpha + ps;
#define PK4(P, BASE, OUT) do { unsigned a0 = cvtpk(P[BASE + 0], P[BASE + 1]), a1 = cvtpk(P[BASE + 2], P[BASE + 3]);   \
    unsigned b0 = cvtpk(P[BASE + 4], P[BASE + 5]), b1 = cvtpk(P[BASE + 6], P[BASE + 7]);                              \
    auto r0 = __builtin_amdgcn_permlane32_swap(a0, b0, false, false); auto r1 = __builtin_amdgcn_permlane32_swap(a1, b1, false, false); \
    u32x4 w = {r0[0], r1[0], r0[1], r1[1]}; OUT = *reinterpret_cast<bf16x8*>(&w); } while (0)
  PK4(p0, 0, pa0); PK4(p0, 8, pa1); PK4(p1, 0, pa2); PK4(p1, 8, pa3);
#undef PK4
}
__device__ __forceinline__ void qkt(f32x16& p0, f32x16& p1, const bf16_t* Ks, const bf16x8* qr, int r32, int hi) {
  p0 = f32x16{}; p1 = f32x16{};
#pragma unroll
  for (int d0 = 0; d0 < 8; ++d0) { int cb = (d0 * 16 + hi * 8) * 2;
    bf16x8 b0 = *reinterpret_cast<const bf16x8*>((const char*)Ks + KSWZ(r32, cb));
    bf16x8 b1 = *reinterpret_cast<const bf16x8*>((const char*)Ks + KSWZ(32 + r32, cb));
    p0 = __builtin_amdgcn_mfma_f32_32x32x16_bf16(b0, qr[d0], p0, 0, 0, 0);
    p1 = __builtin_amdgcn_mfma_f32_32x32x16_bf16(b1, qr[d0], p1, 0, 0, 0); }
}
__device__ __forceinline__ int v_st(int k, int c) { const int kk = (k & ~0xC) | ((k & 4) << 1) | ((k & 8) >> 1); return ((kk >> 3) * 4 + (c >> 5)) * 512 + ((kk & 7) * 32 + (c & 31)) * 2; }
__device__ __forceinline__ int v_rd_base(int lane) { return ((lane & 3) << 3) | (((lane >> 2) & 3) << 6) | (((lane >> 4) & 1) << 5) | (((lane >> 5) & 1) << 8); }
constexpr int v_rd_off(int d0, int ks, int half) { return d0 * 512 + ks * 4096 + half * 2048; }
template <int OFF> __device__ __forceinline__ s16x4 tr_read(int vb) {
  s16x4 r; asm volatile("ds_read_b64_tr_b16 %0, %1 offset:%2" : "=&v"(r) : "v"(vb), "i"(OFF) : "memory"); return r;
}
template <int D0> __device__ __forceinline__ void pv_one(f32x16& od, int vb, bf16x8 pa0, bf16x8 pa1, bf16x8 pa2, bf16x8 pa3) {
  const s16x4 l0 = tr_read<v_rd_off(D0, 0, 0)>(vb), h0 = tr_read<v_rd_off(D0, 0, 1)>(vb), l1 = tr_read<v_rd_off(D0, 1, 0)>(vb), h1 = tr_read<v_rd_off(D0, 1, 1)>(vb);
  const s16x4 l2 = tr_read<v_rd_off(D0, 2, 0)>(vb), h2 = tr_read<v_rd_off(D0, 2, 1)>(vb), l3 = tr_read<v_rd_off(D0, 3, 0)>(vb), h3 = tr_read<v_rd_off(D0, 3, 1)>(vb);
  asm volatile("s_waitcnt lgkmcnt(0)" ::: "memory"); SBAR();
#define PK(L, H) (bf16x8){L[0], L[1], L[2], L[3], H[0], H[1], H[2], H[3]}
  od = __builtin_amdgcn_mfma_f32_32x32x16_bf16(pa0, PK(l0, h0), od, 0, 0, 0);
  od = __builtin_amdgcn_mfma_f32_32x32x16_bf16(pa1, PK(l1, h1), od, 0, 0, 0);
  od = __builtin_amdgcn_mfma_f32_32x32x16_bf16(pa2, PK(l2, h2), od, 0, 0, 0);
  od = __builtin_amdgcn_mfma_f32_32x32x16_bf16(pa3, PK(l3, h3), od, 0, 0, 0);
#undef PK
}
__device__ __forceinline__ void pv_d0(f32x16* o, int vb, bf16x8 pa0, bf16x8 pa1, bf16x8 pa2, bf16x8 pa3) {
  pv_one<0>(o[0], vb, pa0, pa1, pa2, pa3); pv_one<1>(o[1], vb, pa0, pa1, pa2, pa3); pv_one<2>(o[2], vb, pa0, pa1, pa2, pa3); pv_one<3>(o[3], vb, pa0, pa1, pa2, pa3);
}
constexpr int LDQ = NPROJ, LDK = 256;
__device__ __forceinline__ void attn_dense_body(bf16_t* Qb, const bf16_t* __restrict__ Kh, const bf16_t* __restrict__ Vh, int seq, char* lds, const int tid, const bool STORE = true) {
  const int wid = tid >> 6, lane = tid & 63, r32 = lane & 31, hi = lane >> 5;
  bf16_t* V_lds = (bf16_t*)lds; bf16_t* K_lds = (bf16_t*)(lds + 2 * SHM_V);
  float* ws = (float*)(lds + 2 * SHM_V + 2 * SHM_K) + wid * 64; float* li_l = ws; float* al_l = ws + 32;
  float m_reg = -1e30f, l_reg = 0; f32x16 o[4] = {}; bf16x8 qr[8];
  const bf16_t* Qw = Qb + (long)(wid * QBLK + r32) * LDQ + hi * 8;
#pragma unroll
  for (int d0 = 0; d0 < 8; ++d0) qr[d0] = *reinterpret_cast<const bf16x8*>(Qw + d0 * 16);
  const int sr = tid >> 4, sc = (tid & 15) * 8, vst0 = v_st(sr, sc), vst1 = v_st(32 + sr, sc);
  const int vb0 = (int)(uintptr_t)V_lds + v_rd_base(lane);
  struct { bf16x8 vs0, vs1, ks0, ks1; } sr_[1];
#define LD8(p) (*reinterpret_cast<const bf16x8*>(p))
#define SLOAD(i, k0) do { sr_[i].vs0 = LD8(&Vh[(long)((k0) + sr) * LDK + sc]); sr_[i].vs1 = LD8(&Vh[(long)((k0) + 32 + sr) * LDK + sc]); \
    sr_[i].ks0 = LD8(&Kh[(long)((k0) + sr) * LDK + sc]); sr_[i].ks1 = LD8(&Kh[(long)((k0) + 32 + sr) * LDK + sc]); } while (0)
#define SWRITE(b, i) do { *(bf16x8*)((char*)V_lds + (b) * SHM_V + vst0) = sr_[i].vs0;          \
    *(bf16x8*)((char*)V_lds + (b) * SHM_V + vst1) = sr_[i].vs1; int kc = sc * 2;               \
    *(bf16x8*)((char*)K_lds + (b) * SHM_K + KSWZ(sr, kc)) = sr_[i].ks0;                       \
    *(bf16x8*)((char*)K_lds + (b) * SHM_K + KSWZ(32 + sr, kc)) = sr_[i].ks1; } while (0)
#define SWAIT() asm volatile("s_waitcnt vmcnt(0)" ::: "memory")
#define RESC(a) do { if (__any((a) < 1.f)) { if (hi == 0) al_l[r32] = (a); asm volatile("s_waitcnt lgkmcnt(0)" ::: "memory"); \
    _Pragma("unroll") for (int d = 0; d < 4; ++d) _Pragma("unroll") for (int r = 0; r < 16; ++r) o[d][r] *= al_l[crow(r, hi)]; } } while (0)
  f32x16 pA0, pA1, pB0, pB1; float mnA, mnB, alA, alB; bf16x8 pa0, pa1, pa2, pa3; const int NT = seq / KVBLK;
  constexpr int SE = 0, SO = 0;
  SLOAD(SE, 0); asm volatile("s_waitcnt vmcnt(0)" ::: "memory"); SWRITE(0, SE); __syncthreads();
  qkt(pA0, pA1, K_lds, qr, r32, hi); partialSM(pA0, pA1, m_reg, mnA, alA);
  SLOAD(SO, KVBLK);
  SWAIT(); SWRITE(1, SO); __syncthreads();
  for (int j = 1; j + 1 < NT; j += 2) {
    SBAR(); qkt(pB0, pB1, (bf16_t*)((char*)K_lds + SHM_K), qr, r32, hi);
    finishSM(pA0, pA1, alA, l_reg, pa0, pa1, pa2, pa3); SBAR();
    SLOAD(SO, (j + 1) * KVBLK); SBAR();
    pv_d0(o, vb0, pa0, pa1, pa2, pa3); partialSM(pB0, pB1, m_reg, mnB, alB);
    __syncthreads(); SWAIT(); SWRITE(0, SE);
    RESC(alB); __syncthreads();
    SBAR(); qkt(pA0, pA1, K_lds, qr, r32, hi);
    finishSM(pB0, pB1, alB, l_reg, pa0, pa1, pa2, pa3); SBAR();
    SLOAD(SE, (j + 2) * KVBLK); SBAR();
    pv_d0(o, vb0 + (int)SHM_V, pa0, pa1, pa2, pa3); partialSM(pA0, pA1, m_reg, mnA, alA);
    __syncthreads(); SWAIT(); SWRITE(1, SO);
    RESC(alA); __syncthreads();
  }
  SBAR(); qkt(pB0, pB1, (bf16_t*)((char*)K_lds + SHM_K), qr, r32, hi);
  finishSM(pA0, pA1, alA, l_reg, pa0, pa1, pa2, pa3); SBAR();
  pv_d0(o, vb0, pa0, pa1, pa2, pa3); partialSM(pB0, pB1, m_reg, mnB, alB);
  __syncthreads(); RESC(alB);
  finishSM(pB0, pB1, alB, l_reg, pa0, pa1, pa2, pa3); SBAR();
  pv_d0(o, vb0 + (int)SHM_V, pa0, pa1, pa2, pa3);
  if (hi == 0) li_l[r32] = l_reg; asm volatile("s_waitcnt lgkmcnt(0)" ::: "memory");
  float rli[16];
#pragma unroll
  for (int r = 0; r < 16; ++r) rli[r] = __builtin_amdgcn_rcpf(li_l[crow(r, hi)]);
  __syncthreads();
  { bf16_t* stg = (bf16_t*)lds + wid * 4096;
#pragma unroll
    for (int r = 0; r < 16; ++r) { const int orow = crow(r, hi);
#pragma unroll
      for (int d0 = 0; d0 < 4; ++d0) stg[orow * 128 + d0 * 32 + r32] = (bf16_t)(cvtpk(o[d0][r] * rli[r], 0.f) & 0xffffu); }
    asm volatile("s_waitcnt lgkmcnt(0)" ::: "memory");
    bf16_t* Ow = Qb + (long)(wid * QBLK + (lane >> 4)) * LDQ + (lane & 15) * 8;
#pragma unroll
    for (int i = 0; i < 8; ++i) { const u32x4 v = *(const u32x4*)(stg + (i * 4 + (lane >> 4)) * 128 + (lane & 15) * 8); if (STORE) *(u32x4*)(Ow + (long)i * 4 * LDQ) = v; else asm volatile("" :: "v"(v)); }
  }
  __syncthreads();
#undef LD8
#undef SLOAD
#undef SWRITE
#undef SWAIT
#undef RESC
}
#undef KSWZ
#undef SBAR
}


#define XB_TMO      128
#define XB_XCNT(j)  (256  + 64 * (j))
#define XB_XSUB(j)  (1280 + 64 * (j))
#define XB_XGEN(j)  (2304 + 64 * (j))
#define XB_TOP      3328
#define XB_TOPGEN   3392
#define XCD_BAR_WORDS 3456
#define XB_SPIN_CAP (1u << 18)
__device__ __forceinline__ unsigned xb_ld(unsigned* p)              { return __hip_atomic_load(p, __ATOMIC_RELAXED, __HIP_MEMORY_SCOPE_AGENT); }
__device__ __forceinline__ unsigned xb_add(unsigned* p, unsigned v) { return __hip_atomic_fetch_add(p, v, __ATOMIC_RELAXED, __HIP_MEMORY_SCOPE_AGENT); }
__device__ __forceinline__ unsigned xb_xcc_id() { return (unsigned)__builtin_amdgcn_s_getreg((3 << 11) | 20) & 0xFu; }
#define XB_SPIN(cond, bar) do { unsigned _sp = 0; while (cond) { __builtin_amdgcn_s_sleep(1); \
    if ((++_sp & 255u) == 0u) { if (xb_ld(&(bar)[XB_TMO])) break; if (_sp > XB_SPIN_CAP) { atomicAdd(&(bar)[XB_TMO], 1u); break; } } } } while (0)
struct XcdBarrier { unsigned* bar; unsigned x; volatile LAS unsigned* st; };
__device__ __forceinline__ XcdBarrier xcd_barrier_post(unsigned* bar, volatile LAS unsigned* st) {
    XcdBarrier b; b.bar = bar; b.x = xb_xcc_id(); b.st = st;
    if (threadIdx.x == 0) (void)xb_add(&bar[XB_XCNT(b.x)], 1u);
    return b;
}
__device__ __forceinline__ void xcd_barrier_complete(unsigned* bar, unsigned x, unsigned& nloc, unsigned& nx) {
    const unsigned G = gridDim.x * gridDim.y * gridDim.z;
    unsigned sum, cnt, mine, sp = 0u;
    for (;;) {
        sum = 0u; cnt = 0u; mine = 0u;
#pragma unroll
        for (unsigned j = 0; j < 16; ++j) { const unsigned c = xb_ld(&bar[XB_XCNT(j)]); sum += c; cnt += (c > 0u) ? 1u : 0u; mine = (j == x) ? c : mine; }
        if (sum == G) break;
        __builtin_amdgcn_s_sleep(1);
        if ((++sp & 255u) == 0u) { if (xb_ld(&bar[XB_TMO])) break; if (sp > XB_SPIN_CAP) { atomicAdd(&bar[XB_TMO], 1u); break; } }
    }
    nloc = mine > 0u ? mine : 1u; nx = cnt > 0u ? cnt : 1u;
}
__device__ __forceinline__ void xcd_barrier(const XcdBarrier& b) {
    asm volatile("s_waitcnt vmcnt(0)" ::: "memory");
    __syncthreads();
    if (threadIdx.x == 0) {
        unsigned* bar = b.bar;
        __builtin_amdgcn_s_waitcnt(0);
        unsigned nloc = b.st[0], nx = b.st[1];
        if (nloc == 0u) { xcd_barrier_complete(bar, b.x, nloc, nx); b.st[0] = nloc; b.st[1] = nx; }
        const unsigned old = xb_add(&bar[XB_XSUB(b.x)], 1u);
        const unsigned gen = old / nloc;
        if (old + 1u == (gen + 1u) * nloc) {
            __builtin_amdgcn_fence(__ATOMIC_RELEASE, "agent");
            asm volatile("s_waitcnt vmcnt(0)" ::: "memory");
            const unsigned og = xb_add(&bar[XB_TOP], 1u);
            const unsigned tg = og / nx;
            if (og + 1u == (tg + 1u) * nx) xb_add(&bar[XB_TOPGEN], 1u);
            else XB_SPIN(xb_ld(&bar[XB_TOPGEN]) == tg, bar);
            __builtin_amdgcn_fence(__ATOMIC_ACQUIRE, "agent");
            xb_add(&bar[XB_XGEN(b.x)], 1u);
            asm volatile("s_waitcnt vmcnt(0)" ::: "memory");
        } else {
            XB_SPIN(xb_ld(&bar[XB_XGEN(b.x)]) == gen, bar);
            __builtin_amdgcn_fence(__ATOMIC_ACQUIRE, "agent");
            asm volatile("s_waitcnt vmcnt(0)" ::: "memory");
        }
    }
    __syncthreads();
}

struct Args { const float* in[25]; float* out; unsigned char* ws; int ph_lo, ph_hi; };

typedef const float* fptr_t;
typedef __attribute__((address_space(4))) const fptr_t* in_as4_t;
struct Frame {
    LAS unsigned char* lds; char* ldsg;
    int tid, lane, wave, G, bx, gw, NGW;
    const float* const* in;
    unsigned char* ws; float* out;
};
enum { I_XP = 0, I_XS, I_CK, I_CV, I_C, I_CCTX, I_WADA, I_BADA, I_WIN, I_QG, I_KG, I_WPG, I_PSC, I_WSGU, I_BSGU, I_WAO, I_WPO, I_WSO, I_WOUT, I_LN1G, I_LN1B, I_WF1, I_WF2, I_LN2G, I_LN2B };

__device__ __forceinline__ void tr_item(const float* W, int ldw, int src_col, int kb, bf16_t* WT, int ldt, int dst_row, int dst_k, LAS float* scr, int lane) {
    const int k0 = 64 * kb;
#pragma unroll 8
    for (int i = 0; i < 32; ++i) { const int kk = 2 * i + (lane >> 5); scr[kk * 33 + (lane & 31)] = W[(size_t)(k0 + kk) * ldw + src_col + (lane & 31)]; }
    asm volatile("s_waitcnt lgkmcnt(0)" ::: "memory");
    const int c = lane & 7;
#pragma unroll
    for (int j = 0; j < 4; ++j) { const int n = (lane >> 3) + 8 * j; const LAS float* s = scr + (8 * c) * 33 + n;
        u32x4 o; o.x = cvt_pk_bf16(s[0 * 33], s[1 * 33]); o.y = cvt_pk_bf16(s[2 * 33], s[3 * 33]); o.z = cvt_pk_bf16(s[4 * 33], s[5 * 33]); o.w = cvt_pk_bf16(s[6 * 33], s[7 * 33]);
        *(u32x4*)(WT + (size_t)(dst_row + n) * ldt + dst_k + k0 + 8 * c) = o; }
    asm volatile("s_waitcnt lgkmcnt(0)" ::: "memory");
}

__device__ __forceinline__ int win_src_col(int d) {
    if (d < 1024) return d;
    if (d < 1536) return 2048 + (d - 1024);
    if (d < 2048) return 1024 + (d - 1536);
    if (d < 2560) return 2560 + (d - 2048);
    if (d < 3072) return 1536 + (d - 2560);
    return d;
}

__device__ __forceinline__ void phase_prologue(Frame& F) {
    if (F.bx < 192) {
        const int l = F.bx / 96, nb = F.bx % 96;
        LAS float* sc = (LAS float*)F.lds;
        LAS float* red = (LAS float*)(F.lds + 9 * 1024 * 4);
        for (int idx = F.tid; idx < 9 * 1024; idx += 512) { const int v = idx >> 10, k = idx & 1023;
            const float x = v == 0 ? F.in[I_CCTX][k] : F.in[I_C][(v - 1) * 1024 + k]; sc[idx] = x / (1.0f + __expf(-x)); }
        __syncthreads();
        float acc[9];
#pragma unroll
        for (int v = 0; v < 9; ++v) acc[v] = 0.f;
        const float* wp = F.in[I_WADA] + ((size_t)l * 1024 + F.wave * 128) * 6144 + nb * 64 + F.lane;
#pragma unroll 8
        for (int k = 0; k < 128; ++k) { const float w = wp[(size_t)k * 6144];
#pragma unroll
            for (int v = 0; v < 9; ++v) acc[v] += sc[v * 1024 + F.wave * 128 + k] * w; }
#pragma unroll
        for (int v = 0; v < 9; ++v) red[(F.wave * 9 + v) * 64 + F.lane] = acc[v];
        __syncthreads();
        float* mod = (float*)(F.ws + WS_MOD);
        for (int idx = F.tid; idx < 576; idx += 512) { const int v = idx >> 6, ln = idx & 63; float s = 0.f;
#pragma unroll
            for (int w = 0; w < 8; ++w) s += red[(w * 9 + v) * 64 + ln];
            mod[(l * 9 + v) * 6144 + nb * 64 + ln] = s + F.in[I_BADA][l * 6144 + nb * 64 + ln]; }
        __syncthreads();
    }
    LAS float* scr = (LAS float*)(F.lds + F.wave * 8448);
    constexpr int N_WIN = 16 * 192, N_AO = 16 * 32, N_SO = 8 * 32, N_WO = 16 * 32, N_F1 = 16 * 176, N_F2 = 44 * 32, N_PE = 1024, N_WS = 128;
    constexpr int N_L = N_WIN + N_AO + N_SO + N_WO + N_F1 + N_F2 + N_PE + N_WS;
    constexpr int N_ALL = 2 * N_L + 32;
    for (int it = F.gw; it < N_ALL; it += F.NGW) {
        if (it >= 2 * N_L) {
            const int idx = (it - 2 * N_L) * 64 + F.lane; const int pos = idx >> 5, p = idx & 31;
            const float inv = powf(10000.0f, -(float)p / 32.0f); const float ang = (float)pos * inv;
            float* rope = (float*)(F.ws + WS_ROPE); rope[idx] = cosf(ang); rope[2048 + idx] = sinf(ang);
            continue;
        }
        const int l = it / N_L; int r = it % N_L;
        if (r < N_WIN) { const int kb = r / 192, nb = r % 192;
            tr_item(F.in[I_WIN] + (size_t)l * 1024 * 6144, 6144, win_src_col(nb * 32), kb, (bf16_t*)(F.ws + WS_WIN) + (size_t)l * 6144 * 1024, 1024, nb * 32, 0, scr, F.lane); continue; } r -= N_WIN;
        if (r < N_AO) { const int kb = r / 32, nb = r % 32;
            tr_item(F.in[I_WAO] + (size_t)l * 1024 * 1024, 1024, nb * 32, kb, (bf16_t*)(F.ws + WS_WM) + (size_t)l * 1024 * 2048, 2048, nb * 32, 0, scr, F.lane); continue; } r -= N_AO;
        if (r < N_SO) { const int kb = r / 32, nb = r % 32;
            tr_item(F.in[I_WSO] + (size_t)l * 512 * 1024, 1024, nb * 32, kb, (bf16_t*)(F.ws + WS_WM) + (size_t)l * 1024 * 2048, 2048, nb * 32, 1024, scr, F.lane); continue; } r -= N_SO;
        if (r < N_WO) { const int kb = r / 32, nb = r % 32;
            tr_item(F.in[I_WOUT] + (size_t)l * 1024 * 1024, 1024, nb * 32, kb, (bf16_t*)(F.ws + WS_WOUT) + (size_t)l * 1024 * 1024, 1024, nb * 32, 0, scr, F.lane); continue; } r -= N_WO;
        if (r < N_F1) { const int kb = r / 176, nb = r % 176; const int drow = nb * 32; const int pn = drow >> 8, j = drow & 255;
            const int src = j < 128 ? pn * 128 + j : DFF + pn * 128 + (j - 128);
            tr_item(F.in[I_WF1] + (size_t)l * 1024 * 5632, 5632, src, kb, (bf16_t*)(F.ws + WS_WF1) + (size_t)l * 5632 * 1024, 1024, drow, 0, scr, F.lane); continue; } r -= N_F1;
        if (r < N_F2) { const int kb = r / 32, nb = r % 32;
            tr_item(F.in[I_WF2] + (size_t)l * DFF * 1024, 1024, nb * 32, kb, (bf16_t*)(F.ws + WS_WF2) + (size_t)l * 1024 * DFF, DFF, nb * 32, 0, scr, F.lane); continue; } r -= N_F2;
        if (r < N_PE) {
            const int kg = r >> 4, nb = r & 15; const int k0 = kg * 8, g = k0 >> 7; const int n = nb * 64 + F.lane;
            const float* wpg = F.in[I_WPG] + ((size_t)(l * 4 + g) * 128 + (k0 & 127)) * 128;
            const float* psc = F.in[I_PSC] + l * 512 + g * 128;
            const float* wpo = F.in[I_WPO] + ((size_t)l * 512 + g * 128) * 1024 + n;
            float a[8];
#pragma unroll
            for (int i = 0; i < 8; ++i) a[i] = 0.f;
#pragma unroll 4
            for (int j = 0; j < 128; ++j) { const float w = wpo[(size_t)j * 1024] * psc[j];
#pragma unroll
                for (int i = 0; i < 8; ++i) a[i] += wpg[i * 128 + j] * w; }
            u32x4 o; o.x = cvt_pk_bf16(a[0], a[1]); o.y = cvt_pk_bf16(a[2], a[3]); o.z = cvt_pk_bf16(a[4], a[5]); o.w = cvt_pk_bf16(a[6], a[7]);
            *(u32x4*)((bf16_t*)(F.ws + WS_WM) + (size_t)l * 1024 * 2048 + (size_t)n * 2048 + 1536 + k0) = o;
            continue; } r -= N_PE;
        {
            const size_t e0 = (size_t)l * 65536 + (size_t)r * 512 + F.lane * 8;
            const f32x4 a = *(const f32x4*)(F.in[I_WSGU] + e0), b = *(const f32x4*)(F.in[I_WSGU] + e0 + 4);
            u32x4 o; o.x = cvt_pk_bf16(a[0], a[1]); o.y = cvt_pk_bf16(a[2], a[3]); o.z = cvt_pk_bf16(b[0], b[1]); o.w = cvt_pk_bf16(b[2], b[3]);
            *(u32x4*)((bf16_t*)(F.ws + WS_WSGU) + e0) = o;
        }
    }
}

__device__ __forceinline__ const float* x0_row(Frame& F, int t) { return t < T_CTX ? F.in[I_XP] + (size_t)t * DM : F.in[I_XS] + (size_t)(t - T_CTX) * DM; }
__device__ __forceinline__ int vec_of_row(int t) { return t < T_CTX ? 0 : 1 + ((t - T_CTX) >> 12); }

__device__ __forceinline__ void phase_h0(Frame& F) {
    const float* mod = (const float*)(F.ws + WS_MOD);
    bf16_t* act = (bf16_t*)(F.ws + WS_ACT);
    for (int t = F.gw; t < T_ALL; t += F.NGW) {
        const f32x4* xr = (const f32x4*)x0_row(F, t) + F.lane;
        const float* mv = mod + vec_of_row(t) * 6144;
        unsigned long long* o8 = (unsigned long long*)(act + (size_t)t * DM) + F.lane;
#pragma unroll
        for (int j = 0; j < 4; ++j) { const f32x4 x = xr[64 * j]; const int c = 256 * j + 4 * F.lane;
            const f32x4 sh = *(const f32x4*)(mv + c), sc = *(const f32x4*)(mv + 1024 + c);
            const f32x4 h = x * (sc + 1.0f) + sh;
            o8[64 * j] = (unsigned long long)cvt_pk_bf16(h[0], h[1]) | ((unsigned long long)cvt_pk_bf16(h[2], h[3]) << 32); }
    }
}

__device__ __forceinline__ void phase_ln(Frame& F, const float* lg, const float* lb, const float* modl  , int sh_off, int sc_off, const bool dry = false) {
    float* X = F.out; bf16_t* act = (bf16_t*)(F.ws + WS_ACT);
    for (int t = F.gw; t < T_ALL; t += F.NGW) {
        f32x4* xr = (f32x4*)(X + (size_t)t * DM) + F.lane;
        f32x4 v[4]; float s = 0.f;
#pragma unroll
        for (int j = 0; j < 4; ++j) { v[j] = xr[64 * j]; s += (v[j][0] + v[j][1]) + (v[j][2] + v[j][3]); }
        const float mean = wave_sum(s) * (1.f / DM); float s2 = 0.f;
#pragma unroll
        for (int j = 0; j < 4; ++j) { v[j] = v[j] - mean; s2 += (v[j][0] * v[j][0] + v[j][1] * v[j][1]) + (v[j][2] * v[j][2] + v[j][3] * v[j][3]); }
        const float rstd = rsqrtf(wave_sum(s2) * (1.f / DM) + LN_EPS);
        const float* mv = modl ? modl + vec_of_row(t) * 6144 : nullptr;
        unsigned long long* o8 = (unsigned long long*)(act + (size_t)t * DM) + F.lane;
#pragma unroll
        for (int j = 0; j < 4; ++j) { const int c = 256 * j + 4 * F.lane;
            const f32x4 g = *(const f32x4*)(lg + c), b = *(const f32x4*)(lb + c);
            const f32x4 y = v[j] * rstd * g + b; if (!dry) xr[64 * j] = y; else { asm volatile("" :: "v"(y)); continue; }
            if (mv) { const f32x4 sh = *(const f32x4*)(mv + sh_off + c), sc = *(const f32x4*)(mv + sc_off + c);
                const f32x4 h = y * (sc + 1.0f) + sh;
                o8[64 * j] = (unsigned long long)cvt_pk_bf16(h[0], h[1]) | ((unsigned long long)cvt_pk_bf16(h[2], h[3]) << 32); } }
    }
}

__device__ __forceinline__ void load16h(const bf16_t* p, int j, float (&x)[16]) {
#pragma unroll
    for (int a = 0; a < 2; ++a)
#pragma unroll
        for (int hf = 0; hf < 2; ++hf) { const u32x2 w = *(const u32x2*)(p + a * 64 + hf * 32 + 4 * j);
            x[(a * 2 + hf) * 4 + 0] = bf_lo(w.x); x[(a * 2 + hf) * 4 + 1] = bf_hi(w.x); x[(a * 2 + hf) * 4 + 2] = bf_lo(w.y); x[(a * 2 + hf) * 4 + 3] = bf_hi(w.y); }
}
__device__ __forceinline__ void rmsn(float (&x)[16], const float (&g)[16]) {
    float ss = 0.f;
#pragma unroll
    for (int i = 0; i < 16; ++i) ss += x[i] * x[i];
    ss += __shfl_xor(ss, 1); ss += __shfl_xor(ss, 2); ss += __shfl_xor(ss, 4);
    const float rinv = rsqrtf(ss * (1.0f / 128.0f) + LN_EPS);
#pragma unroll
    for (int i = 0; i < 16; ++i) x[i] = x[i] * rinv * g[i];
}
__device__ __forceinline__ void rope16(float (&x)[16], const float* rope, int rowpos, int colpos, int j) {
#pragma unroll
    for (int a = 0; a < 2; ++a) { const int pos = a == 0 ? rowpos : colpos;
        const f32x4 c = *(const f32x4*)(rope + pos * 32 + 4 * j), s = *(const f32x4*)(rope + 2048 + pos * 32 + 4 * j);
#pragma unroll
        for (int e = 0; e < 4; ++e) { const float x1 = x[(a * 2) * 4 + e], x2 = x[(a * 2 + 1) * 4 + e];
            x[(a * 2) * 4 + e] = x1 * c[e] - x2 * s[e]; x[(a * 2 + 1) * 4 + e] = x2 * c[e] + x1 * s[e]; } }
}
__device__ __forceinline__ void store16h(bf16_t* p, int j, const float (&x)[16]) {
#pragma unroll
    for (int a = 0; a < 2; ++a)
#pragma unroll
        for (int hf = 0; hf < 2; ++hf) { u32x2 w; w.x = cvt_pk_bf16(x[(a * 2 + hf) * 4 + 0], x[(a * 2 + hf) * 4 + 1]); w.y = cvt_pk_bf16(x[(a * 2 + hf) * 4 + 2], x[(a * 2 + hf) * 4 + 3]);
            *(u32x2*)(p + a * 64 + hf * 32 + 4 * j) = w; }
}

__device__ __forceinline__ void phase_mid(Frame& F, int l, int part, const bool dry = false) {
    bf16_t* proj = (bf16_t*)(F.ws + WS_PROJ);
    const float* rope = (const float*)(F.ws + WS_ROPE);
    bf16_t* vrt = (bf16_t*)(F.ws + WS_VRT);
    bf16_t* KL = (bf16_t*)(F.ws + WS_KL); bf16_t* VL = (bf16_t*)(F.ws + WS_VL); bf16_t* KC = (bf16_t*)(F.ws + WS_KC); bf16_t* VC = (bf16_t*)(F.ws + WS_VC);
    float* outk = F.out + (size_t)T_ALL * DM; float* outv = outk + (size_t)16 * 2 * 256 * 256;
    const int lane = F.lane, hj = lane & 7;
    const int n8 = part_rows(part) / 8, ncache = 4 * PAST;
    float qg[16], kg[16];
#pragma unroll
    for (int a = 0; a < 2; ++a)
#pragma unroll
        for (int hf = 0; hf < 2; ++hf)
#pragma unroll
            for (int e = 0; e < 4; ++e) { const int d = a * 64 + hf * 32 + 4 * hj + e; qg[(a * 2 + hf) * 4 + e] = F.in[I_QG][l * 128 + d]; kg[(a * 2 + hf) * 4 + e] = F.in[I_KG][l * 128 + d]; }
    for (int it = F.gw; it < n8 + ncache; it += F.NGW) {
        if (it >= n8) {
            const int cr = it - n8; const int bl = cr >> 9, s = cr & 511; const int b = part * 4 + bl;
            const size_t src = (((size_t)b * 2 + l) * PAST + s) * 256 + lane * 4;
            const f32x4 kx = *(const f32x4*)(F.in[I_CK] + src), vx = *(const f32x4*)(F.in[I_CV] + src);
            const size_t dst = ((size_t)bl * SKV_LAT + s) * 256 + lane * 4;
            u32x2 kw, vw; kw.x = cvt_pk_bf16(kx[0], kx[1]); kw.y = cvt_pk_bf16(kx[2], kx[3]); vw.x = cvt_pk_bf16(vx[0], vx[1]); vw.y = cvt_pk_bf16(vx[2], vx[3]);
            if (!dry) { *(u32x2*)(KL + dst) = kw; *(u32x2*)(VL + dst) = vw; } else asm volatile("" :: "v"(kw), "v"(vw));
            continue;
        }
        const int lr0 = it * 8, t0 = part_row0(part) + lr0;
        const bool is_ctx = t0 < T_CTX;
        bf16_t* P0 = proj + (size_t)lr0 * NPROJ;
        {
            float val[8][8];
#pragma unroll
            for (int i = 0; i < 8; ++i) { const u32x4 w = *(const u32x4*)(P0 + (size_t)i * NPROJ + PC_XV + lane * 8);
#pragma unroll
                for (int e = 0; e < 4; ++e) { val[i][2 * e] = gelu1(bf_lo(w[e])); val[i][2 * e + 1] = gelu1(bf_hi(w[e])); } }
#pragma unroll
            for (int i = 0; i < 8; ++i) { float s = 0.f;
#pragma unroll
                for (int e = 0; e < 8; ++e) s += val[i][e];
                const float mean = wave_sum(s) * (1.0f / 512.0f); float s2 = 0.f;
#pragma unroll
                for (int e = 0; e < 8; ++e) { val[i][e] -= mean; s2 += val[i][e] * val[i][e]; }
                const float rstd = rsqrtf(wave_sum(s2) * (1.0f / 512.0f) + LN_EPS);
#pragma unroll
                for (int e = 0; e < 8; ++e) val[i][e] *= rstd; }
            const int chunk = lr0 >> 7, q0 = lr0 & 127;
            bf16_t* vb = vrt + ((size_t)chunk * 512 + lane * 8) * 128 + q0;
#pragma unroll
            for (int e = 0; e < 8; ++e) { u32x4 o; o.x = cvt_pk_bf16(val[0][e], val[1][e]); o.y = cvt_pk_bf16(val[2][e], val[3][e]); o.z = cvt_pk_bf16(val[4][e], val[5][e]); o.w = cvt_pk_bf16(val[6][e], val[7][e]);
                if (!dry) *(u32x4*)(vb + (size_t)e * 128) = o; else asm volatile("" :: "v"(o)); }
        }
#pragma unroll 1
        for (int i = 0; i < 8; ++i) {
            bf16_t* Pr = P0 + (size_t)i * NPROJ; const int t = t0 + i;
            int spos, seqS, rowpos = 0, colpos = 0, bl = 0;
            if (is_ctx) { spos = t & 255; seqS = CTX_S; } else { const int tl = t - T_CTX; spos = tl & 4095; seqS = LAT_S; rowpos = spos >> 6; colpos = spos & 63; bl = (tl >> 12) - part * 4; }
            float x[16];
            load16h(Pr + PC_Q + (lane >> 3) * 128, hj, x); rmsn(x, qg); if (!is_ctx) rope16(x, rope, rowpos, colpos, hj);
            if (!dry) store16h(Pr + PC_Q + (lane >> 3) * 128, hj, x); else asm volatile("" :: "v"(x[0]), "v"(x[5]), "v"(x[10]), "v"(x[15]));
            const int kh = (lane >> 3) & 1;
            load16h(Pr + PC_K + kh * 128, hj, x); rmsn(x, kg);
            const int vi = (lane - 16) & 31;
            const u32x4 vw = *(const u32x4*)(Pr + PC_V + vi * 8);
            float pacc[8], pself[8];
            {
                const int hw = 1 << (lane >> 4);
                const int lo = max(spos - hw, 0), hi = min(spos + hw, seqS);
#pragma unroll
                for (int e = 0; e < 8; ++e) pacc[e] = 0.f;
                for (int dd = lo - spos; dd < hi - spos; ++dd) { const u32x4 w = *(const u32x4*)(Pr + (long)dd * NPROJ + PC_XP + lane * 8);
#pragma unroll
                    for (int e = 0; e < 4; ++e) { pacc[2 * e] += bf_lo(w[e]); pacc[2 * e + 1] += bf_hi(w[e]); } }
                const u32x4 w = *(const u32x4*)(Pr + PC_XP + lane * 8);
#pragma unroll
                for (int e = 0; e < 4; ++e) { pself[2 * e] = bf_lo(w[e]); pself[2 * e + 1] = bf_hi(w[e]); }
                const float rc = 1.0f / (float)(hi - lo);
#pragma unroll
                for (int e = 0; e < 8; ++e) pacc[e] = pacc[e] * rc - pself[e];
            }
            asm volatile("s_waitcnt vmcnt(0)" ::: "memory");
            if (dry) { asm volatile("" :: "v"(x[0]), "v"(x[7]), "v"(vw), "v"(pacc[0]), "v"(pacc[7])); continue; }
            if (is_ctx) {
                if (lane < 16) {
                    float* ok = outk + (((size_t)(t >> 8) * 2 + l) * 256 + (t & 255)) * 256 + kh * 128;
#pragma unroll
                    for (int a = 0; a < 2; ++a)
#pragma unroll
                        for (int hf = 0; hf < 2; ++hf) *(f32x4*)(ok + a * 64 + hf * 32 + 4 * hj) = (f32x4){x[(a * 2 + hf) * 4], x[(a * 2 + hf) * 4 + 1], x[(a * 2 + hf) * 4 + 2], x[(a * 2 + hf) * 4 + 3]};
                    store16h(KC + (size_t)t * 256 + kh * 128, hj, x);
                }
                if (lane >= 16 && lane < 48) {
                    float* ov = outv + (((size_t)(t >> 8) * 2 + l) * 256 + (t & 255)) * 256 + vi * 8;
                    *(f32x4*)ov = (f32x4){bf_lo(vw[0]), bf_hi(vw[0]), bf_lo(vw[1]), bf_hi(vw[1])};
                    *(f32x4*)(ov + 4) = (f32x4){bf_lo(vw[2]), bf_hi(vw[2]), bf_lo(vw[3]), bf_hi(vw[3])};
                    *(u32x4*)(VC + (size_t)t * 256 + vi * 8) = vw;
                }
            } else {
                rope16(x, rope, rowpos, colpos, hj);
                const size_t krow = ((size_t)bl * SKV_LAT + PAST + spos) * 256;
                if (lane < 16) store16h(KL + krow + kh * 128, hj, x);
                if (lane >= 16 && lane < 48) *(u32x4*)(VL + krow + vi * 8) = vw;
            }
            { u32x4 o; o.x = cvt_pk_bf16(pacc[0], pacc[1]); o.y = cvt_pk_bf16(pacc[2], pacc[3]); o.z = cvt_pk_bf16(pacc[4], pacc[5]); o.w = cvt_pk_bf16(pacc[6], pacc[7]);
              *(u32x4*)(Pr + PC_K + lane * 8) = o; }
        }
    }
}

__device__ __forceinline__ void phase_attn(Frame& F, int l, int part, const bool sgu_only_dry = false) {
    bf16_t* proj = (bf16_t*)(F.ws + WS_PROJ);
    const bf16_t* KL = (const bf16_t*)(F.ws + WS_KL); const bf16_t* VL = (const bf16_t*)(F.ws + WS_VL); const bf16_t* KC = (const bf16_t*)(F.ws + WS_KC); const bf16_t* VC = (const bf16_t*)(F.ws + WS_VC);
    const int lat_row0 = part == 0 ? T_CTX : 0;
    if (!sgu_only_dry) {
        int pair, idx, step; int rep = 0;
        const bool xcdmap = (F.G % 8) == 0;
        if (xcdmap) { pair = F.bx & 7; idx = F.bx >> 3; step = F.G >> 3; } else { pair = 0; idx = F.bx; step = F.G; }
        for (;;) {
            int pr = pair, ix = idx;
            if (!xcdmap) { pr = idx >> 6; ix = idx & 63; if (idx >= 512) break; } else if (idx >= 64) break;
            const int bl = pr >> 1, kvh = pr & 1, h = kvh * 4 + (ix >> 4), qb = ix & 15;
            bf16_t* Qb = proj + (size_t)(lat_row0 + bl * LAT_S + qb * 256) * NPROJ + PC_Q + h * 128;
            att::attn_dense_body(Qb, KL + (size_t)bl * SKV_LAT * 256 + kvh * 128, VL + (size_t)bl * SKV_LAT * 256 + kvh * 128, SKV_LAT, F.ldsg, F.tid, PROBE == 3 ? rep == 1 : true);
            if (PROBE == 3) { if (rep == 0) { rep = 1; continue; } rep = 0; }
            idx += step;
        }
    }
    if (part == 0 && !sgu_only_dry) {
        for (int u = F.bx; u < 128; u += F.G) { const int b = u >> 3, h = u & 7;
            bf16_t* Qb = proj + (size_t)(b * 256) * NPROJ + PC_Q + h * 128;
            att::attn_dense_body(Qb, KC + (size_t)b * 256 * 256 + (h >> 2) * 128, VC + (size_t)b * 256 * 256 + (h >> 2) * 128, CTX_S, F.ldsg, F.tid); }
    }
    const bf16_t* vrt = (const bf16_t*)(F.ws + WS_VRT);
    const bf16_t* wsb = (const bf16_t*)(F.ws + WS_WSGU) + (size_t)l * 65536;
    const float* bs = F.in[I_BSGU] + l * 512;
    const int nitem = (part_rows(part) / 128) * 32;
    const int ln = F.lane & 15, quad = F.lane >> 4;
    for (int it = F.gw; it < nitem; it += F.NGW) {
        const int chunk = it >> 5, g = (it >> 3) & 3, cb = (it >> 1) & 3, pb = it & 1;
        f32x4 acc[2][4];
#pragma unroll
        for (int a = 0; a < 2; ++a)
#pragma unroll
            for (int b = 0; b < 4; ++b) acc[a][b] = (f32x4){0.f, 0.f, 0.f, 0.f};
        const bf16_t* ap = vrt + ((size_t)chunk * 512 + g * 128 + cb * 32 + ln) * 128 + quad * 8;
        const bf16_t* bp = wsb + ((size_t)g * 128 + pb * 64 + ln) * 128 + quad * 8;
#pragma unroll
        for (int ks = 0; ks < 4; ++ks) {
            bf16x8 af[2], bfr[4];
#pragma unroll
            for (int ct = 0; ct < 2; ++ct) af[ct] = *(const bf16x8*)(ap + ct * 16 * 128 + ks * 32);
#pragma unroll
            for (int pt = 0; pt < 4; ++pt) bfr[pt] = *(const bf16x8*)(bp + pt * 16 * 128 + ks * 32);
#pragma unroll
            for (int ct = 0; ct < 2; ++ct)
#pragma unroll
                for (int pt = 0; pt < 4; ++pt) acc[ct][pt] = __builtin_amdgcn_mfma_f32_16x16x32_bf16(af[ct], bfr[pt], acc[ct][pt], 0, 0, 0);
        }
#pragma unroll
        for (int pt = 0; pt < 4; ++pt) { const int p = pb * 64 + pt * 16 + ln; const float bsv = bs[g * 128 + p];
#pragma unroll
            for (int ct = 0; ct < 2; ++ct) { const int c = g * 128 + cb * 32 + ct * 16 + quad * 4;
                bf16_t* up = proj + (size_t)(chunk * 128 + p) * NPROJ + PC_U + c;
                const u32x2 w = *(const u32x2*)up;
                const float u0 = gelu1(bf_lo(w.x)), u1 = gelu1(bf_hi(w.x)), u2 = gelu1(bf_lo(w.y)), u3 = gelu1(bf_hi(w.y));
                const f32x4 a = acc[ct][pt];
                u32x2 o; o.x = cvt_pk_bf16(u0 * (a[0] + bsv), u1 * (a[1] + bsv)); o.y = cvt_pk_bf16(u2 * (a[2] + bsv), u3 * (a[3] + bsv));
                if (!sgu_only_dry) *(u32x2*)up = o; else asm volatile("" :: "v"(o)); } }
    }
}

constexpr int NPL = 11, NPHASE = 2 + DEPTH * NPL;
__global__ void __launch_bounds__(NW * 64, 2) fwd_kernel(Args args) {
    extern __shared__ __attribute__((aligned(16))) unsigned char lds[];
    Frame F;
    F.lds = (LAS unsigned char*)lds; F.ldsg = (char*)lds;
    F.G = gridDim.x; F.bx = blockIdx.x; F.NGW = F.G * NW;
    F.in = args.in; F.ws = args.ws; F.out = args.out;
    const float* mod = (const float*)(F.ws + WS_MOD);
    bf16_t* act = (bf16_t*)(F.ws + WS_ACT); bf16_t* proj = (bf16_t*)(F.ws + WS_PROJ);
    volatile LAS unsigned* bst = (volatile LAS unsigned*)(F.lds + 131072 + 64);
    if (threadIdx.x < 2) bst[threadIdx.x] = 0u;
    unsigned* barw = (unsigned*)(F.ws + WS_BAR);
    if (blockIdx.x == 0 && args.ph_lo == 0) { for (int i = threadIdx.x; i < XCD_BAR_WORDS; i += NW * 64) barw[i] = 0u;
        unsigned* cw = (unsigned*)(F.ws + WS_CNT); for (int i = threadIdx.x; i < CNT_WORDS; i += NW * 64) cw[i] = 0u; }
    __syncthreads();
    XcdBarrier xbar; xbar.bar = barw; xbar.x = 0; xbar.st = bst;
    for (int ph = args.ph_lo; ph < args.ph_hi; ++ph) {
        { int tidv = threadIdx.x; asm volatile("" : "+v"(tidv));
          F.tid = tidv; F.lane = tidv & 63; F.wave = __builtin_amdgcn_readfirstlane(tidv >> 6); F.gw = F.bx * NW + F.wave; }

#ifndef PHMASK
#define PHMASK 0xffff
#endif
        if (ph == 0) { if (PHMASK & 1) phase_prologue(F); if (PROBE == 4) { __syncthreads(); phase_prologue(F); } }
        else if (ph == 1) { if (PHMASK & 2) phase_h0(F); if (PROBE == 4) phase_h0(F); }
        else {
            const int l = (ph - 2) / NPL, s = (ph - 2) % NPL;
            if (s < 8) {
                const int part = s >> 2, q = s & 3;
                if (q == 0) { if (PHMASK & 4) {
                    pg8::Gemm g{}; g.A = act + (size_t)part_row0(part) * DM; g.Bt = (const bf16_t*)(F.ws + WS_WIN) + (size_t)l * NPROJ * DM; g.lda = DM; g.ldb = DM;
                    g.nM = part_rows(part) / 256; g.nN = NPROJ / 256; g.nseg = 1; g.k0[0] = 0; g.nt[0] = 16; g.k0[1] = 0; g.nt[1] = 16; g.k0[2] = 0; g.nt[2] = 16;
                    pg8::Order S; S.init(g.nM, g.nN, 1, F.G, F.bx);
                    pg8::EpiStore E{proj, NPROJ};
                    if (PROBE == 2) { pg8::EpiNone E0; pg8::gemm_phase<pg8::EpiNone>(F.lds, g, S, E0, F.tid); }
                    pg8::gemm_phase<pg8::EpiStore>(F.lds, g, S, E, F.tid); }
                } else if (q == 1) { if (PROBE == 5) phase_mid(F, l, part, true); if (PHMASK & 8) phase_mid(F, l, part, false); }
                else if (q == 2) { if (PROBE == 6) phase_attn(F, l, part, true); if (PHMASK & 16) phase_attn(F, l, part, false); }
                else if (PHMASK & 32) {
                    pg8::Gemm g{}; g.A = proj; g.Bt = (const bf16_t*)(F.ws + WS_WM) + (size_t)l * DM * 2048; g.lda = NPROJ; g.ldb = 2048;
                    g.nM = part_rows(part) / 256; g.nN = 4; g.nseg = 3; g.k0[0] = 0; g.nt[0] = 16; g.k0[1] = 1024; g.nt[1] = 8; g.k0[2] = 1536; g.nt[2] = 8;
                    pg8::Order S; S.init(g.nM, g.nN, 3, F.G, F.bx);
                    pg8::EpiGate E{proj, act + (size_t)part_row0(part) * DM, DM};
                    if (PROBE == 2) { pg8::EpiNone E0; pg8::gemm_phase<pg8::EpiNone>(F.lds, g, S, E0, F.tid); }
                    pg8::gemm_phase<pg8::EpiGate>(F.lds, g, S, E, F.tid);
                }
            } else if (s == 8) { if (PHMASK & 64) {
                pg8::Gemm g{}; g.A = act; g.Bt = (const bf16_t*)(F.ws + WS_WOUT) + (size_t)l * DM * DM; g.lda = DM; g.ldb = DM;
                g.nM = T_ALL / 256; g.nN = 4; g.nseg = 1; g.k0[0] = 0; g.nt[0] = 16; g.k0[1] = 0; g.nt[1] = 16; g.k0[2] = 0; g.nt[2] = 16;
                pg8::Order S; S.init(g.nM, g.nN, 1, F.G, F.bx, 1);
                pg8::EpiResidLn<0> E{F.in, F.ws, F.out, l, F.lds + LDS_XCH};
                if (PROBE == 2) { pg8::EpiNone E0; pg8::gemm_phase<pg8::EpiNone>(F.lds, g, S, E0, F.tid); }
                pg8::gemm_phase<pg8::EpiResidLn<0>>(F.lds, g, S, E, F.tid); }
            } else if (s == 9) { if (PHMASK & 256) {
                pg8::Gemm g{}; g.A = act; g.Bt = (const bf16_t*)(F.ws + WS_WF1) + (size_t)l * 2 * DFF * DM; g.lda = DM; g.ldb = DM;
                g.nM = T_ALL / 256; g.nN = 2 * DFF / 256; g.nseg = 1; g.k0[0] = 0; g.nt[0] = 16; g.k0[1] = 0; g.nt[1] = 16; g.k0[2] = 0; g.nt[2] = 16;
                pg8::Order S; S.init(g.nM, g.nN, 1, F.G, F.bx);
                pg8::EpiSwiGLU E{proj, DFF};
                if (PROBE == 2) { pg8::EpiNone E0; pg8::gemm_phase<pg8::EpiNone>(F.lds, g, S, E0, F.tid); }
                pg8::gemm_phase<pg8::EpiSwiGLU>(F.lds, g, S, E, F.tid); }
            } else { if (PHMASK & 512) {
                pg8::Gemm g{}; g.A = proj; g.Bt = (const bf16_t*)(F.ws + WS_WF2) + (size_t)l * DM * DFF; g.lda = DFF; g.ldb = DFF;
                g.nM = T_ALL / 256; g.nN = 4; g.nseg = 1; g.k0[0] = 0; g.nt[0] = 44; g.k0[1] = 0; g.nt[1] = 44; g.k0[2] = 0; g.nt[2] = 44;
                pg8::Order S; S.init(g.nM, g.nN, 1, F.G, F.bx, 1);
                pg8::EpiResidLn<1> E{F.in, F.ws, F.out, l, F.lds + LDS_XCH};
                if (PROBE == 2) { pg8::EpiNone E0; pg8::gemm_phase<pg8::EpiNone>(F.lds, g, S, E0, F.tid); }
                pg8::gemm_phase<pg8::EpiResidLn<1>>(F.lds, g, S, E, F.tid); }
            }
        }
        if (ph + 1 < args.ph_hi) {
            if (ph == args.ph_lo) { cg::this_grid().sync(); xbar = xcd_barrier_post(barw, bst); }
            else xcd_barrier(xbar);
            if (PROBE == 1 && ph == 1) { for (int k = 0; k < 20; ++k) xcd_barrier(xbar); }
        }
    }
}

extern "C" void kernel_launch(void* const* d_in, const int* in_sizes, int n_in, void* d_out, int out_size, void* d_ws, size_t ws_size, hipStream_t stream) {
    static int grid = 0;
    if (grid == 0) {
        if (n_in != 25 || ws_size < WS_END) { fprintf(stderr, "kernel_launch: unexpected n_in %d / ws %zu\n", n_in, ws_size); grid = -1; return; }
        int dev = 0, cus = 0, per_cu = 0;
        if (hipGetDevice(&dev) != hipSuccess || hipDeviceGetAttribute(&cus, hipDeviceAttributeMultiprocessorCount, dev) != hipSuccess) { grid = -1; return; }
        if (hipFuncSetAttribute((const void*)fwd_kernel, hipFuncAttributeMaxDynamicSharedMemorySize, LDS_BYTES) != hipSuccess) { fprintf(stderr, "kernel_launch: hipFuncSetAttribute failed\n"); grid = -1; return; }
        if (hipOccupancyMaxActiveBlocksPerMultiprocessor(&per_cu, (const void*)fwd_kernel, NW * 64, LDS_BYTES) != hipSuccess || per_cu < 1) per_cu = 1;
        (void)hipGetLastError();
        grid = cus * (per_cu > 1 ? 1 : per_cu);
    }
    if (grid < 0) return;
    Args a{};
    for (int i = 0; i < 25; ++i) a.in[i] = (const float*)d_in[i];
    a.out = (float*)d_out; a.ws = (unsigned char*)d_ws;
#if MK_MULTI
    for (int ph = 0; ph < NPHASE; ++ph) { a.ph_lo = ph; a.ph_hi = ph + 1; hipLaunchKernelGGL(fwd_kernel, dim3(grid), dim3(NW * 64), LDS_BYTES, stream, a); }
#else
    a.ph_lo = 0; a.ph_hi = NPHASE;
    void* kargs[] = {&a};
    hipError_t e = hipLaunchCooperativeKernel((const void*)fwd_kernel, dim3(grid), dim3(NW * 64), kargs, LDS_BYTES, stream);
    if (e != hipSuccess) fprintf(stderr, "cooperative launch failed: %s (grid %d)\n", hipGetErrorString(e), grid);
#endif
}
```

```cpp
#include <hip/hip_runtime.h>
#include <hip/hip_bf16.h>
#include <hip/hip_cooperative_groups.h>
#include <cstdio>
#include <cstdint>
namespace cg = cooperative_groups;

#ifndef PROBE
#define PROBE 0
#endif
#ifndef STAGGER
#define STAGGER 0
#endif
#ifndef GATE_PF
#define GATE_PF true
#endif
#ifndef MK_MULTI
#define MK_MULTI 0
#endif

#define LAS __attribute__((address_space(3)))
typedef unsigned short bf16_t;
typedef short bf16x8 __attribute__((ext_vector_type(8)));
typedef short s16x4 __attribute__((ext_vector_type(4)));
typedef float f32x2 __attribute__((ext_vector_type(2)));
typedef float f32x4 __attribute__((ext_vector_type(4)));
typedef float f32x16 __attribute__((ext_vector_type(16)));
typedef unsigned u32x2 __attribute__((ext_vector_type(2)));
typedef unsigned u32x4 __attribute__((ext_vector_type(4)));

constexpr int DM = 1024, NPROJ = 6144, DFF = 2816, DEPTH = 2;
constexpr int T_CTX = 4096, T_ALL = 36864;
constexpr int CTX_S = 256, LAT_S = 4096, PAST = 512, SKV_LAT = 4608;
constexpr int PC_Q = 0, PC_U = 1024, PC_K = 1536, PC_V = 1792, PC_XV = 2048, PC_XP = 2560, PC_G = 3072;
constexpr float LN_EPS = 1e-6f;
constexpr float ALPHA = 1.41421356237309515f;
constexpr int NW = 8;
__host__ __device__ constexpr int part_row0(int p) { return p == 0 ? 0 : 20480; }
__host__ __device__ constexpr int part_rows(int p) { return p == 0 ? 20480 : 16384; }

constexpr size_t MiB = 1u << 20;
constexpr size_t WS_MOD = 0;
constexpr size_t WS_BAR = 448 * 1024;
constexpr size_t WS_ROPE = 512 * 1024;
constexpr size_t WS_WSGU = 768 * 1024;
constexpr size_t WS_WIN = 1 * MiB;
constexpr size_t WS_WM = 25 * MiB;
constexpr size_t WS_WOUT = 33 * MiB;
constexpr size_t WS_WF1 = 37 * MiB;
constexpr size_t WS_WF2 = 59 * MiB;
constexpr size_t WS_ACT = 70 * MiB;
constexpr size_t WS_PROJ = 142 * MiB;
constexpr size_t WS_KL = 382 * MiB, WS_VL = 391 * MiB;
constexpr size_t WS_KC = 400 * MiB, WS_VC = 402 * MiB;
constexpr size_t WS_VRT = 404 * MiB;
constexpr size_t WS_XBUF = 424 * MiB;
constexpr size_t WS_CNT = 426 * MiB;
constexpr int CNT_WORDS = 4 * 144 * 64;
constexpr size_t WS_END = 427 * MiB;

constexpr int LDS_BYTES = 143360;
constexpr int LDS_XCH = 131072 + 256;

__device__ __forceinline__ unsigned cvt_pk_bf16(float lo, float hi) { unsigned r; asm volatile("v_cvt_pk_bf16_f32 %0, %1, %2" : "=v"(r) : "v"(lo), "v"(hi)); return r; }
__device__ __forceinline__ float bf_lo(unsigned u) { return __uint_as_float(u << 16); }
__device__ __forceinline__ float bf_hi(unsigned u) { return __uint_as_float(u & 0xffff0000u); }
__device__ __forceinline__ float wave_sum(float v) {
#pragma unroll
    for (int o = 1; o < 64; o <<= 1) v += __shfl_xor(v, o);
    return v;
}
__device__ __forceinline__ float gelu1(float v) {
    const float av = fabsf(v), d = av * 0.2316418882f + 1.0f;
    const float t = __builtin_amdgcn_rcpf(d);
    float q = t * 0.5307027145f + (-0.7265760135f); q = q * t + 0.7107068705f; q = q * t + (-0.142248368f); q = q * t + 0.127414796f; q = q * t;
    const float e = __builtin_amdgcn_exp2f((v * v) * (-0.72134752044f));
    const float m = v * (q * e), r = v - m;
    return v < 0.f ? m : r;
}
__device__ __forceinline__ float sigmoidf_(float x) { return __builtin_amdgcn_rcpf(1.0f + __expf(-x)); }

namespace pg8 {
constexpr int BM = 256, BK = 64, HALF = 128, HTB = HALF * BK * 2, STAGE_BYTES = 8 * HTB, NXCD = 8, WGM = 8;
__host__ __device__ __forceinline__ int lds_byte(int r, int c) { const int st = (r >> 4) * 2 + (c >> 5), rr = r & 15, cc = c & 31, ob = rr * 64 + cc * 2; return st * 1024 + (ob ^ (((ob >> 9) & 1) << 5)); }
__host__ __device__ __forceinline__ void stage_rc(int b, int& R, int& C) { const int st = b / 1024, sb = b % 1024, swz = sb ^ (((sb >> 9) & 1) << 5); R = (st >> 1) * 16 + swz / 64; C = (st & 1) * 32 + (swz % 64) / 2; }
__host__ __device__ __forceinline__ int perm32(int rho) { const int n = rho >> 4, i = rho & 15; return 8 * (i >> 2) + 4 * n + (i & 3); }

struct Unit { int pm, pn, seg; };
struct Gemm { const bf16_t* A; const bf16_t* Bt; int lda, ldb, nM, nN, nseg; int k0[3]; int nt[3]; };

struct Order {
    int nM, nN, nwg, G, c, nseg, team, stagger;
    __device__ void init(int nM_, int nN_, int nseg_, int G_, int c_, int team_ = 0, int stagger_ = 0) { nM = nM_; nN = nN_; nwg = nM * nN; G = G_; c = c_; nseg = nseg_; team = team_; stagger = stagger_; }
    __device__ bool next(int i, Unit& u) const {
        if (team) {
            u.seg = 0; const int j = c >> 3; u.pn = j & 3; u.pm = i * (G >> 2) + (j >> 2) * 8 + (c & 7); return u.pm < nM;
        }
        const int ti = i / nseg; u.seg = i - ti * nseg;
        const long L = (long)ti * G + c; if (L >= nwg) return false;
        int wgid = (int)L; { const int q = nwg / NXCD, r = nwg % NXCD, xcd = wgid % NXCD, off = wgid / NXCD; wgid = (xcd < r ? xcd * (q + 1) : r * (q + 1) + (xcd - r) * q) + off; }
        const int nig = WGM * nN, gid = wgid / nig, fm = gid * WGM, gsz = (nM - fm) < WGM ? (nM - fm) : WGM;
        u.pm = fm + ((wgid % nig) % gsz); u.pn = (wgid % nig) / gsz; return true;
    }
};

struct EpiStore {
    static constexpr bool PREFETCH = false;
    static constexpr bool PERM = true;
    bf16_t* O; int ldc; int gate_col0;
    __device__ __forceinline__ void run(f32x4 (&acc)[2][2][4][2], const Unit& u, int wr, int wc, int fr, int fq) const {
        const int row0 = u.pm * BM + wr * 64 + fr; const int col0 = u.pn * BM + wc * 32 + 8 * fq;
        const bool gate = u.pn * BM >= gate_col0;
#pragma unroll
        for (int ai = 0; ai < 2; ++ai)
#pragma unroll
            for (int m = 0; m < 4; ++m) { bf16_t* rowp = O + (size_t)(row0 + ai * HALF + m * 16) * ldc + col0;
#pragma unroll
                for (int bj = 0; bj < 2; ++bj) { f32x4 v0 = acc[ai][bj][m][0], v1 = acc[ai][bj][m][1];
                    if (gate) {
#pragma unroll
                        for (int e = 0; e < 4; ++e) { v0[e] = 1.0f + __expf(-fmaxf(v0[e], -80.f)); v1[e] = 1.0f + __expf(-fmaxf(v1[e], -80.f)); } }
                    u32x4 w; w.x = cvt_pk_bf16(v0[0], v0[1]); w.y = cvt_pk_bf16(v0[2], v0[3]); w.z = cvt_pk_bf16(v1[0], v1[1]); w.w = cvt_pk_bf16(v1[2], v1[3]);
                    *(u32x4*)(rowp + bj * HALF) = w; } }
    }
};
struct EpiSwiGLU {
    static constexpr bool PREFETCH = false;
    static constexpr bool PERM = true;
    bf16_t* O; int ldc;
    __device__ __forceinline__ void run(f32x4 (&acc)[2][2][4][2], const Unit& u, int wr, int wc, int fr, int fq) const {
        const int row0 = u.pm * BM + wr * 64 + fr; const int col0 = u.pn * HALF + wc * 32 + 8 * fq;
#pragma unroll
        for (int ai = 0; ai < 2; ++ai)
#pragma unroll
            for (int m = 0; m < 4; ++m) { bf16_t* rowp = O + (size_t)(row0 + ai * HALF + m * 16) * ldc + col0;
                float o[8];
#pragma unroll
                for (int n = 0; n < 2; ++n)
#pragma unroll
                    for (int e = 0; e < 4; ++e) { const float a = acc[ai][0][m][n][e], b = acc[ai][1][m][n][e]; o[n * 4 + e] = a * sigmoidf_(a) * b; }
                u32x4 w; w.x = cvt_pk_bf16(o[0], o[1]); w.y = cvt_pk_bf16(o[2], o[3]); w.z = cvt_pk_bf16(o[4], o[5]); w.w = cvt_pk_bf16(o[6], o[7]);
                *(u32x4*)rowp = w; }
    }
};
struct EpiResid {
    static constexpr bool PREFETCH = false;
    static constexpr bool PERM = false;
    const float* xres_ctx; const float* xres_lat;
    float* out; const float* mod; int goff;
    __device__ __forceinline__ void run(f32x4 (&acc)[2][2][4][2], const Unit& u, int wr, int wc, int fr, int fq) const {
        const int v = u.pm < 16 ? 0 : 1 + ((u.pm - 16) >> 4);
        const float* xb = u.pm < 16 ? xres_ctx + (size_t)u.pm * BM * DM : xres_lat + (size_t)(u.pm - 16) * BM * DM;
        float* ob = out + (size_t)u.pm * BM * DM;
        const int col0 = u.pn * BM + wc * 32 + 4 * fq;
        const float* gp = mod + v * 6144 + goff + col0;
        f32x4 gv[2][2];
#pragma unroll
        for (int bj = 0; bj < 2; ++bj)
#pragma unroll
            for (int n = 0; n < 2; ++n) gv[bj][n] = *(const f32x4*)(gp + bj * HALF + n * 16);
#pragma unroll
        for (int ai = 0; ai < 2; ++ai)
#pragma unroll
            for (int m = 0; m < 4; ++m) { const size_t off = (size_t)(ai * HALF + wr * 64 + m * 16 + fr) * DM + col0;
#pragma unroll
                for (int bj = 0; bj < 2; ++bj)
#pragma unroll
                    for (int n = 0; n < 2; ++n) { const f32x4 x = *(const f32x4*)(xb + off + bj * HALF + n * 16);
                        *(f32x4*)(ob + off + bj * HALF + n * 16) = x * ALPHA + gv[bj][n] * acc[ai][bj][m][n]; } }
    }
};

struct PanelStats {
    unsigned long long* xbuf;
    unsigned* cnt;
    LAS unsigned char* lx;
    __device__ __forceinline__ void run(const f32x4 (&v)[2][2][4][2], const Unit& u, int wr, int wc, int fr, int fq, int wid, int lane) const {
        LAS f32x2* P = (LAS f32x2*)lx; LAS f32x2* S = (LAS f32x2*)(lx + 8192);
#pragma unroll
        for (int ai = 0; ai < 2; ++ai)
#pragma unroll
            for (int m = 0; m < 4; ++m) {
                float s = 0.f;
#pragma unroll
                for (int bj = 0; bj < 2; ++bj)
#pragma unroll
                    for (int n = 0; n < 2; ++n) { const f32x4 x = v[ai][bj][m][n]; s += (x[0] + x[1]) + (x[2] + x[3]); }
                s += __shfl_xor(s, 16); s += __shfl_xor(s, 32);
                const float mw = s * (1.0f / 64.0f); float q = 0.f;
#pragma unroll
                for (int bj = 0; bj < 2; ++bj)
#pragma unroll
                    for (int n = 0; n < 2; ++n) { const f32x4 d = v[ai][bj][m][n] - mw; q += (d[0] * d[0] + d[1] * d[1]) + (d[2] * d[2] + d[3] * d[3]); }
                q += __shfl_xor(q, 16); q += __shfl_xor(q, 32);
                if (fq == 0) P[(ai * HALF + wr * 64 + m * 16 + fr) * 4 + wc] = (f32x2){mw, q};
            }
        asm volatile("s_waitcnt lgkmcnt(0)" ::: "memory"); __builtin_amdgcn_s_barrier(); asm volatile("" ::: "memory");
        const int row = wid * 32 + (lane & 31);
        if (lane < 32) {
            const f32x2 a = P[row * 4 + 0], b = P[row * 4 + 1], c = P[row * 4 + 2], d = P[row * 4 + 3];
            const float mt = (a.x + b.x + c.x + d.x) * 0.25f;
            const float da = a.x - mt, db = b.x - mt, dc = c.x - mt, dd = d.x - mt;
            const float m2 = (a.y + b.y) + (c.y + d.y) + 64.0f * ((da * da + db * db) + (dc * dc + dd * dd));
            unsigned long long* slot = xbuf + ((size_t)(u.pm * BM + row) * 4 + u.pn);
            __hip_atomic_store(slot, ((unsigned long long)__float_as_uint(m2) << 32) | __float_as_uint(mt), __ATOMIC_RELAXED, __HIP_MEMORY_SCOPE_AGENT);
        }
        asm volatile("s_waitcnt vmcnt(0)" ::: "memory");
        if (lane == 0) __hip_atomic_fetch_add(cnt + 64 * u.pm, 1u, __ATOMIC_RELAXED, __HIP_MEMORY_SCOPE_AGENT);
        if (wid == 0) {
            unsigned sp = 0;
            for (;;) {
                if ((unsigned)__builtin_amdgcn_readfirstlane(__hip_atomic_load(cnt + 64 * u.pm, __ATOMIC_RELAXED, __HIP_MEMORY_SCOPE_AGENT)) >= 32u) break;
                if (++sp > (1u << 22)) break;
                __builtin_amdgcn_s_sleep(2);
            }
            __builtin_amdgcn_fence(__ATOMIC_ACQUIRE, "agent");
        }
        asm volatile("s_waitcnt vmcnt(0) lgkmcnt(0)" ::: "memory"); __builtin_amdgcn_s_barrier(); asm volatile("" ::: "memory");
        if (lane < 32) {
            const unsigned long long* slot = xbuf + (size_t)(u.pm * BM + row) * 4; float mt[4], m2[4]; float ms = 0.f;
#pragma unroll
            for (int t = 0; t < 4; ++t) { const unsigned long long w = __hip_atomic_load(slot + t, __ATOMIC_RELAXED, __HIP_MEMORY_SCOPE_AGENT); mt[t] = __uint_as_float((unsigned)w); m2[t] = __uint_as_float((unsigned)(w >> 32)); ms += mt[t]; }
            const float mean = ms * 0.25f; float q = 0.f;
#pragma unroll
            for (int t = 0; t < 4; ++t) { const float dm = mt[t] - mean; q += m2[t] + 256.0f * dm * dm; }
            S[row] = (f32x2){mean, rsqrtf(q * (1.0f / 1024.0f) + LN_EPS)};
        }
        asm volatile("s_waitcnt lgkmcnt(0)" ::: "memory"); __builtin_amdgcn_s_barrier(); asm volatile("" ::: "memory");
    }
};
template <int WHICH>
struct EpiResidLn {
    static constexpr bool PERM = false;
    static constexpr bool PREFETCH = false;
    const float* const* in; unsigned char* ws; float* out_; int l; LAS unsigned char* lx;
    __device__ __forceinline__ void prefetch(const Unit& u, int it, int nit, int wid, int lane_) const {
        int lane = lane_; asm volatile("" : "+v"(lane));
        const float* xb = (WHICH == 0 && l == 0) ? (u.pm < 16 ? in[0] + (size_t)u.pm * BM * DM : in[1] + (size_t)(u.pm - 16) * BM * DM) : out_ + (size_t)u.pm * BM * DM;
        const int R = nit >= 16 ? 2 : 4;
#pragma unroll
        for (int k = 0; k < 4; ++k) { const int j = it * R + k;
            if (k < R && j < 32) __builtin_amdgcn_global_load_lds((const unsigned*)(xb + (size_t)(j * 8 + wid) * DM + u.pn * BM + lane * 4), (LAS unsigned*)(lx + 10240), 16, 0, 0); }
    }
    __device__ __forceinline__ void run(f32x4 (&acc)[2][2][4][2], const Unit& u, int wr, int wc, int fr_, int fq_) const {
        int fr = fr_, fq = fq_; asm volatile("" : "+v"(fr), "+v"(fq));
        int lv = l; asm volatile("" : "+v"(lv)); lv = __builtin_amdgcn_readfirstlane(lv);
        const float* mod = (const float*)(ws + 0) + lv * 9 * 6144;
        float* out = out_;
        const float* xres_ctx = (WHICH == 0 && lv == 0) ? in[0] : out;
        const float* xres_lat = (WHICH == 0 && lv == 0) ? in[1] : out + (size_t)T_CTX * DM;
        const int goff = WHICH == 0 ? 2048 : 5120;
        const float* lg = in[WHICH == 0 ? 19 : 23] + lv * DM; const float* lb = in[WHICH == 0 ? 20 : 24] + lv * DM;
        bf16_t* act = (bf16_t*)(ws + (size_t)70 * 1048576);
        const float* modn = WHICH == 0 ? mod : (const float*)(ws + 0) + (lv + 1 < DEPTH ? lv + 1 : lv) * 9 * 6144;
        const int sh_off = WHICH == 0 ? 3072 : 0, sc_off = WHICH == 0 ? 4096 : 1024;
        PanelStats st{(unsigned long long*)(ws + (size_t)424 * 1048576), (unsigned*)(ws + (size_t)426 * 1048576) + (lv * 2 + WHICH) * 144 * 64, lx};
        const int v = u.pm < 16 ? 0 : 1 + ((u.pm - 16) >> 4);
        const float* xb = u.pm < 16 ? xres_ctx + (size_t)u.pm * BM * DM : xres_lat + (size_t)(u.pm - 16) * BM * DM;
        float* ob = out + (size_t)u.pm * BM * DM;
        const int col0 = u.pn * BM + wc * 32 + 4 * fq;
        const size_t roff = (size_t)(wr * 64 + fr) * DM + col0;
        {
            const float* gp = mod + v * 6144 + goff + col0;
#pragma unroll
            for (int bj = 0; bj < 2; ++bj)
#pragma unroll
                for (int n = 0; n < 2; ++n) { const f32x4 gv = *(const f32x4*)(gp + bj * HALF + n * 16);
#pragma unroll
                    for (int ai = 0; ai < 2; ++ai) {
#pragma unroll
                        for (int m = 0; m < 4; ++m) { const f32x4 x = *(const f32x4*)(xb + roff + (size_t)(ai * HALF + m * 16) * DM + bj * HALF + n * 16); acc[ai][bj][m][n] = x * ALPHA + gv * acc[ai][bj][m][n]; }
#pragma unroll
                        for (int m = 0; m < 4; ++m) asm volatile("" : "+v"(acc[ai][bj][m][n]));
                        asm volatile("" ::: "memory"); } }
        }
        const int lane = fq * 16 + fr, wid = wr * 4 + wc;
        st.run(acc, u, wr, wc, fr, fq, wid, lane);
        const LAS f32x2* S = (const LAS f32x2*)(st.lx + 8192);
        const float* mv = modn + v * 6144;
#pragma unroll
        for (int bj = 0; bj < 2; ++bj)
#pragma unroll
            for (int n = 0; n < 2; ++n) { const int c = col0 + bj * HALF + n * 16;
                const f32x4 g4 = *(const f32x4*)(lg + c), b4 = *(const f32x4*)(lb + c);
                f32x4 sh = (f32x4){0.f, 0.f, 0.f, 0.f}, sc = sh;
                sh = *(const f32x4*)(mv + sh_off + c); sc = *(const f32x4*)(mv + sc_off + c) + 1.0f;
#pragma unroll
                for (int ai = 0; ai < 2; ++ai)
#pragma unroll
                    for (int m = 0; m < 4; ++m) { const size_t off = roff + (size_t)(ai * HALF + m * 16) * DM + bj * HALF + n * 16;
                        const f32x2 sr = S[ai * HALF + wr * 64 + m * 16 + fr];
                        const f32x4 y = (acc[ai][bj][m][n] - sr.x) * sr.y * g4 + b4;
                        *(f32x4*)(ob + off) = y;
                        { const f32x4 h = y * sc + sh; u32x2 w; w.x = cvt_pk_bf16(h[0], h[1]); w.y = cvt_pk_bf16(h[2], h[3]);
                            *(u32x2*)(act + (size_t)u.pm * BM * DM + off) = w; } }
                asm volatile("" ::: "memory"); }
    }
};
struct EpiGate {
    static constexpr bool PERM = true;
    static constexpr bool PREFETCH = GATE_PF;
    LAS unsigned char* lx;
    __device__ __forceinline__ void prefetch(const Unit& u, int it, int nit, int wid, int lane_) const {
        if (u.seg == 2) return;
        int lane = lane_; asm volatile("" : "+v"(lane));
        const char* base = (const char*)(P + (size_t)u.pm * BM * NPROJ + PC_G + u.pn * BM);
        const unsigned lo = (unsigned)(((wid * 2 + (lane >> 5)) * NPROJ + (lane & 31) * 8) * 2);
#pragma unroll
        for (int k = 0; k < 4; ++k) { const int j = it * 4 + k;
            const int goff = u.seg == 0 ? ((j >> 4) == 0 ? 0 : 2048) : 1024; const int jr = j & 15;
            if (j < (u.seg == 0 ? 32 : 16)) __builtin_amdgcn_global_load_lds((const unsigned*)(base + (size_t)(jr * 16 * NPROJ + goff) * 2 + lo), (LAS unsigned*)(lx + 10240), 16, 0, 0); }
    }
    const bf16_t* P;
    bf16_t* O; int ldc;
    __device__ __forceinline__ void run(f32x4 (&acc)[2][2][4][2], const Unit& u, int wr, int wc, int fr, int fq) const {
        const int row0 = u.pm * BM + wr * 64 + fr; const int col0 = u.pn * BM + wc * 32 + 8 * fq;
        const int noff = u.seg == 0 ? 0 : (u.seg == 1 ? 2048 : 1024), doff = u.seg == 0 ? 2048 : 1024;
        const bool last = u.seg == 2;
#pragma unroll
        for (int ai = 0; ai < 2; ++ai)
#pragma unroll
            for (int m = 0; m < 4; ++m) { const size_t r = (size_t)(row0 + ai * HALF + m * 16);
                const bf16_t* gp = P + r * NPROJ + PC_G + col0;
#pragma unroll
                for (int bj = 0; bj < 2; ++bj) {
                    const u32x4 gn = *(const u32x4*)(gp + noff + bj * HALF);
                    u32x4 gd = gn; if (!last) gd = *(const u32x4*)(gp + doff + bj * HALF);
                    float f[8];
#pragma unroll
                    for (int e = 0; e < 4; ++e) {
                        const float r0 = __builtin_amdgcn_rcpf(bf_lo(gn[e])), r1 = __builtin_amdgcn_rcpf(bf_hi(gn[e]));
                        if (last) { f[2 * e] = r0; f[2 * e + 1] = r1; }
                        else { f[2 * e] = bf_lo(gd[e]) * r0; f[2 * e + 1] = bf_hi(gd[e]) * r1; }
                    }
                    f32x4 v0 = acc[ai][bj][m][0], v1 = acc[ai][bj][m][1];
                    v0[0] *= f[0]; v0[1] *= f[1]; v0[2] *= f[2]; v0[3] *= f[3]; v1[0] *= f[4]; v1[1] *= f[5]; v1[2] *= f[6]; v1[3] *= f[7];
                    if (last) { u32x4 w; w.x = cvt_pk_bf16(v0[0], v0[1]); w.y = cvt_pk_bf16(v0[2], v0[3]); w.z = cvt_pk_bf16(v1[0], v1[1]); w.w = cvt_pk_bf16(v1[2], v1[3]);
                        *(u32x4*)(O + r * ldc + col0 + bj * HALF) = w; }
                    else { acc[ai][bj][m][0] = v0; acc[ai][bj][m][1] = v1; }
                } }
    }
};

struct EpiNone { static constexpr bool PREFETCH = false; static constexpr bool PERM = true; __device__ __forceinline__ void run(f32x4 (&acc)[2][2][4][2], const Unit& u, int wr, int wc, int fr, int fq) const {
    _Pragma("unroll") for (int a = 0; a < 2; ++a) _Pragma("unroll") for (int b = 0; b < 2; ++b) _Pragma("unroll") for (int m = 0; m < 4; ++m) _Pragma("unroll") for (int n = 0; n < 2; ++n) asm volatile("" :: "v"(acc[a][b][m][n])); } };
template <class Epi>
__device__ __forceinline__ void gemm_phase(LAS unsigned char* lds, const Gemm g, const Order& S, const Epi& E, const int tid) {
    const int wid = __builtin_amdgcn_readfirstlane(tid >> 6), lane = tid & 63, wr = wid >> 2, wc = wid & 3, fr = lane & 15, fq = lane >> 4;
    unsigned voffA[2], voffB[2];
#pragma unroll
    for (int i = 0; i < 2; ++i) { int R, C; stage_rc(tid * 16 + i * 8192, R, C); const int Rb = Epi::PERM ? ((R & ~31) + perm32(R & 31)) : R;
        voffA[i] = (unsigned)(R * g.lda + C) * 2u; voffB[i] = (unsigned)(Rb * g.ldb + C) * 2u; }
    const size_t kstep = (size_t)(BK * 2);
    const size_t hstepA = (size_t)HALF * g.lda * 2, hstepB = (size_t)HALF * g.ldb * 2;
    const size_t tstepA = 2 * hstepA, tstepB = 2 * hstepB;
    const unsigned ldsw = (unsigned)wid * 1024u;
    const int aoff = lds_byte(wr * 64 + fr, fq * 8), boff = lds_byte(wc * 32 + fr, fq * 8);
#define PG8_SA(b, h) (((b) * 2 + (h)) * HTB)
#define PG8_SB(b, h) ((4 + (b) * 2 + (h)) * HTB)
#define PG8_STAGE(bufoff, gbase, voff) do { _Pragma("unroll") for (int _i = 0; _i < 2; ++_i) \
        __builtin_amdgcn_global_load_lds((const unsigned*)((const char*)(gbase) + (voff)[_i]), (LAS unsigned*)(lds + (bufoff) + ldsw + _i * 8192), 16, 0, 0); } while (0)
#define PG8_LDA(dst, b, h) do { _Pragma("unroll") for (int m = 0; m < 4; ++m) _Pragma("unroll") for (int k = 0; k < 2; ++k) dst[m][k] = *(const LAS bf16x8*)(lds + PG8_SA(b, h) + aoff + m * 2048 + k * 1024); } while (0)
#define PG8_LDB(dst, b, h) do { _Pragma("unroll") for (int n = 0; n < 2; ++n) _Pragma("unroll") for (int k = 0; k < 2; ++k) dst[n][k] = *(const LAS bf16x8*)(lds + PG8_SB(b, h) + boff + n * 2048 + k * 1024); } while (0)
#define PG8_MMA(ai, bj, At, Bt) do { __builtin_amdgcn_s_setprio(1); _Pragma("unroll") for (int m = 0; m < 4; ++m) _Pragma("unroll") for (int n = 0; n < 2; ++n) _Pragma("unroll") for (int k = 0; k < 2; ++k) \
        acc[ai][bj][m][n] = __builtin_amdgcn_mfma_f32_16x16x32_bf16(Bt[n][k], At[m][k], acc[ai][bj][m][n], 0, 0, 0); __builtin_amdgcn_s_setprio(0); } while (0)
#define PG8_WAIT_V(n) asm volatile("s_waitcnt vmcnt(" #n ")" ::: "memory")
#define PG8_WAIT_L(n) asm volatile("s_waitcnt lgkmcnt(" #n ")" ::: "memory")
#define PG8_BAR __builtin_amdgcn_s_barrier()
#define PG8_SCHED __builtin_amdgcn_sched_barrier(0)
#define KOF(sg) ((sg) == 0 ? g.k0[0] : ((sg) == 1 ? g.k0[1] : g.k0[2]))
#define NTF(sg) ((sg) == 0 ? g.nt[0] : ((sg) == 1 ? g.nt[1] : g.nt[2]))
    Unit cur, nxt; int ui = 0;
    if (!S.next(0, cur)) return;
    if (S.stagger) {
        const int mine = (S.nwg - S.c + S.G - 1) / S.G, mx = (S.nwg + S.G - 1) / S.G;
        if (mine < mx) { const unsigned long long t0 = __builtin_amdgcn_s_memrealtime(); while (__builtin_amdgcn_s_memrealtime() - t0 < (unsigned long long)S.stagger) __builtin_amdgcn_s_sleep(16); }
    }
    f32x4 acc[2][2][4][2];
#pragma unroll
    for (int a = 0; a < 2; ++a)
#pragma unroll
        for (int b = 0; b < 2; ++b)
#pragma unroll
            for (int m = 0; m < 4; ++m)
#pragma unroll
                for (int n = 0; n < 2; ++n) acc[a][b][m][n] = (f32x4){0.f, 0.f, 0.f, 0.f};
    bf16x8 At[4][2], B0[2][2], B1[2][2];
    const char* cA = (const char*)g.A + (size_t)cur.pm * tstepA + (size_t)KOF(cur.seg) * 2; const char* cB = (const char*)g.Bt + (size_t)cur.pn * tstepB + (size_t)KOF(cur.seg) * 2;
    PG8_STAGE(PG8_SB(0, 0), cB, voffB); PG8_STAGE(PG8_SB(0, 1), cB + hstepB, voffB); PG8_STAGE(PG8_SA(0, 0), cA, voffA); PG8_STAGE(PG8_SA(0, 1), cA + hstepA, voffA);
    if (wr == 1) PG8_BAR;
    PG8_WAIT_V(2); PG8_BAR;
    PG8_STAGE(PG8_SB(1, 0), cB + kstep, voffB); PG8_STAGE(PG8_SA(1, 0), cA + kstep, voffA); PG8_STAGE(PG8_SB(1, 1), cB + hstepB + kstep, voffB);
    PG8_WAIT_V(6); PG8_BAR;
    for (;;) {
        const bool has_next = S.next(ui + 1, nxt);
        const int nt = NTF(cur.seg);
        const char* nA = has_next ? (const char*)g.A + (size_t)nxt.pm * tstepA + (size_t)KOF(nxt.seg) * 2 : cA;
        const char* nB = has_next ? (const char*)g.Bt + (size_t)nxt.pn * tstepB + (size_t)KOF(nxt.seg) * 2 : cB;
        for (int t = 0; t < nt; t += 2) {
            const bool last = (t == nt - 2);
            const char* a1 = cA + (size_t)(t + 1) * kstep;
            const char* a2 = last ? nA : cA + (size_t)(t + 2) * kstep; const char* b2 = last ? nB : cB + (size_t)(t + 2) * kstep;
            const char* a3 = a2 + kstep; const char* b3 = b2 + kstep;
            PG8_LDB(B0, 0, 0); PG8_LDB(B1, 0, 1); PG8_SCHED; PG8_LDA(At, 0, 0); PG8_STAGE(PG8_SA(1, 1), a1 + hstepA, voffA);
            if constexpr (Epi::PREFETCH) E.prefetch(cur, t >> 1, nt >> 1, wid, lane);
            PG8_WAIT_V(8); PG8_WAIT_L(0); PG8_BAR; PG8_MMA(0, 0, At, B0); PG8_MMA(0, 1, At, B1); PG8_BAR; PG8_SCHED;
            PG8_LDA(At, 0, 1); PG8_STAGE(PG8_SB(0, 0), b2, voffB); PG8_STAGE(PG8_SB(0, 1), b2 + hstepB, voffB); PG8_STAGE(PG8_SA(0, 0), a2, voffA);
            PG8_WAIT_V(8); PG8_WAIT_L(0); PG8_BAR; PG8_MMA(1, 0, At, B0); PG8_MMA(1, 1, At, B1); PG8_BAR; PG8_SCHED;
            PG8_LDB(B0, 1, 0); PG8_LDB(B1, 1, 1); PG8_SCHED; PG8_LDA(At, 1, 0); PG8_STAGE(PG8_SA(0, 1), a2 + hstepA, voffA);
            PG8_WAIT_V(8); PG8_WAIT_L(0); PG8_BAR; PG8_MMA(0, 0, At, B0); PG8_MMA(0, 1, At, B1); PG8_BAR; PG8_SCHED;
            PG8_LDA(At, 1, 1); PG8_STAGE(PG8_SB(1, 0), b3, voffB); PG8_STAGE(PG8_SB(1, 1), b3 + hstepB, voffB); PG8_STAGE(PG8_SA(1, 0), a3, voffA);
            PG8_WAIT_V(8); PG8_WAIT_L(0); PG8_BAR; PG8_MMA(1, 0, At, B0); PG8_MMA(1, 1, At, B1); PG8_BAR; PG8_SCHED;
        }
        if (wr == 0) PG8_BAR;
        E.run(acc, cur, wr, wc, fr, fq);
        if (!has_next) break;
        if (cur.seg == g.nseg - 1) {
#pragma unroll
            for (int a = 0; a < 2; ++a)
#pragma unroll
                for (int b = 0; b < 2; ++b)
#pragma unroll
                    for (int m = 0; m < 4; ++m)
#pragma unroll
                        for (int n = 0; n < 2; ++n) acc[a][b][m][n] = (f32x4){0.f, 0.f, 0.f, 0.f};
        }
        cur = nxt; cA = nA; cB = nB; ++ui;
        if (wr == 1) PG8_BAR;
    }
    PG8_WAIT_V(0);
    PG8_BAR;
#undef KOF
#undef NTF
#undef PG8_SA
#undef PG8_SB
#undef PG8_STAGE
#undef PG8_LDA
#undef PG8_LDB
#undef PG8_MMA
#undef PG8_WAIT_V
#undef PG8_WAIT_L
#undef PG8_BAR
#undef PG8_SCHED
}
}

namespace att {
constexpr int D = 128, QBLK = 32, KVBLK = 64;
constexpr float SCALE = 0.088388347648318440f;
constexpr float THR = 8.f;
constexpr size_t SHM_V = KVBLK * D * 2, SHM_K = KVBLK * D * 2, SHM_ATTN = 2 * SHM_V + 2 * SHM_K + NW * 64 * 4;
#define KSWZ(row, colB) ((row) * 256 + ((colB) ^ (((row) & 7) << 4)))
#define SBAR() __builtin_amdgcn_sched_barrier(0)
__device__ __forceinline__ int crow(int r, int hi) { return (r & 3) + 8 * (r >> 2) + 4 * hi; }
__device__ __forceinline__ unsigned cvtpk(float lo, float hi) { unsigned r; asm volatile("v_cvt_pk_bf16_f32 %0, %1, %2" : "=v"(r) : "v"(lo), "v"(hi)); return r; }
__device__ __forceinline__ void partialSM(f32x16& p0, f32x16& p1, float& m_reg, float& mn, float& alpha) {
  constexpr float C = SCALE * 1.4426950408889634f;
  float pmax = p0[0];
#pragma unroll
  for (int r = 1; r < 16; ++r) pmax = fmaxf(pmax, p0[r]);
#pragma unroll
  for (int r = 0; r < 16; ++r) pmax = fmaxf(pmax, p1[r]);
  { auto rr = __builtin_amdgcn_permlane32_swap(__float_as_uint(pmax), __float_as_uint(pmax), false, false);
    pmax = fmaxf(__uint_as_float(rr[0]), __uint_as_float(rr[1])); }
  if (__builtin_expect(__all(pmax - m_reg <= THR / SCALE), 1)) { mn = m_reg; alpha = 1.f; }
  else { mn = fmaxf(m_reg, pmax); alpha = __builtin_amdgcn_exp2f((m_reg - mn) * C); m_reg = mn; }
  float mnC = -mn * C;
#pragma unroll
  for (int r = 0; r < 16; ++r) p0[r] = fmaf(p0[r], C, mnC);
#pragma unroll
  for (int r = 0; r < 16; ++r) p1[r] = fmaf(p1[r], C, mnC);
#pragma unroll
  for (int r = 0; r < 16; ++r) p0[r] = __builtin_amdgcn_exp2f(p0[r]);
}
__device__ __forceinline__ void finishSM(f32x16& p0, f32x16& p1, float alpha, float& l_reg, bf16x8& pa0, bf16x8& pa1, bf16x8& pa2, bf16x8& pa3) {
#pragma unroll
  for (int r = 0; r < 16; ++r) p1[r] = __builtin_amdgcn_exp2f(p1[r]);
  float ps = 0;
#pragma unroll
  for (int r = 0; r < 16; ++r) ps += p0[r];
#pragma unroll
  for (int r = 0; r < 16; ++r) ps += p1[r];
  { auto rr = __builtin_amdgcn_permlane32_swap(__float_as_uint(ps), __float_as_uint(ps), false, false);
    ps = __uint_as_float(rr[0]) + __uint_as_float(rr[1]); }
  l_reg = l_reg * alpha + ps;
#define PK4(P, BASE, OUT) do { unsigned a0 = cvtpk(P[BASE + 0], P[BASE + 1]), a1 = cvtpk(P[BASE + 2], P[BASE + 3]);   \
    unsigned b0 = cvtpk(P[BASE + 4], P[BASE + 5]), b1 = cvtpk(P[BASE + 6], P[BASE + 7]);                              \
    auto r0 = __builtin_amdgcn_permlane32_swap(a0, b0, false, false); auto r1 = __builtin_amdgcn_permlane32_swap(a1, b1, false, false); \
    u32x4 w = {r0[0], r1[0], r0[1], r1[1]}; OUT = *reinterpret_cast<bf16x8*>(&w); } while (0)
  PK4(p0, 0, pa0); PK4(p0, 8, pa1); PK4(p1, 0, pa2); PK4(p1, 8, pa3);
#undef PK4
}
__device__ __forceinline__ void qkt(f32x16& p0, f32x16& p1, const bf16_t* Ks, const bf16x8* qr, int r32, int hi) {
  p0 = f32x16{}; p1 = f32x16{};
#pragma unroll
  for (int d0 = 0; d0 < 8; ++d0) { int cb = (d0 * 16 + hi * 8) * 2;
    bf16x8 b0 = *reinterpret_cast<const bf16x8*>((const char*)Ks + KSWZ(r32, cb));
    bf16x8 b1 = *reinterpret_cast<const bf16x8*>((const char*)Ks + KSWZ(32 + r32, cb));
    p0 = __builtin_amdgcn_mfma_f32_32x32x16_bf16(b0, qr[d0], p0, 0, 0, 0);
    p1 = __builtin_amdgcn_mfma_f32_32x32x16_bf16(b1, qr[d0], p1, 0, 0, 0); }
}
__device__ __forceinline__ int v_st(int k, int c) { const int kk = (k & ~0xC) | ((k & 4) << 1) | ((k & 8) >> 1); return ((kk >> 3) * 4 + (c >> 5)) * 512 + ((kk & 7) * 32 + (c & 31)) * 2; }
__device__ __forceinline__ int v_rd_base(int lane) { return ((lane & 3) << 3) | (((lane >> 2) & 3) << 6) | (((lane >> 4) & 1) << 5) | (((lane >> 5) & 1) << 8); }
constexpr int v_rd_off(int d0, int ks, int half) { return d0 * 512 + ks * 4096 + half * 2048; }
template <int OFF> __device__ __forceinline__ s16x4 tr_read(int vb) {
  s16x4 r; asm volatile("ds_read_b64_tr_b16 %0, %1 offset:%2" : "=&v"(r) : "v"(vb), "i"(OFF) : "memory"); return r;
}
template <int D0> __device__ __forceinline__ void pv_one(f32x16& od, int vb, bf16x8 pa0, bf16x8 pa1, bf16x8 pa2, bf16x8 pa3) {
  const s16x4 l0 = tr_read<v_rd_off(D0, 0, 0)>(vb), h0 = tr_read<v_rd_off(D0, 0, 1)>(vb), l1 = tr_read<v_rd_off(D0, 1, 0)>(vb), h1 = tr_read<v_rd_off(D0, 1, 1)>(vb);
  const s16x4 l2 = tr_read<v_rd_off(D0, 2, 0)>(vb), h2 = tr_read<v_rd_off(D0, 2, 1)>(vb), l3 = tr_read<v_rd_off(D0, 3, 0)>(vb), h3 = tr_read<v_rd_off(D0, 3, 1)>(vb);
  asm volatile("s_waitcnt lgkmcnt(0)" ::: "memory"); SBAR();
#define PK(L, H) (bf16x8){L[0], L[1], L[2], L[3], H[0], H[1], H[2], H[3]}
  od = __builtin_amdgcn_mfma_f32_32x32x16_bf16(pa0, PK(l0, h0), od, 0, 0, 0);
  od = __builtin_amdgcn_mfma_f32_32x32x16_bf16(pa1, PK(l1, h1), od, 0, 0, 0);
  od = __builtin_amdgcn_mfma_f32_32x32x16_bf16(pa2, PK(l2, h2), od, 0, 0, 0);
  od = __builtin_amdgcn_mfma_f32_32x32x16_bf16(pa3, PK(l3, h3), od, 0, 0, 0);
#undef PK
}
__device__ __forceinline__ void pv_d0(f32x16* o, int vb, bf16x8 pa0, bf16x8 pa1, bf16x8 pa2, bf16x8 pa3) {
  pv_one<0>(o[0], vb, pa0, pa1, pa2, pa3); pv_one<1>(o[1], vb, pa0, pa1, pa2, pa3); pv_one<2>(o[2], vb, pa0, pa1, pa2, pa3); pv_one<3>(o[3], vb, pa0, pa1, pa2, pa3);
}
constexpr int LDQ = NPROJ, LDK = 256;
__device__ __forceinline__ void attn_dense_body(bf16_t* Qb, const bf16_t* __restrict__ Kh, const bf16_t* __restrict__ Vh, int seq, char* lds, const int tid, const bool STORE = true) {
  const int wid = tid >> 6, lane = tid & 63, r32 = lane & 31, hi = lane >> 5;
  bf16_t* V_lds = (bf16_t*)lds; bf16_t* K_lds = (bf16_t*)(lds + 2 * SHM_V);
  float* ws = (float*)(lds + 2 * SHM_V + 2 * SHM_K) + wid * 64; float* li_l = ws; float* al_l = ws + 32;
  float m_reg = -1e30f, l_reg = 0; f32x16 o[4] = {}; bf16x8 qr[8];
  const bf16_t* Qw = Qb + (long)(wid * QBLK + r32) * LDQ + hi * 8;
#pragma unroll
  for (int d0 = 0; d0 < 8; ++d0) qr[d0] = *reinterpret_cast<const bf16x8*>(Qw + d0 * 16);
  int tid2 = tid; asm volatile("" : "+v"(tid2));
  const int sr = tid2 >> 4, sc = (tid2 & 15) * 8, vst0 = v_st(sr, sc), vst1 = v_st(32 + sr, sc);
  const int vb0 = (int)(uintptr_t)V_lds + v_rd_base(tid2 & 63);
  struct { bf16x8 vs0, vs1, ks0, ks1; } sr_[1];
#define LD8(p) (*reinterpret_cast<const bf16x8*>(p))
#define SLOAD(i, k0) do { sr_[i].vs0 = LD8(&Vh[(long)((k0) + sr) * LDK + sc]); sr_[i].vs1 = LD8(&Vh[(long)((k0) + 32 + sr) * LDK + sc]); \
    sr_[i].ks0 = LD8(&Kh[(long)((k0) + sr) * LDK + sc]); sr_[i].ks1 = LD8(&Kh[(long)((k0) + 32 + sr) * LDK + sc]); } while (0)
#define SWRITE(b, i) do { *(bf16x8*)((char*)V_lds + (b) * SHM_V + vst0) = sr_[i].vs0;          \
    *(bf16x8*)((char*)V_lds + (b) * SHM_V + vst1) = sr_[i].vs1; int kc = sc * 2;               \
    *(bf16x8*)((char*)K_lds + (b) * SHM_K + KSWZ(sr, kc)) = sr_[i].ks0;                       \
    *(bf16x8*)((char*)K_lds + (b) * SHM_K + KSWZ(32 + sr, kc)) = sr_[i].ks1; } while (0)
#define SWAIT() asm volatile("s_waitcnt vmcnt(0)" ::: "memory")
#define RESC(a) do { if (__any((a) < 1.f)) { if (hi == 0) al_l[r32] = (a); asm volatile("s_waitcnt lgkmcnt(0)" ::: "memory"); \
    _Pragma("unroll") for (int d = 0; d < 4; ++d) _Pragma("unroll") for (int r = 0; r < 16; ++r) o[d][r] *= al_l[crow(r, hi)]; } } while (0)
  f32x16 pA0, pA1, pB0, pB1; float mnA, mnB, alA, alB; bf16x8 pa0, pa1, pa2, pa3; const int NT = seq / KVBLK;
  constexpr int SE = 0, SO = 0;
  SLOAD(SE, 0); asm volatile("s_waitcnt vmcnt(0)" ::: "memory"); SWRITE(0, SE); __syncthreads();
  qkt(pA0, pA1, K_lds, qr, r32, hi); partialSM(pA0, pA1, m_reg, mnA, alA);
  SLOAD(SO, KVBLK);
  SWAIT(); SWRITE(1, SO); __syncthreads();
  for (int j = 1; j + 1 < NT; j += 2) {
    SBAR(); qkt(pB0, pB1, (bf16_t*)((char*)K_lds + SHM_K), qr, r32, hi);
    finishSM(pA0, pA1, alA, l_reg, pa0, pa1, pa2, pa3); SBAR();
    SLOAD(SO, (j + 1) * KVBLK); SBAR();
    pv_d0(o, vb0, pa0, pa1, pa2, pa3); partialSM(pB0, pB1, m_reg, mnB, alB);
    __syncthreads(); SWAIT(); SWRITE(0, SE);
    RESC(alB); __syncthreads();
    SBAR(); qkt(pA0, pA1, K_lds, qr, r32, hi);
    finishSM(pB0, pB1, alB, l_reg, pa0, pa1, pa2, pa3); SBAR();
    SLOAD(SE, (j + 2) * KVBLK); SBAR();
    pv_d0(o, vb0 + (int)SHM_V, pa0, pa1, pa2, pa3); partialSM(pA0, pA1, m_reg, mnA, alA);
    __syncthreads(); SWAIT(); SWRITE(1, SO);
    RESC(alA); __syncthreads();
  }
  SBAR(); qkt(pB0, pB1, (bf16_t*)((char*)K_lds + SHM_K), qr, r32, hi);
  finishSM(pA0, pA1, alA, l_reg, pa0, pa1, pa2, pa3); SBAR();
  pv_d0(o, vb0, pa0, pa1, pa2, pa3); partialSM(pB0, pB1, m_reg, mnB, alB);
  __syncthreads(); RESC(alB);
  finishSM(pB0, pB1, alB, l_reg, pa0, pa1, pa2, pa3); SBAR();
  pv_d0(o, vb0 + (int)SHM_V, pa0, pa1, pa2, pa3);
  if (hi == 0) li_l[r32] = l_reg; asm volatile("s_waitcnt lgkmcnt(0)" ::: "memory");
  float rli[16];
#pragma unroll
  for (int r = 0; r < 16; ++r) rli[r] = __builtin_amdgcn_rcpf(li_l[crow(r, hi)]);
  __syncthreads();
  { bf16_t* stg = (bf16_t*)lds + wid * 4096;
#pragma unroll
    for (int r = 0; r < 16; ++r) { const int orow = crow(r, hi);
#pragma unroll
      for (int d0 = 0; d0 < 4; ++d0) stg[orow * 128 + d0 * 32 + r32] = (bf16_t)(cvtpk(o[d0][r] * rli[r], 0.f) & 0xffffu); }
    asm volatile("s_waitcnt lgkmcnt(0)" ::: "memory");
    int le = lane; asm volatile("" : "+v"(le));
    bf16_t* Ow = Qb + (long)(wid * QBLK + (le >> 4)) * LDQ + (le & 15) * 8;
#pragma unroll
    for (int i = 0; i < 8; ++i) { const u32x4 v = *(const u32x4*)(stg + (i * 4 + (le >> 4)) * 128 + (le & 15) * 8); if (STORE) *(u32x4*)(Ow + (long)i * 4 * LDQ) = v; else asm volatile("" :: "v"(v)); }
  }
  __syncthreads();
#undef LD8
#undef SLOAD
#undef SWRITE
#undef SWAIT
#undef RESC
}
#undef KSWZ
#undef SBAR
}


#define XB_TMO      128
#define XB_XCNT(j)  (256  + 64 * (j))
#define XB_XSUB(j)  (1280 + 64 * (j))
#define XB_XGEN(j)  (2304 + 64 * (j))
#define XB_TOP      3328
#define XB_TOPGEN   3392
#define XCD_BAR_WORDS 3456
#define XB_SPIN_CAP (1u << 18)
__device__ __forceinline__ unsigned xb_ld(unsigned* p)              { return __hip_atomic_load(p, __ATOMIC_RELAXED, __HIP_MEMORY_SCOPE_AGENT); }
__device__ __forceinline__ unsigned xb_add(unsigned* p, unsigned v) { return __hip_atomic_fetch_add(p, v, __ATOMIC_RELAXED, __HIP_MEMORY_SCOPE_AGENT); }
__device__ __forceinline__ unsigned xb_xcc_id() { return (unsigned)__builtin_amdgcn_s_getreg((3 << 11) | 20) & 0xFu; }
#define XB_SPIN(cond, bar) do { unsigned _sp = 0; while (cond) { __builtin_amdgcn_s_sleep(1); \
    if ((++_sp & 255u) == 0u) { if (xb_ld(&(bar)[XB_TMO])) break; if (_sp > XB_SPIN_CAP) { atomicAdd(&(bar)[XB_TMO], 1u); break; } } } } while (0)
struct XcdBarrier { unsigned* bar; unsigned x; volatile LAS unsigned* st; };
__device__ __forceinline__ XcdBarrier xcd_barrier_post(unsigned* bar, volatile LAS unsigned* st) {
    XcdBarrier b; b.bar = bar; b.x = xb_xcc_id(); b.st = st;
    if (threadIdx.x == 0) (void)xb_add(&bar[XB_XCNT(b.x)], 1u);
    return b;
}
__device__ __forceinline__ void xcd_barrier_complete(unsigned* bar, unsigned x, unsigned& nloc, unsigned& nx) {
    const unsigned G = gridDim.x * gridDim.y * gridDim.z;
    unsigned sum, cnt, mine, sp = 0u;
    for (;;) {
        sum = 0u; cnt = 0u; mine = 0u;
#pragma unroll
        for (unsigned j = 0; j < 16; ++j) { const unsigned c = xb_ld(&bar[XB_XCNT(j)]); sum += c; cnt += (c > 0u) ? 1u : 0u; mine = (j == x) ? c : mine; }
        if (sum == G) break;
        __builtin_amdgcn_s_sleep(1);
        if ((++sp & 255u) == 0u) { if (xb_ld(&bar[XB_TMO])) break; if (sp > XB_SPIN_CAP) { atomicAdd(&bar[XB_TMO], 1u); break; } }
    }
    nloc = mine > 0u ? mine : 1u; nx = cnt > 0u ? cnt : 1u;
}
__device__ __forceinline__ void xcd_barrier(const XcdBarrier& b) {
    asm volatile("s_waitcnt vmcnt(0)" ::: "memory");
    __syncthreads();
    if (threadIdx.x == 0) {
        unsigned* bar = b.bar;
        __builtin_amdgcn_s_waitcnt(0);
        unsigned nloc = b.st[0], nx = b.st[1];
        if (nloc == 0u) { xcd_barrier_complete(bar, b.x, nloc, nx); b.st[0] = nloc; b.st[1] = nx; }
        const unsigned old = xb_add(&bar[XB_XSUB(b.x)], 1u);
        const unsigned gen = old / nloc;
        if (old + 1u == (gen + 1u) * nloc) {
            __builtin_amdgcn_fence(__ATOMIC_RELEASE, "agent");
            asm volatile("s_waitcnt vmcnt(0)" ::: "memory");
            const unsigned og = xb_add(&bar[XB_TOP], 1u);
            const unsigned tg = og / nx;
            if (og + 1u == (tg + 1u) * nx) xb_add(&bar[XB_TOPGEN], 1u);
            else XB_SPIN(xb_ld(&bar[XB_TOPGEN]) == tg, bar);
            __builtin_amdgcn_fence(__ATOMIC_ACQUIRE, "agent");
            xb_add(&bar[XB_XGEN(b.x)], 1u);
            asm volatile("s_waitcnt vmcnt(0)" ::: "memory");
        } else {
            XB_SPIN(xb_ld(&bar[XB_XGEN(b.x)]) == gen, bar);
            __builtin_amdgcn_fence(__ATOMIC_ACQUIRE, "agent");
            asm volatile("s_waitcnt vmcnt(0)" ::: "memory");
        }
    }
    __syncthreads();
}

struct Args { const float* in[25]; float* out; unsigned char* ws; int ph_lo, ph_hi; };

typedef const float* fptr_t;
typedef __attribute__((address_space(4))) const fptr_t* in_as4_t;
struct Frame {
    LAS unsigned char* lds; char* ldsg;
    int tid, lane, wave, G, bx, gw, NGW;
    const float* const* in;
    unsigned char* ws; float* out;
};
enum { I_XP = 0, I_XS, I_CK, I_CV, I_C, I_CCTX, I_WADA, I_BADA, I_WIN, I_QG, I_KG, I_WPG, I_PSC, I_WSGU, I_BSGU, I_WAO, I_WPO, I_WSO, I_WOUT, I_LN1G, I_LN1B, I_WF1, I_WF2, I_LN2G, I_LN2B };

__device__ __forceinline__ void tr_item(const float* W, int ldw, int src_col, int kb, bf16_t* WT, int ldt, int dst_row, int dst_k, LAS float* scr, int lane) {
    const int k0 = 64 * kb;
#pragma unroll 8
    for (int i = 0; i < 32; ++i) { const int kk = 2 * i + (lane >> 5); scr[kk * 33 + (lane & 31)] = W[(size_t)(k0 + kk) * ldw + src_col + (lane & 31)]; }
    asm volatile("s_waitcnt lgkmcnt(0)" ::: "memory");
    const int c = lane & 7;
#pragma unroll
    for (int j = 0; j < 4; ++j) { const int n = (lane >> 3) + 8 * j; const LAS float* s = scr + (8 * c) * 33 + n;
        u32x4 o; o.x = cvt_pk_bf16(s[0 * 33], s[1 * 33]); o.y = cvt_pk_bf16(s[2 * 33], s[3 * 33]); o.z = cvt_pk_bf16(s[4 * 33], s[5 * 33]); o.w = cvt_pk_bf16(s[6 * 33], s[7 * 33]);
        *(u32x4*)(WT + (size_t)(dst_row + n) * ldt + dst_k + k0 + 8 * c) = o; }
    asm volatile("s_waitcnt lgkmcnt(0)" ::: "memory");
}

__device__ __forceinline__ int win_src_col(int d) {
    if (d < 1024) return d;
    if (d < 1536) return 2048 + (d - 1024);
    if (d < 2048) return 1024 + (d - 1536);
    if (d < 2560) return 2560 + (d - 2048);
    if (d < 3072) return 1536 + (d - 2560);
    return d;
}

__device__ __forceinline__ void phase_prologue(Frame& F) {
    if (F.bx < 192) {
        const int l = F.bx / 96, nb = F.bx % 96;
        LAS float* sc = (LAS float*)F.lds;
        LAS float* red = (LAS float*)(F.lds + 9 * 1024 * 4);
        for (int idx = F.tid; idx < 9 * 1024; idx += 512) { const int v = idx >> 10, k = idx & 1023;
            const float x = v == 0 ? F.in[I_CCTX][k] : F.in[I_C][(v - 1) * 1024 + k]; sc[idx] = x / (1.0f + __expf(-x)); }
        __syncthreads();
        float acc[9];
#pragma unroll
        for (int v = 0; v < 9; ++v) acc[v] = 0.f;
        const float* wp = F.in[I_WADA] + ((size_t)l * 1024 + F.wave * 128) * 6144 + nb * 64 + F.lane;
#pragma unroll 8
        for (int k = 0; k < 128; ++k) { const float w = wp[(size_t)k * 6144];
#pragma unroll
            for (int v = 0; v < 9; ++v) acc[v] += sc[v * 1024 + F.wave * 128 + k] * w; }
#pragma unroll
        for (int v = 0; v < 9; ++v) red[(F.wave * 9 + v) * 64 + F.lane] = acc[v];
        __syncthreads();
        float* mod = (float*)(F.ws + WS_MOD);
        for (int idx = F.tid; idx < 576; idx += 512) { const int v = idx >> 6, ln = idx & 63; float s = 0.f;
#pragma unroll
            for (int w = 0; w < 8; ++w) s += red[(w * 9 + v) * 64 + ln];
            mod[(l * 9 + v) * 6144 + nb * 64 + ln] = s + F.in[I_BADA][l * 6144 + nb * 64 + ln]; }
        __syncthreads();
    }
    LAS float* scr = (LAS float*)(F.lds + F.wave * 8448);
    constexpr int N_WIN = 16 * 192, N_AO = 16 * 32, N_SO = 8 * 32, N_WO = 16 * 32, N_F1 = 16 * 176, N_F2 = 44 * 32, N_PE = 1024, N_WS = 128;
    constexpr int N_L = N_WIN + N_AO + N_SO + N_WO + N_F1 + N_F2 + N_PE + N_WS;
    constexpr int N_ALL = 2 * N_L + 32;
    for (int it = F.gw; it < N_ALL; it += F.NGW) {
        if (it >= 2 * N_L) {
            const int idx = (it - 2 * N_L) * 64 + F.lane; const int pos = idx >> 5, p = idx & 31;
            const float inv = powf(10000.0f, -(float)p / 32.0f); const float ang = (float)pos * inv;
            float* rope = (float*)(F.ws + WS_ROPE); rope[idx] = cosf(ang); rope[2048 + idx] = sinf(ang);
            continue;
        }
        const int l = it / N_L; int r = it % N_L;
        if (r < N_WIN) { const int kb = r / 192, nb = r % 192;
            tr_item(F.in[I_WIN] + (size_t)l * 1024 * 6144, 6144, win_src_col(nb * 32), kb, (bf16_t*)(F.ws + WS_WIN) + (size_t)l * 6144 * 1024, 1024, nb * 32, 0, scr, F.lane); continue; } r -= N_WIN;
        if (r < N_AO) { const int kb = r / 32, nb = r % 32;
            tr_item(F.in[I_WAO] + (size_t)l * 1024 * 1024, 1024, nb * 32, kb, (bf16_t*)(F.ws + WS_WM) + (size_t)l * 1024 * 2048, 2048, nb * 32, 0, scr, F.lane); continue; } r -= N_AO;
        if (r < N_SO) { const int kb = r / 32, nb = r % 32;
            tr_item(F.in[I_WSO] + (size_t)l * 512 * 1024, 1024, nb * 32, kb, (bf16_t*)(F.ws + WS_WM) + (size_t)l * 1024 * 2048, 2048, nb * 32, 1024, scr, F.lane); continue; } r -= N_SO;
        if (r < N_WO) { const int kb = r / 32, nb = r % 32;
            tr_item(F.in[I_WOUT] + (size_t)l * 1024 * 1024, 1024, nb * 32, kb, (bf16_t*)(F.ws + WS_WOUT) + (size_t)l * 1024 * 1024, 1024, nb * 32, 0, scr, F.lane); continue; } r -= N_WO;
        if (r < N_F1) { const int kb = r / 176, nb = r % 176; const int drow = nb * 32; const int pn = drow >> 8, j = drow & 255;
            const int src = j < 128 ? pn * 128 + j : DFF + pn * 128 + (j - 128);
            tr_item(F.in[I_WF1] + (size_t)l * 1024 * 5632, 5632, src, kb, (bf16_t*)(F.ws + WS_WF1) + (size_t)l * 5632 * 1024, 1024, drow, 0, scr, F.lane); continue; } r -= N_F1;
        if (r < N_F2) { const int kb = r / 32, nb = r % 32;
            tr_item(F.in[I_WF2] + (size_t)l * DFF * 1024, 1024, nb * 32, kb, (bf16_t*)(F.ws + WS_WF2) + (size_t)l * 1024 * DFF, DFF, nb * 32, 0, scr, F.lane); continue; } r -= N_F2;
        if (r < N_PE) {
            const int kg = r >> 4, nb = r & 15; const int k0 = kg * 8, g = k0 >> 7; const int n = nb * 64 + F.lane;
            const float* wpg = F.in[I_WPG] + ((size_t)(l * 4 + g) * 128 + (k0 & 127)) * 128;
            const float* psc = F.in[I_PSC] + l * 512 + g * 128;
            const float* wpo = F.in[I_WPO] + ((size_t)l * 512 + g * 128) * 1024 + n;
            float a[8];
#pragma unroll
            for (int i = 0; i < 8; ++i) a[i] = 0.f;
#pragma unroll 4
            for (int j = 0; j < 128; ++j) { const float w = wpo[(size_t)j * 1024] * psc[j];
#pragma unroll
                for (int i = 0; i < 8; ++i) a[i] += wpg[i * 128 + j] * w; }
            u32x4 o; o.x = cvt_pk_bf16(a[0], a[1]); o.y = cvt_pk_bf16(a[2], a[3]); o.z = cvt_pk_bf16(a[4], a[5]); o.w = cvt_pk_bf16(a[6], a[7]);
            *(u32x4*)((bf16_t*)(F.ws + WS_WM) + (size_t)l * 1024 * 2048 + (size_t)n * 2048 + 1536 + k0) = o;
            continue; } r -= N_PE;
        {
            const size_t e0 = (size_t)l * 65536 + (size_t)r * 512 + F.lane * 8;
            const f32x4 a = *(const f32x4*)(F.in[I_WSGU] + e0), b = *(const f32x4*)(F.in[I_WSGU] + e0 + 4);
            u32x4 o; o.x = cvt_pk_bf16(a[0], a[1]); o.y = cvt_pk_bf16(a[2], a[3]); o.z = cvt_pk_bf16(b[0], b[1]); o.w = cvt_pk_bf16(b[2], b[3]);
            *(u32x4*)((bf16_t*)(F.ws + WS_WSGU) + e0) = o;
        }
    }
}

__device__ __forceinline__ const float* x0_row(Frame& F, int t) { return t < T_CTX ? F.in[I_XP] + (size_t)t * DM : F.in[I_XS] + (size_t)(t - T_CTX) * DM; }
__device__ __forceinline__ int vec_of_row(int t) { return t < T_CTX ? 0 : 1 + ((t - T_CTX) >> 12); }

__device__ __forceinline__ void phase_h0(Frame& F) {
    const float* mod = (const float*)(F.ws + WS_MOD);
    bf16_t* act = (bf16_t*)(F.ws + WS_ACT);
    for (int t = F.gw; t < T_ALL; t += F.NGW) {
        const f32x4* xr = (const f32x4*)x0_row(F, t) + F.lane;
        const float* mv = mod + vec_of_row(t) * 6144;
        unsigned long long* o8 = (unsigned long long*)(act + (size_t)t * DM) + F.lane;
#pragma unroll
        for (int j = 0; j < 4; ++j) { const f32x4 x = xr[64 * j]; const int c = 256 * j + 4 * F.lane;
            const f32x4 sh = *(const f32x4*)(mv + c), sc = *(const f32x4*)(mv + 1024 + c);
            const f32x4 h = x * (sc + 1.0f) + sh;
            o8[64 * j] = (unsigned long long)cvt_pk_bf16(h[0], h[1]) | ((unsigned long long)cvt_pk_bf16(h[2], h[3]) << 32); }
    }
}

__device__ __forceinline__ void phase_ln(Frame& F, const float* lg, const float* lb, const float* modl  , int sh_off, int sc_off, const bool dry = false) {
    float* X = F.out; bf16_t* act = (bf16_t*)(F.ws + WS_ACT);
    for (int t = F.gw; t < T_ALL; t += F.NGW) {
        f32x4* xr = (f32x4*)(X + (size_t)t * DM) + F.lane;
        f32x4 v[4]; float s = 0.f;
#pragma unroll
        for (int j = 0; j < 4; ++j) { v[j] = xr[64 * j]; s += (v[j][0] + v[j][1]) + (v[j][2] + v[j][3]); }
        const float mean = wave_sum(s) * (1.f / DM); float s2 = 0.f;
#pragma unroll
        for (int j = 0; j < 4; ++j) { v[j] = v[j] - mean; s2 += (v[j][0] * v[j][0] + v[j][1] * v[j][1]) + (v[j][2] * v[j][2] + v[j][3] * v[j][3]); }
        const float rstd = rsqrtf(wave_sum(s2) * (1.f / DM) + LN_EPS);
        const float* mv = modl ? modl + vec_of_row(t) * 6144 : nullptr;
        unsigned long long* o8 = (unsigned long long*)(act + (size_t)t * DM) + F.lane;
#pragma unroll
        for (int j = 0; j < 4; ++j) { const int c = 256 * j + 4 * F.lane;
            const f32x4 g = *(const f32x4*)(lg + c), b = *(const f32x4*)(lb + c);
            const f32x4 y = v[j] * rstd * g + b; if (!dry) xr[64 * j] = y; else { asm volatile("" :: "v"(y)); continue; }
            if (mv) { const f32x4 sh = *(const f32x4*)(mv + sh_off + c), sc = *(const f32x4*)(mv + sc_off + c);
                const f32x4 h = y * (sc + 1.0f) + sh;
                o8[64 * j] = (unsigned long long)cvt_pk_bf16(h[0], h[1]) | ((unsigned long long)cvt_pk_bf16(h[2], h[3]) << 32); } }
    }
}

__device__ __forceinline__ void load16h(const bf16_t* p, int j, float (&x)[16]) {
#pragma unroll
    for (int a = 0; a < 2; ++a)
#pragma unroll
        for (int hf = 0; hf < 2; ++hf) { const u32x2 w = *(const u32x2*)(p + a * 64 + hf * 32 + 4 * j);
            x[(a * 2 + hf) * 4 + 0] = bf_lo(w.x); x[(a * 2 + hf) * 4 + 1] = bf_hi(w.x); x[(a * 2 + hf) * 4 + 2] = bf_lo(w.y); x[(a * 2 + hf) * 4 + 3] = bf_hi(w.y); }
}
__device__ __forceinline__ void rmsn(float (&x)[16], const float (&g)[16]) {
    float ss = 0.f;
#pragma unroll
    for (int i = 0; i < 16; ++i) ss += x[i] * x[i];
    ss += __shfl_xor(ss, 1); ss += __shfl_xor(ss, 2); ss += __shfl_xor(ss, 4);
    const float rinv = rsqrtf(ss * (1.0f / 128.0f) + LN_EPS);
#pragma unroll
    for (int i = 0; i < 16; ++i) x[i] = x[i] * rinv * g[i];
}
__device__ __forceinline__ void rope16(float (&x)[16], const float* rope, int rowpos, int colpos, int j) {
#pragma unroll
    for (int a = 0; a < 2; ++a) { const int pos = a == 0 ? rowpos : colpos;
        const f32x4 c = *(const f32x4*)(rope + pos * 32 + 4 * j), s = *(const f32x4*)(rope + 2048 + pos * 32 + 4 * j);
#pragma unroll
        for (int e = 0; e < 4; ++e) { const float x1 = x[(a * 2) * 4 + e], x2 = x[(a * 2 + 1) * 4 + e];
            x[(a * 2) * 4 + e] = x1 * c[e] - x2 * s[e]; x[(a * 2 + 1) * 4 + e] = x2 * c[e] + x1 * s[e]; } }
}
__device__ __forceinline__ void store16h(bf16_t* p, int j, const float (&x)[16]) {
#pragma unroll
    for (int a = 0; a < 2; ++a)
#pragma unroll
        for (int hf = 0; hf < 2; ++hf) { u32x2 w; w.x = cvt_pk_bf16(x[(a * 2 + hf) * 4 + 0], x[(a * 2 + hf) * 4 + 1]); w.y = cvt_pk_bf16(x[(a * 2 + hf) * 4 + 2], x[(a * 2 + hf) * 4 + 3]);
            *(u32x2*)(p + a * 64 + hf * 32 + 4 * j) = w; }
}

__device__ __forceinline__ void phase_mid(Frame& F, int l, int part, const bool dry = false) {
    bf16_t* proj = (bf16_t*)(F.ws + WS_PROJ);
    const float* rope = (const float*)(F.ws + WS_ROPE);
    bf16_t* vrt = (bf16_t*)(F.ws + WS_VRT);
    bf16_t* KL = (bf16_t*)(F.ws + WS_KL); bf16_t* VL = (bf16_t*)(F.ws + WS_VL); bf16_t* KC = (bf16_t*)(F.ws + WS_KC); bf16_t* VC = (bf16_t*)(F.ws + WS_VC);
    float* outk = F.out + (size_t)T_ALL * DM; float* outv = outk + (size_t)16 * 2 * 256 * 256;
    const int lane = F.lane, hj = lane & 7;
    const int n8 = part_rows(part) / 4, ncache = 4 * PAST;
    float qg[16], kg[16];
#pragma unroll
    for (int a = 0; a < 2; ++a)
#pragma unroll
        for (int hf = 0; hf < 2; ++hf)
#pragma unroll
            for (int e = 0; e < 4; ++e) { const int d = a * 64 + hf * 32 + 4 * hj + e; qg[(a * 2 + hf) * 4 + e] = F.in[I_QG][l * 128 + d]; kg[(a * 2 + hf) * 4 + e] = F.in[I_KG][l * 128 + d]; }
    for (int it = F.gw; it < n8 + ncache; it += F.NGW) {
        if (it >= n8) {
            const int cr = it - n8; const int bl = cr >> 9, s = cr & 511; const int b = part * 4 + bl;
            const size_t src = (((size_t)b * 2 + l) * PAST + s) * 256 + lane * 4;
            const f32x4 kx = *(const f32x4*)(F.in[I_CK] + src), vx = *(const f32x4*)(F.in[I_CV] + src);
            const size_t dst = ((size_t)bl * SKV_LAT + s) * 256 + lane * 4;
            u32x2 kw, vw; kw.x = cvt_pk_bf16(kx[0], kx[1]); kw.y = cvt_pk_bf16(kx[2], kx[3]); vw.x = cvt_pk_bf16(vx[0], vx[1]); vw.y = cvt_pk_bf16(vx[2], vx[3]);
            if (!dry) { *(u32x2*)(KL + dst) = kw; *(u32x2*)(VL + dst) = vw; } else asm volatile("" :: "v"(kw), "v"(vw));
            continue;
        }
        const int lr0 = it * 4, t0 = part_row0(part) + lr0;
        const bool is_ctx = t0 < T_CTX;
        bf16_t* P0 = proj + (size_t)lr0 * NPROJ;
        {
            float val[4][8];
#pragma unroll
            for (int i = 0; i < 4; ++i) { const u32x4 w = *(const u32x4*)(P0 + (size_t)i * NPROJ + PC_XV + lane * 8);
#pragma unroll
                for (int e = 0; e < 4; ++e) { val[i][2 * e] = gelu1(bf_lo(w[e])); val[i][2 * e + 1] = gelu1(bf_hi(w[e])); } }
#pragma unroll
            for (int i = 0; i < 4; ++i) { float s = 0.f;
#pragma unroll
                for (int e = 0; e < 8; ++e) s += val[i][e];
                const float mean = wave_sum(s) * (1.0f / 512.0f); float s2 = 0.f;
#pragma unroll
                for (int e = 0; e < 8; ++e) { val[i][e] -= mean; s2 += val[i][e] * val[i][e]; }
                const float rstd = rsqrtf(wave_sum(s2) * (1.0f / 512.0f) + LN_EPS);
#pragma unroll
                for (int e = 0; e < 8; ++e) val[i][e] *= rstd; }
            const int chunk = lr0 >> 7, q0 = lr0 & 127;
            bf16_t* vb = vrt + ((size_t)chunk * 512 + lane * 8) * 128 + q0;
#pragma unroll
            for (int e = 0; e < 8; ++e) { u32x2 o; o.x = cvt_pk_bf16(val[0][e], val[1][e]); o.y = cvt_pk_bf16(val[2][e], val[3][e]);
                if (!dry) *(u32x2*)(vb + (size_t)e * 128) = o; else asm volatile("" :: "v"(o)); }
        }
#pragma unroll 1
        for (int i = 0; i < 4; ++i) {
            bf16_t* Pr = P0 + (size_t)i * NPROJ; const int t = t0 + i;
            int spos, seqS, rowpos = 0, colpos = 0, bl = 0;
            if (is_ctx) { spos = t & 255; seqS = CTX_S; } else { const int tl = t - T_CTX; spos = tl & 4095; seqS = LAT_S; rowpos = spos >> 6; colpos = spos & 63; bl = (tl >> 12) - part * 4; }
            float x[16];
            load16h(Pr + PC_Q + (lane >> 3) * 128, hj, x); rmsn(x, qg); if (!is_ctx) rope16(x, rope, rowpos, colpos, hj);
            if (!dry) store16h(Pr + PC_Q + (lane >> 3) * 128, hj, x); else asm volatile("" :: "v"(x[0]), "v"(x[5]), "v"(x[10]), "v"(x[15]));
            const int kh = (lane >> 3) & 1;
            load16h(Pr + PC_K + kh * 128, hj, x); rmsn(x, kg);
            const int vi = (lane - 16) & 31;
            const u32x4 vw = *(const u32x4*)(Pr + PC_V + vi * 8);
            float pacc[8], pself[8];
            {
                const int hw = 1 << (lane >> 4);
                const int lo = max(spos - hw, 0), hi = min(spos + hw, seqS);
#pragma unroll
                for (int e = 0; e < 8; ++e) pacc[e] = 0.f;
                u32x4 pw[16];
#pragma unroll
                for (int k = 0; k < 16; ++k) { const int dd = k - 8, sp = spos + dd; const bool ok = (sp >= lo) && (sp < hi);
                    pw[k] = *(const u32x4*)(Pr + (long)(ok ? dd : 0) * NPROJ + PC_XP + lane * 8); }
#pragma unroll
                for (int k = 0; k < 16; ++k) { const int sp = spos + k - 8; const float mk = ((sp >= lo) && (sp < hi)) ? 1.0f : 0.0f;
#pragma unroll
                    for (int e = 0; e < 4; ++e) { pacc[2 * e] += mk * bf_lo(pw[k][e]); pacc[2 * e + 1] += mk * bf_hi(pw[k][e]); } }
#pragma unroll
                for (int e = 0; e < 4; ++e) { pself[2 * e] = bf_lo(pw[8][e]); pself[2 * e + 1] = bf_hi(pw[8][e]); }
                const float rc = 1.0f / (float)(hi - lo);
#pragma unroll
                for (int e = 0; e < 8; ++e) pacc[e] = pacc[e] * rc - pself[e];
            }
            asm volatile("s_waitcnt vmcnt(0)" ::: "memory");
            if (dry) { asm volatile("" :: "v"(x[0]), "v"(x[7]), "v"(vw), "v"(pacc[0]), "v"(pacc[7])); continue; }
            if (is_ctx) {
                if (lane < 16) {
                    float* ok = outk + (((size_t)(t >> 8) * 2 + l) * 256 + (t & 255)) * 256 + kh * 128;
#pragma unroll
                    for (int a = 0; a < 2; ++a)
#pragma unroll
                        for (int hf = 0; hf < 2; ++hf) *(f32x4*)(ok + a * 64 + hf * 32 + 4 * hj) = (f32x4){x[(a * 2 + hf) * 4], x[(a * 2 + hf) * 4 + 1], x[(a * 2 + hf) * 4 + 2], x[(a * 2 + hf) * 4 + 3]};
                    store16h(KC + (size_t)t * 256 + kh * 128, hj, x);
                }
                if (lane >= 16 && lane < 48) {
                    float* ov = outv + (((size_t)(t >> 8) * 2 + l) * 256 + (t & 255)) * 256 + vi * 8;
                    *(f32x4*)ov = (f32x4){bf_lo(vw[0]), bf_hi(vw[0]), bf_lo(vw[1]), bf_hi(vw[1])};
                    *(f32x4*)(ov + 4) = (f32x4){bf_lo(vw[2]), bf_hi(vw[2]), bf_lo(vw[3]), bf_hi(vw[3])};
                    *(u32x4*)(VC + (size_t)t * 256 + vi * 8) = vw;
                }
            } else {
                rope16(x, rope, rowpos, colpos, hj);
                const size_t krow = ((size_t)bl * SKV_LAT + PAST + spos) * 256;
                if (lane < 16) store16h(KL + krow + kh * 128, hj, x);
                if (lane >= 16 && lane < 48) *(u32x4*)(VL + krow + vi * 8) = vw;
            }
            { u32x4 o; o.x = cvt_pk_bf16(pacc[0], pacc[1]); o.y = cvt_pk_bf16(pacc[2], pacc[3]); o.z = cvt_pk_bf16(pacc[4], pacc[5]); o.w = cvt_pk_bf16(pacc[6], pacc[7]);
              *(u32x4*)(Pr + PC_K + lane * 8) = o; }
        }
    }
}

__device__ __forceinline__ void phase_attn(Frame& F, int l, int part, const bool sgu_only_dry = false) {
    bf16_t* proj = (bf16_t*)(F.ws + WS_PROJ);
    const bf16_t* KL = (const bf16_t*)(F.ws + WS_KL); const bf16_t* VL = (const bf16_t*)(F.ws + WS_VL); const bf16_t* KC = (const bf16_t*)(F.ws + WS_KC); const bf16_t* VC = (const bf16_t*)(F.ws + WS_VC);
    const int lat_row0 = part == 0 ? T_CTX : 0;
    if (!sgu_only_dry) {
        int pair, idx, step; int rep = 0;
        const bool xcdmap = (F.G % 8) == 0;
        if (xcdmap) { pair = F.bx & 7; idx = F.bx >> 3; step = F.G >> 3; } else { pair = 0; idx = F.bx; step = F.G; }
        for (;;) {
            int pr = pair, ix = idx;
            if (!xcdmap) { pr = idx >> 6; ix = idx & 63; if (idx >= 512) break; } else if (idx >= 64) break;
            const int bl = pr >> 1, kvh = pr & 1, h = kvh * 4 + (ix >> 4), qb = ix & 15;
            bf16_t* Qb = proj + (size_t)(lat_row0 + bl * LAT_S + qb * 256) * NPROJ + PC_Q + h * 128;
            att::attn_dense_body(Qb, KL + (size_t)bl * SKV_LAT * 256 + kvh * 128, VL + (size_t)bl * SKV_LAT * 256 + kvh * 128, SKV_LAT, F.ldsg, F.tid, PROBE == 3 ? rep == 1 : true);
            if (PROBE == 3) { if (rep == 0) { rep = 1; continue; } rep = 0; }
            idx += step;
        }
    }
    if (part == 0 && !sgu_only_dry) {
        for (int u = F.bx; u < 128; u += F.G) { const int b = u >> 3, h = u & 7;
            bf16_t* Qb = proj + (size_t)(b * 256) * NPROJ + PC_Q + h * 128;
            att::attn_dense_body(Qb, KC + (size_t)b * 256 * 256 + (h >> 2) * 128, VC + (size_t)b * 256 * 256 + (h >> 2) * 128, CTX_S, F.ldsg, F.tid); }
    }
    const bf16_t* vrt = (const bf16_t*)(F.ws + WS_VRT);
    const bf16_t* wsb = (const bf16_t*)(F.ws + WS_WSGU) + (size_t)l * 65536;
    const float* bs = F.in[I_BSGU] + l * 512;
    const int nitem = (part_rows(part) / 128) * 32;
    const int ln = F.lane & 15, quad = F.lane >> 4;
    for (int it = F.NGW - 1 - F.gw; it < nitem; it += F.NGW) {
        const int chunk = it >> 5, g = (it >> 3) & 3, cb = (it >> 1) & 3, pb = it & 1;
        f32x4 acc[2][4];
#pragma unroll
        for (int a = 0; a < 2; ++a)
#pragma unroll
            for (int b = 0; b < 4; ++b) acc[a][b] = (f32x4){0.f, 0.f, 0.f, 0.f};
        const bf16_t* ap = vrt + ((size_t)chunk * 512 + g * 128 + cb * 32 + ln) * 128 + quad * 8;
        const bf16_t* bp = wsb + ((size_t)g * 128 + pb * 64 + ln) * 128 + quad * 8;
        u32x2 xw[4][2];
#pragma unroll
        for (int pt = 0; pt < 4; ++pt)
#pragma unroll
            for (int ct = 0; ct < 2; ++ct) xw[pt][ct] = *(const u32x2*)(proj + (size_t)(chunk * 128 + pb * 64 + pt * 16 + ln) * NPROJ + PC_U + g * 128 + cb * 32 + ct * 16 + quad * 4);
#pragma unroll
        for (int ks = 0; ks < 4; ++ks) {
            bf16x8 af[2], bfr[4];
#pragma unroll
            for (int ct = 0; ct < 2; ++ct) af[ct] = *(const bf16x8*)(ap + ct * 16 * 128 + ks * 32);
#pragma unroll
            for (int pt = 0; pt < 4; ++pt) bfr[pt] = *(const bf16x8*)(bp + pt * 16 * 128 + ks * 32);
#pragma unroll
            for (int ct = 0; ct < 2; ++ct)
#pragma unroll
                for (int pt = 0; pt < 4; ++pt) acc[ct][pt] = __builtin_amdgcn_mfma_f32_16x16x32_bf16(af[ct], bfr[pt], acc[ct][pt], 0, 0, 0);
        }
#pragma unroll
        for (int pt = 0; pt < 4; ++pt) { const int p = pb * 64 + pt * 16 + ln; const float bsv = bs[g * 128 + p];
#pragma unroll
            for (int ct = 0; ct < 2; ++ct) { const int c = g * 128 + cb * 32 + ct * 16 + quad * 4;
                bf16_t* up = proj + (size_t)(chunk * 128 + p) * NPROJ + PC_U + c;
                const u32x2 w = xw[pt][ct];
                const float u0 = gelu1(bf_lo(w.x)), u1 = gelu1(bf_hi(w.x)), u2 = gelu1(bf_lo(w.y)), u3 = gelu1(bf_hi(w.y));
                const f32x4 a = acc[ct][pt];
                u32x2 o; o.x = cvt_pk_bf16(u0 * (a[0] + bsv), u1 * (a[1] + bsv)); o.y = cvt_pk_bf16(u2 * (a[2] + bsv), u3 * (a[3] + bsv));
                if (!sgu_only_dry) *(u32x2*)up = o; else asm volatile("" :: "v"(o)); } }
    }
}

constexpr int NPL = 11, NPHASE = 2 + DEPTH * NPL;
__global__ void __launch_bounds__(NW * 64, 2) fwd_kernel(Args args) {
    extern __shared__ __attribute__((aligned(16))) unsigned char lds[];
    Frame F;
    F.lds = (LAS unsigned char*)lds; F.ldsg = (char*)lds;
    F.G = gridDim.x; F.bx = blockIdx.x; F.NGW = F.G * NW;
    F.in = args.in; F.ws = args.ws; F.out = args.out;
    const float* mod = (const float*)(F.ws + WS_MOD);
    bf16_t* act = (bf16_t*)(F.ws + WS_ACT); bf16_t* proj = (bf16_t*)(F.ws + WS_PROJ);
    volatile LAS unsigned* bst = (volatile LAS unsigned*)(F.lds + 131072 + 64);
    unsigned* barw = (unsigned*)(F.ws + WS_BAR);
    const int wave0 = __builtin_amdgcn_readfirstlane((int)threadIdx.x >> 6);
    { unsigned z0 = 0u; asm volatile("" : "+v"(z0)); int t0 = wave0 * 64 + (int)__builtin_amdgcn_mbcnt_hi(~0u, __builtin_amdgcn_mbcnt_lo(~0u, z0));
      if (t0 < 2) bst[t0] = 0u;
      if (blockIdx.x == 0 && args.ph_lo == 0) { for (int i = t0; i < XCD_BAR_WORDS; i += NW * 64) barw[i] = 0u;
        unsigned* cw = (unsigned*)(F.ws + WS_CNT); for (int i = t0; i < CNT_WORDS; i += NW * 64) cw[i] = 0u; } }
    __syncthreads();
    XcdBarrier xbar; xbar.bar = barw; xbar.x = 0; xbar.st = bst;
    for (int ph = args.ph_lo; ph < args.ph_hi; ++ph) {
        { unsigned zz = 0u; asm volatile("" : "+v"(zz)); const int lanev = (int)__builtin_amdgcn_mbcnt_hi(~0u, __builtin_amdgcn_mbcnt_lo(~0u, zz));
          F.lane = lanev; F.wave = wave0; F.tid = wave0 * 64 + lanev; F.gw = F.bx * NW + F.wave; }

#ifndef PHMASK
#define PHMASK 0xffff
#endif
        if (ph == 0) { if (PHMASK & 1) phase_prologue(F); if (PROBE == 4) { __syncthreads(); phase_prologue(F); } }
        else if (ph == 1) { if (PHMASK & 2) phase_h0(F); if (PROBE == 4) phase_h0(F); }
        else {
            const int l = (ph - 2) / NPL, s = (ph - 2) % NPL;
            if (s < 8) {
                const int part = s >> 2, q = s & 3;
                if (q == 0) { if (PHMASK & 4) {
                    pg8::Gemm g{}; g.A = act + (size_t)part_row0(part) * DM; g.Bt = (const bf16_t*)(F.ws + WS_WIN) + (size_t)l * NPROJ * DM; g.lda = DM; g.ldb = DM;
                    g.nM = part_rows(part) / 256; g.nN = NPROJ / 256; g.nseg = 1; g.k0[0] = 0; g.nt[0] = 16; g.k0[1] = 0; g.nt[1] = 16; g.k0[2] = 0; g.nt[2] = 16;
                    pg8::Order S; S.init(g.nM, g.nN, 1, F.G, F.bx, 0, STAGGER);
                    pg8::EpiStore E{proj, NPROJ, PC_G};
                    if (PROBE == 2) { pg8::EpiNone E0; pg8::gemm_phase<pg8::EpiNone>(F.lds, g, S, E0, F.tid); }
                    if (PROBE == 7) pg8::gemm_phase<pg8::EpiStore>(F.lds, g, S, E, F.tid);
                    pg8::gemm_phase<pg8::EpiStore>(F.lds, g, S, E, F.tid); }
                } else if (q == 1) { if (PROBE == 5) phase_mid(F, l, part, true); if (PHMASK & 8) phase_mid(F, l, part, false); }
                else if (q == 2) { if (PROBE == 6) phase_attn(F, l, part, true); if (PHMASK & 16) phase_attn(F, l, part, false); }
                else if (PHMASK & 32) {
                    pg8::Gemm g{}; g.A = proj; g.Bt = (const bf16_t*)(F.ws + WS_WM) + (size_t)l * DM * 2048; g.lda = NPROJ; g.ldb = 2048;
                    g.nM = part_rows(part) / 256; g.nN = 4; g.nseg = 3; g.k0[0] = 0; g.nt[0] = 16; g.k0[1] = 1024; g.nt[1] = 8; g.k0[2] = 1536; g.nt[2] = 8;
                    pg8::Order S; S.init(g.nM, g.nN, 3, F.G, F.bx);
                    pg8::EpiGate E{F.lds + LDS_XCH, proj, act + (size_t)part_row0(part) * DM, DM};
                    if (PROBE == 2) { pg8::EpiNone E0; pg8::gemm_phase<pg8::EpiNone>(F.lds, g, S, E0, F.tid); }
                    pg8::gemm_phase<pg8::EpiGate>(F.lds, g, S, E, F.tid);
                }
            } else if (s == 8) { if (PHMASK & 64) {
                pg8::Gemm g{}; g.A = act; g.Bt = (const bf16_t*)(F.ws + WS_WOUT) + (size_t)l * DM * DM; g.lda = DM; g.ldb = DM;
                g.nM = T_ALL / 256; g.nN = 4; g.nseg = 1; g.k0[0] = 0; g.nt[0] = 16; g.k0[1] = 0; g.nt[1] = 16; g.k0[2] = 0; g.nt[2] = 16;
                pg8::Order S; S.init(g.nM, g.nN, 1, F.G, F.bx, 1);
                pg8::EpiResidLn<0> E{F.in, F.ws, F.out, l, F.lds + LDS_XCH};
                if (PROBE == 2) { pg8::EpiNone E0; pg8::gemm_phase<pg8::EpiNone>(F.lds, g, S, E0, F.tid); }
                pg8::gemm_phase<pg8::EpiResidLn<0>>(F.lds, g, S, E, F.tid); }
            } else if (s == 9) { if (PHMASK & 256) {
                pg8::Gemm g{}; g.A = act; g.Bt = (const bf16_t*)(F.ws + WS_WF1) + (size_t)l * 2 * DFF * DM; g.lda = DM; g.ldb = DM;
                g.nM = T_ALL / 256; g.nN = 2 * DFF / 256; g.nseg = 1; g.k0[0] = 0; g.nt[0] = 16; g.k0[1] = 0; g.nt[1] = 16; g.k0[2] = 0; g.nt[2] = 16;
                pg8::Order S; S.init(g.nM, g.nN, 1, F.G, F.bx, 0, STAGGER);
                pg8::EpiSwiGLU E{proj, DFF};
                if (PROBE == 2) { pg8::EpiNone E0; pg8::gemm_phase<pg8::EpiNone>(F.lds, g, S, E0, F.tid); }
                if (PROBE == 7) pg8::gemm_phase<pg8::EpiSwiGLU>(F.lds, g, S, E, F.tid);
                pg8::gemm_phase<pg8::EpiSwiGLU>(F.lds, g, S, E, F.tid); }
            } else { if (PHMASK & 512) {
                pg8::Gemm g{}; g.A = proj; g.Bt = (const bf16_t*)(F.ws + WS_WF2) + (size_t)l * DM * DFF; g.lda = DFF; g.ldb = DFF;
                g.nM = T_ALL / 256; g.nN = 4; g.nseg = 1; g.k0[0] = 0; g.nt[0] = 44; g.k0[1] = 0; g.nt[1] = 44; g.k0[2] = 0; g.nt[2] = 44;
                pg8::Order S; S.init(g.nM, g.nN, 1, F.G, F.bx, 1);
                pg8::EpiResidLn<1> E{F.in, F.ws, F.out, l, F.lds + LDS_XCH};
                if (PROBE == 2) { pg8::EpiNone E0; pg8::gemm_phase<pg8::EpiNone>(F.lds, g, S, E0, F.tid); }
                pg8::gemm_phase<pg8::EpiResidLn<1>>(F.lds, g, S, E, F.tid); }
            }
        }
        if (ph + 1 < args.ph_hi) {
            if (ph == args.ph_lo) { cg::this_grid().sync(); xbar = xcd_barrier_post(barw, bst); }
            else xcd_barrier(xbar);
            if (PROBE == 1 && ph == 1) { for (int k = 0; k < 20; ++k) xcd_barrier(xbar); }
        }
    }
}

extern "C" void kernel_launch(void* const* d_in, const int* in_sizes, int n_in, void* d_out, int out_size, void* d_ws, size_t ws_size, hipStream_t stream) {
    static int grid = 0;
    if (grid == 0) {
        if (n_in != 25 || ws_size < WS_END) { fprintf(stderr, "kernel_launch: unexpected n_in %d / ws %zu\n", n_in, ws_size); grid = -1; return; }
        int dev = 0, cus = 0, per_cu = 0;
        if (hipGetDevice(&dev) != hipSuccess || hipDeviceGetAttribute(&cus, hipDeviceAttributeMultiprocessorCount, dev) != hipSuccess) { grid = -1; return; }
        if (hipFuncSetAttribute((const void*)fwd_kernel, hipFuncAttributeMaxDynamicSharedMemorySize, LDS_BYTES) != hipSuccess) { fprintf(stderr, "kernel_launch: hipFuncSetAttribute failed\n"); grid = -1; return; }
        if (hipOccupancyMaxActiveBlocksPerMultiprocessor(&per_cu, (const void*)fwd_kernel, NW * 64, LDS_BYTES) != hipSuccess || per_cu < 1) per_cu = 1;
        (void)hipGetLastError();
        grid = cus * (per_cu > 1 ? 1 : per_cu);
    }
    if (grid < 0) return;
    Args a{};
    for (int i = 0; i < 25; ++i) a.in[i] = (const float*)d_in[i];
    a.out = (float*)d_out; a.ws = (unsigned char*)d_ws;
#if MK_MULTI
    for (int ph = 0; ph < NPHASE; ++ph) { a.ph_lo = ph; a.ph_hi = ph + 1; hipLaunchKernelGGL(fwd_kernel, dim3(grid), dim3(NW * 64), LDS_BYTES, stream, a); }
#else
    a.ph_lo = 0; a.ph_hi = NPHASE;
    void* kargs[] = {&a};
    hipError_t e = hipLaunchCooperativeKernel((const void*)fwd_kernel, dim3(grid), dim3(NW * 64), kargs, LDS_BYTES, stream);
    if (e != hipSuccess) fprintf(stderr, "cooperative launch failed: %s (grid %d)\n", hipGetErrorString(e), grid);
#endif
}
```

```cpp
#include <hip/hip_runtime.h>
#include <hip/hip_bf16.h>
#include <hip/hip_cooperative_groups.h>
#include <cstdio>
#include <cstdint>
namespace cg = cooperative_groups;

#ifndef PROBE
#define PROBE 0
#endif
#ifndef STAGGER
#define STAGGER 0
#endif
#ifndef GATE_PF
#define GATE_PF false
#endif
#ifndef MK_MULTI
#define MK_MULTI 0
#endif

#define LAS __attribute__((address_space(3)))
typedef unsigned short bf16_t;
typedef short bf16x8 __attribute__((ext_vector_type(8)));
typedef short s16x4 __attribute__((ext_vector_type(4)));
typedef float f32x2 __attribute__((ext_vector_type(2)));
typedef float f32x4 __attribute__((ext_vector_type(4)));
typedef float f32x16 __attribute__((ext_vector_type(16)));
typedef unsigned u32x2 __attribute__((ext_vector_type(2)));
typedef unsigned u32x4 __attribute__((ext_vector_type(4)));

constexpr int DM = 1024, NPROJ = 6144, DFF = 2816, DEPTH = 2;
constexpr int T_CTX = 4096, T_ALL = 36864;
constexpr int CTX_S = 256, LAT_S = 4096, PAST = 512, SKV_LAT = 4608;
constexpr int PC_Q = 0, PC_U = 1024, PC_K = 1536, PC_V = 1792, PC_XV = 2048, PC_XP = 2560, PC_G = 3072;
constexpr float LN_EPS = 1e-6f;
constexpr float ALPHA = 1.41421356237309515f;
constexpr int NW = 8;
__host__ __device__ constexpr int part_row0(int p) { return p == 0 ? 0 : 20480; }
__host__ __device__ constexpr int part_rows(int p) { return p == 0 ? 20480 : 16384; }

constexpr size_t MiB = 1u << 20;
constexpr size_t WS_MOD = 0;
constexpr size_t WS_BAR = 448 * 1024;
constexpr size_t WS_ROPE = 512 * 1024;
constexpr size_t WS_WSGU = 768 * 1024;
constexpr size_t WS_WIN = 1 * MiB;
constexpr size_t WS_WM = 25 * MiB;
constexpr size_t WS_WOUT = 33 * MiB;
constexpr size_t WS_WF1 = 37 * MiB;
constexpr size_t WS_WF2 = 59 * MiB;
constexpr size_t WS_ACT = 70 * MiB;
constexpr size_t WS_PROJ = 142 * MiB;
constexpr size_t WS_KL = 382 * MiB, WS_VL = 391 * MiB;
constexpr size_t WS_KC = 400 * MiB, WS_VC = 402 * MiB;
constexpr size_t WS_VRT = 404 * MiB;
constexpr size_t WS_XBUF = 424 * MiB;
constexpr size_t WS_CNT = 426 * MiB;
constexpr int CNT_WORDS = 4 * 144 * 64;
constexpr size_t WS_XB = 427 * MiB;
constexpr size_t WS_END = 499 * MiB;

constexpr int LDS_BYTES = 143360;
constexpr int LDS_XCH = 131072 + 256;

__device__ __forceinline__ unsigned cvt_pk_bf16(float lo, float hi) { unsigned r; asm volatile("v_cvt_pk_bf16_f32 %0, %1, %2" : "=v"(r) : "v"(lo), "v"(hi)); return r; }
__device__ __forceinline__ float bf_lo(unsigned u) { return __uint_as_float(u << 16); }
__device__ __forceinline__ float bf_hi(unsigned u) { return __uint_as_float(u & 0xffff0000u); }
__device__ __forceinline__ float wave_sum(float v) {
#pragma unroll
    for (int o = 1; o < 64; o <<= 1) v += __shfl_xor(v, o);
    return v;
}
__device__ __forceinline__ float gelu1(float v) {
    const float av = fabsf(v), d = av * 0.2316418882f + 1.0f;
    const float t = __builtin_amdgcn_rcpf(d);
    float q = t * 0.5307027145f + (-0.7265760135f); q = q * t + 0.7107068705f; q = q * t + (-0.142248368f); q = q * t + 0.127414796f; q = q * t;
    const float e = __builtin_amdgcn_exp2f((v * v) * (-0.72134752044f));
    const float m = v * (q * e), r = v - m;
    return v < 0.f ? m : r;
}
__device__ __forceinline__ float sigmoidf_(float x) { return __builtin_amdgcn_rcpf(1.0f + __expf(-x)); }

namespace pg8 {
constexpr int BM = 256, BK = 64, HALF = 128, HTB = HALF * BK * 2, STAGE_BYTES = 8 * HTB, NXCD = 8, WGM = 8;
__host__ __device__ __forceinline__ int lds_byte(int r, int c) { const int st = (r >> 4) * 2 + (c >> 5), rr = r & 15, cc = c & 31, ob = rr * 64 + cc * 2; return st * 1024 + (ob ^ (((ob >> 9) & 1) << 5)); }
__host__ __device__ __forceinline__ void stage_rc(int b, int& R, int& C) { const int st = b / 1024, sb = b % 1024, swz = sb ^ (((sb >> 9) & 1) << 5); R = (st >> 1) * 16 + swz / 64; C = (st & 1) * 32 + (swz % 64) / 2; }
__host__ __device__ __forceinline__ int perm32(int rho) { const int n = rho >> 4, i = rho & 15; return 8 * (i >> 2) + 4 * n + (i & 3); }

struct Unit { int pm, pn, seg; };
struct Gemm { const bf16_t* A; const bf16_t* Bt; int lda, ldb, nM, nN, nseg; int k0[3]; int nt[3]; };

struct Order {
    int nM, nN, nwg, G, c, nseg, team, stagger;
    __device__ void init(int nM_, int nN_, int nseg_, int G_, int c_, int team_ = 0, int stagger_ = 0) { nM = nM_; nN = nN_; nwg = nM * nN; G = G_; c = c_; nseg = nseg_; team = team_; stagger = stagger_; }
    __device__ bool next(int i, Unit& u) const {
        if (team) {
            u.seg = 0; const int j = c >> 3; u.pn = j & 3; u.pm = i * (G >> 2) + (j >> 2) * 8 + (c & 7); return u.pm < nM;
        }
        const int ti = i / nseg; u.seg = i - ti * nseg;
        const long L = (long)ti * G + c; if (L >= nwg) return false;
        int wgid = (int)L; { const int q = nwg / NXCD, r = nwg % NXCD, xcd = wgid % NXCD, off = wgid / NXCD; wgid = (xcd < r ? xcd * (q + 1) : r * (q + 1) + (xcd - r) * q) + off; }
        const int nig = WGM * nN, gid = wgid / nig, fm = gid * WGM, gsz = (nM - fm) < WGM ? (nM - fm) : WGM;
        u.pm = fm + ((wgid % nig) % gsz); u.pn = (wgid % nig) / gsz; return true;
    }
};

struct EpiStore {
    static constexpr bool PREFETCH = false;
    static constexpr bool PERM = true;
    bf16_t* O; int ldc; int gate_col0;
    __device__ __forceinline__ void run(f32x4 (&acc)[2][2][4][2], const Unit& u, int wr, int wc, int fr, int fq) const {
        const int row0 = u.pm * BM + wr * 64 + fr; const int col0 = u.pn * BM + wc * 32 + 8 * fq;
        const bool gate = u.pn * BM >= gate_col0;
#pragma unroll
        for (int ai = 0; ai < 2; ++ai)
#pragma unroll
            for (int m = 0; m < 4; ++m) { bf16_t* rowp = O + (size_t)(row0 + ai * HALF + m * 16) * ldc + col0;
#pragma unroll
                for (int bj = 0; bj < 2; ++bj) { f32x4 v0 = acc[ai][bj][m][0], v1 = acc[ai][bj][m][1];
                    if (gate) {
#pragma unroll
                        for (int e = 0; e < 4; ++e) { v0[e] = 1.0f + __expf(-fmaxf(v0[e], -80.f)); v1[e] = 1.0f + __expf(-fmaxf(v1[e], -80.f)); } }
                    u32x4 w; w.x = cvt_pk_bf16(v0[0], v0[1]); w.y = cvt_pk_bf16(v0[2], v0[3]); w.z = cvt_pk_bf16(v1[0], v1[1]); w.w = cvt_pk_bf16(v1[2], v1[3]);
                    *(u32x4*)(rowp + bj * HALF) = w; } }
    }
};
struct EpiSwiGLU {
    static constexpr bool PREFETCH = false;
    static constexpr bool PERM = true;
    bf16_t* O; int ldc;
    __device__ __forceinline__ void run(f32x4 (&acc)[2][2][4][2], const Unit& u, int wr, int wc, int fr, int fq) const {
        const int row0 = u.pm * BM + wr * 64 + fr; const int col0 = u.pn * HALF + wc * 32 + 8 * fq;
#pragma unroll
        for (int ai = 0; ai < 2; ++ai)
#pragma unroll
            for (int m = 0; m < 4; ++m) { bf16_t* rowp = O + (size_t)(row0 + ai * HALF + m * 16) * ldc + col0;
                float o[8];
#pragma unroll
                for (int n = 0; n < 2; ++n)
#pragma unroll
                    for (int e = 0; e < 4; ++e) { const float a = acc[ai][0][m][n][e], b = acc[ai][1][m][n][e]; o[n * 4 + e] = a * sigmoidf_(a) * b; }
                u32x4 w; w.x = cvt_pk_bf16(o[0], o[1]); w.y = cvt_pk_bf16(o[2], o[3]); w.z = cvt_pk_bf16(o[4], o[5]); w.w = cvt_pk_bf16(o[6], o[7]);
                *(u32x4*)rowp = w; }
    }
};
struct EpiResid {
    static constexpr bool PREFETCH = false;
    static constexpr bool PERM = false;
    const float* xres_ctx; const float* xres_lat;
    float* out; const float* mod; int goff;
    __device__ __forceinline__ void run(f32x4 (&acc)[2][2][4][2], const Unit& u, int wr, int wc, int fr, int fq) const {
        const int v = u.pm < 16 ? 0 : 1 + ((u.pm - 16) >> 4);
        const float* xb = u.pm < 16 ? xres_ctx + (size_t)u.pm * BM * DM : xres_lat + (size_t)(u.pm - 16) * BM * DM;
        float* ob = out + (size_t)u.pm * BM * DM;
        const int col0 = u.pn * BM + wc * 32 + 4 * fq;
        const float* gp = mod + v * 6144 + goff + col0;
        f32x4 gv[2][2];
#pragma unroll
        for (int bj = 0; bj < 2; ++bj)
#pragma unroll
            for (int n = 0; n < 2; ++n) gv[bj][n] = *(const f32x4*)(gp + bj * HALF + n * 16);
#pragma unroll
        for (int ai = 0; ai < 2; ++ai)
#pragma unroll
            for (int m = 0; m < 4; ++m) { const size_t off = (size_t)(ai * HALF + wr * 64 + m * 16 + fr) * DM + col0;
#pragma unroll
                for (int bj = 0; bj < 2; ++bj)
#pragma unroll
                    for (int n = 0; n < 2; ++n) { const f32x4 x = *(const f32x4*)(xb + off + bj * HALF + n * 16);
                        *(f32x4*)(ob + off + bj * HALF + n * 16) = x * ALPHA + gv[bj][n] * acc[ai][bj][m][n]; } }
    }
};

struct PanelStats {
    unsigned long long* xbuf;
    unsigned* cnt;
    LAS unsigned char* lx;
    __device__ __forceinline__ void run(const f32x4 (&v)[2][2][4][2], const Unit& u, int wr, int wc, int fr, int fq, int wid, int lane) const {
        LAS f32x2* P = (LAS f32x2*)lx; LAS f32x2* S = (LAS f32x2*)(lx + 8192);
#pragma unroll
        for (int ai = 0; ai < 2; ++ai)
#pragma unroll
            for (int m = 0; m < 4; ++m) {
                float s = 0.f;
#pragma unroll
                for (int bj = 0; bj < 2; ++bj)
#pragma unroll
                    for (int n = 0; n < 2; ++n) { const f32x4 x = v[ai][bj][m][n]; s += (x[0] + x[1]) + (x[2] + x[3]); }
                s += __shfl_xor(s, 16); s += __shfl_xor(s, 32);
                const float mw = s * (1.0f / 64.0f); float q = 0.f;
#pragma unroll
                for (int bj = 0; bj < 2; ++bj)
#pragma unroll
                    for (int n = 0; n < 2; ++n) { const f32x4 d = v[ai][bj][m][n] - mw; q += (d[0] * d[0] + d[1] * d[1]) + (d[2] * d[2] + d[3] * d[3]); }
                q += __shfl_xor(q, 16); q += __shfl_xor(q, 32);
                if (fq == 0) P[(ai * HALF + wr * 64 + m * 16 + fr) * 4 + wc] = (f32x2){mw, q};
            }
        asm volatile("s_waitcnt lgkmcnt(0)" ::: "memory"); __builtin_amdgcn_s_barrier(); asm volatile("" ::: "memory");
        const int row = wid * 32 + (lane & 31);
        if (lane < 32) {
            const f32x2 a = P[row * 4 + 0], b = P[row * 4 + 1], c = P[row * 4 + 2], d = P[row * 4 + 3];
            const float mt = (a.x + b.x + c.x + d.x) * 0.25f;
            const float da = a.x - mt, db = b.x - mt, dc = c.x - mt, dd = d.x - mt;
            const float m2 = (a.y + b.y) + (c.y + d.y) + 64.0f * ((da * da + db * db) + (dc * dc + dd * dd));
            unsigned long long* slot = xbuf + ((size_t)(u.pm * BM + row) * 4 + u.pn);
            __hip_atomic_store(slot, ((unsigned long long)__float_as_uint(m2) << 32) | __float_as_uint(mt), __ATOMIC_RELAXED, __HIP_MEMORY_SCOPE_AGENT);
        }
        asm volatile("s_waitcnt vmcnt(0)" ::: "memory");
        if (lane == 0) __hip_atomic_fetch_add(cnt + 64 * u.pm, 1u, __ATOMIC_RELAXED, __HIP_MEMORY_SCOPE_AGENT);
        if (wid == 0) {
            unsigned sp = 0;
            for (;;) {
                if ((unsigned)__builtin_amdgcn_readfirstlane(__hip_atomic_load(cnt + 64 * u.pm, __ATOMIC_RELAXED, __HIP_MEMORY_SCOPE_AGENT)) >= 32u) break;
                if (++sp > (1u << 22)) break;
                __builtin_amdgcn_s_sleep(2);
            }
            __builtin_amdgcn_fence(__ATOMIC_ACQUIRE, "agent");
        }
        asm volatile("s_waitcnt vmcnt(0) lgkmcnt(0)" ::: "memory"); __builtin_amdgcn_s_barrier(); asm volatile("" ::: "memory");
        if (lane < 32) {
            const unsigned long long* slot = xbuf + (size_t)(u.pm * BM + row) * 4; float mt[4], m2[4]; float ms = 0.f;
#pragma unroll
            for (int t = 0; t < 4; ++t) { const unsigned long long w = __hip_atomic_load(slot + t, __ATOMIC_RELAXED, __HIP_MEMORY_SCOPE_AGENT); mt[t] = __uint_as_float((unsigned)w); m2[t] = __uint_as_float((unsigned)(w >> 32)); ms += mt[t]; }
            const float mean = ms * 0.25f; float q = 0.f;
#pragma unroll
            for (int t = 0; t < 4; ++t) { const float dm = mt[t] - mean; q += m2[t] + 256.0f * dm * dm; }
            S[row] = (f32x2){mean, rsqrtf(q * (1.0f / 1024.0f) + LN_EPS)};
        }
        asm volatile("s_waitcnt lgkmcnt(0)" ::: "memory"); __builtin_amdgcn_s_barrier(); asm volatile("" ::: "memory");
    }
};
template <int WHICH, bool INF32, bool OUTF32>
struct EpiResidLn {
    static constexpr bool PERM = false;
    static constexpr bool PREFETCH = false;
    const float* const* in; unsigned char* ws; float* out_; int l; LAS unsigned char* lx;
    __device__ __forceinline__ void prefetch(const Unit& u, int it, int nit, int wid, int lane_) const {
        int lane = lane_; asm volatile("" : "+v"(lane));
        const float* xb = (WHICH == 0 && l == 0) ? (u.pm < 16 ? in[0] + (size_t)u.pm * BM * DM : in[1] + (size_t)(u.pm - 16) * BM * DM) : out_ + (size_t)u.pm * BM * DM;
        const int R = nit >= 16 ? 2 : 4;
#pragma unroll
        for (int k = 0; k < 4; ++k) { const int j = it * R + k;
            if (k < R && j < 32) __builtin_amdgcn_global_load_lds((const unsigned*)(xb + (size_t)(j * 8 + wid) * DM + u.pn * BM + lane * 4), (LAS unsigned*)(lx + 10240), 16, 0, 0); }
    }
    __device__ __forceinline__ void run(f32x4 (&acc)[2][2][4][2], const Unit& u, int wr, int wc, int fr_, int fq_) const {
        int fr = fr_, fq = fq_; asm volatile("" : "+v"(fr), "+v"(fq));
        int lv = l; asm volatile("" : "+v"(lv)); lv = __builtin_amdgcn_readfirstlane(lv);
        const float* mod = (const float*)(ws + 0) + lv * 9 * 6144;
        float* out = out_;
        const float* xres_ctx = (WHICH == 0 && lv == 0) ? in[0] : out;
        const float* xres_lat = (WHICH == 0 && lv == 0) ? in[1] : out + (size_t)T_CTX * DM;
        const int goff = WHICH == 0 ? 2048 : 5120;
        const float* lg = in[WHICH == 0 ? 19 : 23] + lv * DM; const float* lb = in[WHICH == 0 ? 20 : 24] + lv * DM;
        bf16_t* act = (bf16_t*)(ws + (size_t)70 * 1048576);
        const float* modn = WHICH == 0 ? mod : (const float*)(ws + 0) + (lv + 1 < DEPTH ? lv + 1 : lv) * 9 * 6144;
        const int sh_off = WHICH == 0 ? 3072 : 0, sc_off = WHICH == 0 ? 4096 : 1024;
        PanelStats st{(unsigned long long*)(ws + (size_t)424 * 1048576), (unsigned*)(ws + (size_t)426 * 1048576) + (lv * 2 + WHICH) * 144 * 64, lx};
        const int v = u.pm < 16 ? 0 : 1 + ((u.pm - 16) >> 4);
        const float* xb = u.pm < 16 ? xres_ctx + (size_t)u.pm * BM * DM : xres_lat + (size_t)(u.pm - 16) * BM * DM;
        float* ob = out + (size_t)u.pm * BM * DM;
        bf16_t* xs = (bf16_t*)(ws + (size_t)427 * 1048576);
        const int col0 = u.pn * BM + wc * 32 + 4 * fq;
        const size_t roff = (size_t)(wr * 64 + fr) * DM + col0;
        {
            const float* gp = mod + v * 6144 + goff + col0;
#pragma unroll
            for (int bj = 0; bj < 2; ++bj)
#pragma unroll
                for (int n = 0; n < 2; ++n) { const f32x4 gv = *(const f32x4*)(gp + bj * HALF + n * 16);
#pragma unroll
                    for (int ai = 0; ai < 2; ++ai) {
#pragma unroll
                        for (int m = 0; m < 4; ++m) { f32x4 x; const size_t o_ = roff + (size_t)(ai * HALF + m * 16) * DM + bj * HALF + n * 16;
                            if (INF32) x = *(const f32x4*)(xb + o_);
                            else { const u32x2 w = *(const u32x2*)(xs + (size_t)u.pm * BM * DM + o_); x = (f32x4){bf_lo(w.x), bf_hi(w.x), bf_lo(w.y), bf_hi(w.y)}; }
                            acc[ai][bj][m][n] = x * ALPHA + gv * acc[ai][bj][m][n]; }
#pragma unroll
                        for (int m = 0; m < 4; ++m) asm volatile("" : "+v"(acc[ai][bj][m][n]));
                        asm volatile("" ::: "memory"); } }
        }
        const int lane = fq * 16 + fr, wid = wr * 4 + wc;
        st.run(acc, u, wr, wc, fr, fq, wid, lane);
        const LAS f32x2* S = (const LAS f32x2*)(st.lx + 8192);
        const float* mv = modn + v * 6144;
#pragma unroll
        for (int bj = 0; bj < 2; ++bj)
#pragma unroll
            for (int n = 0; n < 2; ++n) { const int c = col0 + bj * HALF + n * 16;
                const f32x4 g4 = *(const f32x4*)(lg + c), b4 = *(const f32x4*)(lb + c);
                f32x4 sh = (f32x4){0.f, 0.f, 0.f, 0.f}, sc = sh;
                sh = *(const f32x4*)(mv + sh_off + c); sc = *(const f32x4*)(mv + sc_off + c) + 1.0f;
#pragma unroll
                for (int ai = 0; ai < 2; ++ai)
#pragma unroll
                    for (int m = 0; m < 4; ++m) { const size_t off = roff + (size_t)(ai * HALF + m * 16) * DM + bj * HALF + n * 16;
                        const f32x2 sr = S[ai * HALF + wr * 64 + m * 16 + fr];
                        const f32x4 y = (acc[ai][bj][m][n] - sr.x) * sr.y * g4 + b4;
                        if (OUTF32) *(f32x4*)(ob + off) = y;
                        else { u32x2 w; w.x = cvt_pk_bf16(y[0], y[1]); w.y = cvt_pk_bf16(y[2], y[3]); *(u32x2*)(xs + (size_t)u.pm * BM * DM + off) = w; }
                        if (WHICH == 0 || lv + 1 < DEPTH) { const f32x4 h = y * sc + sh; u32x2 w; w.x = cvt_pk_bf16(h[0], h[1]); w.y = cvt_pk_bf16(h[2], h[3]);
                            *(u32x2*)(act + (size_t)u.pm * BM * DM + off) = w; } }
                asm volatile("" ::: "memory"); }
    }
};
struct EpiGate {
    static constexpr bool PERM = true;
    static constexpr bool PREFETCH = GATE_PF;
    LAS unsigned char* lx;
    __device__ __forceinline__ void prefetch(const Unit& u, int it, int nit, int wid, int lane_) const {
        if (u.seg == 2) return;
        int lane = lane_; asm volatile("" : "+v"(lane));
        const bf16_t* gb = P + (size_t)u.pm * BM * NPROJ + PC_G + u.pn * BM + (lane & 31) * 8;
#pragma unroll
        for (int k = 0; k < 4; ++k) { const int j = it * 4 + k;
            const int tile = u.seg == 0 ? (j >> 4) : 0; const int goff = u.seg == 0 ? (tile == 0 ? 0 : 2048) : 1024; const int jr = j & 15;
            if (j < (u.seg == 0 ? 32 : 16)) __builtin_amdgcn_global_load_lds((const unsigned*)(gb + (size_t)(jr * 16 + wid * 2 + (lane >> 5)) * NPROJ + goff), (LAS unsigned*)(lx + 10240), 16, 0, 0); }
    }
    const bf16_t* P;
    bf16_t* O; int ldc;
    __device__ __forceinline__ void run(f32x4 (&acc)[2][2][4][2], const Unit& u, int wr, int wc, int fr, int fq) const {
        const int row0 = u.pm * BM + wr * 64 + fr; const int col0 = u.pn * BM + wc * 32 + 8 * fq;
        const int noff = u.seg == 0 ? 0 : (u.seg == 1 ? 2048 : 1024), doff = u.seg == 0 ? 2048 : 1024;
        const bool last = u.seg == 2;
#pragma unroll
        for (int ai = 0; ai < 2; ++ai)
#pragma unroll
            for (int m = 0; m < 4; ++m) { const size_t r = (size_t)(row0 + ai * HALF + m * 16);
                const bf16_t* gp = P + r * NPROJ + PC_G + col0;
#pragma unroll
                for (int bj = 0; bj < 2; ++bj) {
                    const u32x4 gn = *(const u32x4*)(gp + noff + bj * HALF);
                    u32x4 gd = gn; if (!last) gd = *(const u32x4*)(gp + doff + bj * HALF);
                    float f[8];
#pragma unroll
                    for (int e = 0; e < 4; ++e) {
                        const float r0 = __builtin_amdgcn_rcpf(bf_lo(gn[e])), r1 = __builtin_amdgcn_rcpf(bf_hi(gn[e]));
                        if (last) { f[2 * e] = r0; f[2 * e + 1] = r1; }
                        else { f[2 * e] = bf_lo(gd[e]) * r0; f[2 * e + 1] = bf_hi(gd[e]) * r1; }
                    }
                    f32x4 v0 = acc[ai][bj][m][0], v1 = acc[ai][bj][m][1];
                    v0[0] *= f[0]; v0[1] *= f[1]; v0[2] *= f[2]; v0[3] *= f[3]; v1[0] *= f[4]; v1[1] *= f[5]; v1[2] *= f[6]; v1[3] *= f[7];
                    if (last) { u32x4 w; w.x = cvt_pk_bf16(v0[0], v0[1]); w.y = cvt_pk_bf16(v0[2], v0[3]); w.z = cvt_pk_bf16(v1[0], v1[1]); w.w = cvt_pk_bf16(v1[2], v1[3]);
                        *(u32x4*)(O + r * ldc + col0 + bj * HALF) = w; }
                    else { acc[ai][bj][m][0] = v0; acc[ai][bj][m][1] = v1; }
                } }
    }
};

struct EpiNone { static constexpr bool PREFETCH = false; static constexpr bool PERM = true; __device__ __forceinline__ void run(f32x4 (&acc)[2][2][4][2], const Unit& u, int wr, int wc, int fr, int fq) const {
    _Pragma("unroll") for (int a = 0; a < 2; ++a) _Pragma("unroll") for (int b = 0; b < 2; ++b) _Pragma("unroll") for (int m = 0; m < 4; ++m) _Pragma("unroll") for (int n = 0; n < 2; ++n) asm volatile("" :: "v"(acc[a][b][m][n])); } };
template <class Epi>
__device__ __forceinline__ void gemm_phase(LAS unsigned char* lds, const Gemm g, const Order& S, const Epi& E, const int tid) {
    const int wid = __builtin_amdgcn_readfirstlane(tid >> 6), lane = tid & 63, wr = wid >> 2, wc = wid & 3, fr = lane & 15, fq = lane >> 4;
    unsigned voffA[2], voffB[2];
#pragma unroll
    for (int i = 0; i < 2; ++i) { int R, C; stage_rc(tid * 16 + i * 8192, R, C); const int Rb = Epi::PERM ? ((R & ~31) + perm32(R & 31)) : R;
        voffA[i] = (unsigned)(R * g.lda + C) * 2u; voffB[i] = (unsigned)(Rb * g.ldb + C) * 2u; }
    const size_t kstep = (size_t)(BK * 2);
    const size_t hstepA = (size_t)HALF * g.lda * 2, hstepB = (size_t)HALF * g.ldb * 2;
    const size_t tstepA = 2 * hstepA, tstepB = 2 * hstepB;
    const unsigned ldsw = (unsigned)wid * 1024u;
    const int aoff = lds_byte(wr * 64 + fr, fq * 8), boff = lds_byte(wc * 32 + fr, fq * 8);
#define PG8_SA(b, h) (((b) * 2 + (h)) * HTB)
#define PG8_SB(b, h) ((4 + (b) * 2 + (h)) * HTB)
#define PG8_STAGE(bufoff, gbase, voff) do { _Pragma("unroll") for (int _i = 0; _i < 2; ++_i) \
        __builtin_amdgcn_global_load_lds((const unsigned*)((const char*)(gbase) + (voff)[_i]), (LAS unsigned*)(lds + (bufoff) + ldsw + _i * 8192), 16, 0, 0); } while (0)
#define PG8_LDA(dst, b, h) do { _Pragma("unroll") for (int m = 0; m < 4; ++m) _Pragma("unroll") for (int k = 0; k < 2; ++k) dst[m][k] = *(const LAS bf16x8*)(lds + PG8_SA(b, h) + aoff + m * 2048 + k * 1024); } while (0)
#define PG8_LDB(dst, b, h) do { _Pragma("unroll") for (int n = 0; n < 2; ++n) _Pragma("unroll") for (int k = 0; k < 2; ++k) dst[n][k] = *(const LAS bf16x8*)(lds + PG8_SB(b, h) + boff + n * 2048 + k * 1024); } while (0)
#define PG8_MMA(ai, bj, At, Bt) do { __builtin_amdgcn_s_setprio(1); _Pragma("unroll") for (int m = 0; m < 4; ++m) _Pragma("unroll") for (int n = 0; n < 2; ++n) _Pragma("unroll") for (int k = 0; k < 2; ++k) \
        acc[ai][bj][m][n] = __builtin_amdgcn_mfma_f32_16x16x32_bf16(Bt[n][k], At[m][k], acc[ai][bj][m][n], 0, 0, 0); __builtin_amdgcn_s_setprio(0); } while (0)
#define PG8_WAIT_V(n) asm volatile("s_waitcnt vmcnt(" #n ")" ::: "memory")
#define PG8_WAIT_L(n) asm volatile("s_waitcnt lgkmcnt(" #n ")" ::: "memory")
#define PG8_BAR __builtin_amdgcn_s_barrier()
#define PG8_SCHED __builtin_amdgcn_sched_barrier(0)
#define KOF(sg) ((sg) == 0 ? g.k0[0] : ((sg) == 1 ? g.k0[1] : g.k0[2]))
#define NTF(sg) ((sg) == 0 ? g.nt[0] : ((sg) == 1 ? g.nt[1] : g.nt[2]))
    Unit cur, nxt; int ui = 0;
    if (!S.next(0, cur)) return;
    if (S.stagger) {
        const int mine = (S.nwg - S.c + S.G - 1) / S.G, mx = (S.nwg + S.G - 1) / S.G;
        if (mine < mx) { const unsigned long long t0 = __builtin_amdgcn_s_memrealtime(); while (__builtin_amdgcn_s_memrealtime() - t0 < (unsigned long long)S.stagger) __builtin_amdgcn_s_sleep(16); }
    }
    f32x4 acc[2][2][4][2];
#pragma unroll
    for (int a = 0; a < 2; ++a)
#pragma unroll
        for (int b = 0; b < 2; ++b)
#pragma unroll
            for (int m = 0; m < 4; ++m)
#pragma unroll
                for (int n = 0; n < 2; ++n) acc[a][b][m][n] = (f32x4){0.f, 0.f, 0.f, 0.f};
    bf16x8 At[4][2], B0[2][2], B1[2][2];
    const char* cA = (const char*)g.A + (size_t)cur.pm * tstepA + (size_t)KOF(cur.seg) * 2; const char* cB = (const char*)g.Bt + (size_t)cur.pn * tstepB + (size_t)KOF(cur.seg) * 2;
    PG8_STAGE(PG8_SB(0, 0), cB, voffB); PG8_STAGE(PG8_SB(0, 1), cB + hstepB, voffB); PG8_STAGE(PG8_SA(0, 0), cA, voffA); PG8_STAGE(PG8_SA(0, 1), cA + hstepA, voffA);
    if (wr == 1) PG8_BAR;
    PG8_WAIT_V(2); PG8_BAR;
    PG8_STAGE(PG8_SB(1, 0), cB + kstep, voffB); PG8_STAGE(PG8_SA(1, 0), cA + kstep, voffA); PG8_STAGE(PG8_SB(1, 1), cB + hstepB + kstep, voffB);
    PG8_WAIT_V(6); PG8_BAR;
    for (;;) {
        const bool has_next = S.next(ui + 1, nxt);
        const int nt = NTF(cur.seg);
        const char* nA = has_next ? (const char*)g.A + (size_t)nxt.pm * tstepA + (size_t)KOF(nxt.seg) * 2 : cA;
        const char* nB = has_next ? (const char*)g.Bt + (size_t)nxt.pn * tstepB + (size_t)KOF(nxt.seg) * 2 : cB;
        for (int t = 0; t < nt; t += 2) {
            const bool last = (t == nt - 2);
            const char* a1 = cA + (size_t)(t + 1) * kstep;
            const char* a2 = last ? nA : cA + (size_t)(t + 2) * kstep; const char* b2 = last ? nB : cB + (size_t)(t + 2) * kstep;
            const char* a3 = a2 + kstep; const char* b3 = b2 + kstep;
            PG8_LDB(B0, 0, 0); PG8_LDB(B1, 0, 1); PG8_SCHED; PG8_LDA(At, 0, 0); PG8_STAGE(PG8_SA(1, 1), a1 + hstepA, voffA);
            if constexpr (Epi::PREFETCH) E.prefetch(cur, t >> 1, nt >> 1, wid, lane);
            PG8_WAIT_V(8); PG8_WAIT_L(0); PG8_BAR; PG8_MMA(0, 0, At, B0); PG8_MMA(0, 1, At, B1); PG8_BAR; PG8_SCHED;
            PG8_LDA(At, 0, 1); PG8_STAGE(PG8_SB(0, 0), b2, voffB); PG8_STAGE(PG8_SB(0, 1), b2 + hstepB, voffB); PG8_STAGE(PG8_SA(0, 0), a2, voffA);
            PG8_WAIT_V(8); PG8_WAIT_L(0); PG8_BAR; PG8_MMA(1, 0, At, B0); PG8_MMA(1, 1, At, B1); PG8_BAR; PG8_SCHED;
            PG8_LDB(B0, 1, 0); PG8_LDB(B1, 1, 1); PG8_SCHED; PG8_LDA(At, 1, 0); PG8_STAGE(PG8_SA(0, 1), a2 + hstepA, voffA);
            PG8_WAIT_V(8); PG8_WAIT_L(0); PG8_BAR; PG8_MMA(0, 0, At, B0); PG8_MMA(0, 1, At, B1); PG8_BAR; PG8_SCHED;
            PG8_LDA(At, 1, 1); PG8_STAGE(PG8_SB(1, 0), b3, voffB); PG8_STAGE(PG8_SB(1, 1), b3 + hstepB, voffB); PG8_STAGE(PG8_SA(1, 0), a3, voffA);
            PG8_WAIT_V(8); PG8_WAIT_L(0); PG8_BAR; PG8_MMA(1, 0, At, B0); PG8_MMA(1, 1, At, B1); PG8_BAR; PG8_SCHED;
        }
        if (wr == 0) PG8_BAR;
        E.run(acc, cur, wr, wc, fr, fq);
        if (!has_next) break;
        if (cur.seg == g.nseg - 1) {
#pragma unroll
            for (int a = 0; a < 2; ++a)
#pragma unroll
                for (int b = 0; b < 2; ++b)
#pragma unroll
                    for (int m = 0; m < 4; ++m)
#pragma unroll
                        for (int n = 0; n < 2; ++n) acc[a][b][m][n] = (f32x4){0.f, 0.f, 0.f, 0.f};
        }
        cur = nxt; cA = nA; cB = nB; ++ui;
        if (wr == 1) PG8_BAR;
    }
    PG8_WAIT_V(0);
    PG8_BAR;
#undef KOF
#undef NTF
#undef PG8_SA
#undef PG8_SB
#undef PG8_STAGE
#undef PG8_LDA
#undef PG8_LDB
#undef PG8_MMA
#undef PG8_WAIT_V
#undef PG8_WAIT_L
#undef PG8_BAR
#undef PG8_SCHED
}
}

namespace att {
constexpr int D = 128, QBLK = 32, KVBLK = 64;
constexpr float SCALE = 0.088388347648318440f;
constexpr float THR = 8.f;
constexpr size_t SHM_V = KVBLK * D * 2, SHM_K = KVBLK * D * 2, SHM_ATTN = 2 * SHM_V + 2 * SHM_K + NW * 64 * 4;
#define KSWZ(row, colB) ((row) * 256 + ((colB) ^ (((row) & 7) << 4)))
#define SBAR() __builtin_amdgcn_sched_barrier(0)
__device__ __forceinline__ int crow(int r, int hi) { return (r & 3) + 8 * (r >> 2) + 4 * hi; }
__device__ __forceinline__ unsigned cvtpk(float lo, float hi) { unsigned r; asm volatile("v_cvt_pk_bf16_f32 %0, %1, %2" : "=v"(r) : "v"(lo), "v"(hi)); return r; }
__device__ __forceinline__ void partialSM(f32x16& p0, f32x16& p1, float& m_reg, float& mn, float& alpha) {
  constexpr float C = SCALE * 1.4426950408889634f;
  float pmax = p0[0];
#pragma unroll
  for (int r = 1; r < 16; ++r) pmax = fmaxf(pmax, p0[r]);
#pragma unroll
  for (int r = 0; r < 16; ++r) pmax = fmaxf(pmax, p1[r]);
  { auto rr = __builtin_amdgcn_permlane32_swap(__float_as_uint(pmax), __float_as_uint(pmax), false, false);
    pmax = fmaxf(__uint_as_float(rr[0]), __uint_as_float(rr[1])); }
  if (__builtin_expect(__all(pmax - m_reg <= THR / SCALE), 1)) { mn = m_reg; alpha = 1.f; }
  else { mn = fmaxf(m_reg, pmax); alpha = __builtin_amdgcn_exp2f((m_reg - mn) * C); m_reg = mn; }
  float mnC = -mn * C;
#pragma unroll
  for (int r = 0; r < 16; ++r) p0[r] = fmaf(p0[r], C, mnC);
#pragma unroll
  for (int r = 0; r < 16; ++r) p1[r] = fmaf(p1[r], C, mnC);
#pragma unroll
  for (int r = 0; r < 16; ++r) p0[r] = __builtin_amdgcn_exp2f(p0[r]);
}
__device__ __forceinline__ void finishSM(f32x16& p0, f32x16& p1, float alpha, float& l_reg, bf16x8& pa0, bf16x8& pa1, bf16x8& pa2, bf16x8& pa3) {
#pragma unroll
  for (int r = 0; r < 16; ++r) p1[r] = __builtin_amdgcn_exp2f(p1[r]);
  float ps = 0;
#pragma unroll
  for (int r = 0; r < 16; ++r) ps += p0[r];
#pragma unroll
  for (int r = 0; r < 16; ++r) ps += p1[r];
  { auto rr = __builtin_amdgcn_permlane32_swap(__float_as_uint(ps), __float_as_uint(ps), false, false);
    ps = __uint_as_float(rr[0]) + __uint_as_float(rr[1]); }
  l_reg = l_reg * alpha + ps;
#define PK4(P, BASE, OUT) do { unsigned a0 = cvtpk(P[BASE + 0], P[BASE + 1]), a1 = cvtpk(P[BASE + 2], P[BASE + 3]);   \
    unsigned b0 = cvtpk(P[BASE + 4], P[BASE + 5]), b1 = cvtpk(P[BASE + 6], P[BASE + 7]);                              \
    auto r0 = __builtin_amdgcn_permlane32_swap(a0, b0, false, false); auto r1 = __builtin_amdgcn_permlane32_swap(a1, b1, false, false); \
    u32x4 w = {r0[0], r1[0], r0[1], r1[1]}; OUT = *reinterpret_cast<bf16x8*>(&w); } while (0)
  PK4(p0, 0, pa0); PK4(p0, 8, pa1); PK4(p1, 0, pa2); PK4(p1, 8, pa3);
#undef PK4
}
__device__ __forceinline__ void qkt(f32x16& p0, f32x16& p1, const bf16_t* Ks, const bf16x8* qr, int r32, int hi) {
  p0 = f32x16{}; p1 = f32x16{};
#pragma unroll
  for (int d0 = 0; d0 < 8; ++d0) { int cb = (d0 * 16 + hi * 8) * 2;
    bf16x8 b0 = *reinterpret_cast<const bf16x8*>((const char*)Ks + KSWZ(r32, cb));
    bf16x8 b1 = *reinterpret_cast<const bf16x8*>((const char*)Ks + KSWZ(32 + r32, cb));
    p0 = __builtin_amdgcn_mfma_f32_32x32x16_bf16(b0, qr[d0], p0, 0, 0, 0);
    p1 = __builtin_amdgcn_mfma_f32_32x32x16_bf16(b1, qr[d0], p1, 0, 0, 0); }
}
__device__ __forceinline__ int v_st(int k, int c) { const int kk = (k & ~0xC) | ((k & 4) << 1) | ((k & 8) >> 1); return ((kk >> 3) * 4 + (c >> 5)) * 512 + ((kk & 7) * 32 + (c & 31)) * 2; }
__device__ __forceinline__ int v_rd_base(int lane) { return ((lane & 3) << 3) | (((lane >> 2) & 3) << 6) | (((lane >> 4) & 1) << 5) | (((lane >> 5) & 1) << 8); }
constexpr int v_rd_off(int d0, int ks, int half) { return d0 * 512 + ks * 4096 + half * 2048; }
template <int OFF> __device__ __forceinline__ s16x4 tr_read(int vb) {
  s16x4 r; asm volatile("ds_read_b64_tr_b16 %0, %1 offset:%2" : "=&v"(r) : "v"(vb), "i"(OFF) : "memory"); return r;
}
template <int D0> __device__ __forceinline__ void pv_one(f32x16& od, int vb, bf16x8 pa0, bf16x8 pa1, bf16x8 pa2, bf16x8 pa3) {
  const s16x4 l0 = tr_read<v_rd_off(D0, 0, 0)>(vb), h0 = tr_read<v_rd_off(D0, 0, 1)>(vb), l1 = tr_read<v_rd_off(D0, 1, 0)>(vb), h1 = tr_read<v_rd_off(D0, 1, 1)>(vb);
  const s16x4 l2 = tr_read<v_rd_off(D0, 2, 0)>(vb), h2 = tr_read<v_rd_off(D0, 2, 1)>(vb), l3 = tr_read<v_rd_off(D0, 3, 0)>(vb), h3 = tr_read<v_rd_off(D0, 3, 1)>(vb);
  asm volatile("s_waitcnt lgkmcnt(0)" ::: "memory"); SBAR();
#define PK(L, H) (bf16x8){L[0], L[1], L[2], L[3], H[0], H[1], H[2], H[3]}
  od = __builtin_amdgcn_mfma_f32_32x32x16_bf16(pa0, PK(l0, h0), od, 0, 0, 0);
  od = __builtin_amdgcn_mfma_f32_32x32x16_bf16(pa1, PK(l1, h1), od, 0, 0, 0);
  od = __builtin_amdgcn_mfma_f32_32x32x16_bf16(pa2, PK(l2, h2), od, 0, 0, 0);
  od = __builtin_amdgcn_mfma_f32_32x32x16_bf16(pa3, PK(l3, h3), od, 0, 0, 0);
#undef PK
}
__device__ __forceinline__ void pv_d0(f32x16* o, int vb, bf16x8 pa0, bf16x8 pa1, bf16x8 pa2, bf16x8 pa3) {
  pv_one<0>(o[0], vb, pa0, pa1, pa2, pa3); pv_one<1>(o[1], vb, pa0, pa1, pa2, pa3); pv_one<2>(o[2], vb, pa0, pa1, pa2, pa3); pv_one<3>(o[3], vb, pa0, pa1, pa2, pa3);
}
constexpr int LDQ = NPROJ, LDK = 256;
__device__ __forceinline__ void attn_dense_body(bf16_t* Qb, const bf16_t* __restrict__ Kh, const bf16_t* __restrict__ Vh, int seq, char* lds, const int tid, const float* __restrict__ qg, const float* __restrict__ rope, int s0, const bool STORE = true) {
  const int wid = tid >> 6, lane = tid & 63, r32 = lane & 31, hi = lane >> 5;
  bf16_t* V_lds = (bf16_t*)lds; bf16_t* K_lds = (bf16_t*)(lds + 2 * SHM_V);
  float* ws = (float*)(lds + 2 * SHM_V + 2 * SHM_K) + wid * 64; float* li_l = ws; float* al_l = ws + 32;
  float m_reg = -1e30f, l_reg = 0; f32x16 o[4] = {}; bf16x8 qr[8];
  const bf16_t* Qw = Qb + (long)(wid * QBLK + r32) * LDQ + hi * 8;
#pragma unroll
  for (int d0 = 0; d0 < 8; ++d0) qr[d0] = *reinterpret_cast<const bf16x8*>(Qw + d0 * 16);
  {
    float ss = 0.f;
#pragma unroll
    for (int d0 = 0; d0 < 8; ++d0) { const u32x4 w = __builtin_bit_cast(u32x4, qr[d0]);
#pragma unroll
      for (int e = 0; e < 4; ++e) { const float lo = __uint_as_float(w[e] << 16), hi_ = __uint_as_float(w[e] & 0xffff0000u); ss += lo * lo + hi_ * hi_; } }
    { auto rr = __builtin_amdgcn_permlane32_swap(__float_as_uint(ss), __float_as_uint(ss), false, false); ss = __uint_as_float(rr[0]) + __uint_as_float(rr[1]); }
    const float rinv = rsqrtf(ss * (1.0f / 128.0f) + LN_EPS);
    const int sp = s0 + wid * QBLK + r32;
#pragma unroll
    for (int a = 0; a < 2; ++a) {
      float qf[4][8];
#pragma unroll
      for (int dd = 0; dd < 4; ++dd) { const int d0 = a * 4 + dd; const u32x4 w = __builtin_bit_cast(u32x4, qr[d0]);
        const f32x4 g0 = *(const f32x4*)(qg + d0 * 16 + hi * 8), g1 = *(const f32x4*)(qg + d0 * 16 + hi * 8 + 4);
        qf[dd][0] = __uint_as_float(w[0] << 16) * (rinv * g0[0]); qf[dd][1] = __uint_as_float(w[0] & 0xffff0000u) * (rinv * g0[1]);
        qf[dd][2] = __uint_as_float(w[1] << 16) * (rinv * g0[2]); qf[dd][3] = __uint_as_float(w[1] & 0xffff0000u) * (rinv * g0[3]);
        qf[dd][4] = __uint_as_float(w[2] << 16) * (rinv * g1[0]); qf[dd][5] = __uint_as_float(w[2] & 0xffff0000u) * (rinv * g1[1]);
        qf[dd][6] = __uint_as_float(w[3] << 16) * (rinv * g1[2]); qf[dd][7] = __uint_as_float(w[3] & 0xffff0000u) * (rinv * g1[3]); }
      if (rope) { const int pos = a == 0 ? (sp >> 6) : (sp & 63);
#pragma unroll
        for (int dd = 0; dd < 2; ++dd) { const float* cp = rope + pos * 32 + dd * 16 + hi * 8;
          const f32x4 c0 = *(const f32x4*)cp, c1 = *(const f32x4*)(cp + 4), s0v = *(const f32x4*)(cp + 2048), s1v = *(const f32x4*)(cp + 2048 + 4);
#pragma unroll
          for (int e = 0; e < 4; ++e) { float x1 = qf[dd][e], x2 = qf[dd + 2][e]; qf[dd][e] = x1 * c0[e] - x2 * s0v[e]; qf[dd + 2][e] = x2 * c0[e] + x1 * s0v[e];
            x1 = qf[dd][4 + e]; x2 = qf[dd + 2][4 + e]; qf[dd][4 + e] = x1 * c1[e] - x2 * s1v[e]; qf[dd + 2][4 + e] = x2 * c1[e] + x1 * s1v[e]; } } }
#pragma unroll
      for (int dd = 0; dd < 4; ++dd) { u32x4 w; w.x = cvtpk(qf[dd][0], qf[dd][1]); w.y = cvtpk(qf[dd][2], qf[dd][3]); w.z = cvtpk(qf[dd][4], qf[dd][5]); w.w = cvtpk(qf[dd][6], qf[dd][7]); qr[a * 4 + dd] = __builtin_bit_cast(bf16x8, w); }
      asm volatile("" ::: "memory");
    }
  }
  int tid2 = tid; asm volatile("" : "+v"(tid2));
  const int sr = tid2 >> 4, sc = (tid2 & 15) * 8, vst0 = v_st(sr, sc), vst1 = v_st(32 + sr, sc);
  const int vb0 = (int)(uintptr_t)V_lds + v_rd_base(tid2 & 63);
  struct { bf16x8 vs0, vs1, ks0, ks1; } sr_[1];
#define LD8(p) (*reinterpret_cast<const bf16x8*>(p))
#define SLOAD(i, k0) do { sr_[i].vs0 = LD8(&Vh[(long)((k0) + sr) * LDK + sc]); sr_[i].vs1 = LD8(&Vh[(long)((k0) + 32 + sr) * LDK + sc]); \
    sr_[i].ks0 = LD8(&Kh[(long)((k0) + sr) * LDK + sc]); sr_[i].ks1 = LD8(&Kh[(long)((k0) + 32 + sr) * LDK + sc]); } while (0)
#define SWRITE(b, i) do { *(bf16x8*)((char*)V_lds + (b) * SHM_V + vst0) = sr_[i].vs0;          \
    *(bf16x8*)((char*)V_lds + (b) * SHM_V + vst1) = sr_[i].vs1; int kc = sc * 2;               \
    *(bf16x8*)((char*)K_lds + (b) * SHM_K + KSWZ(sr, kc)) = sr_[i].ks0;                       \
    *(bf16x8*)((char*)K_lds + (b) * SHM_K + KSWZ(32 + sr, kc)) = sr_[i].ks1; } while (0)
#define SWAIT() asm volatile("s_waitcnt vmcnt(0)" ::: "memory")
#define RESC(a) do { if (__any((a) < 1.f)) { if (hi == 0) al_l[r32] = (a); asm volatile("s_waitcnt lgkmcnt(0)" ::: "memory"); \
    _Pragma("unroll") for (int d = 0; d < 4; ++d) _Pragma("unroll") for (int r = 0; r < 16; ++r) o[d][r] *= al_l[crow(r, hi)]; } } while (0)
  f32x16 pA0, pA1, pB0, pB1; float mnA, mnB, alA, alB; bf16x8 pa0, pa1, pa2, pa3; const int NT = seq / KVBLK;
  constexpr int SE = 0, SO = 0;
  SLOAD(SE, 0); asm volatile("s_waitcnt vmcnt(0)" ::: "memory"); SWRITE(0, SE); __syncthreads();
  qkt(pA0, pA1, K_lds, qr, r32, hi); partialSM(pA0, pA1, m_reg, mnA, alA);
  SLOAD(SO, KVBLK);
  SWAIT(); SWRITE(1, SO); __syncthreads();
  for (int j = 1; j + 1 < NT; j += 2) {
    SBAR(); qkt(pB0, pB1, (bf16_t*)((char*)K_lds + SHM_K), qr, r32, hi);
    finishSM(pA0, pA1, alA, l_reg, pa0, pa1, pa2, pa3); SBAR();
    SLOAD(SO, (j + 1) * KVBLK); SBAR();
    pv_d0(o, vb0, pa0, pa1, pa2, pa3); partialSM(pB0, pB1, m_reg, mnB, alB);
    __syncthreads(); SWAIT(); SWRITE(0, SE);
    RESC(alB); __syncthreads();
    SBAR(); qkt(pA0, pA1, K_lds, qr, r32, hi);
    finishSM(pB0, pB1, alB, l_reg, pa0, pa1, pa2, pa3); SBAR();
    SLOAD(SE, (j + 2) * KVBLK); SBAR();
    pv_d0(o, vb0 + (int)SHM_V, pa0, pa1, pa2, pa3); partialSM(pA0, pA1, m_reg, mnA, alA);
    __syncthreads(); SWAIT(); SWRITE(1, SO);
    RESC(alA); __syncthreads();
  }
  SBAR(); qkt(pB0, pB1, (bf16_t*)((char*)K_lds + SHM_K), qr, r32, hi);
  finishSM(pA0, pA1, alA, l_reg, pa0, pa1, pa2, pa3); SBAR();
  pv_d0(o, vb0, pa0, pa1, pa2, pa3); partialSM(pB0, pB1, m_reg, mnB, alB);
  __syncthreads(); RESC(alB);
  finishSM(pB0, pB1, alB, l_reg, pa0, pa1, pa2, pa3); SBAR();
  pv_d0(o, vb0 + (int)SHM_V, pa0, pa1, pa2, pa3);
  if (hi == 0) li_l[r32] = l_reg; asm volatile("s_waitcnt lgkmcnt(0)" ::: "memory");
  float rli[16];
#pragma unroll
  for (int r = 0; r < 16; ++r) rli[r] = __builtin_amdgcn_rcpf(li_l[crow(r, hi)]);
  __syncthreads();
  { bf16_t* stg = (bf16_t*)lds + wid * 4096;
#pragma unroll
    for (int r = 0; r < 16; ++r) { const int orow = crow(r, hi);
#pragma unroll
      for (int d0 = 0; d0 < 4; ++d0) stg[orow * 128 + d0 * 32 + r32] = (bf16_t)(cvtpk(o[d0][r] * rli[r], 0.f) & 0xffffu); }
    asm volatile("s_waitcnt lgkmcnt(0)" ::: "memory");
    bf16_t* Ow = Qb + (long)(wid * QBLK + (lane >> 4)) * LDQ + (lane & 15) * 8;
#pragma unroll
    for (int i = 0; i < 8; ++i) { const u32x4 v = *(const u32x4*)(stg + (i * 4 + (lane >> 4)) * 128 + (lane & 15) * 8); if (STORE) *(u32x4*)(Ow + (long)i * 4 * LDQ) = v; else asm volatile("" :: "v"(v)); }
  }
  __syncthreads();
#undef LD8
#undef SLOAD
#undef SWRITE
#undef SWAIT
#undef RESC
}
#undef KSWZ
#undef SBAR
}


#define XB_TMO      128
#define XB_XCNT(j)  (256  + 64 * (j))
#define XB_XSUB(j)  (1280 + 64 * (j))
#define XB_XGEN(j)  (2304 + 64 * (j))
#define XB_TOP      3328
#define XB_TOPGEN   3392
#define XCD_BAR_WORDS 3456
#define XB_SPIN_CAP (1u << 18)
__device__ __forceinline__ unsigned xb_ld(unsigned* p)              { return __hip_atomic_load(p, __ATOMIC_RELAXED, __HIP_MEMORY_SCOPE_AGENT); }
__device__ __forceinline__ unsigned xb_add(unsigned* p, unsigned v) { return __hip_atomic_fetch_add(p, v, __ATOMIC_RELAXED, __HIP_MEMORY_SCOPE_AGENT); }
__device__ __forceinline__ unsigned xb_xcc_id() { return (unsigned)__builtin_amdgcn_s_getreg((3 << 11) | 20) & 0xFu; }
#define XB_SPIN(cond, bar) do { unsigned _sp = 0; while (cond) { __builtin_amdgcn_s_sleep(1); \
    if ((++_sp & 255u) == 0u) { if (xb_ld(&(bar)[XB_TMO])) break; if (_sp > XB_SPIN_CAP) { atomicAdd(&(bar)[XB_TMO], 1u); break; } } } } while (0)
struct XcdBarrier { unsigned* bar; unsigned x; volatile LAS unsigned* st; };
__device__ __forceinline__ XcdBarrier xcd_barrier_post(unsigned* bar, volatile LAS unsigned* st) {
    XcdBarrier b; b.bar = bar; b.x = xb_xcc_id(); b.st = st;
    if (threadIdx.x == 0) (void)xb_add(&bar[XB_XCNT(b.x)], 1u);
    return b;
}
__device__ __forceinline__ void xcd_barrier_complete(unsigned* bar, unsigned x, unsigned& nloc, unsigned& nx) {
    const unsigned G = gridDim.x * gridDim.y * gridDim.z;
    unsigned sum, cnt, mine, sp = 0u;
    for (;;) {
        sum = 0u; cnt = 0u; mine = 0u;
#pragma unroll
        for (unsigned j = 0; j < 16; ++j) { const unsigned c = xb_ld(&bar[XB_XCNT(j)]); sum += c; cnt += (c > 0u) ? 1u : 0u; mine = (j == x) ? c : mine; }
        if (sum == G) break;
        __builtin_amdgcn_s_sleep(1);
        if ((++sp & 255u) == 0u) { if (xb_ld(&bar[XB_TMO])) break; if (sp > XB_SPIN_CAP) { atomicAdd(&bar[XB_TMO], 1u); break; } }
    }
    nloc = mine > 0u ? mine : 1u; nx = cnt > 0u ? cnt : 1u;
}
__device__ __forceinline__ void xcd_barrier(const XcdBarrier& b) {
    asm volatile("s_waitcnt vmcnt(0)" ::: "memory");
    __syncthreads();
    if (threadIdx.x == 0) {
        unsigned* bar = b.bar;
        __builtin_amdgcn_s_waitcnt(0);
        unsigned nloc = b.st[0], nx = b.st[1];
        if (nloc == 0u) { xcd_barrier_complete(bar, b.x, nloc, nx); b.st[0] = nloc; b.st[1] = nx; }
        const unsigned old = xb_add(&bar[XB_XSUB(b.x)], 1u);
        const unsigned gen = old / nloc;
        if (old + 1u == (gen + 1u) * nloc) {
            __builtin_amdgcn_fence(__ATOMIC_RELEASE, "agent");
            asm volatile("s_waitcnt vmcnt(0)" ::: "memory");
            const unsigned og = xb_add(&bar[XB_TOP], 1u);
            const unsigned tg = og / nx;
            if (og + 1u == (tg + 1u) * nx) xb_add(&bar[XB_TOPGEN], 1u);
            else XB_SPIN(xb_ld(&bar[XB_TOPGEN]) == tg, bar);
            __builtin_amdgcn_fence(__ATOMIC_ACQUIRE, "agent");
            xb_add(&bar[XB_XGEN(b.x)], 1u);
            asm volatile("s_waitcnt vmcnt(0)" ::: "memory");
        } else {
            XB_SPIN(xb_ld(&bar[XB_XGEN(b.x)]) == gen, bar);
            __builtin_amdgcn_fence(__ATOMIC_ACQUIRE, "agent");
            asm volatile("s_waitcnt vmcnt(0)" ::: "memory");
        }
    }
    __syncthreads();
}

struct Args { const float* in[25]; float* out; unsigned char* ws; int ph_lo, ph_hi; };

typedef const float* fptr_t;
typedef __attribute__((address_space(4))) const fptr_t* in_as4_t;
struct Frame {
    LAS unsigned char* lds; char* ldsg;
    int tid, lane, wave, G, bx, gw, NGW;
    const float* const* in;
    unsigned char* ws; float* out;
};
enum { I_XP = 0, I_XS, I_CK, I_CV, I_C, I_CCTX, I_WADA, I_BADA, I_WIN, I_QG, I_KG, I_WPG, I_PSC, I_WSGU, I_BSGU, I_WAO, I_WPO, I_WSO, I_WOUT, I_LN1G, I_LN1B, I_WF1, I_WF2, I_LN2G, I_LN2B };

__device__ __forceinline__ void tr_item(const float* W, int ldw, int src_col, int kb, bf16_t* WT, int ldt, int dst_row, int dst_k, LAS float* scr, int lane) {
    const int k0 = 64 * kb;
#pragma unroll 8
    for (int i = 0; i < 32; ++i) { const int kk = 2 * i + (lane >> 5); scr[kk * 33 + (lane & 31)] = W[(size_t)(k0 + kk) * ldw + src_col + (lane & 31)]; }
    asm volatile("s_waitcnt lgkmcnt(0)" ::: "memory");
    const int c = lane & 7;
#pragma unroll
    for (int j = 0; j < 4; ++j) { const int n = (lane >> 3) + 8 * j; const LAS float* s = scr + (8 * c) * 33 + n;
        u32x4 o; o.x = cvt_pk_bf16(s[0 * 33], s[1 * 33]); o.y = cvt_pk_bf16(s[2 * 33], s[3 * 33]); o.z = cvt_pk_bf16(s[4 * 33], s[5 * 33]); o.w = cvt_pk_bf16(s[6 * 33], s[7 * 33]);
        *(u32x4*)(WT + (size_t)(dst_row + n) * ldt + dst_k + k0 + 8 * c) = o; }
    asm volatile("s_waitcnt lgkmcnt(0)" ::: "memory");
}

__device__ __forceinline__ int win_src_col(int d) {
    if (d < 1024) return d;
    if (d < 1536) return 2048 + (d - 1024);
    if (d < 2048) return 1024 + (d - 1536);
    if (d < 2560) return 2560 + (d - 2048);
    if (d < 3072) return 1536 + (d - 2560);
    return d;
}

__device__ __forceinline__ void phase_prologue(Frame& F) {
    if (F.bx < 192) {
        const int l = F.bx / 96, nb = F.bx % 96;
        LAS float* sc = (LAS float*)F.lds;
        LAS float* red = (LAS float*)(F.lds + 9 * 1024 * 4);
        for (int idx = F.tid; idx < 9 * 1024; idx += 512) { const int v = idx >> 10, k = idx & 1023;
            const float x = v == 0 ? F.in[I_CCTX][k] : F.in[I_C][(v - 1) * 1024 + k]; sc[idx] = x / (1.0f + __expf(-x)); }
        __syncthreads();
        float acc[9];
#pragma unroll
        for (int v = 0; v < 9; ++v) acc[v] = 0.f;
        const float* wp = F.in[I_WADA] + ((size_t)l * 1024 + F.wave * 128) * 6144 + nb * 64 + F.lane;
#pragma unroll 8
        for (int k = 0; k < 128; ++k) { const float w = wp[(size_t)k * 6144];
#pragma unroll
            for (int v = 0; v < 9; ++v) acc[v] += sc[v * 1024 + F.wave * 128 + k] * w; }
#pragma unroll
        for (int v = 0; v < 9; ++v) red[(F.wave * 9 + v) * 64 + F.lane] = acc[v];
        __syncthreads();
        float* mod = (float*)(F.ws + WS_MOD);
        for (int idx = F.tid; idx < 576; idx += 512) { const int v = idx >> 6, ln = idx & 63; float s = 0.f;
#pragma unroll
            for (int w = 0; w < 8; ++w) s += red[(w * 9 + v) * 64 + ln];
            mod[(l * 9 + v) * 6144 + nb * 64 + ln] = s + F.in[I_BADA][l * 6144 + nb * 64 + ln]; }
        __syncthreads();
    }
    LAS float* scr = (LAS float*)(F.lds + F.wave * 8448);
    constexpr int N_WIN = 16 * 192, N_AO = 16 * 32, N_SO = 8 * 32, N_WO = 16 * 32, N_F1 = 16 * 176, N_F2 = 44 * 32, N_PE = 1024, N_WS = 128;
    constexpr int N_L = N_WIN + N_AO + N_SO + N_WO + N_F1 + N_F2 + N_PE + N_WS;
    constexpr int N_ALL = 2 * N_L + 32;
    for (int it = F.gw; it < N_ALL; it += F.NGW) {
        if (it >= 2 * N_L) {
            const int idx = (it - 2 * N_L) * 64 + F.lane; const int pos = idx >> 5, p = idx & 31;
            const float inv = powf(10000.0f, -(float)p / 32.0f); const float ang = (float)pos * inv;
            float* rope = (float*)(F.ws + WS_ROPE); rope[idx] = cosf(ang); rope[2048 + idx] = sinf(ang);
            continue;
        }
        const int l = it / N_L; int r = it % N_L;
        if (r < N_WIN) { const int kb = r / 192, nb = r % 192;
            tr_item(F.in[I_WIN] + (size_t)l * 1024 * 6144, 6144, win_src_col(nb * 32), kb, (bf16_t*)(F.ws + WS_WIN) + (size_t)l * 6144 * 1024, 1024, nb * 32, 0, scr, F.lane); continue; } r -= N_WIN;
        if (r < N_AO) { const int kb = r / 32, nb = r % 32;
            tr_item(F.in[I_WAO] + (size_t)l * 1024 * 1024, 1024, nb * 32, kb, (bf16_t*)(F.ws + WS_WM) + (size_t)l * 1024 * 2048, 2048, nb * 32, 0, scr, F.lane); continue; } r -= N_AO;
        if (r < N_SO) { const int kb = r / 32, nb = r % 32;
            tr_item(F.in[I_WSO] + (size_t)l * 512 * 1024, 1024, nb * 32, kb, (bf16_t*)(F.ws + WS_WM) + (size_t)l * 1024 * 2048, 2048, nb * 32, 1024, scr, F.lane); continue; } r -= N_SO;
        if (r < N_WO) { const int kb = r / 32, nb = r % 32;
            tr_item(F.in[I_WOUT] + (size_t)l * 1024 * 1024, 1024, nb * 32, kb, (bf16_t*)(F.ws + WS_WOUT) + (size_t)l * 1024 * 1024, 1024, nb * 32, 0, scr, F.lane); continue; } r -= N_WO;
        if (r < N_F1) { const int kb = r / 176, nb = r % 176; const int drow = nb * 32; const int pn = drow >> 8, j = drow & 255;
            const int src = j < 128 ? pn * 128 + j : DFF + pn * 128 + (j - 128);
            tr_item(F.in[I_WF1] + (size_t)l * 1024 * 5632, 5632, src, kb, (bf16_t*)(F.ws + WS_WF1) + (size_t)l * 5632 * 1024, 1024, drow, 0, scr, F.lane); continue; } r -= N_F1;
        if (r < N_F2) { const int kb = r / 32, nb = r % 32;
            tr_item(F.in[I_WF2] + (size_t)l * DFF * 1024, 1024, nb * 32, kb, (bf16_t*)(F.ws + WS_WF2) + (size_t)l * 1024 * DFF, DFF, nb * 32, 0, scr, F.lane); continue; } r -= N_F2;
        if (r < N_PE) {
            const int kg = r >> 4, nb = r & 15; const int k0 = kg * 8, g = k0 >> 7; const int n = nb * 64 + F.lane;
            const float* wpg = F.in[I_WPG] + ((size_t)(l * 4 + g) * 128 + (k0 & 127)) * 128;
            const float* psc = F.in[I_PSC] + l * 512 + g * 128;
            const float* wpo = F.in[I_WPO] + ((size_t)l * 512 + g * 128) * 1024 + n;
            float a[8];
#pragma unroll
            for (int i = 0; i < 8; ++i) a[i] = 0.f;
#pragma unroll 4
            for (int j = 0; j < 128; ++j) { const float w = wpo[(size_t)j * 1024] * psc[j];
#pragma unroll
                for (int i = 0; i < 8; ++i) a[i] += wpg[i * 128 + j] * w; }
            u32x4 o; o.x = cvt_pk_bf16(a[0], a[1]); o.y = cvt_pk_bf16(a[2], a[3]); o.z = cvt_pk_bf16(a[4], a[5]); o.w = cvt_pk_bf16(a[6], a[7]);
            *(u32x4*)((bf16_t*)(F.ws + WS_WM) + (size_t)l * 1024 * 2048 + (size_t)n * 2048 + 1536 + k0) = o;
            continue; } r -= N_PE;
        {
            const size_t e0 = (size_t)l * 65536 + (size_t)r * 512 + F.lane * 8;
            const f32x4 a = *(const f32x4*)(F.in[I_WSGU] + e0), b = *(const f32x4*)(F.in[I_WSGU] + e0 + 4);
            u32x4 o; o.x = cvt_pk_bf16(a[0], a[1]); o.y = cvt_pk_bf16(a[2], a[3]); o.z = cvt_pk_bf16(b[0], b[1]); o.w = cvt_pk_bf16(b[2], b[3]);
            *(u32x4*)((bf16_t*)(F.ws + WS_WSGU) + e0) = o;
        }
    }
}

__device__ __forceinline__ const float* x0_row(Frame& F, int t) { return t < T_CTX ? F.in[I_XP] + (size_t)t * DM : F.in[I_XS] + (size_t)(t - T_CTX) * DM; }
__device__ __forceinline__ int vec_of_row(int t) { return t < T_CTX ? 0 : 1 + ((t - T_CTX) >> 12); }

__device__ __forceinline__ void phase_h0(Frame& F) {
    const float* mod = (const float*)(F.ws + WS_MOD);
    bf16_t* act = (bf16_t*)(F.ws + WS_ACT);
    for (int t = F.gw; t < T_ALL; t += F.NGW) {
        const f32x4* xr = (const f32x4*)x0_row(F, t) + F.lane;
        const float* mv = mod + vec_of_row(t) * 6144;
        unsigned long long* o8 = (unsigned long long*)(act + (size_t)t * DM) + F.lane;
#pragma unroll
        for (int j = 0; j < 4; ++j) { const f32x4 x = xr[64 * j]; const int c = 256 * j + 4 * F.lane;
            const f32x4 sh = *(const f32x4*)(mv + c), sc = *(const f32x4*)(mv + 1024 + c);
            const f32x4 h = x * (sc + 1.0f) + sh;
            o8[64 * j] = (unsigned long long)cvt_pk_bf16(h[0], h[1]) | ((unsigned long long)cvt_pk_bf16(h[2], h[3]) << 32); }
    }
}

__device__ __forceinline__ void phase_ln(Frame& F, const float* lg, const float* lb, const float* modl  , int sh_off, int sc_off, const bool dry = false) {
    float* X = F.out; bf16_t* act = (bf16_t*)(F.ws + WS_ACT);
    for (int t = F.gw; t < T_ALL; t += F.NGW) {
        f32x4* xr = (f32x4*)(X + (size_t)t * DM) + F.lane;
        f32x4 v[4]; float s = 0.f;
#pragma unroll
        for (int j = 0; j < 4; ++j) { v[j] = xr[64 * j]; s += (v[j][0] + v[j][1]) + (v[j][2] + v[j][3]); }
        const float mean = wave_sum(s) * (1.f / DM); float s2 = 0.f;
#pragma unroll
        for (int j = 0; j < 4; ++j) { v[j] = v[j] - mean; s2 += (v[j][0] * v[j][0] + v[j][1] * v[j][1]) + (v[j][2] * v[j][2] + v[j][3] * v[j][3]); }
        const float rstd = rsqrtf(wave_sum(s2) * (1.f / DM) + LN_EPS);
        const float* mv = modl ? modl + vec_of_row(t) * 6144 : nullptr;
        unsigned long long* o8 = (unsigned long long*)(act + (size_t)t * DM) + F.lane;
#pragma unroll
        for (int j = 0; j < 4; ++j) { const int c = 256 * j + 4 * F.lane;
            const f32x4 g = *(const f32x4*)(lg + c), b = *(const f32x4*)(lb + c);
            const f32x4 y = v[j] * rstd * g + b; if (!dry) xr[64 * j] = y; else { asm volatile("" :: "v"(y)); continue; }
            if (mv) { const f32x4 sh = *(const f32x4*)(mv + sh_off + c), sc = *(const f32x4*)(mv + sc_off + c);
                const f32x4 h = y * (sc + 1.0f) + sh;
                o8[64 * j] = (unsigned long long)cvt_pk_bf16(h[0], h[1]) | ((unsigned long long)cvt_pk_bf16(h[2], h[3]) << 32); } }
    }
}

__device__ __forceinline__ void load16h(const bf16_t* p, int j, float (&x)[16]) {
#pragma unroll
    for (int a = 0; a < 2; ++a)
#pragma unroll
        for (int hf = 0; hf < 2; ++hf) { const u32x2 w = *(const u32x2*)(p + a * 64 + hf * 32 + 4 * j);
            x[(a * 2 + hf) * 4 + 0] = bf_lo(w.x); x[(a * 2 + hf) * 4 + 1] = bf_hi(w.x); x[(a * 2 + hf) * 4 + 2] = bf_lo(w.y); x[(a * 2 + hf) * 4 + 3] = bf_hi(w.y); }
}
__device__ __forceinline__ void rmsn(float (&x)[16], const float (&g)[16]) {
    float ss = 0.f;
#pragma unroll
    for (int i = 0; i < 16; ++i) ss += x[i] * x[i];
    ss += __shfl_xor(ss, 1); ss += __shfl_xor(ss, 2); ss += __shfl_xor(ss, 4);
    const float rinv = rsqrtf(ss * (1.0f / 128.0f) + LN_EPS);
#pragma unroll
    for (int i = 0; i < 16; ++i) x[i] = x[i] * rinv * g[i];
}
__device__ __forceinline__ void rope16(float (&x)[16], const float* rope, int rowpos, int colpos, int j) {
#pragma unroll
    for (int a = 0; a < 2; ++a) { const int pos = a == 0 ? rowpos : colpos;
        const f32x4 c = *(const f32x4*)(rope + pos * 32 + 4 * j), s = *(const f32x4*)(rope + 2048 + pos * 32 + 4 * j);
#pragma unroll
        for (int e = 0; e < 4; ++e) { const float x1 = x[(a * 2) * 4 + e], x2 = x[(a * 2 + 1) * 4 + e];
            x[(a * 2) * 4 + e] = x1 * c[e] - x2 * s[e]; x[(a * 2 + 1) * 4 + e] = x2 * c[e] + x1 * s[e]; } }
}
__device__ __forceinline__ void store16h(bf16_t* p, int j, const float (&x)[16]) {
#pragma unroll
    for (int a = 0; a < 2; ++a)
#pragma unroll
        for (int hf = 0; hf < 2; ++hf) { u32x2 w; w.x = cvt_pk_bf16(x[(a * 2 + hf) * 4 + 0], x[(a * 2 + hf) * 4 + 1]); w.y = cvt_pk_bf16(x[(a * 2 + hf) * 4 + 2], x[(a * 2 + hf) * 4 + 3]);
            *(u32x2*)(p + a * 64 + hf * 32 + 4 * j) = w; }
}

__device__ __forceinline__ void phase_mid(Frame& F, int l, int part, const bool dry = false) {
    bf16_t* proj = (bf16_t*)(F.ws + WS_PROJ);
    const float* rope = (const float*)(F.ws + WS_ROPE);
    bf16_t* vrt = (bf16_t*)(F.ws + WS_VRT);
    bf16_t* KL = (bf16_t*)(F.ws + WS_KL); bf16_t* VL = (bf16_t*)(F.ws + WS_VL); bf16_t* KC = (bf16_t*)(F.ws + WS_KC); bf16_t* VC = (bf16_t*)(F.ws + WS_VC);
    float* outk = F.out + (size_t)T_ALL * DM; float* outv = outk + (size_t)16 * 2 * 256 * 256;
    const int lane = F.lane, hj = lane & 7;
    const int n8 = part_rows(part) / 4, ncache = 4 * PAST;
    float qg[16], kg[16];
#pragma unroll
    for (int a = 0; a < 2; ++a)
#pragma unroll
        for (int hf = 0; hf < 2; ++hf)
#pragma unroll
            for (int e = 0; e < 4; ++e) { const int d = a * 64 + hf * 32 + 4 * hj + e; qg[(a * 2 + hf) * 4 + e] = F.in[I_QG][l * 128 + d]; kg[(a * 2 + hf) * 4 + e] = F.in[I_KG][l * 128 + d]; }
    for (int it = F.gw; it < n8 + ncache; it += F.NGW) {
        if (it >= n8) {
            const int cr = it - n8; const int bl = cr >> 9, s = cr & 511; const int b = part * 4 + bl;
            const size_t src = (((size_t)b * 2 + l) * PAST + s) * 256 + lane * 4;
            const f32x4 kx = *(const f32x4*)(F.in[I_CK] + src), vx = *(const f32x4*)(F.in[I_CV] + src);
            const size_t dst = ((size_t)bl * SKV_LAT + s) * 256 + lane * 4;
            u32x2 kw, vw; kw.x = cvt_pk_bf16(kx[0], kx[1]); kw.y = cvt_pk_bf16(kx[2], kx[3]); vw.x = cvt_pk_bf16(vx[0], vx[1]); vw.y = cvt_pk_bf16(vx[2], vx[3]);
            if (!dry) { *(u32x2*)(KL + dst) = kw; *(u32x2*)(VL + dst) = vw; } else asm volatile("" :: "v"(kw), "v"(vw));
            continue;
        }
        const int lr0 = it * 4, t0 = part_row0(part) + lr0;
        const bool is_ctx = t0 < T_CTX;
        bf16_t* P0 = proj + (size_t)lr0 * NPROJ;
        {
            float val[4][8];
#pragma unroll
            for (int i = 0; i < 4; ++i) { const u32x4 w = *(const u32x4*)(P0 + (size_t)i * NPROJ + PC_XV + lane * 8);
#pragma unroll
                for (int e = 0; e < 4; ++e) { val[i][2 * e] = gelu1(bf_lo(w[e])); val[i][2 * e + 1] = gelu1(bf_hi(w[e])); } }
#pragma unroll
            for (int i = 0; i < 4; ++i) { float s = 0.f;
#pragma unroll
                for (int e = 0; e < 8; ++e) s += val[i][e];
                const float mean = wave_sum(s) * (1.0f / 512.0f); float s2 = 0.f;
#pragma unroll
                for (int e = 0; e < 8; ++e) { val[i][e] -= mean; s2 += val[i][e] * val[i][e]; }
                const float rstd = rsqrtf(wave_sum(s2) * (1.0f / 512.0f) + LN_EPS);
#pragma unroll
                for (int e = 0; e < 8; ++e) val[i][e] *= rstd; }
            const int chunk = lr0 >> 7, q0 = lr0 & 127;
            bf16_t* vb = vrt + ((size_t)chunk * 512 + lane * 8) * 128 + q0;
#pragma unroll
            for (int e = 0; e < 8; ++e) { u32x2 o; o.x = cvt_pk_bf16(val[0][e], val[1][e]); o.y = cvt_pk_bf16(val[2][e], val[3][e]);
                if (!dry) *(u32x2*)(vb + (size_t)e * 128) = o; else asm volatile("" :: "v"(o)); }
        }
#pragma unroll 1
        for (int i = 0; i < 4; ++i) {
            bf16_t* Pr = P0 + (size_t)i * NPROJ; const int t = t0 + i;
            int spos, seqS, rowpos = 0, colpos = 0, bl = 0;
            if (is_ctx) { spos = t & 255; seqS = CTX_S; } else { const int tl = t - T_CTX; spos = tl & 4095; seqS = LAT_S; rowpos = spos >> 6; colpos = spos & 63; bl = (tl >> 12) - part * 4; }
            float x[16];
            const int kh = (lane >> 3) & 1;
            load16h(Pr + PC_K + kh * 128, hj, x); rmsn(x, kg);
            const int vi = (lane - 16) & 31;
            const u32x4 vw = *(const u32x4*)(Pr + PC_V + vi * 8);
            float pacc[8], pself[8];
            {
                const int hw = 1 << (lane >> 4);
                const int lo = max(spos - hw, 0), hi = min(spos + hw, seqS);
#pragma unroll
                for (int e = 0; e < 8; ++e) pacc[e] = 0.f;
                u32x4 pw[16];
#pragma unroll
                for (int k = 0; k < 16; ++k) { const int dd = k - 8, sp = spos + dd; const bool ok = (sp >= lo) && (sp < hi);
                    pw[k] = *(const u32x4*)(Pr + (long)(ok ? dd : 0) * NPROJ + PC_XP + lane * 8); }
#pragma unroll
                for (int k = 0; k < 16; ++k) { const int sp = spos + k - 8; const float mk = ((sp >= lo) && (sp < hi)) ? 1.0f : 0.0f;
#pragma unroll
                    for (int e = 0; e < 4; ++e) { pacc[2 * e] += mk * bf_lo(pw[k][e]); pacc[2 * e + 1] += mk * bf_hi(pw[k][e]); } }
#pragma unroll
                for (int e = 0; e < 4; ++e) { pself[2 * e] = bf_lo(pw[8][e]); pself[2 * e + 1] = bf_hi(pw[8][e]); }
                const float rc = 1.0f / (float)(hi - lo);
#pragma unroll
                for (int e = 0; e < 8; ++e) pacc[e] = pacc[e] * rc - pself[e];
            }
            asm volatile("s_waitcnt vmcnt(0)" ::: "memory");
            if (dry) { asm volatile("" :: "v"(x[0]), "v"(x[7]), "v"(vw), "v"(pacc[0]), "v"(pacc[7])); continue; }
            if (is_ctx) {
                if (lane < 16) {
                    float* ok = outk + (((size_t)(t >> 8) * 2 + l) * 256 + (t & 255)) * 256 + kh * 128;
#pragma unroll
                    for (int a = 0; a < 2; ++a)
#pragma unroll
                        for (int hf = 0; hf < 2; ++hf) *(f32x4*)(ok + a * 64 + hf * 32 + 4 * hj) = (f32x4){x[(a * 2 + hf) * 4], x[(a * 2 + hf) * 4 + 1], x[(a * 2 + hf) * 4 + 2], x[(a * 2 + hf) * 4 + 3]};
                    store16h(KC + (size_t)t * 256 + kh * 128, hj, x);
                }
                if (lane >= 16 && lane < 48) {
                    float* ov = outv + (((size_t)(t >> 8) * 2 + l) * 256 + (t & 255)) * 256 + vi * 8;
                    *(f32x4*)ov = (f32x4){bf_lo(vw[0]), bf_hi(vw[0]), bf_lo(vw[1]), bf_hi(vw[1])};
                    *(f32x4*)(ov + 4) = (f32x4){bf_lo(vw[2]), bf_hi(vw[2]), bf_lo(vw[3]), bf_hi(vw[3])};
                    *(u32x4*)(VC + (size_t)t * 256 + vi * 8) = vw;
                }
            } else {
                rope16(x, rope, rowpos, colpos, hj);
                const size_t krow = ((size_t)bl * SKV_LAT + PAST + spos) * 256;
                if (lane < 16) store16h(KL + krow + kh * 128, hj, x);
                if (lane >= 16 && lane < 48) *(u32x4*)(VL + krow + vi * 8) = vw;
            }
            { u32x4 o; o.x = cvt_pk_bf16(pacc[0], pacc[1]); o.y = cvt_pk_bf16(pacc[2], pacc[3]); o.z = cvt_pk_bf16(pacc[4], pacc[5]); o.w = cvt_pk_bf16(pacc[6], pacc[7]);
              *(u32x4*)(Pr + PC_K + lane * 8) = o; }
        }
    }
}

__device__ __forceinline__ void phase_attn(Frame& F, int l, int part, const bool sgu_only_dry = false) {
    bf16_t* proj = (bf16_t*)(F.ws + WS_PROJ);
    const bf16_t* KL = (const bf16_t*)(F.ws + WS_KL); const bf16_t* VL = (const bf16_t*)(F.ws + WS_VL); const bf16_t* KC = (const bf16_t*)(F.ws + WS_KC); const bf16_t* VC = (const bf16_t*)(F.ws + WS_VC);
    const int lat_row0 = part == 0 ? T_CTX : 0;
    if (!sgu_only_dry) {
        int pair, idx, step; int rep = 0;
        const bool xcdmap = (F.G % 8) == 0;
        if (xcdmap) { pair = F.bx & 7; idx = F.bx >> 3; step = F.G >> 3; } else { pair = 0; idx = F.bx; step = F.G; }
        for (;;) {
            int pr = pair, ix = idx;
            if (!xcdmap) { pr = idx >> 6; ix = idx & 63; if (idx >= 512) break; } else if (idx >= 64) break;
            const int bl = pr >> 1, kvh = pr & 1, h = kvh * 4 + (ix >> 4), qb = ix & 15;
            bf16_t* Qb = proj + (size_t)(lat_row0 + bl * LAT_S + qb * 256) * NPROJ + PC_Q + h * 128;
            att::attn_dense_body(Qb, KL + (size_t)bl * SKV_LAT * 256 + kvh * 128, VL + (size_t)bl * SKV_LAT * 256 + kvh * 128, SKV_LAT, F.ldsg, F.tid, F.in[I_QG] + l * 128, (const float*)(F.ws + WS_ROPE), qb * 256, PROBE == 3 ? rep == 1 : true);
            if (PROBE == 3) { if (rep == 0) { rep = 1; continue; } rep = 0; }
            idx += step;
        }
    }
    if (part == 0 && !sgu_only_dry) {
        for (int u = F.bx; u < 128; u += F.G) { const int b = u >> 3, h = u & 7;
            bf16_t* Qb = proj + (size_t)(b * 256) * NPROJ + PC_Q + h * 128;
            att::attn_dense_body(Qb, KC + (size_t)b * 256 * 256 + (h >> 2) * 128, VC + (size_t)b * 256 * 256 + (h >> 2) * 128, CTX_S, F.ldsg, F.tid, F.in[I_QG] + l * 128, (const float*)nullptr, 0); }
    }
    const bf16_t* vrt = (const bf16_t*)(F.ws + WS_VRT);
    const bf16_t* wsb = (const bf16_t*)(F.ws + WS_WSGU) + (size_t)l * 65536;
    const float* bs = F.in[I_BSGU] + l * 512;
    const int nitem = (part_rows(part) / 128) * 32;
    const int ln = F.lane & 15, quad = F.lane >> 4;
    for (int it = F.NGW - 1 - F.gw; it < nitem; it += F.NGW) {
        const int chunk = it >> 5, g = (it >> 3) & 3, cb = (it >> 1) & 3, pb = it & 1;
        f32x4 acc[2][4];
#pragma unroll
        for (int a = 0; a < 2; ++a)
#pragma unroll
            for (int b = 0; b < 4; ++b) acc[a][b] = (f32x4){0.f, 0.f, 0.f, 0.f};
        const bf16_t* ap = vrt + ((size_t)chunk * 512 + g * 128 + cb * 32 + ln) * 128 + quad * 8;
        const bf16_t* bp = wsb + ((size_t)g * 128 + pb * 64 + ln) * 128 + quad * 8;
        u32x2 xw[4][2];
#pragma unroll
        for (int pt = 0; pt < 4; ++pt)
#pragma unroll
            for (int ct = 0; ct < 2; ++ct) xw[pt][ct] = *(const u32x2*)(proj + (size_t)(chunk * 128 + pb * 64 + pt * 16 + ln) * NPROJ + PC_U + g * 128 + cb * 32 + ct * 16 + quad * 4);
#pragma unroll
        for (int ks = 0; ks < 4; ++ks) {
            bf16x8 af[2], bfr[4];
#pragma unroll
            for (int ct = 0; ct < 2; ++ct) af[ct] = *(const bf16x8*)(ap + ct * 16 * 128 + ks * 32);
#pragma unroll
            for (int pt = 0; pt < 4; ++pt) bfr[pt] = *(const bf16x8*)(bp + pt * 16 * 128 + ks * 32);
#pragma unroll
            for (int ct = 0; ct < 2; ++ct)
#pragma unroll
                for (int pt = 0; pt < 4; ++pt) acc[ct][pt] = __builtin_amdgcn_mfma_f32_16x16x32_bf16(af[ct], bfr[pt], acc[ct][pt], 0, 0, 0);
        }
#pragma unroll
        for (int pt = 0; pt < 4; ++pt) { const int p = pb * 64 + pt * 16 + ln; const float bsv = bs[g * 128 + p];
#pragma unroll
            for (int ct = 0; ct < 2; ++ct) { const int c = g * 128 + cb * 32 + ct * 16 + quad * 4;
                bf16_t* up = proj + (size_t)(chunk * 128 + p) * NPROJ + PC_U + c;
                const u32x2 w = xw[pt][ct];
                const float u0 = gelu1(bf_lo(w.x)), u1 = gelu1(bf_hi(w.x)), u2 = gelu1(bf_lo(w.y)), u3 = gelu1(bf_hi(w.y));
                const f32x4 a = acc[ct][pt];
                u32x2 o; o.x = cvt_pk_bf16(u0 * (a[0] + bsv), u1 * (a[1] + bsv)); o.y = cvt_pk_bf16(u2 * (a[2] + bsv), u3 * (a[3] + bsv));
                if (!sgu_only_dry) *(u32x2*)up = o; else asm volatile("" :: "v"(o)); } }
    }
}

constexpr int NPL = 11, NPHASE = 2 + DEPTH * NPL;
__global__ void __launch_bounds__(NW * 64, 2) fwd_kernel(Args args) {
    extern __shared__ __attribute__((aligned(16))) unsigned char lds[];
    Frame F;
    F.lds = (LAS unsigned char*)lds; F.ldsg = (char*)lds;
    F.G = gridDim.x; F.bx = blockIdx.x; F.NGW = F.G * NW;
    F.in = args.in; F.ws = args.ws; F.out = args.out;
    const float* mod = (const float*)(F.ws + WS_MOD);
    bf16_t* act = (bf16_t*)(F.ws + WS_ACT); bf16_t* proj = (bf16_t*)(F.ws + WS_PROJ);
    volatile LAS unsigned* bst = (volatile LAS unsigned*)(F.lds + 131072 + 64);
    unsigned* barw = (unsigned*)(F.ws + WS_BAR);
    { int t0 = threadIdx.x; asm volatile("" : "+v"(t0));
      if (t0 < 2) bst[t0] = 0u;
      if (blockIdx.x == 0 && args.ph_lo == 0) { for (int i = t0; i < XCD_BAR_WORDS; i += NW * 64) barw[i] = 0u;
        unsigned* cw = (unsigned*)(F.ws + WS_CNT); for (int i = t0; i < CNT_WORDS; i += NW * 64) cw[i] = 0u; } }
    __syncthreads();
    XcdBarrier xbar; xbar.bar = barw; xbar.x = 0; xbar.st = bst;
    for (int ph = args.ph_lo; ph < args.ph_hi; ++ph) {
        { int tidv = threadIdx.x; asm volatile("" : "+v"(tidv));
          F.tid = tidv; F.lane = tidv & 63; F.wave = __builtin_amdgcn_readfirstlane(tidv >> 6); F.gw = F.bx * NW + F.wave; }

#ifndef PHMASK
#define PHMASK 0xffff
#endif
        if (ph == 0) { if (PHMASK & 1) phase_prologue(F); if (PROBE == 4) { __syncthreads(); phase_prologue(F); } }
        else if (ph == 1) { if (PHMASK & 2) phase_h0(F); if (PROBE == 4) phase_h0(F); }
        else {
            const int l = (ph - 2) / NPL, s = (ph - 2) % NPL;
            if (s < 8) {
                const int part = s >> 2, q = s & 3;
                if (q == 0) { if (PHMASK & 4) {
                    pg8::Gemm g{}; g.A = act + (size_t)part_row0(part) * DM; g.Bt = (const bf16_t*)(F.ws + WS_WIN) + (size_t)l * NPROJ * DM; g.lda = DM; g.ldb = DM;
                    g.nM = part_rows(part) / 256; g.nN = NPROJ / 256; g.nseg = 1; g.k0[0] = 0; g.nt[0] = 16; g.k0[1] = 0; g.nt[1] = 16; g.k0[2] = 0; g.nt[2] = 16;
                    pg8::Order S; S.init(g.nM, g.nN, 1, F.G, F.bx, 0, STAGGER);
                    pg8::EpiStore E{proj, NPROJ, PC_G};
                    if (PROBE == 2) { pg8::EpiNone E0; pg8::gemm_phase<pg8::EpiNone>(F.lds, g, S, E0, F.tid); }
                    if (PROBE == 7) pg8::gemm_phase<pg8::EpiStore>(F.lds, g, S, E, F.tid);
                    pg8::gemm_phase<pg8::EpiStore>(F.lds, g, S, E, F.tid); }
                } else if (q == 1) { if (PROBE == 5) phase_mid(F, l, part, true); if (PHMASK & 8) phase_mid(F, l, part, false); }
                else if (q == 2) { if (PROBE == 6) phase_attn(F, l, part, true); if (PHMASK & 16) phase_attn(F, l, part, false); }
                else if (PHMASK & 32) {
                    pg8::Gemm g{}; g.A = proj; g.Bt = (const bf16_t*)(F.ws + WS_WM) + (size_t)l * DM * 2048; g.lda = NPROJ; g.ldb = 2048;
                    g.nM = part_rows(part) / 256; g.nN = 4; g.nseg = 3; g.k0[0] = 0; g.nt[0] = 16; g.k0[1] = 1024; g.nt[1] = 8; g.k0[2] = 1536; g.nt[2] = 8;
                    pg8::Order S; S.init(g.nM, g.nN, 3, F.G, F.bx);
                    pg8::EpiGate E{F.lds + LDS_XCH, proj, act + (size_t)part_row0(part) * DM, DM};
                    if (PROBE == 2) { pg8::EpiNone E0; pg8::gemm_phase<pg8::EpiNone>(F.lds, g, S, E0, F.tid); }
                    pg8::gemm_phase<pg8::EpiGate>(F.lds, g, S, E, F.tid);
                }
            } else if (s == 8) { if (PHMASK & 64) {
                pg8::Gemm g{}; g.A = act; g.Bt = (const bf16_t*)(F.ws + WS_WOUT) + (size_t)l * DM * DM; g.lda = DM; g.ldb = DM;
                g.nM = T_ALL / 256; g.nN = 4; g.nseg = 1; g.k0[0] = 0; g.nt[0] = 16; g.k0[1] = 0; g.nt[1] = 16; g.k0[2] = 0; g.nt[2] = 16;
                pg8::Order S; S.init(g.nM, g.nN, 1, F.G, F.bx, 1);
                if (l == 0) { pg8::EpiResidLn<0, true, false> E{F.in, F.ws, F.out, l, F.lds + LDS_XCH}; pg8::gemm_phase<pg8::EpiResidLn<0, true, false>>(F.lds, g, S, E, F.tid); }
                else { pg8::EpiResidLn<0, false, false> E{F.in, F.ws, F.out, l, F.lds + LDS_XCH}; pg8::gemm_phase<pg8::EpiResidLn<0, false, false>>(F.lds, g, S, E, F.tid); } }
            } else if (s == 9) { if (PHMASK & 256) {
                pg8::Gemm g{}; g.A = act; g.Bt = (const bf16_t*)(F.ws + WS_WF1) + (size_t)l * 2 * DFF * DM; g.lda = DM; g.ldb = DM;
                g.nM = T_ALL / 256; g.nN = 2 * DFF / 256; g.nseg = 1; g.k0[0] = 0; g.nt[0] = 16; g.k0[1] = 0; g.nt[1] = 16; g.k0[2] = 0; g.nt[2] = 16;
                pg8::Order S; S.init(g.nM, g.nN, 1, F.G, F.bx, 0, STAGGER);
                pg8::EpiSwiGLU E{proj, DFF};
                if (PROBE == 2) { pg8::EpiNone E0; pg8::gemm_phase<pg8::EpiNone>(F.lds, g, S, E0, F.tid); }
                if (PROBE == 7) pg8::gemm_phase<pg8::EpiSwiGLU>(F.lds, g, S, E, F.tid);
                pg8::gemm_phase<pg8::EpiSwiGLU>(F.lds, g, S, E, F.tid); }
            } else { if (PHMASK & 512) {
                pg8::Gemm g{}; g.A = proj; g.Bt = (const bf16_t*)(F.ws + WS_WF2) + (size_t)l * DM * DFF; g.lda = DFF; g.ldb = DFF;
                g.nM = T_ALL / 256; g.nN = 4; g.nseg = 1; g.k0[0] = 0; g.nt[0] = 44; g.k0[1] = 0; g.nt[1] = 44; g.k0[2] = 0; g.nt[2] = 44;
                pg8::Order S; S.init(g.nM, g.nN, 1, F.G, F.bx, 1);
                if (l + 1 < DEPTH) { pg8::EpiResidLn<1, false, false> E{F.in, F.ws, F.out, l, F.lds + LDS_XCH}; pg8::gemm_phase<pg8::EpiResidLn<1, false, false>>(F.lds, g, S, E, F.tid); }
                else { pg8::EpiResidLn<1, false, true> E{F.in, F.ws, F.out, l, F.lds + LDS_XCH}; pg8::gemm_phase<pg8::EpiResidLn<1, false, true>>(F.lds, g, S, E, F.tid); } }
            }
        }
        if (ph + 1 < args.ph_hi) {
            if (ph == args.ph_lo) { cg::this_grid().sync(); xbar = xcd_barrier_post(barw, bst); }
            else xcd_barrier(xbar);
            if (PROBE == 1 && ph == 1) { for (int k = 0; k < 20; ++k) xcd_barrier(xbar); }
        }
    }
}

extern "C" void kernel_launch(void* const* d_in, const int* in_sizes, int n_in, void* d_out, int out_size, void* d_ws, size_t ws_size, hipStream_t stream) {
    static int grid = 0;
    if (grid == 0) {
        if (n_in != 25 || ws_size < WS_END) { fprintf(stderr, "kernel_launch: unexpected n_in %d / ws %zu\n", n_in, ws_size); grid = -1; return; }
        int dev = 0, cus = 0, per_cu = 0;
        if (hipGetDevice(&dev) != hipSuccess || hipDeviceGetAttribute(&cus, hipDeviceAttributeMultiprocessorCount, dev) != hipSuccess) { grid = -1; return; }
        if (hipFuncSetAttribute((const void*)fwd_kernel, hipFuncAttributeMaxDynamicSharedMemorySize, LDS_BYTES) != hipSuccess) { fprintf(stderr, "kernel_launch: hipFuncSetAttribute failed\n"); grid = -1; return; }
        if (hipOccupancyMaxActiveBlocksPerMultiprocessor(&per_cu, (const void*)fwd_kernel, NW * 64, LDS_BYTES) != hipSuccess || per_cu < 1) per_cu = 1;
        (void)hipGetLastError();
        grid = cus * (per_cu > 1 ? 1 : per_cu);
    }
    if (grid < 0) return;
    Args a{};
    for (int i = 0; i < 25; ++i) a.in[i] = (const float*)d_in[i];
    a.out = (float*)d_out; a.ws = (unsigned char*)d_ws;
#if MK_MULTI
    for (int ph = 0; ph < NPHASE; ++ph) { a.ph_lo = ph; a.ph_hi = ph + 1; hipLaunchKernelGGL(fwd_kernel, dim3(grid), dim3(NW * 64), LDS_BYTES, stream, a); }
#else
    a.ph_lo = 0; a.ph_hi = NPHASE;
    void* kargs[] = {&a};
    hipError_t e = hipLaunchCooperativeKernel((const void*)fwd_kernel, dim3(grid), dim3(NW * 64), kargs, LDS_BYTES, stream);
    if (e != hipSuccess) fprintf(stderr, "cooperative launch failed: %s (grid %d)\n", hipGetErrorString(e), grid);
#endif
}
```

```cpp
#include <hip/hip_runtime.h>
#include <hip/hip_bf16.h>
#include <hip/hip_cooperative_groups.h>
#include <cstdio>
#include <cstdint>
namespace cg = cooperative_groups;

#ifndef PROBE
#define PROBE 0
#endif
#ifndef STAGGER
#define STAGGER 0
#endif
#ifndef GATE_PF
#define GATE_PF false
#endif
#ifndef MK_MULTI
#define MK_MULTI 0
#endif

#define LAS __attribute__((address_space(3)))
typedef unsigned short bf16_t;
typedef short bf16x8 __attribute__((ext_vector_type(8)));
typedef short s16x4 __attribute__((ext_vector_type(4)));
typedef float f32x2 __attribute__((ext_vector_type(2)));
typedef float f32x4 __attribute__((ext_vector_type(4)));
typedef float f32x16 __attribute__((ext_vector_type(16)));
typedef unsigned u32x2 __attribute__((ext_vector_type(2)));
typedef unsigned u32x4 __attribute__((ext_vector_type(4)));

constexpr int DM = 1024, NPROJ = 6144, DFF = 2816, DEPTH = 2;
constexpr int T_CTX = 4096, T_ALL = 36864;
constexpr int CTX_S = 256, LAT_S = 4096, PAST = 512, SKV_LAT = 4608;
constexpr int PC_Q = 0, PC_U = 1024, PC_K = 1536, PC_V = 1792, PC_XV = 2048, PC_XP = 2560, PC_G = 3072;
constexpr float LN_EPS = 1e-6f;
constexpr float ALPHA = 1.41421356237309515f;
constexpr int NW = 8;
__host__ __device__ constexpr int part_row0(int p) { return p == 0 ? 0 : 20480; }
__host__ __device__ constexpr int part_rows(int p) { return p == 0 ? 20480 : 16384; }

constexpr size_t MiB = 1u << 20;
constexpr size_t WS_MOD = 0;
constexpr size_t WS_BAR = 448 * 1024;
constexpr size_t WS_ROPE = 512 * 1024;
constexpr size_t WS_WSGU = 768 * 1024;
constexpr size_t WS_WIN = 1 * MiB;
constexpr size_t WS_WM = 25 * MiB;
constexpr size_t WS_WOUT = 33 * MiB;
constexpr size_t WS_WF1 = 37 * MiB;
constexpr size_t WS_WF2 = 59 * MiB;
constexpr size_t WS_ACT = 70 * MiB;
constexpr size_t WS_PROJ = 142 * MiB;
constexpr size_t WS_KL = 382 * MiB, WS_VL = 391 * MiB;
constexpr size_t WS_KC = 400 * MiB, WS_VC = 402 * MiB;
constexpr size_t WS_VRT = 404 * MiB;
constexpr size_t WS_XBUF = 424 * MiB;
constexpr size_t WS_CNT = 426 * MiB;
constexpr int CNT_WORDS = 4 * 144 * 64;
constexpr size_t WS_XB = 427 * MiB;
constexpr size_t WS_END = 499 * MiB;

constexpr int LDS_BYTES = 143360;
constexpr int LDS_XCH = 131072 + 256;

__device__ __forceinline__ unsigned cvt_pk_bf16(float lo, float hi) { unsigned r; asm volatile("v_cvt_pk_bf16_f32 %0, %1, %2" : "=v"(r) : "v"(lo), "v"(hi)); return r; }
__device__ __forceinline__ float bf_lo(unsigned u) { return __uint_as_float(u << 16); }
__device__ __forceinline__ float bf_hi(unsigned u) { return __uint_as_float(u & 0xffff0000u); }
__device__ __forceinline__ float wave_sum(float v) {
#pragma unroll
    for (int o = 1; o < 64; o <<= 1) v += __shfl_xor(v, o);
    return v;
}
__device__ __forceinline__ float gelu1(float v) {
    const float av = fabsf(v), d = av * 0.2316418882f + 1.0f;
    const float t = __builtin_amdgcn_rcpf(d);
    float q = t * 0.5307027145f + (-0.7265760135f); q = q * t + 0.7107068705f; q = q * t + (-0.142248368f); q = q * t + 0.127414796f; q = q * t;
    const float e = __builtin_amdgcn_exp2f((v * v) * (-0.72134752044f));
    const float m = v * (q * e), r = v - m;
    return v < 0.f ? m : r;
}
__device__ __forceinline__ float sigmoidf_(float x) { return __builtin_amdgcn_rcpf(1.0f + __expf(-x)); }

namespace pg8 {
constexpr int BM = 256, BK = 64, HALF = 128, HTB = HALF * BK * 2, STAGE_BYTES = 8 * HTB, NXCD = 8, WGM = 8;
__host__ __device__ __forceinline__ int lds_byte(int r, int c) { const int st = (r >> 4) * 2 + (c >> 5), rr = r & 15, cc = c & 31, ob = rr * 64 + cc * 2; return st * 1024 + (ob ^ (((ob >> 9) & 1) << 5)); }
__host__ __device__ __forceinline__ void stage_rc(int b, int& R, int& C) { const int st = b / 1024, sb = b % 1024, swz = sb ^ (((sb >> 9) & 1) << 5); R = (st >> 1) * 16 + swz / 64; C = (st & 1) * 32 + (swz % 64) / 2; }
__host__ __device__ __forceinline__ int perm32(int rho) { const int n = rho >> 4, i = rho & 15; return 8 * (i >> 2) + 4 * n + (i & 3); }

struct Unit { int pm, pn, seg; };
struct Gemm { const bf16_t* A; const bf16_t* Bt; int lda, ldb, nM, nN, nseg; int k0[3]; int nt[3]; };

struct Order {
    int nM, nN, nwg, G, c, nseg, team, stagger;
    __device__ void init(int nM_, int nN_, int nseg_, int G_, int c_, int team_ = 0, int stagger_ = 0) { nM = nM_; nN = nN_; nwg = nM * nN; G = G_; c = c_; nseg = nseg_; team = team_; stagger = stagger_; }
    __device__ bool next(int i, Unit& u) const {
        if (team) {
            u.seg = 0; const int j = c >> 3; u.pn = j & 3; u.pm = i * (G >> 2) + (j >> 2) * 8 + (c & 7); return u.pm < nM;
        }
        const int ti = i / nseg; u.seg = i - ti * nseg;
        const long L = (long)ti * G + c; if (L >= nwg) return false;
        int wgid = (int)L; { const int q = nwg / NXCD, r = nwg % NXCD, xcd = wgid % NXCD, off = wgid / NXCD; wgid = (xcd < r ? xcd * (q + 1) : r * (q + 1) + (xcd - r) * q) + off; }
        const int nig = WGM * nN, gid = wgid / nig, fm = gid * WGM, gsz = (nM - fm) < WGM ? (nM - fm) : WGM;
        u.pm = fm + ((wgid % nig) % gsz); u.pn = (wgid % nig) / gsz; return true;
    }
};

struct EpiStore {
    static constexpr bool PREFETCH = false;
    static constexpr bool PERM = true;
    bf16_t* O; int ldc; int gate_col0;
    __device__ __forceinline__ void run(f32x4 (&acc)[2][2][4][2], const Unit& u, int wr, int wc, int fr, int fq) const {
        const int row0 = u.pm * BM + wr * 64 + fr; const int col0 = u.pn * BM + wc * 32 + 8 * fq;
        const bool gate = u.pn * BM >= gate_col0;
#pragma unroll
        for (int ai = 0; ai < 2; ++ai)
#pragma unroll
            for (int m = 0; m < 4; ++m) { bf16_t* rowp = O + (size_t)(row0 + ai * HALF + m * 16) * ldc + col0;
#pragma unroll
                for (int bj = 0; bj < 2; ++bj) { f32x4 v0 = acc[ai][bj][m][0], v1 = acc[ai][bj][m][1];
                    if (gate) {
#pragma unroll
                        for (int e = 0; e < 4; ++e) { v0[e] = 1.0f + __expf(-fmaxf(v0[e], -80.f)); v1[e] = 1.0f + __expf(-fmaxf(v1[e], -80.f)); } }
                    u32x4 w; w.x = cvt_pk_bf16(v0[0], v0[1]); w.y = cvt_pk_bf16(v0[2], v0[3]); w.z = cvt_pk_bf16(v1[0], v1[1]); w.w = cvt_pk_bf16(v1[2], v1[3]);
                    *(u32x4*)(rowp + bj * HALF) = w; } }
    }
};
struct EpiSwiGLU {
    static constexpr bool PREFETCH = false;
    static constexpr bool PERM = true;
    bf16_t* O; int ldc;
    __device__ __forceinline__ void run(f32x4 (&acc)[2][2][4][2], const Unit& u, int wr, int wc, int fr, int fq) const {
        const int row0 = u.pm * BM + wr * 64 + fr; const int col0 = u.pn * HALF + wc * 32 + 8 * fq;
#pragma unroll
        for (int ai = 0; ai < 2; ++ai)
#pragma unroll
            for (int m = 0; m < 4; ++m) { bf16_t* rowp = O + (size_t)(row0 + ai * HALF + m * 16) * ldc + col0;
                float o[8];
#pragma unroll
                for (int n = 0; n < 2; ++n)
#pragma unroll
                    for (int e = 0; e < 4; ++e) { const float a = acc[ai][0][m][n][e], b = acc[ai][1][m][n][e]; o[n * 4 + e] = a * sigmoidf_(a) * b; }
                u32x4 w; w.x = cvt_pk_bf16(o[0], o[1]); w.y = cvt_pk_bf16(o[2], o[3]); w.z = cvt_pk_bf16(o[4], o[5]); w.w = cvt_pk_bf16(o[6], o[7]);
                *(u32x4*)rowp = w; }
    }
};
struct EpiResid {
    static constexpr bool PREFETCH = false;
    static constexpr bool PERM = false;
    const float* xres_ctx; const float* xres_lat;
    float* out; const float* mod; int goff;
    __device__ __forceinline__ void run(f32x4 (&acc)[2][2][4][2], const Unit& u, int wr, int wc, int fr, int fq) const {
        const int v = u.pm < 16 ? 0 : 1 + ((u.pm - 16) >> 4);
        const float* xb = u.pm < 16 ? xres_ctx + (size_t)u.pm * BM * DM : xres_lat + (size_t)(u.pm - 16) * BM * DM;
        float* ob = out + (size_t)u.pm * BM * DM;
        const int col0 = u.pn * BM + wc * 32 + 4 * fq;
        const float* gp = mod + v * 6144 + goff + col0;
        f32x4 gv[2][2];
#pragma unroll
        for (int bj = 0; bj < 2; ++bj)
#pragma unroll
            for (int n = 0; n < 2; ++n) gv[bj][n] = *(const f32x4*)(gp + bj * HALF + n * 16);
#pragma unroll
        for (int ai = 0; ai < 2; ++ai)
#pragma unroll
            for (int m = 0; m < 4; ++m) { const size_t off = (size_t)(ai * HALF + wr * 64 + m * 16 + fr) * DM + col0;
#pragma unroll
                for (int bj = 0; bj < 2; ++bj)
#pragma unroll
                    for (int n = 0; n < 2; ++n) { const f32x4 x = *(const f32x4*)(xb + off + bj * HALF + n * 16);
                        *(f32x4*)(ob + off + bj * HALF + n * 16) = x * ALPHA + gv[bj][n] * acc[ai][bj][m][n]; } }
    }
};

struct PanelStats {
    unsigned long long* xbuf;
    unsigned* cnt;
    LAS unsigned char* lx;
    __device__ __forceinline__ void run(const f32x4 (&v)[2][2][4][2], const Unit& u, int wr, int wc, int fr, int fq, int wid, int lane) const {
        LAS f32x2* P = (LAS f32x2*)lx; LAS f32x2* S = (LAS f32x2*)(lx + 8192);
#pragma unroll
        for (int ai = 0; ai < 2; ++ai)
#pragma unroll
            for (int m = 0; m < 4; ++m) {
                float s = 0.f;
#pragma unroll
                for (int bj = 0; bj < 2; ++bj)
#pragma unroll
                    for (int n = 0; n < 2; ++n) { const f32x4 x = v[ai][bj][m][n]; s += (x[0] + x[1]) + (x[2] + x[3]); }
                s += __shfl_xor(s, 16); s += __shfl_xor(s, 32);
                const float mw = s * (1.0f / 64.0f); float q = 0.f;
#pragma unroll
                for (int bj = 0; bj < 2; ++bj)
#pragma unroll
                    for (int n = 0; n < 2; ++n) { const f32x4 d = v[ai][bj][m][n] - mw; q += (d[0] * d[0] + d[1] * d[1]) + (d[2] * d[2] + d[3] * d[3]); }
                q += __shfl_xor(q, 16); q += __shfl_xor(q, 32);
                if (fq == 0) P[(ai * HALF + wr * 64 + m * 16 + fr) * 4 + wc] = (f32x2){mw, q};
            }
        asm volatile("s_waitcnt lgkmcnt(0)" ::: "memory"); __builtin_amdgcn_s_barrier(); asm volatile("" ::: "memory");
        const int row = wid * 32 + (lane & 31);
        if (lane < 32) {
            const f32x2 a = P[row * 4 + 0], b = P[row * 4 + 1], c = P[row * 4 + 2], d = P[row * 4 + 3];
            const float mt = (a.x + b.x + c.x + d.x) * 0.25f;
            const float da = a.x - mt, db = b.x - mt, dc = c.x - mt, dd = d.x - mt;
            const float m2 = (a.y + b.y) + (c.y + d.y) + 64.0f * ((da * da + db * db) + (dc * dc + dd * dd));
            unsigned long long* slot = xbuf + ((size_t)(u.pm * BM + row) * 4 + u.pn);
            __hip_atomic_store(slot, ((unsigned long long)__float_as_uint(m2) << 32) | __float_as_uint(mt), __ATOMIC_RELAXED, __HIP_MEMORY_SCOPE_AGENT);
        }
        asm volatile("s_waitcnt vmcnt(0)" ::: "memory");
        if (lane == 0) __hip_atomic_fetch_add(cnt + 64 * u.pm, 1u, __ATOMIC_RELAXED, __HIP_MEMORY_SCOPE_AGENT);
        if (wid == 0) {
            unsigned sp = 0;
            for (;;) {
                if ((unsigned)__builtin_amdgcn_readfirstlane(__hip_atomic_load(cnt + 64 * u.pm, __ATOMIC_RELAXED, __HIP_MEMORY_SCOPE_AGENT)) >= 32u) break;
                if (++sp > (1u << 22)) break;
                __builtin_amdgcn_s_sleep(2);
            }
            __builtin_amdgcn_fence(__ATOMIC_ACQUIRE, "agent");
        }
        asm volatile("s_waitcnt vmcnt(0) lgkmcnt(0)" ::: "memory"); __builtin_amdgcn_s_barrier(); asm volatile("" ::: "memory");
        if (lane < 32) {
            const unsigned long long* slot = xbuf + (size_t)(u.pm * BM + row) * 4; float mt[4], m2[4]; float ms = 0.f;
#pragma unroll
            for (int t = 0; t < 4; ++t) { const unsigned long long w = __hip_atomic_load(slot + t, __ATOMIC_RELAXED, __HIP_MEMORY_SCOPE_AGENT); mt[t] = __uint_as_float((unsigned)w); m2[t] = __uint_as_float((unsigned)(w >> 32)); ms += mt[t]; }
            const float mean = ms * 0.25f; float q = 0.f;
#pragma unroll
            for (int t = 0; t < 4; ++t) { const float dm = mt[t] - mean; q += m2[t] + 256.0f * dm * dm; }
            S[row] = (f32x2){mean, rsqrtf(q * (1.0f / 1024.0f) + LN_EPS)};
        }
        asm volatile("s_waitcnt lgkmcnt(0)" ::: "memory"); __builtin_amdgcn_s_barrier(); asm volatile("" ::: "memory");
    }
};
template <int WHICH, bool INF32, bool OUTF32>
struct EpiResidLn {
    static constexpr bool PERM = false;
    static constexpr bool PREFETCH = false;
    const float* const* in; unsigned char* ws; float* out_; int l; LAS unsigned char* lx;
    __device__ __forceinline__ void prefetch(const Unit& u, int it, int nit, int wid, int lane_) const {
        int lane = lane_; asm volatile("" : "+v"(lane));
        const float* xb = (WHICH == 0 && l == 0) ? (u.pm < 16 ? in[0] + (size_t)u.pm * BM * DM : in[1] + (size_t)(u.pm - 16) * BM * DM) : out_ + (size_t)u.pm * BM * DM;
        const int R = nit >= 16 ? 2 : 4;
#pragma unroll
        for (int k = 0; k < 4; ++k) { const int j = it * R + k;
            if (k < R && j < 32) __builtin_amdgcn_global_load_lds((const unsigned*)(xb + (size_t)(j * 8 + wid) * DM + u.pn * BM + lane * 4), (LAS unsigned*)(lx + 10240), 16, 0, 0); }
    }
    __device__ __forceinline__ void run(f32x4 (&acc)[2][2][4][2], const Unit& u, int wr, int wc, int fr_, int fq_) const {
        int fr = fr_, fq = fq_; asm volatile("" : "+v"(fr), "+v"(fq));
        int lv = l; asm volatile("" : "+v"(lv)); lv = __builtin_amdgcn_readfirstlane(lv);
        const float* mod = (const float*)(ws + 0) + lv * 9 * 6144;
        float* out = out_;
        const float* xres_ctx = (WHICH == 0 && lv == 0) ? in[0] : out;
        const float* xres_lat = (WHICH == 0 && lv == 0) ? in[1] : out + (size_t)T_CTX * DM;
        const int goff = WHICH == 0 ? 2048 : 5120;
        const float* lg = in[WHICH == 0 ? 19 : 23] + lv * DM; const float* lb = in[WHICH == 0 ? 20 : 24] + lv * DM;
        bf16_t* act = (bf16_t*)(ws + (size_t)70 * 1048576);
        const float* modn = WHICH == 0 ? mod : (const float*)(ws + 0) + (lv + 1 < DEPTH ? lv + 1 : lv) * 9 * 6144;
        const int sh_off = WHICH == 0 ? 3072 : 0, sc_off = WHICH == 0 ? 4096 : 1024;
        PanelStats st{(unsigned long long*)(ws + (size_t)424 * 1048576), (unsigned*)(ws + (size_t)426 * 1048576) + (lv * 2 + WHICH) * 144 * 64, lx};
        const int v = u.pm < 16 ? 0 : 1 + ((u.pm - 16) >> 4);
        const float* xb = u.pm < 16 ? xres_ctx + (size_t)u.pm * BM * DM : xres_lat + (size_t)(u.pm - 16) * BM * DM;
        float* ob = out + (size_t)u.pm * BM * DM;
        bf16_t* xs = (bf16_t*)(ws + (size_t)427 * 1048576);
        const int col0 = u.pn * BM + wc * 32 + 4 * fq;
        const size_t roff = (size_t)(wr * 64 + fr) * DM + col0;
        {
            const float* gp = mod + v * 6144 + goff + col0;
            if constexpr (INF32) {
#pragma unroll
                for (int bj = 0; bj < 2; ++bj)
#pragma unroll
                    for (int n = 0; n < 2; ++n) { const f32x4 gv = *(const f32x4*)(gp + bj * HALF + n * 16);
#pragma unroll
                        for (int ai = 0; ai < 2; ++ai) {
#pragma unroll
                            for (int m = 0; m < 4; ++m) { const size_t o_ = roff + (size_t)(ai * HALF + m * 16) * DM + bj * HALF + n * 16;
                                const f32x4 x = *(const f32x4*)(xb + o_); acc[ai][bj][m][n] = x * ALPHA + gv * acc[ai][bj][m][n]; }
#pragma unroll
                            for (int m = 0; m < 4; ++m) asm volatile("" : "+v"(acc[ai][bj][m][n]));
                            asm volatile("" ::: "memory"); } }
            } else {
                u32x2 xw[2][2][2][4];
                const bf16_t* xp_ = xs + (size_t)u.pm * BM * DM + roff;
#pragma unroll
                for (int bj = 0; bj < 2; ++bj)
#pragma unroll
                    for (int n = 0; n < 2; ++n)
#pragma unroll
                        for (int ai = 0; ai < 2; ++ai)
#pragma unroll
                            for (int m = 0; m < 4; ++m) xw[bj][n][ai][m] = *(const u32x2*)(xp_ + (size_t)(ai * HALF + m * 16) * DM + bj * HALF + n * 16);
#pragma unroll
                for (int bj = 0; bj < 2; ++bj)
#pragma unroll
                    for (int n = 0; n < 2; ++n) { const f32x4 gv = *(const f32x4*)(gp + bj * HALF + n * 16);
#pragma unroll
                        for (int ai = 0; ai < 2; ++ai)
#pragma unroll
                            for (int m = 0; m < 4; ++m) { const u32x2 w = xw[bj][n][ai][m]; const f32x4 x = (f32x4){bf_lo(w.x), bf_hi(w.x), bf_lo(w.y), bf_hi(w.y)};
                                acc[ai][bj][m][n] = x * ALPHA + gv * acc[ai][bj][m][n]; } }
            }
        }
        const int lane = fq * 16 + fr, wid = wr * 4 + wc;
        st.run(acc, u, wr, wc, fr, fq, wid, lane);
        const LAS f32x2* S = (const LAS f32x2*)(st.lx + 8192);
        const float* mv = modn + v * 6144;
#pragma unroll
        for (int bj = 0; bj < 2; ++bj)
#pragma unroll
            for (int n = 0; n < 2; ++n) { const int c = col0 + bj * HALF + n * 16;
                const f32x4 g4 = *(const f32x4*)(lg + c), b4 = *(const f32x4*)(lb + c);
                f32x4 sh = (f32x4){0.f, 0.f, 0.f, 0.f}, sc = sh;
                sh = *(const f32x4*)(mv + sh_off + c); sc = *(const f32x4*)(mv + sc_off + c) + 1.0f;
#pragma unroll
                for (int ai = 0; ai < 2; ++ai)
#pragma unroll
                    for (int m = 0; m < 4; ++m) { const size_t off = roff + (size_t)(ai * HALF + m * 16) * DM + bj * HALF + n * 16;
                        const f32x2 sr = S[ai * HALF + wr * 64 + m * 16 + fr];
                        const f32x4 y = (acc[ai][bj][m][n] - sr.x) * sr.y * g4 + b4;
                        if (OUTF32) *(f32x4*)(ob + off) = y;
                        else { u32x2 w; w.x = cvt_pk_bf16(y[0], y[1]); w.y = cvt_pk_bf16(y[2], y[3]); *(u32x2*)(xs + (size_t)u.pm * BM * DM + off) = w; }
                        if (WHICH == 0 || lv + 1 < DEPTH) { const f32x4 h = y * sc + sh; u32x2 w; w.x = cvt_pk_bf16(h[0], h[1]); w.y = cvt_pk_bf16(h[2], h[3]);
                            *(u32x2*)(act + (size_t)u.pm * BM * DM + off) = w; } }
                asm volatile("" ::: "memory"); }
    }
};
struct EpiGate {
    static constexpr bool PERM = true;
    static constexpr bool PREFETCH = GATE_PF;
    LAS unsigned char* lx;
    __device__ __forceinline__ void prefetch(const Unit& u, int it, int nit, int wid, int lane_) const {
        if (u.seg == 2) return;
        int lane = lane_; asm volatile("" : "+v"(lane));
        const bf16_t* gb = P + (size_t)u.pm * BM * NPROJ + PC_G + u.pn * BM + (lane & 31) * 8;
#pragma unroll
        for (int k = 0; k < 4; ++k) { const int j = it * 4 + k;
            const int tile = u.seg == 0 ? (j >> 4) : 0; const int goff = u.seg == 0 ? (tile == 0 ? 0 : 2048) : 1024; const int jr = j & 15;
            if (j < (u.seg == 0 ? 32 : 16)) __builtin_amdgcn_global_load_lds((const unsigned*)(gb + (size_t)(jr * 16 + wid * 2 + (lane >> 5)) * NPROJ + goff), (LAS unsigned*)(lx + 10240), 16, 0, 0); }
    }
    const bf16_t* P;
    bf16_t* O; int ldc;
    __device__ __forceinline__ void run(f32x4 (&acc)[2][2][4][2], const Unit& u, int wr, int wc, int fr, int fq) const {
        const int row0 = u.pm * BM + wr * 64 + fr; const int col0 = u.pn * BM + wc * 32 + 8 * fq;
        const int noff = u.seg == 0 ? 0 : (u.seg == 1 ? 2048 : 1024), doff = u.seg == 0 ? 2048 : 1024;
        const bool last = u.seg == 2;
#pragma unroll
        for (int ai = 0; ai < 2; ++ai)
#pragma unroll
            for (int m = 0; m < 4; ++m) { const size_t r = (size_t)(row0 + ai * HALF + m * 16);
                const bf16_t* gp = P + r * NPROJ + PC_G + col0;
#pragma unroll
                for (int bj = 0; bj < 2; ++bj) {
                    const u32x4 gn = *(const u32x4*)(gp + noff + bj * HALF);
                    u32x4 gd = gn; if (!last) gd = *(const u32x4*)(gp + doff + bj * HALF);
                    float f[8];
#pragma unroll
                    for (int e = 0; e < 4; ++e) {
                        const float r0 = __builtin_amdgcn_rcpf(bf_lo(gn[e])), r1 = __builtin_amdgcn_rcpf(bf_hi(gn[e]));
                        if (last) { f[2 * e] = r0; f[2 * e + 1] = r1; }
                        else { f[2 * e] = bf_lo(gd[e]) * r0; f[2 * e + 1] = bf_hi(gd[e]) * r1; }
                    }
                    f32x4 v0 = acc[ai][bj][m][0], v1 = acc[ai][bj][m][1];
                    v0[0] *= f[0]; v0[1] *= f[1]; v0[2] *= f[2]; v0[3] *= f[3]; v1[0] *= f[4]; v1[1] *= f[5]; v1[2] *= f[6]; v1[3] *= f[7];
                    if (last) { u32x4 w; w.x = cvt_pk_bf16(v0[0], v0[1]); w.y = cvt_pk_bf16(v0[2], v0[3]); w.z = cvt_pk_bf16(v1[0], v1[1]); w.w = cvt_pk_bf16(v1[2], v1[3]);
                        *(u32x4*)(O + r * ldc + col0 + bj * HALF) = w; }
                    else { acc[ai][bj][m][0] = v0; acc[ai][bj][m][1] = v1; }
                } }
    }
};

struct EpiNone { static constexpr bool PREFETCH = false; static constexpr bool PERM = true; __device__ __forceinline__ void run(f32x4 (&acc)[2][2][4][2], const Unit& u, int wr, int wc, int fr, int fq) const {
    _Pragma("unroll") for (int a = 0; a < 2; ++a) _Pragma("unroll") for (int b = 0; b < 2; ++b) _Pragma("unroll") for (int m = 0; m < 4; ++m) _Pragma("unroll") for (int n = 0; n < 2; ++n) asm volatile("" :: "v"(acc[a][b][m][n])); } };
template <class Epi>
__device__ __forceinline__ void gemm_phase(LAS unsigned char* lds, const Gemm g, const Order& S, const Epi& E, const int tid) {
    const int wid = __builtin_amdgcn_readfirstlane(tid >> 6), lane = tid & 63, wr = wid >> 2, wc = wid & 3, fr = lane & 15, fq = lane >> 4;
    unsigned voffA[2], voffB[2];
#pragma unroll
    for (int i = 0; i < 2; ++i) { int R, C; stage_rc(tid * 16 + i * 8192, R, C); const int Rb = Epi::PERM ? ((R & ~31) + perm32(R & 31)) : R;
        voffA[i] = (unsigned)(R * g.lda + C) * 2u; voffB[i] = (unsigned)(Rb * g.ldb + C) * 2u; }
    const size_t kstep = (size_t)(BK * 2);
    const size_t hstepA = (size_t)HALF * g.lda * 2, hstepB = (size_t)HALF * g.ldb * 2;
    const size_t tstepA = 2 * hstepA, tstepB = 2 * hstepB;
    const unsigned ldsw = (unsigned)wid * 1024u;
    const int aoff = lds_byte(wr * 64 + fr, fq * 8), boff = lds_byte(wc * 32 + fr, fq * 8);
#define PG8_SA(b, h) (((b) * 2 + (h)) * HTB)
#define PG8_SB(b, h) ((4 + (b) * 2 + (h)) * HTB)
#define PG8_STAGE(bufoff, gbase, voff) do { _Pragma("unroll") for (int _i = 0; _i < 2; ++_i) \
        __builtin_amdgcn_global_load_lds((const unsigned*)((const char*)(gbase) + (voff)[_i]), (LAS unsigned*)(lds + (bufoff) + ldsw + _i * 8192), 16, 0, 0); } while (0)
#define PG8_LDA(dst, b, h) do { _Pragma("unroll") for (int m = 0; m < 4; ++m) _Pragma("unroll") for (int k = 0; k < 2; ++k) dst[m][k] = *(const LAS bf16x8*)(lds + PG8_SA(b, h) + aoff + m * 2048 + k * 1024); } while (0)
#define PG8_LDB(dst, b, h) do { _Pragma("unroll") for (int n = 0; n < 2; ++n) _Pragma("unroll") for (int k = 0; k < 2; ++k) dst[n][k] = *(const LAS bf16x8*)(lds + PG8_SB(b, h) + boff + n * 2048 + k * 1024); } while (0)
#define PG8_MMA(ai, bj, At, Bt) do { __builtin_amdgcn_s_setprio(1); _Pragma("unroll") for (int m = 0; m < 4; ++m) _Pragma("unroll") for (int n = 0; n < 2; ++n) _Pragma("unroll") for (int k = 0; k < 2; ++k) \
        acc[ai][bj][m][n] = __builtin_amdgcn_mfma_f32_16x16x32_bf16(Bt[n][k], At[m][k], acc[ai][bj][m][n], 0, 0, 0); __builtin_amdgcn_s_setprio(0); } while (0)
#define PG8_WAIT_V(n) asm volatile("s_waitcnt vmcnt(" #n ")" ::: "memory")
#define PG8_WAIT_L(n) asm volatile("s_waitcnt lgkmcnt(" #n ")" ::: "memory")
#define PG8_BAR __builtin_amdgcn_s_barrier()
#define PG8_SCHED __builtin_amdgcn_sched_barrier(0)
#define KOF(sg) ((sg) == 0 ? g.k0[0] : ((sg) == 1 ? g.k0[1] : g.k0[2]))
#define NTF(sg) ((sg) == 0 ? g.nt[0] : ((sg) == 1 ? g.nt[1] : g.nt[2]))
    Unit cur, nxt; int ui = 0;
    if (!S.next(0, cur)) return;
    if (S.stagger) {
        const int mine = (S.nwg - S.c + S.G - 1) / S.G, mx = (S.nwg + S.G - 1) / S.G;
        if (mine < mx) { const unsigned long long t0 = __builtin_amdgcn_s_memrealtime(); while (__builtin_amdgcn_s_memrealtime() - t0 < (unsigned long long)S.stagger) __builtin_amdgcn_s_sleep(16); }
    }
    f32x4 acc[2][2][4][2];
#pragma unroll
    for (int a = 0; a < 2; ++a)
#pragma unroll
        for (int b = 0; b < 2; ++b)
#pragma unroll
            for (int m = 0; m < 4; ++m)
#pragma unroll
                for (int n = 0; n < 2; ++n) acc[a][b][m][n] = (f32x4){0.f, 0.f, 0.f, 0.f};
    bf16x8 At[4][2], B0[2][2], B1[2][2];
    const char* cA = (const char*)g.A + (size_t)cur.pm * tstepA + (size_t)KOF(cur.seg) * 2; const char* cB = (const char*)g.Bt + (size_t)cur.pn * tstepB + (size_t)KOF(cur.seg) * 2;
    PG8_STAGE(PG8_SB(0, 0), cB, voffB); PG8_STAGE(PG8_SB(0, 1), cB + hstepB, voffB); PG8_STAGE(PG8_SA(0, 0), cA, voffA); PG8_STAGE(PG8_SA(0, 1), cA + hstepA, voffA);
    if (wr == 1) PG8_BAR;
    PG8_WAIT_V(2); PG8_BAR;
    PG8_STAGE(PG8_SB(1, 0), cB + kstep, voffB); PG8_STAGE(PG8_SA(1, 0), cA + kstep, voffA); PG8_STAGE(PG8_SB(1, 1), cB + hstepB + kstep, voffB);
    PG8_WAIT_V(6); PG8_BAR;
    for (;;) {
        const bool has_next = S.next(ui + 1, nxt);
        const int nt = NTF(cur.seg);
        const char* nA = has_next ? (const char*)g.A + (size_t)nxt.pm * tstepA + (size_t)KOF(nxt.seg) * 2 : cA;
        const char* nB = has_next ? (const char*)g.Bt + (size_t)nxt.pn * tstepB + (size_t)KOF(nxt.seg) * 2 : cB;
        for (int t = 0; t < nt; t += 2) {
            const bool last = (t == nt - 2);
            const char* a1 = cA + (size_t)(t + 1) * kstep;
            const char* a2 = last ? nA : cA + (size_t)(t + 2) * kstep; const char* b2 = last ? nB : cB + (size_t)(t + 2) * kstep;
            const char* a3 = a2 + kstep; const char* b3 = b2 + kstep;
            PG8_LDB(B0, 0, 0); PG8_LDB(B1, 0, 1); PG8_SCHED; PG8_LDA(At, 0, 0); PG8_STAGE(PG8_SA(1, 1), a1 + hstepA, voffA);
            if constexpr (Epi::PREFETCH) E.prefetch(cur, t >> 1, nt >> 1, wid, lane);
            PG8_WAIT_V(8); PG8_WAIT_L(0); PG8_BAR; PG8_MMA(0, 0, At, B0); PG8_MMA(0, 1, At, B1); PG8_BAR; PG8_SCHED;
            PG8_LDA(At, 0, 1); PG8_STAGE(PG8_SB(0, 0), b2, voffB); PG8_STAGE(PG8_SB(0, 1), b2 + hstepB, voffB); PG8_STAGE(PG8_SA(0, 0), a2, voffA);
            PG8_WAIT_V(8); PG8_WAIT_L(0); PG8_BAR; PG8_MMA(1, 0, At, B0); PG8_MMA(1, 1, At, B1); PG8_BAR; PG8_SCHED;
            PG8_LDB(B0, 1, 0); PG8_LDB(B1, 1, 1); PG8_SCHED; PG8_LDA(At, 1, 0); PG8_STAGE(PG8_SA(0, 1), a2 + hstepA, voffA);
            PG8_WAIT_V(8); PG8_WAIT_L(0); PG8_BAR; PG8_MMA(0, 0, At, B0); PG8_MMA(0, 1, At, B1); PG8_BAR; PG8_SCHED;
            PG8_LDA(At, 1, 1); PG8_STAGE(PG8_SB(1, 0), b3, voffB); PG8_STAGE(PG8_SB(1, 1), b3 + hstepB, voffB); PG8_STAGE(PG8_SA(1, 0), a3, voffA);
            PG8_WAIT_V(8); PG8_WAIT_L(0); PG8_BAR; PG8_MMA(1, 0, At, B0); PG8_MMA(1, 1, At, B1); PG8_BAR; PG8_SCHED;
        }
        if (wr == 0) PG8_BAR;
        E.run(acc, cur, wr, wc, fr, fq);
        if (!has_next) break;
        if (cur.seg == g.nseg - 1) {
#pragma unroll
            for (int a = 0; a < 2; ++a)
#pragma unroll
                for (int b = 0; b < 2; ++b)
#pragma unroll
                    for (int m = 0; m < 4; ++m)
#pragma unroll
                        for (int n = 0; n < 2; ++n) acc[a][b][m][n] = (f32x4){0.f, 0.f, 0.f, 0.f};
        }
        cur = nxt; cA = nA; cB = nB; ++ui;
        if (wr == 1) PG8_BAR;
    }
    PG8_WAIT_V(0);
    PG8_BAR;
#undef KOF
#undef NTF
#undef PG8_SA
#undef PG8_SB
#undef PG8_STAGE
#undef PG8_LDA
#undef PG8_LDB
#undef PG8_MMA
#undef PG8_WAIT_V
#undef PG8_WAIT_L
#undef PG8_BAR
#undef PG8_SCHED
}
}

namespace att {
constexpr int D = 128, QBLK = 32, KVBLK = 64;
constexpr float SCALE = 0.088388347648318440f;
constexpr float THR = 8.f;
constexpr size_t SHM_V = KVBLK * D * 2, SHM_K = KVBLK * D * 2, SHM_ATTN = 2 * SHM_V + 2 * SHM_K + NW * 64 * 4;
#define KSWZ(row, colB) ((row) * 256 + ((colB) ^ (((row) & 7) << 4)))
#define SBAR() __builtin_amdgcn_sched_barrier(0)
__device__ __forceinline__ int crow(int r, int hi) { return (r & 3) + 8 * (r >> 2) + 4 * hi; }
__device__ __forceinline__ unsigned cvtpk(float lo, float hi) { unsigned r; asm volatile("v_cvt_pk_bf16_f32 %0, %1, %2" : "=v"(r) : "v"(lo), "v"(hi)); return r; }
__device__ __forceinline__ void partialSM(f32x16& p0, f32x16& p1, float& m_reg, float& mn, float& alpha) {
  constexpr float C = SCALE * 1.4426950408889634f;
  float pmax = p0[0];
#pragma unroll
  for (int r = 1; r < 16; ++r) pmax = fmaxf(pmax, p0[r]);
#pragma unroll
  for (int r = 0; r < 16; ++r) pmax = fmaxf(pmax, p1[r]);
  { auto rr = __builtin_amdgcn_permlane32_swap(__float_as_uint(pmax), __float_as_uint(pmax), false, false);
    pmax = fmaxf(__uint_as_float(rr[0]), __uint_as_float(rr[1])); }
  if (__builtin_expect(__all(pmax - m_reg <= THR / SCALE), 1)) { mn = m_reg; alpha = 1.f; }
  else { mn = fmaxf(m_reg, pmax); alpha = __builtin_amdgcn_exp2f((m_reg - mn) * C); m_reg = mn; }
  float mnC = -mn * C;
#pragma unroll
  for (int r = 0; r < 16; ++r) p0[r] = fmaf(p0[r], C, mnC);
#pragma unroll
  for (int r = 0; r < 16; ++r) p1[r] = fmaf(p1[r], C, mnC);
#pragma unroll
  for (int r = 0; r < 16; ++r) p0[r] = __builtin_amdgcn_exp2f(p0[r]);
}
__device__ __forceinline__ void finishSM(f32x16& p0, f32x16& p1, float alpha, float& l_reg, bf16x8& pa0, bf16x8& pa1, bf16x8& pa2, bf16x8& pa3) {
#pragma unroll
  for (int r = 0; r < 16; ++r) p1[r] = __builtin_amdgcn_exp2f(p1[r]);
  float ps = 0;
#pragma unroll
  for (int r = 0; r < 16; ++r) ps += p0[r];
#pragma unroll
  for (int r = 0; r < 16; ++r) ps += p1[r];
  { auto rr = __builtin_amdgcn_permlane32_swap(__float_as_uint(ps), __float_as_uint(ps), false, false);
    ps = __uint_as_float(rr[0]) + __uint_as_float(rr[1]); }
  l_reg = l_reg * alpha + ps;
#define PK4(P, BASE, OUT) do { unsigned a0 = cvtpk(P[BASE + 0], P[BASE + 1]), a1 = cvtpk(P[BASE + 2], P[BASE + 3]);   \
    unsigned b0 = cvtpk(P[BASE + 4], P[BASE + 5]), b1 = cvtpk(P[BASE + 6], P[BASE + 7]);                              \
    auto r0 = __builtin_amdgcn_permlane32_swap(a0, b0, false, false); auto r1 = __builtin_amdgcn_permlane32_swap(a1, b1, false, false); \
    u32x4 w = {r0[0], r1[0], r0[1], r1[1]}; OUT = *reinterpret_cast<bf16x8*>(&w); } while (0)
  PK4(p0, 0, pa0); PK4(p0, 8, pa1); PK4(p1, 0, pa2); PK4(p1, 8, pa3);
#undef PK4
}
__device__ __forceinline__ void qkt(f32x16& p0, f32x16& p1, const bf16_t* Ks, const bf16x8* qr, int r32, int hi) {
  p0 = f32x16{}; p1 = f32x16{};
#pragma unroll
  for (int d0 = 0; d0 < 8; ++d0) { int cb = (d0 * 16 + hi * 8) * 2;
    bf16x8 b0 = *reinterpret_cast<const bf16x8*>((const char*)Ks + KSWZ(r32, cb));
    bf16x8 b1 = *reinterpret_cast<const bf16x8*>((const char*)Ks + KSWZ(32 + r32, cb));
    p0 = __builtin_amdgcn_mfma_f32_32x32x16_bf16(b0, qr[d0], p0, 0, 0, 0);
    p1 = __builtin_amdgcn_mfma_f32_32x32x16_bf16(b1, qr[d0], p1, 0, 0, 0); }
}
__device__ __forceinline__ int v_st(int k, int c) { const int kk = (k & ~0xC) | ((k & 4) << 1) | ((k & 8) >> 1); return ((kk >> 3) * 4 + (c >> 5)) * 512 + ((kk & 7) * 32 + (c & 31)) * 2; }
__device__ __forceinline__ int v_rd_base(int lane) { return ((lane & 3) << 3) | (((lane >> 2) & 3) << 6) | (((lane >> 4) & 1) << 5) | (((lane >> 5) & 1) << 8); }
constexpr int v_rd_off(int d0, int ks, int half) { return d0 * 512 + ks * 4096 + half * 2048; }
template <int OFF> __device__ __forceinline__ s16x4 tr_read(int vb) {
  s16x4 r; asm volatile("ds_read_b64_tr_b16 %0, %1 offset:%2" : "=&v"(r) : "v"(vb), "i"(OFF) : "memory"); return r;
}
template <int D0> __device__ __forceinline__ void pv_one(f32x16& od, int vb, bf16x8 pa0, bf16x8 pa1, bf16x8 pa2, bf16x8 pa3) {
  const s16x4 l0 = tr_read<v_rd_off(D0, 0, 0)>(vb), h0 = tr_read<v_rd_off(D0, 0, 1)>(vb), l1 = tr_read<v_rd_off(D0, 1, 0)>(vb), h1 = tr_read<v_rd_off(D0, 1, 1)>(vb);
  const s16x4 l2 = tr_read<v_rd_off(D0, 2, 0)>(vb), h2 = tr_read<v_rd_off(D0, 2, 1)>(vb), l3 = tr_read<v_rd_off(D0, 3, 0)>(vb), h3 = tr_read<v_rd_off(D0, 3, 1)>(vb);
  asm volatile("s_waitcnt lgkmcnt(0)" ::: "memory"); SBAR();
#define PK(L, H) (bf16x8){L[0], L[1], L[2], L[3], H[0], H[1], H[2], H[3]}
  od = __builtin_amdgcn_mfma_f32_32x32x16_bf16(pa0, PK(l0, h0), od, 0, 0, 0);
  od = __builtin_amdgcn_mfma_f32_32x32x16_bf16(pa1, PK(l1, h1), od, 0, 0, 0);
  od = __builtin_amdgcn_mfma_f32_32x32x16_bf16(pa2, PK(l2, h2), od, 0, 0, 0);
  od = __builtin_amdgcn_mfma_f32_32x32x16_bf16(pa3, PK(l3, h3), od, 0, 0, 0);
#undef PK
}
__device__ __forceinline__ void pv_d0(f32x16* o, int vb, bf16x8 pa0, bf16x8 pa1, bf16x8 pa2, bf16x8 pa3) {
  pv_one<0>(o[0], vb, pa0, pa1, pa2, pa3); pv_one<1>(o[1], vb, pa0, pa1, pa2, pa3); pv_one<2>(o[2], vb, pa0, pa1, pa2, pa3); pv_one<3>(o[3], vb, pa0, pa1, pa2, pa3);
}
constexpr int LDQ = NPROJ, LDK = 256;
__device__ __forceinline__ void attn_dense_body(bf16_t* Qb, const bf16_t* __restrict__ Kh, const bf16_t* __restrict__ Vh, int seq, char* lds, const int tid, const float* __restrict__ qg, const float* __restrict__ rope, int s0, const bool STORE = true) {
  const int wid = tid >> 6, lane = tid & 63, r32 = lane & 31, hi = lane >> 5;
  bf16_t* V_lds = (bf16_t*)lds; bf16_t* K_lds = (bf16_t*)(lds + 2 * SHM_V);
  float* ws = (float*)(lds + 2 * SHM_V + 2 * SHM_K) + wid * 64; float* li_l = ws; float* al_l = ws + 32;
  float m_reg = -1e30f, l_reg = 0; f32x16 o[4] = {}; bf16x8 qr[8];
  const bf16_t* Qw = Qb + (long)(wid * QBLK + r32) * LDQ + hi * 8;
#pragma unroll
  for (int d0 = 0; d0 < 8; ++d0) qr[d0] = *reinterpret_cast<const bf16x8*>(Qw + d0 * 16);
  {
    float ss = 0.f;
#pragma unroll
    for (int d0 = 0; d0 < 8; ++d0) { const u32x4 w = __builtin_bit_cast(u32x4, qr[d0]);
#pragma unroll
      for (int e = 0; e < 4; ++e) { const float lo = __uint_as_float(w[e] << 16), hi_ = __uint_as_float(w[e] & 0xffff0000u); ss += lo * lo + hi_ * hi_; } }
    { auto rr = __builtin_amdgcn_permlane32_swap(__float_as_uint(ss), __float_as_uint(ss), false, false); ss = __uint_as_float(rr[0]) + __uint_as_float(rr[1]); }
    const float rinv = rsqrtf(ss * (1.0f / 128.0f) + LN_EPS);
    const int sp = s0 + wid * QBLK + r32;
#pragma unroll
    for (int a = 0; a < 2; ++a) {
      float qf[4][8];
#pragma unroll
      for (int dd = 0; dd < 4; ++dd) { const int d0 = a * 4 + dd; const u32x4 w = __builtin_bit_cast(u32x4, qr[d0]);
        const f32x4 g0 = *(const f32x4*)(qg + d0 * 16 + hi * 8), g1 = *(const f32x4*)(qg + d0 * 16 + hi * 8 + 4);
        qf[dd][0] = __uint_as_float(w[0] << 16) * (rinv * g0[0]); qf[dd][1] = __uint_as_float(w[0] & 0xffff0000u) * (rinv * g0[1]);
        qf[dd][2] = __uint_as_float(w[1] << 16) * (rinv * g0[2]); qf[dd][3] = __uint_as_float(w[1] & 0xffff0000u) * (rinv * g0[3]);
        qf[dd][4] = __uint_as_float(w[2] << 16) * (rinv * g1[0]); qf[dd][5] = __uint_as_float(w[2] & 0xffff0000u) * (rinv * g1[1]);
        qf[dd][6] = __uint_as_float(w[3] << 16) * (rinv * g1[2]); qf[dd][7] = __uint_as_float(w[3] & 0xffff0000u) * (rinv * g1[3]); }
      if (rope) { const int pos = a == 0 ? (sp >> 6) : (sp & 63);
#pragma unroll
        for (int dd = 0; dd < 2; ++dd) { const float* cp = rope + pos * 32 + dd * 16 + hi * 8;
          const f32x4 c0 = *(const f32x4*)cp, c1 = *(const f32x4*)(cp + 4), s0v = *(const f32x4*)(cp + 2048), s1v = *(const f32x4*)(cp + 2048 + 4);
#pragma unroll
          for (int e = 0; e < 4; ++e) { float x1 = qf[dd][e], x2 = qf[dd + 2][e]; qf[dd][e] = x1 * c0[e] - x2 * s0v[e]; qf[dd + 2][e] = x2 * c0[e] + x1 * s0v[e];
            x1 = qf[dd][4 + e]; x2 = qf[dd + 2][4 + e]; qf[dd][4 + e] = x1 * c1[e] - x2 * s1v[e]; qf[dd + 2][4 + e] = x2 * c1[e] + x1 * s1v[e]; } } }
#pragma unroll
      for (int dd = 0; dd < 4; ++dd) { u32x4 w; w.x = cvtpk(qf[dd][0], qf[dd][1]); w.y = cvtpk(qf[dd][2], qf[dd][3]); w.z = cvtpk(qf[dd][4], qf[dd][5]); w.w = cvtpk(qf[dd][6], qf[dd][7]); qr[a * 4 + dd] = __builtin_bit_cast(bf16x8, w); }
      asm volatile("" ::: "memory");
    }
  }
  int tid2 = tid; asm volatile("" : "+v"(tid2));
  const int sr = tid2 >> 4, sc = (tid2 & 15) * 8, vst0 = v_st(sr, sc), vst1 = v_st(32 + sr, sc);
  const int vb0 = (int)(uintptr_t)V_lds + v_rd_base(tid2 & 63);
  struct { bf16x8 vs0, vs1, ks0, ks1; } sr_[1];
#define LD8(p) (*reinterpret_cast<const bf16x8*>(p))
#define SLOAD(i, k0) do { sr_[i].vs0 = LD8(&Vh[(long)((k0) + sr) * LDK + sc]); sr_[i].vs1 = LD8(&Vh[(long)((k0) + 32 + sr) * LDK + sc]); \
    sr_[i].ks0 = LD8(&Kh[(long)((k0) + sr) * LDK + sc]); sr_[i].ks1 = LD8(&Kh[(long)((k0) + 32 + sr) * LDK + sc]); } while (0)
#define SWRITE(b, i) do { *(bf16x8*)((char*)V_lds + (b) * SHM_V + vst0) = sr_[i].vs0;          \
    *(bf16x8*)((char*)V_lds + (b) * SHM_V + vst1) = sr_[i].vs1; int kc = sc * 2;               \
    *(bf16x8*)((char*)K_lds + (b) * SHM_K + KSWZ(sr, kc)) = sr_[i].ks0;                       \
    *(bf16x8*)((char*)K_lds + (b) * SHM_K + KSWZ(32 + sr, kc)) = sr_[i].ks1; } while (0)
#define SWAIT() asm volatile("s_waitcnt vmcnt(0)" ::: "memory")
#define RESC(a) do { if (__any((a) < 1.f)) { if (hi == 0) al_l[r32] = (a); asm volatile("s_waitcnt lgkmcnt(0)" ::: "memory"); \
    _Pragma("unroll") for (int d = 0; d < 4; ++d) _Pragma("unroll") for (int r = 0; r < 16; ++r) o[d][r] *= al_l[crow(r, hi)]; } } while (0)
  f32x16 pA0, pA1, pB0, pB1; float mnA, mnB, alA, alB; bf16x8 pa0, pa1, pa2, pa3; const int NT = seq / KVBLK;
  constexpr int SE = 0, SO = 0;
  SLOAD(SE, 0); asm volatile("s_waitcnt vmcnt(0)" ::: "memory"); SWRITE(0, SE); __syncthreads();
  qkt(pA0, pA1, K_lds, qr, r32, hi); partialSM(pA0, pA1, m_reg, mnA, alA);
  SLOAD(SO, KVBLK);
  SWAIT(); SWRITE(1, SO); __syncthreads();
  for (int j = 1; j + 1 < NT; j += 2) {
    SBAR(); qkt(pB0, pB1, (bf16_t*)((char*)K_lds + SHM_K), qr, r32, hi);
    finishSM(pA0, pA1, alA, l_reg, pa0, pa1, pa2, pa3); SBAR();
    SLOAD(SO, (j + 1) * KVBLK); SBAR();
    pv_d0(o, vb0, pa0, pa1, pa2, pa3); partialSM(pB0, pB1, m_reg, mnB, alB);
    __syncthreads(); SWAIT(); SWRITE(0, SE);
    RESC(alB); __syncthreads();
    SBAR(); qkt(pA0, pA1, K_lds, qr, r32, hi);
    finishSM(pB0, pB1, alB, l_reg, pa0, pa1, pa2, pa3); SBAR();
    SLOAD(SE, (j + 2) * KVBLK); SBAR();
    pv_d0(o, vb0 + (int)SHM_V, pa0, pa1, pa2, pa3); partialSM(pA0, pA1, m_reg, mnA, alA);
    __syncthreads(); SWAIT(); SWRITE(1, SO);
    RESC(alA); __syncthreads();
  }
  SBAR(); qkt(pB0, pB1, (bf16_t*)((char*)K_lds + SHM_K), qr, r32, hi);
  finishSM(pA0, pA1, alA, l_reg, pa0, pa1, pa2, pa3); SBAR();
  pv_d0(o, vb0, pa0, pa1, pa2, pa3); partialSM(pB0, pB1, m_reg, mnB, alB);
  __syncthreads(); RESC(alB);
  finishSM(pB0, pB1, alB, l_reg, pa0, pa1, pa2, pa3); SBAR();
  pv_d0(o, vb0 + (int)SHM_V, pa0, pa1, pa2, pa3);
  if (hi == 0) li_l[r32] = l_reg; asm volatile("s_waitcnt lgkmcnt(0)" ::: "memory");
  float rli[16];
#pragma unroll
  for (int r = 0; r < 16; ++r) rli[r] = __builtin_amdgcn_rcpf(li_l[crow(r, hi)]);
  __syncthreads();
  { bf16_t* stg = (bf16_t*)lds + wid * 4096;
#pragma unroll
    for (int r = 0; r < 16; ++r) { const int orow = crow(r, hi);
#pragma unroll
      for (int d0 = 0; d0 < 4; ++d0) stg[orow * 128 + d0 * 32 + r32] = (bf16_t)(cvtpk(o[d0][r] * rli[r], 0.f) & 0xffffu); }
    asm volatile("s_waitcnt lgkmcnt(0)" ::: "memory");
    int le = lane; asm volatile("" : "+v"(le));
    bf16_t* Ow = Qb + (long)(wid * QBLK + (le >> 4)) * LDQ + (le & 15) * 8;
#pragma unroll
    for (int i = 0; i < 8; ++i) { const u32x4 v = *(const u32x4*)(stg + (i * 4 + (le >> 4)) * 128 + (le & 15) * 8); if (STORE) *(u32x4*)(Ow + (long)i * 4 * LDQ) = v; else asm volatile("" :: "v"(v)); }
  }
  __syncthreads();
#undef LD8
#undef SLOAD
#undef SWRITE
#undef SWAIT
#undef RESC
}
#undef KSWZ
#undef SBAR
}


#define XB_TMO      128
#define XB_XCNT(j)  (256  + 64 * (j))
#define XB_XSUB(j)  (1280 + 64 * (j))
#define XB_XGEN(j)  (2304 + 64 * (j))
#define XB_TOP      3328
#define XB_TOPGEN   3392
#define XCD_BAR_WORDS 3456
#define XB_SPIN_CAP (1u << 18)
__device__ __forceinline__ unsigned xb_ld(unsigned* p)              { return __hip_atomic_load(p, __ATOMIC_RELAXED, __HIP_MEMORY_SCOPE_AGENT); }
__device__ __forceinline__ unsigned xb_add(unsigned* p, unsigned v) { return __hip_atomic_fetch_add(p, v, __ATOMIC_RELAXED, __HIP_MEMORY_SCOPE_AGENT); }
__device__ __forceinline__ unsigned xb_xcc_id() { return (unsigned)__builtin_amdgcn_s_getreg((3 << 11) | 20) & 0xFu; }
#define XB_SPIN(cond, bar) do { unsigned _sp = 0; while (cond) { __builtin_amdgcn_s_sleep(1); \
    if ((++_sp & 255u) == 0u) { if (xb_ld(&(bar)[XB_TMO])) break; if (_sp > XB_SPIN_CAP) { atomicAdd(&(bar)[XB_TMO], 1u); break; } } } } while (0)
struct XcdBarrier { unsigned* bar; unsigned x; volatile LAS unsigned* st; };
__device__ __forceinline__ XcdBarrier xcd_barrier_post(unsigned* bar, volatile LAS unsigned* st) {
    XcdBarrier b; b.bar = bar; b.x = xb_xcc_id(); b.st = st;
    if (threadIdx.x == 0) (void)xb_add(&bar[XB_XCNT(b.x)], 1u);
    return b;
}
__device__ __forceinline__ void xcd_barrier_complete(unsigned* bar, unsigned x, unsigned& nloc, unsigned& nx) {
    const unsigned G = gridDim.x * gridDim.y * gridDim.z;
    unsigned sum, cnt, mine, sp = 0u;
    for (;;) {
        sum = 0u; cnt = 0u; mine = 0u;
#pragma unroll
        for (unsigned j = 0; j < 16; ++j) { const unsigned c = xb_ld(&bar[XB_XCNT(j)]); sum += c; cnt += (c > 0u) ? 1u : 0u; mine = (j == x) ? c : mine; }
        if (sum == G) break;
        __builtin_amdgcn_s_sleep(1);
        if ((++sp & 255u) == 0u) { if (xb_ld(&bar[XB_TMO])) break; if (sp > XB_SPIN_CAP) { atomicAdd(&bar[XB_TMO], 1u); break; } }
    }
    nloc = mine > 0u ? mine : 1u; nx = cnt > 0u ? cnt : 1u;
}
__device__ __forceinline__ void xcd_barrier(const XcdBarrier& b) {
    asm volatile("s_waitcnt vmcnt(0)" ::: "memory");
    __syncthreads();
    if (threadIdx.x == 0) {
        unsigned* bar = b.bar;
        __builtin_amdgcn_s_waitcnt(0);
        unsigned nloc = b.st[0], nx = b.st[1];
        if (nloc == 0u) { xcd_barrier_complete(bar, b.x, nloc, nx); b.st[0] = nloc; b.st[1] = nx; }
        const unsigned old = xb_add(&bar[XB_XSUB(b.x)], 1u);
        const unsigned gen = old / nloc;
        if (old + 1u == (gen + 1u) * nloc) {
            __builtin_amdgcn_fence(__ATOMIC_RELEASE, "agent");
            asm volatile("s_waitcnt vmcnt(0)" ::: "memory");
            const unsigned og = xb_add(&bar[XB_TOP], 1u);
            const unsigned tg = og / nx;
            if (og + 1u == (tg + 1u) * nx) xb_add(&bar[XB_TOPGEN], 1u);
            else XB_SPIN(xb_ld(&bar[XB_TOPGEN]) == tg, bar);
            __builtin_amdgcn_fence(__ATOMIC_ACQUIRE, "agent");
            xb_add(&bar[XB_XGEN(b.x)], 1u);
            asm volatile("s_waitcnt vmcnt(0)" ::: "memory");
        } else {
            XB_SPIN(xb_ld(&bar[XB_XGEN(b.x)]) == gen, bar);
            __builtin_amdgcn_fence(__ATOMIC_ACQUIRE, "agent");
            asm volatile("s_waitcnt vmcnt(0)" ::: "memory");
        }
    }
    __syncthreads();
}

struct Args { const float* in[25]; float* out; unsigned char* ws; int ph_lo, ph_hi; };

typedef const float* fptr_t;
typedef __attribute__((address_space(4))) const fptr_t* in_as4_t;
struct Frame {
    LAS unsigned char* lds; char* ldsg;
    int tid, lane, wave, G, bx, gw, NGW;
    const float* const* in;
    unsigned char* ws; float* out;
};
enum { I_XP = 0, I_XS, I_CK, I_CV, I_C, I_CCTX, I_WADA, I_BADA, I_WIN, I_QG, I_KG, I_WPG, I_PSC, I_WSGU, I_BSGU, I_WAO, I_WPO, I_WSO, I_WOUT, I_LN1G, I_LN1B, I_WF1, I_WF2, I_LN2G, I_LN2B };

__device__ __forceinline__ void tr_item(const float* W, int ldw, int src_col, int kb, bf16_t* WT, int ldt, int dst_row, int dst_k, LAS float* scr, int lane) {
    const int k0 = 64 * kb;
#pragma unroll 8
    for (int i = 0; i < 32; ++i) { const int kk = 2 * i + (lane >> 5); scr[kk * 33 + (lane & 31)] = W[(size_t)(k0 + kk) * ldw + src_col + (lane & 31)]; }
    asm volatile("s_waitcnt lgkmcnt(0)" ::: "memory");
    const int c = lane & 7;
#pragma unroll
    for (int j = 0; j < 4; ++j) { const int n = (lane >> 3) + 8 * j; const LAS float* s = scr + (8 * c) * 33 + n;
        u32x4 o; o.x = cvt_pk_bf16(s[0 * 33], s[1 * 33]); o.y = cvt_pk_bf16(s[2 * 33], s[3 * 33]); o.z = cvt_pk_bf16(s[4 * 33], s[5 * 33]); o.w = cvt_pk_bf16(s[6 * 33], s[7 * 33]);
        *(u32x4*)(WT + (size_t)(dst_row + n) * ldt + dst_k + k0 + 8 * c) = o; }
    asm volatile("s_waitcnt lgkmcnt(0)" ::: "memory");
}

__device__ __forceinline__ int win_src_col(int d) {
    if (d < 1024) return d;
    if (d < 1536) return 2048 + (d - 1024);
    if (d < 2048) return 1024 + (d - 1536);
    if (d < 2560) return 2560 + (d - 2048);
    if (d < 3072) return 1536 + (d - 2560);
    return d;
}

__device__ __forceinline__ void phase_prologue(Frame& F) {
    if (F.bx < 192) {
        const int l = F.bx / 96, nb = F.bx % 96;
        LAS float* sc = (LAS float*)F.lds;
        LAS float* red = (LAS float*)(F.lds + 9 * 1024 * 4);
        for (int idx = F.tid; idx < 9 * 1024; idx += 512) { const int v = idx >> 10, k = idx & 1023;
            const float x = v == 0 ? F.in[I_CCTX][k] : F.in[I_C][(v - 1) * 1024 + k]; sc[idx] = x / (1.0f + __expf(-x)); }
        __syncthreads();
        float acc[9];
#pragma unroll
        for (int v = 0; v < 9; ++v) acc[v] = 0.f;
        const float* wp = F.in[I_WADA] + ((size_t)l * 1024 + F.wave * 128) * 6144 + nb * 64 + F.lane;
#pragma unroll 8
        for (int k = 0; k < 128; ++k) { const float w = wp[(size_t)k * 6144];
#pragma unroll
            for (int v = 0; v < 9; ++v) acc[v] += sc[v * 1024 + F.wave * 128 + k] * w; }
#pragma unroll
        for (int v = 0; v < 9; ++v) red[(F.wave * 9 + v) * 64 + F.lane] = acc[v];
        __syncthreads();
        float* mod = (float*)(F.ws + WS_MOD);
        for (int idx = F.tid; idx < 576; idx += 512) { const int v = idx >> 6, ln = idx & 63; float s = 0.f;
#pragma unroll
            for (int w = 0; w < 8; ++w) s += red[(w * 9 + v) * 64 + ln];
            mod[(l * 9 + v) * 6144 + nb * 64 + ln] = s + F.in[I_BADA][l * 6144 + nb * 64 + ln]; }
        __syncthreads();
    }
    LAS float* scr = (LAS float*)(F.lds + F.wave * 8448);
    constexpr int N_WIN = 16 * 192, N_AO = 16 * 32, N_SO = 8 * 32, N_WO = 16 * 32, N_F1 = 16 * 176, N_F2 = 44 * 32, N_PE = 1024, N_WS = 128;
    constexpr int N_L = N_WIN + N_AO + N_SO + N_WO + N_F1 + N_F2 + N_PE + N_WS;
    constexpr int N_ALL = 2 * N_L + 32;
    for (int it = F.gw; it < N_ALL; it += F.NGW) {
        if (it >= 2 * N_L) {
            const int idx = (it - 2 * N_L) * 64 + F.lane; const int pos = idx >> 5, p = idx & 31;
            const float inv = powf(10000.0f, -(float)p / 32.0f); const float ang = (float)pos * inv;
            float* rope = (float*)(F.ws + WS_ROPE); rope[idx] = cosf(ang); rope[2048 + idx] = sinf(ang);
            continue;
        }
        const int l = it / N_L; int r = it % N_L;
        if (r < N_WIN) { const int kb = r / 192, nb = r % 192;
            tr_item(F.in[I_WIN] + (size_t)l * 1024 * 6144, 6144, win_src_col(nb * 32), kb, (bf16_t*)(F.ws + WS_WIN) + (size_t)l * 6144 * 1024, 1024, nb * 32, 0, scr, F.lane); continue; } r -= N_WIN;
        if (r < N_AO) { const int kb = r / 32, nb = r % 32;
            tr_item(F.in[I_WAO] + (size_t)l * 1024 * 1024, 1024, nb * 32, kb, (bf16_t*)(F.ws + WS_WM) + (size_t)l * 1024 * 2048, 2048, nb * 32, 0, scr, F.lane); continue; } r -= N_AO;
        if (r < N_SO) { const int kb = r / 32, nb = r % 32;
            tr_item(F.in[I_WSO] + (size_t)l * 512 * 1024, 1024, nb * 32, kb, (bf16_t*)(F.ws + WS_WM) + (size_t)l * 1024 * 2048, 2048, nb * 32, 1024, scr, F.lane); continue; } r -= N_SO;
        if (r < N_WO) { const int kb = r / 32, nb = r % 32;
            tr_item(F.in[I_WOUT] + (size_t)l * 1024 * 1024, 1024, nb * 32, kb, (bf16_t*)(F.ws + WS_WOUT) + (size_t)l * 1024 * 1024, 1024, nb * 32, 0, scr, F.lane); continue; } r -= N_WO;
        if (r < N_F1) { const int kb = r / 176, nb = r % 176; const int drow = nb * 32; const int pn = drow >> 8, j = drow & 255;
            const int src = j < 128 ? pn * 128 + j : DFF + pn * 128 + (j - 128);
            tr_item(F.in[I_WF1] + (size_t)l * 1024 * 5632, 5632, src, kb, (bf16_t*)(F.ws + WS_WF1) + (size_t)l * 5632 * 1024, 1024, drow, 0, scr, F.lane); continue; } r -= N_F1;
        if (r < N_F2) { const int kb = r / 32, nb = r % 32;
            tr_item(F.in[I_WF2] + (size_t)l * DFF * 1024, 1024, nb * 32, kb, (bf16_t*)(F.ws + WS_WF2) + (size_t)l * 1024 * DFF, DFF, nb * 32, 0, scr, F.lane); continue; } r -= N_F2;
        if (r < N_PE) {
            const int kg = r >> 4, nb = r & 15; const int k0 = kg * 8, g = k0 >> 7; const int n = nb * 64 + F.lane;
            const float* wpg = F.in[I_WPG] + ((size_t)(l * 4 + g) * 128 + (k0 & 127)) * 128;
            const float* psc = F.in[I_PSC] + l * 512 + g * 128;
            const float* wpo = F.in[I_WPO] + ((size_t)l * 512 + g * 128) * 1024 + n;
            float a[8];
#pragma unroll
            for (int i = 0; i < 8; ++i) a[i] = 0.f;
#pragma unroll 4
            for (int j = 0; j < 128; ++j) { const float w = wpo[(size_t)j * 1024] * psc[j];
#pragma unroll
                for (int i = 0; i < 8; ++i) a[i] += wpg[i * 128 + j] * w; }
            u32x4 o; o.x = cvt_pk_bf16(a[0], a[1]); o.y = cvt_pk_bf16(a[2], a[3]); o.z = cvt_pk_bf16(a[4], a[5]); o.w = cvt_pk_bf16(a[6], a[7]);
            *(u32x4*)((bf16_t*)(F.ws + WS_WM) + (size_t)l * 1024 * 2048 + (size_t)n * 2048 + 1536 + k0) = o;
            continue; } r -= N_PE;
        {
            const size_t e0 = (size_t)l * 65536 + (size_t)r * 512 + F.lane * 8;
            const f32x4 a = *(const f32x4*)(F.in[I_WSGU] + e0), b = *(const f32x4*)(F.in[I_WSGU] + e0 + 4);
            u32x4 o; o.x = cvt_pk_bf16(a[0], a[1]); o.y = cvt_pk_bf16(a[2], a[3]); o.z = cvt_pk_bf16(b[0], b[1]); o.w = cvt_pk_bf16(b[2], b[3]);
            *(u32x4*)((bf16_t*)(F.ws + WS_WSGU) + e0) = o;
        }
    }
}

__device__ __forceinline__ const float* x0_row(Frame& F, int t) { return t < T_CTX ? F.in[I_XP] + (size_t)t * DM : F.in[I_XS] + (size_t)(t - T_CTX) * DM; }
__device__ __forceinline__ int vec_of_row(int t) { return t < T_CTX ? 0 : 1 + ((t - T_CTX) >> 12); }

__device__ __forceinline__ void phase_h0(Frame& F) {
    const float* mod = (const float*)(F.ws + WS_MOD);
    bf16_t* act = (bf16_t*)(F.ws + WS_ACT);
    for (int t = F.gw; t < T_ALL; t += F.NGW) {
        const f32x4* xr = (const f32x4*)x0_row(F, t) + F.lane;
        const float* mv = mod + vec_of_row(t) * 6144;
        unsigned long long* o8 = (unsigned long long*)(act + (size_t)t * DM) + F.lane;
#pragma unroll
        for (int j = 0; j < 4; ++j) { const f32x4 x = xr[64 * j]; const int c = 256 * j + 4 * F.lane;
            const f32x4 sh = *(const f32x4*)(mv + c), sc = *(const f32x4*)(mv + 1024 + c);
            const f32x4 h = x * (sc + 1.0f) + sh;
            o8[64 * j] = (unsigned long long)cvt_pk_bf16(h[0], h[1]) | ((unsigned long long)cvt_pk_bf16(h[2], h[3]) << 32); }
    }
}

__device__ __forceinline__ void phase_ln(Frame& F, const float* lg, const float* lb, const float* modl  , int sh_off, int sc_off, const bool dry = false) {
    float* X = F.out; bf16_t* act = (bf16_t*)(F.ws + WS_ACT);
    for (int t = F.gw; t < T_ALL; t += F.NGW) {
        f32x4* xr = (f32x4*)(X + (size_t)t * DM) + F.lane;
        f32x4 v[4]; float s = 0.f;
#pragma unroll
        for (int j = 0; j < 4; ++j) { v[j] = xr[64 * j]; s += (v[j][0] + v[j][1]) + (v[j][2] + v[j][3]); }
        const float mean = wave_sum(s) * (1.f / DM); float s2 = 0.f;
#pragma unroll
        for (int j = 0; j < 4; ++j) { v[j] = v[j] - mean; s2 += (v[j][0] * v[j][0] + v[j][1] * v[j][1]) + (v[j][2] * v[j][2] + v[j][3] * v[j][3]); }
        const float rstd = rsqrtf(wave_sum(s2) * (1.f / DM) + LN_EPS);
        const float* mv = modl ? modl + vec_of_row(t) * 6144 : nullptr;
        unsigned long long* o8 = (unsigned long long*)(act + (size_t)t * DM) + F.lane;
#pragma unroll
        for (int j = 0; j < 4; ++j) { const int c = 256 * j + 4 * F.lane;
            const f32x4 g = *(const f32x4*)(lg + c), b = *(const f32x4*)(lb + c);
            const f32x4 y = v[j] * rstd * g + b; if (!dry) xr[64 * j] = y; else { asm volatile("" :: "v"(y)); continue; }
            if (mv) { const f32x4 sh = *(const f32x4*)(mv + sh_off + c), sc = *(const f32x4*)(mv + sc_off + c);
                const f32x4 h = y * (sc + 1.0f) + sh;
                o8[64 * j] = (unsigned long long)cvt_pk_bf16(h[0], h[1]) | ((unsigned long long)cvt_pk_bf16(h[2], h[3]) << 32); } }
    }
}

__device__ __forceinline__ void load16h(const bf16_t* p, int j, float (&x)[16]) {
#pragma unroll
    for (int a = 0; a < 2; ++a)
#pragma unroll
        for (int hf = 0; hf < 2; ++hf) { const u32x2 w = *(const u32x2*)(p + a * 64 + hf * 32 + 4 * j);
            x[(a * 2 + hf) * 4 + 0] = bf_lo(w.x); x[(a * 2 + hf) * 4 + 1] = bf_hi(w.x); x[(a * 2 + hf) * 4 + 2] = bf_lo(w.y); x[(a * 2 + hf) * 4 + 3] = bf_hi(w.y); }
}
__device__ __forceinline__ void rmsn(float (&x)[16], const float (&g)[16]) {
    float ss = 0.f;
#pragma unroll
    for (int i = 0; i < 16; ++i) ss += x[i] * x[i];
    ss += __shfl_xor(ss, 1); ss += __shfl_xor(ss, 2); ss += __shfl_xor(ss, 4);
    const float rinv = rsqrtf(ss * (1.0f / 128.0f) + LN_EPS);
#pragma unroll
    for (int i = 0; i < 16; ++i) x[i] = x[i] * rinv * g[i];
}
__device__ __forceinline__ void rope16(float (&x)[16], const float* rope, int rowpos, int colpos, int j) {
#pragma unroll
    for (int a = 0; a < 2; ++a) { const int pos = a == 0 ? rowpos : colpos;
        const f32x4 c = *(const f32x4*)(rope + pos * 32 + 4 * j), s = *(const f32x4*)(rope + 2048 + pos * 32 + 4 * j);
#pragma unroll
        for (int e = 0; e < 4; ++e) { const float x1 = x[(a * 2) * 4 + e], x2 = x[(a * 2 + 1) * 4 + e];
            x[(a * 2) * 4 + e] = x1 * c[e] - x2 * s[e]; x[(a * 2 + 1) * 4 + e] = x2 * c[e] + x1 * s[e]; } }
}
__device__ __forceinline__ void store16h(bf16_t* p, int j, const float (&x)[16]) {
#pragma unroll
    for (int a = 0; a < 2; ++a)
#pragma unroll
        for (int hf = 0; hf < 2; ++hf) { u32x2 w; w.x = cvt_pk_bf16(x[(a * 2 + hf) * 4 + 0], x[(a * 2 + hf) * 4 + 1]); w.y = cvt_pk_bf16(x[(a * 2 + hf) * 4 + 2], x[(a * 2 + hf) * 4 + 3]);
            *(u32x2*)(p + a * 64 + hf * 32 + 4 * j) = w; }
}

__device__ __forceinline__ void phase_mid(Frame& F, int l, int part, const bool dry = false) {
    bf16_t* proj = (bf16_t*)(F.ws + WS_PROJ);
    const float* rope = (const float*)(F.ws + WS_ROPE);
    bf16_t* vrt = (bf16_t*)(F.ws + WS_VRT);
    bf16_t* KL = (bf16_t*)(F.ws + WS_KL); bf16_t* VL = (bf16_t*)(F.ws + WS_VL); bf16_t* KC = (bf16_t*)(F.ws + WS_KC); bf16_t* VC = (bf16_t*)(F.ws + WS_VC);
    float* outk = F.out + (size_t)T_ALL * DM; float* outv = outk + (size_t)16 * 2 * 256 * 256;
    const int lane = F.lane, hj = lane & 7;
    const int n8 = part_rows(part) / 4, ncache = 4 * PAST;
    float qg[16], kg[16];
#pragma unroll
    for (int a = 0; a < 2; ++a)
#pragma unroll
        for (int hf = 0; hf < 2; ++hf)
#pragma unroll
            for (int e = 0; e < 4; ++e) { const int d = a * 64 + hf * 32 + 4 * hj + e; qg[(a * 2 + hf) * 4 + e] = F.in[I_QG][l * 128 + d]; kg[(a * 2 + hf) * 4 + e] = F.in[I_KG][l * 128 + d]; }
    for (int it = F.gw; it < n8 + ncache; it += F.NGW) {
        if (it >= n8) {
            const int cr = it - n8; const int bl = cr >> 9, s = cr & 511; const int b = part * 4 + bl;
            const size_t src = (((size_t)b * 2 + l) * PAST + s) * 256 + lane * 4;
            const f32x4 kx = *(const f32x4*)(F.in[I_CK] + src), vx = *(const f32x4*)(F.in[I_CV] + src);
            const size_t dst = ((size_t)bl * SKV_LAT + s) * 256 + lane * 4;
            u32x2 kw, vw; kw.x = cvt_pk_bf16(kx[0], kx[1]); kw.y = cvt_pk_bf16(kx[2], kx[3]); vw.x = cvt_pk_bf16(vx[0], vx[1]); vw.y = cvt_pk_bf16(vx[2], vx[3]);
            if (!dry) { *(u32x2*)(KL + dst) = kw; *(u32x2*)(VL + dst) = vw; } else asm volatile("" :: "v"(kw), "v"(vw));
            continue;
        }
        const int lr0 = it * 4, t0 = part_row0(part) + lr0;
        const bool is_ctx = t0 < T_CTX;
        bf16_t* P0 = proj + (size_t)lr0 * NPROJ;
        {
            float val[4][8];
#pragma unroll
            for (int i = 0; i < 4; ++i) { const u32x4 w = *(const u32x4*)(P0 + (size_t)i * NPROJ + PC_XV + lane * 8);
#pragma unroll
                for (int e = 0; e < 4; ++e) { val[i][2 * e] = gelu1(bf_lo(w[e])); val[i][2 * e + 1] = gelu1(bf_hi(w[e])); } }
#pragma unroll
            for (int i = 0; i < 4; ++i) { float s = 0.f;
#pragma unroll
                for (int e = 0; e < 8; ++e) s += val[i][e];
                const float mean = wave_sum(s) * (1.0f / 512.0f); float s2 = 0.f;
#pragma unroll
                for (int e = 0; e < 8; ++e) { val[i][e] -= mean; s2 += val[i][e] * val[i][e]; }
                const float rstd = rsqrtf(wave_sum(s2) * (1.0f / 512.0f) + LN_EPS);
#pragma unroll
                for (int e = 0; e < 8; ++e) val[i][e] *= rstd; }
            const int chunk = lr0 >> 7, q0 = lr0 & 127;
            bf16_t* vb = vrt + ((size_t)chunk * 512 + lane * 8) * 128 + q0;
#pragma unroll
            for (int e = 0; e < 8; ++e) { u32x2 o; o.x = cvt_pk_bf16(val[0][e], val[1][e]); o.y = cvt_pk_bf16(val[2][e], val[3][e]);
                if (!dry) *(u32x2*)(vb + (size_t)e * 128) = o; else asm volatile("" :: "v"(o)); }
        }
#pragma unroll 1
        for (int i = 0; i < 4; ++i) {
            bf16_t* Pr = P0 + (size_t)i * NPROJ; const int t = t0 + i;
            int spos, seqS, rowpos = 0, colpos = 0, bl = 0;
            if (is_ctx) { spos = t & 255; seqS = CTX_S; } else { const int tl = t - T_CTX; spos = tl & 4095; seqS = LAT_S; rowpos = spos >> 6; colpos = spos & 63; bl = (tl >> 12) - part * 4; }
            float x[16];
            const int kh = (lane >> 3) & 1;
            load16h(Pr + PC_K + kh * 128, hj, x); rmsn(x, kg);
            const int vi = (lane - 16) & 31;
            const u32x4 vw = *(const u32x4*)(Pr + PC_V + vi * 8);
            float pacc[8], pself[8];
            {
                const int hw = 1 << (lane >> 4);
                const int lo = max(spos - hw, 0), hi = min(spos + hw, seqS);
#pragma unroll
                for (int e = 0; e < 8; ++e) pacc[e] = 0.f;
                u32x4 pw[16];
#pragma unroll
                for (int k = 0; k < 16; ++k) { const int dd = k - 8, sp = spos + dd; const bool ok = (sp >= lo) && (sp < hi);
                    pw[k] = *(const u32x4*)(Pr + (long)(ok ? dd : 0) * NPROJ + PC_XP + lane * 8); }
#pragma unroll
                for (int k = 0; k < 16; ++k) { const int sp = spos + k - 8; const float mk = ((sp >= lo) && (sp < hi)) ? 1.0f : 0.0f;
#pragma unroll
                    for (int e = 0; e < 4; ++e) { pacc[2 * e] += mk * bf_lo(pw[k][e]); pacc[2 * e + 1] += mk * bf_hi(pw[k][e]); } }
#pragma unroll
                for (int e = 0; e < 4; ++e) { pself[2 * e] = bf_lo(pw[8][e]); pself[2 * e + 1] = bf_hi(pw[8][e]); }
                const float rc = 1.0f / (float)(hi - lo);
#pragma unroll
                for (int e = 0; e < 8; ++e) pacc[e] = pacc[e] * rc - pself[e];
            }
            asm volatile("s_waitcnt vmcnt(0)" ::: "memory");
            if (dry) { asm volatile("" :: "v"(x[0]), "v"(x[7]), "v"(vw), "v"(pacc[0]), "v"(pacc[7])); continue; }
            if (is_ctx) {
                if (lane < 16) {
                    float* ok = outk + (((size_t)(t >> 8) * 2 + l) * 256 + (t & 255)) * 256 + kh * 128;
#pragma unroll
                    for (int a = 0; a < 2; ++a)
#pragma unroll
                        for (int hf = 0; hf < 2; ++hf) *(f32x4*)(ok + a * 64 + hf * 32 + 4 * hj) = (f32x4){x[(a * 2 + hf) * 4], x[(a * 2 + hf) * 4 + 1], x[(a * 2 + hf) * 4 + 2], x[(a * 2 + hf) * 4 + 3]};
                    store16h(KC + (size_t)t * 256 + kh * 128, hj, x);
                }
                if (lane >= 16 && lane < 48) {
                    float* ov = outv + (((size_t)(t >> 8) * 2 + l) * 256 + (t & 255)) * 256 + vi * 8;
                    *(f32x4*)ov = (f32x4){bf_lo(vw[0]), bf_hi(vw[0]), bf_lo(vw[1]), bf_hi(vw[1])};
                    *(f32x4*)(ov + 4) = (f32x4){bf_lo(vw[2]), bf_hi(vw[2]), bf_lo(vw[3]), bf_hi(vw[3])};
                    *(u32x4*)(VC + (size_t)t * 256 + vi * 8) = vw;
                }
            } else {
                rope16(x, rope, rowpos, colpos, hj);
                const size_t krow = ((size_t)bl * SKV_LAT + PAST + spos) * 256;
                if (lane < 16) store16h(KL + krow + kh * 128, hj, x);
                if (lane >= 16 && lane < 48) *(u32x4*)(VL + krow + vi * 8) = vw;
            }
            { u32x4 o; o.x = cvt_pk_bf16(pacc[0], pacc[1]); o.y = cvt_pk_bf16(pacc[2], pacc[3]); o.z = cvt_pk_bf16(pacc[4], pacc[5]); o.w = cvt_pk_bf16(pacc[6], pacc[7]);
              *(u32x4*)(Pr + PC_K + lane * 8) = o; }
        }
    }
}

__device__ __forceinline__ void phase_attn(Frame& F, int l, int part, const bool sgu_only_dry = false) {
    bf16_t* proj = (bf16_t*)(F.ws + WS_PROJ);
    const bf16_t* KL = (const bf16_t*)(F.ws + WS_KL); const bf16_t* VL = (const bf16_t*)(F.ws + WS_VL); const bf16_t* KC = (const bf16_t*)(F.ws + WS_KC); const bf16_t* VC = (const bf16_t*)(F.ws + WS_VC);
    const int lat_row0 = part == 0 ? T_CTX : 0;
    if (!sgu_only_dry) {
        int pair, idx, step; int rep = 0;
        const bool xcdmap = (F.G % 8) == 0;
        if (xcdmap) { pair = F.bx & 7; idx = F.bx >> 3; step = F.G >> 3; } else { pair = 0; idx = F.bx; step = F.G; }
        for (;;) {
            int pr = pair, ix = idx;
            if (!xcdmap) { pr = idx >> 6; ix = idx & 63; if (idx >= 512) break; } else if (idx >= 64) break;
            const int bl = pr >> 1, kvh = pr & 1, h = kvh * 4 + (ix >> 4), qb = ix & 15;
            bf16_t* Qb = proj + (size_t)(lat_row0 + bl * LAT_S + qb * 256) * NPROJ + PC_Q + h * 128;
            att::attn_dense_body(Qb, KL + (size_t)bl * SKV_LAT * 256 + kvh * 128, VL + (size_t)bl * SKV_LAT * 256 + kvh * 128, SKV_LAT, F.ldsg, F.tid, F.in[I_QG] + l * 128, (const float*)(F.ws + WS_ROPE), qb * 256, PROBE == 3 ? rep == 1 : true);
            if (PROBE == 3) { if (rep == 0) { rep = 1; continue; } rep = 0; }
            idx += step;
        }
    }
    if (part == 0 && !sgu_only_dry) {
        for (int u = F.bx; u < 128; u += F.G) { const int b = u >> 3, h = u & 7;
            bf16_t* Qb = proj + (size_t)(b * 256) * NPROJ + PC_Q + h * 128;
            att::attn_dense_body(Qb, KC + (size_t)b * 256 * 256 + (h >> 2) * 128, VC + (size_t)b * 256 * 256 + (h >> 2) * 128, CTX_S, F.ldsg, F.tid, F.in[I_QG] + l * 128, (const float*)nullptr, 0); }
    }
    const bf16_t* vrt = (const bf16_t*)(F.ws + WS_VRT);
    const bf16_t* wsb = (const bf16_t*)(F.ws + WS_WSGU) + (size_t)l * 65536;
    const float* bs = F.in[I_BSGU] + l * 512;
    const int nitem = (part_rows(part) / 128) * 32;
    const int ln = F.lane & 15, quad = F.lane >> 4;
    for (int it = F.NGW - 1 - F.gw; it < nitem; it += F.NGW) {
        const int chunk = it >> 5, g = (it >> 3) & 3, cb = (it >> 1) & 3, pb = it & 1;
        f32x4 acc[2][4];
#pragma unroll
        for (int a = 0; a < 2; ++a)
#pragma unroll
            for (int b = 0; b < 4; ++b) acc[a][b] = (f32x4){0.f, 0.f, 0.f, 0.f};
        const bf16_t* ap = vrt + ((size_t)chunk * 512 + g * 128 + cb * 32 + ln) * 128 + quad * 8;
        const bf16_t* bp = wsb + ((size_t)g * 128 + pb * 64 + ln) * 128 + quad * 8;
        u32x2 xw[4][2];
#pragma unroll
        for (int pt = 0; pt < 4; ++pt)
#pragma unroll
            for (int ct = 0; ct < 2; ++ct) xw[pt][ct] = *(const u32x2*)(proj + (size_t)(chunk * 128 + pb * 64 + pt * 16 + ln) * NPROJ + PC_U + g * 128 + cb * 32 + ct * 16 + quad * 4);
#pragma unroll
        for (int ks = 0; ks < 4; ++ks) {
            bf16x8 af[2], bfr[4];
#pragma unroll
            for (int ct = 0; ct < 2; ++ct) af[ct] = *(const bf16x8*)(ap + ct * 16 * 128 + ks * 32);
#pragma unroll
            for (int pt = 0; pt < 4; ++pt) bfr[pt] = *(const bf16x8*)(bp + pt * 16 * 128 + ks * 32);
#pragma unroll
            for (int ct = 0; ct < 2; ++ct)
#pragma unroll
                for (int pt = 0; pt < 4; ++pt) acc[ct][pt] = __builtin_amdgcn_mfma_f32_16x16x32_bf16(af[ct], bfr[pt], acc[ct][pt], 0, 0, 0);
        }
#pragma unroll
        for (int pt = 0; pt < 4; ++pt) { const int p = pb * 64 + pt * 16 + ln; const float bsv = bs[g * 128 + p];
#pragma unroll
            for (int ct = 0; ct < 2; ++ct) { const int c = g * 128 + cb * 32 + ct * 16 + quad * 4;
                bf16_t* up = proj + (size_t)(chunk * 128 + p) * NPROJ + PC_U + c;
                const u32x2 w = xw[pt][ct];
                const float u0 = gelu1(bf_lo(w.x)), u1 = gelu1(bf_hi(w.x)), u2 = gelu1(bf_lo(w.y)), u3 = gelu1(bf_hi(w.y));
                const f32x4 a = acc[ct][pt];
                u32x2 o; o.x = cvt_pk_bf16(u0 * (a[0] + bsv), u1 * (a[1] + bsv)); o.y = cvt_pk_bf16(u2 * (a[2] + bsv), u3 * (a[3] + bsv));
                if (!sgu_only_dry) *(u32x2*)up = o; else asm volatile("" :: "v"(o)); } }
    }
}

constexpr int NPL = 11, NPHASE = 2 + DEPTH * NPL;
__global__ void __launch_bounds__(NW * 64, 2) fwd_kernel(Args args) {
    extern __shared__ __attribute__((aligned(16))) unsigned char lds[];
    Frame F;
    F.lds = (LAS unsigned char*)lds; F.ldsg = (char*)lds;
    F.G = gridDim.x; F.bx = blockIdx.x; F.NGW = F.G * NW;
    F.in = args.in; F.ws = args.ws; F.out = args.out;
    const float* mod = (const float*)(F.ws + WS_MOD);
    bf16_t* act = (bf16_t*)(F.ws + WS_ACT); bf16_t* proj = (bf16_t*)(F.ws + WS_PROJ);
    volatile LAS unsigned* bst = (volatile LAS unsigned*)(F.lds + 131072 + 64);
    unsigned* barw = (unsigned*)(F.ws + WS_BAR);
    const int wave0 = __builtin_amdgcn_readfirstlane((int)threadIdx.x >> 6);
    { unsigned z0 = 0u; asm volatile("" : "+v"(z0)); int t0 = wave0 * 64 + (int)__builtin_amdgcn_mbcnt_hi(~0u, __builtin_amdgcn_mbcnt_lo(~0u, z0));
      if (t0 < 2) bst[t0] = 0u;
      if (blockIdx.x == 0 && args.ph_lo == 0) { for (int i = t0; i < XCD_BAR_WORDS; i += NW * 64) barw[i] = 0u;
        unsigned* cw = (unsigned*)(F.ws + WS_CNT); for (int i = t0; i < CNT_WORDS; i += NW * 64) cw[i] = 0u; } }
    __syncthreads();
    XcdBarrier xbar; xbar.bar = barw; xbar.x = 0; xbar.st = bst;
    for (int ph = args.ph_lo; ph < args.ph_hi; ++ph) {
        { unsigned zz = 0u; asm volatile("" : "+v"(zz)); const int lanev = (int)__builtin_amdgcn_mbcnt_hi(~0u, __builtin_amdgcn_mbcnt_lo(~0u, zz));
          F.lane = lanev; F.wave = wave0; F.tid = wave0 * 64 + lanev; F.gw = F.bx * NW + F.wave; }

#ifndef PHMASK
#define PHMASK 0xffff
#endif
        if (ph == 0) { if (PHMASK & 1) phase_prologue(F); if (PROBE == 4) { __syncthreads(); phase_prologue(F); } }
        else if (ph == 1) { if (PHMASK & 2) phase_h0(F); if (PROBE == 4) phase_h0(F); }
        else {
            const int l = (ph - 2) / NPL, s = (ph - 2) % NPL;
            if (s < 8) {
                const int part = s >> 2, q = s & 3;
                if (q == 0) { if (PHMASK & 4) {
                    pg8::Gemm g{}; g.A = act + (size_t)part_row0(part) * DM; g.Bt = (const bf16_t*)(F.ws + WS_WIN) + (size_t)l * NPROJ * DM; g.lda = DM; g.ldb = DM;
                    g.nM = part_rows(part) / 256; g.nN = NPROJ / 256; g.nseg = 1; g.k0[0] = 0; g.nt[0] = 16; g.k0[1] = 0; g.nt[1] = 16; g.k0[2] = 0; g.nt[2] = 16;
                    pg8::Order S; S.init(g.nM, g.nN, 1, F.G, F.bx, 0, STAGGER);
                    pg8::EpiStore E{proj, NPROJ, PC_G};
                    if (PROBE == 2) { pg8::EpiNone E0; pg8::gemm_phase<pg8::EpiNone>(F.lds, g, S, E0, F.tid); }
                    if (PROBE == 7) pg8::gemm_phase<pg8::EpiStore>(F.lds, g, S, E, F.tid);
                    pg8::gemm_phase<pg8::EpiStore>(F.lds, g, S, E, F.tid); }
                } else if (q == 1) { if (PROBE == 5) phase_mid(F, l, part, true); if (PHMASK & 8) phase_mid(F, l, part, false); }
                else if (q == 2) { if (PROBE == 6) phase_attn(F, l, part, true); if (PHMASK & 16) phase_attn(F, l, part, false); }
                else if (PHMASK & 32) {
                    pg8::Gemm g{}; g.A = proj; g.Bt = (const bf16_t*)(F.ws + WS_WM) + (size_t)l * DM * 2048; g.lda = NPROJ; g.ldb = 2048;
                    g.nM = part_rows(part) / 256; g.nN = 4; g.nseg = 3; g.k0[0] = 0; g.nt[0] = 16; g.k0[1] = 1024; g.nt[1] = 8; g.k0[2] = 1536; g.nt[2] = 8;
                    pg8::Order S; S.init(g.nM, g.nN, 3, F.G, F.bx);
                    pg8::EpiGate E{F.lds + LDS_XCH, proj, act + (size_t)part_row0(part) * DM, DM};
                    if (PROBE == 2) { pg8::EpiNone E0; pg8::gemm_phase<pg8::EpiNone>(F.lds, g, S, E0, F.tid); }
                    pg8::gemm_phase<pg8::EpiGate>(F.lds, g, S, E, F.tid);
                }
            } else if (s == 8) { if (PHMASK & 64) {
                pg8::Gemm g{}; g.A = act; g.Bt = (const bf16_t*)(F.ws + WS_WOUT) + (size_t)l * DM * DM; g.lda = DM; g.ldb = DM;
                g.nM = T_ALL / 256; g.nN = 4; g.nseg = 1; g.k0[0] = 0; g.nt[0] = 16; g.k0[1] = 0; g.nt[1] = 16; g.k0[2] = 0; g.nt[2] = 16;
                pg8::Order S; S.init(g.nM, g.nN, 1, F.G, F.bx, 1);
                if (l == 0) { pg8::EpiResidLn<0, true, false> E{F.in, F.ws, F.out, l, F.lds + LDS_XCH}; pg8::gemm_phase<pg8::EpiResidLn<0, true, false>>(F.lds, g, S, E, F.tid); }
                else { pg8::EpiResidLn<0, false, false> E{F.in, F.ws, F.out, l, F.lds + LDS_XCH}; pg8::gemm_phase<pg8::EpiResidLn<0, false, false>>(F.lds, g, S, E, F.tid); } }
            } else if (s == 9) { if (PHMASK & 256) {
                pg8::Gemm g{}; g.A = act; g.Bt = (const bf16_t*)(F.ws + WS_WF1) + (size_t)l * 2 * DFF * DM; g.lda = DM; g.ldb = DM;
                g.nM = T_ALL / 256; g.nN = 2 * DFF / 256; g.nseg = 1; g.k0[0] = 0; g.nt[0] = 16; g.k0[1] = 0; g.nt[1] = 16; g.k0[2] = 0; g.nt[2] = 16;
                pg8::Order S; S.init(g.nM, g.nN, 1, F.G, F.bx, 0, STAGGER);
                pg8::EpiSwiGLU E{proj, DFF};
                if (PROBE == 2) { pg8::EpiNone E0; pg8::gemm_phase<pg8::EpiNone>(F.lds, g, S, E0, F.tid); }
                if (PROBE == 7) pg8::gemm_phase<pg8::EpiSwiGLU>(F.lds, g, S, E, F.tid);
                pg8::gemm_phase<pg8::EpiSwiGLU>(F.lds, g, S, E, F.tid); }
            } else { if (PHMASK & 512) {
                pg8::Gemm g{}; g.A = proj; g.Bt = (const bf16_t*)(F.ws + WS_WF2) + (size_t)l * DM * DFF; g.lda = DFF; g.ldb = DFF;
                g.nM = T_ALL / 256; g.nN = 4; g.nseg = 1; g.k0[0] = 0; g.nt[0] = 44; g.k0[1] = 0; g.nt[1] = 44; g.k0[2] = 0; g.nt[2] = 44;
                pg8::Order S; S.init(g.nM, g.nN, 1, F.G, F.bx, 1);
                if (l + 1 < DEPTH) { pg8::EpiResidLn<1, false, false> E{F.in, F.ws, F.out, l, F.lds + LDS_XCH}; pg8::gemm_phase<pg8::EpiResidLn<1, false, false>>(F.lds, g, S, E, F.tid); }
                else { pg8::EpiResidLn<1, false, true> E{F.in, F.ws, F.out, l, F.lds + LDS_XCH}; pg8::gemm_phase<pg8::EpiResidLn<1, false, true>>(F.lds, g, S, E, F.tid); } }
            }
        }
        if (ph + 1 < args.ph_hi) {
            if (ph == args.ph_lo) { cg::this_grid().sync(); xbar = xcd_barrier_post(barw, bst); }
            else xcd_barrier(xbar);
            if (PROBE == 1 && ph == 1) { for (int k = 0; k < 20; ++k) xcd_barrier(xbar); }
        }
    }
}

extern "C" void kernel_launch(void* const* d_in, const int* in_sizes, int n_in, void* d_out, int out_size, void* d_ws, size_t ws_size, hipStream_t stream) {
    static int grid = 0;
    if (grid == 0) {
        if (n_in != 25 || ws_size < WS_END) { fprintf(stderr, "kernel_launch: unexpected n_in %d / ws %zu\n", n_in, ws_size); grid = -1; return; }
        int dev = 0, cus = 0, per_cu = 0;
        if (hipGetDevice(&dev) != hipSuccess || hipDeviceGetAttribute(&cus, hipDeviceAttributeMultiprocessorCount, dev) != hipSuccess) { grid = -1; return; }
        if (hipFuncSetAttribute((const void*)fwd_kernel, hipFuncAttributeMaxDynamicSharedMemorySize, LDS_BYTES) != hipSuccess) { fprintf(stderr, "kernel_launch: hipFuncSetAttribute failed\n"); grid = -1; return; }
        if (hipOccupancyMaxActiveBlocksPerMultiprocessor(&per_cu, (const void*)fwd_kernel, NW * 64, LDS_BYTES) != hipSuccess || per_cu < 1) per_cu = 1;
        (void)hipGetLastError();
        grid = cus * (per_cu > 1 ? 1 : per_cu);
    }
    if (grid < 0) return;
    Args a{};
    for (int i = 0; i < 25; ++i) a.in[i] = (const float*)d_in[i];
    a.out = (float*)d_out; a.ws = (unsigned char*)d_ws;
#if MK_MULTI
    for (int ph = 0; ph < NPHASE; ++ph) { a.ph_lo = ph; a.ph_hi = ph + 1; hipLaunchKernelGGL(fwd_kernel, dim3(grid), dim3(NW * 64), LDS_BYTES, stream, a); }
#else
    a.ph_lo = 0; a.ph_hi = NPHASE;
    void* kargs[] = {&a};
    hipError_t e = hipLaunchCooperativeKernel((const void*)fwd_kernel, dim3(grid), dim3(NW * 64), kargs, LDS_BYTES, stream);
    if (e != hipSuccess) fprintf(stderr, "cooperative launch failed: %s (grid %d)\n", hipGetErrorString(e), grid);
#endif
}
```

```cpp
#include <hip/hip_runtime.h>
#include <hip/hip_bf16.h>
#include <hip/hip_cooperative_groups.h>
#include <cstdio>
#include <cstdint>
namespace cg = cooperative_groups;

#ifndef PROBE
#define PROBE 0
#endif
#ifndef STAGGER
#define STAGGER 0
#endif
#ifndef GATE_PF
#define GATE_PF false
#endif
#ifndef MK_MULTI
#define MK_MULTI 0
#endif

#define LAS __attribute__((address_space(3)))
typedef unsigned short bf16_t;
typedef short bf16x8 __attribute__((ext_vector_type(8)));
typedef short s16x4 __attribute__((ext_vector_type(4)));
typedef float f32x2 __attribute__((ext_vector_type(2)));
typedef float f32x4 __attribute__((ext_vector_type(4)));
typedef float f32x16 __attribute__((ext_vector_type(16)));
typedef unsigned u32x2 __attribute__((ext_vector_type(2)));
typedef unsigned u32x4 __attribute__((ext_vector_type(4)));

constexpr int DM = 1024, NPROJ = 6144, DFF = 2816, DEPTH = 2;
constexpr int T_CTX = 4096, T_ALL = 36864;
constexpr int CTX_S = 256, LAT_S = 4096, PAST = 512, SKV_LAT = 4608;
constexpr int PC_Q = 0, PC_U = 1024, PC_K = 1536, PC_V = 1792, PC_XV = 2048, PC_XP = 2560, PC_G = 3072;
constexpr float LN_EPS = 1e-6f;
constexpr float ALPHA = 1.41421356237309515f;
constexpr int NW = 8;
__host__ __device__ constexpr int part_row0(int p) { return p == 0 ? 0 : 20480; }
__host__ __device__ constexpr int part_rows(int p) { return p == 0 ? 20480 : 16384; }

constexpr size_t MiB = 1u << 20;
constexpr size_t WS_MOD = 0;
constexpr size_t WS_BAR = 448 * 1024;
constexpr size_t WS_ROPE = 512 * 1024;
constexpr size_t WS_WSGU = 768 * 1024;
constexpr size_t WS_WIN = 1 * MiB;
constexpr size_t WS_WM = 25 * MiB;
constexpr size_t WS_WOUT = 33 * MiB;
constexpr size_t WS_WF1 = 37 * MiB;
constexpr size_t WS_WF2 = 59 * MiB;
constexpr size_t WS_ACT = 70 * MiB;
constexpr size_t WS_PROJ = 142 * MiB;
constexpr size_t WS_KL = 382 * MiB, WS_VL = 391 * MiB;
constexpr size_t WS_KC = 400 * MiB, WS_VC = 402 * MiB;
constexpr size_t WS_VRT = 404 * MiB;
constexpr size_t WS_XBUF = 424 * MiB;
constexpr size_t WS_CNT = 426 * MiB;
constexpr int CNT_WORDS = 4 * 144 * 64;
constexpr size_t WS_XB = 427 * MiB;
constexpr size_t WS_END = 499 * MiB;

constexpr int LDS_BYTES = 143360;
constexpr int LDS_XCH = 131072 + 256;

__device__ __forceinline__ unsigned cvt_pk_bf16(float lo, float hi) { unsigned r; asm volatile("v_cvt_pk_bf16_f32 %0, %1, %2" : "=v"(r) : "v"(lo), "v"(hi)); return r; }
__device__ __forceinline__ float bf_lo(unsigned u) { return __uint_as_float(u << 16); }
__device__ __forceinline__ float bf_hi(unsigned u) { return __uint_as_float(u & 0xffff0000u); }
__device__ __forceinline__ float wave_sum(float v) {
#pragma unroll
    for (int o = 1; o < 64; o <<= 1) v += __shfl_xor(v, o);
    return v;
}
__device__ __forceinline__ float gelu1(float v) {
    const float av = fabsf(v), d = av * 0.2316418882f + 1.0f;
    const float t = __builtin_amdgcn_rcpf(d);
    float q = t * 0.5307027145f + (-0.7265760135f); q = q * t + 0.7107068705f; q = q * t + (-0.142248368f); q = q * t + 0.127414796f; q = q * t;
    const float e = __builtin_amdgcn_exp2f((v * v) * (-0.72134752044f));
    const float m = v * (q * e), r = v - m;
    return v < 0.f ? m : r;
}
__device__ __forceinline__ float sigmoidf_(float x) { return __builtin_amdgcn_rcpf(1.0f + __expf(-x)); }

namespace pg8 {
constexpr int BM = 256, BK = 64, HALF = 128, HTB = HALF * BK * 2, STAGE_BYTES = 8 * HTB, NXCD = 8, WGM = 8;
__host__ __device__ __forceinline__ int lds_byte(int r, int c) { const int st = (r >> 4) * 2 + (c >> 5), rr = r & 15, cc = c & 31, ob = rr * 64 + cc * 2; return st * 1024 + (ob ^ (((ob >> 9) & 1) << 5)); }
__host__ __device__ __forceinline__ void stage_rc(int b, int& R, int& C) { const int st = b / 1024, sb = b % 1024, swz = sb ^ (((sb >> 9) & 1) << 5); R = (st >> 1) * 16 + swz / 64; C = (st & 1) * 32 + (swz % 64) / 2; }
__host__ __device__ __forceinline__ int perm32(int rho) { const int n = rho >> 4, i = rho & 15; return 8 * (i >> 2) + 4 * n + (i & 3); }

struct Unit { int pm, pn, seg; };
struct Gemm { const bf16_t* A; const bf16_t* Bt; int lda, ldb, nM, nN, nseg; int k0[3]; int nt[3]; };

struct Order {
    int nM, nN, nwg, G, c, nseg, team, stagger;
    __device__ void init(int nM_, int nN_, int nseg_, int G_, int c_, int team_ = 0, int stagger_ = 0) { nM = nM_; nN = nN_; nwg = nM * nN; G = G_; c = c_; nseg = nseg_; team = team_; stagger = stagger_; }
    __device__ bool next(int i, Unit& u) const {
        if (team) {
            u.seg = 0; const int j = c >> 3; u.pn = j & 3; u.pm = i * (G >> 2) + (j >> 2) * 8 + (c & 7); return u.pm < nM;
        }
        const int ti = i / nseg; u.seg = i - ti * nseg;
        const long L = (long)ti * G + c; if (L >= nwg) return false;
        int wgid = (int)L; { const int q = nwg / NXCD, r = nwg % NXCD, xcd = wgid % NXCD, off = wgid / NXCD; wgid = (xcd < r ? xcd * (q + 1) : r * (q + 1) + (xcd - r) * q) + off; }
        const int nig = WGM * nN, gid = wgid / nig, fm = gid * WGM, gsz = (nM - fm) < WGM ? (nM - fm) : WGM;
        u.pm = fm + ((wgid % nig) % gsz); u.pn = (wgid % nig) / gsz; return true;
    }
};

struct EpiStore {
    static constexpr bool PREFETCH = false;
    static constexpr bool PERM = true;
    bf16_t* O; int ldc; int gate_col0;
    __device__ __forceinline__ void run(f32x4 (&acc)[2][2][4][2], const Unit& u, int wr, int wc, int fr, int fq) const {
        const int row0 = u.pm * BM + wr * 64 + fr; const int col0 = u.pn * BM + wc * 32 + 8 * fq;
        const bool gate = u.pn * BM >= gate_col0;
#pragma unroll
        for (int ai = 0; ai < 2; ++ai)
#pragma unroll
            for (int m = 0; m < 4; ++m) { bf16_t* rowp = O + (size_t)(row0 + ai * HALF + m * 16) * ldc + col0;
#pragma unroll
                for (int bj = 0; bj < 2; ++bj) { f32x4 v0 = acc[ai][bj][m][0], v1 = acc[ai][bj][m][1];
                    if (gate) {
#pragma unroll
                        for (int e = 0; e < 4; ++e) { v0[e] = 1.0f + __expf(-fmaxf(v0[e], -80.f)); v1[e] = 1.0f + __expf(-fmaxf(v1[e], -80.f)); } }
                    u32x4 w; w.x = cvt_pk_bf16(v0[0], v0[1]); w.y = cvt_pk_bf16(v0[2], v0[3]); w.z = cvt_pk_bf16(v1[0], v1[1]); w.w = cvt_pk_bf16(v1[2], v1[3]);
                    *(u32x4*)(rowp + bj * HALF) = w; } }
    }
};
struct EpiSwiGLU {
    static constexpr bool PREFETCH = false;
    static constexpr bool PERM = true;
    bf16_t* O; int ldc;
    __device__ __forceinline__ void run(f32x4 (&acc)[2][2][4][2], const Unit& u, int wr, int wc, int fr, int fq) const {
        const int row0 = u.pm * BM + wr * 64 + fr; const int col0 = u.pn * HALF + wc * 32 + 8 * fq;
#pragma unroll
        for (int ai = 0; ai < 2; ++ai)
#pragma unroll
            for (int m = 0; m < 4; ++m) { bf16_t* rowp = O + (size_t)(row0 + ai * HALF + m * 16) * ldc + col0;
                float o[8];
#pragma unroll
                for (int n = 0; n < 2; ++n)
#pragma unroll
                    for (int e = 0; e < 4; ++e) { const float a = acc[ai][0][m][n][e], b = acc[ai][1][m][n][e]; o[n * 4 + e] = a * sigmoidf_(a) * b; }
                u32x4 w; w.x = cvt_pk_bf16(o[0], o[1]); w.y = cvt_pk_bf16(o[2], o[3]); w.z = cvt_pk_bf16(o[4], o[5]); w.w = cvt_pk_bf16(o[6], o[7]);
                *(u32x4*)rowp = w; }
    }
};
struct EpiResid {
    static constexpr bool PREFETCH = false;
    static constexpr bool PERM = false;
    const float* xres_ctx; const float* xres_lat;
    float* out; const float* mod; int goff;
    __device__ __forceinline__ void run(f32x4 (&acc)[2][2][4][2], const Unit& u, int wr, int wc, int fr, int fq) const {
        const int v = u.pm < 16 ? 0 : 1 + ((u.pm - 16) >> 4);
        const float* xb = u.pm < 16 ? xres_ctx + (size_t)u.pm * BM * DM : xres_lat + (size_t)(u.pm - 16) * BM * DM;
        float* ob = out + (size_t)u.pm * BM * DM;
        const int col0 = u.pn * BM + wc * 32 + 4 * fq;
        const float* gp = mod + v * 6144 + goff + col0;
        f32x4 gv[2][2];
#pragma unroll
        for (int bj = 0; bj < 2; ++bj)
#pragma unroll
            for (int n = 0; n < 2; ++n) gv[bj][n] = *(const f32x4*)(gp + bj * HALF + n * 16);
#pragma unroll
        for (int ai = 0; ai < 2; ++ai)
#pragma unroll
            for (int m = 0; m < 4; ++m) { const size_t off = (size_t)(ai * HALF + wr * 64 + m * 16 + fr) * DM + col0;
#pragma unroll
                for (int bj = 0; bj < 2; ++bj)
#pragma unroll
                    for (int n = 0; n < 2; ++n) { const f32x4 x = *(const f32x4*)(xb + off + bj * HALF + n * 16);
                        *(f32x4*)(ob + off + bj * HALF + n * 16) = x * ALPHA + gv[bj][n] * acc[ai][bj][m][n]; } }
    }
};

struct PanelStats {
    unsigned long long* xbuf;
    unsigned* cnt;
    LAS unsigned char* lx;
    __device__ __forceinline__ void run(const f32x4 (&v)[2][2][4][2], const Unit& u, int wr, int wc, int fr, int fq, int wid, int lane) const {
        LAS f32x2* P = (LAS f32x2*)lx; LAS f32x2* S = (LAS f32x2*)(lx + 8192);
#pragma unroll
        for (int ai = 0; ai < 2; ++ai)
#pragma unroll
            for (int m = 0; m < 4; ++m) {
                float s = 0.f;
#pragma unroll
                for (int bj = 0; bj < 2; ++bj)
#pragma unroll
                    for (int n = 0; n < 2; ++n) { const f32x4 x = v[ai][bj][m][n]; s += (x[0] + x[1]) + (x[2] + x[3]); }
                s += __shfl_xor(s, 16); s += __shfl_xor(s, 32);
                const float mw = s * (1.0f / 64.0f); float q = 0.f;
#pragma unroll
                for (int bj = 0; bj < 2; ++bj)
#pragma unroll
                    for (int n = 0; n < 2; ++n) { const f32x4 d = v[ai][bj][m][n] - mw; q += (d[0] * d[0] + d[1] * d[1]) + (d[2] * d[2] + d[3] * d[3]); }
                q += __shfl_xor(q, 16); q += __shfl_xor(q, 32);
                if (fq == 0) P[(ai * HALF + wr * 64 + m * 16 + fr) * 4 + wc] = (f32x2){mw, q};
            }
        asm volatile("s_waitcnt lgkmcnt(0)" ::: "memory"); __builtin_amdgcn_s_barrier(); asm volatile("" ::: "memory");
        const int row = wid * 32 + (lane & 31);
        if (lane < 32) {
            const f32x2 a = P[row * 4 + 0], b = P[row * 4 + 1], c = P[row * 4 + 2], d = P[row * 4 + 3];
            const float mt = (a.x + b.x + c.x + d.x) * 0.25f;
            const float da = a.x - mt, db = b.x - mt, dc = c.x - mt, dd = d.x - mt;
            const float m2 = (a.y + b.y) + (c.y + d.y) + 64.0f * ((da * da + db * db) + (dc * dc + dd * dd));
            unsigned long long* slot = xbuf + ((size_t)(u.pm * BM + row) * 4 + u.pn);
            __hip_atomic_store(slot, ((unsigned long long)__float_as_uint(m2) << 32) | __float_as_uint(mt), __ATOMIC_RELAXED, __HIP_MEMORY_SCOPE_AGENT);
        }
        asm volatile("s_waitcnt vmcnt(0)" ::: "memory");
        if (lane == 0) __hip_atomic_fetch_add(cnt + 64 * u.pm, 1u, __ATOMIC_RELAXED, __HIP_MEMORY_SCOPE_AGENT);
        if (wid == 0) {
            unsigned sp = 0;
            for (;;) {
                if ((unsigned)__builtin_amdgcn_readfirstlane(__hip_atomic_load(cnt + 64 * u.pm, __ATOMIC_RELAXED, __HIP_MEMORY_SCOPE_AGENT)) >= 32u) break;
                if (++sp > (1u << 22)) break;
                __builtin_amdgcn_s_sleep(2);
            }
            __builtin_amdgcn_fence(__ATOMIC_ACQUIRE, "agent");
        }
        asm volatile("s_waitcnt vmcnt(0) lgkmcnt(0)" ::: "memory"); __builtin_amdgcn_s_barrier(); asm volatile("" ::: "memory");
        if (lane < 32) {
            const unsigned long long* slot = xbuf + (size_t)(u.pm * BM + row) * 4; float mt[4], m2[4]; float ms = 0.f;
#pragma unroll
            for (int t = 0; t < 4; ++t) { const unsigned long long w = __hip_atomic_load(slot + t, __ATOMIC_RELAXED, __HIP_MEMORY_SCOPE_AGENT); mt[t] = __uint_as_float((unsigned)w); m2[t] = __uint_as_float((unsigned)(w >> 32)); ms += mt[t]; }
            const float mean = ms * 0.25f; float q = 0.f;
#pragma unroll
            for (int t = 0; t < 4; ++t) { const float dm = mt[t] - mean; q += m2[t] + 256.0f * dm * dm; }
            S[row] = (f32x2){mean, rsqrtf(q * (1.0f / 1024.0f) + LN_EPS)};
        }
        asm volatile("s_waitcnt lgkmcnt(0)" ::: "memory"); __builtin_amdgcn_s_barrier(); asm volatile("" ::: "memory");
    }
};
template <int WHICH, bool INF32, bool OUTF32>
struct EpiResidLn {
    static constexpr bool PERM = false;
    static constexpr bool PREFETCH = false;
    const float* const* in; unsigned char* ws; float* out_; int l; LAS unsigned char* lx;
    __device__ __forceinline__ void prefetch(const Unit& u, int it, int nit, int wid, int lane_) const {
        int lane = lane_; asm volatile("" : "+v"(lane));
        const float* xb = (WHICH == 0 && l == 0) ? (u.pm < 16 ? in[0] + (size_t)u.pm * BM * DM : in[1] + (size_t)(u.pm - 16) * BM * DM) : out_ + (size_t)u.pm * BM * DM;
        const int R = nit >= 16 ? 2 : 4;
#pragma unroll
        for (int k = 0; k < 4; ++k) { const int j = it * R + k;
            if (k < R && j < 32) __builtin_amdgcn_global_load_lds((const unsigned*)(xb + (size_t)(j * 8 + wid) * DM + u.pn * BM + lane * 4), (LAS unsigned*)(lx + 10240), 16, 0, 0); }
    }
    __device__ __forceinline__ void run(f32x4 (&acc)[2][2][4][2], const Unit& u, int wr, int wc, int fr_, int fq_) const {
        int fr = fr_, fq = fq_; asm volatile("" : "+v"(fr), "+v"(fq));
        int lv = l; asm volatile("" : "+v"(lv)); lv = __builtin_amdgcn_readfirstlane(lv);
        const float* mod = (const float*)(ws + 0) + lv * 9 * 6144;
        float* out = out_;
        const float* xres_ctx = (WHICH == 0 && lv == 0) ? in[0] : out;
        const float* xres_lat = (WHICH == 0 && lv == 0) ? in[1] : out + (size_t)T_CTX * DM;
        const int goff = WHICH == 0 ? 2048 : 5120;
        const float* lg = in[WHICH == 0 ? 19 : 23] + lv * DM; const float* lb = in[WHICH == 0 ? 20 : 24] + lv * DM;
        bf16_t* act = (bf16_t*)(ws + (size_t)70 * 1048576);
        const float* modn = WHICH == 0 ? mod : (const float*)(ws + 0) + (lv + 1 < DEPTH ? lv + 1 : lv) * 9 * 6144;
        const int sh_off = WHICH == 0 ? 3072 : 0, sc_off = WHICH == 0 ? 4096 : 1024;
        PanelStats st{(unsigned long long*)(ws + (size_t)424 * 1048576), (unsigned*)(ws + (size_t)426 * 1048576) + (lv * 2 + WHICH) * 144 * 64, lx};
        const int v = u.pm < 16 ? 0 : 1 + ((u.pm - 16) >> 4);
        const float* xb = u.pm < 16 ? xres_ctx + (size_t)u.pm * BM * DM : xres_lat + (size_t)(u.pm - 16) * BM * DM;
        float* ob = out + (size_t)u.pm * BM * DM;
        bf16_t* xs = (bf16_t*)(ws + (size_t)427 * 1048576);
        const int col0 = u.pn * BM + wc * 32 + 4 * fq;
        const size_t roff = (size_t)(wr * 64 + fr) * DM + col0;
        {
            const float* gp = mod + v * 6144 + goff + col0;
            if constexpr (INF32) {
#pragma unroll
                for (int bj = 0; bj < 2; ++bj)
#pragma unroll
                    for (int n = 0; n < 2; ++n) { const f32x4 gv = *(const f32x4*)(gp + bj * HALF + n * 16);
#pragma unroll
                        for (int ai = 0; ai < 2; ++ai) {
#pragma unroll
                            for (int m = 0; m < 4; ++m) { const size_t o_ = roff + (size_t)(ai * HALF + m * 16) * DM + bj * HALF + n * 16;
                                const f32x4 x = *(const f32x4*)(xb + o_); acc[ai][bj][m][n] = x * ALPHA + gv * acc[ai][bj][m][n]; }
#pragma unroll
                            for (int m = 0; m < 4; ++m) asm volatile("" : "+v"(acc[ai][bj][m][n]));
                            asm volatile("" ::: "memory"); } }
            } else {
                u32x2 xw[2][2][2][4];
                const bf16_t* xp_ = xs + (size_t)u.pm * BM * DM + roff;
#pragma unroll
                for (int bj = 0; bj < 2; ++bj)
#pragma unroll
                    for (int n = 0; n < 2; ++n)
#pragma unroll
                        for (int ai = 0; ai < 2; ++ai)
#pragma unroll
                            for (int m = 0; m < 4; ++m) xw[bj][n][ai][m] = *(const u32x2*)(xp_ + (size_t)(ai * HALF + m * 16) * DM + bj * HALF + n * 16);
#pragma unroll
                for (int bj = 0; bj < 2; ++bj)
#pragma unroll
                    for (int n = 0; n < 2; ++n) { const f32x4 gv = *(const f32x4*)(gp + bj * HALF + n * 16);
#pragma unroll
                        for (int ai = 0; ai < 2; ++ai)
#pragma unroll
                            for (int m = 0; m < 4; ++m) { const u32x2 w = xw[bj][n][ai][m]; const f32x4 x = (f32x4){bf_lo(w.x), bf_hi(w.x), bf_lo(w.y), bf_hi(w.y)};
                                acc[ai][bj][m][n] = x * ALPHA + gv * acc[ai][bj][m][n]; } }
            }
        }
        const int lane = fq * 16 + fr, wid = wr * 4 + wc;
        st.run(acc, u, wr, wc, fr, fq, wid, lane);
        const LAS f32x2* S = (const LAS f32x2*)(st.lx + 8192);
        const float* mv = modn + v * 6144;
#pragma unroll
        for (int bj = 0; bj < 2; ++bj)
#pragma unroll
            for (int n = 0; n < 2; ++n) { const int c = col0 + bj * HALF + n * 16;
                const f32x4 g4 = *(const f32x4*)(lg + c), b4 = *(const f32x4*)(lb + c);
                f32x4 sh = (f32x4){0.f, 0.f, 0.f, 0.f}, sc = sh;
                sh = *(const f32x4*)(mv + sh_off + c); sc = *(const f32x4*)(mv + sc_off + c) + 1.0f;
#pragma unroll
                for (int ai = 0; ai < 2; ++ai)
#pragma unroll
                    for (int m = 0; m < 4; ++m) { const size_t off = roff + (size_t)(ai * HALF + m * 16) * DM + bj * HALF + n * 16;
                        const f32x2 sr = S[ai * HALF + wr * 64 + m * 16 + fr];
                        const f32x4 y = (acc[ai][bj][m][n] - sr.x) * sr.y * g4 + b4;
                        if (OUTF32) *(f32x4*)(ob + off) = y;
                        else { u32x2 w; w.x = cvt_pk_bf16(y[0], y[1]); w.y = cvt_pk_bf16(y[2], y[3]); *(u32x2*)(xs + (size_t)u.pm * BM * DM + off) = w; }
                        if (WHICH == 0 || lv + 1 < DEPTH) { const f32x4 h = y * sc + sh; u32x2 w; w.x = cvt_pk_bf16(h[0], h[1]); w.y = cvt_pk_bf16(h[2], h[3]);
                            *(u32x2*)(act + (size_t)u.pm * BM * DM + off) = w; } }
                asm volatile("" ::: "memory"); }
    }
};
struct EpiGate {
    static constexpr bool PERM = true;
    static constexpr bool PREFETCH = GATE_PF;
    LAS unsigned char* lx;
    __device__ __forceinline__ void prefetch(const Unit& u, int it, int nit, int wid, int lane_) const {
        if (u.seg == 2) return;
        int lane = lane_; asm volatile("" : "+v"(lane));
        const bf16_t* gb = P + (size_t)u.pm * BM * NPROJ + PC_G + u.pn * BM + (lane & 31) * 8;
#pragma unroll
        for (int k = 0; k < 4; ++k) { const int j = it * 4 + k;
            const int tile = u.seg == 0 ? (j >> 4) : 0; const int goff = u.seg == 0 ? (tile == 0 ? 0 : 2048) : 1024; const int jr = j & 15;
            if (j < (u.seg == 0 ? 32 : 16)) __builtin_amdgcn_global_load_lds((const unsigned*)(gb + (size_t)(jr * 16 + wid * 2 + (lane >> 5)) * NPROJ + goff), (LAS unsigned*)(lx + 10240), 16, 0, 0); }
    }
    const bf16_t* P;
    bf16_t* O; int ldc;
    __device__ __forceinline__ void run(f32x4 (&acc)[2][2][4][2], const Unit& u, int wr, int wc, int fr_, int fq_) const {
        int fr = fr_, fq = fq_; asm volatile("" : "+v"(fr), "+v"(fq));
        const int row0 = u.pm * BM + wr * 64 + fr; const int col0 = u.pn * BM + wc * 32 + 8 * fq;
        const bf16_t* gbase = P + (size_t)row0 * NPROJ + PC_G + col0;
        const bool last = u.seg == 2;
        const int noff = u.seg == 0 ? 0 : (u.seg == 1 ? 2048 : 1024), doff = u.seg == 0 ? 2048 : 1024;
#pragma unroll
        for (int am = 0; am < 4; ++am) { const int ai = am >> 1, mb = (am & 1) * 2;
            u32x4 gn[2][2], gd[2][2];
#pragma unroll
            for (int mm = 0; mm < 2; ++mm)
#pragma unroll
                for (int bj = 0; bj < 2; ++bj) { const bf16_t* gp = gbase + (size_t)(ai * HALF + (mb + mm) * 16) * NPROJ + bj * HALF;
                    gn[mm][bj] = *(const u32x4*)(gp + noff); gd[mm][bj] = *(const u32x4*)(gp + doff); }
#pragma unroll
            for (int mm = 0; mm < 2; ++mm)
#pragma unroll
                for (int bj = 0; bj < 2; ++bj) { const int m = mb + mm; f32x4 v0 = acc[ai][bj][m][0], v1 = acc[ai][bj][m][1];
#pragma unroll
                    for (int e = 0; e < 2; ++e) {
                        v0[2 * e]     *= (last ? 1.0f : bf_lo(gd[mm][bj][e])) * __builtin_amdgcn_rcpf(bf_lo(gn[mm][bj][e]));
                        v0[2 * e + 1] *= (last ? 1.0f : bf_hi(gd[mm][bj][e])) * __builtin_amdgcn_rcpf(bf_hi(gn[mm][bj][e]));
                        v1[2 * e]     *= (last ? 1.0f : bf_lo(gd[mm][bj][2 + e])) * __builtin_amdgcn_rcpf(bf_lo(gn[mm][bj][2 + e]));
                        v1[2 * e + 1] *= (last ? 1.0f : bf_hi(gd[mm][bj][2 + e])) * __builtin_amdgcn_rcpf(bf_hi(gn[mm][bj][2 + e])); }
                    acc[ai][bj][m][0] = v0; acc[ai][bj][m][1] = v1;
                    if (last) { u32x4 w; w.x = cvt_pk_bf16(v0[0], v0[1]); w.y = cvt_pk_bf16(v0[2], v0[3]); w.z = cvt_pk_bf16(v1[0], v1[1]); w.w = cvt_pk_bf16(v1[2], v1[3]);
                        *(u32x4*)(O + (size_t)(row0 + ai * HALF + m * 16) * ldc + col0 + bj * HALF) = w; } }
            asm volatile("" ::: "memory");
        }
    }
};

struct EpiNone { static constexpr bool PREFETCH = false; static constexpr bool PERM = true; __device__ __forceinline__ void run(f32x4 (&acc)[2][2][4][2], const Unit& u, int wr, int wc, int fr, int fq) const {
    _Pragma("unroll") for (int a = 0; a < 2; ++a) _Pragma("unroll") for (int b = 0; b < 2; ++b) _Pragma("unroll") for (int m = 0; m < 4; ++m) _Pragma("unroll") for (int n = 0; n < 2; ++n) asm volatile("" :: "v"(acc[a][b][m][n])); } };
template <class Epi>
__device__ __forceinline__ void gemm_phase(LAS unsigned char* lds, const Gemm g, const Order& S, const Epi& E, const int tid) {
    const int wid = __builtin_amdgcn_readfirstlane(tid >> 6), lane = tid & 63, wr = wid >> 2, wc = wid & 3, fr = lane & 15, fq = lane >> 4;
    unsigned voffA[2], voffB[2];
#pragma unroll
    for (int i = 0; i < 2; ++i) { int R, C; stage_rc(tid * 16 + i * 8192, R, C); const int Rb = Epi::PERM ? ((R & ~31) + perm32(R & 31)) : R;
        voffA[i] = (unsigned)(R * g.lda + C) * 2u; voffB[i] = (unsigned)(Rb * g.ldb + C) * 2u; }
    const size_t kstep = (size_t)(BK * 2);
    const size_t hstepA = (size_t)HALF * g.lda * 2, hstepB = (size_t)HALF * g.ldb * 2;
    const size_t tstepA = 2 * hstepA, tstepB = 2 * hstepB;
    const unsigned ldsw = (unsigned)wid * 1024u;
    const int aoff = lds_byte(wr * 64 + fr, fq * 8), boff = lds_byte(wc * 32 + fr, fq * 8);
#define PG8_SA(b, h) (((b) * 2 + (h)) * HTB)
#define PG8_SB(b, h) ((4 + (b) * 2 + (h)) * HTB)
#define PG8_STAGE(bufoff, gbase, voff) do { _Pragma("unroll") for (int _i = 0; _i < 2; ++_i) \
        __builtin_amdgcn_global_load_lds((const unsigned*)((const char*)(gbase) + (voff)[_i]), (LAS unsigned*)(lds + (bufoff) + ldsw + _i * 8192), 16, 0, 0); } while (0)
#define PG8_LDA(dst, b, h) do { _Pragma("unroll") for (int m = 0; m < 4; ++m) _Pragma("unroll") for (int k = 0; k < 2; ++k) dst[m][k] = *(const LAS bf16x8*)(lds + PG8_SA(b, h) + aoff + m * 2048 + k * 1024); } while (0)
#define PG8_LDB(dst, b, h) do { _Pragma("unroll") for (int n = 0; n < 2; ++n) _Pragma("unroll") for (int k = 0; k < 2; ++k) dst[n][k] = *(const LAS bf16x8*)(lds + PG8_SB(b, h) + boff + n * 2048 + k * 1024); } while (0)
#define PG8_MMA(ai, bj, At, Bt) do { __builtin_amdgcn_s_setprio(1); _Pragma("unroll") for (int m = 0; m < 4; ++m) _Pragma("unroll") for (int n = 0; n < 2; ++n) _Pragma("unroll") for (int k = 0; k < 2; ++k) \
        acc[ai][bj][m][n] = __builtin_amdgcn_mfma_f32_16x16x32_bf16(Bt[n][k], At[m][k], acc[ai][bj][m][n], 0, 0, 0); __builtin_amdgcn_s_setprio(0); } while (0)
#define PG8_WAIT_V(n) asm volatile("s_waitcnt vmcnt(" #n ")" ::: "memory")
#define PG8_WAIT_L(n) asm volatile("s_waitcnt lgkmcnt(" #n ")" ::: "memory")
#define PG8_BAR __builtin_amdgcn_s_barrier()
#define PG8_SCHED __builtin_amdgcn_sched_barrier(0)
#define KOF(sg) ((sg) == 0 ? g.k0[0] : ((sg) == 1 ? g.k0[1] : g.k0[2]))
#define NTF(sg) ((sg) == 0 ? g.nt[0] : ((sg) == 1 ? g.nt[1] : g.nt[2]))
    Unit cur, nxt; int ui = 0;
    if (!S.next(0, cur)) return;
    if (S.stagger) {
        const int mine = (S.nwg - S.c + S.G - 1) / S.G, mx = (S.nwg + S.G - 1) / S.G;
        if (mine < mx) { const unsigned long long t0 = __builtin_amdgcn_s_memrealtime(); while (__builtin_amdgcn_s_memrealtime() - t0 < (unsigned long long)S.stagger) __builtin_amdgcn_s_sleep(16); }
    }
    f32x4 acc[2][2][4][2];
#pragma unroll
    for (int a = 0; a < 2; ++a)
#pragma unroll
        for (int b = 0; b < 2; ++b)
#pragma unroll
            for (int m = 0; m < 4; ++m)
#pragma unroll
                for (int n = 0; n < 2; ++n) acc[a][b][m][n] = (f32x4){0.f, 0.f, 0.f, 0.f};
    bf16x8 At[4][2], B0[2][2], B1[2][2];
    const char* cA = (const char*)g.A + (size_t)cur.pm * tstepA + (size_t)KOF(cur.seg) * 2; const char* cB = (const char*)g.Bt + (size_t)cur.pn * tstepB + (size_t)KOF(cur.seg) * 2;
    PG8_STAGE(PG8_SB(0, 0), cB, voffB); PG8_STAGE(PG8_SB(0, 1), cB + hstepB, voffB); PG8_STAGE(PG8_SA(0, 0), cA, voffA); PG8_STAGE(PG8_SA(0, 1), cA + hstepA, voffA);
    if (wr == 1) PG8_BAR;
    PG8_WAIT_V(2); PG8_BAR;
    PG8_STAGE(PG8_SB(1, 0), cB + kstep, voffB); PG8_STAGE(PG8_SA(1, 0), cA + kstep, voffA); PG8_STAGE(PG8_SB(1, 1), cB + hstepB + kstep, voffB);
    PG8_WAIT_V(6); PG8_BAR;
    for (;;) {
        const bool has_next = S.next(ui + 1, nxt);
        const int nt = NTF(cur.seg);
        const char* nA = has_next ? (const char*)g.A + (size_t)nxt.pm * tstepA + (size_t)KOF(nxt.seg) * 2 : cA;
        const char* nB = has_next ? (const char*)g.Bt + (size_t)nxt.pn * tstepB + (size_t)KOF(nxt.seg) * 2 : cB;
        for (int t = 0; t < nt; t += 2) {
            const bool last = (t == nt - 2);
            const char* a1 = cA + (size_t)(t + 1) * kstep;
            const char* a2 = last ? nA : cA + (size_t)(t + 2) * kstep; const char* b2 = last ? nB : cB + (size_t)(t + 2) * kstep;
            const char* a3 = a2 + kstep; const char* b3 = b2 + kstep;
            PG8_LDB(B0, 0, 0); PG8_LDB(B1, 0, 1); PG8_SCHED; PG8_LDA(At, 0, 0); PG8_STAGE(PG8_SA(1, 1), a1 + hstepA, voffA);
            if constexpr (Epi::PREFETCH) E.prefetch(cur, t >> 1, nt >> 1, wid, lane);
            PG8_WAIT_V(8); PG8_WAIT_L(0); PG8_BAR; PG8_MMA(0, 0, At, B0); PG8_MMA(0, 1, At, B1); PG8_BAR; PG8_SCHED;
            PG8_LDA(At, 0, 1); PG8_STAGE(PG8_SB(0, 0), b2, voffB); PG8_STAGE(PG8_SB(0, 1), b2 + hstepB, voffB); PG8_STAGE(PG8_SA(0, 0), a2, voffA);
            PG8_WAIT_V(8); PG8_WAIT_L(0); PG8_BAR; PG8_MMA(1, 0, At, B0); PG8_MMA(1, 1, At, B1); PG8_BAR; PG8_SCHED;
            PG8_LDB(B0, 1, 0); PG8_LDB(B1, 1, 1); PG8_SCHED; PG8_LDA(At, 1, 0); PG8_STAGE(PG8_SA(0, 1), a2 + hstepA, voffA);
            PG8_WAIT_V(8); PG8_WAIT_L(0); PG8_BAR; PG8_MMA(0, 0, At, B0); PG8_MMA(0, 1, At, B1); PG8_BAR; PG8_SCHED;
            PG8_LDA(At, 1, 1); PG8_STAGE(PG8_SB(1, 0), b3, voffB); PG8_STAGE(PG8_SB(1, 1), b3 + hstepB, voffB); PG8_STAGE(PG8_SA(1, 0), a3, voffA);
            PG8_WAIT_V(8); PG8_WAIT_L(0); PG8_BAR; PG8_MMA(1, 0, At, B0); PG8_MMA(1, 1, At, B1); PG8_BAR; PG8_SCHED;
        }
        if (wr == 0) PG8_BAR;
        E.run(acc, cur, wr, wc, fr, fq);
        if (!has_next) break;
        if (cur.seg == g.nseg - 1) {
#pragma unroll
            for (int a = 0; a < 2; ++a)
#pragma unroll
                for (int b = 0; b < 2; ++b)
#pragma unroll
                    for (int m = 0; m < 4; ++m)
#pragma unroll
                        for (int n = 0; n < 2; ++n) acc[a][b][m][n] = (f32x4){0.f, 0.f, 0.f, 0.f};
        }
        cur = nxt; cA = nA; cB = nB; ++ui;
        if (wr == 1) PG8_BAR;
    }
    PG8_WAIT_V(0);
    PG8_BAR;
#undef KOF
#undef NTF
#undef PG8_SA
#undef PG8_SB
#undef PG8_STAGE
#undef PG8_LDA
#undef PG8_LDB
#undef PG8_MMA
#undef PG8_WAIT_V
#undef PG8_WAIT_L
#undef PG8_BAR
#undef PG8_SCHED
}
}

namespace att {
constexpr int D = 128, QBLK = 32, KVBLK = 64;
constexpr float SCALE = 0.088388347648318440f;
constexpr float THR = 8.f;
constexpr size_t SHM_V = KVBLK * D * 2, SHM_K = KVBLK * D * 2, SHM_ATTN = 2 * SHM_V + 2 * SHM_K + NW * 64 * 4;
#define KSWZ(row, colB) ((row) * 256 + ((colB) ^ (((row) & 7) << 4)))
#define SBAR() __builtin_amdgcn_sched_barrier(0)
__device__ __forceinline__ int crow(int r, int hi) { return (r & 3) + 8 * (r >> 2) + 4 * hi; }
__device__ __forceinline__ unsigned cvtpk(float lo, float hi) { unsigned r; asm volatile("v_cvt_pk_bf16_f32 %0, %1, %2" : "=v"(r) : "v"(lo), "v"(hi)); return r; }
__device__ __forceinline__ void partialSM(f32x16& p0, f32x16& p1, float& m_reg, float& mn, float& alpha) {
  constexpr float C = SCALE * 1.4426950408889634f;
  float pmax = p0[0];
#pragma unroll
  for (int r = 1; r < 16; ++r) pmax = fmaxf(pmax, p0[r]);
#pragma unroll
  for (int r = 0; r < 16; ++r) pmax = fmaxf(pmax, p1[r]);
  { auto rr = __builtin_amdgcn_permlane32_swap(__float_as_uint(pmax), __float_as_uint(pmax), false, false);
    pmax = fmaxf(__uint_as_float(rr[0]), __uint_as_float(rr[1])); }
  if (__builtin_expect(__all(pmax - m_reg <= THR / SCALE), 1)) { mn = m_reg; alpha = 1.f; }
  else { mn = fmaxf(m_reg, pmax); alpha = __builtin_amdgcn_exp2f((m_reg - mn) * C); m_reg = mn; }
  float mnC = -mn * C;
#pragma unroll
  for (int r = 0; r < 16; ++r) p0[r] = fmaf(p0[r], C, mnC);
#pragma unroll
  for (int r = 0; r < 16; ++r) p1[r] = fmaf(p1[r], C, mnC);
#pragma unroll
  for (int r = 0; r < 16; ++r) p0[r] = __builtin_amdgcn_exp2f(p0[r]);
}
__device__ __forceinline__ void finishSM(f32x16& p0, f32x16& p1, float alpha, float& l_reg, bf16x8& pa0, bf16x8& pa1, bf16x8& pa2, bf16x8& pa3) {
#pragma unroll
  for (int r = 0; r < 16; ++r) p1[r] = __builtin_amdgcn_exp2f(p1[r]);
  float ps = 0;
#pragma unroll
  for (int r = 0; r < 16; ++r) ps += p0[r];
#pragma unroll
  for (int r = 0; r < 16; ++r) ps += p1[r];
  { auto rr = __builtin_amdgcn_permlane32_swap(__float_as_uint(ps), __float_as_uint(ps), false, false);
    ps = __uint_as_float(rr[0]) + __uint_as_float(rr[1]); }
  l_reg = l_reg * alpha + ps;
#define PK4(P, BASE, OUT) do { unsigned a0 = cvtpk(P[BASE + 0], P[BASE + 1]), a1 = cvtpk(P[BASE + 2], P[BASE + 3]);   \
    unsigned b0 = cvtpk(P[BASE + 4], P[BASE + 5]), b1 = cvtpk(P[BASE + 6], P[BASE + 7]);                              \
    auto r0 = __builtin_amdgcn_permlane32_swap(a0, b0, false, false); auto r1 = __builtin_amdgcn_permlane32_swap(a1, b1, false, false); \
    u32x4 w = {r0[0], r1[0], r0[1], r1[1]}; OUT = *reinterpret_cast<bf16x8*>(&w); } while (0)
  PK4(p0, 0, pa0); PK4(p0, 8, pa1); PK4(p1, 0, pa2); PK4(p1, 8, pa3);
#undef PK4
}
__device__ __forceinline__ void qkt(f32x16& p0, f32x16& p1, const bf16_t* Ks, const bf16x8* qr, int r32, int hi) {
  p0 = f32x16{}; p1 = f32x16{};
#pragma unroll
  for (int d0 = 0; d0 < 8; ++d0) { int cb = (d0 * 16 + hi * 8) * 2;
    bf16x8 b0 = *reinterpret_cast<const bf16x8*>((const char*)Ks + KSWZ(r32, cb));
    bf16x8 b1 = *reinterpret_cast<const bf16x8*>((const char*)Ks + KSWZ(32 + r32, cb));
    p0 = __builtin_amdgcn_mfma_f32_32x32x16_bf16(b0, qr[d0], p0, 0, 0, 0);
    p1 = __builtin_amdgcn_mfma_f32_32x32x16_bf16(b1, qr[d0], p1, 0, 0, 0); }
}
__device__ __forceinline__ int v_st(int k, int c) { const int kk = (k & ~0xC) | ((k & 4) << 1) | ((k & 8) >> 1); return ((kk >> 3) * 4 + (c >> 5)) * 512 + ((kk & 7) * 32 + (c & 31)) * 2; }
__device__ __forceinline__ int v_rd_base(int lane) { return ((lane & 3) << 3) | (((lane >> 2) & 3) << 6) | (((lane >> 4) & 1) << 5) | (((lane >> 5) & 1) << 8); }
constexpr int v_rd_off(int d0, int ks, int half) { return d0 * 512 + ks * 4096 + half * 2048; }
template <int OFF> __device__ __forceinline__ s16x4 tr_read(int vb) {
  s16x4 r; asm volatile("ds_read_b64_tr_b16 %0, %1 offset:%2" : "=&v"(r) : "v"(vb), "i"(OFF) : "memory"); return r;
}
template <int D0> __device__ __forceinline__ void pv_one(f32x16& od, int vb, bf16x8 pa0, bf16x8 pa1, bf16x8 pa2, bf16x8 pa3) {
  const s16x4 l0 = tr_read<v_rd_off(D0, 0, 0)>(vb), h0 = tr_read<v_rd_off(D0, 0, 1)>(vb), l1 = tr_read<v_rd_off(D0, 1, 0)>(vb), h1 = tr_read<v_rd_off(D0, 1, 1)>(vb);
  const s16x4 l2 = tr_read<v_rd_off(D0, 2, 0)>(vb), h2 = tr_read<v_rd_off(D0, 2, 1)>(vb), l3 = tr_read<v_rd_off(D0, 3, 0)>(vb), h3 = tr_read<v_rd_off(D0, 3, 1)>(vb);
  asm volatile("s_waitcnt lgkmcnt(0)" ::: "memory"); SBAR();
#define PK(L, H) (bf16x8){L[0], L[1], L[2], L[3], H[0], H[1], H[2], H[3]}
  od = __builtin_amdgcn_mfma_f32_32x32x16_bf16(pa0, PK(l0, h0), od, 0, 0, 0);
  od = __builtin_amdgcn_mfma_f32_32x32x16_bf16(pa1, PK(l1, h1), od, 0, 0, 0);
  od = __builtin_amdgcn_mfma_f32_32x32x16_bf16(pa2, PK(l2, h2), od, 0, 0, 0);
  od = __builtin_amdgcn_mfma_f32_32x32x16_bf16(pa3, PK(l3, h3), od, 0, 0, 0);
#undef PK
}
__device__ __forceinline__ void pv_d0(f32x16* o, int vb, bf16x8 pa0, bf16x8 pa1, bf16x8 pa2, bf16x8 pa3) {
  pv_one<0>(o[0], vb, pa0, pa1, pa2, pa3); pv_one<1>(o[1], vb, pa0, pa1, pa2, pa3); pv_one<2>(o[2], vb, pa0, pa1, pa2, pa3); pv_one<3>(o[3], vb, pa0, pa1, pa2, pa3);
}
constexpr int LDQ = NPROJ, LDK = 256;
__device__ __forceinline__ void attn_dense_body(bf16_t* Qb, const bf16_t* __restrict__ Kh, const bf16_t* __restrict__ Vh, int seq, char* lds, const int tid, const float* __restrict__ qg, const float* __restrict__ rope, int s0, const bool STORE = true) {
  const int wid = tid >> 6, lane = tid & 63, r32 = lane & 31, hi = lane >> 5;
  bf16_t* V_lds = (bf16_t*)lds; bf16_t* K_lds = (bf16_t*)(lds + 2 * SHM_V);
  float* ws = (float*)(lds + 2 * SHM_V + 2 * SHM_K) + wid * 64; float* li_l = ws; float* al_l = ws + 32;
  float m_reg = -1e30f, l_reg = 0; f32x16 o[4] = {}; bf16x8 qr[8];
  const bf16_t* Qw = Qb + (long)(wid * QBLK + r32) * LDQ + hi * 8;
#pragma unroll
  for (int d0 = 0; d0 < 8; ++d0) qr[d0] = *reinterpret_cast<const bf16x8*>(Qw + d0 * 16);
  {
    float ss = 0.f;
#pragma unroll
    for (int d0 = 0; d0 < 8; ++d0) { const u32x4 w = __builtin_bit_cast(u32x4, qr[d0]);
#pragma unroll
      for (int e = 0; e < 4; ++e) { const float lo = __uint_as_float(w[e] << 16), hi_ = __uint_as_float(w[e] & 0xffff0000u); ss += lo * lo + hi_ * hi_; } }
    { auto rr = __builtin_amdgcn_permlane32_swap(__float_as_uint(ss), __float_as_uint(ss), false, false); ss = __uint_as_float(rr[0]) + __uint_as_float(rr[1]); }
    const float rinv = rsqrtf(ss * (1.0f / 128.0f) + LN_EPS);
    const int sp = s0 + wid * QBLK + r32;
#pragma unroll
    for (int a = 0; a < 2; ++a) {
      float qf[4][8];
#pragma unroll
      for (int dd = 0; dd < 4; ++dd) { const int d0 = a * 4 + dd; const u32x4 w = __builtin_bit_cast(u32x4, qr[d0]);
        const f32x4 g0 = *(const f32x4*)(qg + d0 * 16 + hi * 8), g1 = *(const f32x4*)(qg + d0 * 16 + hi * 8 + 4);
        qf[dd][0] = __uint_as_float(w[0] << 16) * (rinv * g0[0]); qf[dd][1] = __uint_as_float(w[0] & 0xffff0000u) * (rinv * g0[1]);
        qf[dd][2] = __uint_as_float(w[1] << 16) * (rinv * g0[2]); qf[dd][3] = __uint_as_float(w[1] & 0xffff0000u) * (rinv * g0[3]);
        qf[dd][4] = __uint_as_float(w[2] << 16) * (rinv * g1[0]); qf[dd][5] = __uint_as_float(w[2] & 0xffff0000u) * (rinv * g1[1]);
        qf[dd][6] = __uint_as_float(w[3] << 16) * (rinv * g1[2]); qf[dd][7] = __uint_as_float(w[3] & 0xffff0000u) * (rinv * g1[3]); }
      if (rope) { const int pos = a == 0 ? (sp >> 6) : (sp & 63);
#pragma unroll
        for (int dd = 0; dd < 2; ++dd) { const float* cp = rope + pos * 32 + dd * 16 + hi * 8;
          const f32x4 c0 = *(const f32x4*)cp, c1 = *(const f32x4*)(cp + 4), s0v = *(const f32x4*)(cp + 2048), s1v = *(const f32x4*)(cp + 2048 + 4);
#pragma unroll
          for (int e = 0; e < 4; ++e) { float x1 = qf[dd][e], x2 = qf[dd + 2][e]; qf[dd][e] = x1 * c0[e] - x2 * s0v[e]; qf[dd + 2][e] = x2 * c0[e] + x1 * s0v[e];
            x1 = qf[dd][4 + e]; x2 = qf[dd + 2][4 + e]; qf[dd][4 + e] = x1 * c1[e] - x2 * s1v[e]; qf[dd + 2][4 + e] = x2 * c1[e] + x1 * s1v[e]; } } }
#pragma unroll
      for (int dd = 0; dd < 4; ++dd) { u32x4 w; w.x = cvtpk(qf[dd][0], qf[dd][1]); w.y = cvtpk(qf[dd][2], qf[dd][3]); w.z = cvtpk(qf[dd][4], qf[dd][5]); w.w = cvtpk(qf[dd][6], qf[dd][7]); qr[a * 4 + dd] = __builtin_bit_cast(bf16x8, w); }
      asm volatile("" ::: "memory");
    }
  }
  int tid2 = tid; asm volatile("" : "+v"(tid2));
  const int sr = tid2 >> 4, sc = (tid2 & 15) * 8, vst0 = v_st(sr, sc), vst1 = v_st(32 + sr, sc);
  const int vb0 = (int)(uintptr_t)V_lds + v_rd_base(tid2 & 63);
  struct { bf16x8 vs0, vs1, ks0, ks1; } sr_[1];
#define LD8(p) (*reinterpret_cast<const bf16x8*>(p))
#define SLOAD(i, k0) do { sr_[i].vs0 = LD8(&Vh[(long)((k0) + sr) * LDK + sc]); sr_[i].vs1 = LD8(&Vh[(long)((k0) + 32 + sr) * LDK + sc]); \
    sr_[i].ks0 = LD8(&Kh[(long)((k0) + sr) * LDK + sc]); sr_[i].ks1 = LD8(&Kh[(long)((k0) + 32 + sr) * LDK + sc]); } while (0)
#define SWRITE(b, i) do { *(bf16x8*)((char*)V_lds + (b) * SHM_V + vst0) = sr_[i].vs0;          \
    *(bf16x8*)((char*)V_lds + (b) * SHM_V + vst1) = sr_[i].vs1; int kc = sc * 2;               \
    *(bf16x8*)((char*)K_lds + (b) * SHM_K + KSWZ(sr, kc)) = sr_[i].ks0;                       \
    *(bf16x8*)((char*)K_lds + (b) * SHM_K + KSWZ(32 + sr, kc)) = sr_[i].ks1; } while (0)
#define SWAIT() asm volatile("s_waitcnt vmcnt(0)" ::: "memory")
#define RESC(a) do { if (__any((a) < 1.f)) { if (hi == 0) al_l[r32] = (a); asm volatile("s_waitcnt lgkmcnt(0)" ::: "memory"); \
    _Pragma("unroll") for (int d = 0; d < 4; ++d) _Pragma("unroll") for (int r = 0; r < 16; ++r) o[d][r] *= al_l[crow(r, hi)]; } } while (0)
  f32x16 pA0, pA1, pB0, pB1; float mnA, mnB, alA, alB; bf16x8 pa0, pa1, pa2, pa3; const int NT = seq / KVBLK;
  constexpr int SE = 0, SO = 0;
  SLOAD(SE, 0); asm volatile("s_waitcnt vmcnt(0)" ::: "memory"); SWRITE(0, SE); __syncthreads();
  qkt(pA0, pA1, K_lds, qr, r32, hi); partialSM(pA0, pA1, m_reg, mnA, alA);
  SLOAD(SO, KVBLK);
  SWAIT(); SWRITE(1, SO); __syncthreads();
  for (int j = 1; j + 1 < NT; j += 2) {
    SBAR(); qkt(pB0, pB1, (bf16_t*)((char*)K_lds + SHM_K), qr, r32, hi);
    finishSM(pA0, pA1, alA, l_reg, pa0, pa1, pa2, pa3); SBAR();
    SLOAD(SO, (j + 1) * KVBLK); SBAR();
    pv_d0(o, vb0, pa0, pa1, pa2, pa3); partialSM(pB0, pB1, m_reg, mnB, alB);
    __syncthreads(); SWAIT(); SWRITE(0, SE);
    RESC(alB); __syncthreads();
    SBAR(); qkt(pA0, pA1, K_lds, qr, r32, hi);
    finishSM(pB0, pB1, alB, l_reg, pa0, pa1, pa2, pa3); SBAR();
    SLOAD(SE, (j + 2) * KVBLK); SBAR();
    pv_d0(o, vb0 + (int)SHM_V, pa0, pa1, pa2, pa3); partialSM(pA0, pA1, m_reg, mnA, alA);
    __syncthreads(); SWAIT(); SWRITE(1, SO);
    RESC(alA); __syncthreads();
  }
  SBAR(); qkt(pB0, pB1, (bf16_t*)((char*)K_lds + SHM_K), qr, r32, hi);
  finishSM(pA0, pA1, alA, l_reg, pa0, pa1, pa2, pa3); SBAR();
  pv_d0(o, vb0, pa0, pa1, pa2, pa3); partialSM(pB0, pB1, m_reg, mnB, alB);
  __syncthreads(); RESC(alB);
  finishSM(pB0, pB1, alB, l_reg, pa0, pa1, pa2, pa3); SBAR();
  pv_d0(o, vb0 + (int)SHM_V, pa0, pa1, pa2, pa3);
  if (hi == 0) li_l[r32] = l_reg; asm volatile("s_waitcnt lgkmcnt(0)" ::: "memory");
  float rli[16];
#pragma unroll
  for (int r = 0; r < 16; ++r) rli[r] = __builtin_amdgcn_rcpf(li_l[crow(r, hi)]);
  __syncthreads();
  { bf16_t* stg = (bf16_t*)lds + wid * 4096;
#pragma unroll
    for (int r = 0; r < 16; ++r) { const int orow = crow(r, hi);
#pragma unroll
      for (int d0 = 0; d0 < 4; ++d0) stg[orow * 128 + d0 * 32 + r32] = (bf16_t)(cvtpk(o[d0][r] * rli[r], 0.f) & 0xffffu); }
    asm volatile("s_waitcnt lgkmcnt(0)" ::: "memory");
    int le = lane; asm volatile("" : "+v"(le));
    bf16_t* Ow = Qb + (long)(wid * QBLK + (le >> 4)) * LDQ + (le & 15) * 8;
#pragma unroll
    for (int i = 0; i < 8; ++i) { const u32x4 v = *(const u32x4*)(stg + (i * 4 + (le >> 4)) * 128 + (le & 15) * 8); if (STORE) *(u32x4*)(Ow + (long)i * 4 * LDQ) = v; else asm volatile("" :: "v"(v)); }
  }
  __syncthreads();
#undef LD8
#undef SLOAD
#undef SWRITE
#undef SWAIT
#undef RESC
}
#undef KSWZ
#undef SBAR
}


#define XB_TMO      128
#define XB_XCNT(j)  (256  + 64 * (j))
#define XB_XSUB(j)  (1280 + 64 * (j))
#define XB_XGEN(j)  (2304 + 64 * (j))
#define XB_TOP      3328
#define XB_TOPGEN   3392
#define XCD_BAR_WORDS 3456
#define XB_SPIN_CAP (1u << 18)
__device__ __forceinline__ unsigned xb_ld(unsigned* p)              { return __hip_atomic_load(p, __ATOMIC_RELAXED, __HIP_MEMORY_SCOPE_AGENT); }
__device__ __forceinline__ unsigned xb_add(unsigned* p, unsigned v) { return __hip_atomic_fetch_add(p, v, __ATOMIC_RELAXED, __HIP_MEMORY_SCOPE_AGENT); }
__device__ __forceinline__ unsigned xb_xcc_id() { return (unsigned)__builtin_amdgcn_s_getreg((3 << 11) | 20) & 0xFu; }
#define XB_SPIN(cond, bar) do { unsigned _sp = 0; while (cond) { __builtin_amdgcn_s_sleep(1); \
    if ((++_sp & 255u) == 0u) { if (xb_ld(&(bar)[XB_TMO])) break; if (_sp > XB_SPIN_CAP) { atomicAdd(&(bar)[XB_TMO], 1u); break; } } } } while (0)
struct XcdBarrier { unsigned* bar; unsigned x; volatile LAS unsigned* st; };
__device__ __forceinline__ XcdBarrier xcd_barrier_post(unsigned* bar, volatile LAS unsigned* st) {
    XcdBarrier b; b.bar = bar; b.x = xb_xcc_id(); b.st = st;
    if (threadIdx.x == 0) (void)xb_add(&bar[XB_XCNT(b.x)], 1u);
    return b;
}
__device__ __forceinline__ void xcd_barrier_complete(unsigned* bar, unsigned x, unsigned& nloc, unsigned& nx) {
    const unsigned G = gridDim.x * gridDim.y * gridDim.z;
    unsigned sum, cnt, mine, sp = 0u;
    for (;;) {
        sum = 0u; cnt = 0u; mine = 0u;
#pragma unroll
        for (unsigned j = 0; j < 16; ++j) { const unsigned c = xb_ld(&bar[XB_XCNT(j)]); sum += c; cnt += (c > 0u) ? 1u : 0u; mine = (j == x) ? c : mine; }
        if (sum == G) break;
        __builtin_amdgcn_s_sleep(1);
        if ((++sp & 255u) == 0u) { if (xb_ld(&bar[XB_TMO])) break; if (sp > XB_SPIN_CAP) { atomicAdd(&bar[XB_TMO], 1u); break; } }
    }
    nloc = mine > 0u ? mine : 1u; nx = cnt > 0u ? cnt : 1u;
}
__device__ __forceinline__ void xcd_barrier(const XcdBarrier& b) {
    asm volatile("s_waitcnt vmcnt(0)" ::: "memory");
    __syncthreads();
    if (threadIdx.x == 0) {
        unsigned* bar = b.bar;
        __builtin_amdgcn_s_waitcnt(0);
        unsigned nloc = b.st[0], nx = b.st[1];
        if (nloc == 0u) { xcd_barrier_complete(bar, b.x, nloc, nx); b.st[0] = nloc; b.st[1] = nx; }
        const unsigned old = xb_add(&bar[XB_XSUB(b.x)], 1u);
        const unsigned gen = old / nloc;
        if (old + 1u == (gen + 1u) * nloc) {
            __builtin_amdgcn_fence(__ATOMIC_RELEASE, "agent");
            asm volatile("s_waitcnt vmcnt(0)" ::: "memory");
            const unsigned og = xb_add(&bar[XB_TOP], 1u);
            const unsigned tg = og / nx;
            if (og + 1u == (tg + 1u) * nx) xb_add(&bar[XB_TOPGEN], 1u);
            else XB_SPIN(xb_ld(&bar[XB_TOPGEN]) == tg, bar);
            __builtin_amdgcn_fence(__ATOMIC_ACQUIRE, "agent");
            xb_add(&bar[XB_XGEN(b.x)], 1u);
            asm volatile("s_waitcnt vmcnt(0)" ::: "memory");
        } else {
            XB_SPIN(xb_ld(&bar[XB_XGEN(b.x)]) == gen, bar);
            __builtin_amdgcn_fence(__ATOMIC_ACQUIRE, "agent");
            asm volatile("s_waitcnt vmcnt(0)" ::: "memory");
        }
    }
    __syncthreads();
}

struct Args { const float* in[25]; float* out; unsigned char* ws; int ph_lo, ph_hi; };

typedef const float* fptr_t;
typedef __attribute__((address_space(4))) const fptr_t* in_as4_t;
struct Frame {
    LAS unsigned char* lds; char* ldsg;
    int tid, lane, wave, G, bx, gw, NGW;
    const float* const* in;
    unsigned char* ws; float* out;
};
enum { I_XP = 0, I_XS, I_CK, I_CV, I_C, I_CCTX, I_WADA, I_BADA, I_WIN, I_QG, I_KG, I_WPG, I_PSC, I_WSGU, I_BSGU, I_WAO, I_WPO, I_WSO, I_WOUT, I_LN1G, I_LN1B, I_WF1, I_WF2, I_LN2G, I_LN2B };

__device__ __forceinline__ void tr_item(const float* W, int ldw, int src_col, int kb, bf16_t* WT, int ldt, int dst_row, int dst_k, LAS float* scr, int lane) {
    const int k0 = 64 * kb;
#pragma unroll 8
    for (int i = 0; i < 32; ++i) { const int kk = 2 * i + (lane >> 5); scr[kk * 33 + (lane & 31)] = W[(size_t)(k0 + kk) * ldw + src_col + (lane & 31)]; }
    asm volatile("s_waitcnt lgkmcnt(0)" ::: "memory");
    const int c = lane & 7;
#pragma unroll
    for (int j = 0; j < 4; ++j) { const int n = (lane >> 3) + 8 * j; const LAS float* s = scr + (8 * c) * 33 + n;
        u32x4 o; o.x = cvt_pk_bf16(s[0 * 33], s[1 * 33]); o.y = cvt_pk_bf16(s[2 * 33], s[3 * 33]); o.z = cvt_pk_bf16(s[4 * 33], s[5 * 33]); o.w = cvt_pk_bf16(s[6 * 33], s[7 * 33]);
        *(u32x4*)(WT + (size_t)(dst_row + n) * ldt + dst_k + k0 + 8 * c) = o; }
    asm volatile("s_waitcnt lgkmcnt(0)" ::: "memory");
}

__device__ __forceinline__ int win_src_col(int d) {
    if (d < 1024) return d;
    if (d < 1536) return 2048 + (d - 1024);
    if (d < 2048) return 1024 + (d - 1536);
    if (d < 2560) return 2560 + (d - 2048);
    if (d < 3072) return 1536 + (d - 2560);
    return d;
}

__device__ __forceinline__ void phase_prologue(Frame& F) {
    if (F.bx < 192) {
        const int l = F.bx / 96, nb = F.bx % 96;
        LAS float* sc = (LAS float*)F.lds;
        LAS float* red = (LAS float*)(F.lds + 9 * 1024 * 4);
        for (int idx = F.tid; idx < 9 * 1024; idx += 512) { const int v = idx >> 10, k = idx & 1023;
            const float x = v == 0 ? F.in[I_CCTX][k] : F.in[I_C][(v - 1) * 1024 + k]; sc[idx] = x / (1.0f + __expf(-x)); }
        __syncthreads();
        float acc[9];
#pragma unroll
        for (int v = 0; v < 9; ++v) acc[v] = 0.f;
        const float* wp = F.in[I_WADA] + ((size_t)l * 1024 + F.wave * 128) * 6144 + nb * 64 + F.lane;
#pragma unroll 8
        for (int k = 0; k < 128; ++k) { const float w = wp[(size_t)k * 6144];
#pragma unroll
            for (int v = 0; v < 9; ++v) acc[v] += sc[v * 1024 + F.wave * 128 + k] * w; }
#pragma unroll
        for (int v = 0; v < 9; ++v) red[(F.wave * 9 + v) * 64 + F.lane] = acc[v];
        __syncthreads();
        float* mod = (float*)(F.ws + WS_MOD);
        for (int idx = F.tid; idx < 576; idx += 512) { const int v = idx >> 6, ln = idx & 63; float s = 0.f;
#pragma unroll
            for (int w = 0; w < 8; ++w) s += red[(w * 9 + v) * 64 + ln];
            mod[(l * 9 + v) * 6144 + nb * 64 + ln] = s + F.in[I_BADA][l * 6144 + nb * 64 + ln]; }
        __syncthreads();
    }
    LAS float* scr = (LAS float*)(F.lds + F.wave * 8448);
    constexpr int N_WIN = 16 * 192, N_AO = 16 * 32, N_SO = 8 * 32, N_WO = 16 * 32, N_F1 = 16 * 176, N_F2 = 44 * 32, N_PE = 1024, N_WS = 128;
    constexpr int N_L = N_WIN + N_AO + N_SO + N_WO + N_F1 + N_F2 + N_PE + N_WS;
    constexpr int N_ALL = 2 * N_L + 32;
    for (int it = F.gw; it < N_ALL; it += F.NGW) {
        if (it >= 2 * N_L) {
            const int idx = (it - 2 * N_L) * 64 + F.lane; const int pos = idx >> 5, p = idx & 31;
            const float inv = powf(10000.0f, -(float)p / 32.0f); const float ang = (float)pos * inv;
            float* rope = (float*)(F.ws + WS_ROPE); rope[idx] = cosf(ang); rope[2048 + idx] = sinf(ang);
            continue;
        }
        const int l = it / N_L; int r = it % N_L;
        if (r < N_WIN) { const int kb = r / 192, nb = r % 192;
            tr_item(F.in[I_WIN] + (size_t)l * 1024 * 6144, 6144, win_src_col(nb * 32), kb, (bf16_t*)(F.ws + WS_WIN) + (size_t)l * 6144 * 1024, 1024, nb * 32, 0, scr, F.lane); continue; } r -= N_WIN;
        if (r < N_AO) { const int kb = r / 32, nb = r % 32;
            tr_item(F.in[I_WAO] + (size_t)l * 1024 * 1024, 1024, nb * 32, kb, (bf16_t*)(F.ws + WS_WM) + (size_t)l * 1024 * 2048, 2048, nb * 32, 0, scr, F.lane); continue; } r -= N_AO;
        if (r < N_SO) { const int kb = r / 32, nb = r % 32;
            tr_item(F.in[I_WSO] + (size_t)l * 512 * 1024, 1024, nb * 32, kb, (bf16_t*)(F.ws + WS_WM) + (size_t)l * 1024 * 2048, 2048, nb * 32, 1024, scr, F.lane); continue; } r -= N_SO;
        if (r < N_WO) { const int kb = r / 32, nb = r % 32;
            tr_item(F.in[I_WOUT] + (size_t)l * 1024 * 1024, 1024, nb * 32, kb, (bf16_t*)(F.ws + WS_WOUT) + (size_t)l * 1024 * 1024, 1024, nb * 32, 0, scr, F.lane); continue; } r -= N_WO;
        if (r < N_F1) { const int kb = r / 176, nb = r % 176; const int drow = nb * 32; const int pn = drow >> 8, j = drow & 255;
            const int src = j < 128 ? pn * 128 + j : DFF + pn * 128 + (j - 128);
            tr_item(F.in[I_WF1] + (size_t)l * 1024 * 5632, 5632, src, kb, (bf16_t*)(F.ws + WS_WF1) + (size_t)l * 5632 * 1024, 1024, drow, 0, scr, F.lane); continue; } r -= N_F1;
        if (r < N_F2) { const int kb = r / 32, nb = r % 32;
            tr_item(F.in[I_WF2] + (size_t)l * DFF * 1024, 1024, nb * 32, kb, (bf16_t*)(F.ws + WS_WF2) + (size_t)l * 1024 * DFF, DFF, nb * 32, 0, scr, F.lane); continue; } r -= N_F2;
        if (r < N_PE) {
            const int kg = r >> 4, nb = r & 15; const int k0 = kg * 8, g = k0 >> 7; const int n = nb * 64 + F.lane;
            const float* wpg = F.in[I_WPG] + ((size_t)(l * 4 + g) * 128 + (k0 & 127)) * 128;
            const float* psc = F.in[I_PSC] + l * 512 + g * 128;
            const float* wpo = F.in[I_WPO] + ((size_t)l * 512 + g * 128) * 1024 + n;
            float a[8];
#pragma unroll
            for (int i = 0; i < 8; ++i) a[i] = 0.f;
#pragma unroll 4
            for (int j = 0; j < 128; ++j) { const float w = wpo[(size_t)j * 1024] * psc[j];
#pragma unroll
                for (int i = 0; i < 8; ++i) a[i] += wpg[i * 128 + j] * w; }
            u32x4 o; o.x = cvt_pk_bf16(a[0], a[1]); o.y = cvt_pk_bf16(a[2], a[3]); o.z = cvt_pk_bf16(a[4], a[5]); o.w = cvt_pk_bf16(a[6], a[7]);
            *(u32x4*)((bf16_t*)(F.ws + WS_WM) + (size_t)l * 1024 * 2048 + (size_t)n * 2048 + 1536 + k0) = o;
            continue; } r -= N_PE;
        {
            const size_t e0 = (size_t)l * 65536 + (size_t)r * 512 + F.lane * 8;
            const f32x4 a = *(const f32x4*)(F.in[I_WSGU] + e0), b = *(const f32x4*)(F.in[I_WSGU] + e0 + 4);
            u32x4 o; o.x = cvt_pk_bf16(a[0], a[1]); o.y = cvt_pk_bf16(a[2], a[3]); o.z = cvt_pk_bf16(b[0], b[1]); o.w = cvt_pk_bf16(b[2], b[3]);
            *(u32x4*)((bf16_t*)(F.ws + WS_WSGU) + e0) = o;
        }
    }
}

__device__ __forceinline__ const float* x0_row(Frame& F, int t) { return t < T_CTX ? F.in[I_XP] + (size_t)t * DM : F.in[I_XS] + (size_t)(t - T_CTX) * DM; }
__device__ __forceinline__ int vec_of_row(int t) { return t < T_CTX ? 0 : 1 + ((t - T_CTX) >> 12); }

__device__ __forceinline__ void phase_h0(Frame& F) {
    const float* mod = (const float*)(F.ws + WS_MOD);
    bf16_t* act = (bf16_t*)(F.ws + WS_ACT);
    for (int t = F.gw; t < T_ALL; t += F.NGW) {
        const f32x4* xr = (const f32x4*)x0_row(F, t) + F.lane;
        const float* mv = mod + vec_of_row(t) * 6144;
        unsigned long long* o8 = (unsigned long long*)(act + (size_t)t * DM) + F.lane;
#pragma unroll
        for (int j = 0; j < 4; ++j) { const f32x4 x = xr[64 * j]; const int c = 256 * j + 4 * F.lane;
            const f32x4 sh = *(const f32x4*)(mv + c), sc = *(const f32x4*)(mv + 1024 + c);
            const f32x4 h = x * (sc + 1.0f) + sh;
            o8[64 * j] = (unsigned long long)cvt_pk_bf16(h[0], h[1]) | ((unsigned long long)cvt_pk_bf16(h[2], h[3]) << 32); }
    }
}

__device__ __forceinline__ void phase_ln(Frame& F, const float* lg, const float* lb, const float* modl  , int sh_off, int sc_off, const bool dry = false) {
    float* X = F.out; bf16_t* act = (bf16_t*)(F.ws + WS_ACT);
    for (int t = F.gw; t < T_ALL; t += F.NGW) {
        f32x4* xr = (f32x4*)(X + (size_t)t * DM) + F.lane;
        f32x4 v[4]; float s = 0.f;
#pragma unroll
        for (int j = 0; j < 4; ++j) { v[j] = xr[64 * j]; s += (v[j][0] + v[j][1]) + (v[j][2] + v[j][3]); }
        const float mean = wave_sum(s) * (1.f / DM); float s2 = 0.f;
#pragma unroll
        for (int j = 0; j < 4; ++j) { v[j] = v[j] - mean; s2 += (v[j][0] * v[j][0] + v[j][1] * v[j][1]) + (v[j][2] * v[j][2] + v[j][3] * v[j][3]); }
        const float rstd = rsqrtf(wave_sum(s2) * (1.f / DM) + LN_EPS);
        const float* mv = modl ? modl + vec_of_row(t) * 6144 : nullptr;
        unsigned long long* o8 = (unsigned long long*)(act + (size_t)t * DM) + F.lane;
#pragma unroll
        for (int j = 0; j < 4; ++j) { const int c = 256 * j + 4 * F.lane;
            const f32x4 g = *(const f32x4*)(lg + c), b = *(const f32x4*)(lb + c);
            const f32x4 y = v[j] * rstd * g + b; if (!dry) xr[64 * j] = y; else { asm volatile("" :: "v"(y)); continue; }
            if (mv) { const f32x4 sh = *(const f32x4*)(mv + sh_off + c), sc = *(const f32x4*)(mv + sc_off + c);
                const f32x4 h = y * (sc + 1.0f) + sh;
                o8[64 * j] = (unsigned long long)cvt_pk_bf16(h[0], h[1]) | ((unsigned long long)cvt_pk_bf16(h[2], h[3]) << 32); } }
    }
}

__device__ __forceinline__ void load16h(const bf16_t* p, int j, float (&x)[16]) {
#pragma unroll
    for (int a = 0; a < 2; ++a)
#pragma unroll
        for (int hf = 0; hf < 2; ++hf) { const u32x2 w = *(const u32x2*)(p + a * 64 + hf * 32 + 4 * j);
            x[(a * 2 + hf) * 4 + 0] = bf_lo(w.x); x[(a * 2 + hf) * 4 + 1] = bf_hi(w.x); x[(a * 2 + hf) * 4 + 2] = bf_lo(w.y); x[(a * 2 + hf) * 4 + 3] = bf_hi(w.y); }
}
__device__ __forceinline__ void rmsn(float (&x)[16], const float (&g)[16]) {
    float ss = 0.f;
#pragma unroll
    for (int i = 0; i < 16; ++i) ss += x[i] * x[i];
    ss += __shfl_xor(ss, 1); ss += __shfl_xor(ss, 2); ss += __shfl_xor(ss, 4);
    const float rinv = rsqrtf(ss * (1.0f / 128.0f) + LN_EPS);
#pragma unroll
    for (int i = 0; i < 16; ++i) x[i] = x[i] * rinv * g[i];
}
__device__ __forceinline__ void rope16(float (&x)[16], const float* rope, int rowpos, int colpos, int j) {
#pragma unroll
    for (int a = 0; a < 2; ++a) { const int pos = a == 0 ? rowpos : colpos;
        const f32x4 c = *(const f32x4*)(rope + pos * 32 + 4 * j), s = *(const f32x4*)(rope + 2048 + pos * 32 + 4 * j);
#pragma unroll
        for (int e = 0; e < 4; ++e) { const float x1 = x[(a * 2) * 4 + e], x2 = x[(a * 2 + 1) * 4 + e];
            x[(a * 2) * 4 + e] = x1 * c[e] - x2 * s[e]; x[(a * 2 + 1) * 4 + e] = x2 * c[e] + x1 * s[e]; } }
}
__device__ __forceinline__ void store16h(bf16_t* p, int j, const float (&x)[16]) {
#pragma unroll
    for (int a = 0; a < 2; ++a)
#pragma unroll
        for (int hf = 0; hf < 2; ++hf) { u32x2 w; w.x = cvt_pk_bf16(x[(a * 2 + hf) * 4 + 0], x[(a * 2 + hf) * 4 + 1]); w.y = cvt_pk_bf16(x[(a * 2 + hf) * 4 + 2], x[(a * 2 + hf) * 4 + 3]);
            *(u32x2*)(p + a * 64 + hf * 32 + 4 * j) = w; }
}

__device__ __forceinline__ void phase_mid(Frame& F, int l, int part, const bool dry = false) {
    bf16_t* proj = (bf16_t*)(F.ws + WS_PROJ);
    const float* rope = (const float*)(F.ws + WS_ROPE);
    bf16_t* vrt = (bf16_t*)(F.ws + WS_VRT);
    bf16_t* KL = (bf16_t*)(F.ws + WS_KL); bf16_t* VL = (bf16_t*)(F.ws + WS_VL); bf16_t* KC = (bf16_t*)(F.ws + WS_KC); bf16_t* VC = (bf16_t*)(F.ws + WS_VC);
    float* outk = F.out + (size_t)T_ALL * DM; float* outv = outk + (size_t)16 * 2 * 256 * 256;
    const int lane = F.lane, hj = lane & 7;
    const int n8 = part_rows(part) / 4, ncache = 4 * PAST;
    float qg[16], kg[16];
#pragma unroll
    for (int a = 0; a < 2; ++a)
#pragma unroll
        for (int hf = 0; hf < 2; ++hf)
#pragma unroll
            for (int e = 0; e < 4; ++e) { const int d = a * 64 + hf * 32 + 4 * hj + e; qg[(a * 2 + hf) * 4 + e] = F.in[I_QG][l * 128 + d]; kg[(a * 2 + hf) * 4 + e] = F.in[I_KG][l * 128 + d]; }
    for (int it = F.gw; it < n8 + ncache; it += F.NGW) {
        if (it >= n8) {
            const int cr = it - n8; const int bl = cr >> 9, s = cr & 511; const int b = part * 4 + bl;
            const size_t src = (((size_t)b * 2 + l) * PAST + s) * 256 + lane * 4;
            const f32x4 kx = *(const f32x4*)(F.in[I_CK] + src), vx = *(const f32x4*)(F.in[I_CV] + src);
            const size_t dst = ((size_t)bl * SKV_LAT + s) * 256 + lane * 4;
            u32x2 kw, vw; kw.x = cvt_pk_bf16(kx[0], kx[1]); kw.y = cvt_pk_bf16(kx[2], kx[3]); vw.x = cvt_pk_bf16(vx[0], vx[1]); vw.y = cvt_pk_bf16(vx[2], vx[3]);
            if (!dry) { *(u32x2*)(KL + dst) = kw; *(u32x2*)(VL + dst) = vw; } else asm volatile("" :: "v"(kw), "v"(vw));
            continue;
        }
        const int lr0 = it * 4, t0 = part_row0(part) + lr0;
        const bool is_ctx = t0 < T_CTX;
        bf16_t* P0 = proj + (size_t)lr0 * NPROJ;
        {
            float val[4][8];
#pragma unroll
            for (int i = 0; i < 4; ++i) { const u32x4 w = *(const u32x4*)(P0 + (size_t)i * NPROJ + PC_XV + lane * 8);
#pragma unroll
                for (int e = 0; e < 4; ++e) { val[i][2 * e] = gelu1(bf_lo(w[e])); val[i][2 * e + 1] = gelu1(bf_hi(w[e])); } }
#pragma unroll
            for (int i = 0; i < 4; ++i) { float s = 0.f;
#pragma unroll
                for (int e = 0; e < 8; ++e) s += val[i][e];
                const float mean = wave_sum(s) * (1.0f / 512.0f); float s2 = 0.f;
#pragma unroll
                for (int e = 0; e < 8; ++e) { val[i][e] -= mean; s2 += val[i][e] * val[i][e]; }
                const float rstd = rsqrtf(wave_sum(s2) * (1.0f / 512.0f) + LN_EPS);
#pragma unroll
                for (int e = 0; e < 8; ++e) val[i][e] *= rstd; }
            const int chunk = lr0 >> 7, q0 = lr0 & 127;
            bf16_t* vb = vrt + ((size_t)chunk * 512 + lane * 8) * 128 + q0;
#pragma unroll
            for (int e = 0; e < 8; ++e) { u32x2 o; o.x = cvt_pk_bf16(val[0][e], val[1][e]); o.y = cvt_pk_bf16(val[2][e], val[3][e]);
                if (!dry) *(u32x2*)(vb + (size_t)e * 128) = o; else asm volatile("" :: "v"(o)); }
        }
#pragma unroll 1
        for (int i = 0; i < 4; ++i) {
            bf16_t* Pr = P0 + (size_t)i * NPROJ; const int t = t0 + i;
            int spos, seqS, rowpos = 0, colpos = 0, bl = 0;
            if (is_ctx) { spos = t & 255; seqS = CTX_S; } else { const int tl = t - T_CTX; spos = tl & 4095; seqS = LAT_S; rowpos = spos >> 6; colpos = spos & 63; bl = (tl >> 12) - part * 4; }
            float x[16];
            const int kh = (lane >> 3) & 1;
            load16h(Pr + PC_K + kh * 128, hj, x); rmsn(x, kg);
            const int vi = (lane - 16) & 31;
            const u32x4 vw = *(const u32x4*)(Pr + PC_V + vi * 8);
            float pacc[8], pself[8];
            {
                const int hw = 1 << (lane >> 4);
                const int lo = max(spos - hw, 0), hi = min(spos + hw, seqS);
#pragma unroll
                for (int e = 0; e < 8; ++e) pacc[e] = 0.f;
                u32x4 pw[16];
#pragma unroll
                for (int k = 0; k < 16; ++k) { const int dd = k - 8, sp = spos + dd; const bool ok = (sp >= lo) && (sp < hi);
                    pw[k] = *(const u32x4*)(Pr + (long)(ok ? dd : 0) * NPROJ + PC_XP + lane * 8); }
#pragma unroll
                for (int k = 0; k < 16; ++k) { const int sp = spos + k - 8; const float mk = ((sp >= lo) && (sp < hi)) ? 1.0f : 0.0f;
#pragma unroll
                    for (int e = 0; e < 4; ++e) { pacc[2 * e] += mk * bf_lo(pw[k][e]); pacc[2 * e + 1] += mk * bf_hi(pw[k][e]); } }
#pragma unroll
                for (int e = 0; e < 4; ++e) { pself[2 * e] = bf_lo(pw[8][e]); pself[2 * e + 1] = bf_hi(pw[8][e]); }
                const float rc = 1.0f / (float)(hi - lo);
#pragma unroll
                for (int e = 0; e < 8; ++e) pacc[e] = pacc[e] * rc - pself[e];
            }
            asm volatile("s_waitcnt vmcnt(0)" ::: "memory");
            if (dry) { asm volatile("" :: "v"(x[0]), "v"(x[7]), "v"(vw), "v"(pacc[0]), "v"(pacc[7])); continue; }
            if (is_ctx) {
                if (lane < 16) {
                    float* ok = outk + (((size_t)(t >> 8) * 2 + l) * 256 + (t & 255)) * 256 + kh * 128;
#pragma unroll
                    for (int a = 0; a < 2; ++a)
#pragma unroll
                        for (int hf = 0; hf < 2; ++hf) *(f32x4*)(ok + a * 64 + hf * 32 + 4 * hj) = (f32x4){x[(a * 2 + hf) * 4], x[(a * 2 + hf) * 4 + 1], x[(a * 2 + hf) * 4 + 2], x[(a * 2 + hf) * 4 + 3]};
                    store16h(KC + (size_t)t * 256 + kh * 128, hj, x);
                }
                if (lane >= 16 && lane < 48) {
                    float* ov = outv + (((size_t)(t >> 8) * 2 + l) * 256 + (t & 255)) * 256 + vi * 8;
                    *(f32x4*)ov = (f32x4){bf_lo(vw[0]), bf_hi(vw[0]), bf_lo(vw[1]), bf_hi(vw[1])};
                    *(f32x4*)(ov + 4) = (f32x4){bf_lo(vw[2]), bf_hi(vw[2]), bf_lo(vw[3]), bf_hi(vw[3])};
                    *(u32x4*)(VC + (size_t)t * 256 + vi * 8) = vw;
                }
            } else {
                rope16(x, rope, rowpos, colpos, hj);
                const size_t krow = ((size_t)bl * SKV_LAT + PAST + spos) * 256;
                if (lane < 16) store16h(KL + krow + kh * 128, hj, x);
                if (lane >= 16 && lane < 48) *(u32x4*)(VL + krow + vi * 8) = vw;
            }
            { u32x4 o; o.x = cvt_pk_bf16(pacc[0], pacc[1]); o.y = cvt_pk_bf16(pacc[2], pacc[3]); o.z = cvt_pk_bf16(pacc[4], pacc[5]); o.w = cvt_pk_bf16(pacc[6], pacc[7]);
              *(u32x4*)(Pr + PC_K + lane * 8) = o; }
        }
    }
}

__device__ __forceinline__ void phase_attn(Frame& F, int l, int part, const bool sgu_only_dry = false) {
    bf16_t* proj = (bf16_t*)(F.ws + WS_PROJ);
    const bf16_t* KL = (const bf16_t*)(F.ws + WS_KL); const bf16_t* VL = (const bf16_t*)(F.ws + WS_VL); const bf16_t* KC = (const bf16_t*)(F.ws + WS_KC); const bf16_t* VC = (const bf16_t*)(F.ws + WS_VC);
    const int lat_row0 = part == 0 ? T_CTX : 0;
    if (!sgu_only_dry) {
        int pair, idx, step; int rep = 0;
        const bool xcdmap = (F.G % 8) == 0;
        if (xcdmap) { pair = F.bx & 7; idx = F.bx >> 3; step = F.G >> 3; } else { pair = 0; idx = F.bx; step = F.G; }
        for (;;) {
            int pr = pair, ix = idx;
            if (!xcdmap) { pr = idx >> 6; ix = idx & 63; if (idx >= 512) break; } else if (idx >= 64) break;
            const int bl = pr >> 1, kvh = pr & 1, h = kvh * 4 + (ix >> 4), qb = ix & 15;
            bf16_t* Qb = proj + (size_t)(lat_row0 + bl * LAT_S + qb * 256) * NPROJ + PC_Q + h * 128;
            att::attn_dense_body(Qb, KL + (size_t)bl * SKV_LAT * 256 + kvh * 128, VL + (size_t)bl * SKV_LAT * 256 + kvh * 128, SKV_LAT, F.ldsg, F.tid, F.in[I_QG] + l * 128, (const float*)(F.ws + WS_ROPE), qb * 256, PROBE == 3 ? rep == 1 : true);
            if (PROBE == 3) { if (rep == 0) { rep = 1; continue; } rep = 0; }
            idx += step;
        }
    }
    if (part == 0 && !sgu_only_dry) {
        for (int u = F.bx; u < 128; u += F.G) { const int b = u >> 3, h = u & 7;
            bf16_t* Qb = proj + (size_t)(b * 256) * NPROJ + PC_Q + h * 128;
            att::attn_dense_body(Qb, KC + (size_t)b * 256 * 256 + (h >> 2) * 128, VC + (size_t)b * 256 * 256 + (h >> 2) * 128, CTX_S, F.ldsg, F.tid, F.in[I_QG] + l * 128, (const float*)nullptr, 0); }
    }
    const bf16_t* vrt = (const bf16_t*)(F.ws + WS_VRT);
    const bf16_t* wsb = (const bf16_t*)(F.ws + WS_WSGU) + (size_t)l * 65536;
    const float* bs = F.in[I_BSGU] + l * 512;
    const int nitem = (part_rows(part) / 128) * 32;
    const int ln = F.lane & 15, quad = F.lane >> 4;
    for (int it = F.NGW - 1 - F.gw; it < nitem; it += F.NGW) {
        const int chunk = it >> 5, g = (it >> 3) & 3, cb = (it >> 1) & 3, pb = it & 1;
        f32x4 acc[2][4];
#pragma unroll
        for (int a = 0; a < 2; ++a)
#pragma unroll
            for (int b = 0; b < 4; ++b) acc[a][b] = (f32x4){0.f, 0.f, 0.f, 0.f};
        const bf16_t* ap = vrt + ((size_t)chunk * 512 + g * 128 + cb * 32 + ln) * 128 + quad * 8;
        const bf16_t* bp = wsb + ((size_t)g * 128 + pb * 64 + ln) * 128 + quad * 8;
        u32x2 xw[4][2];
#pragma unroll
        for (int pt = 0; pt < 4; ++pt)
#pragma unroll
            for (int ct = 0; ct < 2; ++ct) xw[pt][ct] = *(const u32x2*)(proj + (size_t)(chunk * 128 + pb * 64 + pt * 16 + ln) * NPROJ + PC_U + g * 128 + cb * 32 + ct * 16 + quad * 4);
#pragma unroll
        for (int ks = 0; ks < 4; ++ks) {
            bf16x8 af[2], bfr[4];
#pragma unroll
            for (int ct = 0; ct < 2; ++ct) af[ct] = *(const bf16x8*)(ap + ct * 16 * 128 + ks * 32);
#pragma unroll
            for (int pt = 0; pt < 4; ++pt) bfr[pt] = *(const bf16x8*)(bp + pt * 16 * 128 + ks * 32);
#pragma unroll
            for (int ct = 0; ct < 2; ++ct)
#pragma unroll
                for (int pt = 0; pt < 4; ++pt) acc[ct][pt] = __builtin_amdgcn_mfma_f32_16x16x32_bf16(af[ct], bfr[pt], acc[ct][pt], 0, 0, 0);
        }
#pragma unroll
        for (int pt = 0; pt < 4; ++pt) { const int p = pb * 64 + pt * 16 + ln; const float bsv = bs[g * 128 + p];
#pragma unroll
            for (int ct = 0; ct < 2; ++ct) { const int c = g * 128 + cb * 32 + ct * 16 + quad * 4;
                bf16_t* up = proj + (size_t)(chunk * 128 + p) * NPROJ + PC_U + c;
                const u32x2 w = xw[pt][ct];
                const float u0 = gelu1(bf_lo(w.x)), u1 = gelu1(bf_hi(w.x)), u2 = gelu1(bf_lo(w.y)), u3 = gelu1(bf_hi(w.y));
                const f32x4 a = acc[ct][pt];
                u32x2 o; o.x = cvt_pk_bf16(u0 * (a[0] + bsv), u1 * (a[1] + bsv)); o.y = cvt_pk_bf16(u2 * (a[2] + bsv), u3 * (a[3] + bsv));
                if (!sgu_only_dry) *(u32x2*)up = o; else asm volatile("" :: "v"(o)); } }
    }
}

constexpr int NPL = 11, NPHASE = 2 + DEPTH * NPL;
__global__ void __launch_bounds__(NW * 64, 2) fwd_kernel(Args args) {
    extern __shared__ __attribute__((aligned(16))) unsigned char lds[];
    Frame F;
    F.lds = (LAS unsigned char*)lds; F.ldsg = (char*)lds;
    F.G = gridDim.x; F.bx = blockIdx.x; F.NGW = F.G * NW;
    F.in = args.in; F.ws = args.ws; F.out = args.out;
    const float* mod = (const float*)(F.ws + WS_MOD);
    bf16_t* act = (bf16_t*)(F.ws + WS_ACT); bf16_t* proj = (bf16_t*)(F.ws + WS_PROJ);
    volatile LAS unsigned* bst = (volatile LAS unsigned*)(F.lds + 131072 + 64);
    unsigned* barw = (unsigned*)(F.ws + WS_BAR);
    const int wave0 = __builtin_amdgcn_readfirstlane((int)threadIdx.x >> 6);
    { unsigned z0 = 0u; asm volatile("" : "+v"(z0)); int t0 = wave0 * 64 + (int)__builtin_amdgcn_mbcnt_hi(~0u, __builtin_amdgcn_mbcnt_lo(~0u, z0));
      if (t0 < 2) bst[t0] = 0u;
      if (blockIdx.x == 0 && args.ph_lo == 0) { for (int i = t0; i < XCD_BAR_WORDS; i += NW * 64) barw[i] = 0u;
        unsigned* cw = (unsigned*)(F.ws + WS_CNT); for (int i = t0; i < CNT_WORDS; i += NW * 64) cw[i] = 0u; } }
    __syncthreads();
    XcdBarrier xbar; xbar.bar = barw; xbar.x = 0; xbar.st = bst;
    for (int ph = args.ph_lo; ph < args.ph_hi; ++ph) {
        { unsigned zz = 0u; asm volatile("" : "+v"(zz)); const int lanev = (int)__builtin_amdgcn_mbcnt_hi(~0u, __builtin_amdgcn_mbcnt_lo(~0u, zz));
          F.lane = lanev; F.wave = wave0; F.tid = wave0 * 64 + lanev; F.gw = F.bx * NW + F.wave; }

#ifndef PHMASK
#define PHMASK 0xffff
#endif
        if (ph == 0) { if (PHMASK & 1) phase_prologue(F); if (PROBE == 4) { __syncthreads(); phase_prologue(F); } }
        else if (ph == 1) { if (PHMASK & 2) phase_h0(F); if (PROBE == 4) phase_h0(F); }
        else {
            const int l = (ph - 2) / NPL, s = (ph - 2) % NPL;
            if (s < 8) {
                const int part = s >> 2, q = s & 3;
                if (q == 0) { if (PHMASK & 4) {
                    pg8::Gemm g{}; g.A = act + (size_t)part_row0(part) * DM; g.Bt = (const bf16_t*)(F.ws + WS_WIN) + (size_t)l * NPROJ * DM; g.lda = DM; g.ldb = DM;
                    g.nM = part_rows(part) / 256; g.nN = NPROJ / 256; g.nseg = 1; g.k0[0] = 0; g.nt[0] = 16; g.k0[1] = 0; g.nt[1] = 16; g.k0[2] = 0; g.nt[2] = 16;
                    pg8::Order S; S.init(g.nM, g.nN, 1, F.G, F.bx, 0, STAGGER);
                    pg8::EpiStore E{proj, NPROJ, PC_G};
                    if (PROBE == 2) { pg8::EpiNone E0; pg8::gemm_phase<pg8::EpiNone>(F.lds, g, S, E0, F.tid); }
                    if (PROBE == 7) pg8::gemm_phase<pg8::EpiStore>(F.lds, g, S, E, F.tid);
                    pg8::gemm_phase<pg8::EpiStore>(F.lds, g, S, E, F.tid); }
                } else if (q == 1) { if (PROBE == 5) phase_mid(F, l, part, true); if (PHMASK & 8) phase_mid(F, l, part, false); }
                else if (q == 2) { if (PROBE == 6) phase_attn(F, l, part, true); if (PHMASK & 16) phase_attn(F, l, part, false); }
                else if (PHMASK & 32) {
                    pg8::Gemm g{}; g.A = proj; g.Bt = (const bf16_t*)(F.ws + WS_WM) + (size_t)l * DM * 2048; g.lda = NPROJ; g.ldb = 2048;
                    g.nM = part_rows(part) / 256; g.nN = 4; g.nseg = 3; g.k0[0] = 0; g.nt[0] = 16; g.k0[1] = 1024; g.nt[1] = 8; g.k0[2] = 1536; g.nt[2] = 8;
                    pg8::Order S; S.init(g.nM, g.nN, 3, F.G, F.bx);
                    pg8::EpiGate E{F.lds + LDS_XCH, proj, act + (size_t)part_row0(part) * DM, DM};
                    if (PROBE == 2) { pg8::EpiNone E0; pg8::gemm_phase<pg8::EpiNone>(F.lds, g, S, E0, F.tid); }
                    pg8::gemm_phase<pg8::EpiGate>(F.lds, g, S, E, F.tid);
                }
            } else if (s == 8) { if (PHMASK & 64) {
                pg8::Gemm g{}; g.A = act; g.Bt = (const bf16_t*)(F.ws + WS_WOUT) + (size_t)l * DM * DM; g.lda = DM; g.ldb = DM;
                g.nM = T_ALL / 256; g.nN = 4; g.nseg = 1; g.k0[0] = 0; g.nt[0] = 16; g.k0[1] = 0; g.nt[1] = 16; g.k0[2] = 0; g.nt[2] = 16;
                pg8::Order S; S.init(g.nM, g.nN, 1, F.G, F.bx, 1);
                if (l == 0) { pg8::EpiResidLn<0, true, false> E{F.in, F.ws, F.out, l, F.lds + LDS_XCH}; pg8::gemm_phase<pg8::EpiResidLn<0, true, false>>(F.lds, g, S, E, F.tid); }
                else { pg8::EpiResidLn<0, false, false> E{F.in, F.ws, F.out, l, F.lds + LDS_XCH}; pg8::gemm_phase<pg8::EpiResidLn<0, false, false>>(F.lds, g, S, E, F.tid); } }
            } else if (s == 9) { if (PHMASK & 256) {
                pg8::Gemm g{}; g.A = act; g.Bt = (const bf16_t*)(F.ws + WS_WF1) + (size_t)l * 2 * DFF * DM; g.lda = DM; g.ldb = DM;
                g.nM = T_ALL / 256; g.nN = 2 * DFF / 256; g.nseg = 1; g.k0[0] = 0; g.nt[0] = 16; g.k0[1] = 0; g.nt[1] = 16; g.k0[2] = 0; g.nt[2] = 16;
                pg8::Order S; S.init(g.nM, g.nN, 1, F.G, F.bx, 0, STAGGER);
                pg8::EpiSwiGLU E{proj, DFF};
                if (PROBE == 2) { pg8::EpiNone E0; pg8::gemm_phase<pg8::EpiNone>(F.lds, g, S, E0, F.tid); }
                if (PROBE == 7) pg8::gemm_phase<pg8::EpiSwiGLU>(F.lds, g, S, E, F.tid);
                pg8::gemm_phase<pg8::EpiSwiGLU>(F.lds, g, S, E, F.tid); }
            } else { if (PHMASK & 512) {
                pg8::Gemm g{}; g.A = proj; g.Bt = (const bf16_t*)(F.ws + WS_WF2) + (size_t)l * DM * DFF; g.lda = DFF; g.ldb = DFF;
                g.nM = T_ALL / 256; g.nN = 4; g.nseg = 1; g.k0[0] = 0; g.nt[0] = 44; g.k0[1] = 0; g.nt[1] = 44; g.k0[2] = 0; g.nt[2] = 44;
                pg8::Order S; S.init(g.nM, g.nN, 1, F.G, F.bx, 1);
                if (l + 1 < DEPTH) { pg8::EpiResidLn<1, false, false> E{F.in, F.ws, F.out, l, F.lds + LDS_XCH}; pg8::gemm_phase<pg8::EpiResidLn<1, false, false>>(F.lds, g, S, E, F.tid); }
                else { pg8::EpiResidLn<1, false, true> E{F.in, F.ws, F.out, l, F.lds + LDS_XCH}; pg8::gemm_phase<pg8::EpiResidLn<1, false, true>>(F.lds, g, S, E, F.tid); } }
            }
        }
        if (ph + 1 < args.ph_hi) {
            if (ph == args.ph_lo) { cg::this_grid().sync(); xbar = xcd_barrier_post(barw, bst); }
            else xcd_barrier(xbar);
            if (PROBE == 1 && ph == 1) { for (int k = 0; k < 20; ++k) xcd_barrier(xbar); }
        }
    }
}

extern "C" void kernel_launch(void* const* d_in, const int* in_sizes, int n_in, void* d_out, int out_size, void* d_ws, size_t ws_size, hipStream_t stream) {
    static int grid = 0;
    if (grid == 0) {
        if (n_in != 25 || ws_size < WS_END) { fprintf(stderr, "kernel_launch: unexpected n_in %d / ws %zu\n", n_in, ws_size); grid = -1; return; }
        int dev = 0, cus = 0, per_cu = 0;
        if (hipGetDevice(&dev) != hipSuccess || hipDeviceGetAttribute(&cus, hipDeviceAttributeMultiprocessorCount, dev) != hipSuccess) { grid = -1; return; }
        if (hipFuncSetAttribute((const void*)fwd_kernel, hipFuncAttributeMaxDynamicSharedMemorySize, LDS_BYTES) != hipSuccess) { fprintf(stderr, "kernel_launch: hipFuncSetAttribute failed\n"); grid = -1; return; }
        if (hipOccupancyMaxActiveBlocksPerMultiprocessor(&per_cu, (const void*)fwd_kernel, NW * 64, LDS_BYTES) != hipSuccess || per_cu < 1) per_cu = 1;
        (void)hipGetLastError();
        grid = cus * (per_cu > 1 ? 1 : per_cu);
    }
    if (grid < 0) return;
    Args a{};
    for (int i = 0; i < 25; ++i) a.in[i] = (const float*)d_in[i];
    a.out = (float*)d_out; a.ws = (unsigned char*)d_ws;
#if MK_MULTI
    for (int ph = 0; ph < NPHASE; ++ph) { a.ph_lo = ph; a.ph_hi = ph + 1; hipLaunchKernelGGL(fwd_kernel, dim3(grid), dim3(NW * 64), LDS_BYTES, stream, a); }
#else
    a.ph_lo = 0; a.ph_hi = NPHASE;
    void* kargs[] = {&a};
    hipError_t e = hipLaunchCooperativeKernel((const void*)fwd_kernel, dim3(grid), dim3(NW * 64), kargs, LDS_BYTES, stream);
    if (e != hipSuccess) fprintf(stderr, "cooperative launch failed: %s (grid %d)\n", hipGetErrorString(e), grid);
#endif
}
```

```cpp
#include <hip/hip_runtime.h>
#include <hip/hip_bf16.h>
#include <hip/hip_cooperative_groups.h>
#include <cstdio>
#include <cstdint>
namespace cg = cooperative_groups;

#ifndef PROBE
#define PROBE 0
#endif
#ifndef STAGGER
#define STAGGER 0
#endif
#ifndef GATE_PF
#define GATE_PF false
#endif
#ifndef MK_MULTI
#define MK_MULTI 0
#endif

#define LAS __attribute__((address_space(3)))
typedef unsigned short bf16_t;
typedef short bf16x8 __attribute__((ext_vector_type(8)));
typedef short s16x4 __attribute__((ext_vector_type(4)));
typedef float f32x2 __attribute__((ext_vector_type(2)));
typedef float f32x4 __attribute__((ext_vector_type(4)));
typedef float f32x16 __attribute__((ext_vector_type(16)));
typedef unsigned u32x2 __attribute__((ext_vector_type(2)));
typedef unsigned u32x4 __attribute__((ext_vector_type(4)));

constexpr int DM = 1024, NPROJ = 6144, DFF = 2816, DEPTH = 2;
constexpr int T_CTX = 4096, T_ALL = 36864;
constexpr int CTX_S = 256, LAT_S = 4096, PAST = 512, SKV_LAT = 4608;
constexpr int PC_Q = 0, PC_U = 1024, PC_K = 1536, PC_V = 1792, PC_XV = 2048, PC_XP = 2560, PC_G = 3072;
constexpr float LN_EPS = 1e-6f;
constexpr float ALPHA = 1.41421356237309515f;
constexpr int NW = 8;
__host__ __device__ constexpr int part_row0(int p) { return p == 0 ? 0 : 20480; }
__host__ __device__ constexpr int part_rows(int p) { return p == 0 ? 20480 : 16384; }

constexpr size_t MiB = 1u << 20;
constexpr size_t WS_MOD = 0;
constexpr size_t WS_BAR = 448 * 1024;
constexpr size_t WS_ROPE = 512 * 1024;
constexpr size_t WS_WSGU = 768 * 1024;
constexpr size_t WS_WIN = 1 * MiB;
constexpr size_t WS_WM = 25 * MiB;
constexpr size_t WS_WOUT = 33 * MiB;
constexpr size_t WS_WF1 = 37 * MiB;
constexpr size_t WS_WF2 = 59 * MiB;
constexpr size_t WS_ACT = 70 * MiB;
constexpr size_t WS_PROJ = 142 * MiB;
constexpr size_t WS_KL = 382 * MiB, WS_VL = 391 * MiB;
constexpr size_t WS_KC = 400 * MiB, WS_VC = 402 * MiB;
constexpr size_t WS_VRT = 404 * MiB;
constexpr size_t WS_XBUF = 424 * MiB;
constexpr size_t WS_CNT = 426 * MiB;
constexpr int CNT_WORDS = 4 * 144 * 64;
constexpr size_t WS_XB = 427 * MiB;
constexpr size_t WS_END = 499 * MiB;

constexpr int LDS_BYTES = 143360;
constexpr int LDS_XCH = 131072 + 256;

__device__ __forceinline__ unsigned cvt_pk_bf16(float lo, float hi) { unsigned r; asm volatile("v_cvt_pk_bf16_f32 %0, %1, %2" : "=v"(r) : "v"(lo), "v"(hi)); return r; }
__device__ __forceinline__ float bf_lo(unsigned u) { return __uint_as_float(u << 16); }
__device__ __forceinline__ float bf_hi(unsigned u) { return __uint_as_float(u & 0xffff0000u); }
__device__ __forceinline__ float wave_sum(float v) {
#pragma unroll
    for (int o = 1; o < 64; o <<= 1) v += __shfl_xor(v, o);
    return v;
}
__device__ __forceinline__ float gelu1(float v) {
    const float av = fabsf(v), d = av * 0.2316418882f + 1.0f;
    const float t = __builtin_amdgcn_rcpf(d);
    float q = t * 0.5307027145f + (-0.7265760135f); q = q * t + 0.7107068705f; q = q * t + (-0.142248368f); q = q * t + 0.127414796f; q = q * t;
    const float e = __builtin_amdgcn_exp2f((v * v) * (-0.72134752044f));
    const float m = v * (q * e), r = v - m;
    return v < 0.f ? m : r;
}
__device__ __forceinline__ float sigmoidf_(float x) { return __builtin_amdgcn_rcpf(1.0f + __expf(-x)); }

namespace pg8 {
constexpr int BM = 256, BK = 64, HALF = 128, HTB = HALF * BK * 2, STAGE_BYTES = 8 * HTB, NXCD = 8, WGM = 8;
__host__ __device__ __forceinline__ int lds_byte(int r, int c) { const int st = (r >> 4) * 2 + (c >> 5), rr = r & 15, cc = c & 31, ob = rr * 64 + cc * 2; return st * 1024 + (ob ^ (((ob >> 9) & 1) << 5)); }
__host__ __device__ __forceinline__ void stage_rc(int b, int& R, int& C) { const int st = b / 1024, sb = b % 1024, swz = sb ^ (((sb >> 9) & 1) << 5); R = (st >> 1) * 16 + swz / 64; C = (st & 1) * 32 + (swz % 64) / 2; }
__host__ __device__ __forceinline__ int perm32(int rho) { const int n = rho >> 4, i = rho & 15; return 8 * (i >> 2) + 4 * n + (i & 3); }

struct Unit { int pm, pn, seg; };
struct Gemm { const bf16_t* A; const bf16_t* Bt; int lda, ldb, nM, nN, nseg; int k0[3]; int nt[3]; };

struct Order {
    int nM, nN, nwg, G, c, nseg, team, stagger;
    __device__ void init(int nM_, int nN_, int nseg_, int G_, int c_, int team_ = 0, int stagger_ = 0) { nM = nM_; nN = nN_; nwg = nM * nN; G = G_; c = c_; nseg = nseg_; team = team_; stagger = stagger_; }
    __device__ bool next(int i, Unit& u) const {
        if (team) {
            u.seg = 0; const int j = c >> 3; u.pn = j & 3; u.pm = i * (G >> 2) + (j >> 2) * 8 + (c & 7); return u.pm < nM;
        }
        const int ti = i / nseg; u.seg = i - ti * nseg;
        const long L = (long)ti * G + c; if (L >= nwg) return false;
        int wgid = (int)L; { const int q = nwg / NXCD, r = nwg % NXCD, xcd = wgid % NXCD, off = wgid / NXCD; wgid = (xcd < r ? xcd * (q + 1) : r * (q + 1) + (xcd - r) * q) + off; }
        const int nig = WGM * nN, gid = wgid / nig, fm = gid * WGM, gsz = (nM - fm) < WGM ? (nM - fm) : WGM;
        u.pm = fm + ((wgid % nig) % gsz); u.pn = (wgid % nig) / gsz; return true;
    }
};

struct EpiStore {
    static constexpr bool PREFETCH = false;
    static constexpr bool PERM = true;
    bf16_t* O; int ldc; int gate_col0;
    __device__ __forceinline__ void run(f32x4 (&acc)[2][2][4][2], const Unit& u, int wr, int wc, int fr, int fq) const {
        const int row0 = u.pm * BM + wr * 64 + fr; const int col0 = u.pn * BM + wc * 32 + 8 * fq;
        const bool gate = u.pn * BM >= gate_col0;
#pragma unroll
        for (int ai = 0; ai < 2; ++ai)
#pragma unroll
            for (int m = 0; m < 4; ++m) { bf16_t* rowp = O + (size_t)(row0 + ai * HALF + m * 16) * ldc + col0;
#pragma unroll
                for (int bj = 0; bj < 2; ++bj) { f32x4 v0 = acc[ai][bj][m][0], v1 = acc[ai][bj][m][1];
                    if (gate) {
#pragma unroll
                        for (int e = 0; e < 4; ++e) { v0[e] = 1.0f + __expf(-fmaxf(v0[e], -80.f)); v1[e] = 1.0f + __expf(-fmaxf(v1[e], -80.f)); } }
                    u32x4 w; w.x = cvt_pk_bf16(v0[0], v0[1]); w.y = cvt_pk_bf16(v0[2], v0[3]); w.z = cvt_pk_bf16(v1[0], v1[1]); w.w = cvt_pk_bf16(v1[2], v1[3]);
                    *(u32x4*)(rowp + bj * HALF) = w; } }
    }
};
struct EpiSwiGLU {
    static constexpr bool PREFETCH = false;
    static constexpr bool PERM = true;
    bf16_t* O; int ldc;
    __device__ __forceinline__ void run(f32x4 (&acc)[2][2][4][2], const Unit& u, int wr, int wc, int fr, int fq) const {
        const int row0 = u.pm * BM + wr * 64 + fr; const int col0 = u.pn * HALF + wc * 32 + 8 * fq;
#pragma unroll
        for (int ai = 0; ai < 2; ++ai)
#pragma unroll
            for (int m = 0; m < 4; ++m) { bf16_t* rowp = O + (size_t)(row0 + ai * HALF + m * 16) * ldc + col0;
                float o[8];
#pragma unroll
                for (int n = 0; n < 2; ++n)
#pragma unroll
                    for (int e = 0; e < 4; ++e) { const float a = acc[ai][0][m][n][e], b = acc[ai][1][m][n][e]; o[n * 4 + e] = a * sigmoidf_(a) * b; }
                u32x4 w; w.x = cvt_pk_bf16(o[0], o[1]); w.y = cvt_pk_bf16(o[2], o[3]); w.z = cvt_pk_bf16(o[4], o[5]); w.w = cvt_pk_bf16(o[6], o[7]);
                *(u32x4*)rowp = w; }
    }
};
struct EpiResid {
    static constexpr bool PREFETCH = false;
    static constexpr bool PERM = false;
    const float* xres_ctx; const float* xres_lat;
    float* out; const float* mod; int goff;
    __device__ __forceinline__ void run(f32x4 (&acc)[2][2][4][2], const Unit& u, int wr, int wc, int fr, int fq) const {
        const int v = u.pm < 16 ? 0 : 1 + ((u.pm - 16) >> 4);
        const float* xb = u.pm < 16 ? xres_ctx + (size_t)u.pm * BM * DM : xres_lat + (size_t)(u.pm - 16) * BM * DM;
        float* ob = out + (size_t)u.pm * BM * DM;
        const int col0 = u.pn * BM + wc * 32 + 4 * fq;
        const float* gp = mod + v * 6144 + goff + col0;
        f32x4 gv[2][2];
#pragma unroll
        for (int bj = 0; bj < 2; ++bj)
#pragma unroll
            for (int n = 0; n < 2; ++n) gv[bj][n] = *(const f32x4*)(gp + bj * HALF + n * 16);
#pragma unroll
        for (int ai = 0; ai < 2; ++ai)
#pragma unroll
            for (int m = 0; m < 4; ++m) { const size_t off = (size_t)(ai * HALF + wr * 64 + m * 16 + fr) * DM + col0;
#pragma unroll
                for (int bj = 0; bj < 2; ++bj)
#pragma unroll
                    for (int n = 0; n < 2; ++n) { const f32x4 x = *(const f32x4*)(xb + off + bj * HALF + n * 16);
                        *(f32x4*)(ob + off + bj * HALF + n * 16) = x * ALPHA + gv[bj][n] * acc[ai][bj][m][n]; } }
    }
};

struct PanelStats {
    unsigned long long* xbuf;
    unsigned* cnt;
    LAS unsigned char* lx;
    __device__ __forceinline__ void run(const f32x4 (&v)[2][2][4][2], const Unit& u, int wr, int wc, int fr, int fq, int wid, int lane) const {
        LAS f32x2* P = (LAS f32x2*)lx; LAS f32x2* S = (LAS f32x2*)(lx + 8192);
#pragma unroll
        for (int ai = 0; ai < 2; ++ai)
#pragma unroll
            for (int m = 0; m < 4; ++m) {
                float s = 0.f;
#pragma unroll
                for (int bj = 0; bj < 2; ++bj)
#pragma unroll
                    for (int n = 0; n < 2; ++n) { const f32x4 x = v[ai][bj][m][n]; s += (x[0] + x[1]) + (x[2] + x[3]); }
                s += __shfl_xor(s, 16); s += __shfl_xor(s, 32);
                const float mw = s * (1.0f / 64.0f); float q = 0.f;
#pragma unroll
                for (int bj = 0; bj < 2; ++bj)
#pragma unroll
                    for (int n = 0; n < 2; ++n) { const f32x4 d = v[ai][bj][m][n] - mw; q += (d[0] * d[0] + d[1] * d[1]) + (d[2] * d[2] + d[3] * d[3]); }
                q += __shfl_xor(q, 16); q += __shfl_xor(q, 32);
                if (fq == 0) P[(ai * HALF + wr * 64 + m * 16 + fr) * 4 + wc] = (f32x2){mw, q};
            }
        asm volatile("s_waitcnt lgkmcnt(0)" ::: "memory"); __builtin_amdgcn_s_barrier(); asm volatile("" ::: "memory");
        const int row = wid * 32 + (lane & 31);
        if (lane < 32) {
            const f32x2 a = P[row * 4 + 0], b = P[row * 4 + 1], c = P[row * 4 + 2], d = P[row * 4 + 3];
            const float mt = (a.x + b.x + c.x + d.x) * 0.25f;
            const float da = a.x - mt, db = b.x - mt, dc = c.x - mt, dd = d.x - mt;
            const float m2 = (a.y + b.y) + (c.y + d.y) + 64.0f * ((da * da + db * db) + (dc * dc + dd * dd));
            unsigned long long* slot = xbuf + ((size_t)(u.pm * BM + row) * 4 + u.pn);
            __hip_atomic_store(slot, ((unsigned long long)__float_as_uint(m2) << 32) | __float_as_uint(mt), __ATOMIC_RELAXED, __HIP_MEMORY_SCOPE_AGENT);
        }
        asm volatile("s_waitcnt vmcnt(0)" ::: "memory");
        if (lane == 0) __hip_atomic_fetch_add(cnt + 64 * u.pm, 1u, __ATOMIC_RELAXED, __HIP_MEMORY_SCOPE_AGENT);
        if (wid == 0) {
            unsigned sp = 0;
            for (;;) {
                if ((unsigned)__builtin_amdgcn_readfirstlane(__hip_atomic_load(cnt + 64 * u.pm, __ATOMIC_RELAXED, __HIP_MEMORY_SCOPE_AGENT)) >= 32u) break;
                if (++sp > (1u << 22)) break;
                __builtin_amdgcn_s_sleep(2);
            }
            __builtin_amdgcn_fence(__ATOMIC_ACQUIRE, "agent");
        }
        asm volatile("s_waitcnt vmcnt(0) lgkmcnt(0)" ::: "memory"); __builtin_amdgcn_s_barrier(); asm volatile("" ::: "memory");
        if (lane < 32) {
            const unsigned long long* slot = xbuf + (size_t)(u.pm * BM + row) * 4; float mt[4], m2[4]; float ms = 0.f;
#pragma unroll
            for (int t = 0; t < 4; ++t) { const unsigned long long w = __hip_atomic_load(slot + t, __ATOMIC_RELAXED, __HIP_MEMORY_SCOPE_AGENT); mt[t] = __uint_as_float((unsigned)w); m2[t] = __uint_as_float((unsigned)(w >> 32)); ms += mt[t]; }
            const float mean = ms * 0.25f; float q = 0.f;
#pragma unroll
            for (int t = 0; t < 4; ++t) { const float dm = mt[t] - mean; q += m2[t] + 256.0f * dm * dm; }
            S[row] = (f32x2){mean, rsqrtf(q * (1.0f / 1024.0f) + LN_EPS)};
        }
        asm volatile("s_waitcnt lgkmcnt(0)" ::: "memory"); __builtin_amdgcn_s_barrier(); asm volatile("" ::: "memory");
    }
};
template <int WHICH, bool INF32, bool OUTF32>
struct EpiResidLn {
    static constexpr bool PERM = false;
    static constexpr bool PREFETCH = false;
    const float* const* in; unsigned char* ws; float* out_; int l; LAS unsigned char* lx;
    __device__ __forceinline__ void prefetch(const Unit& u, int it, int nit, int wid, int lane_) const {
        int lane = lane_; asm volatile("" : "+v"(lane));
        const float* xb = (WHICH == 0 && l == 0) ? (u.pm < 16 ? in[0] + (size_t)u.pm * BM * DM : in[1] + (size_t)(u.pm - 16) * BM * DM) : out_ + (size_t)u.pm * BM * DM;
        const int R = nit >= 16 ? 2 : 4;
#pragma unroll
        for (int k = 0; k < 4; ++k) { const int j = it * R + k;
            if (k < R && j < 32) __builtin_amdgcn_global_load_lds((const unsigned*)(xb + (size_t)(j * 8 + wid) * DM + u.pn * BM + lane * 4), (LAS unsigned*)(lx + 10240), 16, 0, 0); }
    }
    __device__ __forceinline__ void run(f32x4 (&acc)[2][2][4][2], const Unit& u, int wr, int wc, int fr_, int fq_) const {
        int fr = fr_, fq = fq_; asm volatile("" : "+v"(fr), "+v"(fq));
        int lv = l; asm volatile("" : "+v"(lv)); lv = __builtin_amdgcn_readfirstlane(lv);
        const float* mod = (const float*)(ws + 0) + lv * 9 * 6144;
        float* out = out_;
        const float* xres_ctx = (WHICH == 0 && lv == 0) ? in[0] : out;
        const float* xres_lat = (WHICH == 0 && lv == 0) ? in[1] : out + (size_t)T_CTX * DM;
        const int goff = WHICH == 0 ? 2048 : 5120;
        const float* lg = in[WHICH == 0 ? 19 : 23] + lv * DM; const float* lb = in[WHICH == 0 ? 20 : 24] + lv * DM;
        bf16_t* act = (bf16_t*)(ws + (size_t)70 * 1048576);
        const float* modn = WHICH == 0 ? mod : (const float*)(ws + 0) + (lv + 1 < DEPTH ? lv + 1 : lv) * 9 * 6144;
        const int sh_off = WHICH == 0 ? 3072 : 0, sc_off = WHICH == 0 ? 4096 : 1024;
        PanelStats st{(unsigned long long*)(ws + (size_t)424 * 1048576), (unsigned*)(ws + (size_t)426 * 1048576) + (lv * 2 + WHICH) * 144 * 64, lx};
        const int v = u.pm < 16 ? 0 : 1 + ((u.pm - 16) >> 4);
        const float* xb = u.pm < 16 ? xres_ctx + (size_t)u.pm * BM * DM : xres_lat + (size_t)(u.pm - 16) * BM * DM;
        float* ob = out + (size_t)u.pm * BM * DM;
        bf16_t* xs = (bf16_t*)(ws + (size_t)427 * 1048576);
        const int col0 = u.pn * BM + wc * 32 + 4 * fq;
        const size_t roff = (size_t)(wr * 64 + fr) * DM + col0;
        {
            const float* gp = mod + v * 6144 + goff + col0;
            if constexpr (INF32) {
#pragma unroll
                for (int bj = 0; bj < 2; ++bj)
#pragma unroll
                    for (int n = 0; n < 2; ++n) { const f32x4 gv = *(const f32x4*)(gp + bj * HALF + n * 16);
#pragma unroll
                        for (int ai = 0; ai < 2; ++ai) {
#pragma unroll
                            for (int m = 0; m < 4; ++m) { const size_t o_ = roff + (size_t)(ai * HALF + m * 16) * DM + bj * HALF + n * 16;
                                const f32x4 x = *(const f32x4*)(xb + o_); acc[ai][bj][m][n] = x * ALPHA + gv * acc[ai][bj][m][n]; }
#pragma unroll
                            for (int m = 0; m < 4; ++m) asm volatile("" : "+v"(acc[ai][bj][m][n]));
                            asm volatile("" ::: "memory"); } }
            } else {
                u32x2 xw[2][2][2][4];
                const bf16_t* xp_ = xs + (size_t)u.pm * BM * DM + roff;
#pragma unroll
                for (int bj = 0; bj < 2; ++bj)
#pragma unroll
                    for (int n = 0; n < 2; ++n)
#pragma unroll
                        for (int ai = 0; ai < 2; ++ai)
#pragma unroll
                            for (int m = 0; m < 4; ++m) xw[bj][n][ai][m] = *(const u32x2*)(xp_ + (size_t)(ai * HALF + m * 16) * DM + bj * HALF + n * 16);
#pragma unroll
                for (int bj = 0; bj < 2; ++bj)
#pragma unroll
                    for (int n = 0; n < 2; ++n) { const f32x4 gv = *(const f32x4*)(gp + bj * HALF + n * 16);
#pragma unroll
                        for (int ai = 0; ai < 2; ++ai)
#pragma unroll
                            for (int m = 0; m < 4; ++m) { const u32x2 w = xw[bj][n][ai][m]; const f32x4 x = (f32x4){bf_lo(w.x), bf_hi(w.x), bf_lo(w.y), bf_hi(w.y)};
                                acc[ai][bj][m][n] = x * ALPHA + gv * acc[ai][bj][m][n]; } }
            }
        }
        const int lane = fq * 16 + fr, wid = wr * 4 + wc;
        st.run(acc, u, wr, wc, fr, fq, wid, lane);
        const LAS f32x2* S = (const LAS f32x2*)(st.lx + 8192);
        const float* mv = modn + v * 6144;
#pragma unroll
        for (int bj = 0; bj < 2; ++bj)
#pragma unroll
            for (int n = 0; n < 2; ++n) { const int c = col0 + bj * HALF + n * 16;
                const f32x4 g4 = *(const f32x4*)(lg + c), b4 = *(const f32x4*)(lb + c);
                f32x4 sh = (f32x4){0.f, 0.f, 0.f, 0.f}, sc = sh;
                sh = *(const f32x4*)(mv + sh_off + c); sc = *(const f32x4*)(mv + sc_off + c) + 1.0f;
#pragma unroll
                for (int ai = 0; ai < 2; ++ai)
#pragma unroll
                    for (int m = 0; m < 4; ++m) { const size_t off = roff + (size_t)(ai * HALF + m * 16) * DM + bj * HALF + n * 16;
                        const f32x2 sr = S[ai * HALF + wr * 64 + m * 16 + fr];
                        const f32x4 y = (acc[ai][bj][m][n] - sr.x) * sr.y * g4 + b4;
                        if (OUTF32) *(f32x4*)(ob + off) = y;
                        else { u32x2 w; w.x = cvt_pk_bf16(y[0], y[1]); w.y = cvt_pk_bf16(y[2], y[3]); *(u32x2*)(xs + (size_t)u.pm * BM * DM + off) = w; }
                        if (WHICH == 0 || lv + 1 < DEPTH) { const f32x4 h = y * sc + sh; u32x2 w; w.x = cvt_pk_bf16(h[0], h[1]); w.y = cvt_pk_bf16(h[2], h[3]);
                            *(u32x2*)(act + (size_t)u.pm * BM * DM + off) = w; } }
                asm volatile("" ::: "memory"); }
    }
};
struct EpiGate {
    static constexpr bool PERM = true;
    static constexpr bool PREFETCH = GATE_PF;
    LAS unsigned char* lx;
    __device__ __forceinline__ void prefetch(const Unit& u, int it, int nit, int wid, int lane_) const {
        if (u.seg == 2) return;
        int lane = lane_; asm volatile("" : "+v"(lane));
        const bf16_t* gb = P + (size_t)u.pm * BM * NPROJ + PC_G + u.pn * BM + (lane & 31) * 8;
#pragma unroll
        for (int k = 0; k < 4; ++k) { const int j = it * 4 + k;
            const int tile = u.seg == 0 ? (j >> 4) : 0; const int goff = u.seg == 0 ? (tile == 0 ? 0 : 2048) : 1024; const int jr = j & 15;
            if (j < (u.seg == 0 ? 32 : 16)) __builtin_amdgcn_global_load_lds((const unsigned*)(gb + (size_t)(jr * 16 + wid * 2 + (lane >> 5)) * NPROJ + goff), (LAS unsigned*)(lx + 10240), 16, 0, 0); }
    }
    const bf16_t* P;
    bf16_t* O; int ldc;
    __device__ __forceinline__ void run(f32x4 (&acc)[2][2][4][2], const Unit& u, int wr, int wc, int fr_, int fq_) const {
        int fr = fr_, fq = fq_; asm volatile("" : "+v"(fr), "+v"(fq));
        const int row0 = u.pm * BM + wr * 64 + fr; const int col0 = u.pn * BM + wc * 32 + 8 * fq;
        const bf16_t* gbase = P + (size_t)row0 * NPROJ + PC_G + col0;
        const bool last = u.seg == 2;
        const int noff = u.seg == 0 ? 0 : (u.seg == 1 ? 2048 : 1024), doff = u.seg == 0 ? 2048 : 1024;
#pragma unroll
        for (int am = 0; am < 2; ++am) { const int ai = am, mb = 0;
            u32x4 gn[4][2], gd[4][2];
#pragma unroll
            for (int mm = 0; mm < 4; ++mm)
#pragma unroll
                for (int bj = 0; bj < 2; ++bj) { const bf16_t* gp = gbase + (size_t)(ai * HALF + (mb + mm) * 16) * NPROJ + bj * HALF;
                    gn[mm][bj] = *(const u32x4*)(gp + noff); gd[mm][bj] = *(const u32x4*)(gp + doff); }
#pragma unroll
            for (int mm = 0; mm < 4; ++mm)
#pragma unroll
                for (int bj = 0; bj < 2; ++bj) { const int m = mb + mm; f32x4 v0 = acc[ai][bj][m][0], v1 = acc[ai][bj][m][1];
#pragma unroll
                    for (int e = 0; e < 2; ++e) {
                        v0[2 * e]     *= (last ? 1.0f : bf_lo(gd[mm][bj][e])) * __builtin_amdgcn_rcpf(bf_lo(gn[mm][bj][e]));
                        v0[2 * e + 1] *= (last ? 1.0f : bf_hi(gd[mm][bj][e])) * __builtin_amdgcn_rcpf(bf_hi(gn[mm][bj][e]));
                        v1[2 * e]     *= (last ? 1.0f : bf_lo(gd[mm][bj][2 + e])) * __builtin_amdgcn_rcpf(bf_lo(gn[mm][bj][2 + e]));
                        v1[2 * e + 1] *= (last ? 1.0f : bf_hi(gd[mm][bj][2 + e])) * __builtin_amdgcn_rcpf(bf_hi(gn[mm][bj][2 + e])); }
                    acc[ai][bj][m][0] = v0; acc[ai][bj][m][1] = v1;
                    if (last) { u32x4 w; w.x = cvt_pk_bf16(v0[0], v0[1]); w.y = cvt_pk_bf16(v0[2], v0[3]); w.z = cvt_pk_bf16(v1[0], v1[1]); w.w = cvt_pk_bf16(v1[2], v1[3]);
                        *(u32x4*)(O + (size_t)(row0 + ai * HALF + m * 16) * ldc + col0 + bj * HALF) = w; } }
            asm volatile("" ::: "memory");
        }
    }
};

struct EpiNone { static constexpr bool PREFETCH = false; static constexpr bool PERM = true; __device__ __forceinline__ void run(f32x4 (&acc)[2][2][4][2], const Unit& u, int wr, int wc, int fr, int fq) const {
    _Pragma("unroll") for (int a = 0; a < 2; ++a) _Pragma("unroll") for (int b = 0; b < 2; ++b) _Pragma("unroll") for (int m = 0; m < 4; ++m) _Pragma("unroll") for (int n = 0; n < 2; ++n) asm volatile("" :: "v"(acc[a][b][m][n])); } };
template <class Epi>
__device__ __forceinline__ void gemm_phase(LAS unsigned char* lds, const Gemm g, const Order& S, const Epi& E, const int tid) {
    const int wid = __builtin_amdgcn_readfirstlane(tid >> 6), lane = tid & 63, wr = wid >> 2, wc = wid & 3, fr = lane & 15, fq = lane >> 4;
    unsigned voffA[2], voffB[2];
#pragma unroll
    for (int i = 0; i < 2; ++i) { int R, C; stage_rc(tid * 16 + i * 8192, R, C); const int Rb = Epi::PERM ? ((R & ~31) + perm32(R & 31)) : R;
        voffA[i] = (unsigned)(R * g.lda + C) * 2u; voffB[i] = (unsigned)(Rb * g.ldb + C) * 2u; }
    const size_t kstep = (size_t)(BK * 2);
    const size_t hstepA = (size_t)HALF * g.lda * 2, hstepB = (size_t)HALF * g.ldb * 2;
    const size_t tstepA = 2 * hstepA, tstepB = 2 * hstepB;
    const unsigned ldsw = (unsigned)wid * 1024u;
    const int aoff = lds_byte(wr * 64 + fr, fq * 8), boff = lds_byte(wc * 32 + fr, fq * 8);
#define PG8_SA(b, h) (((b) * 2 + (h)) * HTB)
#define PG8_SB(b, h) ((4 + (b) * 2 + (h)) * HTB)
#define PG8_STAGE(bufoff, gbase, voff) do { _Pragma("unroll") for (int _i = 0; _i < 2; ++_i) \
        __builtin_amdgcn_global_load_lds((const unsigned*)((const char*)(gbase) + (voff)[_i]), (LAS unsigned*)(lds + (bufoff) + ldsw + _i * 8192), 16, 0, 0); } while (0)
#define PG8_LDA(dst, b, h) do { _Pragma("unroll") for (int m = 0; m < 4; ++m) _Pragma("unroll") for (int k = 0; k < 2; ++k) dst[m][k] = *(const LAS bf16x8*)(lds + PG8_SA(b, h) + aoff + m * 2048 + k * 1024); } while (0)
#define PG8_LDB(dst, b, h) do { _Pragma("unroll") for (int n = 0; n < 2; ++n) _Pragma("unroll") for (int k = 0; k < 2; ++k) dst[n][k] = *(const LAS bf16x8*)(lds + PG8_SB(b, h) + boff + n * 2048 + k * 1024); } while (0)
#define PG8_MMA(ai, bj, At, Bt) do { __builtin_amdgcn_s_setprio(1); _Pragma("unroll") for (int m = 0; m < 4; ++m) _Pragma("unroll") for (int n = 0; n < 2; ++n) _Pragma("unroll") for (int k = 0; k < 2; ++k) \
        acc[ai][bj][m][n] = __builtin_amdgcn_mfma_f32_16x16x32_bf16(Bt[n][k], At[m][k], acc[ai][bj][m][n], 0, 0, 0); __builtin_amdgcn_s_setprio(0); } while (0)
#define PG8_WAIT_V(n) asm volatile("s_waitcnt vmcnt(" #n ")" ::: "memory")
#define PG8_WAIT_L(n) asm volatile("s_waitcnt lgkmcnt(" #n ")" ::: "memory")
#define PG8_BAR __builtin_amdgcn_s_barrier()
#define PG8_SCHED __builtin_amdgcn_sched_barrier(0)
#define KOF(sg) ((sg) == 0 ? g.k0[0] : ((sg) == 1 ? g.k0[1] : g.k0[2]))
#define NTF(sg) ((sg) == 0 ? g.nt[0] : ((sg) == 1 ? g.nt[1] : g.nt[2]))
    Unit cur, nxt; int ui = 0;
    if (!S.next(0, cur)) return;
    if (S.stagger) {
        const int mine = (S.nwg - S.c + S.G - 1) / S.G, mx = (S.nwg + S.G - 1) / S.G;
        if (mine < mx) { const unsigned long long t0 = __builtin_amdgcn_s_memrealtime(); while (__builtin_amdgcn_s_memrealtime() - t0 < (unsigned long long)S.stagger) __builtin_amdgcn_s_sleep(16); }
    }
    f32x4 acc[2][2][4][2];
#pragma unroll
    for (int a = 0; a < 2; ++a)
#pragma unroll
        for (int b = 0; b < 2; ++b)
#pragma unroll
            for (int m = 0; m < 4; ++m)
#pragma unroll
                for (int n = 0; n < 2; ++n) acc[a][b][m][n] = (f32x4){0.f, 0.f, 0.f, 0.f};
    bf16x8 At[4][2], B0[2][2], B1[2][2];
    const char* cA = (const char*)g.A + (size_t)cur.pm * tstepA + (size_t)KOF(cur.seg) * 2; const char* cB = (const char*)g.Bt + (size_t)cur.pn * tstepB + (size_t)KOF(cur.seg) * 2;
    PG8_STAGE(PG8_SB(0, 0), cB, voffB); PG8_STAGE(PG8_SB(0, 1), cB + hstepB, voffB); PG8_STAGE(PG8_SA(0, 0), cA, voffA); PG8_STAGE(PG8_SA(0, 1), cA + hstepA, voffA);
    if (wr == 1) PG8_BAR;
    PG8_WAIT_V(2); PG8_BAR;
    PG8_STAGE(PG8_SB(1, 0), cB + kstep, voffB); PG8_STAGE(PG8_SA(1, 0), cA + kstep, voffA); PG8_STAGE(PG8_SB(1, 1), cB + hstepB + kstep, voffB);
    PG8_WAIT_V(6); PG8_BAR;
    for (;;) {
        const bool has_next = S.next(ui + 1, nxt);
        const int nt = NTF(cur.seg);
        const char* nA = has_next ? (const char*)g.A + (size_t)nxt.pm * tstepA + (size_t)KOF(nxt.seg) * 2 : cA;
        const char* nB = has_next ? (const char*)g.Bt + (size_t)nxt.pn * tstepB + (size_t)KOF(nxt.seg) * 2 : cB;
        for (int t = 0; t < nt; t += 2) {
            const bool last = (t == nt - 2);
            const char* a1 = cA + (size_t)(t + 1) * kstep;
            const char* a2 = last ? nA : cA + (size_t)(t + 2) * kstep; const char* b2 = last ? nB : cB + (size_t)(t + 2) * kstep;
            const char* a3 = a2 + kstep; const char* b3 = b2 + kstep;
            PG8_LDB(B0, 0, 0); PG8_LDB(B1, 0, 1); PG8_SCHED; PG8_LDA(At, 0, 0); PG8_STAGE(PG8_SA(1, 1), a1 + hstepA, voffA);
            if constexpr (Epi::PREFETCH) E.prefetch(cur, t >> 1, nt >> 1, wid, lane);
            PG8_WAIT_V(8); PG8_WAIT_L(0); PG8_BAR; PG8_MMA(0, 0, At, B0); PG8_MMA(0, 1, At, B1); PG8_BAR; PG8_SCHED;
            PG8_LDA(At, 0, 1); PG8_STAGE(PG8_SB(0, 0), b2, voffB); PG8_STAGE(PG8_SB(0, 1), b2 + hstepB, voffB); PG8_STAGE(PG8_SA(0, 0), a2, voffA);
            PG8_WAIT_V(8); PG8_WAIT_L(0); PG8_BAR; PG8_MMA(1, 0, At, B0); PG8_MMA(1, 1, At, B1); PG8_BAR; PG8_SCHED;
            PG8_LDB(B0, 1, 0); PG8_LDB(B1, 1, 1); PG8_SCHED; PG8_LDA(At, 1, 0); PG8_STAGE(PG8_SA(0, 1), a2 + hstepA, voffA);
            PG8_WAIT_V(8); PG8_WAIT_L(0); PG8_BAR; PG8_MMA(0, 0, At, B0); PG8_MMA(0, 1, At, B1); PG8_BAR; PG8_SCHED;
            PG8_LDA(At, 1, 1); PG8_STAGE(PG8_SB(1, 0), b3, voffB); PG8_STAGE(PG8_SB(1, 1), b3 + hstepB, voffB); PG8_STAGE(PG8_SA(1, 0), a3, voffA);
            PG8_WAIT_V(8); PG8_WAIT_L(0); PG8_BAR; PG8_MMA(1, 0, At, B0); PG8_MMA(1, 1, At, B1); PG8_BAR; PG8_SCHED;
        }
        if (wr == 0) PG8_BAR;
        E.run(acc, cur, wr, wc, fr, fq);
        if (!has_next) break;
        if (cur.seg == g.nseg - 1) {
#pragma unroll
            for (int a = 0; a < 2; ++a)
#pragma unroll
                for (int b = 0; b < 2; ++b)
#pragma unroll
                    for (int m = 0; m < 4; ++m)
#pragma unroll
                        for (int n = 0; n < 2; ++n) acc[a][b][m][n] = (f32x4){0.f, 0.f, 0.f, 0.f};
        }
        cur = nxt; cA = nA; cB = nB; ++ui;
        if (wr == 1) PG8_BAR;
    }
    PG8_WAIT_V(0);
    PG8_BAR;
#undef KOF
#undef NTF
#undef PG8_SA
#undef PG8_SB
#undef PG8_STAGE
#undef PG8_LDA
#undef PG8_LDB
#undef PG8_MMA
#undef PG8_WAIT_V
#undef PG8_WAIT_L
#undef PG8_BAR
#undef PG8_SCHED
}
}

namespace att {
constexpr int D = 128, QBLK = 32, KVBLK = 64;
constexpr float SCALE = 0.088388347648318440f;
constexpr float THR = 8.f;
constexpr size_t SHM_V = KVBLK * D * 2, SHM_K = KVBLK * D * 2, SHM_ATTN = 2 * SHM_V + 2 * SHM_K + NW * 64 * 4;
#define KSWZ(row, colB) ((row) * 256 + ((colB) ^ (((row) & 7) << 4)))
#define SBAR() __builtin_amdgcn_sched_barrier(0)
__device__ __forceinline__ int crow(int r, int hi) { return (r & 3) + 8 * (r >> 2) + 4 * hi; }
__device__ __forceinline__ unsigned cvtpk(float lo, float hi) { unsigned r; asm volatile("v_cvt_pk_bf16_f32 %0, %1, %2" : "=v"(r) : "v"(lo), "v"(hi)); return r; }
__device__ __forceinline__ void partialSM(f32x16& p0, f32x16& p1, float& m_reg, float& mn, float& alpha) {
  constexpr float C = SCALE * 1.4426950408889634f;
  float pmax = p0[0];
#pragma unroll
  for (int r = 1; r < 16; ++r) pmax = fmaxf(pmax, p0[r]);
#pragma unroll
  for (int r = 0; r < 16; ++r) pmax = fmaxf(pmax, p1[r]);
  { auto rr = __builtin_amdgcn_permlane32_swap(__float_as_uint(pmax), __float_as_uint(pmax), false, false);
    pmax = fmaxf(__uint_as_float(rr[0]), __uint_as_float(rr[1])); }
  if (__builtin_expect(__all(pmax - m_reg <= THR / SCALE), 1)) { mn = m_reg; alpha = 1.f; }
  else { mn = fmaxf(m_reg, pmax); alpha = __builtin_amdgcn_exp2f((m_reg - mn) * C); m_reg = mn; }
  float mnC = -mn * C;
#pragma unroll
  for (int r = 0; r < 16; ++r) p0[r] = fmaf(p0[r], C, mnC);
#pragma unroll
  for (int r = 0; r < 16; ++r) p1[r] = fmaf(p1[r], C, mnC);
#pragma unroll
  for (int r = 0; r < 16; ++r) p0[r] = __builtin_amdgcn_exp2f(p0[r]);
}
__device__ __forceinline__ void finishSM(f32x16& p0, f32x16& p1, float alpha, float& l_reg, bf16x8& pa0, bf16x8& pa1, bf16x8& pa2, bf16x8& pa3) {
#pragma unroll
  for (int r = 0; r < 16; ++r) p1[r] = __builtin_amdgcn_exp2f(p1[r]);
  float ps = 0;
#pragma unroll
  for (int r = 0; r < 16; ++r) ps += p0[r];
#pragma unroll
  for (int r = 0; r < 16; ++r) ps += p1[r];
  { auto rr = __builtin_amdgcn_permlane32_swap(__float_as_uint(ps), __float_as_uint(ps), false, false);
    ps = __uint_as_float(rr[0]) + __uint_as_float(rr[1]); }
  l_reg = l_reg * alpha + ps;
#define PK4(P, BASE, OUT) do { unsigned a0 = cvtpk(P[BASE + 0], P[BASE + 1]), a1 = cvtpk(P[BASE + 2], P[BASE + 3]);   \
    unsigned b0 = cvtpk(P[BASE + 4], P[BASE + 5]), b1 = cvtpk(P[BASE + 6], P[BASE + 7]);                              \
    auto r0 = __builtin_amdgcn_permlane32_swap(a0, b0, false, false); auto r1 = __builtin_amdgcn_permlane32_swap(a1, b1, false, false); \
    u32x4 w = {r0[0], r1[0], r0[1], r1[1]}; OUT = *reinterpret_cast<bf16x8*>(&w); } while (0)
  PK4(p0, 0, pa0); PK4(p0, 8, pa1); PK4(p1, 0, pa2); PK4(p1, 8, pa3);
#undef PK4
}
__device__ __forceinline__ void qkt(f32x16& p0, f32x16& p1, const bf16_t* Ks, const bf16x8* qr, int r32, int hi) {
  p0 = f32x16{}; p1 = f32x16{};
#pragma unroll
  for (int d0 = 0; d0 < 8; ++d0) { int cb = (d0 * 16 + hi * 8) * 2;
    bf16x8 b0 = *reinterpret_cast<const bf16x8*>((const char*)Ks + KSWZ(r32, cb));
    bf16x8 b1 = *reinterpret_cast<const bf16x8*>((const char*)Ks + KSWZ(32 + r32, cb));
    p0 = __builtin_amdgcn_mfma_f32_32x32x16_bf16(b0, qr[d0], p0, 0, 0, 0);
    p1 = __builtin_amdgcn_mfma_f32_32x32x16_bf16(b1, qr[d0], p1, 0, 0, 0); }
}
__device__ __forceinline__ int v_st(int k, int c) { const int kk = (k & ~0xC) | ((k & 4) << 1) | ((k & 8) >> 1); return ((kk >> 3) * 4 + (c >> 5)) * 512 + ((kk & 7) * 32 + (c & 31)) * 2; }
__device__ __forceinline__ int v_rd_base(int lane) { return ((lane & 3) << 3) | (((lane >> 2) & 3) << 6) | (((lane >> 4) & 1) << 5) | (((lane >> 5) & 1) << 8); }
constexpr int v_rd_off(int d0, int ks, int half) { return d0 * 512 + ks * 4096 + half * 2048; }
template <int OFF> __device__ __forceinline__ s16x4 tr_read(int vb) {
  s16x4 r; asm volatile("ds_read_b64_tr_b16 %0, %1 offset:%2" : "=&v"(r) : "v"(vb), "i"(OFF) : "memory"); return r;
}
template <int D0> __device__ __forceinline__ void pv_one(f32x16& od, int vb, bf16x8 pa0, bf16x8 pa1, bf16x8 pa2, bf16x8 pa3) {
  const s16x4 l0 = tr_read<v_rd_off(D0, 0, 0)>(vb), h0 = tr_read<v_rd_off(D0, 0, 1)>(vb), l1 = tr_read<v_rd_off(D0, 1, 0)>(vb), h1 = tr_read<v_rd_off(D0, 1, 1)>(vb);
  const s16x4 l2 = tr_read<v_rd_off(D0, 2, 0)>(vb), h2 = tr_read<v_rd_off(D0, 2, 1)>(vb), l3 = tr_read<v_rd_off(D0, 3, 0)>(vb), h3 = tr_read<v_rd_off(D0, 3, 1)>(vb);
  asm volatile("s_waitcnt lgkmcnt(0)" ::: "memory"); SBAR();
#define PK(L, H) (bf16x8){L[0], L[1], L[2], L[3], H[0], H[1], H[2], H[3]}
  od = __builtin_amdgcn_mfma_f32_32x32x16_bf16(pa0, PK(l0, h0), od, 0, 0, 0);
  od = __builtin_amdgcn_mfma_f32_32x32x16_bf16(pa1, PK(l1, h1), od, 0, 0, 0);
  od = __builtin_amdgcn_mfma_f32_32x32x16_bf16(pa2, PK(l2, h2), od, 0, 0, 0);
  od = __builtin_amdgcn_mfma_f32_32x32x16_bf16(pa3, PK(l3, h3), od, 0, 0, 0);
#undef PK
}
__device__ __forceinline__ void pv_d0(f32x16* o, int vb, bf16x8 pa0, bf16x8 pa1, bf16x8 pa2, bf16x8 pa3) {
  pv_one<0>(o[0], vb, pa0, pa1, pa2, pa3); pv_one<1>(o[1], vb, pa0, pa1, pa2, pa3); pv_one<2>(o[2], vb, pa0, pa1, pa2, pa3); pv_one<3>(o[3], vb, pa0, pa1, pa2, pa3);
}
constexpr int LDQ = NPROJ, LDK = 256;
__device__ __forceinline__ void attn_dense_body(bf16_t* Qb, const bf16_t* __restrict__ Kh, const bf16_t* __restrict__ Vh, int seq, char* lds, const int tid, const float* __restrict__ qg, const float* __restrict__ rope, int s0, const bool STORE = true) {
  const int wid = tid >> 6, lane = tid & 63, r32 = lane & 31, hi = lane >> 5;
  bf16_t* V_lds = (bf16_t*)lds; bf16_t* K_lds = (bf16_t*)(lds + 2 * SHM_V);
  float* ws = (float*)(lds + 2 * SHM_V + 2 * SHM_K) + wid * 64; float* li_l = ws; float* al_l = ws + 32;
  float m_reg = -1e30f, l_reg = 0; f32x16 o[4] = {}; bf16x8 qr[8];
  const bf16_t* Qw = Qb + (long)(wid * QBLK + r32) * LDQ + hi * 8;
#pragma unroll
  for (int d0 = 0; d0 < 8; ++d0) qr[d0] = *reinterpret_cast<const bf16x8*>(Qw + d0 * 16);
  {
    float ss = 0.f;
#pragma unroll
    for (int d0 = 0; d0 < 8; ++d0) { const u32x4 w = __builtin_bit_cast(u32x4, qr[d0]);
#pragma unroll
      for (int e = 0; e < 4; ++e) { const float lo = __uint_as_float(w[e] << 16), hi_ = __uint_as_float(w[e] & 0xffff0000u); ss += lo * lo + hi_ * hi_; } }
    { auto rr = __builtin_amdgcn_permlane32_swap(__float_as_uint(ss), __float_as_uint(ss), false, false); ss = __uint_as_float(rr[0]) + __uint_as_float(rr[1]); }
    const float rinv = rsqrtf(ss * (1.0f / 128.0f) + LN_EPS);
    const int sp = s0 + wid * QBLK + r32;
#pragma unroll
    for (int a = 0; a < 2; ++a) {
      float qf[4][8];
#pragma unroll
      for (int dd = 0; dd < 4; ++dd) { const int d0 = a * 4 + dd; const u32x4 w = __builtin_bit_cast(u32x4, qr[d0]);
        const f32x4 g0 = *(const f32x4*)(qg + d0 * 16 + hi * 8), g1 = *(const f32x4*)(qg + d0 * 16 + hi * 8 + 4);
        qf[dd][0] = __uint_as_float(w[0] << 16) * (rinv * g0[0]); qf[dd][1] = __uint_as_float(w[0] & 0xffff0000u) * (rinv * g0[1]);
        qf[dd][2] = __uint_as_float(w[1] << 16) * (rinv * g0[2]); qf[dd][3] = __uint_as_float(w[1] & 0xffff0000u) * (rinv * g0[3]);
        qf[dd][4] = __uint_as_float(w[2] << 16) * (rinv * g1[0]); qf[dd][5] = __uint_as_float(w[2] & 0xffff0000u) * (rinv * g1[1]);
        qf[dd][6] = __uint_as_float(w[3] << 16) * (rinv * g1[2]); qf[dd][7] = __uint_as_float(w[3] & 0xffff0000u) * (rinv * g1[3]); }
      if (rope) { const int pos = a == 0 ? (sp >> 6) : (sp & 63);
#pragma unroll
        for (int dd = 0; dd < 2; ++dd) { const float* cp = rope + pos * 32 + dd * 16 + hi * 8;
          const f32x4 c0 = *(const f32x4*)cp, c1 = *(const f32x4*)(cp + 4), s0v = *(const f32x4*)(cp + 2048), s1v = *(const f32x4*)(cp + 2048 + 4);
#pragma unroll
          for (int e = 0; e < 4; ++e) { float x1 = qf[dd][e], x2 = qf[dd + 2][e]; qf[dd][e] = x1 * c0[e] - x2 * s0v[e]; qf[dd + 2][e] = x2 * c0[e] + x1 * s0v[e];
            x1 = qf[dd][4 + e]; x2 = qf[dd + 2][4 + e]; qf[dd][4 + e] = x1 * c1[e] - x2 * s1v[e]; qf[dd + 2][4 + e] = x2 * c1[e] + x1 * s1v[e]; } } }
#pragma unroll
      for (int dd = 0; dd < 4; ++dd) { u32x4 w; w.x = cvtpk(qf[dd][0], qf[dd][1]); w.y = cvtpk(qf[dd][2], qf[dd][3]); w.z = cvtpk(qf[dd][4], qf[dd][5]); w.w = cvtpk(qf[dd][6], qf[dd][7]); qr[a * 4 + dd] = __builtin_bit_cast(bf16x8, w); }
      asm volatile("" ::: "memory");
    }
  }
  int tid2 = tid; asm volatile("" : "+v"(tid2));
  const int sr = tid2 >> 4, sc = (tid2 & 15) * 8, vst0 = v_st(sr, sc), vst1 = v_st(32 + sr, sc);
  const int vb0 = (int)(uintptr_t)V_lds + v_rd_base(tid2 & 63);
  struct { bf16x8 vs0, vs1, ks0, ks1; } sr_[1];
#define LD8(p) (*reinterpret_cast<const bf16x8*>(p))
#define SLOAD(i, k0) do { sr_[i].vs0 = LD8(&Vh[(long)((k0) + sr) * LDK + sc]); sr_[i].vs1 = LD8(&Vh[(long)((k0) + 32 + sr) * LDK + sc]); \
    sr_[i].ks0 = LD8(&Kh[(long)((k0) + sr) * LDK + sc]); sr_[i].ks1 = LD8(&Kh[(long)((k0) + 32 + sr) * LDK + sc]); } while (0)
#define SWRITE(b, i) do { *(bf16x8*)((char*)V_lds + (b) * SHM_V + vst0) = sr_[i].vs0;          \
    *(bf16x8*)((char*)V_lds + (b) * SHM_V + vst1) = sr_[i].vs1; int kc = sc * 2;               \
    *(bf16x8*)((char*)K_lds + (b) * SHM_K + KSWZ(sr, kc)) = sr_[i].ks0;                       \
    *(bf16x8*)((char*)K_lds + (b) * SHM_K + KSWZ(32 + sr, kc)) = sr_[i].ks1; } while (0)
#define SWAIT() asm volatile("s_waitcnt vmcnt(0)" ::: "memory")
#define RESC(a) do { if (__any((a) < 1.f)) { if (hi == 0) al_l[r32] = (a); asm volatile("s_waitcnt lgkmcnt(0)" ::: "memory"); \
    _Pragma("unroll") for (int d = 0; d < 4; ++d) _Pragma("unroll") for (int r = 0; r < 16; ++r) o[d][r] *= al_l[crow(r, hi)]; } } while (0)
  f32x16 pA0, pA1, pB0, pB1; float mnA, mnB, alA, alB; bf16x8 pa0, pa1, pa2, pa3; const int NT = seq / KVBLK;
  constexpr int SE = 0, SO = 0;
  SLOAD(SE, 0); asm volatile("s_waitcnt vmcnt(0)" ::: "memory"); SWRITE(0, SE); __syncthreads();
  qkt(pA0, pA1, K_lds, qr, r32, hi); partialSM(pA0, pA1, m_reg, mnA, alA);
  SLOAD(SO, KVBLK);
  SWAIT(); SWRITE(1, SO); __syncthreads();
  for (int j = 1; j + 1 < NT; j += 2) {
    SBAR(); qkt(pB0, pB1, (bf16_t*)((char*)K_lds + SHM_K), qr, r32, hi);
    finishSM(pA0, pA1, alA, l_reg, pa0, pa1, pa2, pa3); SBAR();
    SLOAD(SO, (j + 1) * KVBLK); SBAR();
    pv_d0(o, vb0, pa0, pa1, pa2, pa3); partialSM(pB0, pB1, m_reg, mnB, alB);
    __syncthreads(); SWAIT(); SWRITE(0, SE);
    RESC(alB); __syncthreads();
    SBAR(); qkt(pA0, pA1, K_lds, qr, r32, hi);
    finishSM(pB0, pB1, alB, l_reg, pa0, pa1, pa2, pa3); SBAR();
    SLOAD(SE, (j + 2) * KVBLK); SBAR();
    pv_d0(o, vb0 + (int)SHM_V, pa0, pa1, pa2, pa3); partialSM(pA0, pA1, m_reg, mnA, alA);
    __syncthreads(); SWAIT(); SWRITE(1, SO);
    RESC(alA); __syncthreads();
  }
  SBAR(); qkt(pB0, pB1, (bf16_t*)((char*)K_lds + SHM_K), qr, r32, hi);
  finishSM(pA0, pA1, alA, l_reg, pa0, pa1, pa2, pa3); SBAR();
  pv_d0(o, vb0, pa0, pa1, pa2, pa3); partialSM(pB0, pB1, m_reg, mnB, alB);
  __syncthreads(); RESC(alB);
  finishSM(pB0, pB1, alB, l_reg, pa0, pa1, pa2, pa3); SBAR();
  pv_d0(o, vb0 + (int)SHM_V, pa0, pa1, pa2, pa3);
  if (hi == 0) li_l[r32] = l_reg; asm volatile("s_waitcnt lgkmcnt(0)" ::: "memory");
  float rli[16];
#pragma unroll
  for (int r = 0; r < 16; ++r) rli[r] = __builtin_amdgcn_rcpf(li_l[crow(r, hi)]);
  __syncthreads();
  { bf16_t* stg = (bf16_t*)lds + wid * 4096;
#pragma unroll
    for (int r = 0; r < 16; ++r) { const int orow = crow(r, hi);
#pragma unroll
      for (int d0 = 0; d0 < 4; ++d0) stg[orow * 128 + d0 * 32 + r32] = (bf16_t)(cvtpk(o[d0][r] * rli[r], 0.f) & 0xffffu); }
    asm volatile("s_waitcnt lgkmcnt(0)" ::: "memory");
    int le = lane; asm volatile("" : "+v"(le));
    bf16_t* Ow = Qb + (long)(wid * QBLK + (le >> 4)) * LDQ + (le & 15) * 8;
#pragma unroll
    for (int i = 0; i < 8; ++i) { const u32x4 v = *(const u32x4*)(stg + (i * 4 + (le >> 4)) * 128 + (le & 15) * 8); if (STORE) *(u32x4*)(Ow + (long)i * 4 * LDQ) = v; else asm volatile("" :: "v"(v)); }
  }
  __syncthreads();
#undef LD8
#undef SLOAD
#undef SWRITE
#undef SWAIT
#undef RESC
}
#undef KSWZ
#undef SBAR
}


#define XB_TMO      128
#define XB_XCNT(j)  (256  + 64 * (j))
#define XB_XSUB(j)  (1280 + 64 * (j))
#define XB_XGEN(j)  (2304 + 64 * (j))
#define XB_TOP      3328
#define XB_TOPGEN   3392
#define XCD_BAR_WORDS 3456
#define XB_SPIN_CAP (1u << 18)
__device__ __forceinline__ unsigned xb_ld(unsigned* p)              { return __hip_atomic_load(p, __ATOMIC_RELAXED, __HIP_MEMORY_SCOPE_AGENT); }
__device__ __forceinline__ unsigned xb_add(unsigned* p, unsigned v) { return __hip_atomic_fetch_add(p, v, __ATOMIC_RELAXED, __HIP_MEMORY_SCOPE_AGENT); }
__device__ __forceinline__ unsigned xb_xcc_id() { return (unsigned)__builtin_amdgcn_s_getreg((3 << 11) | 20) & 0xFu; }
#define XB_SPIN(cond, bar) do { unsigned _sp = 0; while (cond) { __builtin_amdgcn_s_sleep(1); \
    if ((++_sp & 255u) == 0u) { if (xb_ld(&(bar)[XB_TMO])) break; if (_sp > XB_SPIN_CAP) { atomicAdd(&(bar)[XB_TMO], 1u); break; } } } } while (0)
struct XcdBarrier { unsigned* bar; unsigned x; volatile LAS unsigned* st; };
__device__ __forceinline__ XcdBarrier xcd_barrier_post(unsigned* bar, volatile LAS unsigned* st) {
    XcdBarrier b; b.bar = bar; b.x = xb_xcc_id(); b.st = st;
    if (threadIdx.x == 0) (void)xb_add(&bar[XB_XCNT(b.x)], 1u);
    return b;
}
__device__ __forceinline__ void xcd_barrier_complete(unsigned* bar, unsigned x, unsigned& nloc, unsigned& nx) {
    const unsigned G = gridDim.x * gridDim.y * gridDim.z;
    unsigned sum, cnt, mine, sp = 0u;
    for (;;) {
        sum = 0u; cnt = 0u; mine = 0u;
#pragma unroll
        for (unsigned j = 0; j < 16; ++j) { const unsigned c = xb_ld(&bar[XB_XCNT(j)]); sum += c; cnt += (c > 0u) ? 1u : 0u; mine = (j == x) ? c : mine; }
        if (sum == G) break;
        __builtin_amdgcn_s_sleep(1);
        if ((++sp & 255u) == 0u) { if (xb_ld(&bar[XB_TMO])) break; if (sp > XB_SPIN_CAP) { atomicAdd(&bar[XB_TMO], 1u); break; } }
    }
    nloc = mine > 0u ? mine : 1u; nx = cnt > 0u ? cnt : 1u;
}
__device__ __forceinline__ void xcd_barrier(const XcdBarrier& b) {
    asm volatile("s_waitcnt vmcnt(0)" ::: "memory");
    __syncthreads();
    if (threadIdx.x == 0) {
        unsigned* bar = b.bar;
        __builtin_amdgcn_s_waitcnt(0);
        unsigned nloc = b.st[0], nx = b.st[1];
        if (nloc == 0u) { xcd_barrier_complete(bar, b.x, nloc, nx); b.st[0] = nloc; b.st[1] = nx; }
        const unsigned old = xb_add(&bar[XB_XSUB(b.x)], 1u);
        const unsigned gen = old / nloc;
        if (old + 1u == (gen + 1u) * nloc) {
            __builtin_amdgcn_fence(__ATOMIC_RELEASE, "agent");
            asm volatile("s_waitcnt vmcnt(0)" ::: "memory");
            const unsigned og = xb_add(&bar[XB_TOP], 1u);
            const unsigned tg = og / nx;
            if (og + 1u == (tg + 1u) * nx) xb_add(&bar[XB_TOPGEN], 1u);
            else XB_SPIN(xb_ld(&bar[XB_TOPGEN]) == tg, bar);
            __builtin_amdgcn_fence(__ATOMIC_ACQUIRE, "agent");
            xb_add(&bar[XB_XGEN(b.x)], 1u);
            asm volatile("s_waitcnt vmcnt(0)" ::: "memory");
        } else {
            XB_SPIN(xb_ld(&bar[XB_XGEN(b.x)]) == gen, bar);
            __builtin_amdgcn_fence(__ATOMIC_ACQUIRE, "agent");
            asm volatile("s_waitcnt vmcnt(0)" ::: "memory");
        }
    }
    __syncthreads();
}

struct Args { const float* in[25]; float* out; unsigned char* ws; int ph_lo, ph_hi; };

typedef const float* fptr_t;
typedef __attribute__((address_space(4))) const fptr_t* in_as4_t;
struct Frame {
    LAS unsigned char* lds; char* ldsg;
    int tid, lane, wave, G, bx, gw, NGW;
    const float* const* in;
    unsigned char* ws; float* out;
};
enum { I_XP = 0, I_XS, I_CK, I_CV, I_C, I_CCTX, I_WADA, I_BADA, I_WIN, I_QG, I_KG, I_WPG, I_PSC, I_WSGU, I_BSGU, I_WAO, I_WPO, I_WSO, I_WOUT, I_LN1G, I_LN1B, I_WF1, I_WF2, I_LN2G, I_LN2B };

__device__ __forceinline__ void tr_item(const float* W, int ldw, int src_col, int kb, bf16_t* WT, int ldt, int dst_row, int dst_k, LAS float* scr, int lane) {
    const int k0 = 64 * kb;
#pragma unroll 8
    for (int i = 0; i < 32; ++i) { const int kk = 2 * i + (lane >> 5); scr[kk * 33 + (lane & 31)] = W[(size_t)(k0 + kk) * ldw + src_col + (lane & 31)]; }
    asm volatile("s_waitcnt lgkmcnt(0)" ::: "memory");
    const int c = lane & 7;
#pragma unroll
    for (int j = 0; j < 4; ++j) { const int n = (lane >> 3) + 8 * j; const LAS float* s = scr + (8 * c) * 33 + n;
        u32x4 o; o.x = cvt_pk_bf16(s[0 * 33], s[1 * 33]); o.y = cvt_pk_bf16(s[2 * 33], s[3 * 33]); o.z = cvt_pk_bf16(s[4 * 33], s[5 * 33]); o.w = cvt_pk_bf16(s[6 * 33], s[7 * 33]);
        *(u32x4*)(WT + (size_t)(dst_row + n) * ldt + dst_k + k0 + 8 * c) = o; }
    asm volatile("s_waitcnt lgkmcnt(0)" ::: "memory");
}

__device__ __forceinline__ int win_src_col(int d) {
    if (d < 1024) return d;
    if (d < 1536) return 2048 + (d - 1024);
    if (d < 2048) return 1024 + (d - 1536);
    if (d < 2560) return 2560 + (d - 2048);
    if (d < 3072) return 1536 + (d - 2560);
    return d;
}

__device__ __forceinline__ void phase_prologue(Frame& F) {
    if (F.bx < 192) {
        const int l = F.bx / 96, nb = F.bx % 96;
        LAS float* sc = (LAS float*)F.lds;
        LAS float* red = (LAS float*)(F.lds + 9 * 1024 * 4);
        for (int idx = F.tid; idx < 9 * 1024; idx += 512) { const int v = idx >> 10, k = idx & 1023;
            const float x = v == 0 ? F.in[I_CCTX][k] : F.in[I_C][(v - 1) * 1024 + k]; sc[idx] = x / (1.0f + __expf(-x)); }
        __syncthreads();
        float acc[9];
#pragma unroll
        for (int v = 0; v < 9; ++v) acc[v] = 0.f;
        const float* wp = F.in[I_WADA] + ((size_t)l * 1024 + F.wave * 128) * 6144 + nb * 64 + F.lane;
#pragma unroll 8
        for (int k = 0; k < 128; ++k) { const float w = wp[(size_t)k * 6144];
#pragma unroll
            for (int v = 0; v < 9; ++v) acc[v] += sc[v * 1024 + F.wave * 128 + k] * w; }
#pragma unroll
        for (int v = 0; v < 9; ++v) red[(F.wave * 9 + v) * 64 + F.lane] = acc[v];
        __syncthreads();
        float* mod = (float*)(F.ws + WS_MOD);
        for (int idx = F.tid; idx < 576; idx += 512) { const int v = idx >> 6, ln = idx & 63; float s = 0.f;
#pragma unroll
            for (int w = 0; w < 8; ++w) s += red[(w * 9 + v) * 64 + ln];
            mod[(l * 9 + v) * 6144 + nb * 64 + ln] = s + F.in[I_BADA][l * 6144 + nb * 64 + ln]; }
        __syncthreads();
    }
    LAS float* scr = (LAS float*)(F.lds + F.wave * 8448);
    constexpr int N_WIN = 16 * 192, N_AO = 16 * 32, N_SO = 8 * 32, N_WO = 16 * 32, N_F1 = 16 * 176, N_F2 = 44 * 32, N_PE = 1024, N_WS = 128;
    constexpr int N_L = N_WIN + N_AO + N_SO + N_WO + N_F1 + N_F2 + N_PE + N_WS;
    constexpr int N_ALL = 2 * N_L + 32;
    for (int it = F.gw; it < N_ALL; it += F.NGW) {
        if (it >= 2 * N_L) {
            const int idx = (it - 2 * N_L) * 64 + F.lane; const int pos = idx >> 5, p = idx & 31;
            const float inv = powf(10000.0f, -(float)p / 32.0f); const float ang = (float)pos * inv;
            float* rope = (float*)(F.ws + WS_ROPE); rope[idx] = cosf(ang); rope[2048 + idx] = sinf(ang);
            continue;
        }
        const int l = it / N_L; int r = it % N_L;
        if (r < N_WIN) { const int kb = r / 192, nb = r % 192;
            tr_item(F.in[I_WIN] + (size_t)l * 1024 * 6144, 6144, win_src_col(nb * 32), kb, (bf16_t*)(F.ws + WS_WIN) + (size_t)l * 6144 * 1024, 1024, nb * 32, 0, scr, F.lane); continue; } r -= N_WIN;
        if (r < N_AO) { const int kb = r / 32, nb = r % 32;
            tr_item(F.in[I_WAO] + (size_t)l * 1024 * 1024, 1024, nb * 32, kb, (bf16_t*)(F.ws + WS_WM) + (size_t)l * 1024 * 2048, 2048, nb * 32, 0, scr, F.lane); continue; } r -= N_AO;
        if (r < N_SO) { const int kb = r / 32, nb = r % 32;
            tr_item(F.in[I_WSO] + (size_t)l * 512 * 1024, 1024, nb * 32, kb, (bf16_t*)(F.ws + WS_WM) + (size_t)l * 1024 * 2048, 2048, nb * 32, 1024, scr, F.lane); continue; } r -= N_SO;
        if (r < N_WO) { const int kb = r / 32, nb = r % 32;
            tr_item(F.in[I_WOUT] + (size_t)l * 1024 * 1024, 1024, nb * 32, kb, (bf16_t*)(F.ws + WS_WOUT) + (size_t)l * 1024 * 1024, 1024, nb * 32, 0, scr, F.lane); continue; } r -= N_WO;
        if (r < N_F1) { const int kb = r / 176, nb = r % 176; const int drow = nb * 32; const int pn = drow >> 8, j = drow & 255;
            const int src = j < 128 ? pn * 128 + j : DFF + pn * 128 + (j - 128);
            tr_item(F.in[I_WF1] + (size_t)l * 1024 * 5632, 5632, src, kb, (bf16_t*)(F.ws + WS_WF1) + (size_t)l * 5632 * 1024, 1024, drow, 0, scr, F.lane); continue; } r -= N_F1;
        if (r < N_F2) { const int kb = r / 32, nb = r % 32;
            tr_item(F.in[I_WF2] + (size_t)l * DFF * 1024, 1024, nb * 32, kb, (bf16_t*)(F.ws + WS_WF2) + (size_t)l * 1024 * DFF, DFF, nb * 32, 0, scr, F.lane); continue; } r -= N_F2;
        if (r < N_PE) {
            const int kg = r >> 4, nb = r & 15; const int k0 = kg * 8, g = k0 >> 7; const int n = nb * 64 + F.lane;
            const float* wpg = F.in[I_WPG] + ((size_t)(l * 4 + g) * 128 + (k0 & 127)) * 128;
            const float* psc = F.in[I_PSC] + l * 512 + g * 128;
            const float* wpo = F.in[I_WPO] + ((size_t)l * 512 + g * 128) * 1024 + n;
            float a[8];
#pragma unroll
            for (int i = 0; i < 8; ++i) a[i] = 0.f;
#pragma unroll 4
            for (int j = 0; j < 128; ++j) { const float w = wpo[(size_t)j * 1024] * psc[j];
#pragma unroll
                for (int i = 0; i < 8; ++i) a[i] += wpg[i * 128 + j] * w; }
            u32x4 o; o.x = cvt_pk_bf16(a[0], a[1]); o.y = cvt_pk_bf16(a[2], a[3]); o.z = cvt_pk_bf16(a[4], a[5]); o.w = cvt_pk_bf16(a[6], a[7]);
            *(u32x4*)((bf16_t*)(F.ws + WS_WM) + (size_t)l * 1024 * 2048 + (size_t)n * 2048 + 1536 + k0) = o;
            continue; } r -= N_PE;
        {
            const size_t e0 = (size_t)l * 65536 + (size_t)r * 512 + F.lane * 8;
            const f32x4 a = *(const f32x4*)(F.in[I_WSGU] + e0), b = *(const f32x4*)(F.in[I_WSGU] + e0 + 4);
            u32x4 o; o.x = cvt_pk_bf16(a[0], a[1]); o.y = cvt_pk_bf16(a[2], a[3]); o.z = cvt_pk_bf16(b[0], b[1]); o.w = cvt_pk_bf16(b[2], b[3]);
            *(u32x4*)((bf16_t*)(F.ws + WS_WSGU) + e0) = o;
        }
    }
}

__device__ __forceinline__ const float* x0_row(Frame& F, int t) { return t < T_CTX ? F.in[I_XP] + (size_t)t * DM : F.in[I_XS] + (size_t)(t - T_CTX) * DM; }
__device__ __forceinline__ int vec_of_row(int t) { return t < T_CTX ? 0 : 1 + ((t - T_CTX) >> 12); }

__device__ __forceinline__ void phase_h0(Frame& F) {
    const float* mod = (const float*)(F.ws + WS_MOD);
    bf16_t* act = (bf16_t*)(F.ws + WS_ACT);
    for (int t = F.gw; t < T_ALL; t += F.NGW) {
        const f32x4* xr = (const f32x4*)x0_row(F, t) + F.lane;
        const float* mv = mod + vec_of_row(t) * 6144;
        unsigned long long* o8 = (unsigned long long*)(act + (size_t)t * DM) + F.lane;
#pragma unroll
        for (int j = 0; j < 4; ++j) { const f32x4 x = xr[64 * j]; const int c = 256 * j + 4 * F.lane;
            const f32x4 sh = *(const f32x4*)(mv + c), sc = *(const f32x4*)(mv + 1024 + c);
            const f32x4 h = x * (sc + 1.0f) + sh;
            o8[64 * j] = (unsigned long long)cvt_pk_bf16(h[0], h[1]) | ((unsigned long long)cvt_pk_bf16(h[2], h[3]) << 32); }
    }
}

__device__ __forceinline__ void phase_ln(Frame& F, const float* lg, const float* lb, const float* modl  , int sh_off, int sc_off, const bool dry = false) {
    float* X = F.out; bf16_t* act = (bf16_t*)(F.ws + WS_ACT);
    for (int t = F.gw; t < T_ALL; t += F.NGW) {
        f32x4* xr = (f32x4*)(X + (size_t)t * DM) + F.lane;
        f32x4 v[4]; float s = 0.f;
#pragma unroll
        for (int j = 0; j < 4; ++j) { v[j] = xr[64 * j]; s += (v[j][0] + v[j][1]) + (v[j][2] + v[j][3]); }
        const float mean = wave_sum(s) * (1.f / DM); float s2 = 0.f;
#pragma unroll
        for (int j = 0; j < 4; ++j) { v[j] = v[j] - mean; s2 += (v[j][0] * v[j][0] + v[j][1] * v[j][1]) + (v[j][2] * v[j][2] + v[j][3] * v[j][3]); }
        const float rstd = rsqrtf(wave_sum(s2) * (1.f / DM) + LN_EPS);
        const float* mv = modl ? modl + vec_of_row(t) * 6144 : nullptr;
        unsigned long long* o8 = (unsigned long long*)(act + (size_t)t * DM) + F.lane;
#pragma unroll
        for (int j = 0; j < 4; ++j) { const int c = 256 * j + 4 * F.lane;
            const f32x4 g = *(const f32x4*)(lg + c), b = *(const f32x4*)(lb + c);
            const f32x4 y = v[j] * rstd * g + b; if (!dry) xr[64 * j] = y; else { asm volatile("" :: "v"(y)); continue; }
            if (mv) { const f32x4 sh = *(const f32x4*)(mv + sh_off + c), sc = *(const f32x4*)(mv + sc_off + c);
                const f32x4 h = y * (sc + 1.0f) + sh;
                o8[64 * j] = (unsigned long long)cvt_pk_bf16(h[0], h[1]) | ((unsigned long long)cvt_pk_bf16(h[2], h[3]) << 32); } }
    }
}

__device__ __forceinline__ void load16h(const bf16_t* p, int j, float (&x)[16]) {
#pragma unroll
    for (int a = 0; a < 2; ++a)
#pragma unroll
        for (int hf = 0; hf < 2; ++hf) { const u32x2 w = *(const u32x2*)(p + a * 64 + hf * 32 + 4 * j);
            x[(a * 2 + hf) * 4 + 0] = bf_lo(w.x); x[(a * 2 + hf) * 4 + 1] = bf_hi(w.x); x[(a * 2 + hf) * 4 + 2] = bf_lo(w.y); x[(a * 2 + hf) * 4 + 3] = bf_hi(w.y); }
}
__device__ __forceinline__ void rmsn(float (&x)[16], const float (&g)[16]) {
    float ss = 0.f;
#pragma unroll
    for (int i = 0; i < 16; ++i) ss += x[i] * x[i];
    ss += __shfl_xor(ss, 1); ss += __shfl_xor(ss, 2); ss += __shfl_xor(ss, 4);
    const float rinv = rsqrtf(ss * (1.0f / 128.0f) + LN_EPS);
#pragma unroll
    for (int i = 0; i < 16; ++i) x[i] = x[i] * rinv * g[i];
}
__device__ __forceinline__ void rope16(float (&x)[16], const float* rope, int rowpos, int colpos, int j) {
#pragma unroll
    for (int a = 0; a < 2; ++a) { const int pos = a == 0 ? rowpos : colpos;
        const f32x4 c = *(const f32x4*)(rope + pos * 32 + 4 * j), s = *(const f32x4*)(rope + 2048 + pos * 32 + 4 * j);
#pragma unroll
        for (int e = 0; e < 4; ++e) { const float x1 = x[(a * 2) * 4 + e], x2 = x[(a * 2 + 1) * 4 + e];
            x[(a * 2) * 4 + e] = x1 * c[e] - x2 * s[e]; x[(a * 2 + 1) * 4 + e] = x2 * c[e] + x1 * s[e]; } }
}
__device__ __forceinline__ void store16h(bf16_t* p, int j, const float (&x)[16]) {
#pragma unroll
    for (int a = 0; a < 2; ++a)
#pragma unroll
        for (int hf = 0; hf < 2; ++hf) { u32x2 w; w.x = cvt_pk_bf16(x[(a * 2 + hf) * 4 + 0], x[(a * 2 + hf) * 4 + 1]); w.y = cvt_pk_bf16(x[(a * 2 + hf) * 4 + 2], x[(a * 2 + hf) * 4 + 3]);
            *(u32x2*)(p + a * 64 + hf * 32 + 4 * j) = w; }
}

__device__ __forceinline__ void phase_mid(Frame& F, int l, int part, const bool dry = false) {
    bf16_t* proj = (bf16_t*)(F.ws + WS_PROJ);
    const float* rope = (const float*)(F.ws + WS_ROPE);
    bf16_t* vrt = (bf16_t*)(F.ws + WS_VRT);
    bf16_t* KL = (bf16_t*)(F.ws + WS_KL); bf16_t* VL = (bf16_t*)(F.ws + WS_VL); bf16_t* KC = (bf16_t*)(F.ws + WS_KC); bf16_t* VC = (bf16_t*)(F.ws + WS_VC);
    float* outk = F.out + (size_t)T_ALL * DM; float* outv = outk + (size_t)16 * 2 * 256 * 256;
    const int lane = F.lane, hj = lane & 7;
    const int n8 = part_rows(part) / 4, ncache = 4 * PAST;
    float qg[16], kg[16];
#pragma unroll
    for (int a = 0; a < 2; ++a)
#pragma unroll
        for (int hf = 0; hf < 2; ++hf)
#pragma unroll
            for (int e = 0; e < 4; ++e) { const int d = a * 64 + hf * 32 + 4 * hj + e; qg[(a * 2 + hf) * 4 + e] = F.in[I_QG][l * 128 + d]; kg[(a * 2 + hf) * 4 + e] = F.in[I_KG][l * 128 + d]; }
    for (int it = F.gw; it < n8 + ncache; it += F.NGW) {
        if (it >= n8) {
            const int cr = it - n8; const int bl = cr >> 9, s = cr & 511; const int b = part * 4 + bl;
            const size_t src = (((size_t)b * 2 + l) * PAST + s) * 256 + lane * 4;
            const f32x4 kx = *(const f32x4*)(F.in[I_CK] + src), vx = *(const f32x4*)(F.in[I_CV] + src);
            const size_t dst = ((size_t)bl * SKV_LAT + s) * 256 + lane * 4;
            u32x2 kw, vw; kw.x = cvt_pk_bf16(kx[0], kx[1]); kw.y = cvt_pk_bf16(kx[2], kx[3]); vw.x = cvt_pk_bf16(vx[0], vx[1]); vw.y = cvt_pk_bf16(vx[2], vx[3]);
            if (!dry) { *(u32x2*)(KL + dst) = kw; *(u32x2*)(VL + dst) = vw; } else asm volatile("" :: "v"(kw), "v"(vw));
            continue;
        }
        const int lr0 = it * 4, t0 = part_row0(part) + lr0;
        const bool is_ctx = t0 < T_CTX;
        bf16_t* P0 = proj + (size_t)lr0 * NPROJ;
        {
            float val[4][8];
#pragma unroll
            for (int i = 0; i < 4; ++i) { const u32x4 w = *(const u32x4*)(P0 + (size_t)i * NPROJ + PC_XV + lane * 8);
#pragma unroll
                for (int e = 0; e < 4; ++e) { val[i][2 * e] = gelu1(bf_lo(w[e])); val[i][2 * e + 1] = gelu1(bf_hi(w[e])); } }
#pragma unroll
            for (int i = 0; i < 4; ++i) { float s = 0.f;
#pragma unroll
                for (int e = 0; e < 8; ++e) s += val[i][e];
                const float mean = wave_sum(s) * (1.0f / 512.0f); float s2 = 0.f;
#pragma unroll
                for (int e = 0; e < 8; ++e) { val[i][e] -= mean; s2 += val[i][e] * val[i][e]; }
                const float rstd = rsqrtf(wave_sum(s2) * (1.0f / 512.0f) + LN_EPS);
#pragma unroll
                for (int e = 0; e < 8; ++e) val[i][e] *= rstd; }
            const int chunk = lr0 >> 7, q0 = lr0 & 127;
            bf16_t* vb = vrt + ((size_t)chunk * 512 + lane * 8) * 128 + q0;
#pragma unroll
            for (int e = 0; e < 8; ++e) { u32x2 o; o.x = cvt_pk_bf16(val[0][e], val[1][e]); o.y = cvt_pk_bf16(val[2][e], val[3][e]);
                if (!dry) *(u32x2*)(vb + (size_t)e * 128) = o; else asm volatile("" :: "v"(o)); }
        }
#pragma unroll 1
        for (int i = 0; i < 4; ++i) {
            bf16_t* Pr = P0 + (size_t)i * NPROJ; const int t = t0 + i;
            int spos, seqS, rowpos = 0, colpos = 0, bl = 0;
            if (is_ctx) { spos = t & 255; seqS = CTX_S; } else { const int tl = t - T_CTX; spos = tl & 4095; seqS = LAT_S; rowpos = spos >> 6; colpos = spos & 63; bl = (tl >> 12) - part * 4; }
            float x[16];
            const int kh = (lane >> 3) & 1;
            load16h(Pr + PC_K + kh * 128, hj, x); rmsn(x, kg);
            const int vi = (lane - 16) & 31;
            const u32x4 vw = *(const u32x4*)(Pr + PC_V + vi * 8);
            float pacc[8], pself[8];
            {
                const int hw = 1 << (lane >> 4);
                const int lo = max(spos - hw, 0), hi = min(spos + hw, seqS);
#pragma unroll
                for (int e = 0; e < 8; ++e) pacc[e] = 0.f;
                u32x4 pw[16];
#pragma unroll
                for (int k = 0; k < 16; ++k) { const int dd = k - 8, sp = spos + dd; const bool ok = (sp >= lo) && (sp < hi);
                    pw[k] = *(const u32x4*)(Pr + (long)(ok ? dd : 0) * NPROJ + PC_XP + lane * 8); }
#pragma unroll
                for (int k = 0; k < 16; ++k) { const int sp = spos + k - 8; const float mk = ((sp >= lo) && (sp < hi)) ? 1.0f : 0.0f;
#pragma unroll
                    for (int e = 0; e < 4; ++e) { pacc[2 * e] += mk * bf_lo(pw[k][e]); pacc[2 * e + 1] += mk * bf_hi(pw[k][e]); } }
#pragma unroll
                for (int e = 0; e < 4; ++e) { pself[2 * e] = bf_lo(pw[8][e]); pself[2 * e + 1] = bf_hi(pw[8][e]); }
                const float rc = 1.0f / (float)(hi - lo);
#pragma unroll
                for (int e = 0; e < 8; ++e) pacc[e] = pacc[e] * rc - pself[e];
            }
            asm volatile("s_waitcnt vmcnt(0)" ::: "memory");
            if (dry) { asm volatile("" :: "v"(x[0]), "v"(x[7]), "v"(vw), "v"(pacc[0]), "v"(pacc[7])); continue; }
            if (is_ctx) {
                if (lane < 16) {
                    float* ok = outk + (((size_t)(t >> 8) * 2 + l) * 256 + (t & 255)) * 256 + kh * 128;
#pragma unroll
                    for (int a = 0; a < 2; ++a)
#pragma unroll
                        for (int hf = 0; hf < 2; ++hf) *(f32x4*)(ok + a * 64 + hf * 32 + 4 * hj) = (f32x4){x[(a * 2 + hf) * 4], x[(a * 2 + hf) * 4 + 1], x[(a * 2 + hf) * 4 + 2], x[(a * 2 + hf) * 4 + 3]};
                    store16h(KC + (size_t)t * 256 + kh * 128, hj, x);
                }
                if (lane >= 16 && lane < 48) {
                    float* ov = outv + (((size_t)(t >> 8) * 2 + l) * 256 + (t & 255)) * 256 + vi * 8;
                    *(f32x4*)ov = (f32x4){bf_lo(vw[0]), bf_hi(vw[0]), bf_lo(vw[1]), bf_hi(vw[1])};
                    *(f32x4*)(ov + 4) = (f32x4){bf_lo(vw[2]), bf_hi(vw[2]), bf_lo(vw[3]), bf_hi(vw[3])};
                    *(u32x4*)(VC + (size_t)t * 256 + vi * 8) = vw;
                }
            } else {
                rope16(x, rope, rowpos, colpos, hj);
                const size_t krow = ((size_t)bl * SKV_LAT + PAST + spos) * 256;
                if (lane < 16) store16h(KL + krow + kh * 128, hj, x);
                if (lane >= 16 && lane < 48) *(u32x4*)(VL + krow + vi * 8) = vw;
            }
            { u32x4 o; o.x = cvt_pk_bf16(pacc[0], pacc[1]); o.y = cvt_pk_bf16(pacc[2], pacc[3]); o.z = cvt_pk_bf16(pacc[4], pacc[5]); o.w = cvt_pk_bf16(pacc[6], pacc[7]);
              *(u32x4*)(Pr + PC_K + lane * 8) = o; }
        }
    }
}

__device__ __forceinline__ void phase_attn(Frame& F, int l, int part, const bool sgu_only_dry = false) {
    bf16_t* proj = (bf16_t*)(F.ws + WS_PROJ);
    const bf16_t* KL = (const bf16_t*)(F.ws + WS_KL); const bf16_t* VL = (const bf16_t*)(F.ws + WS_VL); const bf16_t* KC = (const bf16_t*)(F.ws + WS_KC); const bf16_t* VC = (const bf16_t*)(F.ws + WS_VC);
    const int lat_row0 = part == 0 ? T_CTX : 0;
    if (!sgu_only_dry) {
        int pair, idx, step; int rep = 0;
        const bool xcdmap = (F.G % 8) == 0;
        if (xcdmap) { pair = F.bx & 7; idx = F.bx >> 3; step = F.G >> 3; } else { pair = 0; idx = F.bx; step = F.G; }
        for (;;) {
            int pr = pair, ix = idx;
            if (!xcdmap) { pr = idx >> 6; ix = idx & 63; if (idx >= 512) break; } else if (idx >= 64) break;
            const int bl = pr >> 1, kvh = pr & 1, h = kvh * 4 + (ix >> 4), qb = ix & 15;
            bf16_t* Qb = proj + (size_t)(lat_row0 + bl * LAT_S + qb * 256) * NPROJ + PC_Q + h * 128;
            att::attn_dense_body(Qb, KL + (size_t)bl * SKV_LAT * 256 + kvh * 128, VL + (size_t)bl * SKV_LAT * 256 + kvh * 128, SKV_LAT, F.ldsg, F.tid, F.in[I_QG] + l * 128, (const float*)(F.ws + WS_ROPE), qb * 256, PROBE == 3 ? rep == 1 : true);
            if (PROBE == 3) { if (rep == 0) { rep = 1; continue; } rep = 0; }
            idx += step;
        }
    }
    if (part == 0 && !sgu_only_dry) {
        for (int u = F.bx; u < 128; u += F.G) { const int b = u >> 3, h = u & 7;
            bf16_t* Qb = proj + (size_t)(b * 256) * NPROJ + PC_Q + h * 128;
            att::attn_dense_body(Qb, KC + (size_t)b * 256 * 256 + (h >> 2) * 128, VC + (size_t)b * 256 * 256 + (h >> 2) * 128, CTX_S, F.ldsg, F.tid, F.in[I_QG] + l * 128, (const float*)nullptr, 0); }
    }
    const bf16_t* vrt = (const bf16_t*)(F.ws + WS_VRT);
    const bf16_t* wsb = (const bf16_t*)(F.ws + WS_WSGU) + (size_t)l * 65536;
    const float* bs = F.in[I_BSGU] + l * 512;
    const int nitem = (part_rows(part) / 128) * 32;
    const int ln = F.lane & 15, quad = F.lane >> 4;
    for (int it = F.NGW - 1 - F.gw; it < nitem; it += F.NGW) {
        const int chunk = it >> 5, g = (it >> 3) & 3, cb = (it >> 1) & 3, pb = it & 1;
        f32x4 acc[2][4];
#pragma unroll
        for (int a = 0; a < 2; ++a)
#pragma unroll
            for (int b = 0; b < 4; ++b) acc[a][b] = (f32x4){0.f, 0.f, 0.f, 0.f};
        const bf16_t* ap = vrt + ((size_t)chunk * 512 + g * 128 + cb * 32 + ln) * 128 + quad * 8;
        const bf16_t* bp = wsb + ((size_t)g * 128 + pb * 64 + ln) * 128 + quad * 8;
        u32x2 xw[4][2];
#pragma unroll
        for (int pt = 0; pt < 4; ++pt)
#pragma unroll
            for (int ct = 0; ct < 2; ++ct) xw[pt][ct] = *(const u32x2*)(proj + (size_t)(chunk * 128 + pb * 64 + pt * 16 + ln) * NPROJ + PC_U + g * 128 + cb * 32 + ct * 16 + quad * 4);
#pragma unroll
        for (int ks = 0; ks < 4; ++ks) {
            bf16x8 af[2], bfr[4];
#pragma unroll
            for (int ct = 0; ct < 2; ++ct) af[ct] = *(const bf16x8*)(ap + ct * 16 * 128 + ks * 32);
#pragma unroll
            for (int pt = 0; pt < 4; ++pt) bfr[pt] = *(const bf16x8*)(bp + pt * 16 * 128 + ks * 32);
#pragma unroll
            for (int ct = 0; ct < 2; ++ct)
#pragma unroll
                for (int pt = 0; pt < 4; ++pt) acc[ct][pt] = __builtin_amdgcn_mfma_f32_16x16x32_bf16(af[ct], bfr[pt], acc[ct][pt], 0, 0, 0);
        }
#pragma unroll
        for (int pt = 0; pt < 4; ++pt) { const int p = pb * 64 + pt * 16 + ln; const float bsv = bs[g * 128 + p];
#pragma unroll
            for (int ct = 0; ct < 2; ++ct) { const int c = g * 128 + cb * 32 + ct * 16 + quad * 4;
                bf16_t* up = proj + (size_t)(chunk * 128 + p) * NPROJ + PC_U + c;
                const u32x2 w = xw[pt][ct];
                const float u0 = gelu1(bf_lo(w.x)), u1 = gelu1(bf_hi(w.x)), u2 = gelu1(bf_lo(w.y)), u3 = gelu1(bf_hi(w.y));
                const f32x4 a = acc[ct][pt];
                u32x2 o; o.x = cvt_pk_bf16(u0 * (a[0] + bsv), u1 * (a[1] + bsv)); o.y = cvt_pk_bf16(u2 * (a[2] + bsv), u3 * (a[3] + bsv));
                if (!sgu_only_dry) *(u32x2*)up = o; else asm volatile("" :: "v"(o)); } }
    }
}

constexpr int NPL = 11, NPHASE = 2 + DEPTH * NPL;
__global__ void __launch_bounds__(NW * 64, 2) fwd_kernel(Args args) {
    extern __shared__ __attribute__((aligned(16))) unsigned char lds[];
    Frame F;
    F.lds = (LAS unsigned char*)lds; F.ldsg = (char*)lds;
    F.G = gridDim.x; F.bx = blockIdx.x; F.NGW = F.G * NW;
    F.in = args.in; F.ws = args.ws; F.out = args.out;
    const float* mod = (const float*)(F.ws + WS_MOD);
    bf16_t* act = (bf16_t*)(F.ws + WS_ACT); bf16_t* proj = (bf16_t*)(F.ws + WS_PROJ);
    volatile LAS unsigned* bst = (volatile LAS unsigned*)(F.lds + 131072 + 64);
    unsigned* barw = (unsigned*)(F.ws + WS_BAR);
    const int wave0 = __builtin_amdgcn_readfirstlane((int)threadIdx.x >> 6);
    { unsigned z0 = 0u; asm volatile("" : "+v"(z0)); int t0 = wave0 * 64 + (int)__builtin_amdgcn_mbcnt_hi(~0u, __builtin_amdgcn_mbcnt_lo(~0u, z0));
      if (t0 < 2) bst[t0] = 0u;
      if (blockIdx.x == 0 && args.ph_lo == 0) { for (int i = t0; i < XCD_BAR_WORDS; i += NW * 64) barw[i] = 0u;
        unsigned* cw = (unsigned*)(F.ws + WS_CNT); for (int i = t0; i < CNT_WORDS; i += NW * 64) cw[i] = 0u; } }
    __syncthreads();
    XcdBarrier xbar; xbar.bar = barw; xbar.x = 0; xbar.st = bst;
    for (int ph = args.ph_lo; ph < args.ph_hi; ++ph) {
        { unsigned zz = 0u; asm volatile("" : "+v"(zz)); const int lanev = (int)__builtin_amdgcn_mbcnt_hi(~0u, __builtin_amdgcn_mbcnt_lo(~0u, zz));
          F.lane = lanev; F.wave = wave0; F.tid = wave0 * 64 + lanev; F.gw = F.bx * NW + F.wave; }

#ifndef PHMASK
#define PHMASK 0xffff
#endif
        if (ph == 0) { if (PHMASK & 1) phase_prologue(F); if (PROBE == 4) { __syncthreads(); phase_prologue(F); } }
        else if (ph == 1) { if (PHMASK & 2) phase_h0(F); if (PROBE == 4) phase_h0(F); }
        else {
            const int l = (ph - 2) / NPL, s = (ph - 2) % NPL;
            if (s < 8) {
                const int part = s >> 2, q = s & 3;
                if (q == 0) { if (PHMASK & 4) {
                    pg8::Gemm g{}; g.A = act + (size_t)part_row0(part) * DM; g.Bt = (const bf16_t*)(F.ws + WS_WIN) + (size_t)l * NPROJ * DM; g.lda = DM; g.ldb = DM;
                    g.nM = part_rows(part) / 256; g.nN = NPROJ / 256; g.nseg = 1; g.k0[0] = 0; g.nt[0] = 16; g.k0[1] = 0; g.nt[1] = 16; g.k0[2] = 0; g.nt[2] = 16;
                    pg8::Order S; S.init(g.nM, g.nN, 1, F.G, F.bx, 0, STAGGER);
                    pg8::EpiStore E{proj, NPROJ, PC_G};
                    if (PROBE == 2) { pg8::EpiNone E0; pg8::gemm_phase<pg8::EpiNone>(F.lds, g, S, E0, F.tid); }
                    if (PROBE == 7) pg8::gemm_phase<pg8::EpiStore>(F.lds, g, S, E, F.tid);
                    pg8::gemm_phase<pg8::EpiStore>(F.lds, g, S, E, F.tid); }
                } else if (q == 1) { if (PROBE == 5) phase_mid(F, l, part, true); if (PHMASK & 8) phase_mid(F, l, part, false); }
                else if (q == 2) { if (PROBE == 6) phase_attn(F, l, part, true); if (PHMASK & 16) phase_attn(F, l, part, false); }
                else if (PHMASK & 32) {
                    pg8::Gemm g{}; g.A = proj; g.Bt = (const bf16_t*)(F.ws + WS_WM) + (size_t)l * DM * 2048; g.lda = NPROJ; g.ldb = 2048;
                    g.nM = part_rows(part) / 256; g.nN = 4; g.nseg = 3; g.k0[0] = 0; g.nt[0] = 16; g.k0[1] = 1024; g.nt[1] = 8; g.k0[2] = 1536; g.nt[2] = 8;
                    pg8::Order S; S.init(g.nM, g.nN, 3, F.G, F.bx);
                    pg8::EpiGate E{F.lds + LDS_XCH, proj, act + (size_t)part_row0(part) * DM, DM};
                    if (PROBE == 2) { pg8::EpiNone E0; pg8::gemm_phase<pg8::EpiNone>(F.lds, g, S, E0, F.tid); }
                    pg8::gemm_phase<pg8::EpiGate>(F.lds, g, S, E, F.tid);
                }
            } else if (s == 8) { if (PHMASK & 64) {
                pg8::Gemm g{}; g.A = act; g.Bt = (const bf16_t*)(F.ws + WS_WOUT) + (size_t)l * DM * DM; g.lda = DM; g.ldb = DM;
                g.nM = T_ALL / 256; g.nN = 4; g.nseg = 1; g.k0[0] = 0; g.nt[0] = 16; g.k0[1] = 0; g.nt[1] = 16; g.k0[2] = 0; g.nt[2] = 16;
                pg8::Order S; S.init(g.nM, g.nN, 1, F.G, F.bx, 1);
                if (l == 0) { pg8::EpiResidLn<0, true, false> E{F.in, F.ws, F.out, l, F.lds + LDS_XCH}; pg8::gemm_phase<pg8::EpiResidLn<0, true, false>>(F.lds, g, S, E, F.tid); }
                else { pg8::EpiResidLn<0, false, false> E{F.in, F.ws, F.out, l, F.lds + LDS_XCH}; pg8::gemm_phase<pg8::EpiResidLn<0, false, false>>(F.lds, g, S, E, F.tid); } }
            } else if (s == 9) { if (PHMASK & 256) {
                pg8::Gemm g{}; g.A = act; g.Bt = (const bf16_t*)(F.ws + WS_WF1) + (size_t)l * 2 * DFF * DM; g.lda = DM; g.ldb = DM;
                g.nM = T_ALL / 256; g.nN = 2 * DFF / 256; g.nseg = 1; g.k0[0] = 0; g.nt[0] = 16; g.k0[1] = 0; g.nt[1] = 16; g.k0[2] = 0; g.nt[2] = 16;
                pg8::Order S; S.init(g.nM, g.nN, 1, F.G, F.bx, 0, STAGGER);
                pg8::EpiSwiGLU E{proj, DFF};
                if (PROBE == 2) { pg8::EpiNone E0; pg8::gemm_phase<pg8::EpiNone>(F.lds, g, S, E0, F.tid); }
                if (PROBE == 7) pg8::gemm_phase<pg8::EpiSwiGLU>(F.lds, g, S, E, F.tid);
                pg8::gemm_phase<pg8::EpiSwiGLU>(F.lds, g, S, E, F.tid); }
            } else { if (PHMASK & 512) {
                pg8::Gemm g{}; g.A = proj; g.Bt = (const bf16_t*)(F.ws + WS_WF2) + (size_t)l * DM * DFF; g.lda = DFF; g.ldb = DFF;
                g.nM = T_ALL / 256; g.nN = 4; g.nseg = 1; g.k0[0] = 0; g.nt[0] = 44; g.k0[1] = 0; g.nt[1] = 44; g.k0[2] = 0; g.nt[2] = 44;
                pg8::Order S; S.init(g.nM, g.nN, 1, F.G, F.bx, 1);
                if (l + 1 < DEPTH) { pg8::EpiResidLn<1, false, false> E{F.in, F.ws, F.out, l, F.lds + LDS_XCH}; pg8::gemm_phase<pg8::EpiResidLn<1, false, false>>(F.lds, g, S, E, F.tid); }
                else { pg8::EpiResidLn<1, false, true> E{F.in, F.ws, F.out, l, F.lds + LDS_XCH}; pg8::gemm_phase<pg8::EpiResidLn<1, false, true>>(F.lds, g, S, E, F.tid); } }
            }
        }
        if (ph + 1 < args.ph_hi) {
            if (ph == args.ph_lo) { cg::this_grid().sync(); xbar = xcd_barrier_post(barw, bst); }
            else xcd_barrier(xbar);
            if (PROBE == 1 && ph == 1) { for (int k = 0; k < 20; ++k) xcd_barrier(xbar); }
        }
    }
}

extern "C" void kernel_launch(void* const* d_in, const int* in_sizes, int n_in, void* d_out, int out_size, void* d_ws, size_t ws_size, hipStream_t stream) {
    static int grid = 0;
    if (grid == 0) {
        if (n_in != 25 || ws_size < WS_END) { fprintf(stderr, "kernel_launch: unexpected n_in %d / ws %zu\n", n_in, ws_size); grid = -1; return; }
        int dev = 0, cus = 0, per_cu = 0;
        if (hipGetDevice(&dev) != hipSuccess || hipDeviceGetAttribute(&cus, hipDeviceAttributeMultiprocessorCount, dev) != hipSuccess) { grid = -1; return; }
        if (hipFuncSetAttribute((const void*)fwd_kernel, hipFuncAttributeMaxDynamicSharedMemorySize, LDS_BYTES) != hipSuccess) { fprintf(stderr, "kernel_launch: hipFuncSetAttribute failed\n"); grid = -1; return; }
        if (hipOccupancyMaxActiveBlocksPerMultiprocessor(&per_cu, (const void*)fwd_kernel, NW * 64, LDS_BYTES) != hipSuccess || per_cu < 1) per_cu = 1;
        (void)hipGetLastError();
        grid = cus * (per_cu > 1 ? 1 : per_cu);
    }
    if (grid < 0) return;
    Args a{};
    for (int i = 0; i < 25; ++i) a.in[i] = (const float*)d_in[i];
    a.out = (float*)d_out; a.ws = (unsigned char*)d_ws;
#if MK_MULTI
    for (int ph = 0; ph < NPHASE; ++ph) { a.ph_lo = ph; a.ph_hi = ph + 1; hipLaunchKernelGGL(fwd_kernel, dim3(grid), dim3(NW * 64), LDS_BYTES, stream, a); }
#else
    a.ph_lo = 0; a.ph_hi = NPHASE;
    void* kargs[] = {&a};
    hipError_t e = hipLaunchCooperativeKernel((const void*)fwd_kernel, dim3(grid), dim3(NW * 64), kargs, LDS_BYTES, stream);
    if (e != hipSuccess) fprintf(stderr, "cooperative launch failed: %s (grid %d)\n", hipGetErrorString(e), grid);
#endif
}
```

```cpp
#include <hip/hip_runtime.h>
#include <hip/hip_bf16.h>
#include <hip/hip_cooperative_groups.h>
#include <cstdio>
#include <cstdint>
namespace cg = cooperative_groups;

#ifndef PROBE
#define PROBE 0
#endif
#ifndef STAGGER
#define STAGGER 0
#endif
#ifndef GATE_PF
#define GATE_PF false
#endif
#ifndef MK_MULTI
#define MK_MULTI 0
#endif

#define LAS __attribute__((address_space(3)))
typedef unsigned short bf16_t;
typedef short bf16x8 __attribute__((ext_vector_type(8)));
typedef short s16x4 __attribute__((ext_vector_type(4)));
typedef float f32x2 __attribute__((ext_vector_type(2)));
typedef float f32x4 __attribute__((ext_vector_type(4)));
typedef float f32x16 __attribute__((ext_vector_type(16)));
typedef unsigned u32x2 __attribute__((ext_vector_type(2)));
typedef unsigned u32x4 __attribute__((ext_vector_type(4)));

constexpr int DM = 1024, NPROJ = 6144, DFF = 2816, DEPTH = 2;
constexpr int T_CTX = 4096, T_ALL = 36864;
constexpr int CTX_S = 256, LAT_S = 4096, PAST = 512, SKV_LAT = 4608;
constexpr int PC_Q = 0, PC_U = 1024, PC_K = 1536, PC_V = 1792, PC_XV = 2048, PC_XP = 2560, PC_G = 3072;
constexpr float LN_EPS = 1e-6f;
constexpr float ALPHA = 1.41421356237309515f;
constexpr int NW = 8;
__host__ __device__ constexpr int part_row0(int p) { return p == 0 ? 0 : 20480; }
__host__ __device__ constexpr int part_rows(int p) { return p == 0 ? 20480 : 16384; }

constexpr size_t MiB = 1u << 20;
constexpr size_t WS_MOD = 0;
constexpr size_t WS_BAR = 448 * 1024;
constexpr size_t WS_ROPE = 512 * 1024;
constexpr size_t WS_WSGU = 768 * 1024;
constexpr size_t WS_WIN = 1 * MiB;
constexpr size_t WS_WM = 25 * MiB;
constexpr size_t WS_WOUT = 33 * MiB;
constexpr size_t WS_WF1 = 37 * MiB;
constexpr size_t WS_WF2 = 59 * MiB;
constexpr size_t WS_ACT = 70 * MiB;
constexpr size_t WS_PROJ = 142 * MiB;
constexpr size_t WS_KL = 382 * MiB, WS_VL = 391 * MiB;
constexpr size_t WS_KC = 400 * MiB, WS_VC = 402 * MiB;
constexpr size_t WS_VRT = 404 * MiB;
constexpr size_t WS_XBUF = 424 * MiB;
constexpr size_t WS_CNT = 426 * MiB;
constexpr int CNT_WORDS = 4 * 144 * 64;
constexpr size_t WS_XB = 427 * MiB;
constexpr size_t WS_END = 499 * MiB;

constexpr int LDS_BYTES = 143360;
constexpr int LDS_XCH = 131072 + 256;

__device__ __forceinline__ unsigned cvt_pk_bf16(float lo, float hi) { unsigned r; asm volatile("v_cvt_pk_bf16_f32 %0, %1, %2" : "=v"(r) : "v"(lo), "v"(hi)); return r; }
__device__ __forceinline__ float bf_lo(unsigned u) { return __uint_as_float(u << 16); }
__device__ __forceinline__ float bf_hi(unsigned u) { return __uint_as_float(u & 0xffff0000u); }
__device__ __forceinline__ float wave_sum(float v) {
#pragma unroll
    for (int o = 1; o < 64; o <<= 1) v += __shfl_xor(v, o);
    return v;
}
__device__ __forceinline__ float gelu1(float v) {
    const float av = fabsf(v), d = av * 0.2316418882f + 1.0f;
    const float t = __builtin_amdgcn_rcpf(d);
    float q = t * 0.5307027145f + (-0.7265760135f); q = q * t + 0.7107068705f; q = q * t + (-0.142248368f); q = q * t + 0.127414796f; q = q * t;
    const float e = __builtin_amdgcn_exp2f((v * v) * (-0.72134752044f));
    const float m = v * (q * e), r = v - m;
    return v < 0.f ? m : r;
}
__device__ __forceinline__ float sigmoidf_(float x) { return __builtin_amdgcn_rcpf(1.0f + __expf(-x)); }

namespace pg8 {
constexpr int BM = 256, BK = 64, HALF = 128, HTB = HALF * BK * 2, STAGE_BYTES = 8 * HTB, NXCD = 8, WGM = 8;
__host__ __device__ __forceinline__ int lds_byte(int r, int c) { const int st = (r >> 4) * 2 + (c >> 5), rr = r & 15, cc = c & 31, ob = rr * 64 + cc * 2; return st * 1024 + (ob ^ (((ob >> 9) & 1) << 5)); }
__host__ __device__ __forceinline__ void stage_rc(int b, int& R, int& C) { const int st = b / 1024, sb = b % 1024, swz = sb ^ (((sb >> 9) & 1) << 5); R = (st >> 1) * 16 + swz / 64; C = (st & 1) * 32 + (swz % 64) / 2; }
__host__ __device__ __forceinline__ int perm32(int rho) { const int n = rho >> 4, i = rho & 15; return 8 * (i >> 2) + 4 * n + (i & 3); }

struct Unit { int pm, pn, seg; };
struct Gemm { const bf16_t* A; const bf16_t* Bt; int lda, ldb, nM, nN, nseg; int k0[3]; int nt[3]; };

struct Order {
    int nM, nN, nwg, G, c, nseg, team, stagger;
    __device__ void init(int nM_, int nN_, int nseg_, int G_, int c_, int team_ = 0, int stagger_ = 0) { nM = nM_; nN = nN_; nwg = nM * nN; G = G_; c = c_; nseg = nseg_; team = team_; stagger = stagger_; }
    __device__ bool next(int i, Unit& u) const {
        if (team) {
            u.seg = 0; const int j = c >> 3; u.pn = j & 3; u.pm = i * (G >> 2) + (j >> 2) * 8 + (c & 7); return u.pm < nM;
        }
        const int ti = i / nseg; u.seg = i - ti * nseg;
        const long L = (long)ti * G + c; if (L >= nwg) return false;
        int wgid = (int)L; { const int q = nwg / NXCD, r = nwg % NXCD, xcd = wgid % NXCD, off = wgid / NXCD; wgid = (xcd < r ? xcd * (q + 1) : r * (q + 1) + (xcd - r) * q) + off; }
        const int nig = WGM * nN, gid = wgid / nig, fm = gid * WGM, gsz = (nM - fm) < WGM ? (nM - fm) : WGM;
        u.pm = fm + ((wgid % nig) % gsz); u.pn = (wgid % nig) / gsz; return true;
    }
};

struct EpiStore {
    static constexpr bool PREFETCH = false;
    static constexpr bool PERM = true;
    bf16_t* O; int ldc; int gate_col0;
    __device__ __forceinline__ void run(f32x4 (&acc)[2][2][4][2], const Unit& u, int wr, int wc, int fr, int fq) const {
        const int row0 = u.pm * BM + wr * 64 + fr; const int col0 = u.pn * BM + wc * 32 + 8 * fq;
        const bool gate = u.pn * BM >= gate_col0;
#pragma unroll
        for (int ai = 0; ai < 2; ++ai)
#pragma unroll
            for (int m = 0; m < 4; ++m) { bf16_t* rowp = O + (size_t)(row0 + ai * HALF + m * 16) * ldc + col0;
#pragma unroll
                for (int bj = 0; bj < 2; ++bj) { f32x4 v0 = acc[ai][bj][m][0], v1 = acc[ai][bj][m][1];
                    if (gate) {
#pragma unroll
                        for (int e = 0; e < 4; ++e) { v0[e] = 1.0f + __expf(-fmaxf(v0[e], -80.f)); v1[e] = 1.0f + __expf(-fmaxf(v1[e], -80.f)); } }
                    u32x4 w; w.x = cvt_pk_bf16(v0[0], v0[1]); w.y = cvt_pk_bf16(v0[2], v0[3]); w.z = cvt_pk_bf16(v1[0], v1[1]); w.w = cvt_pk_bf16(v1[2], v1[3]);
                    *(u32x4*)(rowp + bj * HALF) = w; } }
    }
};
struct EpiSwiGLU {
    static constexpr bool PREFETCH = false;
    static constexpr bool PERM = true;
    bf16_t* O; int ldc;
    __device__ __forceinline__ void run(f32x4 (&acc)[2][2][4][2], const Unit& u, int wr, int wc, int fr, int fq) const {
        const int row0 = u.pm * BM + wr * 64 + fr; const int col0 = u.pn * HALF + wc * 32 + 8 * fq;
#pragma unroll
        for (int ai = 0; ai < 2; ++ai)
#pragma unroll
            for (int m = 0; m < 4; ++m) { bf16_t* rowp = O + (size_t)(row0 + ai * HALF + m * 16) * ldc + col0;
                float o[8];
#pragma unroll
                for (int n = 0; n < 2; ++n)
#pragma unroll
                    for (int e = 0; e < 4; ++e) { const float a = acc[ai][0][m][n][e], b = acc[ai][1][m][n][e]; o[n * 4 + e] = a * sigmoidf_(a) * b; }
                u32x4 w; w.x = cvt_pk_bf16(o[0], o[1]); w.y = cvt_pk_bf16(o[2], o[3]); w.z = cvt_pk_bf16(o[4], o[5]); w.w = cvt_pk_bf16(o[6], o[7]);
                *(u32x4*)rowp = w; }
    }
};
struct EpiResid {
    static constexpr bool PREFETCH = false;
    static constexpr bool PERM = false;
    const float* xres_ctx; const float* xres_lat;
    float* out; const float* mod; int goff;
    __device__ __forceinline__ void run(f32x4 (&acc)[2][2][4][2], const Unit& u, int wr, int wc, int fr, int fq) const {
        const int v = u.pm < 16 ? 0 : 1 + ((u.pm - 16) >> 4);
        const float* xb = u.pm < 16 ? xres_ctx + (size_t)u.pm * BM * DM : xres_lat + (size_t)(u.pm - 16) * BM * DM;
        float* ob = out + (size_t)u.pm * BM * DM;
        const int col0 = u.pn * BM + wc * 32 + 4 * fq;
        const float* gp = mod + v * 6144 + goff + col0;
        f32x4 gv[2][2];
#pragma unroll
        for (int bj = 0; bj < 2; ++bj)
#pragma unroll
            for (int n = 0; n < 2; ++n) gv[bj][n] = *(const f32x4*)(gp + bj * HALF + n * 16);
#pragma unroll
        for (int ai = 0; ai < 2; ++ai)
#pragma unroll
            for (int m = 0; m < 4; ++m) { const size_t off = (size_t)(ai * HALF + wr * 64 + m * 16 + fr) * DM + col0;
#pragma unroll
                for (int bj = 0; bj < 2; ++bj)
#pragma unroll
                    for (int n = 0; n < 2; ++n) { const f32x4 x = *(const f32x4*)(xb + off + bj * HALF + n * 16);
                        *(f32x4*)(ob + off + bj * HALF + n * 16) = x * ALPHA + gv[bj][n] * acc[ai][bj][m][n]; } }
    }
};

struct PanelStats {
    unsigned long long* xbuf;
    unsigned* cnt;
    LAS unsigned char* lx;
    __device__ __forceinline__ void run(const f32x4 (&v)[2][2][4][2], const Unit& u, int wr, int wc, int fr, int fq, int wid, int lane) const {
        LAS f32x2* P = (LAS f32x2*)lx; LAS f32x2* S = (LAS f32x2*)(lx + 8192);
#pragma unroll
        for (int ai = 0; ai < 2; ++ai)
#pragma unroll
            for (int m = 0; m < 4; ++m) {
                float s = 0.f;
#pragma unroll
                for (int bj = 0; bj < 2; ++bj)
#pragma unroll
                    for (int n = 0; n < 2; ++n) { const f32x4 x = v[ai][bj][m][n]; s += (x[0] + x[1]) + (x[2] + x[3]); }
                s += __shfl_xor(s, 16); s += __shfl_xor(s, 32);
                const float mw = s * (1.0f / 64.0f); float q = 0.f;
#pragma unroll
                for (int bj = 0; bj < 2; ++bj)
#pragma unroll
                    for (int n = 0; n < 2; ++n) { const f32x4 d = v[ai][bj][m][n] - mw; q += (d[0] * d[0] + d[1] * d[1]) + (d[2] * d[2] + d[3] * d[3]); }
                q += __shfl_xor(q, 16); q += __shfl_xor(q, 32);
                if (fq == 0) P[(ai * HALF + wr * 64 + m * 16 + fr) * 4 + wc] = (f32x2){mw, q};
            }
        asm volatile("s_waitcnt lgkmcnt(0)" ::: "memory"); __builtin_amdgcn_s_barrier(); asm volatile("" ::: "memory");
        const int row = wid * 32 + (lane & 31);
        if (lane < 32) {
            const f32x2 a = P[row * 4 + 0], b = P[row * 4 + 1], c = P[row * 4 + 2], d = P[row * 4 + 3];
            const float mt = (a.x + b.x + c.x + d.x) * 0.25f;
            const float da = a.x - mt, db = b.x - mt, dc = c.x - mt, dd = d.x - mt;
            const float m2 = (a.y + b.y) + (c.y + d.y) + 64.0f * ((da * da + db * db) + (dc * dc + dd * dd));
            unsigned long long* slot = xbuf + ((size_t)(u.pm * BM + row) * 4 + u.pn);
            __hip_atomic_store(slot, ((unsigned long long)__float_as_uint(m2) << 32) | __float_as_uint(mt), __ATOMIC_RELAXED, __HIP_MEMORY_SCOPE_AGENT);
        }
        asm volatile("s_waitcnt vmcnt(0)" ::: "memory");
        if (lane == 0) __hip_atomic_fetch_add(cnt + 64 * u.pm, 1u, __ATOMIC_RELAXED, __HIP_MEMORY_SCOPE_AGENT);
        if (wid == 0) {
            unsigned sp = 0;
            for (;;) {
                if ((unsigned)__builtin_amdgcn_readfirstlane(__hip_atomic_load(cnt + 64 * u.pm, __ATOMIC_RELAXED, __HIP_MEMORY_SCOPE_AGENT)) >= 32u) break;
                if (++sp > (1u << 22)) break;
                __builtin_amdgcn_s_sleep(2);
            }
            __builtin_amdgcn_fence(__ATOMIC_ACQUIRE, "agent");
        }
        asm volatile("s_waitcnt vmcnt(0) lgkmcnt(0)" ::: "memory"); __builtin_amdgcn_s_barrier(); asm volatile("" ::: "memory");
        if (lane < 32) {
            const unsigned long long* slot = xbuf + (size_t)(u.pm * BM + row) * 4; float mt[4], m2[4]; float ms = 0.f;
#pragma unroll
            for (int t = 0; t < 4; ++t) { const unsigned long long w = __hip_atomic_load(slot + t, __ATOMIC_RELAXED, __HIP_MEMORY_SCOPE_AGENT); mt[t] = __uint_as_float((unsigned)w); m2[t] = __uint_as_float((unsigned)(w >> 32)); ms += mt[t]; }
            const float mean = ms * 0.25f; float q = 0.f;
#pragma unroll
            for (int t = 0; t < 4; ++t) { const float dm = mt[t] - mean; q += m2[t] + 256.0f * dm * dm; }
            S[row] = (f32x2){mean, rsqrtf(q * (1.0f / 1024.0f) + LN_EPS)};
        }
        asm volatile("s_waitcnt lgkmcnt(0)" ::: "memory"); __builtin_amdgcn_s_barrier(); asm volatile("" ::: "memory");
    }
};
template <int WHICH, bool INF32, bool OUTF32>
struct EpiResidLn {
    static constexpr bool PERM = false;
    static constexpr bool PREFETCH = false;
    const float* const* in; unsigned char* ws; float* out_; int l; LAS unsigned char* lx;
    __device__ __forceinline__ void prefetch(const Unit& u, int it, int nit, int wid, int lane_) const {
        int lane = lane_; asm volatile("" : "+v"(lane));
        const float* xb = (WHICH == 0 && l == 0) ? (u.pm < 16 ? in[0] + (size_t)u.pm * BM * DM : in[1] + (size_t)(u.pm - 16) * BM * DM) : out_ + (size_t)u.pm * BM * DM;
        const int R = nit >= 16 ? 2 : 4;
#pragma unroll
        for (int k = 0; k < 4; ++k) { const int j = it * R + k;
            if (k < R && j < 32) __builtin_amdgcn_global_load_lds((const unsigned*)(xb + (size_t)(j * 8 + wid) * DM + u.pn * BM + lane * 4), (LAS unsigned*)(lx + 10240), 16, 0, 0); }
    }
    __device__ __forceinline__ void run(f32x4 (&acc)[2][2][4][2], const Unit& u, int wr, int wc, int fr_, int fq_) const {
        int fr = fr_, fq = fq_; asm volatile("" : "+v"(fr), "+v"(fq));
        int lv = l; asm volatile("" : "+v"(lv)); lv = __builtin_amdgcn_readfirstlane(lv);
        const float* mod = (const float*)(ws + 0) + lv * 9 * 6144;
        float* out = out_;
        const float* xres_ctx = (WHICH == 0 && lv == 0) ? in[0] : out;
        const float* xres_lat = (WHICH == 0 && lv == 0) ? in[1] : out + (size_t)T_CTX * DM;
        const int goff = WHICH == 0 ? 2048 : 5120;
        const float* lg = in[WHICH == 0 ? 19 : 23] + lv * DM; const float* lb = in[WHICH == 0 ? 20 : 24] + lv * DM;
        bf16_t* act = (bf16_t*)(ws + (size_t)70 * 1048576);
        const float* modn = WHICH == 0 ? mod : (const float*)(ws + 0) + (lv + 1 < DEPTH ? lv + 1 : lv) * 9 * 6144;
        const int sh_off = WHICH == 0 ? 3072 : 0, sc_off = WHICH == 0 ? 4096 : 1024;
        PanelStats st{(unsigned long long*)(ws + (size_t)424 * 1048576), (unsigned*)(ws + (size_t)426 * 1048576) + (lv * 2 + WHICH) * 144 * 64, lx};
        const int v = u.pm < 16 ? 0 : 1 + ((u.pm - 16) >> 4);
        const float* xb = u.pm < 16 ? xres_ctx + (size_t)u.pm * BM * DM : xres_lat + (size_t)(u.pm - 16) * BM * DM;
        float* ob = out + (size_t)u.pm * BM * DM;
        bf16_t* xs = (bf16_t*)(ws + (size_t)427 * 1048576);
        const int col0 = u.pn * BM + wc * 32 + 4 * fq;
        const size_t roff = (size_t)(wr * 64 + fr) * DM + col0;
        {
            const float* gp = mod + v * 6144 + goff + col0;
            if constexpr (INF32) {
#pragma unroll
                for (int bj = 0; bj < 2; ++bj)
#pragma unroll
                    for (int n = 0; n < 2; ++n) { const f32x4 gv = *(const f32x4*)(gp + bj * HALF + n * 16);
#pragma unroll
                        for (int ai = 0; ai < 2; ++ai) {
#pragma unroll
                            for (int m = 0; m < 4; ++m) { const size_t o_ = roff + (size_t)(ai * HALF + m * 16) * DM + bj * HALF + n * 16;
                                const f32x4 x = *(const f32x4*)(xb + o_); acc[ai][bj][m][n] = x * ALPHA + gv * acc[ai][bj][m][n]; }
#pragma unroll
                            for (int m = 0; m < 4; ++m) asm volatile("" : "+v"(acc[ai][bj][m][n]));
                            asm volatile("" ::: "memory"); } }
            } else {
                u32x2 xw[2][2][2][4];
                const bf16_t* xp_ = xs + (size_t)u.pm * BM * DM + roff;
#pragma unroll
                for (int bj = 0; bj < 2; ++bj)
#pragma unroll
                    for (int n = 0; n < 2; ++n)
#pragma unroll
                        for (int ai = 0; ai < 2; ++ai)
#pragma unroll
                            for (int m = 0; m < 4; ++m) xw[bj][n][ai][m] = *(const u32x2*)(xp_ + (size_t)(ai * HALF + m * 16) * DM + bj * HALF + n * 16);
#pragma unroll
                for (int bj = 0; bj < 2; ++bj)
#pragma unroll
                    for (int n = 0; n < 2; ++n) { const f32x4 gv = *(const f32x4*)(gp + bj * HALF + n * 16);
#pragma unroll
                        for (int ai = 0; ai < 2; ++ai)
#pragma unroll
                            for (int m = 0; m < 4; ++m) { const u32x2 w = xw[bj][n][ai][m]; const f32x4 x = (f32x4){bf_lo(w.x), bf_hi(w.x), bf_lo(w.y), bf_hi(w.y)};
                                acc[ai][bj][m][n] = x * ALPHA + gv * acc[ai][bj][m][n]; } }
            }
        }
        const int lane = fq * 16 + fr, wid = wr * 4 + wc;
        st.run(acc, u, wr, wc, fr, fq, wid, lane);
        const LAS f32x2* S = (const LAS f32x2*)(st.lx + 8192);
        const float* mv = modn + v * 6144;
#pragma unroll
        for (int bj = 0; bj < 2; ++bj)
#pragma unroll
            for (int n = 0; n < 2; ++n) { const int c = col0 + bj * HALF + n * 16;
                const f32x4 g4 = *(const f32x4*)(lg + c), b4 = *(const f32x4*)(lb + c);
                f32x4 sh = (f32x4){0.f, 0.f, 0.f, 0.f}, sc = sh;
                sh = *(const f32x4*)(mv + sh_off + c); sc = *(const f32x4*)(mv + sc_off + c) + 1.0f;
#pragma unroll
                for (int ai = 0; ai < 2; ++ai)
#pragma unroll
                    for (int m = 0; m < 4; ++m) { const size_t off = roff + (size_t)(ai * HALF + m * 16) * DM + bj * HALF + n * 16;
                        const f32x2 sr = S[ai * HALF + wr * 64 + m * 16 + fr];
                        const f32x4 y = (acc[ai][bj][m][n] - sr.x) * sr.y * g4 + b4;
                        if (OUTF32) *(f32x4*)(ob + off) = y;
                        else { u32x2 w; w.x = cvt_pk_bf16(y[0], y[1]); w.y = cvt_pk_bf16(y[2], y[3]); *(u32x2*)(xs + (size_t)u.pm * BM * DM + off) = w; }
                        if (WHICH == 0 || lv + 1 < DEPTH) { const f32x4 h = y * sc + sh; u32x2 w; w.x = cvt_pk_bf16(h[0], h[1]); w.y = cvt_pk_bf16(h[2], h[3]);
                            *(u32x2*)(act + (size_t)u.pm * BM * DM + off) = w; } }
                asm volatile("" ::: "memory"); }
    }
};
struct EpiGate {
    static constexpr bool PERM = true;
    static constexpr bool PREFETCH = GATE_PF;
    LAS unsigned char* lx;
    __device__ __forceinline__ void prefetch(const Unit& u, int it, int nit, int wid, int lane_) const {
        if (u.seg == 2) return;
        int lane = lane_; asm volatile("" : "+v"(lane));
        const bf16_t* gb = P + (size_t)u.pm * BM * NPROJ + PC_G + u.pn * BM + (lane & 31) * 8;
#pragma unroll
        for (int k = 0; k < 4; ++k) { const int j = it * 4 + k;
            const int tile = u.seg == 0 ? (j >> 4) : 0; const int goff = u.seg == 0 ? (tile == 0 ? 0 : 2048) : 1024; const int jr = j & 15;
            if (j < (u.seg == 0 ? 32 : 16)) __builtin_amdgcn_global_load_lds((const unsigned*)(gb + (size_t)(jr * 16 + wid * 2 + (lane >> 5)) * NPROJ + goff), (LAS unsigned*)(lx + 10240), 16, 0, 0); }
    }
    const bf16_t* P;
    bf16_t* O; int ldc;
    __device__ __forceinline__ void run(f32x4 (&acc)[2][2][4][2], const Unit& u, int wr, int wc, int fr_, int fq_) const {
        int fr = fr_, fq = fq_; asm volatile("" : "+v"(fr), "+v"(fq));
        const int row0 = u.pm * BM + wr * 64 + fr; const int col0 = u.pn * BM + wc * 32 + 8 * fq;
        const bf16_t* gbase = P + (size_t)row0 * NPROJ + PC_G + col0;
        const bool last = u.seg == 2;
        const int noff = u.seg == 0 ? 0 : (u.seg == 1 ? 2048 : 1024), doff = u.seg == 0 ? 2048 : 1024;
#pragma unroll
        for (int am = 0; am < 2; ++am) { const int ai = am, mb = 0;
            u32x4 gn[4][2], gd[4][2];
#pragma unroll
            for (int mm = 0; mm < 4; ++mm)
#pragma unroll
                for (int bj = 0; bj < 2; ++bj) { const bf16_t* gp = gbase + (size_t)(ai * HALF + (mb + mm) * 16) * NPROJ + bj * HALF;
                    gn[mm][bj] = *(const u32x4*)(gp + noff); gd[mm][bj] = *(const u32x4*)(gp + doff); }
#pragma unroll
            for (int mm = 0; mm < 4; ++mm)
#pragma unroll
                for (int bj = 0; bj < 2; ++bj) { const int m = mb + mm; f32x4 v0 = acc[ai][bj][m][0], v1 = acc[ai][bj][m][1];
#pragma unroll
                    for (int e = 0; e < 2; ++e) {
                        v0[2 * e]     *= (last ? 1.0f : bf_lo(gd[mm][bj][e])) * __builtin_amdgcn_rcpf(bf_lo(gn[mm][bj][e]));
                        v0[2 * e + 1] *= (last ? 1.0f : bf_hi(gd[mm][bj][e])) * __builtin_amdgcn_rcpf(bf_hi(gn[mm][bj][e]));
                        v1[2 * e]     *= (last ? 1.0f : bf_lo(gd[mm][bj][2 + e])) * __builtin_amdgcn_rcpf(bf_lo(gn[mm][bj][2 + e]));
                        v1[2 * e + 1] *= (last ? 1.0f : bf_hi(gd[mm][bj][2 + e])) * __builtin_amdgcn_rcpf(bf_hi(gn[mm][bj][2 + e])); }
                    acc[ai][bj][m][0] = v0; acc[ai][bj][m][1] = v1;
                    if (last) { u32x4 w; w.x = cvt_pk_bf16(v0[0], v0[1]); w.y = cvt_pk_bf16(v0[2], v0[3]); w.z = cvt_pk_bf16(v1[0], v1[1]); w.w = cvt_pk_bf16(v1[2], v1[3]);
                        *(u32x4*)(O + (size_t)(row0 + ai * HALF + m * 16) * ldc + col0 + bj * HALF) = w; } }
            asm volatile("" ::: "memory");
        }
    }
};

struct EpiNone { static constexpr bool PREFETCH = false; static constexpr bool PERM = true; __device__ __forceinline__ void run(f32x4 (&acc)[2][2][4][2], const Unit& u, int wr, int wc, int fr, int fq) const {
    _Pragma("unroll") for (int a = 0; a < 2; ++a) _Pragma("unroll") for (int b = 0; b < 2; ++b) _Pragma("unroll") for (int m = 0; m < 4; ++m) _Pragma("unroll") for (int n = 0; n < 2; ++n) asm volatile("" :: "v"(acc[a][b][m][n])); } };
template <class Epi>
__device__ __forceinline__ void gemm_phase(LAS unsigned char* lds, const Gemm g, const Order& S, const Epi& E, const int tid) {
    const int wid = __builtin_amdgcn_readfirstlane(tid >> 6), lane = tid & 63, wr = wid >> 2, wc = wid & 3, fr = lane & 15, fq = lane >> 4;
    unsigned voffA[2], voffB[2];
#pragma unroll
    for (int i = 0; i < 2; ++i) { int R, C; stage_rc(tid * 16 + i * 8192, R, C); const int Rb = Epi::PERM ? ((R & ~31) + perm32(R & 31)) : R;
        voffA[i] = (unsigned)(R * g.lda + C) * 2u; voffB[i] = (unsigned)(Rb * g.ldb + C) * 2u; }
    const size_t kstep = (size_t)(BK * 2);
    const size_t hstepA = (size_t)HALF * g.lda * 2, hstepB = (size_t)HALF * g.ldb * 2;
    const size_t tstepA = 2 * hstepA, tstepB = 2 * hstepB;
    const unsigned ldsw = (unsigned)wid * 1024u;
    const int aoff = lds_byte(wr * 64 + fr, fq * 8), boff = lds_byte(wc * 32 + fr, fq * 8);
#define PG8_SA(b, h) (((b) * 2 + (h)) * HTB)
#define PG8_SB(b, h) ((4 + (b) * 2 + (h)) * HTB)
#define PG8_STAGE(bufoff, gbase, voff) do { _Pragma("unroll") for (int _i = 0; _i < 2; ++_i) \
        __builtin_amdgcn_global_load_lds((const unsigned*)((const char*)(gbase) + (voff)[_i]), (LAS unsigned*)(lds + (bufoff) + ldsw + _i * 8192), 16, 0, 0); } while (0)
#define PG8_LDA(dst, b, h) do { _Pragma("unroll") for (int m = 0; m < 4; ++m) _Pragma("unroll") for (int k = 0; k < 2; ++k) dst[m][k] = *(const LAS bf16x8*)(lds + PG8_SA(b, h) + aoff + m * 2048 + k * 1024); } while (0)
#define PG8_LDB(dst, b, h) do { _Pragma("unroll") for (int n = 0; n < 2; ++n) _Pragma("unroll") for (int k = 0; k < 2; ++k) dst[n][k] = *(const LAS bf16x8*)(lds + PG8_SB(b, h) + boff + n * 2048 + k * 1024); } while (0)
#define PG8_MMA(ai, bj, At, Bt) do { __builtin_amdgcn_s_setprio(1); _Pragma("unroll") for (int m = 0; m < 4; ++m) _Pragma("unroll") for (int n = 0; n < 2; ++n) _Pragma("unroll") for (int k = 0; k < 2; ++k) \
        acc[ai][bj][m][n] = __builtin_amdgcn_mfma_f32_16x16x32_bf16(Bt[n][k], At[m][k], acc[ai][bj][m][n], 0, 0, 0); __builtin_amdgcn_s_setprio(0); } while (0)
#define PG8_WAIT_V(n) asm volatile("s_waitcnt vmcnt(" #n ")" ::: "memory")
#define PG8_WAIT_L(n) asm volatile("s_waitcnt lgkmcnt(" #n ")" ::: "memory")
#define PG8_BAR __builtin_amdgcn_s_barrier()
#define PG8_SCHED __builtin_amdgcn_sched_barrier(0)
#define KOF(sg) ((sg) == 0 ? g.k0[0] : ((sg) == 1 ? g.k0[1] : g.k0[2]))
#define NTF(sg) ((sg) == 0 ? g.nt[0] : ((sg) == 1 ? g.nt[1] : g.nt[2]))
    Unit cur, nxt; int ui = 0;
    if (!S.next(0, cur)) return;
    if (S.stagger) {
        const int mine = (S.nwg - S.c + S.G - 1) / S.G, mx = (S.nwg + S.G - 1) / S.G;
        if (mine < mx) { const unsigned long long t0 = __builtin_amdgcn_s_memrealtime(); while (__builtin_amdgcn_s_memrealtime() - t0 < (unsigned long long)S.stagger) __builtin_amdgcn_s_sleep(16); }
    }
    f32x4 acc[2][2][4][2];
#pragma unroll
    for (int a = 0; a < 2; ++a)
#pragma unroll
        for (int b = 0; b < 2; ++b)
#pragma unroll
            for (int m = 0; m < 4; ++m)
#pragma unroll
                for (int n = 0; n < 2; ++n) acc[a][b][m][n] = (f32x4){0.f, 0.f, 0.f, 0.f};
    bf16x8 At[4][2], B0[2][2], B1[2][2];
    const char* cA = (const char*)g.A + (size_t)cur.pm * tstepA + (size_t)KOF(cur.seg) * 2; const char* cB = (const char*)g.Bt + (size_t)cur.pn * tstepB + (size_t)KOF(cur.seg) * 2;
    PG8_STAGE(PG8_SB(0, 0), cB, voffB); PG8_STAGE(PG8_SB(0, 1), cB + hstepB, voffB); PG8_STAGE(PG8_SA(0, 0), cA, voffA); PG8_STAGE(PG8_SA(0, 1), cA + hstepA, voffA);
    if (wr == 1) PG8_BAR;
    PG8_WAIT_V(2); PG8_BAR;
    PG8_STAGE(PG8_SB(1, 0), cB + kstep, voffB); PG8_STAGE(PG8_SA(1, 0), cA + kstep, voffA); PG8_STAGE(PG8_SB(1, 1), cB + hstepB + kstep, voffB);
    PG8_WAIT_V(6); PG8_BAR;
    for (;;) {
        const bool has_next = S.next(ui + 1, nxt);
        const int nt = NTF(cur.seg);
        const char* nA = has_next ? (const char*)g.A + (size_t)nxt.pm * tstepA + (size_t)KOF(nxt.seg) * 2 : cA;
        const char* nB = has_next ? (const char*)g.Bt + (size_t)nxt.pn * tstepB + (size_t)KOF(nxt.seg) * 2 : cB;
        for (int t = 0; t < nt; t += 2) {
            const bool last = (t == nt - 2);
            const char* a1 = cA + (size_t)(t + 1) * kstep;
            const char* a2 = last ? nA : cA + (size_t)(t + 2) * kstep; const char* b2 = last ? nB : cB + (size_t)(t + 2) * kstep;
            const char* a3 = a2 + kstep; const char* b3 = b2 + kstep;
            PG8_LDB(B0, 0, 0); PG8_LDB(B1, 0, 1); PG8_SCHED; PG8_LDA(At, 0, 0); PG8_STAGE(PG8_SA(1, 1), a1 + hstepA, voffA);
            if constexpr (Epi::PREFETCH) E.prefetch(cur, t >> 1, nt >> 1, wid, lane);
            PG8_WAIT_V(8); PG8_WAIT_L(0); PG8_BAR; PG8_MMA(0, 0, At, B0); PG8_MMA(0, 1, At, B1); PG8_BAR; PG8_SCHED;
            PG8_LDA(At, 0, 1); PG8_STAGE(PG8_SB(0, 0), b2, voffB); PG8_STAGE(PG8_SB(0, 1), b2 + hstepB, voffB); PG8_STAGE(PG8_SA(0, 0), a2, voffA);
            PG8_WAIT_V(8); PG8_WAIT_L(0); PG8_BAR; PG8_MMA(1, 0, At, B0); PG8_MMA(1, 1, At, B1); PG8_BAR; PG8_SCHED;
            PG8_LDB(B0, 1, 0); PG8_LDB(B1, 1, 1); PG8_SCHED; PG8_LDA(At, 1, 0); PG8_STAGE(PG8_SA(0, 1), a2 + hstepA, voffA);
            PG8_WAIT_V(8); PG8_WAIT_L(0); PG8_BAR; PG8_MMA(0, 0, At, B0); PG8_MMA(0, 1, At, B1); PG8_BAR; PG8_SCHED;
            PG8_LDA(At, 1, 1); PG8_STAGE(PG8_SB(1, 0), b3, voffB); PG8_STAGE(PG8_SB(1, 1), b3 + hstepB, voffB); PG8_STAGE(PG8_SA(1, 0), a3, voffA);
            PG8_WAIT_V(8); PG8_WAIT_L(0); PG8_BAR; PG8_MMA(1, 0, At, B0); PG8_MMA(1, 1, At, B1); PG8_BAR; PG8_SCHED;
        }
        if (wr == 0) PG8_BAR;
        E.run(acc, cur, wr, wc, fr, fq);
        if (!has_next) break;
        if (cur.seg == g.nseg - 1) {
#pragma unroll
            for (int a = 0; a < 2; ++a)
#pragma unroll
                for (int b = 0; b < 2; ++b)
#pragma unroll
                    for (int m = 0; m < 4; ++m)
#pragma unroll
                        for (int n = 0; n < 2; ++n) acc[a][b][m][n] = (f32x4){0.f, 0.f, 0.f, 0.f};
        }
        cur = nxt; cA = nA; cB = nB; ++ui;
        if (wr == 1) PG8_BAR;
    }
    PG8_WAIT_V(0);
    PG8_BAR;
#undef KOF
#undef NTF
#undef PG8_SA
#undef PG8_SB
#undef PG8_STAGE
#undef PG8_LDA
#undef PG8_LDB
#undef PG8_MMA
#undef PG8_WAIT_V
#undef PG8_WAIT_L
#undef PG8_BAR
#undef PG8_SCHED
}
}

namespace att {
constexpr int D = 128, QBLK = 32, KVBLK = 64;
constexpr float SCALE = 0.088388347648318440f;
constexpr float THR = 8.f;
constexpr size_t SHM_V = KVBLK * D * 2, SHM_K = KVBLK * D * 2, SHM_ATTN = 2 * SHM_V + 2 * SHM_K + NW * 64 * 4;
#define KSWZ(row, colB) ((row) * 256 + ((colB) ^ (((row) & 7) << 4)))
#define SBAR() __builtin_amdgcn_sched_barrier(0)
__device__ __forceinline__ int crow(int r, int hi) { return (r & 3) + 8 * (r >> 2) + 4 * hi; }
__device__ __forceinline__ unsigned cvtpk(float lo, float hi) { unsigned r; asm volatile("v_cvt_pk_bf16_f32 %0, %1, %2" : "=v"(r) : "v"(lo), "v"(hi)); return r; }
__device__ __forceinline__ void partialSM(f32x16& p0, f32x16& p1, float& m_reg, float& mn, float& alpha) {
  constexpr float C = SCALE * 1.4426950408889634f;
  float pmax = p0[0];
#pragma unroll
  for (int r = 1; r < 16; ++r) pmax = fmaxf(pmax, p0[r]);
#pragma unroll
  for (int r = 0; r < 16; ++r) pmax = fmaxf(pmax, p1[r]);
  { auto rr = __builtin_amdgcn_permlane32_swap(__float_as_uint(pmax), __float_as_uint(pmax), false, false);
    pmax = fmaxf(__uint_as_float(rr[0]), __uint_as_float(rr[1])); }
  if (__builtin_expect(__all(pmax - m_reg <= THR / SCALE), 1)) { mn = m_reg; alpha = 1.f; }
  else { mn = fmaxf(m_reg, pmax); alpha = __builtin_amdgcn_exp2f((m_reg - mn) * C); m_reg = mn; }
  float mnC = -mn * C;
#pragma unroll
  for (int r = 0; r < 16; ++r) p0[r] = fmaf(p0[r], C, mnC);
#pragma unroll
  for (int r = 0; r < 16; ++r) p1[r] = fmaf(p1[r], C, mnC);
#pragma unroll
  for (int r = 0; r < 16; ++r) p0[r] = __builtin_amdgcn_exp2f(p0[r]);
}
__device__ __forceinline__ void finishSM(f32x16& p0, f32x16& p1, float alpha, float& l_reg, bf16x8& pa0, bf16x8& pa1, bf16x8& pa2, bf16x8& pa3) {
#pragma unroll
  for (int r = 0; r < 16; ++r) p1[r] = __builtin_amdgcn_exp2f(p1[r]);
  float ps = 0;
#pragma unroll
  for (int r = 0; r < 16; ++r) ps += p0[r];
#pragma unroll
  for (int r = 0; r < 16; ++r) ps += p1[r];
  { auto rr = __builtin_amdgcn_permlane32_swap(__float_as_uint(ps), __float_as_uint(ps), false, false);
    ps = __uint_as_float(rr[0]) + __uint_as_float(rr[1]); }
  l_reg = l_reg * alpha + ps;
#define PK4(P, BASE, OUT) do { unsigned a0 = cvtpk(P[BASE + 0], P[BASE + 1]), a1 = cvtpk(P[BASE + 2], P[BASE + 3]);   \
    unsigned b0 = cvtpk(P[BASE + 4], P[BASE + 5]), b1 = cvtpk(P[BASE + 6], P[BASE + 7]);                              \
    auto r0 = __builtin_amdgcn_permlane32_swap(a0, b0, false, false); auto r1 = __builtin_amdgcn_permlane32_swap(a1, b1, false, false); \
    u32x4 w = {r0[0], r1[0], r0[1], r1[1]}; OUT = *reinterpret_cast<bf16x8*>(&w); } while (0)
  PK4(p0, 0, pa0); PK4(p0, 8, pa1); PK4(p1, 0, pa2); PK4(p1, 8, pa3);
#undef PK4
}
__device__ __forceinline__ void qkt(f32x16& p0, f32x16& p1, const bf16_t* Ks, const bf16x8* qr, int r32, int hi) {
  p0 = f32x16{}; p1 = f32x16{};
#pragma unroll
  for (int d0 = 0; d0 < 8; ++d0) { int cb = (d0 * 16 + hi * 8) * 2;
    bf16x8 b0 = *reinterpret_cast<const bf16x8*>((const char*)Ks + KSWZ(r32, cb));
    bf16x8 b1 = *reinterpret_cast<const bf16x8*>((const char*)Ks + KSWZ(32 + r32, cb));
    p0 = __builtin_amdgcn_mfma_f32_32x32x16_bf16(b0, qr[d0], p0, 0, 0, 0);
    p1 = __builtin_amdgcn_mfma_f32_32x32x16_bf16(b1, qr[d0], p1, 0, 0, 0); }
}
__device__ __forceinline__ int v_st(int k, int c) { const int kk = (k & ~0xC) | ((k & 4) << 1) | ((k & 8) >> 1); return ((kk >> 3) * 4 + (c >> 5)) * 512 + ((kk & 7) * 32 + (c & 31)) * 2; }
__device__ __forceinline__ int v_rd_base(int lane) { return ((lane & 3) << 3) | (((lane >> 2) & 3) << 6) | (((lane >> 4) & 1) << 5) | (((lane >> 5) & 1) << 8); }
constexpr int v_rd_off(int d0, int ks, int half) { return d0 * 512 + ks * 4096 + half * 2048; }
template <int OFF> __device__ __forceinline__ s16x4 tr_read(int vb) {
  s16x4 r; asm volatile("ds_read_b64_tr_b16 %0, %1 offset:%2" : "=&v"(r) : "v"(vb), "i"(OFF) : "memory"); return r;
}
template <int D0> __device__ __forceinline__ void pv_one(f32x16& od, int vb, bf16x8 pa0, bf16x8 pa1, bf16x8 pa2, bf16x8 pa3) {
  const s16x4 l0 = tr_read<v_rd_off(D0, 0, 0)>(vb), h0 = tr_read<v_rd_off(D0, 0, 1)>(vb), l1 = tr_read<v_rd_off(D0, 1, 0)>(vb), h1 = tr_read<v_rd_off(D0, 1, 1)>(vb);
  const s16x4 l2 = tr_read<v_rd_off(D0, 2, 0)>(vb), h2 = tr_read<v_rd_off(D0, 2, 1)>(vb), l3 = tr_read<v_rd_off(D0, 3, 0)>(vb), h3 = tr_read<v_rd_off(D0, 3, 1)>(vb);
  asm volatile("s_waitcnt lgkmcnt(0)" ::: "memory"); SBAR();
#define PK(L, H) (bf16x8){L[0], L[1], L[2], L[3], H[0], H[1], H[2], H[3]}
  od = __builtin_amdgcn_mfma_f32_32x32x16_bf16(pa0, PK(l0, h0), od, 0, 0, 0);
  od = __builtin_amdgcn_mfma_f32_32x32x16_bf16(pa1, PK(l1, h1), od, 0, 0, 0);
  od = __builtin_amdgcn_mfma_f32_32x32x16_bf16(pa2, PK(l2, h2), od, 0, 0, 0);
  od = __builtin_amdgcn_mfma_f32_32x32x16_bf16(pa3, PK(l3, h3), od, 0, 0, 0);
#undef PK
}
__device__ __forceinline__ void pv_d0(f32x16* o, int vb, bf16x8 pa0, bf16x8 pa1, bf16x8 pa2, bf16x8 pa3) {
  pv_one<0>(o[0], vb, pa0, pa1, pa2, pa3); pv_one<1>(o[1], vb, pa0, pa1, pa2, pa3); pv_one<2>(o[2], vb, pa0, pa1, pa2, pa3); pv_one<3>(o[3], vb, pa0, pa1, pa2, pa3);
}
constexpr int LDQ = NPROJ, LDK = 256;
__device__ __forceinline__ void attn_dense_body(bf16_t* Qb, const bf16_t* __restrict__ Kh, const bf16_t* __restrict__ Vh, int seq, char* lds, const int tid, const float* __restrict__ qg, const float* __restrict__ rope, int s0, const bool STORE = true) {
  const int wid = tid >> 6, lane = tid & 63, r32 = lane & 31, hi = lane >> 5;
  bf16_t* V_lds = (bf16_t*)lds; bf16_t* K_lds = (bf16_t*)(lds + 2 * SHM_V);
  float* ws = (float*)(lds + 2 * SHM_V + 2 * SHM_K) + wid * 64; float* li_l = ws; float* al_l = ws + 32;
  float m_reg = -1e30f, l_reg = 0; f32x16 o[4] = {}; bf16x8 qr[8];
  const bf16_t* Qw = Qb + (long)(wid * QBLK + r32) * LDQ + hi * 8;
#pragma unroll
  for (int d0 = 0; d0 < 8; ++d0) qr[d0] = *reinterpret_cast<const bf16x8*>(Qw + d0 * 16);
  {
    float ss = 0.f;
#pragma unroll
    for (int d0 = 0; d0 < 8; ++d0) { const u32x4 w = __builtin_bit_cast(u32x4, qr[d0]);
#pragma unroll
      for (int e = 0; e < 4; ++e) { const float lo = __uint_as_float(w[e] << 16), hi_ = __uint_as_float(w[e] & 0xffff0000u); ss += lo * lo + hi_ * hi_; } }
    { auto rr = __builtin_amdgcn_permlane32_swap(__float_as_uint(ss), __float_as_uint(ss), false, false); ss = __uint_as_float(rr[0]) + __uint_as_float(rr[1]); }
    const float rinv = rsqrtf(ss * (1.0f / 128.0f) + LN_EPS);
    const int sp = s0 + wid * QBLK + r32;
#pragma unroll
    for (int a = 0; a < 2; ++a) {
      float qf[4][8];
#pragma unroll
      for (int dd = 0; dd < 4; ++dd) { const int d0 = a * 4 + dd; const u32x4 w = __builtin_bit_cast(u32x4, qr[d0]);
        const f32x4 g0 = *(const f32x4*)(qg + d0 * 16 + hi * 8), g1 = *(const f32x4*)(qg + d0 * 16 + hi * 8 + 4);
        qf[dd][0] = __uint_as_float(w[0] << 16) * (rinv * g0[0]); qf[dd][1] = __uint_as_float(w[0] & 0xffff0000u) * (rinv * g0[1]);
        qf[dd][2] = __uint_as_float(w[1] << 16) * (rinv * g0[2]); qf[dd][3] = __uint_as_float(w[1] & 0xffff0000u) * (rinv * g0[3]);
        qf[dd][4] = __uint_as_float(w[2] << 16) * (rinv * g1[0]); qf[dd][5] = __uint_as_float(w[2] & 0xffff0000u) * (rinv * g1[1]);
        qf[dd][6] = __uint_as_float(w[3] << 16) * (rinv * g1[2]); qf[dd][7] = __uint_as_float(w[3] & 0xffff0000u) * (rinv * g1[3]); }
      if (rope) { const int pos = a == 0 ? (sp >> 6) : (sp & 63);
#pragma unroll
        for (int dd = 0; dd < 2; ++dd) { const float* cp = rope + pos * 32 + dd * 16 + hi * 8;
          const f32x4 c0 = *(const f32x4*)cp, c1 = *(const f32x4*)(cp + 4), s0v = *(const f32x4*)(cp + 2048), s1v = *(const f32x4*)(cp + 2048 + 4);
#pragma unroll
          for (int e = 0; e < 4; ++e) { float x1 = qf[dd][e], x2 = qf[dd + 2][e]; qf[dd][e] = x1 * c0[e] - x2 * s0v[e]; qf[dd + 2][e] = x2 * c0[e] + x1 * s0v[e];
            x1 = qf[dd][4 + e]; x2 = qf[dd + 2][4 + e]; qf[dd][4 + e] = x1 * c1[e] - x2 * s1v[e]; qf[dd + 2][4 + e] = x2 * c1[e] + x1 * s1v[e]; } } }
#pragma unroll
      for (int dd = 0; dd < 4; ++dd) { u32x4 w; w.x = cvtpk(qf[dd][0], qf[dd][1]); w.y = cvtpk(qf[dd][2], qf[dd][3]); w.z = cvtpk(qf[dd][4], qf[dd][5]); w.w = cvtpk(qf[dd][6], qf[dd][7]); qr[a * 4 + dd] = __builtin_bit_cast(bf16x8, w); }
      asm volatile("" ::: "memory");
    }
  }
  int tid2 = tid; asm volatile("" : "+v"(tid2));
  const int sr = tid2 >> 4, sc = (tid2 & 15) * 8, vst0 = v_st(sr, sc), vst1 = v_st(32 + sr, sc);
  const int vb0 = (int)(uintptr_t)V_lds + v_rd_base(tid2 & 63);
  struct { bf16x8 vs0, vs1, ks0, ks1; } sr_[1];
#define LD8(p) (*reinterpret_cast<const bf16x8*>(p))
#define SLOAD(i, k0) do { sr_[i].vs0 = LD8(&Vh[(long)((k0) + sr) * LDK + sc]); sr_[i].vs1 = LD8(&Vh[(long)((k0) + 32 + sr) * LDK + sc]); \
    sr_[i].ks0 = LD8(&Kh[(long)((k0) + sr) * LDK + sc]); sr_[i].ks1 = LD8(&Kh[(long)((k0) + 32 + sr) * LDK + sc]); } while (0)
#define SWRITE(b, i) do { *(bf16x8*)((char*)V_lds + (b) * SHM_V + vst0) = sr_[i].vs0;          \
    *(bf16x8*)((char*)V_lds + (b) * SHM_V + vst1) = sr_[i].vs1; int kc = sc * 2;               \
    *(bf16x8*)((char*)K_lds + (b) * SHM_K + KSWZ(sr, kc)) = sr_[i].ks0;                       \
    *(bf16x8*)((char*)K_lds + (b) * SHM_K + KSWZ(32 + sr, kc)) = sr_[i].ks1; } while (0)
#define SWAIT() asm volatile("s_waitcnt vmcnt(0)" ::: "memory")
#define RESC(a) do { if (__any((a) < 1.f)) { if (hi == 0) al_l[r32] = (a); asm volatile("s_waitcnt lgkmcnt(0)" ::: "memory"); \
    _Pragma("unroll") for (int d = 0; d < 4; ++d) _Pragma("unroll") for (int r = 0; r < 16; ++r) o[d][r] *= al_l[crow(r, hi)]; } } while (0)
  f32x16 pA0, pA1, pB0, pB1; float mnA, mnB, alA, alB; bf16x8 pa0, pa1, pa2, pa3; const int NT = seq / KVBLK;
  constexpr int SE = 0, SO = 0;
  SLOAD(SE, 0); asm volatile("s_waitcnt vmcnt(0)" ::: "memory"); SWRITE(0, SE); __syncthreads();
  qkt(pA0, pA1, K_lds, qr, r32, hi); partialSM(pA0, pA1, m_reg, mnA, alA);
  SLOAD(SO, KVBLK);
  SWAIT(); SWRITE(1, SO); __syncthreads();
  for (int j = 1; j + 1 < NT; j += 2) {
    SBAR(); qkt(pB0, pB1, (bf16_t*)((char*)K_lds + SHM_K), qr, r32, hi);
    finishSM(pA0, pA1, alA, l_reg, pa0, pa1, pa2, pa3); SBAR();
    SLOAD(SO, (j + 1) * KVBLK); SBAR();
    pv_d0(o, vb0, pa0, pa1, pa2, pa3); partialSM(pB0, pB1, m_reg, mnB, alB);
    __syncthreads(); SWAIT(); SWRITE(0, SE);
    RESC(alB); __syncthreads();
    SBAR(); qkt(pA0, pA1, K_lds, qr, r32, hi);
    finishSM(pB0, pB1, alB, l_reg, pa0, pa1, pa2, pa3); SBAR();
    SLOAD(SE, (j + 2) * KVBLK); SBAR();
    pv_d0(o, vb0 + (int)SHM_V, pa0, pa1, pa2, pa3); partialSM(pA0, pA1, m_reg, mnA, alA);
    __syncthreads(); SWAIT(); SWRITE(1, SO);
    RESC(alA); __syncthreads();
  }
  SBAR(); qkt(pB0, pB1, (bf16_t*)((char*)K_lds + SHM_K), qr, r32, hi);
  finishSM(pA0, pA1, alA, l_reg, pa0, pa1, pa2, pa3); SBAR();
  pv_d0(o, vb0, pa0, pa1, pa2, pa3); partialSM(pB0, pB1, m_reg, mnB, alB);
  __syncthreads(); RESC(alB);
  finishSM(pB0, pB1, alB, l_reg, pa0, pa1, pa2, pa3); SBAR();
  pv_d0(o, vb0 + (int)SHM_V, pa0, pa1, pa2, pa3);
  if (hi == 0) li_l[r32] = l_reg; asm volatile("s_waitcnt lgkmcnt(0)" ::: "memory");
  float rli[16];
#pragma unroll
  for (int r = 0; r < 16; ++r) rli[r] = __builtin_amdgcn_rcpf(li_l[crow(r, hi)]);
  __syncthreads();
  { bf16_t* stg = (bf16_t*)lds + wid * 4096;
#pragma unroll
    for (int r = 0; r < 16; ++r) { const int orow = crow(r, hi);
#pragma unroll
      for (int d0 = 0; d0 < 4; ++d0) stg[orow * 128 + d0 * 32 + r32] = (bf16_t)(cvtpk(o[d0][r] * rli[r], 0.f) & 0xffffu); }
    asm volatile("s_waitcnt lgkmcnt(0)" ::: "memory");
    int le = lane; asm volatile("" : "+v"(le));
    bf16_t* Ow = Qb + (long)(wid * QBLK + (le >> 4)) * LDQ + (le & 15) * 8;
#pragma unroll
    for (int i = 0; i < 8; ++i) { const u32x4 v = *(const u32x4*)(stg + (i * 4 + (le >> 4)) * 128 + (le & 15) * 8); if (STORE) *(u32x4*)(Ow + (long)i * 4 * LDQ) = v; else asm volatile("" :: "v"(v)); }
  }
  __syncthreads();
#undef LD8
#undef SLOAD
#undef SWRITE
#undef SWAIT
#undef RESC
}
#undef KSWZ
#undef SBAR
}


#define XB_TMO      128
#define XB_XCNT(j)  (256  + 64 * (j))
#define XB_XSUB(j)  (1280 + 64 * (j))
#define XB_XGEN(j)  (2304 + 64 * (j))
#define XB_TOP      3328
#define XB_TOPGEN   3392
#define XCD_BAR_WORDS 3456
#define XB_SPIN_CAP (1u << 18)
__device__ __forceinline__ unsigned xb_ld(unsigned* p)              { return __hip_atomic_load(p, __ATOMIC_RELAXED, __HIP_MEMORY_SCOPE_AGENT); }
__device__ __forceinline__ unsigned xb_add(unsigned* p, unsigned v) { return __hip_atomic_fetch_add(p, v, __ATOMIC_RELAXED, __HIP_MEMORY_SCOPE_AGENT); }
__device__ __forceinline__ unsigned xb_xcc_id() { return (unsigned)__builtin_amdgcn_s_getreg((3 << 11) | 20) & 0xFu; }
#define XB_SPIN(cond, bar) do { unsigned _sp = 0; while (cond) { __builtin_amdgcn_s_sleep(1); \
    if ((++_sp & 255u) == 0u) { if (xb_ld(&(bar)[XB_TMO])) break; if (_sp > XB_SPIN_CAP) { atomicAdd(&(bar)[XB_TMO], 1u); break; } } } } while (0)
struct XcdBarrier { unsigned* bar; unsigned x; volatile LAS unsigned* st; };
__device__ __forceinline__ XcdBarrier xcd_barrier_post(unsigned* bar, volatile LAS unsigned* st) {
    XcdBarrier b; b.bar = bar; b.x = xb_xcc_id(); b.st = st;
    if (threadIdx.x == 0) (void)xb_add(&bar[XB_XCNT(b.x)], 1u);
    return b;
}
__device__ __forceinline__ void xcd_barrier_complete(unsigned* bar, unsigned x, unsigned& nloc, unsigned& nx) {
    const unsigned G = gridDim.x * gridDim.y * gridDim.z;
    unsigned sum, cnt, mine, sp = 0u;
    for (;;) {
        sum = 0u; cnt = 0u; mine = 0u;
#pragma unroll
        for (unsigned j = 0; j < 16; ++j) { const unsigned c = xb_ld(&bar[XB_XCNT(j)]); sum += c; cnt += (c > 0u) ? 1u : 0u; mine = (j == x) ? c : mine; }
        if (sum == G) break;
        __builtin_amdgcn_s_sleep(1);
        if ((++sp & 255u) == 0u) { if (xb_ld(&bar[XB_TMO])) break; if (sp > XB_SPIN_CAP) { atomicAdd(&bar[XB_TMO], 1u); break; } }
    }
    nloc = mine > 0u ? mine : 1u; nx = cnt > 0u ? cnt : 1u;
}
__device__ __forceinline__ void xcd_barrier(const XcdBarrier& b) {
    asm volatile("s_waitcnt vmcnt(0)" ::: "memory");
    __syncthreads();
    if (threadIdx.x == 0) {
        unsigned* bar = b.bar;
        __builtin_amdgcn_s_waitcnt(0);
        unsigned nloc = b.st[0], nx = b.st[1];
        if (nloc == 0u) { xcd_barrier_complete(bar, b.x, nloc, nx); b.st[0] = nloc; b.st[1] = nx; }
        const unsigned old = xb_add(&bar[XB_XSUB(b.x)], 1u);
        const unsigned gen = old / nloc;
        if (old + 1u == (gen + 1u) * nloc) {
            __builtin_amdgcn_fence(__ATOMIC_RELEASE, "agent");
            asm volatile("s_waitcnt vmcnt(0)" ::: "memory");
            const unsigned og = xb_add(&bar[XB_TOP], 1u);
            const unsigned tg = og / nx;
            if (og + 1u == (tg + 1u) * nx) xb_add(&bar[XB_TOPGEN], 1u);
            else XB_SPIN(xb_ld(&bar[XB_TOPGEN]) == tg, bar);
            __builtin_amdgcn_fence(__ATOMIC_ACQUIRE, "agent");
            xb_add(&bar[XB_XGEN(b.x)], 1u);
            asm volatile("s_waitcnt vmcnt(0)" ::: "memory");
        } else {
            XB_SPIN(xb_ld(&bar[XB_XGEN(b.x)]) == gen, bar);
            __builtin_amdgcn_fence(__ATOMIC_ACQUIRE, "agent");
            asm volatile("s_waitcnt vmcnt(0)" ::: "memory");
        }
    }
    __syncthreads();
}

struct Args { const float* in[25]; float* out; unsigned char* ws; int ph_lo, ph_hi; };

typedef const float* fptr_t;
typedef __attribute__((address_space(4))) const fptr_t* in_as4_t;
struct Frame {
    LAS unsigned char* lds; char* ldsg;
    int tid, lane, wave, G, bx, gw, NGW;
    const float* const* in;
    unsigned char* ws; float* out;
};
enum { I_XP = 0, I_XS, I_CK, I_CV, I_C, I_CCTX, I_WADA, I_BADA, I_WIN, I_QG, I_KG, I_WPG, I_PSC, I_WSGU, I_BSGU, I_WAO, I_WPO, I_WSO, I_WOUT, I_LN1G, I_LN1B, I_WF1, I_WF2, I_LN2G, I_LN2B };

__device__ __forceinline__ void tr_item(const float* W, int ldw, int src_col, int kb, bf16_t* WT, int ldt, int dst_row, int dst_k, LAS float* scr, int lane) {
    const int k0 = 64 * kb;
#pragma unroll 8
    for (int i = 0; i < 32; ++i) { const int kk = 2 * i + (lane >> 5); scr[kk * 33 + (lane & 31)] = W[(size_t)(k0 + kk) * ldw + src_col + (lane & 31)]; }
    asm volatile("s_waitcnt lgkmcnt(0)" ::: "memory");
    const int c = lane & 7;
#pragma unroll
    for (int j = 0; j < 4; ++j) { const int n = (lane >> 3) + 8 * j; const LAS float* s = scr + (8 * c) * 33 + n;
        u32x4 o; o.x = cvt_pk_bf16(s[0 * 33], s[1 * 33]); o.y = cvt_pk_bf16(s[2 * 33], s[3 * 33]); o.z = cvt_pk_bf16(s[4 * 33], s[5 * 33]); o.w = cvt_pk_bf16(s[6 * 33], s[7 * 33]);
        *(u32x4*)(WT + (size_t)(dst_row + n) * ldt + dst_k + k0 + 8 * c) = o; }
    asm volatile("s_waitcnt lgkmcnt(0)" ::: "memory");
}

__device__ __forceinline__ int win_src_col(int d) {
    if (d < 1024) return d;
    if (d < 1536) return 2048 + (d - 1024);
    if (d < 2048) return 1024 + (d - 1536);
    if (d < 2560) return 2560 + (d - 2048);
    if (d < 3072) return 1536 + (d - 2560);
    return d;
}

__device__ __forceinline__ void phase_prologue(Frame& F) {
    if (F.bx < 192) {
        const int l = F.bx / 96, nb = F.bx % 96;
        LAS float* sc = (LAS float*)F.lds;
        LAS float* red = (LAS float*)(F.lds + 9 * 1024 * 4);
        for (int idx = F.tid; idx < 9 * 1024; idx += 512) { const int v = idx >> 10, k = idx & 1023;
            const float x = v == 0 ? F.in[I_CCTX][k] : F.in[I_C][(v - 1) * 1024 + k]; sc[idx] = x / (1.0f + __expf(-x)); }
        __syncthreads();
        float acc[9];
#pragma unroll
        for (int v = 0; v < 9; ++v) acc[v] = 0.f;
        const float* wp = F.in[I_WADA] + ((size_t)l * 1024 + F.wave * 128) * 6144 + nb * 64 + F.lane;
#pragma unroll 8
        for (int k = 0; k < 128; ++k) { const float w = wp[(size_t)k * 6144];
#pragma unroll
            for (int v = 0; v < 9; ++v) acc[v] += sc[v * 1024 + F.wave * 128 + k] * w; }
#pragma unroll
        for (int v = 0; v < 9; ++v) red[(F.wave * 9 + v) * 64 + F.lane] = acc[v];
        __syncthreads();
        float* mod = (float*)(F.ws + WS_MOD);
        for (int idx = F.tid; idx < 576; idx += 512) { const int v = idx >> 6, ln = idx & 63; float s = 0.f;
#pragma unroll
            for (int w = 0; w < 8; ++w) s += red[(w * 9 + v) * 64 + ln];
            mod[(l * 9 + v) * 6144 + nb * 64 + ln] = s + F.in[I_BADA][l * 6144 + nb * 64 + ln]; }
        __syncthreads();
    }
    LAS float* scr = (LAS float*)(F.lds + F.wave * 8448);
    constexpr int N_WIN = 16 * 192, N_AO = 16 * 32, N_SO = 8 * 32, N_WO = 16 * 32, N_F1 = 16 * 176, N_F2 = 44 * 32, N_PE = 1024, N_WS = 128;
    constexpr int N_L = N_WIN + N_AO + N_SO + N_WO + N_F1 + N_F2 + N_PE + N_WS;
    constexpr int N_ALL = 2 * N_L + 32;
    for (int it = F.gw; it < N_ALL; it += F.NGW) {
        if (it >= 2 * N_L) {
            const int idx = (it - 2 * N_L) * 64 + F.lane; const int pos = idx >> 5, p = idx & 31;
            const float inv = powf(10000.0f, -(float)p / 32.0f); const float ang = (float)pos * inv;
            float* rope = (float*)(F.ws + WS_ROPE); rope[idx] = cosf(ang); rope[2048 + idx] = sinf(ang);
            continue;
        }
        const int l = it / N_L; int r = it % N_L;
        if (r < N_WIN) { const int kb = r / 192, nb = r % 192;
            tr_item(F.in[I_WIN] + (size_t)l * 1024 * 6144, 6144, win_src_col(nb * 32), kb, (bf16_t*)(F.ws + WS_WIN) + (size_t)l * 6144 * 1024, 1024, nb * 32, 0, scr, F.lane); continue; } r -= N_WIN;
        if (r < N_AO) { const int kb = r / 32, nb = r % 32;
            tr_item(F.in[I_WAO] + (size_t)l * 1024 * 1024, 1024, nb * 32, kb, (bf16_t*)(F.ws + WS_WM) + (size_t)l * 1024 * 2048, 2048, nb * 32, 0, scr, F.lane); continue; } r -= N_AO;
        if (r < N_SO) { const int kb = r / 32, nb = r % 32;
            tr_item(F.in[I_WSO] + (size_t)l * 512 * 1024, 1024, nb * 32, kb, (bf16_t*)(F.ws + WS_WM) + (size_t)l * 1024 * 2048, 2048, nb * 32, 1024, scr, F.lane); continue; } r -= N_SO;
        if (r < N_WO) { const int kb = r / 32, nb = r % 32;
            tr_item(F.in[I_WOUT] + (size_t)l * 1024 * 1024, 1024, nb * 32, kb, (bf16_t*)(F.ws + WS_WOUT) + (size_t)l * 1024 * 1024, 1024, nb * 32, 0, scr, F.lane); continue; } r -= N_WO;
        if (r < N_F1) { const int kb = r / 176, nb = r % 176; const int drow = nb * 32; const int pn = drow >> 8, j = drow & 255;
            const int src = j < 128 ? pn * 128 + j : DFF + pn * 128 + (j - 128);
            tr_item(F.in[I_WF1] + (size_t)l * 1024 * 5632, 5632, src, kb, (bf16_t*)(F.ws + WS_WF1) + (size_t)l * 5632 * 1024, 1024, drow, 0, scr, F.lane); continue; } r -= N_F1;
        if (r < N_F2) { const int kb = r / 32, nb = r % 32;
            tr_item(F.in[I_WF2] + (size_t)l * DFF * 1024, 1024, nb * 32, kb, (bf16_t*)(F.ws + WS_WF2) + (size_t)l * 1024 * DFF, DFF, nb * 32, 0, scr, F.lane); continue; } r -= N_F2;
        if (r < N_PE) {
            const int kg = r >> 4, nb = r & 15; const int k0 = kg * 8, g = k0 >> 7; const int n = nb * 64 + F.lane;
            const float* wpg = F.in[I_WPG] + ((size_t)(l * 4 + g) * 128 + (k0 & 127)) * 128;
            const float* psc = F.in[I_PSC] + l * 512 + g * 128;
            const float* wpo = F.in[I_WPO] + ((size_t)l * 512 + g * 128) * 1024 + n;
            float a[8];
#pragma unroll
            for (int i = 0; i < 8; ++i) a[i] = 0.f;
#pragma unroll 4
            for (int j = 0; j < 128; ++j) { const float w = wpo[(size_t)j * 1024] * psc[j];
#pragma unroll
                for (int i = 0; i < 8; ++i) a[i] += wpg[i * 128 + j] * w; }
            u32x4 o; o.x = cvt_pk_bf16(a[0], a[1]); o.y = cvt_pk_bf16(a[2], a[3]); o.z = cvt_pk_bf16(a[4], a[5]); o.w = cvt_pk_bf16(a[6], a[7]);
            *(u32x4*)((bf16_t*)(F.ws + WS_WM) + (size_t)l * 1024 * 2048 + (size_t)n * 2048 + 1536 + k0) = o;
            continue; } r -= N_PE;
        {
            const size_t e0 = (size_t)l * 65536 + (size_t)r * 512 + F.lane * 8;
            const f32x4 a = *(const f32x4*)(F.in[I_WSGU] + e0), b = *(const f32x4*)(F.in[I_WSGU] + e0 + 4);
            u32x4 o; o.x = cvt_pk_bf16(a[0], a[1]); o.y = cvt_pk_bf16(a[2], a[3]); o.z = cvt_pk_bf16(b[0], b[1]); o.w = cvt_pk_bf16(b[2], b[3]);
            *(u32x4*)((bf16_t*)(F.ws + WS_WSGU) + e0) = o;
        }
    }
}

__device__ __forceinline__ const float* x0_row(Frame& F, int t) { return t < T_CTX ? F.in[I_XP] + (size_t)t * DM : F.in[I_XS] + (size_t)(t - T_CTX) * DM; }
__device__ __forceinline__ int vec_of_row(int t) { return t < T_CTX ? 0 : 1 + ((t - T_CTX) >> 12); }

__device__ __forceinline__ void phase_h0(Frame& F) {
    const float* mod = (const float*)(F.ws + WS_MOD);
    bf16_t* act = (bf16_t*)(F.ws + WS_ACT);
    for (int t = F.gw; t < T_ALL; t += F.NGW) {
        const f32x4* xr = (const f32x4*)x0_row(F, t) + F.lane;
        const float* mv = mod + vec_of_row(t) * 6144;
        unsigned long long* o8 = (unsigned long long*)(act + (size_t)t * DM) + F.lane;
#pragma unroll
        for (int j = 0; j < 4; ++j) { const f32x4 x = xr[64 * j]; const int c = 256 * j + 4 * F.lane;
            const f32x4 sh = *(const f32x4*)(mv + c), sc = *(const f32x4*)(mv + 1024 + c);
            const f32x4 h = x * (sc + 1.0f) + sh;
            o8[64 * j] = (unsigned long long)cvt_pk_bf16(h[0], h[1]) | ((unsigned long long)cvt_pk_bf16(h[2], h[3]) << 32); }
    }
}

__device__ __forceinline__ void phase_ln(Frame& F, const float* lg, const float* lb, const float* modl  , int sh_off, int sc_off, const bool dry = false) {
    float* X = F.out; bf16_t* act = (bf16_t*)(F.ws + WS_ACT);
    for (int t = F.gw; t < T_ALL; t += F.NGW) {
        f32x4* xr = (f32x4*)(X + (size_t)t * DM) + F.lane;
        f32x4 v[4]; float s = 0.f;
#pragma unroll
        for (int j = 0; j < 4; ++j) { v[j] = xr[64 * j]; s += (v[j][0] + v[j][1]) + (v[j][2] + v[j][3]); }
        const float mean = wave_sum(s) * (1.f / DM); float s2 = 0.f;
#pragma unroll
        for (int j = 0; j < 4; ++j) { v[j] = v[j] - mean; s2 += (v[j][0] * v[j][0] + v[j][1] * v[j][1]) + (v[j][2] * v[j][2] + v[j][3] * v[j][3]); }
        const float rstd = rsqrtf(wave_sum(s2) * (1.f / DM) + LN_EPS);
        const float* mv = modl ? modl + vec_of_row(t) * 6144 : nullptr;
        unsigned long long* o8 = (unsigned long long*)(act + (size_t)t * DM) + F.lane;
#pragma unroll
        for (int j = 0; j < 4; ++j) { const int c = 256 * j + 4 * F.lane;
            const f32x4 g = *(const f32x4*)(lg + c), b = *(const f32x4*)(lb + c);
            const f32x4 y = v[j] * rstd * g + b; if (!dry) xr[64 * j] = y; else { asm volatile("" :: "v"(y)); continue; }
            if (mv) { const f32x4 sh = *(const f32x4*)(mv + sh_off + c), sc = *(const f32x4*)(mv + sc_off + c);
                const f32x4 h = y * (sc + 1.0f) + sh;
                o8[64 * j] = (unsigned long long)cvt_pk_bf16(h[0], h[1]) | ((unsigned long long)cvt_pk_bf16(h[2], h[3]) << 32); } }
    }
}

__device__ __forceinline__ void load16h(const bf16_t* p, int j, float (&x)[16]) {
#pragma unroll
    for (int a = 0; a < 2; ++a)
#pragma unroll
        for (int hf = 0; hf < 2; ++hf) { const u32x2 w = *(const u32x2*)(p + a * 64 + hf * 32 + 4 * j);
            x[(a * 2 + hf) * 4 + 0] = bf_lo(w.x); x[(a * 2 + hf) * 4 + 1] = bf_hi(w.x); x[(a * 2 + hf) * 4 + 2] = bf_lo(w.y); x[(a * 2 + hf) * 4 + 3] = bf_hi(w.y); }
}
__device__ __forceinline__ void rmsn(float (&x)[16], const float (&g)[16]) {
    float ss = 0.f;
#pragma unroll
    for (int i = 0; i < 16; ++i) ss += x[i] * x[i];
    ss += __shfl_xor(ss, 1); ss += __shfl_xor(ss, 2); ss += __shfl_xor(ss, 4);
    const float rinv = rsqrtf(ss * (1.0f / 128.0f) + LN_EPS);
#pragma unroll
    for (int i = 0; i < 16; ++i) x[i] = x[i] * rinv * g[i];
}
__device__ __forceinline__ void rope16(float (&x)[16], const float* rope, int rowpos, int colpos, int j) {
#pragma unroll
    for (int a = 0; a < 2; ++a) { const int pos = a == 0 ? rowpos : colpos;
        const f32x4 c = *(const f32x4*)(rope + pos * 32 + 4 * j), s = *(const f32x4*)(rope + 2048 + pos * 32 + 4 * j);
#pragma unroll
        for (int e = 0; e < 4; ++e) { const float x1 = x[(a * 2) * 4 + e], x2 = x[(a * 2 + 1) * 4 + e];
            x[(a * 2) * 4 + e] = x1 * c[e] - x2 * s[e]; x[(a * 2 + 1) * 4 + e] = x2 * c[e] + x1 * s[e]; } }
}
__device__ __forceinline__ void store16h(bf16_t* p, int j, const float (&x)[16]) {
#pragma unroll
    for (int a = 0; a < 2; ++a)
#pragma unroll
        for (int hf = 0; hf < 2; ++hf) { u32x2 w; w.x = cvt_pk_bf16(x[(a * 2 + hf) * 4 + 0], x[(a * 2 + hf) * 4 + 1]); w.y = cvt_pk_bf16(x[(a * 2 + hf) * 4 + 2], x[(a * 2 + hf) * 4 + 3]);
            *(u32x2*)(p + a * 64 + hf * 32 + 4 * j) = w; }
}

__device__ __forceinline__ void phase_mid(Frame& F, int l, int part, const bool dry = false) {
    bf16_t* proj = (bf16_t*)(F.ws + WS_PROJ);
    const float* rope = (const float*)(F.ws + WS_ROPE);
    bf16_t* vrt = (bf16_t*)(F.ws + WS_VRT);
    bf16_t* KL = (bf16_t*)(F.ws + WS_KL); bf16_t* VL = (bf16_t*)(F.ws + WS_VL); bf16_t* KC = (bf16_t*)(F.ws + WS_KC); bf16_t* VC = (bf16_t*)(F.ws + WS_VC);
    float* outk = F.out + (size_t)T_ALL * DM; float* outv = outk + (size_t)16 * 2 * 256 * 256;
    const int lane = F.lane, hj = lane & 7;
    const int n8 = part_rows(part) / 4, ncache = 4 * PAST;
    float qg[16], kg[16];
#pragma unroll
    for (int a = 0; a < 2; ++a)
#pragma unroll
        for (int hf = 0; hf < 2; ++hf)
#pragma unroll
            for (int e = 0; e < 4; ++e) { const int d = a * 64 + hf * 32 + 4 * hj + e; qg[(a * 2 + hf) * 4 + e] = F.in[I_QG][l * 128 + d]; kg[(a * 2 + hf) * 4 + e] = F.in[I_KG][l * 128 + d]; }
    for (int it = F.gw; it < n8 + ncache; it += F.NGW) {
        if (it >= n8) {
            const int cr = it - n8; const int bl = cr >> 9, s = cr & 511; const int b = part * 4 + bl;
            const size_t src = (((size_t)b * 2 + l) * PAST + s) * 256 + lane * 4;
            const f32x4 kx = *(const f32x4*)(F.in[I_CK] + src), vx = *(const f32x4*)(F.in[I_CV] + src);
            const size_t dst = ((size_t)bl * SKV_LAT + s) * 256 + lane * 4;
            u32x2 kw, vw; kw.x = cvt_pk_bf16(kx[0], kx[1]); kw.y = cvt_pk_bf16(kx[2], kx[3]); vw.x = cvt_pk_bf16(vx[0], vx[1]); vw.y = cvt_pk_bf16(vx[2], vx[3]);
            if (!dry) { *(u32x2*)(KL + dst) = kw; *(u32x2*)(VL + dst) = vw; } else asm volatile("" :: "v"(kw), "v"(vw));
            continue;
        }
        const int lr0 = it * 4, t0 = part_row0(part) + lr0;
        const bool is_ctx = t0 < T_CTX;
        bf16_t* P0 = proj + (size_t)lr0 * NPROJ;
        {
            float val[4][8];
#pragma unroll
            for (int i = 0; i < 4; ++i) { const u32x4 w = *(const u32x4*)(P0 + (size_t)i * NPROJ + PC_XV + lane * 8);
#pragma unroll
                for (int e = 0; e < 4; ++e) { val[i][2 * e] = gelu1(bf_lo(w[e])); val[i][2 * e + 1] = gelu1(bf_hi(w[e])); } }
#pragma unroll
            for (int i = 0; i < 4; ++i) { float s = 0.f;
#pragma unroll
                for (int e = 0; e < 8; ++e) s += val[i][e];
                const float mean = wave_sum(s) * (1.0f / 512.0f); float s2 = 0.f;
#pragma unroll
                for (int e = 0; e < 8; ++e) { val[i][e] -= mean; s2 += val[i][e] * val[i][e]; }
                const float rstd = rsqrtf(wave_sum(s2) * (1.0f / 512.0f) + LN_EPS);
#pragma unroll
                for (int e = 0; e < 8; ++e) val[i][e] *= rstd; }
            const int chunk = lr0 >> 7, q0 = lr0 & 127;
            bf16_t* vb = vrt + ((size_t)chunk * 512 + lane * 8) * 128 + q0;
#pragma unroll
            for (int e = 0; e < 8; ++e) { u32x2 o; o.x = cvt_pk_bf16(val[0][e], val[1][e]); o.y = cvt_pk_bf16(val[2][e], val[3][e]);
                if (!dry) *(u32x2*)(vb + (size_t)e * 128) = o; else asm volatile("" :: "v"(o)); }
        }
#pragma unroll 1
        for (int i = 0; i < 4; ++i) {
            bf16_t* Pr = P0 + (size_t)i * NPROJ; const int t = t0 + i;
            int spos, seqS, rowpos = 0, colpos = 0, bl = 0;
            if (is_ctx) { spos = t & 255; seqS = CTX_S; } else { const int tl = t - T_CTX; spos = tl & 4095; seqS = LAT_S; rowpos = spos >> 6; colpos = spos & 63; bl = (tl >> 12) - part * 4; }
            float x[16];
            const int kh = (lane >> 3) & 1;
            u32x2 kw[4];
#pragma unroll
            for (int a = 0; a < 2; ++a)
#pragma unroll
                for (int hf = 0; hf < 2; ++hf) kw[a * 2 + hf] = *(const u32x2*)(Pr + PC_K + kh * 128 + a * 64 + hf * 32 + 4 * hj);
            const int vi = (lane - 16) & 31;
            const u32x4 vw = *(const u32x4*)(Pr + PC_V + vi * 8);
            f32x4 rcv[2], rsv[2];
#pragma unroll
            for (int a = 0; a < 2; ++a) { const int pos = a == 0 ? rowpos : colpos; rcv[a] = *(const f32x4*)(rope + pos * 32 + 4 * hj); rsv[a] = *(const f32x4*)(rope + 2048 + pos * 32 + 4 * hj); }
            float pacc[8], pself[8];
            {
                const int hw = 1 << (lane >> 4);
                const int lo = max(spos - hw, 0), hi = min(spos + hw, seqS);
#pragma unroll
                for (int e = 0; e < 8; ++e) pacc[e] = 0.f;
                u32x4 pw[16];
#pragma unroll
                for (int k = 0; k < 16; ++k) { const int dd = k - 8, sp = spos + dd; const bool ok = (sp >= lo) && (sp < hi);
                    pw[k] = *(const u32x4*)(Pr + (long)(ok ? dd : 0) * NPROJ + PC_XP + lane * 8); }
#pragma unroll
                for (int k = 0; k < 16; ++k) { const int sp = spos + k - 8; const float mk = ((sp >= lo) && (sp < hi)) ? 1.0f : 0.0f;
#pragma unroll
                    for (int e = 0; e < 4; ++e) { pacc[2 * e] += mk * bf_lo(pw[k][e]); pacc[2 * e + 1] += mk * bf_hi(pw[k][e]); } }
#pragma unroll
                for (int e = 0; e < 4; ++e) { pself[2 * e] = bf_lo(pw[8][e]); pself[2 * e + 1] = bf_hi(pw[8][e]); }
                const float rc = 1.0f / (float)(hi - lo);
#pragma unroll
                for (int e = 0; e < 8; ++e) pacc[e] = pacc[e] * rc - pself[e];
            }
#pragma unroll
            for (int q4 = 0; q4 < 4; ++q4) { x[q4 * 4 + 0] = bf_lo(kw[q4].x); x[q4 * 4 + 1] = bf_hi(kw[q4].x); x[q4 * 4 + 2] = bf_lo(kw[q4].y); x[q4 * 4 + 3] = bf_hi(kw[q4].y); }
            rmsn(x, kg);
            if (dry) { asm volatile("" :: "v"(x[0]), "v"(x[7]), "v"(vw), "v"(pacc[0]), "v"(pacc[7])); continue; }
            if (is_ctx) {
                if (lane < 16) {
                    float* ok = outk + (((size_t)(t >> 8) * 2 + l) * 256 + (t & 255)) * 256 + kh * 128;
#pragma unroll
                    for (int a = 0; a < 2; ++a)
#pragma unroll
                        for (int hf = 0; hf < 2; ++hf) *(f32x4*)(ok + a * 64 + hf * 32 + 4 * hj) = (f32x4){x[(a * 2 + hf) * 4], x[(a * 2 + hf) * 4 + 1], x[(a * 2 + hf) * 4 + 2], x[(a * 2 + hf) * 4 + 3]};
                    store16h(KC + (size_t)t * 256 + kh * 128, hj, x);
                }
                if (lane >= 16 && lane < 48) {
                    float* ov = outv + (((size_t)(t >> 8) * 2 + l) * 256 + (t & 255)) * 256 + vi * 8;
                    *(f32x4*)ov = (f32x4){bf_lo(vw[0]), bf_hi(vw[0]), bf_lo(vw[1]), bf_hi(vw[1])};
                    *(f32x4*)(ov + 4) = (f32x4){bf_lo(vw[2]), bf_hi(vw[2]), bf_lo(vw[3]), bf_hi(vw[3])};
                    *(u32x4*)(VC + (size_t)t * 256 + vi * 8) = vw;
                }
            } else {
#pragma unroll
                for (int a = 0; a < 2; ++a)
#pragma unroll
                    for (int e = 0; e < 4; ++e) { const float x1 = x[(a * 2) * 4 + e], x2 = x[(a * 2 + 1) * 4 + e];
                        x[(a * 2) * 4 + e] = x1 * rcv[a][e] - x2 * rsv[a][e]; x[(a * 2 + 1) * 4 + e] = x2 * rcv[a][e] + x1 * rsv[a][e]; }
                const size_t krow = ((size_t)bl * SKV_LAT + PAST + spos) * 256;
                if (lane < 16) store16h(KL + krow + kh * 128, hj, x);
                if (lane >= 16 && lane < 48) *(u32x4*)(VL + krow + vi * 8) = vw;
            }
            { u32x4 o; o.x = cvt_pk_bf16(pacc[0], pacc[1]); o.y = cvt_pk_bf16(pacc[2], pacc[3]); o.z = cvt_pk_bf16(pacc[4], pacc[5]); o.w = cvt_pk_bf16(pacc[6], pacc[7]);
              *(u32x4*)(Pr + PC_K + lane * 8) = o; }
        }
    }
}

__device__ __forceinline__ void phase_attn(Frame& F, int l, int part, const bool sgu_only_dry = false) {
    bf16_t* proj = (bf16_t*)(F.ws + WS_PROJ);
    const bf16_t* KL = (const bf16_t*)(F.ws + WS_KL); const bf16_t* VL = (const bf16_t*)(F.ws + WS_VL); const bf16_t* KC = (const bf16_t*)(F.ws + WS_KC); const bf16_t* VC = (const bf16_t*)(F.ws + WS_VC);
    const int lat_row0 = part == 0 ? T_CTX : 0;
    if (!sgu_only_dry) {
        int pair, idx, step; int rep = 0;
        const bool xcdmap = (F.G % 8) == 0;
        if (xcdmap) { pair = F.bx & 7; idx = F.bx >> 3; step = F.G >> 3; } else { pair = 0; idx = F.bx; step = F.G; }
        for (;;) {
            int pr = pair, ix = idx;
            if (!xcdmap) { pr = idx >> 6; ix = idx & 63; if (idx >= 512) break; } else if (idx >= 64) break;
            const int bl = pr >> 1, kvh = pr & 1, h = kvh * 4 + (ix >> 4), qb = ix & 15;
            bf16_t* Qb = proj + (size_t)(lat_row0 + bl * LAT_S + qb * 256) * NPROJ + PC_Q + h * 128;
            att::attn_dense_body(Qb, KL + (size_t)bl * SKV_LAT * 256 + kvh * 128, VL + (size_t)bl * SKV_LAT * 256 + kvh * 128, SKV_LAT, F.ldsg, F.tid, F.in[I_QG] + l * 128, (const float*)(F.ws + WS_ROPE), qb * 256, PROBE == 3 ? rep == 1 : true);
            if (PROBE == 3) { if (rep == 0) { rep = 1; continue; } rep = 0; }
            idx += step;
        }
    }
    if (part == 0 && !sgu_only_dry) {
        for (int u = F.bx; u < 128; u += F.G) { const int b = u >> 3, h = u & 7;
            bf16_t* Qb = proj + (size_t)(b * 256) * NPROJ + PC_Q + h * 128;
            att::attn_dense_body(Qb, KC + (size_t)b * 256 * 256 + (h >> 2) * 128, VC + (size_t)b * 256 * 256 + (h >> 2) * 128, CTX_S, F.ldsg, F.tid, F.in[I_QG] + l * 128, (const float*)nullptr, 0); }
    }
    const bf16_t* vrt = (const bf16_t*)(F.ws + WS_VRT);
    const bf16_t* wsb = (const bf16_t*)(F.ws + WS_WSGU) + (size_t)l * 65536;
    const float* bs = F.in[I_BSGU] + l * 512;
    const int nitem = (part_rows(part) / 128) * 32;
    const int ln = F.lane & 15, quad = F.lane >> 4;
    for (int it = F.NGW - 1 - F.gw; it < nitem; it += F.NGW) {
        const int chunk = it >> 5, g = (it >> 3) & 3, cb = (it >> 1) & 3, pb = it & 1;
        f32x4 acc[2][4];
#pragma unroll
        for (int a = 0; a < 2; ++a)
#pragma unroll
            for (int b = 0; b < 4; ++b) acc[a][b] = (f32x4){0.f, 0.f, 0.f, 0.f};
        const bf16_t* ap = vrt + ((size_t)chunk * 512 + g * 128 + cb * 32 + ln) * 128 + quad * 8;
        const bf16_t* bp = wsb + ((size_t)g * 128 + pb * 64 + ln) * 128 + quad * 8;
        u32x2 xw[4][2];
#pragma unroll
        for (int pt = 0; pt < 4; ++pt)
#pragma unroll
            for (int ct = 0; ct < 2; ++ct) xw[pt][ct] = *(const u32x2*)(proj + (size_t)(chunk * 128 + pb * 64 + pt * 16 + ln) * NPROJ + PC_U + g * 128 + cb * 32 + ct * 16 + quad * 4);
#pragma unroll
        for (int ks = 0; ks < 4; ++ks) {
            bf16x8 af[2], bfr[4];
#pragma unroll
            for (int ct = 0; ct < 2; ++ct) af[ct] = *(const bf16x8*)(ap + ct * 16 * 128 + ks * 32);
#pragma unroll
            for (int pt = 0; pt < 4; ++pt) bfr[pt] = *(const bf16x8*)(bp + pt * 16 * 128 + ks * 32);
#pragma unroll
            for (int ct = 0; ct < 2; ++ct)
#pragma unroll
                for (int pt = 0; pt < 4; ++pt) acc[ct][pt] = __builtin_amdgcn_mfma_f32_16x16x32_bf16(af[ct], bfr[pt], acc[ct][pt], 0, 0, 0);
        }
#pragma unroll
        for (int pt = 0; pt < 4; ++pt) { const int p = pb * 64 + pt * 16 + ln; const float bsv = bs[g * 128 + p];
#pragma unroll
            for (int ct = 0; ct < 2; ++ct) { const int c = g * 128 + cb * 32 + ct * 16 + quad * 4;
                bf16_t* up = proj + (size_t)(chunk * 128 + p) * NPROJ + PC_U + c;
                const u32x2 w = xw[pt][ct];
                const float u0 = gelu1(bf_lo(w.x)), u1 = gelu1(bf_hi(w.x)), u2 = gelu1(bf_lo(w.y)), u3 = gelu1(bf_hi(w.y));
                const f32x4 a = acc[ct][pt];
                u32x2 o; o.x = cvt_pk_bf16(u0 * (a[0] + bsv), u1 * (a[1] + bsv)); o.y = cvt_pk_bf16(u2 * (a[2] + bsv), u3 * (a[3] + bsv));
                if (!sgu_only_dry) *(u32x2*)up = o; else asm volatile("" :: "v"(o)); } }
    }
}

constexpr int NPL = 11, NPHASE = 2 + DEPTH * NPL;
__global__ void __launch_bounds__(NW * 64, 2) fwd_kernel(Args args) {
    extern __shared__ __attribute__((aligned(16))) unsigned char lds[];
    Frame F;
    F.lds = (LAS unsigned char*)lds; F.ldsg = (char*)lds;
    F.G = gridDim.x; F.bx = blockIdx.x; F.NGW = F.G * NW;
    F.in = args.in; F.ws = args.ws; F.out = args.out;
    const float* mod = (const float*)(F.ws + WS_MOD);
    bf16_t* act = (bf16_t*)(F.ws + WS_ACT); bf16_t* proj = (bf16_t*)(F.ws + WS_PROJ);
    volatile LAS unsigned* bst = (volatile LAS unsigned*)(F.lds + 131072 + 64);
    unsigned* barw = (unsigned*)(F.ws + WS_BAR);
    const int wave0 = __builtin_amdgcn_readfirstlane((int)threadIdx.x >> 6);
    { unsigned z0 = 0u; asm volatile("" : "+v"(z0)); int t0 = wave0 * 64 + (int)__builtin_amdgcn_mbcnt_hi(~0u, __builtin_amdgcn_mbcnt_lo(~0u, z0));
      if (t0 < 2) bst[t0] = 0u;
      if (blockIdx.x == 0 && args.ph_lo == 0) { for (int i = t0; i < XCD_BAR_WORDS; i += NW * 64) barw[i] = 0u;
        unsigned* cw = (unsigned*)(F.ws + WS_CNT); for (int i = t0; i < CNT_WORDS; i += NW * 64) cw[i] = 0u; } }
    __syncthreads();
    XcdBarrier xbar; xbar.bar = barw; xbar.x = 0; xbar.st = bst;
    for (int ph = args.ph_lo; ph < args.ph_hi; ++ph) {
        { unsigned zz = 0u; asm volatile("" : "+v"(zz)); const int lanev = (int)__builtin_amdgcn_mbcnt_hi(~0u, __builtin_amdgcn_mbcnt_lo(~0u, zz));
          F.lane = lanev; F.wave = wave0; F.tid = wave0 * 64 + lanev; F.gw = F.bx * NW + F.wave; }

#ifndef PHMASK
#define PHMASK 0xffff
#endif
        if (ph == 0) { if (PHMASK & 1) phase_prologue(F); if (PROBE == 4) { __syncthreads(); phase_prologue(F); } }
        else if (ph == 1) { if (PHMASK & 2) phase_h0(F); if (PROBE == 4) phase_h0(F); }
        else {
            const int l = (ph - 2) / NPL, s = (ph - 2) % NPL;
            if (s < 8) {
                const int part = s >> 2, q = s & 3;
                if (q == 0) { if (PHMASK & 4) {
                    pg8::Gemm g{}; g.A = act + (size_t)part_row0(part) * DM; g.Bt = (const bf16_t*)(F.ws + WS_WIN) + (size_t)l * NPROJ * DM; g.lda = DM; g.ldb = DM;
                    g.nM = part_rows(part) / 256; g.nN = NPROJ / 256; g.nseg = 1; g.k0[0] = 0; g.nt[0] = 16; g.k0[1] = 0; g.nt[1] = 16; g.k0[2] = 0; g.nt[2] = 16;
                    pg8::Order S; S.init(g.nM, g.nN, 1, F.G, F.bx, 0, STAGGER);
                    pg8::EpiStore E{proj, NPROJ, PC_G};
                    if (PROBE == 2) { pg8::EpiNone E0; pg8::gemm_phase<pg8::EpiNone>(F.lds, g, S, E0, F.tid); }
                    if (PROBE == 7) pg8::gemm_phase<pg8::EpiStore>(F.lds, g, S, E, F.tid);
                    pg8::gemm_phase<pg8::EpiStore>(F.lds, g, S, E, F.tid); }
                } else if (q == 1) { if (PROBE == 5) phase_mid(F, l, part, true); if (PHMASK & 8) phase_mid(F, l, part, false); }
                else if (q == 2) { if (PROBE == 6) phase_attn(F, l, part, true); if (PHMASK & 16) phase_attn(F, l, part, false); }
                else if (PHMASK & 32) {
                    pg8::Gemm g{}; g.A = proj; g.Bt = (const bf16_t*)(F.ws + WS_WM) + (size_t)l * DM * 2048; g.lda = NPROJ; g.ldb = 2048;
                    g.nM = part_rows(part) / 256; g.nN = 4; g.nseg = 3; g.k0[0] = 0; g.nt[0] = 16; g.k0[1] = 1024; g.nt[1] = 8; g.k0[2] = 1536; g.nt[2] = 8;
                    pg8::Order S; S.init(g.nM, g.nN, 3, F.G, F.bx);
                    pg8::EpiGate E{F.lds + LDS_XCH, proj, act + (size_t)part_row0(part) * DM, DM};
                    if (PROBE == 2) { pg8::EpiNone E0; pg8::gemm_phase<pg8::EpiNone>(F.lds, g, S, E0, F.tid); }
                    pg8::gemm_phase<pg8::EpiGate>(F.lds, g, S, E, F.tid);
                }
            } else if (s == 8) { if (PHMASK & 64) {
                pg8::Gemm g{}; g.A = act; g.Bt = (const bf16_t*)(F.ws + WS_WOUT) + (size_t)l * DM * DM; g.lda = DM; g.ldb = DM;
                g.nM = T_ALL / 256; g.nN = 4; g.nseg = 1; g.k0[0] = 0; g.nt[0] = 16; g.k0[1] = 0; g.nt[1] = 16; g.k0[2] = 0; g.nt[2] = 16;
                pg8::Order S; S.init(g.nM, g.nN, 1, F.G, F.bx, 1);
                if (l == 0) { pg8::EpiResidLn<0, true, false> E{F.in, F.ws, F.out, l, F.lds + LDS_XCH}; pg8::gemm_phase<pg8::EpiResidLn<0, true, false>>(F.lds, g, S, E, F.tid); }
                else { pg8::EpiResidLn<0, false, false> E{F.in, F.ws, F.out, l, F.lds + LDS_XCH}; pg8::gemm_phase<pg8::EpiResidLn<0, false, false>>(F.lds, g, S, E, F.tid); } }
            } else if (s == 9) { if (PHMASK & 256) {
                pg8::Gemm g{}; g.A = act; g.Bt = (const bf16_t*)(F.ws + WS_WF1) + (size_t)l * 2 * DFF * DM; g.lda = DM; g.ldb = DM;
                g.nM = T_ALL / 256; g.nN = 2 * DFF / 256; g.nseg = 1; g.k0[0] = 0; g.nt[0] = 16; g.k0[1] = 0; g.nt[1] = 16; g.k0[2] = 0; g.nt[2] = 16;
                pg8::Order S; S.init(g.nM, g.nN, 1, F.G, F.bx, 0, STAGGER);
                pg8::EpiSwiGLU E{proj, DFF};
                if (PROBE == 2) { pg8::EpiNone E0; pg8::gemm_phase<pg8::EpiNone>(F.lds, g, S, E0, F.tid); }
                if (PROBE == 7) pg8::gemm_phase<pg8::EpiSwiGLU>(F.lds, g, S, E, F.tid);
                pg8::gemm_phase<pg8::EpiSwiGLU>(F.lds, g, S, E, F.tid); }
            } else { if (PHMASK & 512) {
                pg8::Gemm g{}; g.A = proj; g.Bt = (const bf16_t*)(F.ws + WS_WF2) + (size_t)l * DM * DFF; g.lda = DFF; g.ldb = DFF;
                g.nM = T_ALL / 256; g.nN = 4; g.nseg = 1; g.k0[0] = 0; g.nt[0] = 44; g.k0[1] = 0; g.nt[1] = 44; g.k0[2] = 0; g.nt[2] = 44;
                pg8::Order S; S.init(g.nM, g.nN, 1, F.G, F.bx, 1);
                if (l + 1 < DEPTH) { pg8::EpiResidLn<1, false, false> E{F.in, F.ws, F.out, l, F.lds + LDS_XCH}; pg8::gemm_phase<pg8::EpiResidLn<1, false, false>>(F.lds, g, S, E, F.tid); }
                else { pg8::EpiResidLn<1, false, true> E{F.in, F.ws, F.out, l, F.lds + LDS_XCH}; pg8::gemm_phase<pg8::EpiResidLn<1, false, true>>(F.lds, g, S, E, F.tid); } }
            }
        }
        if (ph + 1 < args.ph_hi) {
            if (ph == args.ph_lo) { cg::this_grid().sync(); xbar = xcd_barrier_post(barw, bst); }
            else xcd_barrier(xbar);
            if (PROBE == 1 && ph == 1) { for (int k = 0; k < 20; ++k) xcd_barrier(xbar); }
        }
    }
}

extern "C" void kernel_launch(void* const* d_in, const int* in_sizes, int n_in, void* d_out, int out_size, void* d_ws, size_t ws_size, hipStream_t stream) {
    static int grid = 0;
    if (grid == 0) {
        if (n_in != 25 || ws_size < WS_END) { fprintf(stderr, "kernel_launch: unexpected n_in %d / ws %zu\n", n_in, ws_size); grid = -1; return; }
        int dev = 0, cus = 0, per_cu = 0;
        if (hipGetDevice(&dev) != hipSuccess || hipDeviceGetAttribute(&cus, hipDeviceAttributeMultiprocessorCount, dev) != hipSuccess) { grid = -1; return; }
        if (hipFuncSetAttribute((const void*)fwd_kernel, hipFuncAttributeMaxDynamicSharedMemorySize, LDS_BYTES) != hipSuccess) { fprintf(stderr, "kernel_launch: hipFuncSetAttribute failed\n"); grid = -1; return; }
        if (hipOccupancyMaxActiveBlocksPerMultiprocessor(&per_cu, (const void*)fwd_kernel, NW * 64, LDS_BYTES) != hipSuccess || per_cu < 1) per_cu = 1;
        (void)hipGetLastError();
        grid = cus * (per_cu > 1 ? 1 : per_cu);
    }
    if (grid < 0) return;
    Args a{};
    for (int i = 0; i < 25; ++i) a.in[i] = (const float*)d_in[i];
    a.out = (float*)d_out; a.ws = (unsigned char*)d_ws;
#if MK_MULTI
    for (int ph = 0; ph < NPHASE; ++ph) { a.ph_lo = ph; a.ph_hi = ph + 1; hipLaunchKernelGGL(fwd_kernel, dim3(grid), dim3(NW * 64), LDS_BYTES, stream, a); }
#else
    a.ph_lo = 0; a.ph_hi = NPHASE;
    void* kargs[] = {&a};
    hipError_t e = hipLaunchCooperativeKernel((const void*)fwd_kernel, dim3(grid), dim3(NW * 64), kargs, LDS_BYTES, stream);
    if (e != hipSuccess) fprintf(stderr, "cooperative launch failed: %s (grid %d)\n", hipGetErrorString(e), grid);
#endif
}
```

```cpp
#include <hip/hip_runtime.h>
#include <hip/hip_bf16.h>
#include <hip/hip_cooperative_groups.h>
#include <cstdio>
#include <cstdint>
namespace cg = cooperative_groups;

#ifndef PROBE
#define PROBE 0
#endif
#ifndef STAGGER
#define STAGGER 0
#endif
#ifndef GATE_PF
#define GATE_PF false
#endif
#ifndef MK_MULTI
#define MK_MULTI 0
#endif

#define LAS __attribute__((address_space(3)))
typedef unsigned short bf16_t;
typedef short bf16x8 __attribute__((ext_vector_type(8)));
typedef short s16x4 __attribute__((ext_vector_type(4)));
typedef float f32x2 __attribute__((ext_vector_type(2)));
typedef float f32x4 __attribute__((ext_vector_type(4)));
typedef float f32x16 __attribute__((ext_vector_type(16)));
typedef unsigned u32x2 __attribute__((ext_vector_type(2)));
typedef unsigned u32x4 __attribute__((ext_vector_type(4)));

constexpr int DM = 1024, NPROJ = 6144, DFF = 2816, DEPTH = 2;
constexpr int T_CTX = 4096, T_ALL = 36864;
constexpr int CTX_S = 256, LAT_S = 4096, PAST = 512, SKV_LAT = 4608;
constexpr int PC_Q = 0, PC_U = 1024, PC_K = 1536, PC_V = 1792, PC_XV = 2048, PC_XP = 2560, PC_G = 3072;
constexpr float LN_EPS = 1e-6f;
constexpr float ALPHA = 1.41421356237309515f;
constexpr int NW = 8;
__host__ __device__ constexpr int part_row0(int p) { return p == 0 ? 0 : 20480; }
__host__ __device__ constexpr int part_rows(int p) { return p == 0 ? 20480 : 16384; }

constexpr size_t MiB = 1u << 20;
constexpr size_t WS_MOD = 0;
constexpr size_t WS_BAR = 448 * 1024;
constexpr size_t WS_ROPE = 512 * 1024;
constexpr size_t WS_WSGU = 768 * 1024;
constexpr size_t WS_WIN = 1 * MiB;
constexpr size_t WS_WM = 25 * MiB;
constexpr size_t WS_WOUT = 33 * MiB;
constexpr size_t WS_WF1 = 37 * MiB;
constexpr size_t WS_WF2 = 59 * MiB;
constexpr size_t WS_ACT = 70 * MiB;
constexpr size_t WS_PROJ = 142 * MiB;
constexpr size_t WS_KL = 382 * MiB, WS_VL = 391 * MiB;
constexpr size_t WS_KC = 400 * MiB, WS_VC = 402 * MiB;
constexpr size_t WS_VRT = 404 * MiB;
constexpr size_t WS_XBUF = 424 * MiB;
constexpr size_t WS_CNT = 426 * MiB;
constexpr int CNT_WORDS = 4 * 144 * 64;
constexpr size_t WS_XB = 427 * MiB;
constexpr size_t WS_END = 499 * MiB;

constexpr int LDS_BYTES = 143360;
constexpr int LDS_XCH = 131072 + 256;

__device__ __forceinline__ unsigned cvt_pk_bf16(float lo, float hi) { unsigned r; asm volatile("v_cvt_pk_bf16_f32 %0, %1, %2" : "=v"(r) : "v"(lo), "v"(hi)); return r; }
__device__ __forceinline__ float bf_lo(unsigned u) { return __uint_as_float(u << 16); }
__device__ __forceinline__ float bf_hi(unsigned u) { return __uint_as_float(u & 0xffff0000u); }
__device__ __forceinline__ float wave_sum(float v) {
#pragma unroll
    for (int o = 1; o < 64; o <<= 1) v += __shfl_xor(v, o);
    return v;
}
__device__ __forceinline__ float gelu1(float v) {
    const float av = fabsf(v), d = av * 0.2316418882f + 1.0f;
    const float t = __builtin_amdgcn_rcpf(d);
    float q = t * 0.5307027145f + (-0.7265760135f); q = q * t + 0.7107068705f; q = q * t + (-0.142248368f); q = q * t + 0.127414796f; q = q * t;
    const float e = __builtin_amdgcn_exp2f((v * v) * (-0.72134752044f));
    const float m = v * (q * e), r = v - m;
    return v < 0.f ? m : r;
}
__device__ __forceinline__ float sigmoidf_(float x) { return __builtin_amdgcn_rcpf(1.0f + __expf(-x)); }

namespace pg8 {
constexpr int BM = 256, BK = 64, HALF = 128, HTB = HALF * BK * 2, STAGE_BYTES = 8 * HTB, NXCD = 8, WGM = 8;
__host__ __device__ __forceinline__ int lds_byte(int r, int c) { const int st = (r >> 4) * 2 + (c >> 5), rr = r & 15, cc = c & 31, ob = rr * 64 + cc * 2; return st * 1024 + (ob ^ (((ob >> 9) & 1) << 5)); }
__host__ __device__ __forceinline__ void stage_rc(int b, int& R, int& C) { const int st = b / 1024, sb = b % 1024, swz = sb ^ (((sb >> 9) & 1) << 5); R = (st >> 1) * 16 + swz / 64; C = (st & 1) * 32 + (swz % 64) / 2; }
__host__ __device__ __forceinline__ int perm32(int rho) { const int n = rho >> 4, i = rho & 15; return 8 * (i >> 2) + 4 * n + (i & 3); }

struct Unit { int pm, pn, seg; };
struct Gemm { const bf16_t* A; const bf16_t* Bt; int lda, ldb, nM, nN, nseg; int k0[3]; int nt[3]; };

struct Order {
    int nM, nN, nwg, G, c, nseg, team, stagger;
    __device__ void init(int nM_, int nN_, int nseg_, int G_, int c_, int team_ = 0, int stagger_ = 0) { nM = nM_; nN = nN_; nwg = nM * nN; G = G_; c = c_; nseg = nseg_; team = team_; stagger = stagger_; }
    __device__ bool next(int i, Unit& u) const {
        if (team) {
            u.seg = 0; const int j = c >> 3; u.pn = j & 3; u.pm = i * (G >> 2) + (j >> 2) * 8 + (c & 7); return u.pm < nM;
        }
        const int ti = i / nseg; u.seg = i - ti * nseg;
        const long L = (long)ti * G + c; if (L >= nwg) return false;
        int wgid = (int)L; { const int q = nwg / NXCD, r = nwg % NXCD, xcd = wgid % NXCD, off = wgid / NXCD; wgid = (xcd < r ? xcd * (q + 1) : r * (q + 1) + (xcd - r) * q) + off; }
        const int nig = WGM * nN, gid = wgid / nig, fm = gid * WGM, gsz = (nM - fm) < WGM ? (nM - fm) : WGM;
        u.pm = fm + ((wgid % nig) % gsz); u.pn = (wgid % nig) / gsz; return true;
    }
};

struct EpiStore {
    static constexpr bool PREFETCH = false;
    static constexpr bool PERM = true;
    bf16_t* O; int ldc; int gate_col0;
    __device__ __forceinline__ void run(f32x4 (&acc)[2][2][4][2], const Unit& u, int wr, int wc, int fr, int fq) const {
        const int row0 = u.pm * BM + wr * 64 + fr; const int col0 = u.pn * BM + wc * 32 + 8 * fq;
        const bool gate = u.pn * BM >= gate_col0;
#pragma unroll
        for (int ai = 0; ai < 2; ++ai)
#pragma unroll
            for (int m = 0; m < 4; ++m) { bf16_t* rowp = O + (size_t)(row0 + ai * HALF + m * 16) * ldc + col0;
#pragma unroll
                for (int bj = 0; bj < 2; ++bj) { f32x4 v0 = acc[ai][bj][m][0], v1 = acc[ai][bj][m][1];
                    if (gate) {
#pragma unroll
                        for (int e = 0; e < 4; ++e) { v0[e] = 1.0f + __expf(-fmaxf(v0[e], -80.f)); v1[e] = 1.0f + __expf(-fmaxf(v1[e], -80.f)); } }
                    u32x4 w; w.x = cvt_pk_bf16(v0[0], v0[1]); w.y = cvt_pk_bf16(v0[2], v0[3]); w.z = cvt_pk_bf16(v1[0], v1[1]); w.w = cvt_pk_bf16(v1[2], v1[3]);
                    *(u32x4*)(rowp + bj * HALF) = w; } }
    }
};
struct EpiSwiGLU {
    static constexpr bool PREFETCH = false;
    static constexpr bool PERM = true;
    bf16_t* O; int ldc;
    __device__ __forceinline__ void run(f32x4 (&acc)[2][2][4][2], const Unit& u, int wr, int wc, int fr, int fq) const {
        const int row0 = u.pm * BM + wr * 64 + fr; const int col0 = u.pn * HALF + wc * 32 + 8 * fq;
#pragma unroll
        for (int ai = 0; ai < 2; ++ai)
#pragma unroll
            for (int m = 0; m < 4; ++m) { bf16_t* rowp = O + (size_t)(row0 + ai * HALF + m * 16) * ldc + col0;
                float o[8];
#pragma unroll
                for (int n = 0; n < 2; ++n)
#pragma unroll
                    for (int e = 0; e < 4; ++e) { const float a = acc[ai][0][m][n][e], b = acc[ai][1][m][n][e]; o[n * 4 + e] = a * sigmoidf_(a) * b; }
                u32x4 w; w.x = cvt_pk_bf16(o[0], o[1]); w.y = cvt_pk_bf16(o[2], o[3]); w.z = cvt_pk_bf16(o[4], o[5]); w.w = cvt_pk_bf16(o[6], o[7]);
                *(u32x4*)rowp = w; }
    }
};
struct EpiResid {
    static constexpr bool PREFETCH = false;
    static constexpr bool PERM = false;
    const float* xres_ctx; const float* xres_lat;
    float* out; const float* mod; int goff;
    __device__ __forceinline__ void run(f32x4 (&acc)[2][2][4][2], const Unit& u, int wr, int wc, int fr, int fq) const {
        const int v = u.pm < 16 ? 0 : 1 + ((u.pm - 16) >> 4);
        const float* xb = u.pm < 16 ? xres_ctx + (size_t)u.pm * BM * DM : xres_lat + (size_t)(u.pm - 16) * BM * DM;
        float* ob = out + (size_t)u.pm * BM * DM;
        const int col0 = u.pn * BM + wc * 32 + 4 * fq;
        const float* gp = mod + v * 6144 + goff + col0;
        f32x4 gv[2][2];
#pragma unroll
        for (int bj = 0; bj < 2; ++bj)
#pragma unroll
            for (int n = 0; n < 2; ++n) gv[bj][n] = *(const f32x4*)(gp + bj * HALF + n * 16);
#pragma unroll
        for (int ai = 0; ai < 2; ++ai)
#pragma unroll
            for (int m = 0; m < 4; ++m) { const size_t off = (size_t)(ai * HALF + wr * 64 + m * 16 + fr) * DM + col0;
#pragma unroll
                for (int bj = 0; bj < 2; ++bj)
#pragma unroll
                    for (int n = 0; n < 2; ++n) { const f32x4 x = *(const f32x4*)(xb + off + bj * HALF + n * 16);
                        *(f32x4*)(ob + off + bj * HALF + n * 16) = x * ALPHA + gv[bj][n] * acc[ai][bj][m][n]; } }
    }
};

struct PanelStats {
    unsigned long long* xbuf;
    unsigned* cnt;
    LAS unsigned char* lx;
    __device__ __forceinline__ void run(const f32x4 (&v)[2][2][4][2], const Unit& u, int wr, int wc, int fr, int fq, int wid, int lane) const {
        LAS f32x2* P = (LAS f32x2*)lx; LAS f32x2* S = (LAS f32x2*)(lx + 8192);
#pragma unroll
        for (int ai = 0; ai < 2; ++ai)
#pragma unroll
            for (int m = 0; m < 4; ++m) {
                float s = 0.f;
#pragma unroll
                for (int bj = 0; bj < 2; ++bj)
#pragma unroll
                    for (int n = 0; n < 2; ++n) { const f32x4 x = v[ai][bj][m][n]; s += (x[0] + x[1]) + (x[2] + x[3]); }
                s += __shfl_xor(s, 16); s += __shfl_xor(s, 32);
                const float mw = s * (1.0f / 64.0f); float q = 0.f;
#pragma unroll
                for (int bj = 0; bj < 2; ++bj)
#pragma unroll
                    for (int n = 0; n < 2; ++n) { const f32x4 d = v[ai][bj][m][n] - mw; q += (d[0] * d[0] + d[1] * d[1]) + (d[2] * d[2] + d[3] * d[3]); }
                q += __shfl_xor(q, 16); q += __shfl_xor(q, 32);
                if (fq == 0) P[(ai * HALF + wr * 64 + m * 16 + fr) * 4 + wc] = (f32x2){mw, q};
            }
        asm volatile("s_waitcnt lgkmcnt(0)" ::: "memory"); __builtin_amdgcn_s_barrier(); asm volatile("" ::: "memory");
        const int row = wid * 32 + (lane & 31);
        if (lane < 32) {
            const f32x2 a = P[row * 4 + 0], b = P[row * 4 + 1], c = P[row * 4 + 2], d = P[row * 4 + 3];
            const float mt = (a.x + b.x + c.x + d.x) * 0.25f;
            const float da = a.x - mt, db = b.x - mt, dc = c.x - mt, dd = d.x - mt;
            const float m2 = (a.y + b.y) + (c.y + d.y) + 64.0f * ((da * da + db * db) + (dc * dc + dd * dd));
            unsigned long long* slot = xbuf + ((size_t)(u.pm * BM + row) * 4 + u.pn);
            __hip_atomic_store(slot, ((unsigned long long)__float_as_uint(m2) << 32) | __float_as_uint(mt), __ATOMIC_RELAXED, __HIP_MEMORY_SCOPE_AGENT);
        }
        asm volatile("s_waitcnt vmcnt(0)" ::: "memory");
        if (lane == 0) __hip_atomic_fetch_add(cnt + 64 * u.pm, 1u, __ATOMIC_RELAXED, __HIP_MEMORY_SCOPE_AGENT);
        if (wid == 0) {
            unsigned sp = 0;
            for (;;) {
                if ((unsigned)__builtin_amdgcn_readfirstlane(__hip_atomic_load(cnt + 64 * u.pm, __ATOMIC_RELAXED, __HIP_MEMORY_SCOPE_AGENT)) >= 32u) break;
                if (++sp > (1u << 22)) break;
                __builtin_amdgcn_s_sleep(2);
            }
            __builtin_amdgcn_fence(__ATOMIC_ACQUIRE, "agent");
        }
        asm volatile("s_waitcnt vmcnt(0) lgkmcnt(0)" ::: "memory"); __builtin_amdgcn_s_barrier(); asm volatile("" ::: "memory");
        if (lane < 32) {
            const unsigned long long* slot = xbuf + (size_t)(u.pm * BM + row) * 4; float mt[4], m2[4]; float ms = 0.f;
#pragma unroll
            for (int t = 0; t < 4; ++t) { const unsigned long long w = __hip_atomic_load(slot + t, __ATOMIC_RELAXED, __HIP_MEMORY_SCOPE_AGENT); mt[t] = __uint_as_float((unsigned)w); m2[t] = __uint_as_float((unsigned)(w >> 32)); ms += mt[t]; }
            const float mean = ms * 0.25f; float q = 0.f;
#pragma unroll
            for (int t = 0; t < 4; ++t) { const float dm = mt[t] - mean; q += m2[t] + 256.0f * dm * dm; }
            S[row] = (f32x2){mean, rsqrtf(q * (1.0f / 1024.0f) + LN_EPS)};
        }
        asm volatile("s_waitcnt lgkmcnt(0)" ::: "memory"); __builtin_amdgcn_s_barrier(); asm volatile("" ::: "memory");
    }
};
template <int WHICH, bool INF32, bool OUTF32>
struct EpiResidLn {
    static constexpr bool PERM = false;
    static constexpr bool PREFETCH = false;
    const float* const* in; unsigned char* ws; float* out_; int l; LAS unsigned char* lx;
    __device__ __forceinline__ void prefetch(const Unit& u, int it, int nit, int wid, int lane_) const {
        int lane = lane_; asm volatile("" : "+v"(lane));
        const float* xb = (WHICH == 0 && l == 0) ? (u.pm < 16 ? in[0] + (size_t)u.pm * BM * DM : in[1] + (size_t)(u.pm - 16) * BM * DM) : out_ + (size_t)u.pm * BM * DM;
        const int R = nit >= 16 ? 2 : 4;
#pragma unroll
        for (int k = 0; k < 4; ++k) { const int j = it * R + k;
            if (k < R && j < 32) __builtin_amdgcn_global_load_lds((const unsigned*)(xb + (size_t)(j * 8 + wid) * DM + u.pn * BM + lane * 4), (LAS unsigned*)(lx + 10240), 16, 0, 0); }
    }
    __device__ __forceinline__ void run(f32x4 (&acc)[2][2][4][2], const Unit& u, int wr, int wc, int fr_, int fq_) const {
        int fr = fr_, fq = fq_; asm volatile("" : "+v"(fr), "+v"(fq));
        int lv = l; asm volatile("" : "+v"(lv)); lv = __builtin_amdgcn_readfirstlane(lv);
        const float* mod = (const float*)(ws + 0) + lv * 9 * 6144;
        float* out = out_;
        const float* xres_ctx = (WHICH == 0 && lv == 0) ? in[0] : out;
        const float* xres_lat = (WHICH == 0 && lv == 0) ? in[1] : out + (size_t)T_CTX * DM;
        const int goff = WHICH == 0 ? 2048 : 5120;
        const float* lg = in[WHICH == 0 ? 19 : 23] + lv * DM; const float* lb = in[WHICH == 0 ? 20 : 24] + lv * DM;
        bf16_t* act = (bf16_t*)(ws + (size_t)70 * 1048576);
        const float* modn = WHICH == 0 ? mod : (const float*)(ws + 0) + (lv + 1 < DEPTH ? lv + 1 : lv) * 9 * 6144;
        const int sh_off = WHICH == 0 ? 3072 : 0, sc_off = WHICH == 0 ? 4096 : 1024;
        PanelStats st{(unsigned long long*)(ws + (size_t)424 * 1048576), (unsigned*)(ws + (size_t)426 * 1048576) + (lv * 2 + WHICH) * 144 * 64, lx};
        const int v = u.pm < 16 ? 0 : 1 + ((u.pm - 16) >> 4);
        const float* xb = u.pm < 16 ? xres_ctx + (size_t)u.pm * BM * DM : xres_lat + (size_t)(u.pm - 16) * BM * DM;
        float* ob = out + (size_t)u.pm * BM * DM;
        bf16_t* xs = (bf16_t*)(ws + (size_t)427 * 1048576);
        const int col0 = u.pn * BM + wc * 32 + 4 * fq;
        const size_t roff = (size_t)(wr * 64 + fr) * DM + col0;
        {
            const float* gp = mod + v * 6144 + goff + col0;
            if constexpr (INF32) {
#pragma unroll
                for (int bj = 0; bj < 2; ++bj)
#pragma unroll
                    for (int n = 0; n < 2; ++n) { const f32x4 gv = *(const f32x4*)(gp + bj * HALF + n * 16);
#pragma unroll
                        for (int ai = 0; ai < 2; ++ai) {
#pragma unroll
                            for (int m = 0; m < 4; ++m) { const size_t o_ = roff + (size_t)(ai * HALF + m * 16) * DM + bj * HALF + n * 16;
                                const f32x4 x = *(const f32x4*)(xb + o_); acc[ai][bj][m][n] = x * ALPHA + gv * acc[ai][bj][m][n]; }
#pragma unroll
                            for (int m = 0; m < 4; ++m) asm volatile("" : "+v"(acc[ai][bj][m][n]));
                            asm volatile("" ::: "memory"); } }
            } else {
                u32x2 xw[2][2][2][4];
                const bf16_t* xp_ = xs + (size_t)u.pm * BM * DM + roff;
#pragma unroll
                for (int bj = 0; bj < 2; ++bj)
#pragma unroll
                    for (int n = 0; n < 2; ++n)
#pragma unroll
                        for (int ai = 0; ai < 2; ++ai)
#pragma unroll
                            for (int m = 0; m < 4; ++m) xw[bj][n][ai][m] = *(const u32x2*)(xp_ + (size_t)(ai * HALF + m * 16) * DM + bj * HALF + n * 16);
                f32x4 gvv[2][2];
#pragma unroll
                for (int bj = 0; bj < 2; ++bj)
#pragma unroll
                    for (int n = 0; n < 2; ++n) gvv[bj][n] = *(const f32x4*)(gp + bj * HALF + n * 16);
#pragma unroll
                for (int bj = 0; bj < 2; ++bj)
#pragma unroll
                    for (int n = 0; n < 2; ++n) { const f32x4 gv = gvv[bj][n];
#pragma unroll
                        for (int ai = 0; ai < 2; ++ai)
#pragma unroll
                            for (int m = 0; m < 4; ++m) { const u32x2 w = xw[bj][n][ai][m]; const f32x4 x = (f32x4){bf_lo(w.x), bf_hi(w.x), bf_lo(w.y), bf_hi(w.y)};
                                acc[ai][bj][m][n] = x * ALPHA + gv * acc[ai][bj][m][n]; } }
            }
        }
        const int lane = fq * 16 + fr, wid = wr * 4 + wc;
        st.run(acc, u, wr, wc, fr, fq, wid, lane);
        const LAS f32x2* S = (const LAS f32x2*)(st.lx + 8192);
        const float* mv = modn + v * 6144;
#pragma unroll
        for (int bj = 0; bj < 2; ++bj)
#pragma unroll
            for (int n = 0; n < 2; ++n) { const int c = col0 + bj * HALF + n * 16;
                const f32x4 g4 = *(const f32x4*)(lg + c), b4 = *(const f32x4*)(lb + c);
                f32x4 sh = (f32x4){0.f, 0.f, 0.f, 0.f}, sc = sh;
                sh = *(const f32x4*)(mv + sh_off + c); sc = *(const f32x4*)(mv + sc_off + c) + 1.0f;
#pragma unroll
                for (int ai = 0; ai < 2; ++ai)
#pragma unroll
                    for (int m = 0; m < 4; ++m) { const size_t off = roff + (size_t)(ai * HALF + m * 16) * DM + bj * HALF + n * 16;
                        const f32x2 sr = S[ai * HALF + wr * 64 + m * 16 + fr];
                        const f32x4 y = (acc[ai][bj][m][n] - sr.x) * sr.y * g4 + b4;
                        if (OUTF32) *(f32x4*)(ob + off) = y;
                        else { u32x2 w; w.x = cvt_pk_bf16(y[0], y[1]); w.y = cvt_pk_bf16(y[2], y[3]); *(u32x2*)(xs + (size_t)u.pm * BM * DM + off) = w; }
                        if (WHICH == 0 || lv + 1 < DEPTH) { const f32x4 h = y * sc + sh; u32x2 w; w.x = cvt_pk_bf16(h[0], h[1]); w.y = cvt_pk_bf16(h[2], h[3]);
                            *(u32x2*)(act + (size_t)u.pm * BM * DM + off) = w; } }
                asm volatile("" ::: "memory"); }
    }
};
struct EpiGate {
    static constexpr bool PERM = true;
    static constexpr bool PREFETCH = GATE_PF;
    LAS unsigned char* lx;
    __device__ __forceinline__ void prefetch(const Unit& u, int it, int nit, int wid, int lane_) const {
        if (u.seg == 2) return;
        int lane = lane_; asm volatile("" : "+v"(lane));
        const bf16_t* gb = P + (size_t)u.pm * BM * NPROJ + PC_G + u.pn * BM + (lane & 31) * 8;
#pragma unroll
        for (int k = 0; k < 4; ++k) { const int j = it * 4 + k;
            const int tile = u.seg == 0 ? (j >> 4) : 0; const int goff = u.seg == 0 ? (tile == 0 ? 0 : 2048) : 1024; const int jr = j & 15;
            if (j < (u.seg == 0 ? 32 : 16)) __builtin_amdgcn_global_load_lds((const unsigned*)(gb + (size_t)(jr * 16 + wid * 2 + (lane >> 5)) * NPROJ + goff), (LAS unsigned*)(lx + 10240), 16, 0, 0); }
    }
    const bf16_t* P;
    bf16_t* O; int ldc;
    __device__ __forceinline__ void run(f32x4 (&acc)[2][2][4][2], const Unit& u, int wr, int wc, int fr_, int fq_) const {
        int fr = fr_, fq = fq_; asm volatile("" : "+v"(fr), "+v"(fq));
        const int row0 = u.pm * BM + wr * 64 + fr; const int col0 = u.pn * BM + wc * 32 + 8 * fq;
        const bf16_t* gbase = P + (size_t)row0 * NPROJ + PC_G + col0;
        const bool last = u.seg == 2;
        const int noff = u.seg == 0 ? 0 : (u.seg == 1 ? 2048 : 1024), doff = u.seg == 0 ? 2048 : 1024;
#pragma unroll
        for (int am = 0; am < 2; ++am) { const int ai = am, mb = 0;
            u32x4 gn[4][2], gd[4][2];
#pragma unroll
            for (int mm = 0; mm < 4; ++mm)
#pragma unroll
                for (int bj = 0; bj < 2; ++bj) { const bf16_t* gp = gbase + (size_t)(ai * HALF + (mb + mm) * 16) * NPROJ + bj * HALF;
                    gn[mm][bj] = *(const u32x4*)(gp + noff); gd[mm][bj] = *(const u32x4*)(gp + doff); }
#pragma unroll
            for (int mm = 0; mm < 4; ++mm)
#pragma unroll
                for (int bj = 0; bj < 2; ++bj) { const int m = mb + mm; f32x4 v0 = acc[ai][bj][m][0], v1 = acc[ai][bj][m][1];
#pragma unroll
                    for (int e = 0; e < 2; ++e) {
                        v0[2 * e]     *= (last ? 1.0f : bf_lo(gd[mm][bj][e])) * __builtin_amdgcn_rcpf(bf_lo(gn[mm][bj][e]));
                        v0[2 * e + 1] *= (last ? 1.0f : bf_hi(gd[mm][bj][e])) * __builtin_amdgcn_rcpf(bf_hi(gn[mm][bj][e]));
                        v1[2 * e]     *= (last ? 1.0f : bf_lo(gd[mm][bj][2 + e])) * __builtin_amdgcn_rcpf(bf_lo(gn[mm][bj][2 + e]));
                        v1[2 * e + 1] *= (last ? 1.0f : bf_hi(gd[mm][bj][2 + e])) * __builtin_amdgcn_rcpf(bf_hi(gn[mm][bj][2 + e])); }
                    acc[ai][bj][m][0] = v0; acc[ai][bj][m][1] = v1;
                    if (last) { u32x4 w; w.x = cvt_pk_bf16(v0[0], v0[1]); w.y = cvt_pk_bf16(v0[2], v0[3]); w.z = cvt_pk_bf16(v1[0], v1[1]); w.w = cvt_pk_bf16(v1[2], v1[3]);
                        *(u32x4*)(O + (size_t)(row0 + ai * HALF + m * 16) * ldc + col0 + bj * HALF) = w; } }
            asm volatile("" ::: "memory");
        }
    }
};

struct EpiNone { static constexpr bool PREFETCH = false; static constexpr bool PERM = true; __device__ __forceinline__ void run(f32x4 (&acc)[2][2][4][2], const Unit& u, int wr, int wc, int fr, int fq) const {
    _Pragma("unroll") for (int a = 0; a < 2; ++a) _Pragma("unroll") for (int b = 0; b < 2; ++b) _Pragma("unroll") for (int m = 0; m < 4; ++m) _Pragma("unroll") for (int n = 0; n < 2; ++n) asm volatile("" :: "v"(acc[a][b][m][n])); } };
template <class Epi>
__device__ __forceinline__ void gemm_phase(LAS unsigned char* lds, const Gemm g, const Order& S, const Epi& E, const int tid) {
    const int wid = __builtin_amdgcn_readfirstlane(tid >> 6), lane = tid & 63, wr = wid >> 2, wc = wid & 3, fr = lane & 15, fq = lane >> 4;
    unsigned voffA[2], voffB[2];
#pragma unroll
    for (int i = 0; i < 2; ++i) { int R, C; stage_rc(tid * 16 + i * 8192, R, C); const int Rb = Epi::PERM ? ((R & ~31) + perm32(R & 31)) : R;
        voffA[i] = (unsigned)(R * g.lda + C) * 2u; voffB[i] = (unsigned)(Rb * g.ldb + C) * 2u; }
    const size_t kstep = (size_t)(BK * 2);
    const size_t hstepA = (size_t)HALF * g.lda * 2, hstepB = (size_t)HALF * g.ldb * 2;
    const size_t tstepA = 2 * hstepA, tstepB = 2 * hstepB;
    const unsigned ldsw = (unsigned)wid * 1024u;
    const int aoff = lds_byte(wr * 64 + fr, fq * 8), boff = lds_byte(wc * 32 + fr, fq * 8);
#define PG8_SA(b, h) (((b) * 2 + (h)) * HTB)
#define PG8_SB(b, h) ((4 + (b) * 2 + (h)) * HTB)
#define PG8_STAGE(bufoff, gbase, voff) do { _Pragma("unroll") for (int _i = 0; _i < 2; ++_i) \
        __builtin_amdgcn_global_load_lds((const unsigned*)((const char*)(gbase) + (voff)[_i]), (LAS unsigned*)(lds + (bufoff) + ldsw + _i * 8192), 16, 0, 0); } while (0)
#define PG8_LDA(dst, b, h) do { _Pragma("unroll") for (int m = 0; m < 4; ++m) _Pragma("unroll") for (int k = 0; k < 2; ++k) dst[m][k] = *(const LAS bf16x8*)(lds + PG8_SA(b, h) + aoff + m * 2048 + k * 1024); } while (0)
#define PG8_LDB(dst, b, h) do { _Pragma("unroll") for (int n = 0; n < 2; ++n) _Pragma("unroll") for (int k = 0; k < 2; ++k) dst[n][k] = *(const LAS bf16x8*)(lds + PG8_SB(b, h) + boff + n * 2048 + k * 1024); } while (0)
#define PG8_MMA(ai, bj, At, Bt) do { __builtin_amdgcn_s_setprio(1); _Pragma("unroll") for (int m = 0; m < 4; ++m) _Pragma("unroll") for (int n = 0; n < 2; ++n) _Pragma("unroll") for (int k = 0; k < 2; ++k) \
        acc[ai][bj][m][n] = __builtin_amdgcn_mfma_f32_16x16x32_bf16(Bt[n][k], At[m][k], acc[ai][bj][m][n], 0, 0, 0); __builtin_amdgcn_s_setprio(0); } while (0)
#define PG8_WAIT_V(n) asm volatile("s_waitcnt vmcnt(" #n ")" ::: "memory")
#define PG8_WAIT_L(n) asm volatile("s_waitcnt lgkmcnt(" #n ")" ::: "memory")
#define PG8_BAR __builtin_amdgcn_s_barrier()
#define PG8_SCHED __builtin_amdgcn_sched_barrier(0)
#define KOF(sg) ((sg) == 0 ? g.k0[0] : ((sg) == 1 ? g.k0[1] : g.k0[2]))
#define NTF(sg) ((sg) == 0 ? g.nt[0] : ((sg) == 1 ? g.nt[1] : g.nt[2]))
    Unit cur, nxt; int ui = 0;
    if (!S.next(0, cur)) return;
    if (S.stagger) {
        const int mine = (S.nwg - S.c + S.G - 1) / S.G, mx = (S.nwg + S.G - 1) / S.G;
        if (mine < mx) { const unsigned long long t0 = __builtin_amdgcn_s_memrealtime(); while (__builtin_amdgcn_s_memrealtime() - t0 < (unsigned long long)S.stagger) __builtin_amdgcn_s_sleep(16); }
    }
    f32x4 acc[2][2][4][2];
#pragma unroll
    for (int a = 0; a < 2; ++a)
#pragma unroll
        for (int b = 0; b < 2; ++b)
#pragma unroll
            for (int m = 0; m < 4; ++m)
#pragma unroll
                for (int n = 0; n < 2; ++n) acc[a][b][m][n] = (f32x4){0.f, 0.f, 0.f, 0.f};
    bf16x8 At[4][2], B0[2][2], B1[2][2];
    const char* cA = (const char*)g.A + (size_t)cur.pm * tstepA + (size_t)KOF(cur.seg) * 2; const char* cB = (const char*)g.Bt + (size_t)cur.pn * tstepB + (size_t)KOF(cur.seg) * 2;
    PG8_STAGE(PG8_SB(0, 0), cB, voffB); PG8_STAGE(PG8_SB(0, 1), cB + hstepB, voffB); PG8_STAGE(PG8_SA(0, 0), cA, voffA); PG8_STAGE(PG8_SA(0, 1), cA + hstepA, voffA);
    if (wr == 1) PG8_BAR;
    PG8_WAIT_V(2); PG8_BAR;
    PG8_STAGE(PG8_SB(1, 0), cB + kstep, voffB); PG8_STAGE(PG8_SA(1, 0), cA + kstep, voffA); PG8_STAGE(PG8_SB(1, 1), cB + hstepB + kstep, voffB);
    PG8_WAIT_V(6); PG8_BAR;
    for (;;) {
        const bool has_next = S.next(ui + 1, nxt);
        const int nt = NTF(cur.seg);
        const char* nA = has_next ? (const char*)g.A + (size_t)nxt.pm * tstepA + (size_t)KOF(nxt.seg) * 2 : cA;
        const char* nB = has_next ? (const char*)g.Bt + (size_t)nxt.pn * tstepB + (size_t)KOF(nxt.seg) * 2 : cB;
        for (int t = 0; t < nt; t += 2) {
            const bool last = (t == nt - 2);
            const char* a1 = cA + (size_t)(t + 1) * kstep;
            const char* a2 = last ? nA : cA + (size_t)(t + 2) * kstep; const char* b2 = last ? nB : cB + (size_t)(t + 2) * kstep;
            const char* a3 = a2 + kstep; const char* b3 = b2 + kstep;
            PG8_LDB(B0, 0, 0); PG8_LDB(B1, 0, 1); PG8_SCHED; PG8_LDA(At, 0, 0); PG8_STAGE(PG8_SA(1, 1), a1 + hstepA, voffA);
            if constexpr (Epi::PREFETCH) E.prefetch(cur, t >> 1, nt >> 1, wid, lane);
            PG8_WAIT_V(8); PG8_WAIT_L(0); PG8_BAR; PG8_MMA(0, 0, At, B0); PG8_MMA(0, 1, At, B1); PG8_BAR; PG8_SCHED;
            PG8_LDA(At, 0, 1); PG8_STAGE(PG8_SB(0, 0), b2, voffB); PG8_STAGE(PG8_SB(0, 1), b2 + hstepB, voffB); PG8_STAGE(PG8_SA(0, 0), a2, voffA);
            PG8_WAIT_V(8); PG8_WAIT_L(0); PG8_BAR; PG8_MMA(1, 0, At, B0); PG8_MMA(1, 1, At, B1); PG8_BAR; PG8_SCHED;
            PG8_LDB(B0, 1, 0); PG8_LDB(B1, 1, 1); PG8_SCHED; PG8_LDA(At, 1, 0); PG8_STAGE(PG8_SA(0, 1), a2 + hstepA, voffA);
            PG8_WAIT_V(8); PG8_WAIT_L(0); PG8_BAR; PG8_MMA(0, 0, At, B0); PG8_MMA(0, 1, At, B1); PG8_BAR; PG8_SCHED;
            PG8_LDA(At, 1, 1); PG8_STAGE(PG8_SB(1, 0), b3, voffB); PG8_STAGE(PG8_SB(1, 1), b3 + hstepB, voffB); PG8_STAGE(PG8_SA(1, 0), a3, voffA);
            PG8_WAIT_V(8); PG8_WAIT_L(0); PG8_BAR; PG8_MMA(1, 0, At, B0); PG8_MMA(1, 1, At, B1); PG8_BAR; PG8_SCHED;
        }
        if (wr == 0) PG8_BAR;
        E.run(acc, cur, wr, wc, fr, fq);
        if (!has_next) break;
        if (cur.seg == g.nseg - 1) {
#pragma unroll
            for (int a = 0; a < 2; ++a)
#pragma unroll
                for (int b = 0; b < 2; ++b)
#pragma unroll
                    for (int m = 0; m < 4; ++m)
#pragma unroll
                        for (int n = 0; n < 2; ++n) acc[a][b][m][n] = (f32x4){0.f, 0.f, 0.f, 0.f};
        }
        cur = nxt; cA = nA; cB = nB; ++ui;
        if (wr == 1) PG8_BAR;
    }
    PG8_WAIT_V(0);
    PG8_BAR;
#undef KOF
#undef NTF
#undef PG8_SA
#undef PG8_SB
#undef PG8_STAGE
#undef PG8_LDA
#undef PG8_LDB
#undef PG8_MMA
#undef PG8_WAIT_V
#undef PG8_WAIT_L
#undef PG8_BAR
#undef PG8_SCHED
}
}

namespace att {
constexpr int D = 128, QBLK = 32, KVBLK = 64;
constexpr float SCALE = 0.088388347648318440f;
constexpr float THR = 8.f;
constexpr size_t SHM_V = KVBLK * D * 2, SHM_K = KVBLK * D * 2, SHM_ATTN = 2 * SHM_V + 2 * SHM_K + NW * 64 * 4;
#define KSWZ(row, colB) ((row) * 256 + ((colB) ^ (((row) & 7) << 4)))
#define SBAR() __builtin_amdgcn_sched_barrier(0)
__device__ __forceinline__ int crow(int r, int hi) { return (r & 3) + 8 * (r >> 2) + 4 * hi; }
__device__ __forceinline__ unsigned cvtpk(float lo, float hi) { unsigned r; asm volatile("v_cvt_pk_bf16_f32 %0, %1, %2" : "=v"(r) : "v"(lo), "v"(hi)); return r; }
__device__ __forceinline__ void partialSM(f32x16& p0, f32x16& p1, float& m_reg, float& mn, float& alpha) {
  constexpr float C = SCALE * 1.4426950408889634f;
  float pmax = p0[0];
#pragma unroll
  for (int r = 1; r < 16; ++r) pmax = fmaxf(pmax, p0[r]);
#pragma unroll
  for (int r = 0; r < 16; ++r) pmax = fmaxf(pmax, p1[r]);
  { auto rr = __builtin_amdgcn_permlane32_swap(__float_as_uint(pmax), __float_as_uint(pmax), false, false);
    pmax = fmaxf(__uint_as_float(rr[0]), __uint_as_float(rr[1])); }
  if (__builtin_expect(__all(pmax - m_reg <= THR / SCALE), 1)) { mn = m_reg; alpha = 1.f; }
  else { mn = fmaxf(m_reg, pmax); alpha = __builtin_amdgcn_exp2f((m_reg - mn) * C); m_reg = mn; }
  float mnC = -mn * C;
#pragma unroll
  for (int r = 0; r < 16; ++r) p0[r] = fmaf(p0[r], C, mnC);
#pragma unroll
  for (int r = 0; r < 16; ++r) p1[r] = fmaf(p1[r], C, mnC);
#pragma unroll
  for (int r = 0; r < 16; ++r) p0[r] = __builtin_amdgcn_exp2f(p0[r]);
}
__device__ __forceinline__ void finishSM(f32x16& p0, f32x16& p1, float alpha, float& l_reg, bf16x8& pa0, bf16x8& pa1, bf16x8& pa2, bf16x8& pa3) {
#pragma unroll
  for (int r = 0; r < 16; ++r) p1[r] = __builtin_amdgcn_exp2f(p1[r]);
  float ps = 0;
#pragma unroll
  for (int r = 0; r < 16; ++r) ps += p0[r];
#pragma unroll
  for (int r = 0; r < 16; ++r) ps += p1[r];
  { auto rr = __builtin_amdgcn_permlane32_swap(__float_as_uint(ps), __float_as_uint(ps), false, false);
    ps = __uint_as_float(rr[0]) + __uint_as_float(rr[1]); }
  l_reg = l_reg * alpha + ps;
#define PK4(P, BASE, OUT) do { unsigned a0 = cvtpk(P[BASE + 0], P[BASE + 1]), a1 = cvtpk(P[BASE + 2], P[BASE + 3]);   \
    unsigned b0 = cvtpk(P[BASE + 4], P[BASE + 5]), b1 = cvtpk(P[BASE + 6], P[BASE + 7]);                              \
    auto r0 = __builtin_amdgcn_permlane32_swap(a0, b0, false, false); auto r1 = __builtin_amdgcn_permlane32_swap(a1, b1, false, false); \
    u32x4 w = {r0[0], r1[0], r0[1], r1[1]}; OUT = *reinterpret_cast<bf16x8*>(&w); } while (0)
  PK4(p0, 0, pa0); PK4(p0, 8, pa1); PK4(p1, 0, pa2); PK4(p1, 8, pa3);
#undef PK4
}
__device__ __forceinline__ void qkt(f32x16& p0, f32x16& p1, const bf16_t* Ks, const bf16x8* qr, int r32, int hi) {
  p0 = f32x16{}; p1 = f32x16{};
#pragma unroll
  for (int d0 = 0; d0 < 8; ++d0) { int cb = (d0 * 16 + hi * 8) * 2;
    bf16x8 b0 = *reinterpret_cast<const bf16x8*>((const char*)Ks + KSWZ(r32, cb));
    bf16x8 b1 = *reinterpret_cast<const bf16x8*>((const char*)Ks + KSWZ(32 + r32, cb));
    p0 = __builtin_amdgcn_mfma_f32_32x32x16_bf16(b0, qr[d0], p0, 0, 0, 0);
    p1 = __builtin_amdgcn_mfma_f32_32x32x16_bf16(b1, qr[d0], p1, 0, 0, 0); }
}
__device__ __forceinline__ int v_st(int k, int c) { const int kk = (k & ~0xC) | ((k & 4) << 1) | ((k & 8) >> 1); return ((kk >> 3) * 4 + (c >> 5)) * 512 + ((kk & 7) * 32 + (c & 31)) * 2; }
__device__ __forceinline__ int v_rd_base(int lane) { return ((lane & 3) << 3) | (((lane >> 2) & 3) << 6) | (((lane >> 4) & 1) << 5) | (((lane >> 5) & 1) << 8); }
constexpr int v_rd_off(int d0, int ks, int half) { return d0 * 512 + ks * 4096 + half * 2048; }
template <int OFF> __device__ __forceinline__ s16x4 tr_read(int vb) {
  s16x4 r; asm volatile("ds_read_b64_tr_b16 %0, %1 offset:%2" : "=&v"(r) : "v"(vb), "i"(OFF) : "memory"); return r;
}
template <int D0> __device__ __forceinline__ void pv_one(f32x16& od, int vb, bf16x8 pa0, bf16x8 pa1, bf16x8 pa2, bf16x8 pa3) {
  const s16x4 l0 = tr_read<v_rd_off(D0, 0, 0)>(vb), h0 = tr_read<v_rd_off(D0, 0, 1)>(vb), l1 = tr_read<v_rd_off(D0, 1, 0)>(vb), h1 = tr_read<v_rd_off(D0, 1, 1)>(vb);
  const s16x4 l2 = tr_read<v_rd_off(D0, 2, 0)>(vb), h2 = tr_read<v_rd_off(D0, 2, 1)>(vb), l3 = tr_read<v_rd_off(D0, 3, 0)>(vb), h3 = tr_read<v_rd_off(D0, 3, 1)>(vb);
  asm volatile("s_waitcnt lgkmcnt(0)" ::: "memory"); SBAR();
#define PK(L, H) (bf16x8){L[0], L[1], L[2], L[3], H[0], H[1], H[2], H[3]}
  od = __builtin_amdgcn_mfma_f32_32x32x16_bf16(pa0, PK(l0, h0), od, 0, 0, 0);
  od = __builtin_amdgcn_mfma_f32_32x32x16_bf16(pa1, PK(l1, h1), od, 0, 0, 0);
  od = __builtin_amdgcn_mfma_f32_32x32x16_bf16(pa2, PK(l2, h2), od, 0, 0, 0);
  od = __builtin_amdgcn_mfma_f32_32x32x16_bf16(pa3, PK(l3, h3), od, 0, 0, 0);
#undef PK
}
__device__ __forceinline__ void pv_d0(f32x16* o, int vb, bf16x8 pa0, bf16x8 pa1, bf16x8 pa2, bf16x8 pa3) {
  pv_one<0>(o[0], vb, pa0, pa1, pa2, pa3); pv_one<1>(o[1], vb, pa0, pa1, pa2, pa3); pv_one<2>(o[2], vb, pa0, pa1, pa2, pa3); pv_one<3>(o[3], vb, pa0, pa1, pa2, pa3);
}
constexpr int LDQ = NPROJ, LDK = 256;
__device__ __forceinline__ void attn_dense_body(bf16_t* Qb, const bf16_t* __restrict__ Kh, const bf16_t* __restrict__ Vh, int seq, char* lds, const int tid, const float* __restrict__ qg, const float* __restrict__ rope, int s0, const bool STORE = true) {
  const int wid = tid >> 6, lane = tid & 63, r32 = lane & 31, hi = lane >> 5;
  bf16_t* V_lds = (bf16_t*)lds; bf16_t* K_lds = (bf16_t*)(lds + 2 * SHM_V);
  float* ws = (float*)(lds + 2 * SHM_V + 2 * SHM_K) + wid * 64; float* li_l = ws; float* al_l = ws + 32;
  float m_reg = -1e30f, l_reg = 0; f32x16 o[4] = {}; bf16x8 qr[8];
  const bf16_t* Qw = Qb + (long)(wid * QBLK + r32) * LDQ + hi * 8;
#pragma unroll
  for (int d0 = 0; d0 < 8; ++d0) qr[d0] = *reinterpret_cast<const bf16x8*>(Qw + d0 * 16);
  {
    float ss = 0.f;
#pragma unroll
    for (int d0 = 0; d0 < 8; ++d0) { const u32x4 w = __builtin_bit_cast(u32x4, qr[d0]);
#pragma unroll
      for (int e = 0; e < 4; ++e) { const float lo = __uint_as_float(w[e] << 16), hi_ = __uint_as_float(w[e] & 0xffff0000u); ss += lo * lo + hi_ * hi_; } }
    { auto rr = __builtin_amdgcn_permlane32_swap(__float_as_uint(ss), __float_as_uint(ss), false, false); ss = __uint_as_float(rr[0]) + __uint_as_float(rr[1]); }
    const float rinv = rsqrtf(ss * (1.0f / 128.0f) + LN_EPS);
    const int sp = s0 + wid * QBLK + r32;
#pragma unroll
    for (int a = 0; a < 2; ++a) {
      float qf[4][8];
#pragma unroll
      for (int dd = 0; dd < 4; ++dd) { const int d0 = a * 4 + dd; const u32x4 w = __builtin_bit_cast(u32x4, qr[d0]);
        const f32x4 g0 = *(const f32x4*)(qg + d0 * 16 + hi * 8), g1 = *(const f32x4*)(qg + d0 * 16 + hi * 8 + 4);
        qf[dd][0] = __uint_as_float(w[0] << 16) * (rinv * g0[0]); qf[dd][1] = __uint_as_float(w[0] & 0xffff0000u) * (rinv * g0[1]);
        qf[dd][2] = __uint_as_float(w[1] << 16) * (rinv * g0[2]); qf[dd][3] = __uint_as_float(w[1] & 0xffff0000u) * (rinv * g0[3]);
        qf[dd][4] = __uint_as_float(w[2] << 16) * (rinv * g1[0]); qf[dd][5] = __uint_as_float(w[2] & 0xffff0000u) * (rinv * g1[1]);
        qf[dd][6] = __uint_as_float(w[3] << 16) * (rinv * g1[2]); qf[dd][7] = __uint_as_float(w[3] & 0xffff0000u) * (rinv * g1[3]); }
      if (rope) { const int pos = a == 0 ? (sp >> 6) : (sp & 63);
#pragma unroll
        for (int dd = 0; dd < 2; ++dd) { const float* cp = rope + pos * 32 + dd * 16 + hi * 8;
          const f32x4 c0 = *(const f32x4*)cp, c1 = *(const f32x4*)(cp + 4), s0v = *(const f32x4*)(cp + 2048), s1v = *(const f32x4*)(cp + 2048 + 4);
#pragma unroll
          for (int e = 0; e < 4; ++e) { float x1 = qf[dd][e], x2 = qf[dd + 2][e]; qf[dd][e] = x1 * c0[e] - x2 * s0v[e]; qf[dd + 2][e] = x2 * c0[e] + x1 * s0v[e];
            x1 = qf[dd][4 + e]; x2 = qf[dd + 2][4 + e]; qf[dd][4 + e] = x1 * c1[e] - x2 * s1v[e]; qf[dd + 2][4 + e] = x2 * c1[e] + x1 * s1v[e]; } } }
#pragma unroll
      for (int dd = 0; dd < 4; ++dd) { u32x4 w; w.x = cvtpk(qf[dd][0], qf[dd][1]); w.y = cvtpk(qf[dd][2], qf[dd][3]); w.z = cvtpk(qf[dd][4], qf[dd][5]); w.w = cvtpk(qf[dd][6], qf[dd][7]); qr[a * 4 + dd] = __builtin_bit_cast(bf16x8, w); }
      asm volatile("" ::: "memory");
    }
  }
  int tid2 = tid; asm volatile("" : "+v"(tid2));
  const int sr = tid2 >> 4, sc = (tid2 & 15) * 8, vst0 = v_st(sr, sc), vst1 = v_st(32 + sr, sc);
  const int vb0 = (int)(uintptr_t)V_lds + v_rd_base(tid2 & 63);
  struct { bf16x8 vs0, vs1, ks0, ks1; } sr_[1];
#define LD8(p) (*reinterpret_cast<const bf16x8*>(p))
#define SLOAD(i, k0) do { sr_[i].vs0 = LD8(&Vh[(long)((k0) + sr) * LDK + sc]); sr_[i].vs1 = LD8(&Vh[(long)((k0) + 32 + sr) * LDK + sc]); \
    sr_[i].ks0 = LD8(&Kh[(long)((k0) + sr) * LDK + sc]); sr_[i].ks1 = LD8(&Kh[(long)((k0) + 32 + sr) * LDK + sc]); } while (0)
#define SWRITE(b, i) do { *(bf16x8*)((char*)V_lds + (b) * SHM_V + vst0) = sr_[i].vs0;          \
    *(bf16x8*)((char*)V_lds + (b) * SHM_V + vst1) = sr_[i].vs1; int kc = sc * 2;               \
    *(bf16x8*)((char*)K_lds + (b) * SHM_K + KSWZ(sr, kc)) = sr_[i].ks0;                       \
    *(bf16x8*)((char*)K_lds + (b) * SHM_K + KSWZ(32 + sr, kc)) = sr_[i].ks1; } while (0)
#define SWAIT() asm volatile("s_waitcnt vmcnt(0)" ::: "memory")
#define RESC(a) do { if (__any((a) < 1.f)) { if (hi == 0) al_l[r32] = (a); asm volatile("s_waitcnt lgkmcnt(0)" ::: "memory"); \
    _Pragma("unroll") for (int d = 0; d < 4; ++d) _Pragma("unroll") for (int r = 0; r < 16; ++r) o[d][r] *= al_l[crow(r, hi)]; } } while (0)
  f32x16 pA0, pA1, pB0, pB1; float mnA, mnB, alA, alB; bf16x8 pa0, pa1, pa2, pa3; const int NT = seq / KVBLK;
  constexpr int SE = 0, SO = 0;
  SLOAD(SE, 0); asm volatile("s_waitcnt vmcnt(0)" ::: "memory"); SWRITE(0, SE); __syncthreads();
  qkt(pA0, pA1, K_lds, qr, r32, hi); partialSM(pA0, pA1, m_reg, mnA, alA);
  SLOAD(SO, KVBLK);
  SWAIT(); SWRITE(1, SO); __syncthreads();
  for (int j = 1; j + 1 < NT; j += 2) {
    SBAR(); qkt(pB0, pB1, (bf16_t*)((char*)K_lds + SHM_K), qr, r32, hi);
    finishSM(pA0, pA1, alA, l_reg, pa0, pa1, pa2, pa3); SBAR();
    SLOAD(SO, (j + 1) * KVBLK); SBAR();
    pv_d0(o, vb0, pa0, pa1, pa2, pa3); partialSM(pB0, pB1, m_reg, mnB, alB);
    __syncthreads(); SWAIT(); SWRITE(0, SE);
    RESC(alB); __syncthreads();
    SBAR(); qkt(pA0, pA1, K_lds, qr, r32, hi);
    finishSM(pB0, pB1, alB, l_reg, pa0, pa1, pa2, pa3); SBAR();
    SLOAD(SE, (j + 2) * KVBLK); SBAR();
    pv_d0(o, vb0 + (int)SHM_V, pa0, pa1, pa2, pa3); partialSM(pA0, pA1, m_reg, mnA, alA);
    __syncthreads(); SWAIT(); SWRITE(1, SO);
    RESC(alA); __syncthreads();
  }
  SBAR(); qkt(pB0, pB1, (bf16_t*)((char*)K_lds + SHM_K), qr, r32, hi);
  finishSM(pA0, pA1, alA, l_reg, pa0, pa1, pa2, pa3); SBAR();
  pv_d0(o, vb0, pa0, pa1, pa2, pa3); partialSM(pB0, pB1, m_reg, mnB, alB);
  __syncthreads(); RESC(alB);
  finishSM(pB0, pB1, alB, l_reg, pa0, pa1, pa2, pa3); SBAR();
  pv_d0(o, vb0 + (int)SHM_V, pa0, pa1, pa2, pa3);
  if (hi == 0) li_l[r32] = l_reg; asm volatile("s_waitcnt lgkmcnt(0)" ::: "memory");
  float rli[16];
#pragma unroll
  for (int r = 0; r < 16; ++r) rli[r] = __builtin_amdgcn_rcpf(li_l[crow(r, hi)]);
  __syncthreads();
  { bf16_t* stg = (bf16_t*)lds + wid * 4096;
#pragma unroll
    for (int r = 0; r < 16; ++r) { const int orow = crow(r, hi);
#pragma unroll
      for (int d0 = 0; d0 < 4; ++d0) stg[orow * 128 + d0 * 32 + r32] = (bf16_t)(cvtpk(o[d0][r] * rli[r], 0.f) & 0xffffu); }
    asm volatile("s_waitcnt lgkmcnt(0)" ::: "memory");
    int le = lane; asm volatile("" : "+v"(le));
    bf16_t* Ow = Qb + (long)(wid * QBLK + (le >> 4)) * LDQ + (le & 15) * 8;
#pragma unroll
    for (int i = 0; i < 8; ++i) { const u32x4 v = *(const u32x4*)(stg + (i * 4 + (le >> 4)) * 128 + (le & 15) * 8); if (STORE) *(u32x4*)(Ow + (long)i * 4 * LDQ) = v; else asm volatile("" :: "v"(v)); }
  }
  __syncthreads();
#undef LD8
#undef SLOAD
#undef SWRITE
#undef SWAIT
#undef RESC
}
#undef KSWZ
#undef SBAR
}


#define XB_TMO      128
#define XB_XCNT(j)  (256  + 64 * (j))
#define XB_XSUB(j)  (1280 + 64 * (j))
#define XB_XGEN(j)  (2304 + 64 * (j))
#define XB_TOP      3328
#define XB_TOPGEN   3392
#define XCD_BAR_WORDS 3456
#define XB_SPIN_CAP (1u << 18)
__device__ __forceinline__ unsigned xb_ld(unsigned* p)              { return __hip_atomic_load(p, __ATOMIC_RELAXED, __HIP_MEMORY_SCOPE_AGENT); }
__device__ __forceinline__ unsigned xb_add(unsigned* p, unsigned v) { return __hip_atomic_fetch_add(p, v, __ATOMIC_RELAXED, __HIP_MEMORY_SCOPE_AGENT); }
__device__ __forceinline__ unsigned xb_xcc_id() { return (unsigned)__builtin_amdgcn_s_getreg((3 << 11) | 20) & 0xFu; }
#define XB_SPIN(cond, bar) do { unsigned _sp = 0; while (cond) { __builtin_amdgcn_s_sleep(1); \
    if ((++_sp & 255u) == 0u) { if (xb_ld(&(bar)[XB_TMO])) break; if (_sp > XB_SPIN_CAP) { atomicAdd(&(bar)[XB_TMO], 1u); break; } } } } while (0)
struct XcdBarrier { unsigned* bar; unsigned x; volatile LAS unsigned* st; };
__device__ __forceinline__ XcdBarrier xcd_barrier_post(unsigned* bar, volatile LAS unsigned* st) {
    XcdBarrier b; b.bar = bar; b.x = xb_xcc_id(); b.st = st;
    if (threadIdx.x == 0) (void)xb_add(&bar[XB_XCNT(b.x)], 1u);
    return b;
}
__device__ __forceinline__ void xcd_barrier_complete(unsigned* bar, unsigned x, unsigned& nloc, unsigned& nx) {
    const unsigned G = gridDim.x * gridDim.y * gridDim.z;
    unsigned sum, cnt, mine, sp = 0u;
    for (;;) {
        sum = 0u; cnt = 0u; mine = 0u;
#pragma unroll
        for (unsigned j = 0; j < 16; ++j) { const unsigned c = xb_ld(&bar[XB_XCNT(j)]); sum += c; cnt += (c > 0u) ? 1u : 0u; mine = (j == x) ? c : mine; }
        if (sum == G) break;
        __builtin_amdgcn_s_sleep(1);
        if ((++sp & 255u) == 0u) { if (xb_ld(&bar[XB_TMO])) break; if (sp > XB_SPIN_CAP) { atomicAdd(&bar[XB_TMO], 1u); break; } }
    }
    nloc = mine > 0u ? mine : 1u; nx = cnt > 0u ? cnt : 1u;
}
__device__ __forceinline__ void xcd_barrier(const XcdBarrier& b) {
    asm volatile("s_waitcnt vmcnt(0)" ::: "memory");
    __syncthreads();
    if (threadIdx.x == 0) {
        unsigned* bar = b.bar;
        __builtin_amdgcn_s_waitcnt(0);
        unsigned nloc = b.st[0], nx = b.st[1];
        if (nloc == 0u) { xcd_barrier_complete(bar, b.x, nloc, nx); b.st[0] = nloc; b.st[1] = nx; }
        const unsigned old = xb_add(&bar[XB_XSUB(b.x)], 1u);
        const unsigned gen = old / nloc;
        if (old + 1u == (gen + 1u) * nloc) {
            __builtin_amdgcn_fence(__ATOMIC_RELEASE, "agent");
            asm volatile("s_waitcnt vmcnt(0)" ::: "memory");
            const unsigned og = xb_add(&bar[XB_TOP], 1u);
            const unsigned tg = og / nx;
            if (og + 1u == (tg + 1u) * nx) xb_add(&bar[XB_TOPGEN], 1u);
            else XB_SPIN(xb_ld(&bar[XB_TOPGEN]) == tg, bar);
            __builtin_amdgcn_fence(__ATOMIC_ACQUIRE, "agent");
            xb_add(&bar[XB_XGEN(b.x)], 1u);
            asm volatile("s_waitcnt vmcnt(0)" ::: "memory");
        } else {
            XB_SPIN(xb_ld(&bar[XB_XGEN(b.x)]) == gen, bar);
            __builtin_amdgcn_fence(__ATOMIC_ACQUIRE, "agent");
            asm volatile("s_waitcnt vmcnt(0)" ::: "memory");
        }
    }
    __syncthreads();
}

struct Args { const float* in[25]; float* out; unsigned char* ws; int ph_lo, ph_hi; };

typedef const float* fptr_t;
typedef __attribute__((address_space(4))) const fptr_t* in_as4_t;
struct Frame {
    LAS unsigned char* lds; char* ldsg;
    int tid, lane, wave, G, bx, gw, NGW;
    const float* const* in;
    unsigned char* ws; float* out;
};
enum { I_XP = 0, I_XS, I_CK, I_CV, I_C, I_CCTX, I_WADA, I_BADA, I_WIN, I_QG, I_KG, I_WPG, I_PSC, I_WSGU, I_BSGU, I_WAO, I_WPO, I_WSO, I_WOUT, I_LN1G, I_LN1B, I_WF1, I_WF2, I_LN2G, I_LN2B };

__device__ __forceinline__ void tr_item(const float* W, int ldw, int src_col, int kb, bf16_t* WT, int ldt, int dst_row, int dst_k, LAS float* scr, int lane) {
    const int k0 = 64 * kb;
#pragma unroll 8
    for (int i = 0; i < 32; ++i) { const int kk = 2 * i + (lane >> 5); scr[kk * 33 + (lane & 31)] = W[(size_t)(k0 + kk) * ldw + src_col + (lane & 31)]; }
    asm volatile("s_waitcnt lgkmcnt(0)" ::: "memory");
    const int c = lane & 7;
#pragma unroll
    for (int j = 0; j < 4; ++j) { const int n = (lane >> 3) + 8 * j; const LAS float* s = scr + (8 * c) * 33 + n;
        u32x4 o; o.x = cvt_pk_bf16(s[0 * 33], s[1 * 33]); o.y = cvt_pk_bf16(s[2 * 33], s[3 * 33]); o.z = cvt_pk_bf16(s[4 * 33], s[5 * 33]); o.w = cvt_pk_bf16(s[6 * 33], s[7 * 33]);
        *(u32x4*)(WT + (size_t)(dst_row + n) * ldt + dst_k + k0 + 8 * c) = o; }
    asm volatile("s_waitcnt lgkmcnt(0)" ::: "memory");
}

__device__ __forceinline__ int win_src_col(int d) {
    if (d < 1024) return d;
    if (d < 1536) return 2048 + (d - 1024);
    if (d < 2048) return 1024 + (d - 1536);
    if (d < 2560) return 2560 + (d - 2048);
    if (d < 3072) return 1536 + (d - 2560);
    return d;
}

__device__ __forceinline__ void phase_prologue(Frame& F) {
    if (F.bx < 192) {
        const int l = F.bx / 96, nb = F.bx % 96;
        LAS float* sc = (LAS float*)F.lds;
        LAS float* red = (LAS float*)(F.lds + 9 * 1024 * 4);
        for (int idx = F.tid; idx < 9 * 1024; idx += 512) { const int v = idx >> 10, k = idx & 1023;
            const float x = v == 0 ? F.in[I_CCTX][k] : F.in[I_C][(v - 1) * 1024 + k]; sc[idx] = x / (1.0f + __expf(-x)); }
        __syncthreads();
        float acc[9];
#pragma unroll
        for (int v = 0; v < 9; ++v) acc[v] = 0.f;
        const float* wp = F.in[I_WADA] + ((size_t)l * 1024 + F.wave * 128) * 6144 + nb * 64 + F.lane;
#pragma unroll 8
        for (int k = 0; k < 128; ++k) { const float w = wp[(size_t)k * 6144];
#pragma unroll
            for (int v = 0; v < 9; ++v) acc[v] += sc[v * 1024 + F.wave * 128 + k] * w; }
#pragma unroll
        for (int v = 0; v < 9; ++v) red[(F.wave * 9 + v) * 64 + F.lane] = acc[v];
        __syncthreads();
        float* mod = (float*)(F.ws + WS_MOD);
        for (int idx = F.tid; idx < 576; idx += 512) { const int v = idx >> 6, ln = idx & 63; float s = 0.f;
#pragma unroll
            for (int w = 0; w < 8; ++w) s += red[(w * 9 + v) * 64 + ln];
            mod[(l * 9 + v) * 6144 + nb * 64 + ln] = s + F.in[I_BADA][l * 6144 + nb * 64 + ln]; }
        __syncthreads();
    }
    LAS float* scr = (LAS float*)(F.lds + F.wave * 8448);
    constexpr int N_WIN = 16 * 192, N_AO = 16 * 32, N_SO = 8 * 32, N_WO = 16 * 32, N_F1 = 16 * 176, N_F2 = 44 * 32, N_PE = 1024, N_WS = 128;
    constexpr int N_L = N_WIN + N_AO + N_SO + N_WO + N_F1 + N_F2 + N_PE + N_WS;
    constexpr int N_ALL = 2 * N_L + 32;
    for (int it = F.gw; it < N_ALL; it += F.NGW) {
        if (it >= 2 * N_L) {
            const int idx = (it - 2 * N_L) * 64 + F.lane; const int pos = idx >> 5, p = idx & 31;
            const float inv = powf(10000.0f, -(float)p / 32.0f); const float ang = (float)pos * inv;
            float* rope = (float*)(F.ws + WS_ROPE); rope[idx] = cosf(ang); rope[2048 + idx] = sinf(ang);
            continue;
        }
        const int l = it / N_L; int r = it % N_L;
        if (r < N_WIN) { const int kb = r / 192, nb = r % 192;
            tr_item(F.in[I_WIN] + (size_t)l * 1024 * 6144, 6144, win_src_col(nb * 32), kb, (bf16_t*)(F.ws + WS_WIN) + (size_t)l * 6144 * 1024, 1024, nb * 32, 0, scr, F.lane); continue; } r -= N_WIN;
        if (r < N_AO) { const int kb = r / 32, nb = r % 32;
            tr_item(F.in[I_WAO] + (size_t)l * 1024 * 1024, 1024, nb * 32, kb, (bf16_t*)(F.ws + WS_WM) + (size_t)l * 1024 * 2048, 2048, nb * 32, 0, scr, F.lane); continue; } r -= N_AO;
        if (r < N_SO) { const int kb = r / 32, nb = r % 32;
            tr_item(F.in[I_WSO] + (size_t)l * 512 * 1024, 1024, nb * 32, kb, (bf16_t*)(F.ws + WS_WM) + (size_t)l * 1024 * 2048, 2048, nb * 32, 1024, scr, F.lane); continue; } r -= N_SO;
        if (r < N_WO) { const int kb = r / 32, nb = r % 32;
            tr_item(F.in[I_WOUT] + (size_t)l * 1024 * 1024, 1024, nb * 32, kb, (bf16_t*)(F.ws + WS_WOUT) + (size_t)l * 1024 * 1024, 1024, nb * 32, 0, scr, F.lane); continue; } r -= N_WO;
        if (r < N_F1) { const int kb = r / 176, nb = r % 176; const int drow = nb * 32; const int pn = drow >> 8, j = drow & 255;
            const int src = j < 128 ? pn * 128 + j : DFF + pn * 128 + (j - 128);
            tr_item(F.in[I_WF1] + (size_t)l * 1024 * 5632, 5632, src, kb, (bf16_t*)(F.ws + WS_WF1) + (size_t)l * 5632 * 1024, 1024, drow, 0, scr, F.lane); continue; } r -= N_F1;
        if (r < N_F2) { const int kb = r / 32, nb = r % 32;
            tr_item(F.in[I_WF2] + (size_t)l * DFF * 1024, 1024, nb * 32, kb, (bf16_t*)(F.ws + WS_WF2) + (size_t)l * 1024 * DFF, DFF, nb * 32, 0, scr, F.lane); continue; } r -= N_F2;
        if (r < N_PE) {
            const int kg = r >> 4, nb = r & 15; const int k0 = kg * 8, g = k0 >> 7; const int n = nb * 64 + F.lane;
            const float* wpg = F.in[I_WPG] + ((size_t)(l * 4 + g) * 128 + (k0 & 127)) * 128;
            const float* psc = F.in[I_PSC] + l * 512 + g * 128;
            const float* wpo = F.in[I_WPO] + ((size_t)l * 512 + g * 128) * 1024 + n;
            float a[8];
#pragma unroll
            for (int i = 0; i < 8; ++i) a[i] = 0.f;
#pragma unroll 4
            for (int j = 0; j < 128; ++j) { const float w = wpo[(size_t)j * 1024] * psc[j];
#pragma unroll
                for (int i = 0; i < 8; ++i) a[i] += wpg[i * 128 + j] * w; }
            u32x4 o; o.x = cvt_pk_bf16(a[0], a[1]); o.y = cvt_pk_bf16(a[2], a[3]); o.z = cvt_pk_bf16(a[4], a[5]); o.w = cvt_pk_bf16(a[6], a[7]);
            *(u32x4*)((bf16_t*)(F.ws + WS_WM) + (size_t)l * 1024 * 2048 + (size_t)n * 2048 + 1536 + k0) = o;
            continue; } r -= N_PE;
        {
            const size_t e0 = (size_t)l * 65536 + (size_t)r * 512 + F.lane * 8;
            const f32x4 a = *(const f32x4*)(F.in[I_WSGU] + e0), b = *(const f32x4*)(F.in[I_WSGU] + e0 + 4);
            u32x4 o; o.x = cvt_pk_bf16(a[0], a[1]); o.y = cvt_pk_bf16(a[2], a[3]); o.z = cvt_pk_bf16(b[0], b[1]); o.w = cvt_pk_bf16(b[2], b[3]);
            *(u32x4*)((bf16_t*)(F.ws + WS_WSGU) + e0) = o;
        }
    }
}

__device__ __forceinline__ const float* x0_row(Frame& F, int t) { return t < T_CTX ? F.in[I_XP] + (size_t)t * DM : F.in[I_XS] + (size_t)(t - T_CTX) * DM; }
__device__ __forceinline__ int vec_of_row(int t) { return t < T_CTX ? 0 : 1 + ((t - T_CTX) >> 12); }

__device__ __forceinline__ void phase_h0(Frame& F) {
    const float* mod = (const float*)(F.ws + WS_MOD);
    bf16_t* act = (bf16_t*)(F.ws + WS_ACT);
    for (int t = F.gw; t < T_ALL; t += F.NGW) {
        const f32x4* xr = (const f32x4*)x0_row(F, t) + F.lane;
        const float* mv = mod + vec_of_row(t) * 6144;
        unsigned long long* o8 = (unsigned long long*)(act + (size_t)t * DM) + F.lane;
#pragma unroll
        for (int j = 0; j < 4; ++j) { const f32x4 x = xr[64 * j]; const int c = 256 * j + 4 * F.lane;
            const f32x4 sh = *(const f32x4*)(mv + c), sc = *(const f32x4*)(mv + 1024 + c);
            const f32x4 h = x * (sc + 1.0f) + sh;
            o8[64 * j] = (unsigned long long)cvt_pk_bf16(h[0], h[1]) | ((unsigned long long)cvt_pk_bf16(h[2], h[3]) << 32); }
    }
}

__device__ __forceinline__ void phase_ln(Frame& F, const float* lg, const float* lb, const float* modl  , int sh_off, int sc_off, const bool dry = false) {
    float* X = F.out; bf16_t* act = (bf16_t*)(F.ws + WS_ACT);
    for (int t = F.gw; t < T_ALL; t += F.NGW) {
        f32x4* xr = (f32x4*)(X + (size_t)t * DM) + F.lane;
        f32x4 v[4]; float s = 0.f;
#pragma unroll
        for (int j = 0; j < 4; ++j) { v[j] = xr[64 * j]; s += (v[j][0] + v[j][1]) + (v[j][2] + v[j][3]); }
        const float mean = wave_sum(s) * (1.f / DM); float s2 = 0.f;
#pragma unroll
        for (int j = 0; j < 4; ++j) { v[j] = v[j] - mean; s2 += (v[j][0] * v[j][0] + v[j][1] * v[j][1]) + (v[j][2] * v[j][2] + v[j][3] * v[j][3]); }
        const float rstd = rsqrtf(wave_sum(s2) * (1.f / DM) + LN_EPS);
        const float* mv = modl ? modl + vec_of_row(t) * 6144 : nullptr;
        unsigned long long* o8 = (unsigned long long*)(act + (size_t)t * DM) + F.lane;
#pragma unroll
        for (int j = 0; j < 4; ++j) { const int c = 256 * j + 4 * F.lane;
            const f32x4 g = *(const f32x4*)(lg + c), b = *(const f32x4*)(lb + c);
            const f32x4 y = v[j] * rstd * g + b; if (!dry) xr[64 * j] = y; else { asm volatile("" :: "v"(y)); continue; }
            if (mv) { const f32x4 sh = *(const f32x4*)(mv + sh_off + c), sc = *(const f32x4*)(mv + sc_off + c);
                const f32x4 h = y * (sc + 1.0f) + sh;
                o8[64 * j] = (unsigned long long)cvt_pk_bf16(h[0], h[1]) | ((unsigned long long)cvt_pk_bf16(h[2], h[3]) << 32); } }
    }
}

__device__ __forceinline__ void load16h(const bf16_t* p, int j, float (&x)[16]) {
#pragma unroll
    for (int a = 0; a < 2; ++a)
#pragma unroll
        for (int hf = 0; hf < 2; ++hf) { const u32x2 w = *(const u32x2*)(p + a * 64 + hf * 32 + 4 * j);
            x[(a * 2 + hf) * 4 + 0] = bf_lo(w.x); x[(a * 2 + hf) * 4 + 1] = bf_hi(w.x); x[(a * 2 + hf) * 4 + 2] = bf_lo(w.y); x[(a * 2 + hf) * 4 + 3] = bf_hi(w.y); }
}
__device__ __forceinline__ void rmsn(float (&x)[16], const float (&g)[16]) {
    float ss = 0.f;
#pragma unroll
    for (int i = 0; i < 16; ++i) ss += x[i] * x[i];
    ss += __shfl_xor(ss, 1); ss += __shfl_xor(ss, 2); ss += __shfl_xor(ss, 4);
    const float rinv = rsqrtf(ss * (1.0f / 128.0f) + LN_EPS);
#pragma unroll
    for (int i = 0; i < 16; ++i) x[i] = x[i] * rinv * g[i];
}
__device__ __forceinline__ void rope16(float (&x)[16], const float* rope, int rowpos, int colpos, int j) {
#pragma unroll
    for (int a = 0; a < 2; ++a) { const int pos = a == 0 ? rowpos : colpos;
        const f32x4 c = *(const f32x4*)(rope + pos * 32 + 4 * j), s = *(const f32x4*)(rope + 2048 + pos * 32 + 4 * j);
#pragma unroll
        for (int e = 0; e < 4; ++e) { const float x1 = x[(a * 2) * 4 + e], x2 = x[(a * 2 + 1) * 4 + e];
            x[(a * 2) * 4 + e] = x1 * c[e] - x2 * s[e]; x[(a * 2 + 1) * 4 + e] = x2 * c[e] + x1 * s[e]; } }
}
__device__ __forceinline__ void store16h(bf16_t* p, int j, const float (&x)[16]) {
#pragma unroll
    for (int a = 0; a < 2; ++a)
#pragma unroll
        for (int hf = 0; hf < 2; ++hf) { u32x2 w; w.x = cvt_pk_bf16(x[(a * 2 + hf) * 4 + 0], x[(a * 2 + hf) * 4 + 1]); w.y = cvt_pk_bf16(x[(a * 2 + hf) * 4 + 2], x[(a * 2 + hf) * 4 + 3]);
            *(u32x2*)(p + a * 64 + hf * 32 + 4 * j) = w; }
}

__device__ __forceinline__ void phase_mid(Frame& F, int l, int part, const bool dry = false) {
    bf16_t* proj = (bf16_t*)(F.ws + WS_PROJ);
    const float* rope = (const float*)(F.ws + WS_ROPE);
    bf16_t* vrt = (bf16_t*)(F.ws + WS_VRT);
    bf16_t* KL = (bf16_t*)(F.ws + WS_KL); bf16_t* VL = (bf16_t*)(F.ws + WS_VL); bf16_t* KC = (bf16_t*)(F.ws + WS_KC); bf16_t* VC = (bf16_t*)(F.ws + WS_VC);
    float* outk = F.out + (size_t)T_ALL * DM; float* outv = outk + (size_t)16 * 2 * 256 * 256;
    const int lane = F.lane, hj = lane & 7;
    const int n8 = part_rows(part) / 4, ncache = 4 * PAST;
    float qg[16], kg[16];
#pragma unroll
    for (int a = 0; a < 2; ++a)
#pragma unroll
        for (int hf = 0; hf < 2; ++hf)
#pragma unroll
            for (int e = 0; e < 4; ++e) { const int d = a * 64 + hf * 32 + 4 * hj + e; qg[(a * 2 + hf) * 4 + e] = F.in[I_QG][l * 128 + d]; kg[(a * 2 + hf) * 4 + e] = F.in[I_KG][l * 128 + d]; }
    for (int it = F.gw; it < n8 + ncache; it += F.NGW) {
        if (it >= n8) {
            const int cr = it - n8; const int bl = cr >> 9, s = cr & 511; const int b = part * 4 + bl;
            const size_t src = (((size_t)b * 2 + l) * PAST + s) * 256 + lane * 4;
            const f32x4 kx = *(const f32x4*)(F.in[I_CK] + src), vx = *(const f32x4*)(F.in[I_CV] + src);
            const size_t dst = ((size_t)bl * SKV_LAT + s) * 256 + lane * 4;
            u32x2 kw, vw; kw.x = cvt_pk_bf16(kx[0], kx[1]); kw.y = cvt_pk_bf16(kx[2], kx[3]); vw.x = cvt_pk_bf16(vx[0], vx[1]); vw.y = cvt_pk_bf16(vx[2], vx[3]);
            if (!dry) { *(u32x2*)(KL + dst) = kw; *(u32x2*)(VL + dst) = vw; } else asm volatile("" :: "v"(kw), "v"(vw));
            continue;
        }
        const int lr0 = it * 4, t0 = part_row0(part) + lr0;
        const bool is_ctx = t0 < T_CTX;
        bf16_t* P0 = proj + (size_t)lr0 * NPROJ;
        {
            float val[4][8];
#pragma unroll
            for (int i = 0; i < 4; ++i) { const u32x4 w = *(const u32x4*)(P0 + (size_t)i * NPROJ + PC_XV + lane * 8);
#pragma unroll
                for (int e = 0; e < 4; ++e) { val[i][2 * e] = gelu1(bf_lo(w[e])); val[i][2 * e + 1] = gelu1(bf_hi(w[e])); } }
#pragma unroll
            for (int i = 0; i < 4; ++i) { float s = 0.f;
#pragma unroll
                for (int e = 0; e < 8; ++e) s += val[i][e];
                const float mean = wave_sum(s) * (1.0f / 512.0f); float s2 = 0.f;
#pragma unroll
                for (int e = 0; e < 8; ++e) { val[i][e] -= mean; s2 += val[i][e] * val[i][e]; }
                const float rstd = rsqrtf(wave_sum(s2) * (1.0f / 512.0f) + LN_EPS);
#pragma unroll
                for (int e = 0; e < 8; ++e) val[i][e] *= rstd; }
            const int chunk = lr0 >> 7, q0 = lr0 & 127;
            bf16_t* vb = vrt + ((size_t)chunk * 512 + lane * 8) * 128 + q0;
#pragma unroll
            for (int e = 0; e < 8; ++e) { u32x2 o; o.x = cvt_pk_bf16(val[0][e], val[1][e]); o.y = cvt_pk_bf16(val[2][e], val[3][e]);
                if (!dry) *(u32x2*)(vb + (size_t)e * 128) = o; else asm volatile("" :: "v"(o)); }
        }
#pragma unroll 1
        for (int i = 0; i < 4; ++i) {
            bf16_t* Pr = P0 + (size_t)i * NPROJ; const int t = t0 + i;
            int spos, seqS, rowpos = 0, colpos = 0, bl = 0;
            if (is_ctx) { spos = t & 255; seqS = CTX_S; } else { const int tl = t - T_CTX; spos = tl & 4095; seqS = LAT_S; rowpos = spos >> 6; colpos = spos & 63; bl = (tl >> 12) - part * 4; }
            float x[16];
            const int kh = (lane >> 3) & 1;
            u32x2 kw[4];
#pragma unroll
            for (int a = 0; a < 2; ++a)
#pragma unroll
                for (int hf = 0; hf < 2; ++hf) kw[a * 2 + hf] = *(const u32x2*)(Pr + PC_K + kh * 128 + a * 64 + hf * 32 + 4 * hj);
            const int vi = (lane - 16) & 31;
            const u32x4 vw = *(const u32x4*)(Pr + PC_V + vi * 8);
            f32x4 rcv[2], rsv[2];
#pragma unroll
            for (int a = 0; a < 2; ++a) { const int pos = a == 0 ? rowpos : colpos; rcv[a] = *(const f32x4*)(rope + pos * 32 + 4 * hj); rsv[a] = *(const f32x4*)(rope + 2048 + pos * 32 + 4 * hj); }
            float pacc[8], pself[8];
            {
                const int hw = 1 << (lane >> 4);
                const int lo = max(spos - hw, 0), hi = min(spos + hw, seqS);
#pragma unroll
                for (int e = 0; e < 8; ++e) pacc[e] = 0.f;
                u32x4 pw[16];
#pragma unroll
                for (int k = 0; k < 16; ++k) { const int dd = k - 8, sp = spos + dd; const bool ok = (sp >= lo) && (sp < hi);
                    pw[k] = *(const u32x4*)(Pr + (long)(ok ? dd : 0) * NPROJ + PC_XP + lane * 8); }
#pragma unroll
                for (int k = 0; k < 16; ++k) { const int sp = spos + k - 8; const float mk = ((sp >= lo) && (sp < hi)) ? 1.0f : 0.0f;
#pragma unroll
                    for (int e = 0; e < 4; ++e) { pacc[2 * e] += mk * bf_lo(pw[k][e]); pacc[2 * e + 1] += mk * bf_hi(pw[k][e]); } }
#pragma unroll
                for (int e = 0; e < 4; ++e) { pself[2 * e] = bf_lo(pw[8][e]); pself[2 * e + 1] = bf_hi(pw[8][e]); }
                const float rc = 1.0f / (float)(hi - lo);
#pragma unroll
                for (int e = 0; e < 8; ++e) pacc[e] = pacc[e] * rc - pself[e];
            }
#pragma unroll
            for (int q4 = 0; q4 < 4; ++q4) { x[q4 * 4 + 0] = bf_lo(kw[q4].x); x[q4 * 4 + 1] = bf_hi(kw[q4].x); x[q4 * 4 + 2] = bf_lo(kw[q4].y); x[q4 * 4 + 3] = bf_hi(kw[q4].y); }
            rmsn(x, kg);
            if (dry) { asm volatile("" :: "v"(x[0]), "v"(x[7]), "v"(vw), "v"(pacc[0]), "v"(pacc[7])); continue; }
            if (is_ctx) {
                if (lane < 16) {
                    float* ok = outk + (((size_t)(t >> 8) * 2 + l) * 256 + (t & 255)) * 256 + kh * 128;
#pragma unroll
                    for (int a = 0; a < 2; ++a)
#pragma unroll
                        for (int hf = 0; hf < 2; ++hf) *(f32x4*)(ok + a * 64 + hf * 32 + 4 * hj) = (f32x4){x[(a * 2 + hf) * 4], x[(a * 2 + hf) * 4 + 1], x[(a * 2 + hf) * 4 + 2], x[(a * 2 + hf) * 4 + 3]};
                    store16h(KC + (size_t)t * 256 + kh * 128, hj, x);
                }
                if (lane >= 16 && lane < 48) {
                    float* ov = outv + (((size_t)(t >> 8) * 2 + l) * 256 + (t & 255)) * 256 + vi * 8;
                    *(f32x4*)ov = (f32x4){bf_lo(vw[0]), bf_hi(vw[0]), bf_lo(vw[1]), bf_hi(vw[1])};
                    *(f32x4*)(ov + 4) = (f32x4){bf_lo(vw[2]), bf_hi(vw[2]), bf_lo(vw[3]), bf_hi(vw[3])};
                    *(u32x4*)(VC + (size_t)t * 256 + vi * 8) = vw;
                }
            } else {
#pragma unroll
                for (int a = 0; a < 2; ++a)
#pragma unroll
                    for (int e = 0; e < 4; ++e) { const float x1 = x[(a * 2) * 4 + e], x2 = x[(a * 2 + 1) * 4 + e];
                        x[(a * 2) * 4 + e] = x1 * rcv[a][e] - x2 * rsv[a][e]; x[(a * 2 + 1) * 4 + e] = x2 * rcv[a][e] + x1 * rsv[a][e]; }
                const size_t krow = ((size_t)bl * SKV_LAT + PAST + spos) * 256;
                if (lane < 16) store16h(KL + krow + kh * 128, hj, x);
                if (lane >= 16 && lane < 48) *(u32x4*)(VL + krow + vi * 8) = vw;
            }
            { u32x4 o; o.x = cvt_pk_bf16(pacc[0], pacc[1]); o.y = cvt_pk_bf16(pacc[2], pacc[3]); o.z = cvt_pk_bf16(pacc[4], pacc[5]); o.w = cvt_pk_bf16(pacc[6], pacc[7]);
              *(u32x4*)(Pr + PC_K + lane * 8) = o; }
        }
    }
}

__device__ __forceinline__ void phase_attn(Frame& F, int l, int part, const bool sgu_only_dry = false) {
    bf16_t* proj = (bf16_t*)(F.ws + WS_PROJ);
    const bf16_t* KL = (const bf16_t*)(F.ws + WS_KL); const bf16_t* VL = (const bf16_t*)(F.ws + WS_VL); const bf16_t* KC = (const bf16_t*)(F.ws + WS_KC); const bf16_t* VC = (const bf16_t*)(F.ws + WS_VC);
    const int lat_row0 = part == 0 ? T_CTX : 0;
    if (!sgu_only_dry) {
        int pair, idx, step; int rep = 0;
        const bool xcdmap = (F.G % 8) == 0;
        if (xcdmap) { pair = F.bx & 7; idx = F.bx >> 3; step = F.G >> 3; } else { pair = 0; idx = F.bx; step = F.G; }
        for (;;) {
            int pr = pair, ix = idx;
            if (!xcdmap) { pr = idx >> 6; ix = idx & 63; if (idx >= 512) break; } else if (idx >= 64) break;
            const int bl = pr >> 1, kvh = pr & 1, h = kvh * 4 + (ix >> 4), qb = ix & 15;
            bf16_t* Qb = proj + (size_t)(lat_row0 + bl * LAT_S + qb * 256) * NPROJ + PC_Q + h * 128;
            att::attn_dense_body(Qb, KL + (size_t)bl * SKV_LAT * 256 + kvh * 128, VL + (size_t)bl * SKV_LAT * 256 + kvh * 128, SKV_LAT, F.ldsg, F.tid, F.in[I_QG] + l * 128, (const float*)(F.ws + WS_ROPE), qb * 256, PROBE == 3 ? rep == 1 : true);
            if (PROBE == 3) { if (rep == 0) { rep = 1; continue; } rep = 0; }
            idx += step;
        }
    }
    if (part == 0 && !sgu_only_dry) {
        for (int u = F.bx; u < 128; u += F.G) { const int b = u >> 3, h = u & 7;
            bf16_t* Qb = proj + (size_t)(b * 256) * NPROJ + PC_Q + h * 128;
            att::attn_dense_body(Qb, KC + (size_t)b * 256 * 256 + (h >> 2) * 128, VC + (size_t)b * 256 * 256 + (h >> 2) * 128, CTX_S, F.ldsg, F.tid, F.in[I_QG] + l * 128, (const float*)nullptr, 0); }
    }
    const bf16_t* vrt = (const bf16_t*)(F.ws + WS_VRT);
    const bf16_t* wsb = (const bf16_t*)(F.ws + WS_WSGU) + (size_t)l * 65536;
    const float* bs = F.in[I_BSGU] + l * 512;
    const int nitem = (part_rows(part) / 128) * 32;
    const int ln = F.lane & 15, quad = F.lane >> 4;
    for (int it = F.NGW - 1 - F.gw; it < nitem; it += F.NGW) {
        const int chunk = it >> 5, g = (it >> 3) & 3, cb = (it >> 1) & 3, pb = it & 1;
        f32x4 acc[2][4];
#pragma unroll
        for (int a = 0; a < 2; ++a)
#pragma unroll
            for (int b = 0; b < 4; ++b) acc[a][b] = (f32x4){0.f, 0.f, 0.f, 0.f};
        const bf16_t* ap = vrt + ((size_t)chunk * 512 + g * 128 + cb * 32 + ln) * 128 + quad * 8;
        const bf16_t* bp = wsb + ((size_t)g * 128 + pb * 64 + ln) * 128 + quad * 8;
        u32x2 xw[4][2];
#pragma unroll
        for (int pt = 0; pt < 4; ++pt)
#pragma unroll
            for (int ct = 0; ct < 2; ++ct) xw[pt][ct] = *(const u32x2*)(proj + (size_t)(chunk * 128 + pb * 64 + pt * 16 + ln) * NPROJ + PC_U + g * 128 + cb * 32 + ct * 16 + quad * 4);
#pragma unroll
        for (int ks = 0; ks < 4; ++ks) {
            bf16x8 af[2], bfr[4];
#pragma unroll
            for (int ct = 0; ct < 2; ++ct) af[ct] = *(const bf16x8*)(ap + ct * 16 * 128 + ks * 32);
#pragma unroll
            for (int pt = 0; pt < 4; ++pt) bfr[pt] = *(const bf16x8*)(bp + pt * 16 * 128 + ks * 32);
#pragma unroll
            for (int ct = 0; ct < 2; ++ct)
#pragma unroll
                for (int pt = 0; pt < 4; ++pt) acc[ct][pt] = __builtin_amdgcn_mfma_f32_16x16x32_bf16(af[ct], bfr[pt], acc[ct][pt], 0, 0, 0);
        }
#pragma unroll
        for (int pt = 0; pt < 4; ++pt) { const int p = pb * 64 + pt * 16 + ln; const float bsv = bs[g * 128 + p];
#pragma unroll
            for (int ct = 0; ct < 2; ++ct) { const int c = g * 128 + cb * 32 + ct * 16 + quad * 4;
                bf16_t* up = proj + (size_t)(chunk * 128 + p) * NPROJ + PC_U + c;
                const u32x2 w = xw[pt][ct];
                const float u0 = gelu1(bf_lo(w.x)), u1 = gelu1(bf_hi(w.x)), u2 = gelu1(bf_lo(w.y)), u3 = gelu1(bf_hi(w.y));
                const f32x4 a = acc[ct][pt];
                u32x2 o; o.x = cvt_pk_bf16(u0 * (a[0] + bsv), u1 * (a[1] + bsv)); o.y = cvt_pk_bf16(u2 * (a[2] + bsv), u3 * (a[3] + bsv));
                if (!sgu_only_dry) *(u32x2*)up = o; else asm volatile("" :: "v"(o)); } }
    }
}

constexpr int NPL = 11, NPHASE = 2 + DEPTH * NPL;
__global__ void __launch_bounds__(NW * 64, 2) fwd_kernel(Args args) {
    extern __shared__ __attribute__((aligned(16))) unsigned char lds[];
    Frame F;
    F.lds = (LAS unsigned char*)lds; F.ldsg = (char*)lds;
    F.G = gridDim.x; F.bx = blockIdx.x; F.NGW = F.G * NW;
    F.in = args.in; F.ws = args.ws; F.out = args.out;
    const float* mod = (const float*)(F.ws + WS_MOD);
    bf16_t* act = (bf16_t*)(F.ws + WS_ACT); bf16_t* proj = (bf16_t*)(F.ws + WS_PROJ);
    volatile LAS unsigned* bst = (volatile LAS unsigned*)(F.lds + 131072 + 64);
    unsigned* barw = (unsigned*)(F.ws + WS_BAR);
    const int wave0 = __builtin_amdgcn_readfirstlane((int)threadIdx.x >> 6);
    { unsigned z0 = 0u; asm volatile("" : "+v"(z0)); int t0 = wave0 * 64 + (int)__builtin_amdgcn_mbcnt_hi(~0u, __builtin_amdgcn_mbcnt_lo(~0u, z0));
      if (t0 < 2) bst[t0] = 0u;
      if (blockIdx.x == 0 && args.ph_lo == 0) { for (int i = t0; i < XCD_BAR_WORDS; i += NW * 64) barw[i] = 0u;
        unsigned* cw = (unsigned*)(F.ws + WS_CNT); for (int i = t0; i < CNT_WORDS; i += NW * 64) cw[i] = 0u; } }
    __syncthreads();
    XcdBarrier xbar; xbar.bar = barw; xbar.x = 0; xbar.st = bst;
    for (int ph = args.ph_lo; ph < args.ph_hi; ++ph) {
        { unsigned zz = 0u; asm volatile("" : "+v"(zz)); const int lanev = (int)__builtin_amdgcn_mbcnt_hi(~0u, __builtin_amdgcn_mbcnt_lo(~0u, zz));
          F.lane = lanev; F.wave = wave0; F.tid = wave0 * 64 + lanev; F.gw = F.bx * NW + F.wave; }

#ifndef PHMASK
#define PHMASK 0xffff
#endif
        if (ph == 0) { if (PHMASK & 1) phase_prologue(F); if (PROBE == 4) { __syncthreads(); phase_prologue(F); } }
        else if (ph == 1) { if (PHMASK & 2) phase_h0(F); if (PROBE == 4) phase_h0(F); }
        else {
            const int l = (ph - 2) / NPL, s = (ph - 2) % NPL;
            if (s < 8) {
                const int part = s >> 2, q = s & 3;
                if (q == 0) { if (PHMASK & 4) {
                    pg8::Gemm g{}; g.A = act + (size_t)part_row0(part) * DM; g.Bt = (const bf16_t*)(F.ws + WS_WIN) + (size_t)l * NPROJ * DM; g.lda = DM; g.ldb = DM;
                    g.nM = part_rows(part) / 256; g.nN = NPROJ / 256; g.nseg = 1; g.k0[0] = 0; g.nt[0] = 16; g.k0[1] = 0; g.nt[1] = 16; g.k0[2] = 0; g.nt[2] = 16;
                    pg8::Order S; S.init(g.nM, g.nN, 1, F.G, F.bx, 0, STAGGER);
                    pg8::EpiStore E{proj, NPROJ, PC_G};
                    if (PROBE == 2) { pg8::EpiNone E0; pg8::gemm_phase<pg8::EpiNone>(F.lds, g, S, E0, F.tid); }
                    if (PROBE == 7) pg8::gemm_phase<pg8::EpiStore>(F.lds, g, S, E, F.tid);
                    pg8::gemm_phase<pg8::EpiStore>(F.lds, g, S, E, F.tid); }
                } else if (q == 1) { if (PROBE == 5) phase_mid(F, l, part, true); if (PHMASK & 8) phase_mid(F, l, part, false); }
                else if (q == 2) { if (PROBE == 6) phase_attn(F, l, part, true); if (PHMASK & 16) phase_attn(F, l, part, false); }
                else if (PHMASK & 32) {
                    pg8::Gemm g{}; g.A = proj; g.Bt = (const bf16_t*)(F.ws + WS_WM) + (size_t)l * DM * 2048; g.lda = NPROJ; g.ldb = 2048;
                    g.nM = part_rows(part) / 256; g.nN = 4; g.nseg = 3; g.k0[0] = 0; g.nt[0] = 16; g.k0[1] = 1024; g.nt[1] = 8; g.k0[2] = 1536; g.nt[2] = 8;
                    pg8::Order S; S.init(g.nM, g.nN, 3, F.G, F.bx);
                    pg8::EpiGate E{F.lds + LDS_XCH, proj, act + (size_t)part_row0(part) * DM, DM};
                    if (PROBE == 2) { pg8::EpiNone E0; pg8::gemm_phase<pg8::EpiNone>(F.lds, g, S, E0, F.tid); }
                    pg8::gemm_phase<pg8::EpiGate>(F.lds, g, S, E, F.tid);
                }
            } else if (s == 8) { if (PHMASK & 64) {
                pg8::Gemm g{}; g.A = act; g.Bt = (const bf16_t*)(F.ws + WS_WOUT) + (size_t)l * DM * DM; g.lda = DM; g.ldb = DM;
                g.nM = T_ALL / 256; g.nN = 4; g.nseg = 1; g.k0[0] = 0; g.nt[0] = 16; g.k0[1] = 0; g.nt[1] = 16; g.k0[2] = 0; g.nt[2] = 16;
                pg8::Order S; S.init(g.nM, g.nN, 1, F.G, F.bx, 1);
                if (l == 0) { pg8::EpiResidLn<0, true, false> E{F.in, F.ws, F.out, l, F.lds + LDS_XCH}; pg8::gemm_phase<pg8::EpiResidLn<0, true, false>>(F.lds, g, S, E, F.tid); }
                else { pg8::EpiResidLn<0, false, false> E{F.in, F.ws, F.out, l, F.lds + LDS_XCH}; pg8::gemm_phase<pg8::EpiResidLn<0, false, false>>(F.lds, g, S, E, F.tid); } }
            } else if (s == 9) { if (PHMASK & 256) {
                pg8::Gemm g{}; g.A = act; g.Bt = (const bf16_t*)(F.ws + WS_WF1) + (size_t)l * 2 * DFF * DM; g.lda = DM; g.ldb = DM;
                g.nM = T_ALL / 256; g.nN = 2 * DFF / 256; g.nseg = 1; g.k0[0] = 0; g.nt[0] = 16; g.k0[1] = 0; g.nt[1] = 16; g.k0[2] = 0; g.nt[2] = 16;
                pg8::Order S; S.init(g.nM, g.nN, 1, F.G, F.bx, 0, STAGGER);
                pg8::EpiSwiGLU E{proj, DFF};
                if (PROBE == 2) { pg8::EpiNone E0; pg8::gemm_phase<pg8::EpiNone>(F.lds, g, S, E0, F.tid); }
                if (PROBE == 7) pg8::gemm_phase<pg8::EpiSwiGLU>(F.lds, g, S, E, F.tid);
                pg8::gemm_phase<pg8::EpiSwiGLU>(F.lds, g, S, E, F.tid); }
            } else { if (PHMASK & 512) {
                pg8::Gemm g{}; g.A = proj; g.Bt = (const bf16_t*)(F.ws + WS_WF2) + (size_t)l * DM * DFF; g.lda = DFF; g.ldb = DFF;
                g.nM = T_ALL / 256; g.nN = 4; g.nseg = 1; g.k0[0] = 0; g.nt[0] = 44; g.k0[1] = 0; g.nt[1] = 44; g.k0[2] = 0; g.nt[2] = 44;
                pg8::Order S; S.init(g.nM, g.nN, 1, F.G, F.bx, 1);
                if (l + 1 < DEPTH) { pg8::EpiResidLn<1, false, false> E{F.in, F.ws, F.out, l, F.lds + LDS_XCH}; pg8::gemm_phase<pg8::EpiResidLn<1, false, false>>(F.lds, g, S, E, F.tid); }
                else { pg8::EpiResidLn<1, false, true> E{F.in, F.ws, F.out, l, F.lds + LDS_XCH}; pg8::gemm_phase<pg8::EpiResidLn<1, false, true>>(F.lds, g, S, E, F.tid); } }
            }
        }
        if (ph + 1 < args.ph_hi) {
            if (ph == args.ph_lo) { cg::this_grid().sync(); xbar = xcd_barrier_post(barw, bst); }
            else xcd_barrier(xbar);
            if (PROBE == 1 && ph == 1) { for (int k = 0; k < 20; ++k) xcd_barrier(xbar); }
        }
    }
}

extern "C" void kernel_launch(void* const* d_in, const int* in_sizes, int n_in, void* d_out, int out_size, void* d_ws, size_t ws_size, hipStream_t stream) {
    static int grid = 0;
    if (grid == 0) {
        if (n_in != 25 || ws_size < WS_END) { fprintf(stderr, "kernel_launch: unexpected n_in %d / ws %zu\n", n_in, ws_size); grid = -1; return; }
        int dev = 0, cus = 0, per_cu = 0;
        if (hipGetDevice(&dev) != hipSuccess || hipDeviceGetAttribute(&cus, hipDeviceAttributeMultiprocessorCount, dev) != hipSuccess) { grid = -1; return; }
        if (hipFuncSetAttribute((const void*)fwd_kernel, hipFuncAttributeMaxDynamicSharedMemorySize, LDS_BYTES) != hipSuccess) { fprintf(stderr, "kernel_launch: hipFuncSetAttribute failed\n"); grid = -1; return; }
        if (hipOccupancyMaxActiveBlocksPerMultiprocessor(&per_cu, (const void*)fwd_kernel, NW * 64, LDS_BYTES) != hipSuccess || per_cu < 1) per_cu = 1;
        (void)hipGetLastError();
        grid = cus * (per_cu > 1 ? 1 : per_cu);
    }
    if (grid < 0) return;
    Args a{};
    for (int i = 0; i < 25; ++i) a.in[i] = (const float*)d_in[i];
    a.out = (float*)d_out; a.ws = (unsigned char*)d_ws;
#if MK_MULTI
    for (int ph = 0; ph < NPHASE; ++ph) { a.ph_lo = ph; a.ph_hi = ph + 1; hipLaunchKernelGGL(fwd_kernel, dim3(grid), dim3(NW * 64), LDS_BYTES, stream, a); }
#else
    a.ph_lo = 0; a.ph_hi = NPHASE;
    void* kargs[] = {&a};
    hipError_t e = hipLaunchCooperativeKernel((const void*)fwd_kernel, dim3(grid), dim3(NW * 64), kargs, LDS_BYTES, stream);
    if (e != hipSuccess) fprintf(stderr, "cooperative launch failed: %s (grid %d)\n", hipGetErrorString(e), grid);
#endif
}
```

```cpp
#include <hip/hip_runtime.h>
#include <hip/hip_bf16.h>
#include <hip/hip_cooperative_groups.h>
#include <cstdio>
#include <cstdint>
namespace cg = cooperative_groups;

#ifndef PROBE
#define PROBE 0
#endif
#ifndef STAGGER
#define STAGGER 0
#endif
#ifndef GATE_PF
#define GATE_PF false
#endif
#ifndef MK_MULTI
#define MK_MULTI 0
#endif

#define LAS __attribute__((address_space(3)))
typedef unsigned short bf16_t;
typedef short bf16x8 __attribute__((ext_vector_type(8)));
typedef short s16x4 __attribute__((ext_vector_type(4)));
typedef float f32x2 __attribute__((ext_vector_type(2)));
typedef float f32x4 __attribute__((ext_vector_type(4)));
typedef float f32x16 __attribute__((ext_vector_type(16)));
typedef unsigned u32x2 __attribute__((ext_vector_type(2)));
typedef unsigned u32x4 __attribute__((ext_vector_type(4)));

constexpr int DM = 1024, NPROJ = 6144, DFF = 2816, DEPTH = 2;
constexpr int T_CTX = 4096, T_ALL = 36864;
constexpr int CTX_S = 256, LAT_S = 4096, PAST = 512, SKV_LAT = 4608;
constexpr int PC_Q = 0, PC_U = 1024, PC_K = 1536, PC_V = 1792, PC_XV = 2048, PC_XP = 2560, PC_G = 3072;
constexpr float LN_EPS = 1e-6f;
constexpr float ALPHA = 1.41421356237309515f;
constexpr int NW = 8;
__host__ __device__ constexpr int part_row0(int p) { return p == 0 ? 0 : 20480; }
__host__ __device__ constexpr int part_rows(int p) { return p == 0 ? 20480 : 16384; }

constexpr size_t MiB = 1u << 20;
constexpr size_t WS_MOD = 0;
constexpr size_t WS_BAR = 448 * 1024;
constexpr size_t WS_ROPE = 512 * 1024;
constexpr size_t WS_WSGU = 768 * 1024;
constexpr size_t WS_WIN = 1 * MiB;
constexpr size_t WS_WM = 25 * MiB;
constexpr size_t WS_WOUT = 33 * MiB;
constexpr size_t WS_WF1 = 37 * MiB;
constexpr size_t WS_WF2 = 59 * MiB;
constexpr size_t WS_ACT = 70 * MiB;
constexpr size_t WS_PROJ = 142 * MiB;
constexpr size_t WS_KL = 382 * MiB, WS_VL = 391 * MiB;
constexpr size_t WS_KC = 400 * MiB, WS_VC = 402 * MiB;
constexpr size_t WS_VRT = 404 * MiB;
constexpr size_t WS_XBUF = 424 * MiB;
constexpr size_t WS_CNT = 426 * MiB;
constexpr int CNT_WORDS = 4 * 144 * 64;
constexpr size_t WS_XB = 427 * MiB;
constexpr size_t WS_END = 499 * MiB;

constexpr int LDS_BYTES = 143360;
constexpr int LDS_XCH = 131072 + 256;

__device__ __forceinline__ unsigned cvt_pk_bf16(float lo, float hi) { unsigned r; asm volatile("v_cvt_pk_bf16_f32 %0, %1, %2" : "=v"(r) : "v"(lo), "v"(hi)); return r; }
__device__ __forceinline__ float bf_lo(unsigned u) { return __uint_as_float(u << 16); }
__device__ __forceinline__ float bf_hi(unsigned u) { return __uint_as_float(u & 0xffff0000u); }
__device__ __forceinline__ float wave_sum(float v) {
#pragma unroll
    for (int o = 1; o < 64; o <<= 1) v += __shfl_xor(v, o);
    return v;
}
__device__ __forceinline__ float gelu1(float v) {
    const float av = fabsf(v), d = av * 0.2316418882f + 1.0f;
    const float t = __builtin_amdgcn_rcpf(d);
    float q = t * 0.5307027145f + (-0.7265760135f); q = q * t + 0.7107068705f; q = q * t + (-0.142248368f); q = q * t + 0.127414796f; q = q * t;
    const float e = __builtin_amdgcn_exp2f((v * v) * (-0.72134752044f));
    const float m = v * (q * e), r = v - m;
    return v < 0.f ? m : r;
}
__device__ __forceinline__ float sigmoidf_(float x) { return __builtin_amdgcn_rcpf(1.0f + __expf(-x)); }

namespace pg8 {
constexpr int BM = 256, BK = 64, HALF = 128, HTB = HALF * BK * 2, STAGE_BYTES = 8 * HTB, NXCD = 8, WGM = 8;
__host__ __device__ __forceinline__ int lds_byte(int r, int c) { const int st = (r >> 4) * 2 + (c >> 5), rr = r & 15, cc = c & 31, ob = rr * 64 + cc * 2; return st * 1024 + (ob ^ (((ob >> 9) & 1) << 5)); }
__host__ __device__ __forceinline__ void stage_rc(int b, int& R, int& C) { const int st = b / 1024, sb = b % 1024, swz = sb ^ (((sb >> 9) & 1) << 5); R = (st >> 1) * 16 + swz / 64; C = (st & 1) * 32 + (swz % 64) / 2; }
__host__ __device__ __forceinline__ int perm32(int rho) { const int n = rho >> 4, i = rho & 15; return 8 * (i >> 2) + 4 * n + (i & 3); }

struct Unit { int pm, pn, seg; };
struct Gemm { const bf16_t* A; const bf16_t* Bt; int lda, ldb, nM, nN, nseg; int k0[3]; int nt[3]; };

struct Order {
    int nM, nN, nwg, G, c, nseg, team, stagger;
    __device__ void init(int nM_, int nN_, int nseg_, int G_, int c_, int team_ = 0, int stagger_ = 0) { nM = nM_; nN = nN_; nwg = nM * nN; G = G_; c = c_; nseg = nseg_; team = team_; stagger = stagger_; }
    __device__ bool next(int i, Unit& u) const {
        if (team) {
            u.seg = 0; const int j = c >> 3; u.pn = j & 3; u.pm = i * (G >> 2) + (j >> 2) * 8 + (c & 7); return u.pm < nM;
        }
        const int ti = i / nseg; u.seg = i - ti * nseg;
        const long L = (long)ti * G + c; if (L >= nwg) return false;
        int wgid = (int)L; { const int q = nwg / NXCD, r = nwg % NXCD, xcd = wgid % NXCD, off = wgid / NXCD; wgid = (xcd < r ? xcd * (q + 1) : r * (q + 1) + (xcd - r) * q) + off; }
        const int nig = WGM * nN, gid = wgid / nig, fm = gid * WGM, gsz = (nM - fm) < WGM ? (nM - fm) : WGM;
        u.pm = fm + ((wgid % nig) % gsz); u.pn = (wgid % nig) / gsz; return true;
    }
};

struct EpiStore {
    static constexpr bool PREFETCH = false;
    static constexpr bool PERM = true;
    bf16_t* O; int ldc; int gate_col0;
    __device__ __forceinline__ void run(f32x4 (&acc)[2][2][4][2], const Unit& u, int wr, int wc, int fr, int fq) const {
        const int row0 = u.pm * BM + wr * 64 + fr; const int col0 = u.pn * BM + wc * 32 + 8 * fq;
        const bool gate = u.pn * BM >= gate_col0;
#pragma unroll
        for (int ai = 0; ai < 2; ++ai)
#pragma unroll
            for (int m = 0; m < 4; ++m) { bf16_t* rowp = O + (size_t)(row0 + ai * HALF + m * 16) * ldc + col0;
#pragma unroll
                for (int bj = 0; bj < 2; ++bj) { f32x4 v0 = acc[ai][bj][m][0], v1 = acc[ai][bj][m][1];
                    if (gate) {
#pragma unroll
                        for (int e = 0; e < 4; ++e) { v0[e] = 1.0f + __expf(-fmaxf(v0[e], -80.f)); v1[e] = 1.0f + __expf(-fmaxf(v1[e], -80.f)); } }
                    u32x4 w; w.x = cvt_pk_bf16(v0[0], v0[1]); w.y = cvt_pk_bf16(v0[2], v0[3]); w.z = cvt_pk_bf16(v1[0], v1[1]); w.w = cvt_pk_bf16(v1[2], v1[3]);
                    *(u32x4*)(rowp + bj * HALF) = w; } }
    }
};
struct EpiSwiGLU {
    static constexpr bool PREFETCH = false;
    static constexpr bool PERM = true;
    bf16_t* O; int ldc;
    __device__ __forceinline__ void run(f32x4 (&acc)[2][2][4][2], const Unit& u, int wr, int wc, int fr, int fq) const {
        const int row0 = u.pm * BM + wr * 64 + fr; const int col0 = u.pn * HALF + wc * 32 + 8 * fq;
#pragma unroll
        for (int ai = 0; ai < 2; ++ai)
#pragma unroll
            for (int m = 0; m < 4; ++m) { bf16_t* rowp = O + (size_t)(row0 + ai * HALF + m * 16) * ldc + col0;
                float o[8];
#pragma unroll
                for (int n = 0; n < 2; ++n)
#pragma unroll
                    for (int e = 0; e < 4; ++e) { const float a = acc[ai][0][m][n][e], b = acc[ai][1][m][n][e]; o[n * 4 + e] = a * sigmoidf_(a) * b; }
                u32x4 w; w.x = cvt_pk_bf16(o[0], o[1]); w.y = cvt_pk_bf16(o[2], o[3]); w.z = cvt_pk_bf16(o[4], o[5]); w.w = cvt_pk_bf16(o[6], o[7]);
                *(u32x4*)rowp = w; }
    }
};
struct EpiResid {
    static constexpr bool PREFETCH = false;
    static constexpr bool PERM = false;
    const float* xres_ctx; const float* xres_lat;
    float* out; const float* mod; int goff;
    __device__ __forceinline__ void run(f32x4 (&acc)[2][2][4][2], const Unit& u, int wr, int wc, int fr, int fq) const {
        const int v = u.pm < 16 ? 0 : 1 + ((u.pm - 16) >> 4);
        const float* xb = u.pm < 16 ? xres_ctx + (size_t)u.pm * BM * DM : xres_lat + (size_t)(u.pm - 16) * BM * DM;
        float* ob = out + (size_t)u.pm * BM * DM;
        const int col0 = u.pn * BM + wc * 32 + 4 * fq;
        const float* gp = mod + v * 6144 + goff + col0;
        f32x4 gv[2][2];
#pragma unroll
        for (int bj = 0; bj < 2; ++bj)
#pragma unroll
            for (int n = 0; n < 2; ++n) gv[bj][n] = *(const f32x4*)(gp + bj * HALF + n * 16);
#pragma unroll
        for (int ai = 0; ai < 2; ++ai)
#pragma unroll
            for (int m = 0; m < 4; ++m) { const size_t off = (size_t)(ai * HALF + wr * 64 + m * 16 + fr) * DM + col0;
#pragma unroll
                for (int bj = 0; bj < 2; ++bj)
#pragma unroll
                    for (int n = 0; n < 2; ++n) { const f32x4 x = *(const f32x4*)(xb + off + bj * HALF + n * 16);
                        *(f32x4*)(ob + off + bj * HALF + n * 16) = x * ALPHA + gv[bj][n] * acc[ai][bj][m][n]; } }
    }
};

struct PanelStats {
    unsigned long long* xbuf;
    unsigned* cnt;
    LAS unsigned char* lx;
    __device__ __forceinline__ void run(const f32x4 (&v)[2][2][4][2], const Unit& u, int wr, int wc, int fr, int fq, int wid, int lane) const {
        LAS f32x2* P = (LAS f32x2*)lx; LAS f32x2* S = (LAS f32x2*)(lx + 8192);
#pragma unroll
        for (int ai = 0; ai < 2; ++ai)
#pragma unroll
            for (int m = 0; m < 4; ++m) {
                float s = 0.f;
#pragma unroll
                for (int bj = 0; bj < 2; ++bj)
#pragma unroll
                    for (int n = 0; n < 2; ++n) { const f32x4 x = v[ai][bj][m][n]; s += (x[0] + x[1]) + (x[2] + x[3]); }
                s += __shfl_xor(s, 16); s += __shfl_xor(s, 32);
                const float mw = s * (1.0f / 64.0f); float q = 0.f;
#pragma unroll
                for (int bj = 0; bj < 2; ++bj)
#pragma unroll
                    for (int n = 0; n < 2; ++n) { const f32x4 d = v[ai][bj][m][n] - mw; q += (d[0] * d[0] + d[1] * d[1]) + (d[2] * d[2] + d[3] * d[3]); }
                q += __shfl_xor(q, 16); q += __shfl_xor(q, 32);
                if (fq == 0) P[(ai * HALF + wr * 64 + m * 16 + fr) * 4 + wc] = (f32x2){mw, q};
            }
        asm volatile("s_waitcnt lgkmcnt(0)" ::: "memory"); __builtin_amdgcn_s_barrier(); asm volatile("" ::: "memory");
        const int row = wid * 32 + (lane & 31);
        if (lane < 32) {
            const f32x2 a = P[row * 4 + 0], b = P[row * 4 + 1], c = P[row * 4 + 2], d = P[row * 4 + 3];
            const float mt = (a.x + b.x + c.x + d.x) * 0.25f;
            const float da = a.x - mt, db = b.x - mt, dc = c.x - mt, dd = d.x - mt;
            const float m2 = (a.y + b.y) + (c.y + d.y) + 64.0f * ((da * da + db * db) + (dc * dc + dd * dd));
            unsigned long long* slot = xbuf + ((size_t)(u.pm * BM + row) * 4 + u.pn);
            __hip_atomic_store(slot, ((unsigned long long)__float_as_uint(m2) << 32) | __float_as_uint(mt), __ATOMIC_RELAXED, __HIP_MEMORY_SCOPE_AGENT);
        }
        asm volatile("s_waitcnt vmcnt(0)" ::: "memory");
        if (lane == 0) __hip_atomic_fetch_add(cnt + 64 * u.pm, 1u, __ATOMIC_RELAXED, __HIP_MEMORY_SCOPE_AGENT);
        if (wid == 0) {
            unsigned sp = 0;
            for (;;) {
                if ((unsigned)__builtin_amdgcn_readfirstlane(__hip_atomic_load(cnt + 64 * u.pm, __ATOMIC_RELAXED, __HIP_MEMORY_SCOPE_AGENT)) >= 32u) break;
                if (++sp > (1u << 22)) break;
                __builtin_amdgcn_s_sleep(2);
            }
            __builtin_amdgcn_fence(__ATOMIC_ACQUIRE, "agent");
        }
        asm volatile("s_waitcnt vmcnt(0) lgkmcnt(0)" ::: "memory"); __builtin_amdgcn_s_barrier(); asm volatile("" ::: "memory");
        if (lane < 32) {
            const unsigned long long* slot = xbuf + (size_t)(u.pm * BM + row) * 4; float mt[4], m2[4]; float ms = 0.f;
#pragma unroll
            for (int t = 0; t < 4; ++t) { const unsigned long long w = __hip_atomic_load(slot + t, __ATOMIC_RELAXED, __HIP_MEMORY_SCOPE_AGENT); mt[t] = __uint_as_float((unsigned)w); m2[t] = __uint_as_float((unsigned)(w >> 32)); ms += mt[t]; }
            const float mean = ms * 0.25f; float q = 0.f;
#pragma unroll
            for (int t = 0; t < 4; ++t) { const float dm = mt[t] - mean; q += m2[t] + 256.0f * dm * dm; }
            S[row] = (f32x2){mean, rsqrtf(q * (1.0f / 1024.0f) + LN_EPS)};
        }
        asm volatile("s_waitcnt lgkmcnt(0)" ::: "memory"); __builtin_amdgcn_s_barrier(); asm volatile("" ::: "memory");
    }
};
template <int WHICH, bool INF32, bool OUTF32>
struct EpiResidLn {
    static constexpr bool PERM = false;
    static constexpr bool PREFETCH = false;
    const float* const* in; unsigned char* ws; float* out_; int l; LAS unsigned char* lx;
    __device__ __forceinline__ void prefetch(const Unit& u, int it, int nit, int wid, int lane_) const {
        int lane = lane_; asm volatile("" : "+v"(lane));
        const float* xb = (WHICH == 0 && l == 0) ? (u.pm < 16 ? in[0] + (size_t)u.pm * BM * DM : in[1] + (size_t)(u.pm - 16) * BM * DM) : out_ + (size_t)u.pm * BM * DM;
        const int R = nit >= 16 ? 2 : 4;
#pragma unroll
        for (int k = 0; k < 4; ++k) { const int j = it * R + k;
            if (k < R && j < 32) __builtin_amdgcn_global_load_lds((const unsigned*)(xb + (size_t)(j * 8 + wid) * DM + u.pn * BM + lane * 4), (LAS unsigned*)(lx + 10240), 16, 0, 0); }
    }
    __device__ __forceinline__ void run(f32x4 (&acc)[2][2][4][2], const Unit& u, int wr, int wc, int fr_, int fq_) const {
        int fr = fr_, fq = fq_; asm volatile("" : "+v"(fr), "+v"(fq));
        int lv = l; asm volatile("" : "+v"(lv)); lv = __builtin_amdgcn_readfirstlane(lv);
        const float* mod = (const float*)(ws + 0) + lv * 9 * 6144;
        float* out = out_;
        const float* xres_ctx = (WHICH == 0 && lv == 0) ? in[0] : out;
        const float* xres_lat = (WHICH == 0 && lv == 0) ? in[1] : out + (size_t)T_CTX * DM;
        const int goff = WHICH == 0 ? 2048 : 5120;
        const float* lg = in[WHICH == 0 ? 19 : 23] + lv * DM; const float* lb = in[WHICH == 0 ? 20 : 24] + lv * DM;
        bf16_t* act = (bf16_t*)(ws + (size_t)70 * 1048576);
        const float* modn = WHICH == 0 ? mod : (const float*)(ws + 0) + (lv + 1 < DEPTH ? lv + 1 : lv) * 9 * 6144;
        const int sh_off = WHICH == 0 ? 3072 : 0, sc_off = WHICH == 0 ? 4096 : 1024;
        PanelStats st{(unsigned long long*)(ws + (size_t)424 * 1048576), (unsigned*)(ws + (size_t)426 * 1048576) + (lv * 2 + WHICH) * 144 * 64, lx};
        const int v = u.pm < 16 ? 0 : 1 + ((u.pm - 16) >> 4);
        const float* xb = u.pm < 16 ? xres_ctx + (size_t)u.pm * BM * DM : xres_lat + (size_t)(u.pm - 16) * BM * DM;
        float* ob = out + (size_t)u.pm * BM * DM;
        bf16_t* xs = (bf16_t*)(ws + (size_t)427 * 1048576);
        const int col0 = u.pn * BM + wc * 32 + 4 * fq;
        const size_t roff = (size_t)(wr * 64 + fr) * DM + col0;
        {
            const float* gp = mod + v * 6144 + goff + col0;
            if constexpr (INF32) {
#pragma unroll
                for (int bj = 0; bj < 2; ++bj)
#pragma unroll
                    for (int n = 0; n < 2; ++n) { const f32x4 gv = *(const f32x4*)(gp + bj * HALF + n * 16);
#pragma unroll
                        for (int ai = 0; ai < 2; ++ai) {
#pragma unroll
                            for (int m = 0; m < 4; ++m) { const size_t o_ = roff + (size_t)(ai * HALF + m * 16) * DM + bj * HALF + n * 16;
                                const f32x4 x = *(const f32x4*)(xb + o_); acc[ai][bj][m][n] = x * ALPHA + gv * acc[ai][bj][m][n]; }
#pragma unroll
                            for (int m = 0; m < 4; ++m) asm volatile("" : "+v"(acc[ai][bj][m][n]));
                            asm volatile("" ::: "memory"); } }
            } else {
                u32x2 xw[2][2][2][4];
                const bf16_t* xp_ = xs + (size_t)u.pm * BM * DM + roff;
#pragma unroll
                for (int bj = 0; bj < 2; ++bj)
#pragma unroll
                    for (int n = 0; n < 2; ++n)
#pragma unroll
                        for (int ai = 0; ai < 2; ++ai)
#pragma unroll
                            for (int m = 0; m < 4; ++m) xw[bj][n][ai][m] = *(const u32x2*)(xp_ + (size_t)(ai * HALF + m * 16) * DM + bj * HALF + n * 16);
                f32x4 gvv[2][2];
#pragma unroll
                for (int bj = 0; bj < 2; ++bj)
#pragma unroll
                    for (int n = 0; n < 2; ++n) gvv[bj][n] = *(const f32x4*)(gp + bj * HALF + n * 16);
#pragma unroll
                for (int bj = 0; bj < 2; ++bj)
#pragma unroll
                    for (int n = 0; n < 2; ++n) { const f32x4 gv = gvv[bj][n];
#pragma unroll
                        for (int ai = 0; ai < 2; ++ai)
#pragma unroll
                            for (int m = 0; m < 4; ++m) { const u32x2 w = xw[bj][n][ai][m]; const f32x4 x = (f32x4){bf_lo(w.x), bf_hi(w.x), bf_lo(w.y), bf_hi(w.y)};
                                acc[ai][bj][m][n] = x * ALPHA + gv * acc[ai][bj][m][n]; } }
            }
        }
        const int lane = fq * 16 + fr, wid = wr * 4 + wc;
        st.run(acc, u, wr, wc, fr, fq, wid, lane);
        const LAS f32x2* S = (const LAS f32x2*)(st.lx + 8192);
        const float* mv = modn + v * 6144;
        f32x4 G4[2][2], B4[2][2], SH[2][2], SC[2][2];
#pragma unroll
        for (int bj = 0; bj < 2; ++bj)
#pragma unroll
            for (int n = 0; n < 2; ++n) { const int c = col0 + bj * HALF + n * 16;
                G4[bj][n] = *(const f32x4*)(lg + c); B4[bj][n] = *(const f32x4*)(lb + c); SH[bj][n] = *(const f32x4*)(mv + sh_off + c); SC[bj][n] = *(const f32x4*)(mv + sc_off + c); }
#pragma unroll
        for (int bj = 0; bj < 2; ++bj)
#pragma unroll
            for (int n = 0; n < 2; ++n) {
                const f32x4 g4 = G4[bj][n], b4 = B4[bj][n], sh = SH[bj][n], sc = SC[bj][n] + 1.0f;
#pragma unroll
                for (int ai = 0; ai < 2; ++ai)
#pragma unroll
                    for (int m = 0; m < 4; ++m) { const size_t off = roff + (size_t)(ai * HALF + m * 16) * DM + bj * HALF + n * 16;
                        const f32x2 sr = S[ai * HALF + wr * 64 + m * 16 + fr];
                        const f32x4 y = (acc[ai][bj][m][n] - sr.x) * sr.y * g4 + b4;
                        if (OUTF32) *(f32x4*)(ob + off) = y;
                        else { u32x2 w; w.x = cvt_pk_bf16(y[0], y[1]); w.y = cvt_pk_bf16(y[2], y[3]); *(u32x2*)(xs + (size_t)u.pm * BM * DM + off) = w; }
                        if (WHICH == 0 || lv + 1 < DEPTH) { const f32x4 h = y * sc + sh; u32x2 w; w.x = cvt_pk_bf16(h[0], h[1]); w.y = cvt_pk_bf16(h[2], h[3]);
                            *(u32x2*)(act + (size_t)u.pm * BM * DM + off) = w; } }
                asm volatile("" ::: "memory"); }
    }
};
struct EpiGate {
    static constexpr bool PERM = true;
    static constexpr bool PREFETCH = GATE_PF;
    LAS unsigned char* lx;
    __device__ __forceinline__ void prefetch(const Unit& u, int it, int nit, int wid, int lane_) const {
        if (u.seg == 2) return;
        int lane = lane_; asm volatile("" : "+v"(lane));
        const bf16_t* gb = P + (size_t)u.pm * BM * NPROJ + PC_G + u.pn * BM + (lane & 31) * 8;
#pragma unroll
        for (int k = 0; k < 4; ++k) { const int j = it * 4 + k;
            const int tile = u.seg == 0 ? (j >> 4) : 0; const int goff = u.seg == 0 ? (tile == 0 ? 0 : 2048) : 1024; const int jr = j & 15;
            if (j < (u.seg == 0 ? 32 : 16)) __builtin_amdgcn_global_load_lds((const unsigned*)(gb + (size_t)(jr * 16 + wid * 2 + (lane >> 5)) * NPROJ + goff), (LAS unsigned*)(lx + 10240), 16, 0, 0); }
    }
    const bf16_t* P;
    bf16_t* O; int ldc;
    __device__ __forceinline__ void run(f32x4 (&acc)[2][2][4][2], const Unit& u, int wr, int wc, int fr_, int fq_) const {
        int fr = fr_, fq = fq_; asm volatile("" : "+v"(fr), "+v"(fq));
        const int row0 = u.pm * BM + wr * 64 + fr; const int col0 = u.pn * BM + wc * 32 + 8 * fq;
        const bf16_t* gbase = P + (size_t)row0 * NPROJ + PC_G + col0;
        const bool last = u.seg == 2;
        const int noff = u.seg == 0 ? 0 : (u.seg == 1 ? 2048 : 1024), doff = u.seg == 0 ? 2048 : 1024;
#pragma unroll
        for (int am = 0; am < 2; ++am) { const int ai = am, mb = 0;
            u32x4 gn[4][2], gd[4][2];
#pragma unroll
            for (int mm = 0; mm < 4; ++mm)
#pragma unroll
                for (int bj = 0; bj < 2; ++bj) { const bf16_t* gp = gbase + (size_t)(ai * HALF + (mb + mm) * 16) * NPROJ + bj * HALF;
                    gn[mm][bj] = *(const u32x4*)(gp + noff); gd[mm][bj] = *(const u32x4*)(gp + doff); }
#pragma unroll
            for (int mm = 0; mm < 4; ++mm)
#pragma unroll
                for (int bj = 0; bj < 2; ++bj) { const int m = mb + mm; f32x4 v0 = acc[ai][bj][m][0], v1 = acc[ai][bj][m][1];
#pragma unroll
                    for (int e = 0; e < 2; ++e) {
                        v0[2 * e]     *= (last ? 1.0f : bf_lo(gd[mm][bj][e])) * __builtin_amdgcn_rcpf(bf_lo(gn[mm][bj][e]));
                        v0[2 * e + 1] *= (last ? 1.0f : bf_hi(gd[mm][bj][e])) * __builtin_amdgcn_rcpf(bf_hi(gn[mm][bj][e]));
                        v1[2 * e]     *= (last ? 1.0f : bf_lo(gd[mm][bj][2 + e])) * __builtin_amdgcn_rcpf(bf_lo(gn[mm][bj][2 + e]));
                        v1[2 * e + 1] *= (last ? 1.0f : bf_hi(gd[mm][bj][2 + e])) * __builtin_amdgcn_rcpf(bf_hi(gn[mm][bj][2 + e])); }
                    acc[ai][bj][m][0] = v0; acc[ai][bj][m][1] = v1;
                    if (last) { u32x4 w; w.x = cvt_pk_bf16(v0[0], v0[1]); w.y = cvt_pk_bf16(v0[2], v0[3]); w.z = cvt_pk_bf16(v1[0], v1[1]); w.w = cvt_pk_bf16(v1[2], v1[3]);
                        *(u32x4*)(O + (size_t)(row0 + ai * HALF + m * 16) * ldc + col0 + bj * HALF) = w; } }
            asm volatile("" ::: "memory");
        }
    }
};

struct EpiNone { static constexpr bool PREFETCH = false; static constexpr bool PERM = true; __device__ __forceinline__ void run(f32x4 (&acc)[2][2][4][2], const Unit& u, int wr, int wc, int fr, int fq) const {
    _Pragma("unroll") for (int a = 0; a < 2; ++a) _Pragma("unroll") for (int b = 0; b < 2; ++b) _Pragma("unroll") for (int m = 0; m < 4; ++m) _Pragma("unroll") for (int n = 0; n < 2; ++n) asm volatile("" :: "v"(acc[a][b][m][n])); } };
template <class Epi>
__device__ __forceinline__ void gemm_phase(LAS unsigned char* lds, const Gemm g, const Order& S, const Epi& E, const int tid) {
    const int wid = __builtin_amdgcn_readfirstlane(tid >> 6), lane = tid & 63, wr = wid >> 2, wc = wid & 3, fr = lane & 15, fq = lane >> 4;
    unsigned voffA[2], voffB[2];
#pragma unroll
    for (int i = 0; i < 2; ++i) { int R, C; stage_rc(tid * 16 + i * 8192, R, C); const int Rb = Epi::PERM ? ((R & ~31) + perm32(R & 31)) : R;
        voffA[i] = (unsigned)(R * g.lda + C) * 2u; voffB[i] = (unsigned)(Rb * g.ldb + C) * 2u; }
    const size_t kstep = (size_t)(BK * 2);
    const size_t hstepA = (size_t)HALF * g.lda * 2, hstepB = (size_t)HALF * g.ldb * 2;
    const size_t tstepA = 2 * hstepA, tstepB = 2 * hstepB;
    const unsigned ldsw = (unsigned)wid * 1024u;
    const int aoff = lds_byte(wr * 64 + fr, fq * 8), boff = lds_byte(wc * 32 + fr, fq * 8);
#define PG8_SA(b, h) (((b) * 2 + (h)) * HTB)
#define PG8_SB(b, h) ((4 + (b) * 2 + (h)) * HTB)
#define PG8_STAGE(bufoff, gbase, voff) do { _Pragma("unroll") for (int _i = 0; _i < 2; ++_i) \
        __builtin_amdgcn_global_load_lds((const unsigned*)((const char*)(gbase) + (voff)[_i]), (LAS unsigned*)(lds + (bufoff) + ldsw + _i * 8192), 16, 0, 0); } while (0)
#define PG8_LDA(dst, b, h) do { _Pragma("unroll") for (int m = 0; m < 4; ++m) _Pragma("unroll") for (int k = 0; k < 2; ++k) dst[m][k] = *(const LAS bf16x8*)(lds + PG8_SA(b, h) + aoff + m * 2048 + k * 1024); } while (0)
#define PG8_LDB(dst, b, h) do { _Pragma("unroll") for (int n = 0; n < 2; ++n) _Pragma("unroll") for (int k = 0; k < 2; ++k) dst[n][k] = *(const LAS bf16x8*)(lds + PG8_SB(b, h) + boff + n * 2048 + k * 1024); } while (0)
#define PG8_MMA(ai, bj, At, Bt) do { __builtin_amdgcn_s_setprio(1); _Pragma("unroll") for (int m = 0; m < 4; ++m) _Pragma("unroll") for (int n = 0; n < 2; ++n) _Pragma("unroll") for (int k = 0; k < 2; ++k) \
        acc[ai][bj][m][n] = __builtin_amdgcn_mfma_f32_16x16x32_bf16(Bt[n][k], At[m][k], acc[ai][bj][m][n], 0, 0, 0); __builtin_amdgcn_s_setprio(0); } while (0)
#define PG8_WAIT_V(n) asm volatile("s_waitcnt vmcnt(" #n ")" ::: "memory")
#define PG8_WAIT_L(n) asm volatile("s_waitcnt lgkmcnt(" #n ")" ::: "memory")
#define PG8_BAR __builtin_amdgcn_s_barrier()
#define PG8_SCHED __builtin_amdgcn_sched_barrier(0)
#define KOF(sg) ((sg) == 0 ? g.k0[0] : ((sg) == 1 ? g.k0[1] : g.k0[2]))
#define NTF(sg) ((sg) == 0 ? g.nt[0] : ((sg) == 1 ? g.nt[1] : g.nt[2]))
    Unit cur, nxt; int ui = 0;
    if (!S.next(0, cur)) return;
    if (S.stagger) {
        const int mine = (S.nwg - S.c + S.G - 1) / S.G, mx = (S.nwg + S.G - 1) / S.G;
        if (mine < mx) { const unsigned long long t0 = __builtin_amdgcn_s_memrealtime(); while (__builtin_amdgcn_s_memrealtime() - t0 < (unsigned long long)S.stagger) __builtin_amdgcn_s_sleep(16); }
    }
    f32x4 acc[2][2][4][2];
#pragma unroll
    for (int a = 0; a < 2; ++a)
#pragma unroll
        for (int b = 0; b < 2; ++b)
#pragma unroll
            for (int m = 0; m < 4; ++m)
#pragma unroll
                for (int n = 0; n < 2; ++n) acc[a][b][m][n] = (f32x4){0.f, 0.f, 0.f, 0.f};
    bf16x8 At[4][2], B0[2][2], B1[2][2];
    const char* cA = (const char*)g.A + (size_t)cur.pm * tstepA + (size_t)KOF(cur.seg) * 2; const char* cB = (const char*)g.Bt + (size_t)cur.pn * tstepB + (size_t)KOF(cur.seg) * 2;
    PG8_STAGE(PG8_SB(0, 0), cB, voffB); PG8_STAGE(PG8_SB(0, 1), cB + hstepB, voffB); PG8_STAGE(PG8_SA(0, 0), cA, voffA); PG8_STAGE(PG8_SA(0, 1), cA + hstepA, voffA);
    if (wr == 1) PG8_BAR;
    PG8_WAIT_V(2); PG8_BAR;
    PG8_STAGE(PG8_SB(1, 0), cB + kstep, voffB); PG8_STAGE(PG8_SA(1, 0), cA + kstep, voffA); PG8_STAGE(PG8_SB(1, 1), cB + hstepB + kstep, voffB);
    PG8_WAIT_V(6); PG8_BAR;
    for (;;) {
        const bool has_next = S.next(ui + 1, nxt);
        const int nt = NTF(cur.seg);
        const char* nA = has_next ? (const char*)g.A + (size_t)nxt.pm * tstepA + (size_t)KOF(nxt.seg) * 2 : cA;
        const char* nB = has_next ? (const char*)g.Bt + (size_t)nxt.pn * tstepB + (size_t)KOF(nxt.seg) * 2 : cB;
        for (int t = 0; t < nt; t += 2) {
            const bool last = (t == nt - 2);
            const char* a1 = cA + (size_t)(t + 1) * kstep;
            const char* a2 = last ? nA : cA + (size_t)(t + 2) * kstep; const char* b2 = last ? nB : cB + (size_t)(t + 2) * kstep;
            const char* a3 = a2 + kstep; const char* b3 = b2 + kstep;
            PG8_LDB(B0, 0, 0); PG8_LDB(B1, 0, 1); PG8_SCHED; PG8_LDA(At, 0, 0); PG8_STAGE(PG8_SA(1, 1), a1 + hstepA, voffA);
            if constexpr (Epi::PREFETCH) E.prefetch(cur, t >> 1, nt >> 1, wid, lane);
            PG8_WAIT_V(8); PG8_WAIT_L(0); PG8_BAR; PG8_MMA(0, 0, At, B0); PG8_MMA(0, 1, At, B1); PG8_BAR; PG8_SCHED;
            PG8_LDA(At, 0, 1); PG8_STAGE(PG8_SB(0, 0), b2, voffB); PG8_STAGE(PG8_SB(0, 1), b2 + hstepB, voffB); PG8_STAGE(PG8_SA(0, 0), a2, voffA);
            PG8_WAIT_V(8); PG8_WAIT_L(0); PG8_BAR; PG8_MMA(1, 0, At, B0); PG8_MMA(1, 1, At, B1); PG8_BAR; PG8_SCHED;
            PG8_LDB(B0, 1, 0); PG8_LDB(B1, 1, 1); PG8_SCHED; PG8_LDA(At, 1, 0); PG8_STAGE(PG8_SA(0, 1), a2 + hstepA, voffA);
            PG8_WAIT_V(8); PG8_WAIT_L(0); PG8_BAR; PG8_MMA(0, 0, At, B0); PG8_MMA(0, 1, At, B1); PG8_BAR; PG8_SCHED;
            PG8_LDA(At, 1, 1); PG8_STAGE(PG8_SB(1, 0), b3, voffB); PG8_STAGE(PG8_SB(1, 1), b3 + hstepB, voffB); PG8_STAGE(PG8_SA(1, 0), a3, voffA);
            PG8_WAIT_V(8); PG8_WAIT_L(0); PG8_BAR; PG8_MMA(1, 0, At, B0); PG8_MMA(1, 1, At, B1); PG8_BAR; PG8_SCHED;
        }
        if (wr == 0) PG8_BAR;
        E.run(acc, cur, wr, wc, fr, fq);
        if (!has_next) break;
        if (cur.seg == g.nseg - 1) {
#pragma unroll
            for (int a = 0; a < 2; ++a)
#pragma unroll
                for (int b = 0; b < 2; ++b)
#pragma unroll
                    for (int m = 0; m < 4; ++m)
#pragma unroll
                        for (int n = 0; n < 2; ++n) acc[a][b][m][n] = (f32x4){0.f, 0.f, 0.f, 0.f};
        }
        cur = nxt; cA = nA; cB = nB; ++ui;
        if (wr == 1) PG8_BAR;
    }
    PG8_WAIT_V(0);
    PG8_BAR;
#undef KOF
#undef NTF
#undef PG8_SA
#undef PG8_SB
#undef PG8_STAGE
#undef PG8_LDA
#undef PG8_LDB
#undef PG8_MMA
#undef PG8_WAIT_V
#undef PG8_WAIT_L
#undef PG8_BAR
#undef PG8_SCHED
}
}

namespace att {
constexpr int D = 128, QBLK = 32, KVBLK = 64;
constexpr float SCALE = 0.088388347648318440f;
constexpr float THR = 8.f;
constexpr size_t SHM_V = KVBLK * D * 2, SHM_K = KVBLK * D * 2, SHM_ATTN = 2 * SHM_V + 2 * SHM_K + NW * 64 * 4;
#define KSWZ(row, colB) ((row) * 256 + ((colB) ^ (((row) & 7) << 4)))
#define SBAR() __builtin_amdgcn_sched_barrier(0)
__device__ __forceinline__ int crow(int r, int hi) { return (r & 3) + 8 * (r >> 2) + 4 * hi; }
__device__ __forceinline__ unsigned cvtpk(float lo, float hi) { unsigned r; asm volatile("v_cvt_pk_bf16_f32 %0, %1, %2" : "=v"(r) : "v"(lo), "v"(hi)); return r; }
__device__ __forceinline__ void partialSM(f32x16& p0, f32x16& p1, float& m_reg, float& mn, float& alpha) {
  constexpr float C = SCALE * 1.4426950408889634f;
  float pmax = p0[0];
#pragma unroll
  for (int r = 1; r < 16; ++r) pmax = fmaxf(pmax, p0[r]);
#pragma unroll
  for (int r = 0; r < 16; ++r) pmax = fmaxf(pmax, p1[r]);
  { auto rr = __builtin_amdgcn_permlane32_swap(__float_as_uint(pmax), __float_as_uint(pmax), false, false);
    pmax = fmaxf(__uint_as_float(rr[0]), __uint_as_float(rr[1])); }
  if (__builtin_expect(__all(pmax - m_reg <= THR / SCALE), 1)) { mn = m_reg; alpha = 1.f; }
  else { mn = fmaxf(m_reg, pmax); alpha = __builtin_amdgcn_exp2f((m_reg - mn) * C); m_reg = mn; }
  float mnC = -mn * C;
#pragma unroll
  for (int r = 0; r < 16; ++r) p0[r] = fmaf(p0[r], C, mnC);
#pragma unroll
  for (int r = 0; r < 16; ++r) p1[r] = fmaf(p1[r], C, mnC);
#pragma unroll
  for (int r = 0; r < 16; ++r) p0[r] = __builtin_amdgcn_exp2f(p0[r]);
}
__device__ __forceinline__ void finishSM(f32x16& p0, f32x16& p1, float alpha, float& l_reg, bf16x8& pa0, bf16x8& pa1, bf16x8& pa2, bf16x8& pa3) {
#pragma unroll
  for (int r = 0; r < 16; ++r) p1[r] = __builtin_amdgcn_exp2f(p1[r]);
  float ps = 0;
#pragma unroll
  for (int r = 0; r < 16; ++r) ps += p0[r];
#pragma unroll
  for (int r = 0; r < 16; ++r) ps += p1[r];
  { auto rr = __builtin_amdgcn_permlane32_swap(__float_as_uint(ps), __float_as_uint(ps), false, false);
    ps = __uint_as_float(rr[0]) + __uint_as_float(rr[1]); }
  l_reg = l_reg * alpha + ps;
#define PK4(P, BASE, OUT) do { unsigned a0 = cvtpk(P[BASE + 0], P[BASE + 1]), a1 = cvtpk(P[BASE + 2], P[BASE + 3]);   \
    unsigned b0 = cvtpk(P[BASE + 4], P[BASE + 5]), b1 = cvtpk(P[BASE + 6], P[BASE + 7]);                              \
    auto r0 = __builtin_amdgcn_permlane32_swap(a0, b0, false, false); auto r1 = __builtin_amdgcn_permlane32_swap(a1, b1, false, false); \
    u32x4 w = {r0[0], r1[0], r0[1], r1[1]}; OUT = *reinterpret_cast<bf16x8*>(&w); } while (0)
  PK4(p0, 0, pa0); PK4(p0, 8, pa1); PK4(p1, 0, pa2); PK4(p1, 8, pa3);
#undef PK4
}
__device__ __forceinline__ void qkt(f32x16& p0, f32x16& p1, const bf16_t* Ks, const bf16x8* qr, int r32, int hi) {
  p0 = f32x16{}; p1 = f32x16{};
#pragma unroll
  for (int d0 = 0; d0 < 8; ++d0) { int cb = (d0 * 16 + hi * 8) * 2;
    bf16x8 b0 = *reinterpret_cast<const bf16x8*>((const char*)Ks + KSWZ(r32, cb));
    bf16x8 b1 = *reinterpret_cast<const bf16x8*>((const char*)Ks + KSWZ(32 + r32, cb));
    p0 = __builtin_amdgcn_mfma_f32_32x32x16_bf16(b0, qr[d0], p0, 0, 0, 0);
    p1 = __builtin_amdgcn_mfma_f32_32x32x16_bf16(b1, qr[d0], p1, 0, 0, 0); }
}
__device__ __forceinline__ int v_st(int k, int c) { const int kk = (k & ~0xC) | ((k & 4) << 1) | ((k & 8) >> 1); return ((kk >> 3) * 4 + (c >> 5)) * 512 + ((kk & 7) * 32 + (c & 31)) * 2; }
__device__ __forceinline__ int v_rd_base(int lane) { return ((lane & 3) << 3) | (((lane >> 2) & 3) << 6) | (((lane >> 4) & 1) << 5) | (((lane >> 5) & 1) << 8); }
constexpr int v_rd_off(int d0, int ks, int half) { return d0 * 512 + ks * 4096 + half * 2048; }
template <int OFF> __device__ __forceinline__ s16x4 tr_read(int vb) {
  s16x4 r; asm volatile("ds_read_b64_tr_b16 %0, %1 offset:%2" : "=&v"(r) : "v"(vb), "i"(OFF) : "memory"); return r;
}
template <int D0> __device__ __forceinline__ void pv_one(f32x16& od, int vb, bf16x8 pa0, bf16x8 pa1, bf16x8 pa2, bf16x8 pa3) {
  const s16x4 l0 = tr_read<v_rd_off(D0, 0, 0)>(vb), h0 = tr_read<v_rd_off(D0, 0, 1)>(vb), l1 = tr_read<v_rd_off(D0, 1, 0)>(vb), h1 = tr_read<v_rd_off(D0, 1, 1)>(vb);
  const s16x4 l2 = tr_read<v_rd_off(D0, 2, 0)>(vb), h2 = tr_read<v_rd_off(D0, 2, 1)>(vb), l3 = tr_read<v_rd_off(D0, 3, 0)>(vb), h3 = tr_read<v_rd_off(D0, 3, 1)>(vb);
  asm volatile("s_waitcnt lgkmcnt(0)" ::: "memory"); SBAR();
#define PK(L, H) (bf16x8){L[0], L[1], L[2], L[3], H[0], H[1], H[2], H[3]}
  od = __builtin_amdgcn_mfma_f32_32x32x16_bf16(pa0, PK(l0, h0), od, 0, 0, 0);
  od = __builtin_amdgcn_mfma_f32_32x32x16_bf16(pa1, PK(l1, h1), od, 0, 0, 0);
  od = __builtin_amdgcn_mfma_f32_32x32x16_bf16(pa2, PK(l2, h2), od, 0, 0, 0);
  od = __builtin_amdgcn_mfma_f32_32x32x16_bf16(pa3, PK(l3, h3), od, 0, 0, 0);
#undef PK
}
__device__ __forceinline__ void pv_d0(f32x16* o, int vb, bf16x8 pa0, bf16x8 pa1, bf16x8 pa2, bf16x8 pa3) {
  pv_one<0>(o[0], vb, pa0, pa1, pa2, pa3); pv_one<1>(o[1], vb, pa0, pa1, pa2, pa3); pv_one<2>(o[2], vb, pa0, pa1, pa2, pa3); pv_one<3>(o[3], vb, pa0, pa1, pa2, pa3);
}
constexpr int LDQ = NPROJ, LDK = 256;
__device__ __forceinline__ void attn_dense_body(bf16_t* Qb, const bf16_t* __restrict__ Kh, const bf16_t* __restrict__ Vh, int seq, char* lds, const int tid, const float* __restrict__ qg, const float* __restrict__ rope, int s0, const bool STORE = true) {
  const int wid = tid >> 6, lane = tid & 63, r32 = lane & 31, hi = lane >> 5;
  bf16_t* V_lds = (bf16_t*)lds; bf16_t* K_lds = (bf16_t*)(lds + 2 * SHM_V);
  float* ws = (float*)(lds + 2 * SHM_V + 2 * SHM_K) + wid * 64; float* li_l = ws; float* al_l = ws + 32;
  float m_reg = -1e30f, l_reg = 0; f32x16 o[4] = {}; bf16x8 qr[8];
  const bf16_t* Qw = Qb + (long)(wid * QBLK + r32) * LDQ + hi * 8;
#pragma unroll
  for (int d0 = 0; d0 < 8; ++d0) qr[d0] = *reinterpret_cast<const bf16x8*>(Qw + d0 * 16);
  {
    float ss = 0.f;
#pragma unroll
    for (int d0 = 0; d0 < 8; ++d0) { const u32x4 w = __builtin_bit_cast(u32x4, qr[d0]);
#pragma unroll
      for (int e = 0; e < 4; ++e) { const float lo = __uint_as_float(w[e] << 16), hi_ = __uint_as_float(w[e] & 0xffff0000u); ss += lo * lo + hi_ * hi_; } }
    { auto rr = __builtin_amdgcn_permlane32_swap(__float_as_uint(ss), __float_as_uint(ss), false, false); ss = __uint_as_float(rr[0]) + __uint_as_float(rr[1]); }
    const float rinv = rsqrtf(ss * (1.0f / 128.0f) + LN_EPS);
    const int sp = s0 + wid * QBLK + r32;
#pragma unroll
    for (int a = 0; a < 2; ++a) {
      float qf[4][8];
#pragma unroll
      for (int dd = 0; dd < 4; ++dd) { const int d0 = a * 4 + dd; const u32x4 w = __builtin_bit_cast(u32x4, qr[d0]);
        const f32x4 g0 = *(const f32x4*)(qg + d0 * 16 + hi * 8), g1 = *(const f32x4*)(qg + d0 * 16 + hi * 8 + 4);
        qf[dd][0] = __uint_as_float(w[0] << 16) * (rinv * g0[0]); qf[dd][1] = __uint_as_float(w[0] & 0xffff0000u) * (rinv * g0[1]);
        qf[dd][2] = __uint_as_float(w[1] << 16) * (rinv * g0[2]); qf[dd][3] = __uint_as_float(w[1] & 0xffff0000u) * (rinv * g0[3]);
        qf[dd][4] = __uint_as_float(w[2] << 16) * (rinv * g1[0]); qf[dd][5] = __uint_as_float(w[2] & 0xffff0000u) * (rinv * g1[1]);
        qf[dd][6] = __uint_as_float(w[3] << 16) * (rinv * g1[2]); qf[dd][7] = __uint_as_float(w[3] & 0xffff0000u) * (rinv * g1[3]); }
      if (rope) { const int pos = a == 0 ? (sp >> 6) : (sp & 63);
#pragma unroll
        for (int dd = 0; dd < 2; ++dd) { const float* cp = rope + pos * 32 + dd * 16 + hi * 8;
          const f32x4 c0 = *(const f32x4*)cp, c1 = *(const f32x4*)(cp + 4), s0v = *(const f32x4*)(cp + 2048), s1v = *(const f32x4*)(cp + 2048 + 4);
#pragma unroll
          for (int e = 0; e < 4; ++e) { float x1 = qf[dd][e], x2 = qf[dd + 2][e]; qf[dd][e] = x1 * c0[e] - x2 * s0v[e]; qf[dd + 2][e] = x2 * c0[e] + x1 * s0v[e];
            x1 = qf[dd][4 + e]; x2 = qf[dd + 2][4 + e]; qf[dd][4 + e] = x1 * c1[e] - x2 * s1v[e]; qf[dd + 2][4 + e] = x2 * c1[e] + x1 * s1v[e]; } } }
#pragma unroll
      for (int dd = 0; dd < 4; ++dd) { u32x4 w; w.x = cvtpk(qf[dd][0], qf[dd][1]); w.y = cvtpk(qf[dd][2], qf[dd][3]); w.z = cvtpk(qf[dd][4], qf[dd][5]); w.w = cvtpk(qf[dd][6], qf[dd][7]); qr[a * 4 + dd] = __builtin_bit_cast(bf16x8, w); }
      asm volatile("" ::: "memory");
    }
  }
  int tid2 = tid; asm volatile("" : "+v"(tid2));
  const int sr = tid2 >> 4, sc = (tid2 & 15) * 8, vst0 = v_st(sr, sc), vst1 = v_st(32 + sr, sc);
  const int vb0 = (int)(uintptr_t)V_lds + v_rd_base(tid2 & 63);
  struct { bf16x8 vs0, vs1, ks0, ks1; } sr_[1];
#define LD8(p) (*reinterpret_cast<const bf16x8*>(p))
#define SLOAD(i, k0) do { sr_[i].vs0 = LD8(&Vh[(long)((k0) + sr) * LDK + sc]); sr_[i].vs1 = LD8(&Vh[(long)((k0) + 32 + sr) * LDK + sc]); \
    sr_[i].ks0 = LD8(&Kh[(long)((k0) + sr) * LDK + sc]); sr_[i].ks1 = LD8(&Kh[(long)((k0) + 32 + sr) * LDK + sc]); } while (0)
#define SWRITE(b, i) do { *(bf16x8*)((char*)V_lds + (b) * SHM_V + vst0) = sr_[i].vs0;          \
    *(bf16x8*)((char*)V_lds + (b) * SHM_V + vst1) = sr_[i].vs1; int kc = sc * 2;               \
    *(bf16x8*)((char*)K_lds + (b) * SHM_K + KSWZ(sr, kc)) = sr_[i].ks0;                       \
    *(bf16x8*)((char*)K_lds + (b) * SHM_K + KSWZ(32 + sr, kc)) = sr_[i].ks1; } while (0)
#define SWAIT() asm volatile("s_waitcnt vmcnt(0)" ::: "memory")
#define RESC(a) do { if (__any((a) < 1.f)) { if (hi == 0) al_l[r32] = (a); asm volatile("s_waitcnt lgkmcnt(0)" ::: "memory"); \
    _Pragma("unroll") for (int d = 0; d < 4; ++d) _Pragma("unroll") for (int r = 0; r < 16; ++r) o[d][r] *= al_l[crow(r, hi)]; } } while (0)
  f32x16 pA0, pA1, pB0, pB1; float mnA, mnB, alA, alB; bf16x8 pa0, pa1, pa2, pa3; const int NT = seq / KVBLK;
  constexpr int SE = 0, SO = 0;
  SLOAD(SE, 0); asm volatile("s_waitcnt vmcnt(0)" ::: "memory"); SWRITE(0, SE); __syncthreads();
  qkt(pA0, pA1, K_lds, qr, r32, hi); partialSM(pA0, pA1, m_reg, mnA, alA);
  SLOAD(SO, KVBLK);
  SWAIT(); SWRITE(1, SO); __syncthreads();
  for (int j = 1; j + 1 < NT; j += 2) {
    SBAR(); qkt(pB0, pB1, (bf16_t*)((char*)K_lds + SHM_K), qr, r32, hi);
    finishSM(pA0, pA1, alA, l_reg, pa0, pa1, pa2, pa3); SBAR();
    SLOAD(SO, (j + 1) * KVBLK); SBAR();
    pv_d0(o, vb0, pa0, pa1, pa2, pa3); partialSM(pB0, pB1, m_reg, mnB, alB);
    __syncthreads(); SWAIT(); SWRITE(0, SE);
    RESC(alB); __syncthreads();
    SBAR(); qkt(pA0, pA1, K_lds, qr, r32, hi);
    finishSM(pB0, pB1, alB, l_reg, pa0, pa1, pa2, pa3); SBAR();
    SLOAD(SE, (j + 2) * KVBLK); SBAR();
    pv_d0(o, vb0 + (int)SHM_V, pa0, pa1, pa2, pa3); partialSM(pA0, pA1, m_reg, mnA, alA);
    __syncthreads(); SWAIT(); SWRITE(1, SO);
    RESC(alA); __syncthreads();
  }
  SBAR(); qkt(pB0, pB1, (bf16_t*)((char*)K_lds + SHM_K), qr, r32, hi);
  finishSM(pA0, pA1, alA, l_reg, pa0, pa1, pa2, pa3); SBAR();
  pv_d0(o, vb0, pa0, pa1, pa2, pa3); partialSM(pB0, pB1, m_reg, mnB, alB);
  __syncthreads(); RESC(alB);
  finishSM(pB0, pB1, alB, l_reg, pa0, pa1, pa2, pa3); SBAR();
  pv_d0(o, vb0 + (int)SHM_V, pa0, pa1, pa2, pa3);
  if (hi == 0) li_l[r32] = l_reg; asm volatile("s_waitcnt lgkmcnt(0)" ::: "memory");
  float rli[16];
#pragma unroll
  for (int r = 0; r < 16; ++r) rli[r] = __builtin_amdgcn_rcpf(li_l[crow(r, hi)]);
  __syncthreads();
  { bf16_t* stg = (bf16_t*)lds + wid * 4096;
#pragma unroll
    for (int r = 0; r < 16; ++r) { const int orow = crow(r, hi);
#pragma unroll
      for (int d0 = 0; d0 < 4; ++d0) stg[orow * 128 + d0 * 32 + r32] = (bf16_t)(cvtpk(o[d0][r] * rli[r], 0.f) & 0xffffu); }
    asm volatile("s_waitcnt lgkmcnt(0)" ::: "memory");
    int le = lane; asm volatile("" : "+v"(le));
    bf16_t* Ow = Qb + (long)(wid * QBLK + (le >> 4)) * LDQ + (le & 15) * 8;
#pragma unroll
    for (int i = 0; i < 8; ++i) { const u32x4 v = *(const u32x4*)(stg + (i * 4 + (le >> 4)) * 128 + (le & 15) * 8); if (STORE) *(u32x4*)(Ow + (long)i * 4 * LDQ) = v; else asm volatile("" :: "v"(v)); }
  }
  __syncthreads();
#undef LD8
#undef SLOAD
#undef SWRITE
#undef SWAIT
#undef RESC
}
#undef KSWZ
#undef SBAR
}


#define XB_TMO      128
#define XB_XCNT(j)  (256  + 64 * (j))
#define XB_XSUB(j)  (1280 + 64 * (j))
#define XB_XGEN(j)  (2304 + 64 * (j))
#define XB_TOP      3328
#define XB_TOPGEN   3392
#define XCD_BAR_WORDS 3456
#define XB_SPIN_CAP (1u << 18)
__device__ __forceinline__ unsigned xb_ld(unsigned* p)              { return __hip_atomic_load(p, __ATOMIC_RELAXED, __HIP_MEMORY_SCOPE_AGENT); }
__device__ __forceinline__ unsigned xb_add(unsigned* p, unsigned v) { return __hip_atomic_fetch_add(p, v, __ATOMIC_RELAXED, __HIP_MEMORY_SCOPE_AGENT); }
__device__ __forceinline__ unsigned xb_xcc_id() { return (unsigned)__builtin_amdgcn_s_getreg((3 << 11) | 20) & 0xFu; }
#define XB_SPIN(cond, bar) do { unsigned _sp = 0; while (cond) { __builtin_amdgcn_s_sleep(1); \
    if ((++_sp & 255u) == 0u) { if (xb_ld(&(bar)[XB_TMO])) break; if (_sp > XB_SPIN_CAP) { atomicAdd(&(bar)[XB_TMO], 1u); break; } } } } while (0)
struct XcdBarrier { unsigned* bar; unsigned x; volatile LAS unsigned* st; };
__device__ __forceinline__ XcdBarrier xcd_barrier_post(unsigned* bar, volatile LAS unsigned* st) {
    XcdBarrier b; b.bar = bar; b.x = xb_xcc_id(); b.st = st;
    if (threadIdx.x == 0) (void)xb_add(&bar[XB_XCNT(b.x)], 1u);
    return b;
}
__device__ __forceinline__ void xcd_barrier_complete(unsigned* bar, unsigned x, unsigned& nloc, unsigned& nx) {
    const unsigned G = gridDim.x * gridDim.y * gridDim.z;
    unsigned sum, cnt, mine, sp = 0u;
    for (;;) {
        sum = 0u; cnt = 0u; mine = 0u;
#pragma unroll
        for (unsigned j = 0; j < 16; ++j) { const unsigned c = xb_ld(&bar[XB_XCNT(j)]); sum += c; cnt += (c > 0u) ? 1u : 0u; mine = (j == x) ? c : mine; }
        if (sum == G) break;
        __builtin_amdgcn_s_sleep(1);
        if ((++sp & 255u) == 0u) { if (xb_ld(&bar[XB_TMO])) break; if (sp > XB_SPIN_CAP) { atomicAdd(&bar[XB_TMO], 1u); break; } }
    }
    nloc = mine > 0u ? mine : 1u; nx = cnt > 0u ? cnt : 1u;
}
__device__ __forceinline__ void xcd_barrier(const XcdBarrier& b) {
    asm volatile("s_waitcnt vmcnt(0)" ::: "memory");
    __syncthreads();
    if (threadIdx.x == 0) {
        unsigned* bar = b.bar;
        __builtin_amdgcn_s_waitcnt(0);
        unsigned nloc = b.st[0], nx = b.st[1];
        if (nloc == 0u) { xcd_barrier_complete(bar, b.x, nloc, nx); b.st[0] = nloc; b.st[1] = nx; }
        const unsigned old = xb_add(&bar[XB_XSUB(b.x)], 1u);
        const unsigned gen = old / nloc;
        if (old + 1u == (gen + 1u) * nloc) {
            __builtin_amdgcn_fence(__ATOMIC_RELEASE, "agent");
            asm volatile("s_waitcnt vmcnt(0)" ::: "memory");
            const unsigned og = xb_add(&bar[XB_TOP], 1u);
            const unsigned tg = og / nx;
            if (og + 1u == (tg + 1u) * nx) xb_add(&bar[XB_TOPGEN], 1u);
            else XB_SPIN(xb_ld(&bar[XB_TOPGEN]) == tg, bar);
            __builtin_amdgcn_fence(__ATOMIC_ACQUIRE, "agent");
            xb_add(&bar[XB_XGEN(b.x)], 1u);
            asm volatile("s_waitcnt vmcnt(0)" ::: "memory");
        } else {
            XB_SPIN(xb_ld(&bar[XB_XGEN(b.x)]) == gen, bar);
            __builtin_amdgcn_fence(__ATOMIC_ACQUIRE, "agent");
            asm volatile("s_waitcnt vmcnt(0)" ::: "memory");
        }
    }
    __syncthreads();
}

struct Args { const float* in[25]; float* out; unsigned char* ws; int ph_lo, ph_hi; };

typedef const float* fptr_t;
typedef __attribute__((address_space(4))) const fptr_t* in_as4_t;
struct Frame {
    LAS unsigned char* lds; char* ldsg;
    int tid, lane, wave, G, bx, gw, NGW;
    const float* const* in;
    unsigned char* ws; float* out;
};
enum { I_XP = 0, I_XS, I_CK, I_CV, I_C, I_CCTX, I_WADA, I_BADA, I_WIN, I_QG, I_KG, I_WPG, I_PSC, I_WSGU, I_BSGU, I_WAO, I_WPO, I_WSO, I_WOUT, I_LN1G, I_LN1B, I_WF1, I_WF2, I_LN2G, I_LN2B };

__device__ __forceinline__ void tr_item(const float* W, int ldw, int src_col, int kb, bf16_t* WT, int ldt, int dst_row, int dst_k, LAS float* scr, int lane) {
    const int k0 = 64 * kb;
#pragma unroll 8
    for (int i = 0; i < 32; ++i) { const int kk = 2 * i + (lane >> 5); scr[kk * 33 + (lane & 31)] = W[(size_t)(k0 + kk) * ldw + src_col + (lane & 31)]; }
    asm volatile("s_waitcnt lgkmcnt(0)" ::: "memory");
    const int c = lane & 7;
#pragma unroll
    for (int j = 0; j < 4; ++j) { const int n = (lane >> 3) + 8 * j; const LAS float* s = scr + (8 * c) * 33 + n;
        u32x4 o; o.x = cvt_pk_bf16(s[0 * 33], s[1 * 33]); o.y = cvt_pk_bf16(s[2 * 33], s[3 * 33]); o.z = cvt_pk_bf16(s[4 * 33], s[5 * 33]); o.w = cvt_pk_bf16(s[6 * 33], s[7 * 33]);
        *(u32x4*)(WT + (size_t)(dst_row + n) * ldt + dst_k + k0 + 8 * c) = o; }
    asm volatile("s_waitcnt lgkmcnt(0)" ::: "memory");
}

__device__ __forceinline__ int win_src_col(int d) {
    if (d < 1024) return d;
    if (d < 1536) return 2048 + (d - 1024);
    if (d < 2048) return 1024 + (d - 1536);
    if (d < 2560) return 2560 + (d - 2048);
    if (d < 3072) return 1536 + (d - 2560);
    return d;
}

__device__ __forceinline__ void phase_prologue(Frame& F) {
    if (F.bx < 192) {
        const int l = F.bx / 96, nb = F.bx % 96;
        LAS float* sc = (LAS float*)F.lds;
        LAS float* red = (LAS float*)(F.lds + 9 * 1024 * 4);
        for (int idx = F.tid; idx < 9 * 1024; idx += 512) { const int v = idx >> 10, k = idx & 1023;
            const float x = v == 0 ? F.in[I_CCTX][k] : F.in[I_C][(v - 1) * 1024 + k]; sc[idx] = x / (1.0f + __expf(-x)); }
        __syncthreads();
        float acc[9];
#pragma unroll
        for (int v = 0; v < 9; ++v) acc[v] = 0.f;
        const float* wp = F.in[I_WADA] + ((size_t)l * 1024 + F.wave * 128) * 6144 + nb * 64 + F.lane;
#pragma unroll 8
        for (int k = 0; k < 128; ++k) { const float w = wp[(size_t)k * 6144];
#pragma unroll
            for (int v = 0; v < 9; ++v) acc[v] += sc[v * 1024 + F.wave * 128 + k] * w; }
#pragma unroll
        for (int v = 0; v < 9; ++v) red[(F.wave * 9 + v) * 64 + F.lane] = acc[v];
        __syncthreads();
        float* mod = (float*)(F.ws + WS_MOD);
        for (int idx = F.tid; idx < 576; idx += 512) { const int v = idx >> 6, ln = idx & 63; float s = 0.f;
#pragma unroll
            for (int w = 0; w < 8; ++w) s += red[(w * 9 + v) * 64 + ln];
            mod[(l * 9 + v) * 6144 + nb * 64 + ln] = s + F.in[I_BADA][l * 6144 + nb * 64 + ln]; }
        __syncthreads();
    }
    LAS float* scr = (LAS float*)(F.lds + F.wave * 8448);
    constexpr int N_WIN = 16 * 192, N_AO = 16 * 32, N_SO = 8 * 32, N_WO = 16 * 32, N_F1 = 16 * 176, N_F2 = 44 * 32, N_PE = 1024, N_WS = 128;
    constexpr int N_L = N_WIN + N_AO + N_SO + N_WO + N_F1 + N_F2 + N_PE + N_WS;
    constexpr int N_ALL = 2 * N_L + 32;
    for (int it = F.gw; it < N_ALL; it += F.NGW) {
        if (it >= 2 * N_L) {
            const int idx = (it - 2 * N_L) * 64 + F.lane; const int pos = idx >> 5, p = idx & 31;
            const float inv = powf(10000.0f, -(float)p / 32.0f); const float ang = (float)pos * inv;
            float* rope = (float*)(F.ws + WS_ROPE); rope[idx] = cosf(ang); rope[2048 + idx] = sinf(ang);
            continue;
        }
        const int l = it / N_L; int r = it % N_L;
        if (r < N_WIN) { const int kb = r / 192, nb = r % 192;
            tr_item(F.in[I_WIN] + (size_t)l * 1024 * 6144, 6144, win_src_col(nb * 32), kb, (bf16_t*)(F.ws + WS_WIN) + (size_t)l * 6144 * 1024, 1024, nb * 32, 0, scr, F.lane); continue; } r -= N_WIN;
        if (r < N_AO) { const int kb = r / 32, nb = r % 32;
            tr_item(F.in[I_WAO] + (size_t)l * 1024 * 1024, 1024, nb * 32, kb, (bf16_t*)(F.ws + WS_WM) + (size_t)l * 1024 * 2048, 2048, nb * 32, 0, scr, F.lane); continue; } r -= N_AO;
        if (r < N_SO) { const int kb = r / 32, nb = r % 32;
            tr_item(F.in[I_WSO] + (size_t)l * 512 * 1024, 1024, nb * 32, kb, (bf16_t*)(F.ws + WS_WM) + (size_t)l * 1024 * 2048, 2048, nb * 32, 1024, scr, F.lane); continue; } r -= N_SO;
        if (r < N_WO) { const int kb = r / 32, nb = r % 32;
            tr_item(F.in[I_WOUT] + (size_t)l * 1024 * 1024, 1024, nb * 32, kb, (bf16_t*)(F.ws + WS_WOUT) + (size_t)l * 1024 * 1024, 1024, nb * 32, 0, scr, F.lane); continue; } r -= N_WO;
        if (r < N_F1) { const int kb = r / 176, nb = r % 176; const int drow = nb * 32; const int pn = drow >> 8, j = drow & 255;
            const int src = j < 128 ? pn * 128 + j : DFF + pn * 128 + (j - 128);
            tr_item(F.in[I_WF1] + (size_t)l * 1024 * 5632, 5632, src, kb, (bf16_t*)(F.ws + WS_WF1) + (size_t)l * 5632 * 1024, 1024, drow, 0, scr, F.lane); continue; } r -= N_F1;
        if (r < N_F2) { const int kb = r / 32, nb = r % 32;
            tr_item(F.in[I_WF2] + (size_t)l * DFF * 1024, 1024, nb * 32, kb, (bf16_t*)(F.ws + WS_WF2) + (size_t)l * 1024 * DFF, DFF, nb * 32, 0, scr, F.lane); continue; } r -= N_F2;
        if (r < N_PE) {
            const int kg = r >> 4, nb = r & 15; const int k0 = kg * 8, g = k0 >> 7; const int n = nb * 64 + F.lane;
            const float* wpg = F.in[I_WPG] + ((size_t)(l * 4 + g) * 128 + (k0 & 127)) * 128;
            const float* psc = F.in[I_PSC] + l * 512 + g * 128;
            const float* wpo = F.in[I_WPO] + ((size_t)l * 512 + g * 128) * 1024 + n;
            float a[8];
#pragma unroll
            for (int i = 0; i < 8; ++i) a[i] = 0.f;
#pragma unroll 4
            for (int j = 0; j < 128; ++j) { const float w = wpo[(size_t)j * 1024] * psc[j];
#pragma unroll
                for (int i = 0; i < 8; ++i) a[i] += wpg[i * 128 + j] * w; }
            u32x4 o; o.x = cvt_pk_bf16(a[0], a[1]); o.y = cvt_pk_bf16(a[2], a[3]); o.z = cvt_pk_bf16(a[4], a[5]); o.w = cvt_pk_bf16(a[6], a[7]);
            *(u32x4*)((bf16_t*)(F.ws + WS_WM) + (size_t)l * 1024 * 2048 + (size_t)n * 2048 + 1536 + k0) = o;
            continue; } r -= N_PE;
        {
            const size_t e0 = (size_t)l * 65536 + (size_t)r * 512 + F.lane * 8;
            const f32x4 a = *(const f32x4*)(F.in[I_WSGU] + e0), b = *(const f32x4*)(F.in[I_WSGU] + e0 + 4);
            u32x4 o; o.x = cvt_pk_bf16(a[0], a[1]); o.y = cvt_pk_bf16(a[2], a[3]); o.z = cvt_pk_bf16(b[0], b[1]); o.w = cvt_pk_bf16(b[2], b[3]);
            *(u32x4*)((bf16_t*)(F.ws + WS_WSGU) + e0) = o;
        }
    }
}

__device__ __forceinline__ const float* x0_row(Frame& F, int t) { return t < T_CTX ? F.in[I_XP] + (size_t)t * DM : F.in[I_XS] + (size_t)(t - T_CTX) * DM; }
__device__ __forceinline__ int vec_of_row(int t) { return t < T_CTX ? 0 : 1 + ((t - T_CTX) >> 12); }

__device__ __forceinline__ void phase_h0(Frame& F) {
    const float* mod = (const float*)(F.ws + WS_MOD);
    bf16_t* act = (bf16_t*)(F.ws + WS_ACT);
    for (int t = F.gw; t < T_ALL; t += F.NGW) {
        const f32x4* xr = (const f32x4*)x0_row(F, t) + F.lane;
        const float* mv = mod + vec_of_row(t) * 6144;
        unsigned long long* o8 = (unsigned long long*)(act + (size_t)t * DM) + F.lane;
#pragma unroll
        for (int j = 0; j < 4; ++j) { const f32x4 x = xr[64 * j]; const int c = 256 * j + 4 * F.lane;
            const f32x4 sh = *(const f32x4*)(mv + c), sc = *(const f32x4*)(mv + 1024 + c);
            const f32x4 h = x * (sc + 1.0f) + sh;
            o8[64 * j] = (unsigned long long)cvt_pk_bf16(h[0], h[1]) | ((unsigned long long)cvt_pk_bf16(h[2], h[3]) << 32); }
    }
}

__device__ __forceinline__ void phase_ln(Frame& F, const float* lg, const float* lb, const float* modl  , int sh_off, int sc_off, const bool dry = false) {
    float* X = F.out; bf16_t* act = (bf16_t*)(F.ws + WS_ACT);
    for (int t = F.gw; t < T_ALL; t += F.NGW) {
        f32x4* xr = (f32x4*)(X + (size_t)t * DM) + F.lane;
        f32x4 v[4]; float s = 0.f;
#pragma unroll
        for (int j = 0; j < 4; ++j) { v[j] = xr[64 * j]; s += (v[j][0] + v[j][1]) + (v[j][2] + v[j][3]); }
        const float mean = wave_sum(s) * (1.f / DM); float s2 = 0.f;
#pragma unroll
        for (int j = 0; j < 4; ++j) { v[j] = v[j] - mean; s2 += (v[j][0] * v[j][0] + v[j][1] * v[j][1]) + (v[j][2] * v[j][2] + v[j][3] * v[j][3]); }
        const float rstd = rsqrtf(wave_sum(s2) * (1.f / DM) + LN_EPS);
        const float* mv = modl ? modl + vec_of_row(t) * 6144 : nullptr;
        unsigned long long* o8 = (unsigned long long*)(act + (size_t)t * DM) + F.lane;
#pragma unroll
        for (int j = 0; j < 4; ++j) { const int c = 256 * j + 4 * F.lane;
            const f32x4 g = *(const f32x4*)(lg + c), b = *(const f32x4*)(lb + c);
            const f32x4 y = v[j] * rstd * g + b; if (!dry) xr[64 * j] = y; else { asm volatile("" :: "v"(y)); continue; }
            if (mv) { const f32x4 sh = *(const f32x4*)(mv + sh_off + c), sc = *(const f32x4*)(mv + sc_off + c);
                const f32x4 h = y * (sc + 1.0f) + sh;
                o8[64 * j] = (unsigned long long)cvt_pk_bf16(h[0], h[1]) | ((unsigned long long)cvt_pk_bf16(h[2], h[3]) << 32); } }
    }
}

__device__ __forceinline__ void load16h(const bf16_t* p, int j, float (&x)[16]) {
#pragma unroll
    for (int a = 0; a < 2; ++a)
#pragma unroll
        for (int hf = 0; hf < 2; ++hf) { const u32x2 w = *(const u32x2*)(p + a * 64 + hf * 32 + 4 * j);
            x[(a * 2 + hf) * 4 + 0] = bf_lo(w.x); x[(a * 2 + hf) * 4 + 1] = bf_hi(w.x); x[(a * 2 + hf) * 4 + 2] = bf_lo(w.y); x[(a * 2 + hf) * 4 + 3] = bf_hi(w.y); }
}
__device__ __forceinline__ void rmsn(float (&x)[16], const float (&g)[16]) {
    float ss = 0.f;
#pragma unroll
    for (int i = 0; i < 16; ++i) ss += x[i] * x[i];
    ss += __shfl_xor(ss, 1); ss += __shfl_xor(ss, 2); ss += __shfl_xor(ss, 4);
    const float rinv = rsqrtf(ss * (1.0f / 128.0f) + LN_EPS);
#pragma unroll
    for (int i = 0; i < 16; ++i) x[i] = x[i] * rinv * g[i];
}
__device__ __forceinline__ void rope16(float (&x)[16], const float* rope, int rowpos, int colpos, int j) {
#pragma unroll
    for (int a = 0; a < 2; ++a) { const int pos = a == 0 ? rowpos : colpos;
        const f32x4 c = *(const f32x4*)(rope + pos * 32 + 4 * j), s = *(const f32x4*)(rope + 2048 + pos * 32 + 4 * j);
#pragma unroll
        for (int e = 0; e < 4; ++e) { const float x1 = x[(a * 2) * 4 + e], x2 = x[(a * 2 + 1) * 4 + e];
            x[(a * 2) * 4 + e] = x1 * c[e] - x2 * s[e]; x[(a * 2 + 1) * 4 + e] = x2 * c[e] + x1 * s[e]; } }
}
__device__ __forceinline__ void store16h(bf16_t* p, int j, const float (&x)[16]) {
#pragma unroll
    for (int a = 0; a < 2; ++a)
#pragma unroll
        for (int hf = 0; hf < 2; ++hf) { u32x2 w; w.x = cvt_pk_bf16(x[(a * 2 + hf) * 4 + 0], x[(a * 2 + hf) * 4 + 1]); w.y = cvt_pk_bf16(x[(a * 2 + hf) * 4 + 2], x[(a * 2 + hf) * 4 + 3]);
            *(u32x2*)(p + a * 64 + hf * 32 + 4 * j) = w; }
}

__device__ __forceinline__ void phase_mid(Frame& F, int l, int part, const bool dry = false) {
    bf16_t* proj = (bf16_t*)(F.ws + WS_PROJ);
    const float* rope = (const float*)(F.ws + WS_ROPE);
    bf16_t* vrt = (bf16_t*)(F.ws + WS_VRT);
    bf16_t* KL = (bf16_t*)(F.ws + WS_KL); bf16_t* VL = (bf16_t*)(F.ws + WS_VL); bf16_t* KC = (bf16_t*)(F.ws + WS_KC); bf16_t* VC = (bf16_t*)(F.ws + WS_VC);
    float* outk = F.out + (size_t)T_ALL * DM; float* outv = outk + (size_t)16 * 2 * 256 * 256;
    const int lane = F.lane, hj = lane & 7;
    const int n8 = part_rows(part) / 4, ncache = 4 * PAST;
    float qg[16], kg[16];
#pragma unroll
    for (int a = 0; a < 2; ++a)
#pragma unroll
        for (int hf = 0; hf < 2; ++hf)
#pragma unroll
            for (int e = 0; e < 4; ++e) { const int d = a * 64 + hf * 32 + 4 * hj + e; qg[(a * 2 + hf) * 4 + e] = F.in[I_QG][l * 128 + d]; kg[(a * 2 + hf) * 4 + e] = F.in[I_KG][l * 128 + d]; }
    for (int it = F.gw; it < n8 + ncache; it += F.NGW) {
        if (it >= n8) {
            const int cr = it - n8; const int bl = cr >> 9, s = cr & 511; const int b = part * 4 + bl;
            const size_t src = (((size_t)b * 2 + l) * PAST + s) * 256 + lane * 4;
            const f32x4 kx = *(const f32x4*)(F.in[I_CK] + src), vx = *(const f32x4*)(F.in[I_CV] + src);
            const size_t dst = ((size_t)bl * SKV_LAT + s) * 256 + lane * 4;
            u32x2 kw, vw; kw.x = cvt_pk_bf16(kx[0], kx[1]); kw.y = cvt_pk_bf16(kx[2], kx[3]); vw.x = cvt_pk_bf16(vx[0], vx[1]); vw.y = cvt_pk_bf16(vx[2], vx[3]);
            if (!dry) { *(u32x2*)(KL + dst) = kw; *(u32x2*)(VL + dst) = vw; } else asm volatile("" :: "v"(kw), "v"(vw));
            continue;
        }
        const int lr0 = it * 4, t0 = part_row0(part) + lr0;
        const bool is_ctx = t0 < T_CTX;
        bf16_t* P0 = proj + (size_t)lr0 * NPROJ;
        {
            float val[4][8];
#pragma unroll
            for (int i = 0; i < 4; ++i) { const u32x4 w = *(const u32x4*)(P0 + (size_t)i * NPROJ + PC_XV + lane * 8);
#pragma unroll
                for (int e = 0; e < 4; ++e) { val[i][2 * e] = gelu1(bf_lo(w[e])); val[i][2 * e + 1] = gelu1(bf_hi(w[e])); } }
#pragma unroll
            for (int i = 0; i < 4; ++i) { float s = 0.f;
#pragma unroll
                for (int e = 0; e < 8; ++e) s += val[i][e];
                const float mean = wave_sum(s) * (1.0f / 512.0f); float s2 = 0.f;
#pragma unroll
                for (int e = 0; e < 8; ++e) { val[i][e] -= mean; s2 += val[i][e] * val[i][e]; }
                const float rstd = rsqrtf(wave_sum(s2) * (1.0f / 512.0f) + LN_EPS);
#pragma unroll
                for (int e = 0; e < 8; ++e) val[i][e] *= rstd; }
            const int chunk = lr0 >> 7, q0 = lr0 & 127;
            bf16_t* vb = vrt + ((size_t)chunk * 512 + lane * 8) * 128 + q0;
#pragma unroll
            for (int e = 0; e < 8; ++e) { u32x2 o; o.x = cvt_pk_bf16(val[0][e], val[1][e]); o.y = cvt_pk_bf16(val[2][e], val[3][e]);
                if (!dry) *(u32x2*)(vb + (size_t)e * 128) = o; else asm volatile("" :: "v"(o)); }
        }
#pragma unroll 1
        for (int i = 0; i < 4; ++i) {
            bf16_t* Pr = P0 + (size_t)i * NPROJ; const int t = t0 + i;
            int spos, seqS, rowpos = 0, colpos = 0, bl = 0;
            if (is_ctx) { spos = t & 255; seqS = CTX_S; } else { const int tl = t - T_CTX; spos = tl & 4095; seqS = LAT_S; rowpos = spos >> 6; colpos = spos & 63; bl = (tl >> 12) - part * 4; }
            float x[16];
            const int kh = (lane >> 3) & 1;
            u32x2 kw[4];
#pragma unroll
            for (int a = 0; a < 2; ++a)
#pragma unroll
                for (int hf = 0; hf < 2; ++hf) kw[a * 2 + hf] = *(const u32x2*)(Pr + PC_K + kh * 128 + a * 64 + hf * 32 + 4 * hj);
            const int vi = (lane - 16) & 31;
            const u32x4 vw = *(const u32x4*)(Pr + PC_V + vi * 8);
            f32x4 rcv[2], rsv[2];
#pragma unroll
            for (int a = 0; a < 2; ++a) { const int pos = a == 0 ? rowpos : colpos; rcv[a] = *(const f32x4*)(rope + pos * 32 + 4 * hj); rsv[a] = *(const f32x4*)(rope + 2048 + pos * 32 + 4 * hj); }
            float pacc[8], pself[8];
            {
                const int hw = 1 << (lane >> 4);
                const int lo = max(spos - hw, 0), hi = min(spos + hw, seqS);
#pragma unroll
                for (int e = 0; e < 8; ++e) pacc[e] = 0.f;
                u32x4 pw[16];
#pragma unroll
                for (int k = 0; k < 16; ++k) { const int dd = k - 8, sp = spos + dd; const bool ok = (sp >= lo) && (sp < hi);
                    pw[k] = *(const u32x4*)(Pr + (long)(ok ? dd : 0) * NPROJ + PC_XP + lane * 8); }
#pragma unroll
                for (int k = 0; k < 16; ++k) { const int sp = spos + k - 8; const float mk = ((sp >= lo) && (sp < hi)) ? 1.0f : 0.0f;
#pragma unroll
                    for (int e = 0; e < 4; ++e) { pacc[2 * e] += mk * bf_lo(pw[k][e]); pacc[2 * e + 1] += mk * bf_hi(pw[k][e]); } }
#pragma unroll
                for (int e = 0; e < 4; ++e) { pself[2 * e] = bf_lo(pw[8][e]); pself[2 * e + 1] = bf_hi(pw[8][e]); }
                const float rc = 1.0f / (float)(hi - lo);
#pragma unroll
                for (int e = 0; e < 8; ++e) pacc[e] = pacc[e] * rc - pself[e];
            }
#pragma unroll
            for (int q4 = 0; q4 < 4; ++q4) { x[q4 * 4 + 0] = bf_lo(kw[q4].x); x[q4 * 4 + 1] = bf_hi(kw[q4].x); x[q4 * 4 + 2] = bf_lo(kw[q4].y); x[q4 * 4 + 3] = bf_hi(kw[q4].y); }
            rmsn(x, kg);
            if (dry) { asm volatile("" :: "v"(x[0]), "v"(x[7]), "v"(vw), "v"(pacc[0]), "v"(pacc[7])); continue; }
            if (is_ctx) {
                if (lane < 16) {
                    float* ok = outk + (((size_t)(t >> 8) * 2 + l) * 256 + (t & 255)) * 256 + kh * 128;
#pragma unroll
                    for (int a = 0; a < 2; ++a)
#pragma unroll
                        for (int hf = 0; hf < 2; ++hf) *(f32x4*)(ok + a * 64 + hf * 32 + 4 * hj) = (f32x4){x[(a * 2 + hf) * 4], x[(a * 2 + hf) * 4 + 1], x[(a * 2 + hf) * 4 + 2], x[(a * 2 + hf) * 4 + 3]};
                    store16h(KC + (size_t)t * 256 + kh * 128, hj, x);
                }
                if (lane >= 16 && lane < 48) {
                    float* ov = outv + (((size_t)(t >> 8) * 2 + l) * 256 + (t & 255)) * 256 + vi * 8;
                    *(f32x4*)ov = (f32x4){bf_lo(vw[0]), bf_hi(vw[0]), bf_lo(vw[1]), bf_hi(vw[1])};
                    *(f32x4*)(ov + 4) = (f32x4){bf_lo(vw[2]), bf_hi(vw[2]), bf_lo(vw[3]), bf_hi(vw[3])};
                    *(u32x4*)(VC + (size_t)t * 256 + vi * 8) = vw;
                }
            } else {
#pragma unroll
                for (int a = 0; a < 2; ++a)
#pragma unroll
                    for (int e = 0; e < 4; ++e) { const float x1 = x[(a * 2) * 4 + e], x2 = x[(a * 2 + 1) * 4 + e];
                        x[(a * 2) * 4 + e] = x1 * rcv[a][e] - x2 * rsv[a][e]; x[(a * 2 + 1) * 4 + e] = x2 * rcv[a][e] + x1 * rsv[a][e]; }
                const size_t krow = ((size_t)bl * SKV_LAT + PAST + spos) * 256;
                if (lane < 16) store16h(KL + krow + kh * 128, hj, x);
                if (lane >= 16 && lane < 48) *(u32x4*)(VL + krow + vi * 8) = vw;
            }
            { u32x4 o; o.x = cvt_pk_bf16(pacc[0], pacc[1]); o.y = cvt_pk_bf16(pacc[2], pacc[3]); o.z = cvt_pk_bf16(pacc[4], pacc[5]); o.w = cvt_pk_bf16(pacc[6], pacc[7]);
              *(u32x4*)(Pr + PC_K + lane * 8) = o; }
        }
    }
}

__device__ __forceinline__ void phase_attn(Frame& F, int l, int part, const bool sgu_only_dry = false) {
    bf16_t* proj = (bf16_t*)(F.ws + WS_PROJ);
    const bf16_t* KL = (const bf16_t*)(F.ws + WS_KL); const bf16_t* VL = (const bf16_t*)(F.ws + WS_VL); const bf16_t* KC = (const bf16_t*)(F.ws + WS_KC); const bf16_t* VC = (const bf16_t*)(F.ws + WS_VC);
    const int lat_row0 = part == 0 ? T_CTX : 0;
    if (!sgu_only_dry) {
        int pair, idx, step; int rep = 0;
        const bool xcdmap = (F.G % 8) == 0;
        if (xcdmap) { pair = F.bx & 7; idx = F.bx >> 3; step = F.G >> 3; } else { pair = 0; idx = F.bx; step = F.G; }
        for (;;) {
            int pr = pair, ix = idx;
            if (!xcdmap) { pr = idx >> 6; ix = idx & 63; if (idx >= 512) break; } else if (idx >= 64) break;
            const int bl = pr >> 1, kvh = pr & 1, h = kvh * 4 + (ix >> 4), qb = ix & 15;
            bf16_t* Qb = proj + (size_t)(lat_row0 + bl * LAT_S + qb * 256) * NPROJ + PC_Q + h * 128;
            att::attn_dense_body(Qb, KL + (size_t)bl * SKV_LAT * 256 + kvh * 128, VL + (size_t)bl * SKV_LAT * 256 + kvh * 128, SKV_LAT, F.ldsg, F.tid, F.in[I_QG] + l * 128, (const float*)(F.ws + WS_ROPE), qb * 256, PROBE == 3 ? rep == 1 : true);
            if (PROBE == 3) { if (rep == 0) { rep = 1; continue; } rep = 0; }
            idx += step;
        }
    }
    if (part == 0 && !sgu_only_dry) {
        for (int u = F.bx; u < 128; u += F.G) { const int b = u >> 3, h = u & 7;
            bf16_t* Qb = proj + (size_t)(b * 256) * NPROJ + PC_Q + h * 128;
            att::attn_dense_body(Qb, KC + (size_t)b * 256 * 256 + (h >> 2) * 128, VC + (size_t)b * 256 * 256 + (h >> 2) * 128, CTX_S, F.ldsg, F.tid, F.in[I_QG] + l * 128, (const float*)nullptr, 0); }
    }
    const bf16_t* vrt = (const bf16_t*)(F.ws + WS_VRT);
    const bf16_t* wsb = (const bf16_t*)(F.ws + WS_WSGU) + (size_t)l * 65536;
    const float* bs = F.in[I_BSGU] + l * 512;
    const int nitem = (part_rows(part) / 128) * 32;
    const int ln = F.lane & 15, quad = F.lane >> 4;
    for (int it = F.NGW - 1 - F.gw; it < nitem; it += F.NGW) {
        const int chunk = it >> 5, g = (it >> 3) & 3, cb = (it >> 1) & 3, pb = it & 1;
        f32x4 acc[2][4];
#pragma unroll
        for (int a = 0; a < 2; ++a)
#pragma unroll
            for (int b = 0; b < 4; ++b) acc[a][b] = (f32x4){0.f, 0.f, 0.f, 0.f};
        const bf16_t* ap = vrt + ((size_t)chunk * 512 + g * 128 + cb * 32 + ln) * 128 + quad * 8;
        const bf16_t* bp = wsb + ((size_t)g * 128 + pb * 64 + ln) * 128 + quad * 8;
        u32x2 xw[4][2];
#pragma unroll
        for (int pt = 0; pt < 4; ++pt)
#pragma unroll
            for (int ct = 0; ct < 2; ++ct) xw[pt][ct] = *(const u32x2*)(proj + (size_t)(chunk * 128 + pb * 64 + pt * 16 + ln) * NPROJ + PC_U + g * 128 + cb * 32 + ct * 16 + quad * 4);
#pragma unroll
        for (int ks = 0; ks < 4; ++ks) {
            bf16x8 af[2], bfr[4];
#pragma unroll
            for (int ct = 0; ct < 2; ++ct) af[ct] = *(const bf16x8*)(ap + ct * 16 * 128 + ks * 32);
#pragma unroll
            for (int pt = 0; pt < 4; ++pt) bfr[pt] = *(const bf16x8*)(bp + pt * 16 * 128 + ks * 32);
#pragma unroll
            for (int ct = 0; ct < 2; ++ct)
#pragma unroll
                for (int pt = 0; pt < 4; ++pt) acc[ct][pt] = __builtin_amdgcn_mfma_f32_16x16x32_bf16(af[ct], bfr[pt], acc[ct][pt], 0, 0, 0);
        }
#pragma unroll
        for (int pt = 0; pt < 4; ++pt) { const int p = pb * 64 + pt * 16 + ln; const float bsv = bs[g * 128 + p];
#pragma unroll
            for (int ct = 0; ct < 2; ++ct) { const int c = g * 128 + cb * 32 + ct * 16 + quad * 4;
                bf16_t* up = proj + (size_t)(chunk * 128 + p) * NPROJ + PC_U + c;
                const u32x2 w = xw[pt][ct];
                const float u0 = gelu1(bf_lo(w.x)), u1 = gelu1(bf_hi(w.x)), u2 = gelu1(bf_lo(w.y)), u3 = gelu1(bf_hi(w.y));
                const f32x4 a = acc[ct][pt];
                u32x2 o; o.x = cvt_pk_bf16(u0 * (a[0] + bsv), u1 * (a[1] + bsv)); o.y = cvt_pk_bf16(u2 * (a[2] + bsv), u3 * (a[3] + bsv));
                if (!sgu_only_dry) *(u32x2*)up = o; else asm volatile("" :: "v"(o)); } }
    }
}

constexpr int NPL = 11, NPHASE = 2 + DEPTH * NPL;
__global__ void __launch_bounds__(NW * 64, 2) fwd_kernel(Args args) {
    extern __shared__ __attribute__((aligned(16))) unsigned char lds[];
    Frame F;
    F.lds = (LAS unsigned char*)lds; F.ldsg = (char*)lds;
    F.G = gridDim.x; F.bx = blockIdx.x; F.NGW = F.G * NW;
    F.in = args.in; F.ws = args.ws; F.out = args.out;
    const float* mod = (const float*)(F.ws + WS_MOD);
    bf16_t* act = (bf16_t*)(F.ws + WS_ACT); bf16_t* proj = (bf16_t*)(F.ws + WS_PROJ);
    volatile LAS unsigned* bst = (volatile LAS unsigned*)(F.lds + 131072 + 64);
    unsigned* barw = (unsigned*)(F.ws + WS_BAR);
    const int wave0 = __builtin_amdgcn_readfirstlane((int)threadIdx.x >> 6);
    { unsigned z0 = 0u; asm volatile("" : "+v"(z0)); int t0 = wave0 * 64 + (int)__builtin_amdgcn_mbcnt_hi(~0u, __builtin_amdgcn_mbcnt_lo(~0u, z0));
      if (t0 < 2) bst[t0] = 0u;
      if (blockIdx.x == 0 && args.ph_lo == 0) { for (int i = t0; i < XCD_BAR_WORDS; i += NW * 64) barw[i] = 0u;
        unsigned* cw = (unsigned*)(F.ws + WS_CNT); for (int i = t0; i < CNT_WORDS; i += NW * 64) cw[i] = 0u; } }
    __syncthreads();
    XcdBarrier xbar; xbar.bar = barw; xbar.x = 0; xbar.st = bst;
    for (int ph = args.ph_lo; ph < args.ph_hi; ++ph) {
        { unsigned zz = 0u; asm volatile("" : "+v"(zz)); const int lanev = (int)__builtin_amdgcn_mbcnt_hi(~0u, __builtin_amdgcn_mbcnt_lo(~0u, zz));
          F.lane = lanev; F.wave = wave0; F.tid = wave0 * 64 + lanev; F.gw = F.bx * NW + F.wave; }

#ifndef PHMASK
#define PHMASK 0xffff
#endif
        if (ph == 0) { if (PHMASK & 1) phase_prologue(F); if (PROBE == 4) { __syncthreads(); phase_prologue(F); } }
        else if (ph == 1) { if (PHMASK & 2) phase_h0(F); if (PROBE == 4) phase_h0(F); }
        else {
            const int l = (ph - 2) / NPL, s = (ph - 2) % NPL;
            if (s < 8) {
                const int part = s >> 2, q = s & 3;
                if (q == 0) { if (PHMASK & 4) {
                    pg8::Gemm g{}; g.A = act + (size_t)part_row0(part) * DM; g.Bt = (const bf16_t*)(F.ws + WS_WIN) + (size_t)l * NPROJ * DM; g.lda = DM; g.ldb = DM;
                    g.nM = part_rows(part) / 256; g.nN = NPROJ / 256; g.nseg = 1; g.k0[0] = 0; g.nt[0] = 16; g.k0[1] = 0; g.nt[1] = 16; g.k0[2] = 0; g.nt[2] = 16;
                    pg8::Order S; S.init(g.nM, g.nN, 1, F.G, F.bx, 0, STAGGER);
                    pg8::EpiStore E{proj, NPROJ, PC_G};
                    if (PROBE == 2) { pg8::EpiNone E0; pg8::gemm_phase<pg8::EpiNone>(F.lds, g, S, E0, F.tid); }
                    if (PROBE == 7) pg8::gemm_phase<pg8::EpiStore>(F.lds, g, S, E, F.tid);
                    pg8::gemm_phase<pg8::EpiStore>(F.lds, g, S, E, F.tid); }
                } else if (q == 1) { if (PROBE == 5) phase_mid(F, l, part, true); if (PHMASK & 8) phase_mid(F, l, part, false); }
                else if (q == 2) { if (PROBE == 6) phase_attn(F, l, part, true); if (PHMASK & 16) phase_attn(F, l, part, false); }
                else if (PHMASK & 32) {
                    pg8::Gemm g{}; g.A = proj; g.Bt = (const bf16_t*)(F.ws + WS_WM) + (size_t)l * DM * 2048; g.lda = NPROJ; g.ldb = 2048;
                    g.nM = part_rows(part) / 256; g.nN = 4; g.nseg = 3; g.k0[0] = 0; g.nt[0] = 16; g.k0[1] = 1024; g.nt[1] = 8; g.k0[2] = 1536; g.nt[2] = 8;
                    pg8::Order S; S.init(g.nM, g.nN, 3, F.G, F.bx);
                    pg8::EpiGate E{F.lds + LDS_XCH, proj, act + (size_t)part_row0(part) * DM, DM};
                    if (PROBE == 2) { pg8::EpiNone E0; pg8::gemm_phase<pg8::EpiNone>(F.lds, g, S, E0, F.tid); }
                    pg8::gemm_phase<pg8::EpiGate>(F.lds, g, S, E, F.tid);
                }
            } else if (s == 8) { if (PHMASK & 64) {
                pg8::Gemm g{}; g.A = act; g.Bt = (const bf16_t*)(F.ws + WS_WOUT) + (size_t)l * DM * DM; g.lda = DM; g.ldb = DM;
                g.nM = T_ALL / 256; g.nN = 4; g.nseg = 1; g.k0[0] = 0; g.nt[0] = 16; g.k0[1] = 0; g.nt[1] = 16; g.k0[2] = 0; g.nt[2] = 16;
                pg8::Order S; S.init(g.nM, g.nN, 1, F.G, F.bx, 1);
                if (l == 0) { pg8::EpiResidLn<0, true, false> E{F.in, F.ws, F.out, l, F.lds + LDS_XCH}; pg8::gemm_phase<pg8::EpiResidLn<0, true, false>>(F.lds, g, S, E, F.tid); }
                else { pg8::EpiResidLn<0, false, false> E{F.in, F.ws, F.out, l, F.lds + LDS_XCH}; pg8::gemm_phase<pg8::EpiResidLn<0, false, false>>(F.lds, g, S, E, F.tid); } }
            } else if (s == 9) { if (PHMASK & 256) {
                pg8::Gemm g{}; g.A = act; g.Bt = (const bf16_t*)(F.ws + WS_WF1) + (size_t)l * 2 * DFF * DM; g.lda = DM; g.ldb = DM;
                g.nM = T_ALL / 256; g.nN = 2 * DFF / 256; g.nseg = 1; g.k0[0] = 0; g.nt[0] = 16; g.k0[1] = 0; g.nt[1] = 16; g.k0[2] = 0; g.nt[2] = 16;
                pg8::Order S; S.init(g.nM, g.nN, 1, F.G, F.bx, 0, STAGGER);
                pg8::EpiSwiGLU E{proj, DFF};
                if (PROBE == 2) { pg8::EpiNone E0; pg8::gemm_phase<pg8::EpiNone>(F.lds, g, S, E0, F.tid); }
                if (PROBE == 7) pg8::gemm_phase<pg8::EpiSwiGLU>(F.lds, g, S, E, F.tid);
                pg8::gemm_phase<pg8::EpiSwiGLU>(F.lds, g, S, E, F.tid); }
            } else { if (PHMASK & 512) {
                pg8::Gemm g{}; g.A = proj; g.Bt = (const bf16_t*)(F.ws + WS_WF2) + (size_t)l * DM * DFF; g.lda = DFF; g.ldb = DFF;
                g.nM = T_ALL / 256; g.nN = 4; g.nseg = 1; g.k0[0] = 0; g.nt[0] = 44; g.k0[1] = 0; g.nt[1] = 44; g.k0[2] = 0; g.nt[2] = 44;
                pg8::Order S; S.init(g.nM, g.nN, 1, F.G, F.bx, 1);
                if (l + 1 < DEPTH) { pg8::EpiResidLn<1, false, false> E{F.in, F.ws, F.out, l, F.lds + LDS_XCH}; pg8::gemm_phase<pg8::EpiResidLn<1, false, false>>(F.lds, g, S, E, F.tid); }
                else { pg8::EpiResidLn<1, false, true> E{F.in, F.ws, F.out, l, F.lds + LDS_XCH}; pg8::gemm_phase<pg8::EpiResidLn<1, false, true>>(F.lds, g, S, E, F.tid); } }
            }
        }
        if (ph + 1 < args.ph_hi) {
            if (ph == args.ph_lo) { cg::this_grid().sync(); xbar = xcd_barrier_post(barw, bst); }
            else xcd_barrier(xbar);
            if (PROBE == 1 && ph == 1) { for (int k = 0; k < 20; ++k) xcd_barrier(xbar); }
        }
    }
}

extern "C" void kernel_launch(void* const* d_in, const int* in_sizes, int n_in, void* d_out, int out_size, void* d_ws, size_t ws_size, hipStream_t stream) {
    static int grid = 0;
    if (grid == 0) {
        if (n_in != 25 || ws_size < WS_END) { fprintf(stderr, "kernel_launch: unexpected n_in %d / ws %zu\n", n_in, ws_size); grid = -1; return; }
        int dev = 0, cus = 0, per_cu = 0;
        if (hipGetDevice(&dev) != hipSuccess || hipDeviceGetAttribute(&cus, hipDeviceAttributeMultiprocessorCount, dev) != hipSuccess) { grid = -1; return; }
        if (hipFuncSetAttribute((const void*)fwd_kernel, hipFuncAttributeMaxDynamicSharedMemorySize, LDS_BYTES) != hipSuccess) { fprintf(stderr, "kernel_launch: hipFuncSetAttribute failed\n"); grid = -1; return; }
        if (hipOccupancyMaxActiveBlocksPerMultiprocessor(&per_cu, (const void*)fwd_kernel, NW * 64, LDS_BYTES) != hipSuccess || per_cu < 1) per_cu = 1;
        (void)hipGetLastError();
        grid = cus * (per_cu > 1 ? 1 : per_cu);
    }
    if (grid < 0) return;
    Args a{};
    for (int i = 0; i < 25; ++i) a.in[i] = (const float*)d_in[i];
    a.out = (float*)d_out; a.ws = (unsigned char*)d_ws;
#if MK_MULTI
    for (int ph = 0; ph < NPHASE; ++ph) { a.ph_lo = ph; a.ph_hi = ph + 1; hipLaunchKernelGGL(fwd_kernel, dim3(grid), dim3(NW * 64), LDS_BYTES, stream, a); }
#else
    a.ph_lo = 0; a.ph_hi = NPHASE;
    void* kargs[] = {&a};
    hipError_t e = hipLaunchCooperativeKernel((const void*)fwd_kernel, dim3(grid), dim3(NW * 64), kargs, LDS_BYTES, stream);
    if (e != hipSuccess) fprintf(stderr, "cooperative launch failed: %s (grid %d)\n", hipGetErrorString(e), grid);
#endif
}
```

```cpp
#include <hip/hip_runtime.h>
#include <hip/hip_bf16.h>
#include <hip/hip_cooperative_groups.h>
#include <cstdio>
#include <cstdint>
namespace cg = cooperative_groups;

#ifndef PROBE
#define PROBE 0
#endif
#ifndef STAGGER
#define STAGGER 0
#endif
#ifndef GATE_PF
#define GATE_PF false
#endif
#ifndef MK_MULTI
#define MK_MULTI 0
#endif

#define LAS __attribute__((address_space(3)))
typedef unsigned short bf16_t;
typedef short bf16x8 __attribute__((ext_vector_type(8)));
typedef short s16x4 __attribute__((ext_vector_type(4)));
typedef float f32x2 __attribute__((ext_vector_type(2)));
typedef float f32x4 __attribute__((ext_vector_type(4)));
typedef float f32x16 __attribute__((ext_vector_type(16)));
typedef unsigned u32x2 __attribute__((ext_vector_type(2)));
typedef unsigned u32x4 __attribute__((ext_vector_type(4)));

constexpr int DM = 1024, NPROJ = 6144, DFF = 2816, DEPTH = 2;
constexpr int T_CTX = 4096, T_ALL = 36864;
constexpr int CTX_S = 256, LAT_S = 4096, PAST = 512, SKV_LAT = 4608;
constexpr int PC_Q = 0, PC_U = 1024, PC_K = 1536, PC_V = 1792, PC_XV = 2048, PC_XP = 2560, PC_G = 3072;
constexpr float LN_EPS = 1e-6f;
constexpr float ALPHA = 1.41421356237309515f;
constexpr int NW = 8;
__host__ __device__ constexpr int part_row0(int p) { return p == 0 ? 0 : 20480; }
__host__ __device__ constexpr int part_rows(int p) { return p == 0 ? 20480 : 16384; }

constexpr size_t MiB = 1u << 20;
constexpr size_t WS_MOD = 0;
constexpr size_t WS_BAR = 448 * 1024;
constexpr size_t WS_ROPE = 512 * 1024;
constexpr size_t WS_WSGU = 768 * 1024;
constexpr size_t WS_WIN = 1 * MiB;
constexpr size_t WS_WM = 25 * MiB;
constexpr size_t WS_WOUT = 33 * MiB;
constexpr size_t WS_WF1 = 37 * MiB;
constexpr size_t WS_WF2 = 59 * MiB;
constexpr size_t WS_ACT = 70 * MiB;
constexpr size_t WS_PROJ = 142 * MiB;
constexpr size_t WS_KL = 382 * MiB, WS_VL = 391 * MiB;
constexpr size_t WS_KC = 400 * MiB, WS_VC = 402 * MiB;
constexpr size_t WS_VRT = 404 * MiB;
constexpr size_t WS_XBUF = 424 * MiB;
constexpr size_t WS_CNT = 426 * MiB;
constexpr int CNT_WORDS = 4 * 144 * 64;
constexpr size_t WS_XB = 427 * MiB;
constexpr size_t WS_END = 499 * MiB;

constexpr int LDS_BYTES = 143360;
constexpr int LDS_XCH = 131072 + 256;

__device__ __forceinline__ unsigned cvt_pk_bf16(float lo, float hi) { unsigned r; asm volatile("v_cvt_pk_bf16_f32 %0, %1, %2" : "=v"(r) : "v"(lo), "v"(hi)); return r; }
__device__ __forceinline__ float bf_lo(unsigned u) { return __uint_as_float(u << 16); }
__device__ __forceinline__ float bf_hi(unsigned u) { return __uint_as_float(u & 0xffff0000u); }
__device__ __forceinline__ float wave_sum(float v) {
#pragma unroll
    for (int o = 1; o < 64; o <<= 1) v += __shfl_xor(v, o);
    return v;
}
__device__ __forceinline__ float gelu1(float v) {
    const float av = fabsf(v), d = av * 0.2316418882f + 1.0f;
    const float t = __builtin_amdgcn_rcpf(d);
    float q = t * 0.5307027145f + (-0.7265760135f); q = q * t + 0.7107068705f; q = q * t + (-0.142248368f); q = q * t + 0.127414796f; q = q * t;
    const float e = __builtin_amdgcn_exp2f((v * v) * (-0.72134752044f));
    const float m = v * (q * e), r = v - m;
    return v < 0.f ? m : r;
}
__device__ __forceinline__ float sigmoidf_(float x) { return __builtin_amdgcn_rcpf(1.0f + __expf(-x)); }

namespace pg8 {
constexpr int BM = 256, BK = 64, HALF = 128, HTB = HALF * BK * 2, STAGE_BYTES = 8 * HTB, NXCD = 8, WGM = 8;
__host__ __device__ __forceinline__ int lds_byte(int r, int c) { const int st = (r >> 4) * 2 + (c >> 5), rr = r & 15, cc = c & 31, ob = rr * 64 + cc * 2; return st * 1024 + (ob ^ (((ob >> 9) & 1) << 5)); }
__host__ __device__ __forceinline__ void stage_rc(int b, int& R, int& C) { const int st = b / 1024, sb = b % 1024, swz = sb ^ (((sb >> 9) & 1) << 5); R = (st >> 1) * 16 + swz / 64; C = (st & 1) * 32 + (swz % 64) / 2; }
__host__ __device__ __forceinline__ int perm32(int rho) { const int n = rho >> 4, i = rho & 15; return 8 * (i >> 2) + 4 * n + (i & 3); }

struct Unit { int pm, pn, seg; };
struct Gemm { const bf16_t* A; const bf16_t* Bt; int lda, ldb, nM, nN, nseg; int k0[3]; int nt[3]; };

struct Order {
    int nM, nN, nwg, G, c, nseg, team, stagger;
    __device__ void init(int nM_, int nN_, int nseg_, int G_, int c_, int team_ = 0, int stagger_ = 0) { nM = nM_; nN = nN_; nwg = nM * nN; G = G_; c = c_; nseg = nseg_; team = team_; stagger = stagger_; }
    __device__ bool next(int i, Unit& u) const {
        if (team) {
            u.seg = 0; const int j = c >> 3; u.pn = j & 3; u.pm = i * (G >> 2) + (j >> 2) * 8 + (c & 7); return u.pm < nM;
        }
        const int ti = i / nseg; u.seg = i - ti * nseg;
        const long L = (long)ti * G + c; if (L >= nwg) return false;
        int wgid = (int)L; { const int q = nwg / NXCD, r = nwg % NXCD, xcd = wgid % NXCD, off = wgid / NXCD; wgid = (xcd < r ? xcd * (q + 1) : r * (q + 1) + (xcd - r) * q) + off; }
        const int nig = WGM * nN, gid = wgid / nig, fm = gid * WGM, gsz = (nM - fm) < WGM ? (nM - fm) : WGM;
        u.pm = fm + ((wgid % nig) % gsz); u.pn = (wgid % nig) / gsz; return true;
    }
};

struct EpiStore {
    static constexpr bool PREFETCH = false;
    static constexpr bool PERM = true;
    bf16_t* O; int ldc; int gate_col0;
    __device__ __forceinline__ void run(f32x4 (&acc)[2][2][4][2], const Unit& u, int wr, int wc, int fr, int fq) const {
        const int row0 = u.pm * BM + wr * 64 + fr; const int col0 = u.pn * BM + wc * 32 + 8 * fq;
        const bool gate = u.pn * BM >= gate_col0;
#pragma unroll
        for (int ai = 0; ai < 2; ++ai)
#pragma unroll
            for (int m = 0; m < 4; ++m) { bf16_t* rowp = O + (size_t)(row0 + ai * HALF + m * 16) * ldc + col0;
#pragma unroll
                for (int bj = 0; bj < 2; ++bj) { f32x4 v0 = acc[ai][bj][m][0], v1 = acc[ai][bj][m][1];
                    if (gate) {
#pragma unroll
                        for (int e = 0; e < 4; ++e) { v0[e] = 1.0f + __expf(-fmaxf(v0[e], -80.f)); v1[e] = 1.0f + __expf(-fmaxf(v1[e], -80.f)); } }
                    u32x4 w; w.x = cvt_pk_bf16(v0[0], v0[1]); w.y = cvt_pk_bf16(v0[2], v0[3]); w.z = cvt_pk_bf16(v1[0], v1[1]); w.w = cvt_pk_bf16(v1[2], v1[3]);
                    *(u32x4*)(rowp + bj * HALF) = w; } }
    }
};
struct EpiSwiGLU {
    static constexpr bool PREFETCH = false;
    static constexpr bool PERM = true;
    bf16_t* O; int ldc;
    __device__ __forceinline__ void run(f32x4 (&acc)[2][2][4][2], const Unit& u, int wr, int wc, int fr, int fq) const {
        const int row0 = u.pm * BM + wr * 64 + fr; const int col0 = u.pn * HALF + wc * 32 + 8 * fq;
#pragma unroll
        for (int ai = 0; ai < 2; ++ai)
#pragma unroll
            for (int m = 0; m < 4; ++m) { bf16_t* rowp = O + (size_t)(row0 + ai * HALF + m * 16) * ldc + col0;
                float o[8];
#pragma unroll
                for (int n = 0; n < 2; ++n)
#pragma unroll
                    for (int e = 0; e < 4; ++e) { const float a = acc[ai][0][m][n][e], b = acc[ai][1][m][n][e]; o[n * 4 + e] = a * sigmoidf_(a) * b; }
                u32x4 w; w.x = cvt_pk_bf16(o[0], o[1]); w.y = cvt_pk_bf16(o[2], o[3]); w.z = cvt_pk_bf16(o[4], o[5]); w.w = cvt_pk_bf16(o[6], o[7]);
                *(u32x4*)rowp = w; }
    }
};
struct EpiResid {
    static constexpr bool PREFETCH = false;
    static constexpr bool PERM = false;
    const float* xres_ctx; const float* xres_lat;
    float* out; const float* mod; int goff;
    __device__ __forceinline__ void run(f32x4 (&acc)[2][2][4][2], const Unit& u, int wr, int wc, int fr, int fq) const {
        const int v = u.pm < 16 ? 0 : 1 + ((u.pm - 16) >> 4);
        const float* xb = u.pm < 16 ? xres_ctx + (size_t)u.pm * BM * DM : xres_lat + (size_t)(u.pm - 16) * BM * DM;
        float* ob = out + (size_t)u.pm * BM * DM;
        const int col0 = u.pn * BM + wc * 32 + 4 * fq;
        const float* gp = mod + v * 6144 + goff + col0;
        f32x4 gv[2][2];
#pragma unroll
        for (int bj = 0; bj < 2; ++bj)
#pragma unroll
            for (int n = 0; n < 2; ++n) gv[bj][n] = *(const f32x4*)(gp + bj * HALF + n * 16);
#pragma unroll
        for (int ai = 0; ai < 2; ++ai)
#pragma unroll
            for (int m = 0; m < 4; ++m) { const size_t off = (size_t)(ai * HALF + wr * 64 + m * 16 + fr) * DM + col0;
#pragma unroll
                for (int bj = 0; bj < 2; ++bj)
#pragma unroll
                    for (int n = 0; n < 2; ++n) { const f32x4 x = *(const f32x4*)(xb + off + bj * HALF + n * 16);
                        *(f32x4*)(ob + off + bj * HALF + n * 16) = x * ALPHA + gv[bj][n] * acc[ai][bj][m][n]; } }
    }
};

struct PanelStats {
    unsigned long long* xbuf;
    unsigned* cnt;
    LAS unsigned char* lx;
    __device__ __forceinline__ void run(const f32x4 (&v)[2][2][4][2], const Unit& u, int wr, int wc, int fr, int fq, int wid, int lane) const {
        LAS f32x2* P = (LAS f32x2*)lx; LAS f32x2* S = (LAS f32x2*)(lx + 8192);
#pragma unroll
        for (int ai = 0; ai < 2; ++ai)
#pragma unroll
            for (int m = 0; m < 4; ++m) {
                float s = 0.f;
#pragma unroll
                for (int bj = 0; bj < 2; ++bj)
#pragma unroll
                    for (int n = 0; n < 2; ++n) { const f32x4 x = v[ai][bj][m][n]; s += (x[0] + x[1]) + (x[2] + x[3]); }
                s += __shfl_xor(s, 16); s += __shfl_xor(s, 32);
                const float mw = s * (1.0f / 64.0f); float q = 0.f;
#pragma unroll
                for (int bj = 0; bj < 2; ++bj)
#pragma unroll
                    for (int n = 0; n < 2; ++n) { const f32x4 d = v[ai][bj][m][n] - mw; q += (d[0] * d[0] + d[1] * d[1]) + (d[2] * d[2] + d[3] * d[3]); }
                q += __shfl_xor(q, 16); q += __shfl_xor(q, 32);
                if (fq == 0) P[(ai * HALF + wr * 64 + m * 16 + fr) * 4 + wc] = (f32x2){mw, q};
            }
        asm volatile("s_waitcnt lgkmcnt(0)" ::: "memory"); __builtin_amdgcn_s_barrier(); asm volatile("" ::: "memory");
        const int row = wid * 32 + (lane & 31);
        if (lane < 32) {
            const f32x2 a = P[row * 4 + 0], b = P[row * 4 + 1], c = P[row * 4 + 2], d = P[row * 4 + 3];
            const float mt = (a.x + b.x + c.x + d.x) * 0.25f;
            const float da = a.x - mt, db = b.x - mt, dc = c.x - mt, dd = d.x - mt;
            const float m2 = (a.y + b.y) + (c.y + d.y) + 64.0f * ((da * da + db * db) + (dc * dc + dd * dd));
            unsigned long long* slot = xbuf + ((size_t)(u.pm * BM + row) * 4 + u.pn);
            __hip_atomic_store(slot, ((unsigned long long)__float_as_uint(m2) << 32) | __float_as_uint(mt), __ATOMIC_RELAXED, __HIP_MEMORY_SCOPE_AGENT);
        }
        asm volatile("s_waitcnt vmcnt(0)" ::: "memory");
        if (lane == 0) __hip_atomic_fetch_add(cnt + 64 * u.pm, 1u, __ATOMIC_RELAXED, __HIP_MEMORY_SCOPE_AGENT);
        if (wid == 0) {
            unsigned sp = 0;
            for (;;) {
                if ((unsigned)__builtin_amdgcn_readfirstlane(__hip_atomic_load(cnt + 64 * u.pm, __ATOMIC_RELAXED, __HIP_MEMORY_SCOPE_AGENT)) >= 32u) break;
                if (++sp > (1u << 22)) break;
                __builtin_amdgcn_s_sleep(2);
            }
            __builtin_amdgcn_fence(__ATOMIC_ACQUIRE, "agent");
        }
        asm volatile("s_waitcnt vmcnt(0) lgkmcnt(0)" ::: "memory"); __builtin_amdgcn_s_barrier(); asm volatile("" ::: "memory");
        if (lane < 32) {
            const unsigned long long* slot = xbuf + (size_t)(u.pm * BM + row) * 4; float mt[4], m2[4]; float ms = 0.f;
#pragma unroll
            for (int t = 0; t < 4; ++t) { const unsigned long long w = __hip_atomic_load(slot + t, __ATOMIC_RELAXED, __HIP_MEMORY_SCOPE_AGENT); mt[t] = __uint_as_float((unsigned)w); m2[t] = __uint_as_float((unsigned)(w >> 32)); ms += mt[t]; }
            const float mean = ms * 0.25f; float q = 0.f;
#pragma unroll
            for (int t = 0; t < 4; ++t) { const float dm = mt[t] - mean; q += m2[t] + 256.0f * dm * dm; }
            S[row] = (f32x2){mean, rsqrtf(q * (1.0f / 1024.0f) + LN_EPS)};
        }
        asm volatile("s_waitcnt lgkmcnt(0)" ::: "memory"); __builtin_amdgcn_s_barrier(); asm volatile("" ::: "memory");
    }
};
template <int WHICH, bool INF32, bool OUTF32>
struct EpiResidLn {
    static constexpr bool PERM = false;
    static constexpr bool PREFETCH = false;
    const float* const* in; unsigned char* ws; float* out_; int l; LAS unsigned char* lx;
    __device__ __forceinline__ void prefetch(const Unit& u, int it, int nit, int wid, int lane_) const {
        int lane = lane_; asm volatile("" : "+v"(lane));
        const float* xb = (WHICH == 0 && l == 0) ? (u.pm < 16 ? in[0] + (size_t)u.pm * BM * DM : in[1] + (size_t)(u.pm - 16) * BM * DM) : out_ + (size_t)u.pm * BM * DM;
        const int R = nit >= 16 ? 2 : 4;
#pragma unroll
        for (int k = 0; k < 4; ++k) { const int j = it * R + k;
            if (k < R && j < 32) __builtin_amdgcn_global_load_lds((const unsigned*)(xb + (size_t)(j * 8 + wid) * DM + u.pn * BM + lane * 4), (LAS unsigned*)(lx + 10240), 16, 0, 0); }
    }
    __device__ __forceinline__ void run(f32x4 (&acc)[2][2][4][2], const Unit& u, int wr, int wc, int fr_, int fq_) const {
        int fr = fr_, fq = fq_; asm volatile("" : "+v"(fr), "+v"(fq));
        int lv = l; asm volatile("" : "+v"(lv)); lv = __builtin_amdgcn_readfirstlane(lv);
        const float* mod = (const float*)(ws + 0) + lv * 9 * 6144;
        float* out = out_;
        const float* xres_ctx = (WHICH == 0 && lv == 0) ? in[0] : out;
        const float* xres_lat = (WHICH == 0 && lv == 0) ? in[1] : out + (size_t)T_CTX * DM;
        const int goff = WHICH == 0 ? 2048 : 5120;
        const float* lg = in[WHICH == 0 ? 19 : 23] + lv * DM; const float* lb = in[WHICH == 0 ? 20 : 24] + lv * DM;
        bf16_t* act = (bf16_t*)(ws + (size_t)70 * 1048576);
        const float* modn = WHICH == 0 ? mod : (const float*)(ws + 0) + (lv + 1 < DEPTH ? lv + 1 : lv) * 9 * 6144;
        const int sh_off = WHICH == 0 ? 3072 : 0, sc_off = WHICH == 0 ? 4096 : 1024;
        PanelStats st{(unsigned long long*)(ws + (size_t)424 * 1048576), (unsigned*)(ws + (size_t)426 * 1048576) + (lv * 2 + WHICH) * 144 * 64, lx};
        const int v = u.pm < 16 ? 0 : 1 + ((u.pm - 16) >> 4);
        const float* xb = u.pm < 16 ? xres_ctx + (size_t)u.pm * BM * DM : xres_lat + (size_t)(u.pm - 16) * BM * DM;
        float* ob = out + (size_t)u.pm * BM * DM;
        bf16_t* xs = (bf16_t*)(ws + (size_t)427 * 1048576);
        const int col0 = u.pn * BM + wc * 32 + 4 * fq;
        const size_t roff = (size_t)(wr * 64 + fr) * DM + col0;
        {
            const float* gp = mod + v * 6144 + goff + col0;
            if constexpr (INF32) {
#pragma unroll
                for (int bj = 0; bj < 2; ++bj)
#pragma unroll
                    for (int n = 0; n < 2; ++n) { const f32x4 gv = *(const f32x4*)(gp + bj * HALF + n * 16);
#pragma unroll
                        for (int ai = 0; ai < 2; ++ai) {
                            f32x4 xf[4];
#pragma unroll
                            for (int m = 0; m < 4; ++m) xf[m] = *(const f32x4*)(xb + roff + (size_t)(ai * HALF + m * 16) * DM + bj * HALF + n * 16);
#pragma unroll
                            for (int m = 0; m < 4; ++m) acc[ai][bj][m][n] = xf[m] * ALPHA + gv * acc[ai][bj][m][n];
#pragma unroll
                            for (int m = 0; m < 4; ++m) asm volatile("" : "+v"(acc[ai][bj][m][n]));
                            asm volatile("" ::: "memory"); } }
            } else {
                u32x2 xw[2][2][2][4];
                const bf16_t* xp_ = xs + (size_t)u.pm * BM * DM + roff;
#pragma unroll
                for (int bj = 0; bj < 2; ++bj)
#pragma unroll
                    for (int n = 0; n < 2; ++n)
#pragma unroll
                        for (int ai = 0; ai < 2; ++ai)
#pragma unroll
                            for (int m = 0; m < 4; ++m) xw[bj][n][ai][m] = *(const u32x2*)(xp_ + (size_t)(ai * HALF + m * 16) * DM + bj * HALF + n * 16);
                f32x4 gvv[2][2];
#pragma unroll
                for (int bj = 0; bj < 2; ++bj)
#pragma unroll
                    for (int n = 0; n < 2; ++n) gvv[bj][n] = *(const f32x4*)(gp + bj * HALF + n * 16);
#pragma unroll
                for (int bj = 0; bj < 2; ++bj)
#pragma unroll
                    for (int n = 0; n < 2; ++n) { const f32x4 gv = gvv[bj][n];
#pragma unroll
                        for (int ai = 0; ai < 2; ++ai)
#pragma unroll
                            for (int m = 0; m < 4; ++m) { const u32x2 w = xw[bj][n][ai][m]; const f32x4 x = (f32x4){bf_lo(w.x), bf_hi(w.x), bf_lo(w.y), bf_hi(w.y)};
                                acc[ai][bj][m][n] = x * ALPHA + gv * acc[ai][bj][m][n]; } }
            }
        }
        const int lane = fq * 16 + fr, wid = wr * 4 + wc;
        st.run(acc, u, wr, wc, fr, fq, wid, lane);
        const LAS f32x2* S = (const LAS f32x2*)(st.lx + 8192);
        const float* mv = modn + v * 6144;
        f32x4 G4[2][2], B4[2][2], SH[2][2], SC[2][2];
#pragma unroll
        for (int bj = 0; bj < 2; ++bj)
#pragma unroll
            for (int n = 0; n < 2; ++n) { const int c = col0 + bj * HALF + n * 16;
                G4[bj][n] = *(const f32x4*)(lg + c); B4[bj][n] = *(const f32x4*)(lb + c); SH[bj][n] = *(const f32x4*)(mv + sh_off + c); SC[bj][n] = *(const f32x4*)(mv + sc_off + c); }
#pragma unroll
        for (int bj = 0; bj < 2; ++bj)
#pragma unroll
            for (int n = 0; n < 2; ++n) {
                const f32x4 g4 = G4[bj][n], b4 = B4[bj][n], sh = SH[bj][n], sc = SC[bj][n] + 1.0f;
#pragma unroll
                for (int ai = 0; ai < 2; ++ai)
#pragma unroll
                    for (int m = 0; m < 4; ++m) { const size_t off = roff + (size_t)(ai * HALF + m * 16) * DM + bj * HALF + n * 16;
                        const f32x2 sr = S[ai * HALF + wr * 64 + m * 16 + fr];
                        const f32x4 y = (acc[ai][bj][m][n] - sr.x) * sr.y * g4 + b4;
                        if (OUTF32) *(f32x4*)(ob + off) = y;
                        else { u32x2 w; w.x = cvt_pk_bf16(y[0], y[1]); w.y = cvt_pk_bf16(y[2], y[3]); *(u32x2*)(xs + (size_t)u.pm * BM * DM + off) = w; }
                        if (WHICH == 0 || lv + 1 < DEPTH) { const f32x4 h = y * sc + sh; u32x2 w; w.x = cvt_pk_bf16(h[0], h[1]); w.y = cvt_pk_bf16(h[2], h[3]);
                            *(u32x2*)(act + (size_t)u.pm * BM * DM + off) = w; } }
                asm volatile("" ::: "memory"); }
    }
};
struct EpiGate {
    static constexpr bool PERM = true;
    static constexpr bool PREFETCH = GATE_PF;
    LAS unsigned char* lx;
    __device__ __forceinline__ void prefetch(const Unit& u, int it, int nit, int wid, int lane_) const {
        if (u.seg == 2) return;
        int lane = lane_; asm volatile("" : "+v"(lane));
        const bf16_t* gb = P + (size_t)u.pm * BM * NPROJ + PC_G + u.pn * BM + (lane & 31) * 8;
#pragma unroll
        for (int k = 0; k < 4; ++k) { const int j = it * 4 + k;
            const int tile = u.seg == 0 ? (j >> 4) : 0; const int goff = u.seg == 0 ? (tile == 0 ? 0 : 2048) : 1024; const int jr = j & 15;
            if (j < (u.seg == 0 ? 32 : 16)) __builtin_amdgcn_global_load_lds((const unsigned*)(gb + (size_t)(jr * 16 + wid * 2 + (lane >> 5)) * NPROJ + goff), (LAS unsigned*)(lx + 10240), 16, 0, 0); }
    }
    const bf16_t* P;
    bf16_t* O; int ldc;
    __device__ __forceinline__ void run(f32x4 (&acc)[2][2][4][2], const Unit& u, int wr, int wc, int fr_, int fq_) const {
        int fr = fr_, fq = fq_; asm volatile("" : "+v"(fr), "+v"(fq));
        const int row0 = u.pm * BM + wr * 64 + fr; const int col0 = u.pn * BM + wc * 32 + 8 * fq;
        const bf16_t* gbase = P + (size_t)row0 * NPROJ + PC_G + col0;
        const bool last = u.seg == 2;
        const int noff = u.seg == 0 ? 0 : (u.seg == 1 ? 2048 : 1024), doff = u.seg == 0 ? 2048 : 1024;
#pragma unroll
        for (int am = 0; am < 2; ++am) { const int ai = am, mb = 0;
            u32x4 gn[4][2], gd[4][2];
#pragma unroll
            for (int mm = 0; mm < 4; ++mm)
#pragma unroll
                for (int bj = 0; bj < 2; ++bj) { const bf16_t* gp = gbase + (size_t)(ai * HALF + (mb + mm) * 16) * NPROJ + bj * HALF;
                    gn[mm][bj] = *(const u32x4*)(gp + noff); gd[mm][bj] = *(const u32x4*)(gp + doff); }
#pragma unroll
            for (int mm = 0; mm < 4; ++mm)
#pragma unroll
                for (int bj = 0; bj < 2; ++bj) { const int m = mb + mm; f32x4 v0 = acc[ai][bj][m][0], v1 = acc[ai][bj][m][1];
#pragma unroll
                    for (int e = 0; e < 2; ++e) {
                        v0[2 * e]     *= (last ? 1.0f : bf_lo(gd[mm][bj][e])) * __builtin_amdgcn_rcpf(bf_lo(gn[mm][bj][e]));
                        v0[2 * e + 1] *= (last ? 1.0f : bf_hi(gd[mm][bj][e])) * __builtin_amdgcn_rcpf(bf_hi(gn[mm][bj][e]));
                        v1[2 * e]     *= (last ? 1.0f : bf_lo(gd[mm][bj][2 + e])) * __builtin_amdgcn_rcpf(bf_lo(gn[mm][bj][2 + e]));
                        v1[2 * e + 1] *= (last ? 1.0f : bf_hi(gd[mm][bj][2 + e])) * __builtin_amdgcn_rcpf(bf_hi(gn[mm][bj][2 + e])); }
                    acc[ai][bj][m][0] = v0; acc[ai][bj][m][1] = v1;
                    if (last) { u32x4 w; w.x = cvt_pk_bf16(v0[0], v0[1]); w.y = cvt_pk_bf16(v0[2], v0[3]); w.z = cvt_pk_bf16(v1[0], v1[1]); w.w = cvt_pk_bf16(v1[2], v1[3]);
                        *(u32x4*)(O + (size_t)(row0 + ai * HALF + m * 16) * ldc + col0 + bj * HALF) = w; } }
            asm volatile("" ::: "memory");
        }
    }
};

struct EpiNone { static constexpr bool PREFETCH = false; static constexpr bool PERM = true; __device__ __forceinline__ void run(f32x4 (&acc)[2][2][4][2], const Unit& u, int wr, int wc, int fr, int fq) const {
    _Pragma("unroll") for (int a = 0; a < 2; ++a) _Pragma("unroll") for (int b = 0; b < 2; ++b) _Pragma("unroll") for (int m = 0; m < 4; ++m) _Pragma("unroll") for (int n = 0; n < 2; ++n) asm volatile("" :: "v"(acc[a][b][m][n])); } };
template <class Epi>
__device__ __forceinline__ void gemm_phase(LAS unsigned char* lds, const Gemm g, const Order& S, const Epi& E, const int tid) {
    const int wid = __builtin_amdgcn_readfirstlane(tid >> 6), lane = tid & 63, wr = wid >> 2, wc = wid & 3, fr = lane & 15, fq = lane >> 4;
    unsigned voffA[2], voffB[2];
#pragma unroll
    for (int i = 0; i < 2; ++i) { int R, C; stage_rc(tid * 16 + i * 8192, R, C); const int Rb = Epi::PERM ? ((R & ~31) + perm32(R & 31)) : R;
        voffA[i] = (unsigned)(R * g.lda + C) * 2u; voffB[i] = (unsigned)(Rb * g.ldb + C) * 2u; }
    const size_t kstep = (size_t)(BK * 2);
    const size_t hstepA = (size_t)HALF * g.lda * 2, hstepB = (size_t)HALF * g.ldb * 2;
    const size_t tstepA = 2 * hstepA, tstepB = 2 * hstepB;
    const unsigned ldsw = (unsigned)wid * 1024u;
    const int aoff = lds_byte(wr * 64 + fr, fq * 8), boff = lds_byte(wc * 32 + fr, fq * 8);
#define PG8_SA(b, h) (((b) * 2 + (h)) * HTB)
#define PG8_SB(b, h) ((4 + (b) * 2 + (h)) * HTB)
#define PG8_STAGE(bufoff, gbase, voff) do { _Pragma("unroll") for (int _i = 0; _i < 2; ++_i) \
        __builtin_amdgcn_global_load_lds((const unsigned*)((const char*)(gbase) + (voff)[_i]), (LAS unsigned*)(lds + (bufoff) + ldsw + _i * 8192), 16, 0, 0); } while (0)
#define PG8_LDA(dst, b, h) do { _Pragma("unroll") for (int m = 0; m < 4; ++m) _Pragma("unroll") for (int k = 0; k < 2; ++k) dst[m][k] = *(const LAS bf16x8*)(lds + PG8_SA(b, h) + aoff + m * 2048 + k * 1024); } while (0)
#define PG8_LDB(dst, b, h) do { _Pragma("unroll") for (int n = 0; n < 2; ++n) _Pragma("unroll") for (int k = 0; k < 2; ++k) dst[n][k] = *(const LAS bf16x8*)(lds + PG8_SB(b, h) + boff + n * 2048 + k * 1024); } while (0)
#define PG8_MMA(ai, bj, At, Bt) do { __builtin_amdgcn_s_setprio(1); _Pragma("unroll") for (int m = 0; m < 4; ++m) _Pragma("unroll") for (int n = 0; n < 2; ++n) _Pragma("unroll") for (int k = 0; k < 2; ++k) \
        acc[ai][bj][m][n] = __builtin_amdgcn_mfma_f32_16x16x32_bf16(Bt[n][k], At[m][k], acc[ai][bj][m][n], 0, 0, 0); __builtin_amdgcn_s_setprio(0); } while (0)
#define PG8_WAIT_V(n) asm volatile("s_waitcnt vmcnt(" #n ")" ::: "memory")
#define PG8_WAIT_L(n) asm volatile("s_waitcnt lgkmcnt(" #n ")" ::: "memory")
#define PG8_BAR __builtin_amdgcn_s_barrier()
#define PG8_SCHED __builtin_amdgcn_sched_barrier(0)
#define KOF(sg) ((sg) == 0 ? g.k0[0] : ((sg) == 1 ? g.k0[1] : g.k0[2]))
#define NTF(sg) ((sg) == 0 ? g.nt[0] : ((sg) == 1 ? g.nt[1] : g.nt[2]))
    Unit cur, nxt; int ui = 0;
    if (!S.next(0, cur)) return;
    if (S.stagger) {
        const int mine = (S.nwg - S.c + S.G - 1) / S.G, mx = (S.nwg + S.G - 1) / S.G;
        if (mine < mx) { const unsigned long long t0 = __builtin_amdgcn_s_memrealtime(); while (__builtin_amdgcn_s_memrealtime() - t0 < (unsigned long long)S.stagger) __builtin_amdgcn_s_sleep(16); }
    }
    f32x4 acc[2][2][4][2];
#pragma unroll
    for (int a = 0; a < 2; ++a)
#pragma unroll
        for (int b = 0; b < 2; ++b)
#pragma unroll
            for (int m = 0; m < 4; ++m)
#pragma unroll
                for (int n = 0; n < 2; ++n) acc[a][b][m][n] = (f32x4){0.f, 0.f, 0.f, 0.f};
    bf16x8 At[4][2], B0[2][2], B1[2][2];
    const char* cA = (const char*)g.A + (size_t)cur.pm * tstepA + (size_t)KOF(cur.seg) * 2; const char* cB = (const char*)g.Bt + (size_t)cur.pn * tstepB + (size_t)KOF(cur.seg) * 2;
    PG8_STAGE(PG8_SB(0, 0), cB, voffB); PG8_STAGE(PG8_SB(0, 1), cB + hstepB, voffB); PG8_STAGE(PG8_SA(0, 0), cA, voffA); PG8_STAGE(PG8_SA(0, 1), cA + hstepA, voffA);
    if (wr == 1) PG8_BAR;
    PG8_WAIT_V(2); PG8_BAR;
    PG8_STAGE(PG8_SB(1, 0), cB + kstep, voffB); PG8_STAGE(PG8_SA(1, 0), cA + kstep, voffA); PG8_STAGE(PG8_SB(1, 1), cB + hstepB + kstep, voffB);
    PG8_WAIT_V(6); PG8_BAR;
    for (;;) {
        const bool has_next = S.next(ui + 1, nxt);
        const int nt = NTF(cur.seg);
        const char* nA = has_next ? (const char*)g.A + (size_t)nxt.pm * tstepA + (size_t)KOF(nxt.seg) * 2 : cA;
        const char* nB = has_next ? (const char*)g.Bt + (size_t)nxt.pn * tstepB + (size_t)KOF(nxt.seg) * 2 : cB;
        for (int t = 0; t < nt; t += 2) {
            const bool last = (t == nt - 2);
            const char* a1 = cA + (size_t)(t + 1) * kstep;
            const char* a2 = last ? nA : cA + (size_t)(t + 2) * kstep; const char* b2 = last ? nB : cB + (size_t)(t + 2) * kstep;
            const char* a3 = a2 + kstep; const char* b3 = b2 + kstep;
            PG8_LDB(B0, 0, 0); PG8_LDB(B1, 0, 1); PG8_SCHED; PG8_LDA(At, 0, 0); PG8_STAGE(PG8_SA(1, 1), a1 + hstepA, voffA);
            if constexpr (Epi::PREFETCH) E.prefetch(cur, t >> 1, nt >> 1, wid, lane);
            PG8_WAIT_V(8); PG8_WAIT_L(0); PG8_BAR; PG8_MMA(0, 0, At, B0); PG8_MMA(0, 1, At, B1); PG8_BAR; PG8_SCHED;
            PG8_LDA(At, 0, 1); PG8_STAGE(PG8_SB(0, 0), b2, voffB); PG8_STAGE(PG8_SB(0, 1), b2 + hstepB, voffB); PG8_STAGE(PG8_SA(0, 0), a2, voffA);
            PG8_WAIT_V(8); PG8_WAIT_L(0); PG8_BAR; PG8_MMA(1, 0, At, B0); PG8_MMA(1, 1, At, B1); PG8_BAR; PG8_SCHED;
            PG8_LDB(B0, 1, 0); PG8_LDB(B1, 1, 1); PG8_SCHED; PG8_LDA(At, 1, 0); PG8_STAGE(PG8_SA(0, 1), a2 + hstepA, voffA);
            PG8_WAIT_V(8); PG8_WAIT_L(0); PG8_BAR; PG8_MMA(0, 0, At, B0); PG8_MMA(0, 1, At, B1); PG8_BAR; PG8_SCHED;
            PG8_LDA(At, 1, 1); PG8_STAGE(PG8_SB(1, 0), b3, voffB); PG8_STAGE(PG8_SB(1, 1), b3 + hstepB, voffB); PG8_STAGE(PG8_SA(1, 0), a3, voffA);
            PG8_WAIT_V(8); PG8_WAIT_L(0); PG8_BAR; PG8_MMA(1, 0, At, B0); PG8_MMA(1, 1, At, B1); PG8_BAR; PG8_SCHED;
        }
        if (wr == 0) PG8_BAR;
        E.run(acc, cur, wr, wc, fr, fq);
        if (!has_next) break;
        if (cur.seg == g.nseg - 1) {
#pragma unroll
            for (int a = 0; a < 2; ++a)
#pragma unroll
                for (int b = 0; b < 2; ++b)
#pragma unroll
                    for (int m = 0; m < 4; ++m)
#pragma unroll
                        for (int n = 0; n < 2; ++n) acc[a][b][m][n] = (f32x4){0.f, 0.f, 0.f, 0.f};
        }
        cur = nxt; cA = nA; cB = nB; ++ui;
        if (wr == 1) PG8_BAR;
    }
    PG8_WAIT_V(0);
    PG8_BAR;
#undef KOF
#undef NTF
#undef PG8_SA
#undef PG8_SB
#undef PG8_STAGE
#undef PG8_LDA
#undef PG8_LDB
#undef PG8_MMA
#undef PG8_WAIT_V
#undef PG8_WAIT_L
#undef PG8_BAR
#undef PG8_SCHED
}
}

namespace att {
constexpr int D = 128, QBLK = 32, KVBLK = 64;
constexpr float SCALE = 0.088388347648318440f;
constexpr float THR = 8.f;
constexpr size_t SHM_V = KVBLK * D * 2, SHM_K = KVBLK * D * 2, SHM_ATTN = 2 * SHM_V + 2 * SHM_K + NW * 64 * 4;
#define KSWZ(row, colB) ((row) * 256 + ((colB) ^ (((row) & 7) << 4)))
#define SBAR() __builtin_amdgcn_sched_barrier(0)
__device__ __forceinline__ int crow(int r, int hi) { return (r & 3) + 8 * (r >> 2) + 4 * hi; }
__device__ __forceinline__ unsigned cvtpk(float lo, float hi) { unsigned r; asm volatile("v_cvt_pk_bf16_f32 %0, %1, %2" : "=v"(r) : "v"(lo), "v"(hi)); return r; }
__device__ __forceinline__ void partialSM(f32x16& p0, f32x16& p1, float& m_reg, float& mn, float& alpha) {
  constexpr float C = SCALE * 1.4426950408889634f;
  float pmax = p0[0];
#pragma unroll
  for (int r = 1; r < 16; ++r) pmax = fmaxf(pmax, p0[r]);
#pragma unroll
  for (int r = 0; r < 16; ++r) pmax = fmaxf(pmax, p1[r]);
  { auto rr = __builtin_amdgcn_permlane32_swap(__float_as_uint(pmax), __float_as_uint(pmax), false, false);
    pmax = fmaxf(__uint_as_float(rr[0]), __uint_as_float(rr[1])); }
  if (__builtin_expect(__all(pmax - m_reg <= THR / SCALE), 1)) { mn = m_reg; alpha = 1.f; }
  else { mn = fmaxf(m_reg, pmax); alpha = __builtin_amdgcn_exp2f((m_reg - mn) * C); m_reg = mn; }
  float mnC = -mn * C;
#pragma unroll
  for (int r = 0; r < 16; ++r) p0[r] = fmaf(p0[r], C, mnC);
#pragma unroll
  for (int r = 0; r < 16; ++r) p1[r] = fmaf(p1[r], C, mnC);
#pragma unroll
  for (int r = 0; r < 16; ++r) p0[r] = __builtin_amdgcn_exp2f(p0[r]);
}
__device__ __forceinline__ void finishSM(f32x16& p0, f32x16& p1, float alpha, float& l_reg, bf16x8& pa0, bf16x8& pa1, bf16x8& pa2, bf16x8& pa3) {
#pragma unroll
  for (int r = 0; r < 16; ++r) p1[r] = __builtin_amdgcn_exp2f(p1[r]);
  float ps = 0;
#pragma unroll
  for (int r = 0; r < 16; ++r) ps += p0[r];
#pragma unroll
  for (int r = 0; r < 16; ++r) ps += p1[r];
  { auto rr = __builtin_amdgcn_permlane32_swap(__float_as_uint(ps), __float_as_uint(ps), false, false);
    ps = __uint_as_float(rr[0]) + __uint_as_float(rr[1]); }
  l_reg = l_reg * alpha + ps;
#define PK4(P, BASE, OUT) do { unsigned a0 = cvtpk(P[BASE + 0], P[BASE + 1]), a1 = cvtpk(P[BASE + 2], P[BASE + 3]);   \
    unsigned b0 = cvtpk(P[BASE + 4], P[BASE + 5]), b1 = cvtpk(P[BASE + 6], P[BASE + 7]);                              \
    auto r0 = __builtin_amdgcn_permlane32_swap(a0, b0, false, false); auto r1 = __builtin_amdgcn_permlane32_swap(a1, b1, false, false); \
    u32x4 w = {r0[0], r1[0], r0[1], r1[1]}; OUT = *reinterpret_cast<bf16x8*>(&w); } while (0)
  PK4(p0, 0, pa0); PK4(p0, 8, pa1); PK4(p1, 0, pa2); PK4(p1, 8, pa3);
#undef PK4
}
__device__ __forceinline__ void qkt(f32x16& p0, f32x16& p1, const bf16_t* Ks, const bf16x8* qr, int r32, int hi) {
  p0 = f32x16{}; p1 = f32x16{};
#pragma unroll
  for (int d0 = 0; d0 < 8; ++d0) { int cb = (d0 * 16 + hi * 8) * 2;
    bf16x8 b0 = *reinterpret_cast<const bf16x8*>((const char*)Ks + KSWZ(r32, cb));
    bf16x8 b1 = *reinterpret_cast<const bf16x8*>((const char*)Ks + KSWZ(32 + r32, cb));
    p0 = __builtin_amdgcn_mfma_f32_32x32x16_bf16(b0, qr[d0], p0, 0, 0, 0);
    p1 = __builtin_amdgcn_mfma_f32_32x32x16_bf16(b1, qr[d0], p1, 0, 0, 0); }
}
__device__ __forceinline__ int v_st(int k, int c) { const int kk = (k & ~0xC) | ((k & 4) << 1) | ((k & 8) >> 1); return ((kk >> 3) * 4 + (c >> 5)) * 512 + ((kk & 7) * 32 + (c & 31)) * 2; }
__device__ __forceinline__ int v_rd_base(int lane) { return ((lane & 3) << 3) | (((lane >> 2) & 3) << 6) | (((lane >> 4) & 1) << 5) | (((lane >> 5) & 1) << 8); }
constexpr int v_rd_off(int d0, int ks, int half) { return d0 * 512 + ks * 4096 + half * 2048; }
template <int OFF> __device__ __forceinline__ s16x4 tr_read(int vb) {
  s16x4 r; asm volatile("ds_read_b64_tr_b16 %0, %1 offset:%2" : "=&v"(r) : "v"(vb), "i"(OFF) : "memory"); return r;
}
template <int D0> __device__ __forceinline__ void pv_one(f32x16& od, int vb, bf16x8 pa0, bf16x8 pa1, bf16x8 pa2, bf16x8 pa3) {
  const s16x4 l0 = tr_read<v_rd_off(D0, 0, 0)>(vb), h0 = tr_read<v_rd_off(D0, 0, 1)>(vb), l1 = tr_read<v_rd_off(D0, 1, 0)>(vb), h1 = tr_read<v_rd_off(D0, 1, 1)>(vb);
  const s16x4 l2 = tr_read<v_rd_off(D0, 2, 0)>(vb), h2 = tr_read<v_rd_off(D0, 2, 1)>(vb), l3 = tr_read<v_rd_off(D0, 3, 0)>(vb), h3 = tr_read<v_rd_off(D0, 3, 1)>(vb);
  asm volatile("s_waitcnt lgkmcnt(0)" ::: "memory"); SBAR();
#define PK(L, H) (bf16x8){L[0], L[1], L[2], L[3], H[0], H[1], H[2], H[3]}
  od = __builtin_amdgcn_mfma_f32_32x32x16_bf16(pa0, PK(l0, h0), od, 0, 0, 0);
  od = __builtin_amdgcn_mfma_f32_32x32x16_bf16(pa1, PK(l1, h1), od, 0, 0, 0);
  od = __builtin_amdgcn_mfma_f32_32x32x16_bf16(pa2, PK(l2, h2), od, 0, 0, 0);
  od = __builtin_amdgcn_mfma_f32_32x32x16_bf16(pa3, PK(l3, h3), od, 0, 0, 0);
#undef PK
}
__device__ __forceinline__ void pv_d0(f32x16* o, int vb, bf16x8 pa0, bf16x8 pa1, bf16x8 pa2, bf16x8 pa3) {
  pv_one<0>(o[0], vb, pa0, pa1, pa2, pa3); pv_one<1>(o[1], vb, pa0, pa1, pa2, pa3); pv_one<2>(o[2], vb, pa0, pa1, pa2, pa3); pv_one<3>(o[3], vb, pa0, pa1, pa2, pa3);
}
constexpr int LDQ = NPROJ, LDK = 256;
__device__ __forceinline__ void attn_dense_body(bf16_t* Qb, const bf16_t* __restrict__ Kh, const bf16_t* __restrict__ Vh, int seq, char* lds, const int tid, const float* __restrict__ qg, const float* __restrict__ rope, int s0, const bool STORE = true) {
  const int wid = tid >> 6, lane = tid & 63, r32 = lane & 31, hi = lane >> 5;
  bf16_t* V_lds = (bf16_t*)lds; bf16_t* K_lds = (bf16_t*)(lds + 2 * SHM_V);
  float* ws = (float*)(lds + 2 * SHM_V + 2 * SHM_K) + wid * 64; float* li_l = ws; float* al_l = ws + 32;
  float m_reg = -1e30f, l_reg = 0; f32x16 o[4] = {}; bf16x8 qr[8];
  const bf16_t* Qw = Qb + (long)(wid * QBLK + r32) * LDQ + hi * 8;
#pragma unroll
  for (int d0 = 0; d0 < 8; ++d0) qr[d0] = *reinterpret_cast<const bf16x8*>(Qw + d0 * 16);
  {
    float ss = 0.f;
#pragma unroll
    for (int d0 = 0; d0 < 8; ++d0) { const u32x4 w = __builtin_bit_cast(u32x4, qr[d0]);
#pragma unroll
      for (int e = 0; e < 4; ++e) { const float lo = __uint_as_float(w[e] << 16), hi_ = __uint_as_float(w[e] & 0xffff0000u); ss += lo * lo + hi_ * hi_; } }
    { auto rr = __builtin_amdgcn_permlane32_swap(__float_as_uint(ss), __float_as_uint(ss), false, false); ss = __uint_as_float(rr[0]) + __uint_as_float(rr[1]); }
    const float rinv = rsqrtf(ss * (1.0f / 128.0f) + LN_EPS);
    const int sp = s0 + wid * QBLK + r32;
#pragma unroll
    for (int a = 0; a < 2; ++a) {
      float qf[4][8];
#pragma unroll
      for (int dd = 0; dd < 4; ++dd) { const int d0 = a * 4 + dd; const u32x4 w = __builtin_bit_cast(u32x4, qr[d0]);
        const f32x4 g0 = *(const f32x4*)(qg + d0 * 16 + hi * 8), g1 = *(const f32x4*)(qg + d0 * 16 + hi * 8 + 4);
        qf[dd][0] = __uint_as_float(w[0] << 16) * (rinv * g0[0]); qf[dd][1] = __uint_as_float(w[0] & 0xffff0000u) * (rinv * g0[1]);
        qf[dd][2] = __uint_as_float(w[1] << 16) * (rinv * g0[2]); qf[dd][3] = __uint_as_float(w[1] & 0xffff0000u) * (rinv * g0[3]);
        qf[dd][4] = __uint_as_float(w[2] << 16) * (rinv * g1[0]); qf[dd][5] = __uint_as_float(w[2] & 0xffff0000u) * (rinv * g1[1]);
        qf[dd][6] = __uint_as_float(w[3] << 16) * (rinv * g1[2]); qf[dd][7] = __uint_as_float(w[3] & 0xffff0000u) * (rinv * g1[3]); }
      if (rope) { const int pos = a == 0 ? (sp >> 6) : (sp & 63);
#pragma unroll
        for (int dd = 0; dd < 2; ++dd) { const float* cp = rope + pos * 32 + dd * 16 + hi * 8;
          const f32x4 c0 = *(const f32x4*)cp, c1 = *(const f32x4*)(cp + 4), s0v = *(const f32x4*)(cp + 2048), s1v = *(const f32x4*)(cp + 2048 + 4);
#pragma unroll
          for (int e = 0; e < 4; ++e) { float x1 = qf[dd][e], x2 = qf[dd + 2][e]; qf[dd][e] = x1 * c0[e] - x2 * s0v[e]; qf[dd + 2][e] = x2 * c0[e] + x1 * s0v[e];
            x1 = qf[dd][4 + e]; x2 = qf[dd + 2][4 + e]; qf[dd][4 + e] = x1 * c1[e] - x2 * s1v[e]; qf[dd + 2][4 + e] = x2 * c1[e] + x1 * s1v[e]; } } }
#pragma unroll
      for (int dd = 0; dd < 4; ++dd) { u32x4 w; w.x = cvtpk(qf[dd][0], qf[dd][1]); w.y = cvtpk(qf[dd][2], qf[dd][3]); w.z = cvtpk(qf[dd][4], qf[dd][5]); w.w = cvtpk(qf[dd][6], qf[dd][7]); qr[a * 4 + dd] = __builtin_bit_cast(bf16x8, w); }
      asm volatile("" ::: "memory");
    }
  }
  int tid2 = tid; asm volatile("" : "+v"(tid2));
  const int sr = tid2 >> 4, sc = (tid2 & 15) * 8, vst0 = v_st(sr, sc), vst1 = v_st(32 + sr, sc);
  const int vb0 = (int)(uintptr_t)V_lds + v_rd_base(tid2 & 63);
  struct { bf16x8 vs0, vs1, ks0, ks1; } sr_[1];
#define LD8(p) (*reinterpret_cast<const bf16x8*>(p))
#define SLOAD(i, k0) do { sr_[i].vs0 = LD8(&Vh[(long)((k0) + sr) * LDK + sc]); sr_[i].vs1 = LD8(&Vh[(long)((k0) + 32 + sr) * LDK + sc]); \
    sr_[i].ks0 = LD8(&Kh[(long)((k0) + sr) * LDK + sc]); sr_[i].ks1 = LD8(&Kh[(long)((k0) + 32 + sr) * LDK + sc]); } while (0)
#define SWRITE(b, i) do { *(bf16x8*)((char*)V_lds + (b) * SHM_V + vst0) = sr_[i].vs0;          \
    *(bf16x8*)((char*)V_lds + (b) * SHM_V + vst1) = sr_[i].vs1; int kc = sc * 2;               \
    *(bf16x8*)((char*)K_lds + (b) * SHM_K + KSWZ(sr, kc)) = sr_[i].ks0;                       \
    *(bf16x8*)((char*)K_lds + (b) * SHM_K + KSWZ(32 + sr, kc)) = sr_[i].ks1; } while (0)
#define SWAIT() asm volatile("s_waitcnt vmcnt(0)" ::: "memory")
#define RESC(a) do { if (__any((a) < 1.f)) { if (hi == 0) al_l[r32] = (a); asm volatile("s_waitcnt lgkmcnt(0)" ::: "memory"); \
    _Pragma("unroll") for (int d = 0; d < 4; ++d) _Pragma("unroll") for (int r = 0; r < 16; ++r) o[d][r] *= al_l[crow(r, hi)]; } } while (0)
  f32x16 pA0, pA1, pB0, pB1; float mnA, mnB, alA, alB; bf16x8 pa0, pa1, pa2, pa3; const int NT = seq / KVBLK;
  constexpr int SE = 0, SO = 0;
  SLOAD(SE, 0); asm volatile("s_waitcnt vmcnt(0)" ::: "memory"); SWRITE(0, SE); __syncthreads();
  qkt(pA0, pA1, K_lds, qr, r32, hi); partialSM(pA0, pA1, m_reg, mnA, alA);
  SLOAD(SO, KVBLK);
  SWAIT(); SWRITE(1, SO); __syncthreads();
  for (int j = 1; j + 1 < NT; j += 2) {
    SBAR(); qkt(pB0, pB1, (bf16_t*)((char*)K_lds + SHM_K), qr, r32, hi);
    finishSM(pA0, pA1, alA, l_reg, pa0, pa1, pa2, pa3); SBAR();
    SLOAD(SO, (j + 1) * KVBLK); SBAR();
    pv_d0(o, vb0, pa0, pa1, pa2, pa3); partialSM(pB0, pB1, m_reg, mnB, alB);
    __syncthreads(); SWAIT(); SWRITE(0, SE);
    RESC(alB); __syncthreads();
    SBAR(); qkt(pA0, pA1, K_lds, qr, r32, hi);
    finishSM(pB0, pB1, alB, l_reg, pa0, pa1, pa2, pa3); SBAR();
    SLOAD(SE, (j + 2) * KVBLK); SBAR();
    pv_d0(o, vb0 + (int)SHM_V, pa0, pa1, pa2, pa3); partialSM(pA0, pA1, m_reg, mnA, alA);
    __syncthreads(); SWAIT(); SWRITE(1, SO);
    RESC(alA); __syncthreads();
  }
  SBAR(); qkt(pB0, pB1, (bf16_t*)((char*)K_lds + SHM_K), qr, r32, hi);
  finishSM(pA0, pA1, alA, l_reg, pa0, pa1, pa2, pa3); SBAR();
  pv_d0(o, vb0, pa0, pa1, pa2, pa3); partialSM(pB0, pB1, m_reg, mnB, alB);
  __syncthreads(); RESC(alB);
  finishSM(pB0, pB1, alB, l_reg, pa0, pa1, pa2, pa3); SBAR();
  pv_d0(o, vb0 + (int)SHM_V, pa0, pa1, pa2, pa3);
  if (hi == 0) li_l[r32] = l_reg; asm volatile("s_waitcnt lgkmcnt(0)" ::: "memory");
  float rli[16];
#pragma unroll
  for (int r = 0; r < 16; ++r) rli[r] = __builtin_amdgcn_rcpf(li_l[crow(r, hi)]);
  __syncthreads();
  { bf16_t* stg = (bf16_t*)lds + wid * 4096;
#pragma unroll
    for (int r = 0; r < 16; ++r) { const int orow = crow(r, hi);
#pragma unroll
      for (int d0 = 0; d0 < 4; ++d0) stg[orow * 128 + d0 * 32 + r32] = (bf16_t)(cvtpk(o[d0][r] * rli[r], 0.f) & 0xffffu); }
    asm volatile("s_waitcnt lgkmcnt(0)" ::: "memory");
    int le = lane; asm volatile("" : "+v"(le));
    bf16_t* Ow = Qb + (long)(wid * QBLK + (le >> 4)) * LDQ + (le & 15) * 8;
#pragma unroll
    for (int i = 0; i < 8; ++i) { const u32x4 v = *(const u32x4*)(stg + (i * 4 + (le >> 4)) * 128 + (le & 15) * 8); if (STORE) *(u32x4*)(Ow + (long)i * 4 * LDQ) = v; else asm volatile("" :: "v"(v)); }
  }
  __syncthreads();
#undef LD8
#undef SLOAD
#undef SWRITE
#undef SWAIT
#undef RESC
}
#undef KSWZ
#undef SBAR
}


#define XB_TMO      128
#define XB_XCNT(j)  (256  + 64 * (j))
#define XB_XSUB(j)  (1280 + 64 * (j))
#define XB_XGEN(j)  (2304 + 64 * (j))
#define XB_TOP      3328
#define XB_TOPGEN   3392
#define XCD_BAR_WORDS 3456
#define XB_SPIN_CAP (1u << 18)
__device__ __forceinline__ unsigned xb_ld(unsigned* p)              { return __hip_atomic_load(p, __ATOMIC_RELAXED, __HIP_MEMORY_SCOPE_AGENT); }
__device__ __forceinline__ unsigned xb_add(unsigned* p, unsigned v) { return __hip_atomic_fetch_add(p, v, __ATOMIC_RELAXED, __HIP_MEMORY_SCOPE_AGENT); }
__device__ __forceinline__ unsigned xb_xcc_id() { return (unsigned)__builtin_amdgcn_s_getreg((3 << 11) | 20) & 0xFu; }
#define XB_SPIN(cond, bar) do { unsigned _sp = 0; while (cond) { __builtin_amdgcn_s_sleep(1); \
    if ((++_sp & 255u) == 0u) { if (xb_ld(&(bar)[XB_TMO])) break; if (_sp > XB_SPIN_CAP) { atomicAdd(&(bar)[XB_TMO], 1u); break; } } } } while (0)
struct XcdBarrier { unsigned* bar; unsigned x; volatile LAS unsigned* st; };
__device__ __forceinline__ XcdBarrier xcd_barrier_post(unsigned* bar, volatile LAS unsigned* st) {
    XcdBarrier b; b.bar = bar; b.x = xb_xcc_id(); b.st = st;
    if (threadIdx.x == 0) (void)xb_add(&bar[XB_XCNT(b.x)], 1u);
    return b;
}
__device__ __forceinline__ void xcd_barrier_complete(unsigned* bar, unsigned x, unsigned& nloc, unsigned& nx) {
    const unsigned G = gridDim.x * gridDim.y * gridDim.z;
    unsigned sum, cnt, mine, sp = 0u;
    for (;;) {
        sum = 0u; cnt = 0u; mine = 0u;
#pragma unroll
        for (unsigned j = 0; j < 16; ++j) { const unsigned c = xb_ld(&bar[XB_XCNT(j)]); sum += c; cnt += (c > 0u) ? 1u : 0u; mine = (j == x) ? c : mine; }
        if (sum == G) break;
        __builtin_amdgcn_s_sleep(1);
        if ((++sp & 255u) == 0u) { if (xb_ld(&bar[XB_TMO])) break; if (sp > XB_SPIN_CAP) { atomicAdd(&bar[XB_TMO], 1u); break; } }
    }
    nloc = mine > 0u ? mine : 1u; nx = cnt > 0u ? cnt : 1u;
}
__device__ __forceinline__ void xcd_barrier(const XcdBarrier& b) {
    asm volatile("s_waitcnt vmcnt(0)" ::: "memory");
    __syncthreads();
    if (threadIdx.x == 0) {
        unsigned* bar = b.bar;
        __builtin_amdgcn_s_waitcnt(0);
        unsigned nloc = b.st[0], nx = b.st[1];
        if (nloc == 0u) { xcd_barrier_complete(bar, b.x, nloc, nx); b.st[0] = nloc; b.st[1] = nx; }
        const unsigned old = xb_add(&bar[XB_XSUB(b.x)], 1u);
        const unsigned gen = old / nloc;
        if (old + 1u == (gen + 1u) * nloc) {
            __builtin_amdgcn_fence(__ATOMIC_RELEASE, "agent");
            asm volatile("s_waitcnt vmcnt(0)" ::: "memory");
            const unsigned og = xb_add(&bar[XB_TOP], 1u);
            const unsigned tg = og / nx;
            if (og + 1u == (tg + 1u) * nx) xb_add(&bar[XB_TOPGEN], 1u);
            else XB_SPIN(xb_ld(&bar[XB_TOPGEN]) == tg, bar);
            __builtin_amdgcn_fence(__ATOMIC_ACQUIRE, "agent");
            xb_add(&bar[XB_XGEN(b.x)], 1u);
            asm volatile("s_waitcnt vmcnt(0)" ::: "memory");
        } else {
            XB_SPIN(xb_ld(&bar[XB_XGEN(b.x)]) == gen, bar);
            __builtin_amdgcn_fence(__ATOMIC_ACQUIRE, "agent");
            asm volatile("s_waitcnt vmcnt(0)" ::: "memory");
        }
    }
    __syncthreads();
}

struct Args { const float* in[25]; float* out; unsigned char* ws; int ph_lo, ph_hi; };

typedef const float* fptr_t;
typedef __attribute__((address_space(4))) const fptr_t* in_as4_t;
struct Frame {
    LAS unsigned char* lds; char* ldsg;
    int tid, lane, wave, G, bx, gw, NGW;
    const float* const* in;
    unsigned char* ws; float* out;
};
enum { I_XP = 0, I_XS, I_CK, I_CV, I_C, I_CCTX, I_WADA, I_BADA, I_WIN, I_QG, I_KG, I_WPG, I_PSC, I_WSGU, I_BSGU, I_WAO, I_WPO, I_WSO, I_WOUT, I_LN1G, I_LN1B, I_WF1, I_WF2, I_LN2G, I_LN2B };

__device__ __forceinline__ void tr_item(const float* W, int ldw, int src_col, int kb, bf16_t* WT, int ldt, int dst_row, int dst_k, LAS float* scr, int lane) {
    const int k0 = 64 * kb;
#pragma unroll 8
    for (int i = 0; i < 32; ++i) { const int kk = 2 * i + (lane >> 5); scr[kk * 33 + (lane & 31)] = W[(size_t)(k0 + kk) * ldw + src_col + (lane & 31)]; }
    asm volatile("s_waitcnt lgkmcnt(0)" ::: "memory");
    const int c = lane & 7;
#pragma unroll
    for (int j = 0; j < 4; ++j) { const int n = (lane >> 3) + 8 * j; const LAS float* s = scr + (8 * c) * 33 + n;
        u32x4 o; o.x = cvt_pk_bf16(s[0 * 33], s[1 * 33]); o.y = cvt_pk_bf16(s[2 * 33], s[3 * 33]); o.z = cvt_pk_bf16(s[4 * 33], s[5 * 33]); o.w = cvt_pk_bf16(s[6 * 33], s[7 * 33]);
        *(u32x4*)(WT + (size_t)(dst_row + n) * ldt + dst_k + k0 + 8 * c) = o; }
    asm volatile("s_waitcnt lgkmcnt(0)" ::: "memory");
}

__device__ __forceinline__ int win_src_col(int d) {
    if (d < 1024) return d;
    if (d < 1536) return 2048 + (d - 1024);
    if (d < 2048) return 1024 + (d - 1536);
    if (d < 2560) return 2560 + (d - 2048);
    if (d < 3072) return 1536 + (d - 2560);
    return d;
}

__device__ __forceinline__ void phase_prologue(Frame& F) {
    if (F.bx < 192) {
        const int l = F.bx / 96, nb = F.bx % 96;
        LAS float* sc = (LAS float*)F.lds;
        LAS float* red = (LAS float*)(F.lds + 9 * 1024 * 4);
        for (int idx = F.tid; idx < 9 * 1024; idx += 512) { const int v = idx >> 10, k = idx & 1023;
            const float x = v == 0 ? F.in[I_CCTX][k] : F.in[I_C][(v - 1) * 1024 + k]; sc[idx] = x / (1.0f + __expf(-x)); }
        __syncthreads();
        float acc[9];
#pragma unroll
        for (int v = 0; v < 9; ++v) acc[v] = 0.f;
        const float* wp = F.in[I_WADA] + ((size_t)l * 1024 + F.wave * 128) * 6144 + nb * 64 + F.lane;
#pragma unroll 8
        for (int k = 0; k < 128; ++k) { const float w = wp[(size_t)k * 6144];
#pragma unroll
            for (int v = 0; v < 9; ++v) acc[v] += sc[v * 1024 + F.wave * 128 + k] * w; }
#pragma unroll
        for (int v = 0; v < 9; ++v) red[(F.wave * 9 + v) * 64 + F.lane] = acc[v];
        __syncthreads();
        float* mod = (float*)(F.ws + WS_MOD);
        for (int idx = F.tid; idx < 576; idx += 512) { const int v = idx >> 6, ln = idx & 63; float s = 0.f;
#pragma unroll
            for (int w = 0; w < 8; ++w) s += red[(w * 9 + v) * 64 + ln];
            mod[(l * 9 + v) * 6144 + nb * 64 + ln] = s + F.in[I_BADA][l * 6144 + nb * 64 + ln]; }
        __syncthreads();
    }
    LAS float* scr = (LAS float*)(F.lds + F.wave * 8448);
    constexpr int N_WIN = 16 * 192, N_AO = 16 * 32, N_SO = 8 * 32, N_WO = 16 * 32, N_F1 = 16 * 176, N_F2 = 44 * 32, N_PE = 1024, N_WS = 128;
    constexpr int N_L = N_WIN + N_AO + N_SO + N_WO + N_F1 + N_F2 + N_PE + N_WS;
    constexpr int N_ALL = 2 * N_L + 32;
    for (int it = F.gw; it < N_ALL; it += F.NGW) {
        if (it >= 2 * N_L) {
            const int idx = (it - 2 * N_L) * 64 + F.lane; const int pos = idx >> 5, p = idx & 31;
            const float inv = powf(10000.0f, -(float)p / 32.0f); const float ang = (float)pos * inv;
            float* rope = (float*)(F.ws + WS_ROPE); rope[idx] = cosf(ang); rope[2048 + idx] = sinf(ang);
            continue;
        }
        const int l = it / N_L; int r = it % N_L;
        if (r < N_WIN) { const int kb = r / 192, nb = r % 192;
            tr_item(F.in[I_WIN] + (size_t)l * 1024 * 6144, 6144, win_src_col(nb * 32), kb, (bf16_t*)(F.ws + WS_WIN) + (size_t)l * 6144 * 1024, 1024, nb * 32, 0, scr, F.lane); continue; } r -= N_WIN;
        if (r < N_AO) { const int kb = r / 32, nb = r % 32;
            tr_item(F.in[I_WAO] + (size_t)l * 1024 * 1024, 1024, nb * 32, kb, (bf16_t*)(F.ws + WS_WM) + (size_t)l * 1024 * 2048, 2048, nb * 32, 0, scr, F.lane); continue; } r -= N_AO;
        if (r < N_SO) { const int kb = r / 32, nb = r % 32;
            tr_item(F.in[I_WSO] + (size_t)l * 512 * 1024, 1024, nb * 32, kb, (bf16_t*)(F.ws + WS_WM) + (size_t)l * 1024 * 2048, 2048, nb * 32, 1024, scr, F.lane); continue; } r -= N_SO;
        if (r < N_WO) { const int kb = r / 32, nb = r % 32;
            tr_item(F.in[I_WOUT] + (size_t)l * 1024 * 1024, 1024, nb * 32, kb, (bf16_t*)(F.ws + WS_WOUT) + (size_t)l * 1024 * 1024, 1024, nb * 32, 0, scr, F.lane); continue; } r -= N_WO;
        if (r < N_F1) { const int kb = r / 176, nb = r % 176; const int drow = nb * 32; const int pn = drow >> 8, j = drow & 255;
            const int src = j < 128 ? pn * 128 + j : DFF + pn * 128 + (j - 128);
            tr_item(F.in[I_WF1] + (size_t)l * 1024 * 5632, 5632, src, kb, (bf16_t*)(F.ws + WS_WF1) + (size_t)l * 5632 * 1024, 1024, drow, 0, scr, F.lane); continue; } r -= N_F1;
        if (r < N_F2) { const int kb = r / 32, nb = r % 32;
            tr_item(F.in[I_WF2] + (size_t)l * DFF * 1024, 1024, nb * 32, kb, (bf16_t*)(F.ws + WS_WF2) + (size_t)l * 1024 * DFF, DFF, nb * 32, 0, scr, F.lane); continue; } r -= N_F2;
        if (r < N_PE) {
            const int kg = r >> 4, nb = r & 15; const int k0 = kg * 8, g = k0 >> 7; const int n = nb * 64 + F.lane;
            const float* wpg = F.in[I_WPG] + ((size_t)(l * 4 + g) * 128 + (k0 & 127)) * 128;
            const float* psc = F.in[I_PSC] + l * 512 + g * 128;
            const float* wpo = F.in[I_WPO] + ((size_t)l * 512 + g * 128) * 1024 + n;
            float a[8];
#pragma unroll
            for (int i = 0; i < 8; ++i) a[i] = 0.f;
#pragma unroll 4
            for (int j = 0; j < 128; ++j) { const float w = wpo[(size_t)j * 1024] * psc[j];
#pragma unroll
                for (int i = 0; i < 8; ++i) a[i] += wpg[i * 128 + j] * w; }
            u32x4 o; o.x = cvt_pk_bf16(a[0], a[1]); o.y = cvt_pk_bf16(a[2], a[3]); o.z = cvt_pk_bf16(a[4], a[5]); o.w = cvt_pk_bf16(a[6], a[7]);
            *(u32x4*)((bf16_t*)(F.ws + WS_WM) + (size_t)l * 1024 * 2048 + (size_t)n * 2048 + 1536 + k0) = o;
            continue; } r -= N_PE;
        {
            const size_t e0 = (size_t)l * 65536 + (size_t)r * 512 + F.lane * 8;
            const f32x4 a = *(const f32x4*)(F.in[I_WSGU] + e0), b = *(const f32x4*)(F.in[I_WSGU] + e0 + 4);
            u32x4 o; o.x = cvt_pk_bf16(a[0], a[1]); o.y = cvt_pk_bf16(a[2], a[3]); o.z = cvt_pk_bf16(b[0], b[1]); o.w = cvt_pk_bf16(b[2], b[3]);
            *(u32x4*)((bf16_t*)(F.ws + WS_WSGU) + e0) = o;
        }
    }
}

__device__ __forceinline__ const float* x0_row(Frame& F, int t) { return t < T_CTX ? F.in[I_XP] + (size_t)t * DM : F.in[I_XS] + (size_t)(t - T_CTX) * DM; }
__device__ __forceinline__ int vec_of_row(int t) { return t < T_CTX ? 0 : 1 + ((t - T_CTX) >> 12); }

__device__ __forceinline__ void phase_h0(Frame& F) {
    const float* mod = (const float*)(F.ws + WS_MOD);
    bf16_t* act = (bf16_t*)(F.ws + WS_ACT);
    for (int t = F.gw; t < T_ALL; t += F.NGW) {
        const f32x4* xr = (const f32x4*)x0_row(F, t) + F.lane;
        const float* mv = mod + vec_of_row(t) * 6144;
        unsigned long long* o8 = (unsigned long long*)(act + (size_t)t * DM) + F.lane;
#pragma unroll
        for (int j = 0; j < 4; ++j) { const f32x4 x = xr[64 * j]; const int c = 256 * j + 4 * F.lane;
            const f32x4 sh = *(const f32x4*)(mv + c), sc = *(const f32x4*)(mv + 1024 + c);
            const f32x4 h = x * (sc + 1.0f) + sh;
            o8[64 * j] = (unsigned long long)cvt_pk_bf16(h[0], h[1]) | ((unsigned long long)cvt_pk_bf16(h[2], h[3]) << 32); }
    }
}

__device__ __forceinline__ void phase_ln(Frame& F, const float* lg, const float* lb, const float* modl  , int sh_off, int sc_off, const bool dry = false) {
    float* X = F.out; bf16_t* act = (bf16_t*)(F.ws + WS_ACT);
    for (int t = F.gw; t < T_ALL; t += F.NGW) {
        f32x4* xr = (f32x4*)(X + (size_t)t * DM) + F.lane;
        f32x4 v[4]; float s = 0.f;
#pragma unroll
        for (int j = 0; j < 4; ++j) { v[j] = xr[64 * j]; s += (v[j][0] + v[j][1]) + (v[j][2] + v[j][3]); }
        const float mean = wave_sum(s) * (1.f / DM); float s2 = 0.f;
#pragma unroll
        for (int j = 0; j < 4; ++j) { v[j] = v[j] - mean; s2 += (v[j][0] * v[j][0] + v[j][1] * v[j][1]) + (v[j][2] * v[j][2] + v[j][3] * v[j][3]); }
        const float rstd = rsqrtf(wave_sum(s2) * (1.f / DM) + LN_EPS);
        const float* mv = modl ? modl + vec_of_row(t) * 6144 : nullptr;
        unsigned long long* o8 = (unsigned long long*)(act + (size_t)t * DM) + F.lane;
#pragma unroll
        for (int j = 0; j < 4; ++j) { const int c = 256 * j + 4 * F.lane;
            const f32x4 g = *(const f32x4*)(lg + c), b = *(const f32x4*)(lb + c);
            const f32x4 y = v[j] * rstd * g + b; if (!dry) xr[64 * j] = y; else { asm volatile("" :: "v"(y)); continue; }
            if (mv) { const f32x4 sh = *(const f32x4*)(mv + sh_off + c), sc = *(const f32x4*)(mv + sc_off + c);
                const f32x4 h = y * (sc + 1.0f) + sh;
                o8[64 * j] = (unsigned long long)cvt_pk_bf16(h[0], h[1]) | ((unsigned long long)cvt_pk_bf16(h[2], h[3]) << 32); } }
    }
}

__device__ __forceinline__ void load16h(const bf16_t* p, int j, float (&x)[16]) {
#pragma unroll
    for (int a = 0; a < 2; ++a)
#pragma unroll
        for (int hf = 0; hf < 2; ++hf) { const u32x2 w = *(const u32x2*)(p + a * 64 + hf * 32 + 4 * j);
            x[(a * 2 + hf) * 4 + 0] = bf_lo(w.x); x[(a * 2 + hf) * 4 + 1] = bf_hi(w.x); x[(a * 2 + hf) * 4 + 2] = bf_lo(w.y); x[(a * 2 + hf) * 4 + 3] = bf_hi(w.y); }
}
__device__ __forceinline__ void rmsn(float (&x)[16], const float (&g)[16]) {
    float ss = 0.f;
#pragma unroll
    for (int i = 0; i < 16; ++i) ss += x[i] * x[i];
    ss += __shfl_xor(ss, 1); ss += __shfl_xor(ss, 2); ss += __shfl_xor(ss, 4);
    const float rinv = rsqrtf(ss * (1.0f / 128.0f) + LN_EPS);
#pragma unroll
    for (int i = 0; i < 16; ++i) x[i] = x[i] * rinv * g[i];
}
__device__ __forceinline__ void rope16(float (&x)[16], const float* rope, int rowpos, int colpos, int j) {
#pragma unroll
    for (int a = 0; a < 2; ++a) { const int pos = a == 0 ? rowpos : colpos;
        const f32x4 c = *(const f32x4*)(rope + pos * 32 + 4 * j), s = *(const f32x4*)(rope + 2048 + pos * 32 + 4 * j);
#pragma unroll
        for (int e = 0; e < 4; ++e) { const float x1 = x[(a * 2) * 4 + e], x2 = x[(a * 2 + 1) * 4 + e];
            x[(a * 2) * 4 + e] = x1 * c[e] - x2 * s[e]; x[(a * 2 + 1) * 4 + e] = x2 * c[e] + x1 * s[e]; } }
}
__device__ __forceinline__ void store16h(bf16_t* p, int j, const float (&x)[16]) {
#pragma unroll
    for (int a = 0; a < 2; ++a)
#pragma unroll
        for (int hf = 0; hf < 2; ++hf) { u32x2 w; w.x = cvt_pk_bf16(x[(a * 2 + hf) * 4 + 0], x[(a * 2 + hf) * 4 + 1]); w.y = cvt_pk_bf16(x[(a * 2 + hf) * 4 + 2], x[(a * 2 + hf) * 4 + 3]);
            *(u32x2*)(p + a * 64 + hf * 32 + 4 * j) = w; }
}

__device__ __forceinline__ void phase_mid(Frame& F, int l, int part, const bool dry = false) {
    bf16_t* proj = (bf16_t*)(F.ws + WS_PROJ);
    const float* rope = (const float*)(F.ws + WS_ROPE);
    bf16_t* vrt = (bf16_t*)(F.ws + WS_VRT);
    bf16_t* KL = (bf16_t*)(F.ws + WS_KL); bf16_t* VL = (bf16_t*)(F.ws + WS_VL); bf16_t* KC = (bf16_t*)(F.ws + WS_KC); bf16_t* VC = (bf16_t*)(F.ws + WS_VC);
    float* outk = F.out + (size_t)T_ALL * DM; float* outv = outk + (size_t)16 * 2 * 256 * 256;
    const int lane = F.lane, hj = lane & 7;
    const int n8 = part_rows(part) / 4, ncache = 4 * PAST;
    float qg[16], kg[16];
#pragma unroll
    for (int a = 0; a < 2; ++a)
#pragma unroll
        for (int hf = 0; hf < 2; ++hf)
#pragma unroll
            for (int e = 0; e < 4; ++e) { const int d = a * 64 + hf * 32 + 4 * hj + e; qg[(a * 2 + hf) * 4 + e] = F.in[I_QG][l * 128 + d]; kg[(a * 2 + hf) * 4 + e] = F.in[I_KG][l * 128 + d]; }
    for (int it = F.gw; it < n8 + ncache; it += F.NGW) {
        if (it >= n8) {
            const int cr = it - n8; const int bl = cr >> 9, s = cr & 511; const int b = part * 4 + bl;
            const size_t src = (((size_t)b * 2 + l) * PAST + s) * 256 + lane * 4;
            const f32x4 kx = *(const f32x4*)(F.in[I_CK] + src), vx = *(const f32x4*)(F.in[I_CV] + src);
            const size_t dst = ((size_t)bl * SKV_LAT + s) * 256 + lane * 4;
            u32x2 kw, vw; kw.x = cvt_pk_bf16(kx[0], kx[1]); kw.y = cvt_pk_bf16(kx[2], kx[3]); vw.x = cvt_pk_bf16(vx[0], vx[1]); vw.y = cvt_pk_bf16(vx[2], vx[3]);
            if (!dry) { *(u32x2*)(KL + dst) = kw; *(u32x2*)(VL + dst) = vw; } else asm volatile("" :: "v"(kw), "v"(vw));
            continue;
        }
        const int lr0 = it * 4, t0 = part_row0(part) + lr0;
        const bool is_ctx = t0 < T_CTX;
        bf16_t* P0 = proj + (size_t)lr0 * NPROJ;
        {
            float val[4][8];
#pragma unroll
            for (int i = 0; i < 4; ++i) { const u32x4 w = *(const u32x4*)(P0 + (size_t)i * NPROJ + PC_XV + lane * 8);
#pragma unroll
                for (int e = 0; e < 4; ++e) { val[i][2 * e] = gelu1(bf_lo(w[e])); val[i][2 * e + 1] = gelu1(bf_hi(w[e])); } }
#pragma unroll
            for (int i = 0; i < 4; ++i) { float s = 0.f;
#pragma unroll
                for (int e = 0; e < 8; ++e) s += val[i][e];
                const float mean = wave_sum(s) * (1.0f / 512.0f); float s2 = 0.f;
#pragma unroll
                for (int e = 0; e < 8; ++e) { val[i][e] -= mean; s2 += val[i][e] * val[i][e]; }
                const float rstd = rsqrtf(wave_sum(s2) * (1.0f / 512.0f) + LN_EPS);
#pragma unroll
                for (int e = 0; e < 8; ++e) val[i][e] *= rstd; }
            const int chunk = lr0 >> 7, q0 = lr0 & 127;
            bf16_t* vb = vrt + ((size_t)chunk * 512 + lane * 8) * 128 + q0;
#pragma unroll
            for (int e = 0; e < 8; ++e) { u32x2 o; o.x = cvt_pk_bf16(val[0][e], val[1][e]); o.y = cvt_pk_bf16(val[2][e], val[3][e]);
                if (!dry) *(u32x2*)(vb + (size_t)e * 128) = o; else asm volatile("" :: "v"(o)); }
        }
#pragma unroll 1
        for (int i = 0; i < 4; ++i) {
            bf16_t* Pr = P0 + (size_t)i * NPROJ; const int t = t0 + i;
            int spos, seqS, rowpos = 0, colpos = 0, bl = 0;
            if (is_ctx) { spos = t & 255; seqS = CTX_S; } else { const int tl = t - T_CTX; spos = tl & 4095; seqS = LAT_S; rowpos = spos >> 6; colpos = spos & 63; bl = (tl >> 12) - part * 4; }
            float x[16];
            const int kh = (lane >> 3) & 1;
            u32x2 kw[4];
#pragma unroll
            for (int a = 0; a < 2; ++a)
#pragma unroll
                for (int hf = 0; hf < 2; ++hf) kw[a * 2 + hf] = *(const u32x2*)(Pr + PC_K + kh * 128 + a * 64 + hf * 32 + 4 * hj);
            const int vi = (lane - 16) & 31;
            const u32x4 vw = *(const u32x4*)(Pr + PC_V + vi * 8);
            f32x4 rcv[2], rsv[2];
#pragma unroll
            for (int a = 0; a < 2; ++a) { const int pos = a == 0 ? rowpos : colpos; rcv[a] = *(const f32x4*)(rope + pos * 32 + 4 * hj); rsv[a] = *(const f32x4*)(rope + 2048 + pos * 32 + 4 * hj); }
            float pacc[8], pself[8];
            {
                const int hw = 1 << (lane >> 4);
                const int lo = max(spos - hw, 0), hi = min(spos + hw, seqS);
#pragma unroll
                for (int e = 0; e < 8; ++e) pacc[e] = 0.f;
                u32x4 pw[16];
#pragma unroll
                for (int k = 0; k < 16; ++k) { const int dd = k - 8, sp = spos + dd; const bool ok = (sp >= lo) && (sp < hi);
                    pw[k] = *(const u32x4*)(Pr + (long)(ok ? dd : 0) * NPROJ + PC_XP + lane * 8); }
#pragma unroll
                for (int k = 0; k < 16; ++k) { const int sp = spos + k - 8; const float mk = ((sp >= lo) && (sp < hi)) ? 1.0f : 0.0f;
#pragma unroll
                    for (int e = 0; e < 4; ++e) { pacc[2 * e] += mk * bf_lo(pw[k][e]); pacc[2 * e + 1] += mk * bf_hi(pw[k][e]); } }
#pragma unroll
                for (int e = 0; e < 4; ++e) { pself[2 * e] = bf_lo(pw[8][e]); pself[2 * e + 1] = bf_hi(pw[8][e]); }
                const float rc = 1.0f / (float)(hi - lo);
#pragma unroll
                for (int e = 0; e < 8; ++e) pacc[e] = pacc[e] * rc - pself[e];
            }
#pragma unroll
            for (int q4 = 0; q4 < 4; ++q4) { x[q4 * 4 + 0] = bf_lo(kw[q4].x); x[q4 * 4 + 1] = bf_hi(kw[q4].x); x[q4 * 4 + 2] = bf_lo(kw[q4].y); x[q4 * 4 + 3] = bf_hi(kw[q4].y); }
            rmsn(x, kg);
            if (dry) { asm volatile("" :: "v"(x[0]), "v"(x[7]), "v"(vw), "v"(pacc[0]), "v"(pacc[7])); continue; }
            if (is_ctx) {
                if (lane < 16) {
                    float* ok = outk + (((size_t)(t >> 8) * 2 + l) * 256 + (t & 255)) * 256 + kh * 128;
#pragma unroll
                    for (int a = 0; a < 2; ++a)
#pragma unroll
                        for (int hf = 0; hf < 2; ++hf) *(f32x4*)(ok + a * 64 + hf * 32 + 4 * hj) = (f32x4){x[(a * 2 + hf) * 4], x[(a * 2 + hf) * 4 + 1], x[(a * 2 + hf) * 4 + 2], x[(a * 2 + hf) * 4 + 3]};
                    store16h(KC + (size_t)t * 256 + kh * 128, hj, x);
                }
                if (lane >= 16 && lane < 48) {
                    float* ov = outv + (((size_t)(t >> 8) * 2 + l) * 256 + (t & 255)) * 256 + vi * 8;
                    *(f32x4*)ov = (f32x4){bf_lo(vw[0]), bf_hi(vw[0]), bf_lo(vw[1]), bf_hi(vw[1])};
                    *(f32x4*)(ov + 4) = (f32x4){bf_lo(vw[2]), bf_hi(vw[2]), bf_lo(vw[3]), bf_hi(vw[3])};
                    *(u32x4*)(VC + (size_t)t * 256 + vi * 8) = vw;
                }
            } else {
#pragma unroll
                for (int a = 0; a < 2; ++a)
#pragma unroll
                    for (int e = 0; e < 4; ++e) { const float x1 = x[(a * 2) * 4 + e], x2 = x[(a * 2 + 1) * 4 + e];
                        x[(a * 2) * 4 + e] = x1 * rcv[a][e] - x2 * rsv[a][e]; x[(a * 2 + 1) * 4 + e] = x2 * rcv[a][e] + x1 * rsv[a][e]; }
                const size_t krow = ((size_t)bl * SKV_LAT + PAST + spos) * 256;
                if (lane < 16) store16h(KL + krow + kh * 128, hj, x);
                if (lane >= 16 && lane < 48) *(u32x4*)(VL + krow + vi * 8) = vw;
            }
            { u32x4 o; o.x = cvt_pk_bf16(pacc[0], pacc[1]); o.y = cvt_pk_bf16(pacc[2], pacc[3]); o.z = cvt_pk_bf16(pacc[4], pacc[5]); o.w = cvt_pk_bf16(pacc[6], pacc[7]);
              *(u32x4*)(Pr + PC_K + lane * 8) = o; }
        }
    }
}

__device__ __forceinline__ void phase_attn(Frame& F, int l, int part, const bool sgu_only_dry = false) {
    bf16_t* proj = (bf16_t*)(F.ws + WS_PROJ);
    const bf16_t* KL = (const bf16_t*)(F.ws + WS_KL); const bf16_t* VL = (const bf16_t*)(F.ws + WS_VL); const bf16_t* KC = (const bf16_t*)(F.ws + WS_KC); const bf16_t* VC = (const bf16_t*)(F.ws + WS_VC);
    const int lat_row0 = part == 0 ? T_CTX : 0;
    if (!sgu_only_dry) {
        int pair, idx, step; int rep = 0;
        const bool xcdmap = (F.G % 8) == 0;
        if (xcdmap) { pair = F.bx & 7; idx = F.bx >> 3; step = F.G >> 3; } else { pair = 0; idx = F.bx; step = F.G; }
        for (;;) {
            int pr = pair, ix = idx;
            if (!xcdmap) { pr = idx >> 6; ix = idx & 63; if (idx >= 512) break; } else if (idx >= 64) break;
            const int bl = pr >> 1, kvh = pr & 1, h = kvh * 4 + (ix >> 4), qb = ix & 15;
            bf16_t* Qb = proj + (size_t)(lat_row0 + bl * LAT_S + qb * 256) * NPROJ + PC_Q + h * 128;
            att::attn_dense_body(Qb, KL + (size_t)bl * SKV_LAT * 256 + kvh * 128, VL + (size_t)bl * SKV_LAT * 256 + kvh * 128, SKV_LAT, F.ldsg, F.tid, F.in[I_QG] + l * 128, (const float*)(F.ws + WS_ROPE), qb * 256, PROBE == 3 ? rep == 1 : true);
            if (PROBE == 3) { if (rep == 0) { rep = 1; continue; } rep = 0; }
            idx += step;
        }
    }
    if (part == 0 && !sgu_only_dry) {
        for (int u = F.bx; u < 128; u += F.G) { const int b = u >> 3, h = u & 7;
            bf16_t* Qb = proj + (size_t)(b * 256) * NPROJ + PC_Q + h * 128;
            att::attn_dense_body(Qb, KC + (size_t)b * 256 * 256 + (h >> 2) * 128, VC + (size_t)b * 256 * 256 + (h >> 2) * 128, CTX_S, F.ldsg, F.tid, F.in[I_QG] + l * 128, (const float*)nullptr, 0); }
    }
    const bf16_t* vrt = (const bf16_t*)(F.ws + WS_VRT);
    const bf16_t* wsb = (const bf16_t*)(F.ws + WS_WSGU) + (size_t)l * 65536;
    const float* bs = F.in[I_BSGU] + l * 512;
    const int nitem = (part_rows(part) / 128) * 32;
    const int ln = F.lane & 15, quad = F.lane >> 4;
    for (int it = F.NGW - 1 - F.gw; it < nitem; it += F.NGW) {
        const int chunk = it >> 5, g = (it >> 3) & 3, cb = (it >> 1) & 3, pb = it & 1;
        f32x4 acc[2][4];
#pragma unroll
        for (int a = 0; a < 2; ++a)
#pragma unroll
            for (int b = 0; b < 4; ++b) acc[a][b] = (f32x4){0.f, 0.f, 0.f, 0.f};
        const bf16_t* ap = vrt + ((size_t)chunk * 512 + g * 128 + cb * 32 + ln) * 128 + quad * 8;
        const bf16_t* bp = wsb + ((size_t)g * 128 + pb * 64 + ln) * 128 + quad * 8;
        u32x2 xw[4][2];
#pragma unroll
        for (int pt = 0; pt < 4; ++pt)
#pragma unroll
            for (int ct = 0; ct < 2; ++ct) xw[pt][ct] = *(const u32x2*)(proj + (size_t)(chunk * 128 + pb * 64 + pt * 16 + ln) * NPROJ + PC_U + g * 128 + cb * 32 + ct * 16 + quad * 4);
#pragma unroll
        for (int ks = 0; ks < 4; ++ks) {
            bf16x8 af[2], bfr[4];
#pragma unroll
            for (int ct = 0; ct < 2; ++ct) af[ct] = *(const bf16x8*)(ap + ct * 16 * 128 + ks * 32);
#pragma unroll
            for (int pt = 0; pt < 4; ++pt) bfr[pt] = *(const bf16x8*)(bp + pt * 16 * 128 + ks * 32);
#pragma unroll
            for (int ct = 0; ct < 2; ++ct)
#pragma unroll
                for (int pt = 0; pt < 4; ++pt) acc[ct][pt] = __builtin_amdgcn_mfma_f32_16x16x32_bf16(af[ct], bfr[pt], acc[ct][pt], 0, 0, 0);
        }
#pragma unroll
        for (int pt = 0; pt < 4; ++pt) { const int p = pb * 64 + pt * 16 + ln; const float bsv = bs[g * 128 + p];
#pragma unroll
            for (int ct = 0; ct < 2; ++ct) { const int c = g * 128 + cb * 32 + ct * 16 + quad * 4;
                bf16_t* up = proj + (size_t)(chunk * 128 + p) * NPROJ + PC_U + c;
                const u32x2 w = xw[pt][ct];
                const float u0 = gelu1(bf_lo(w.x)), u1 = gelu1(bf_hi(w.x)), u2 = gelu1(bf_lo(w.y)), u3 = gelu1(bf_hi(w.y));
                const f32x4 a = acc[ct][pt];
                u32x2 o; o.x = cvt_pk_bf16(u0 * (a[0] + bsv), u1 * (a[1] + bsv)); o.y = cvt_pk_bf16(u2 * (a[2] + bsv), u3 * (a[3] + bsv));
                if (!sgu_only_dry) *(u32x2*)up = o; else asm volatile("" :: "v"(o)); } }
    }
}

constexpr int NPL = 11, NPHASE = 2 + DEPTH * NPL;
__global__ void __launch_bounds__(NW * 64, 2) fwd_kernel(Args args) {
    extern __shared__ __attribute__((aligned(16))) unsigned char lds[];
    Frame F;
    F.lds = (LAS unsigned char*)lds; F.ldsg = (char*)lds;
    F.G = gridDim.x; F.bx = blockIdx.x; F.NGW = F.G * NW;
    F.in = args.in; F.ws = args.ws; F.out = args.out;
    const float* mod = (const float*)(F.ws + WS_MOD);
    bf16_t* act = (bf16_t*)(F.ws + WS_ACT); bf16_t* proj = (bf16_t*)(F.ws + WS_PROJ);
    volatile LAS unsigned* bst = (volatile LAS unsigned*)(F.lds + 131072 + 64);
    unsigned* barw = (unsigned*)(F.ws + WS_BAR);
    const int wave0 = __builtin_amdgcn_readfirstlane((int)threadIdx.x >> 6);
    { unsigned z0 = 0u; asm volatile("" : "+v"(z0)); int t0 = wave0 * 64 + (int)__builtin_amdgcn_mbcnt_hi(~0u, __builtin_amdgcn_mbcnt_lo(~0u, z0));
      if (t0 < 2) bst[t0] = 0u;
      if (blockIdx.x == 0 && args.ph_lo == 0) { for (int i = t0; i < XCD_BAR_WORDS; i += NW * 64) barw[i] = 0u;
        unsigned* cw = (unsigned*)(F.ws + WS_CNT); for (int i = t0; i < CNT_WORDS; i += NW * 64) cw[i] = 0u; } }
    __syncthreads();
    XcdBarrier xbar; xbar.bar = barw; xbar.x = 0; xbar.st = bst;
    for (int ph = args.ph_lo; ph < args.ph_hi; ++ph) {
        { unsigned zz = 0u; asm volatile("" : "+v"(zz)); const int lanev = (int)__builtin_amdgcn_mbcnt_hi(~0u, __builtin_amdgcn_mbcnt_lo(~0u, zz));
          F.lane = lanev; F.wave = wave0; F.tid = wave0 * 64 + lanev; F.gw = F.bx * NW + F.wave; }

#ifndef PHMASK
#define PHMASK 0xffff
#endif
        if (ph == 0) { if (PHMASK & 1) phase_prologue(F); if (PROBE == 4) { __syncthreads(); phase_prologue(F); } }
        else if (ph == 1) { if (PHMASK & 2) phase_h0(F); if (PROBE == 4) phase_h0(F); }
        else {
            const int l = (ph - 2) / NPL, s = (ph - 2) % NPL;
            if (s < 8) {
                const int part = s >> 2, q = s & 3;
                if (q == 0) { if (PHMASK & 4) {
                    pg8::Gemm g{}; g.A = act + (size_t)part_row0(part) * DM; g.Bt = (const bf16_t*)(F.ws + WS_WIN) + (size_t)l * NPROJ * DM; g.lda = DM; g.ldb = DM;
                    g.nM = part_rows(part) / 256; g.nN = NPROJ / 256; g.nseg = 1; g.k0[0] = 0; g.nt[0] = 16; g.k0[1] = 0; g.nt[1] = 16; g.k0[2] = 0; g.nt[2] = 16;
                    pg8::Order S; S.init(g.nM, g.nN, 1, F.G, F.bx, 0, STAGGER);
                    pg8::EpiStore E{proj, NPROJ, PC_G};
                    if (PROBE == 2) { pg8::EpiNone E0; pg8::gemm_phase<pg8::EpiNone>(F.lds, g, S, E0, F.tid); }
                    if (PROBE == 7) pg8::gemm_phase<pg8::EpiStore>(F.lds, g, S, E, F.tid);
                    pg8::gemm_phase<pg8::EpiStore>(F.lds, g, S, E, F.tid); }
                } else if (q == 1) { if (PROBE == 5) phase_mid(F, l, part, true); if (PHMASK & 8) phase_mid(F, l, part, false); }
                else if (q == 2) { if (PROBE == 6) phase_attn(F, l, part, true); if (PHMASK & 16) phase_attn(F, l, part, false); }
                else if (PHMASK & 32) {
                    pg8::Gemm g{}; g.A = proj; g.Bt = (const bf16_t*)(F.ws + WS_WM) + (size_t)l * DM * 2048; g.lda = NPROJ; g.ldb = 2048;
                    g.nM = part_rows(part) / 256; g.nN = 4; g.nseg = 3; g.k0[0] = 0; g.nt[0] = 16; g.k0[1] = 1024; g.nt[1] = 8; g.k0[2] = 1536; g.nt[2] = 8;
                    pg8::Order S; S.init(g.nM, g.nN, 3, F.G, F.bx);
                    pg8::EpiGate E{F.lds + LDS_XCH, proj, act + (size_t)part_row0(part) * DM, DM};
                    if (PROBE == 2) { pg8::EpiNone E0; pg8::gemm_phase<pg8::EpiNone>(F.lds, g, S, E0, F.tid); }
                    pg8::gemm_phase<pg8::EpiGate>(F.lds, g, S, E, F.tid);
                }
            } else if (s == 8) { if (PHMASK & 64) {
                pg8::Gemm g{}; g.A = act; g.Bt = (const bf16_t*)(F.ws + WS_WOUT) + (size_t)l * DM * DM; g.lda = DM; g.ldb = DM;
                g.nM = T_ALL / 256; g.nN = 4; g.nseg = 1; g.k0[0] = 0; g.nt[0] = 16; g.k0[1] = 0; g.nt[1] = 16; g.k0[2] = 0; g.nt[2] = 16;
                pg8::Order S; S.init(g.nM, g.nN, 1, F.G, F.bx, 1);
                if (l == 0) { pg8::EpiResidLn<0, true, false> E{F.in, F.ws, F.out, l, F.lds + LDS_XCH}; pg8::gemm_phase<pg8::EpiResidLn<0, true, false>>(F.lds, g, S, E, F.tid); }
                else { pg8::EpiResidLn<0, false, false> E{F.in, F.ws, F.out, l, F.lds + LDS_XCH}; pg8::gemm_phase<pg8::EpiResidLn<0, false, false>>(F.lds, g, S, E, F.tid); } }
            } else if (s == 9) { if (PHMASK & 256) {
                pg8::Gemm g{}; g.A = act; g.Bt = (const bf16_t*)(F.ws + WS_WF1) + (size_t)l * 2 * DFF * DM; g.lda = DM; g.ldb = DM;
                g.nM = T_ALL / 256; g.nN = 2 * DFF / 256; g.nseg = 1; g.k0[0] = 0; g.nt[0] = 16; g.k0[1] = 0; g.nt[1] = 16; g.k0[2] = 0; g.nt[2] = 16;
                pg8::Order S; S.init(g.nM, g.nN, 1, F.G, F.bx, 0, STAGGER);
                pg8::EpiSwiGLU E{proj, DFF};
                if (PROBE == 2) { pg8::EpiNone E0; pg8::gemm_phase<pg8::EpiNone>(F.lds, g, S, E0, F.tid); }
                if (PROBE == 7) pg8::gemm_phase<pg8::EpiSwiGLU>(F.lds, g, S, E, F.tid);
                pg8::gemm_phase<pg8::EpiSwiGLU>(F.lds, g, S, E, F.tid); }
            } else { if (PHMASK & 512) {
                pg8::Gemm g{}; g.A = proj; g.Bt = (const bf16_t*)(F.ws + WS_WF2) + (size_t)l * DM * DFF; g.lda = DFF; g.ldb = DFF;
                g.nM = T_ALL / 256; g.nN = 4; g.nseg = 1; g.k0[0] = 0; g.nt[0] = 44; g.k0[1] = 0; g.nt[1] = 44; g.k0[2] = 0; g.nt[2] = 44;
                pg8::Order S; S.init(g.nM, g.nN, 1, F.G, F.bx, 1);
                if (l + 1 < DEPTH) { pg8::EpiResidLn<1, false, false> E{F.in, F.ws, F.out, l, F.lds + LDS_XCH}; pg8::gemm_phase<pg8::EpiResidLn<1, false, false>>(F.lds, g, S, E, F.tid); }
                else { pg8::EpiResidLn<1, false, true> E{F.in, F.ws, F.out, l, F.lds + LDS_XCH}; pg8::gemm_phase<pg8::EpiResidLn<1, false, true>>(F.lds, g, S, E, F.tid); } }
            }
        }
        if (ph + 1 < args.ph_hi) {
            if (ph == args.ph_lo) { cg::this_grid().sync(); xbar = xcd_barrier_post(barw, bst); }
            else xcd_barrier(xbar);
            if (PROBE == 1 && ph == 1) { for (int k = 0; k < 20; ++k) xcd_barrier(xbar); }
        }
    }
}

extern "C" void kernel_launch(void* const* d_in, const int* in_sizes, int n_in, void* d_out, int out_size, void* d_ws, size_t ws_size, hipStream_t stream) {
    static int grid = 0;
    if (grid == 0) {
        if (n_in != 25 || ws_size < WS_END) { fprintf(stderr, "kernel_launch: unexpected n_in %d / ws %zu\n", n_in, ws_size); grid = -1; return; }
        int dev = 0, cus = 0, per_cu = 0;
        if (hipGetDevice(&dev) != hipSuccess || hipDeviceGetAttribute(&cus, hipDeviceAttributeMultiprocessorCount, dev) != hipSuccess) { grid = -1; return; }
        if (hipFuncSetAttribute((const void*)fwd_kernel, hipFuncAttributeMaxDynamicSharedMemorySize, LDS_BYTES) != hipSuccess) { fprintf(stderr, "kernel_launch: hipFuncSetAttribute failed\n"); grid = -1; return; }
        if (hipOccupancyMaxActiveBlocksPerMultiprocessor(&per_cu, (const void*)fwd_kernel, NW * 64, LDS_BYTES) != hipSuccess || per_cu < 1) per_cu = 1;
        (void)hipGetLastError();
        grid = cus * (per_cu > 1 ? 1 : per_cu);
    }
    if (grid < 0) return;
    Args a{};
    for (int i = 0; i < 25; ++i) a.in[i] = (const float*)d_in[i];
    a.out = (float*)d_out; a.ws = (unsigned char*)d_ws;
#if MK_MULTI
    for (int ph = 0; ph < NPHASE; ++ph) { a.ph_lo = ph; a.ph_hi = ph + 1; hipLaunchKernelGGL(fwd_kernel, dim3(grid), dim3(NW * 64), LDS_BYTES, stream, a); }
#else
    a.ph_lo = 0; a.ph_hi = NPHASE;
    void* kargs[] = {&a};
    hipError_t e = hipLaunchCooperativeKernel((const void*)fwd_kernel, dim3(grid), dim3(NW * 64), kargs, LDS_BYTES, stream);
    if (e != hipSuccess) fprintf(stderr, "cooperative launch failed: %s (grid %d)\n", hipGetErrorString(e), grid);
#endif
}
```
